# Optimizing an MI355X kernel written in HIP

```python
import math
import jax, jax.numpy as jnp
from jax import lax
import numpy as np

D_MODEL = 1024
BATCH = 4
SEQ = 4096
DEPTH = 1

CHUNK = 64
Q_BLOCK = 128
EPS = 1e-6

SB_HEADS = 8
SB_HEAD_DIM = 64
SB_WIDTH = SB_HEADS * SB_HEAD_DIM

MLA_HEADS = 8
MLA_NOPE_DIM = 64
MLA_ROPE_DIM = 32
MLA_QK_DIM = MLA_NOPE_DIM + MLA_ROPE_DIM
MLA_V_DIM = 64
MLA_Q_LORA = 384
MLA_KV_LORA = 256
MLA_WIDTH = MLA_HEADS * MLA_V_DIM
ROPE_THETA = 10000.0

IN_COLS = (SB_WIDTH, SB_WIDTH, SB_WIDTH,
           MLA_Q_LORA, MLA_KV_LORA, MLA_ROPE_DIM,
           D_MODEL, D_MODEL)
IN_WIDTH = sum(IN_COLS)
IN_SPLITS = tuple(int(c) for c in np.cumsum(IN_COLS)[:-1])

N_EXPERTS = 32
TOP_K = 4
D_FF = 1024
SWIGLU_LIMIT = 7.0
SWIGLU_ALPHA = 1.702
EXPERT_BLOCK = 256

kernel_name = "hybrid_stickbreak_mla_moe_block"


def rmsnorm(x, g):
    xf = x.astype(jnp.float32)
    xf = xf * lax.rsqrt(jnp.mean(xf * xf, axis=-1, keepdims=True) + EPS)
    return (xf * g.astype(jnp.float32)).astype(x.dtype)


def apply_rope(x, positions):
    half = MLA_ROPE_DIM // 2
    inv_freq = ROPE_THETA ** (-jnp.arange(half, dtype=jnp.float32) / half)
    ang = positions.astype(jnp.float32)[:, :, None, None] * inv_freq
    cos = jnp.cos(ang).astype(x.dtype)
    sin = jnp.sin(ang).astype(x.dtype)
    x1, x2 = x[..., :half], x[..., half:]
    return jnp.concatenate([x1 * cos - x2 * sin, x2 * cos + x1 * sin], axis=-1)


def stick_breaking_attention(q, k, v):
    seq = q.shape[2]
    scale = 1.0 / math.sqrt(q.shape[-1])
    outs = []
    for i in range(seq // Q_BLOCK):
        q0 = i * Q_BLOCK
        kn = q0 + Q_BLOCK
        z = jnp.einsum('bhqd,bhkd->bhqk', q[:, :, q0:kn], k[:, :, :kn]).astype(jnp.float32) * scale
        t_idx = q0 + jnp.arange(Q_BLOCK)[:, None]
        s_idx = jnp.arange(kn)[None, :]
        strict = s_idx < t_idx
        log_beta = jax.nn.log_sigmoid(z)
        log_stay = jnp.where(strict, log_beta - z, 0.0)
        later = lax.cumsum(log_stay, axis=3, reverse=True) - log_stay
        a = jnp.where(strict, jnp.exp(log_beta + later), 0.0)
        outs.append(jnp.einsum('bhqk,bhkd->bhqd', a.astype(v.dtype), v[:, :, :kn]))
    return jnp.concatenate(outs, axis=2)


def chunk_causal_softmax_attention(q, k, v):
    seq = q.shape[2]
    scale = 1.0 / math.sqrt(q.shape[-1])
    outs = []
    for i in range(seq // Q_BLOCK):
        q0 = i * Q_BLOCK
        kn = q0 + Q_BLOCK
        s = jnp.einsum('bhqd,bhkd->bhqk', q[:, :, q0:kn], k[:, :, :kn]).astype(jnp.float32) * scale
        q_chunk = (q0 + jnp.arange(Q_BLOCK))[:, None] // CHUNK
        k_chunk = jnp.arange(kn)[None, :] // CHUNK
        s = jnp.where(k_chunk <= q_chunk, s, -jnp.inf)
        p = jax.nn.softmax(s, axis=-1)
        outs.append(jnp.einsum('bhqk,bhkd->bhqd', p.astype(v.dtype), v[:, :, :kn]))
    return jnp.concatenate(outs, axis=2)


def moe_ffn(h, w_router, b_router, w_up, b_up, w_down, b_down):
    n_tok, d = h.shape
    logits = (h @ w_router + b_router).astype(jnp.float32)
    top_logit, top_idx = lax.top_k(logits, TOP_K)
    top_w = jax.nn.softmax(top_logit, axis=-1)
    n_assign = n_tok * TOP_K
    e_flat = top_idx.reshape(n_assign).astype(jnp.int32)
    tok_flat = jnp.repeat(jnp.arange(n_tok, dtype=jnp.int32), TOP_K)
    w_flat = top_w.reshape(n_assign)
    order = jnp.argsort(e_flat)
    e_sorted = e_flat[order]
    counts = jnp.bincount(e_flat, length=N_EXPERTS)
    padded = (counts + EXPERT_BLOCK - 1) // EXPERT_BLOCK * EXPERT_BLOCK
    starts = jnp.cumsum(counts) - counts
    pad_starts = jnp.cumsum(padded) - padded
    dest = pad_starts[e_sorted] + jnp.arange(n_assign, dtype=jnp.int32) - starts[e_sorted]
    n_blocks = -(-(n_assign + N_EXPERTS * (EXPERT_BLOCK - 1)) // EXPERT_BLOCK)
    n_rows = n_blocks * EXPERT_BLOCK
    row_tok = jnp.full((n_rows,), n_tok, jnp.int32).at[dest].set(tok_flat[order])
    row_w = jnp.zeros((n_rows,), jnp.float32).at[dest].set(w_flat[order])
    block_start = jnp.arange(n_blocks, dtype=jnp.int32) * EXPERT_BLOCK
    block_expert = jnp.minimum(jnp.searchsorted(pad_starts + padded, block_start, side='right'),
                               N_EXPERTS - 1).astype(jnp.int32)
    h_pad = jnp.concatenate([h, jnp.zeros((1, d), h.dtype)], axis=0)
    xb = h_pad[row_tok].reshape(n_blocks, EXPERT_BLOCK, d)

    def expert_block(args):
        xblk, e = args
        gu = xblk @ w_up[e] + b_up[e]
        x_glu = jnp.minimum(gu[:, 0::2], SWIGLU_LIMIT)
        x_lin = jnp.clip(gu[:, 1::2], -SWIGLU_LIMIT, SWIGLU_LIMIT)
        act = x_glu * jax.nn.sigmoid(SWIGLU_ALPHA * x_glu) * (x_lin + 1.0)
        return act @ w_down[e] + b_down[e]

    yb = lax.map(expert_block, (xb, block_expert))
    y_rows = yb.reshape(n_rows, d) * row_w[:, None].astype(yb.dtype)
    return jax.ops.segment_sum(y_rows, row_tok, num_segments=n_tok + 1)[:n_tok].astype(h.dtype)


def setup_inputs(seed: int = 0) -> dict:
    key = jax.random.key(seed)
    ks = jax.random.split(key, 22)

    def dense(k, shape, fan_in):
        return jax.random.normal(k, shape, jnp.float32) * (fan_in ** -0.5)

    def gain(k, shape):
        return 1.0 + 0.05 * jax.random.normal(k, shape, jnp.float32)

    def small(k, shape):
        return 0.01 * jax.random.normal(k, shape, jnp.float32)

    offsets = jax.random.randint(ks[1], (BATCH, 1), 0, 1024, dtype=jnp.int32)
    positions = jnp.arange(SEQ, dtype=jnp.int32)[None, :] + offsets
    return {
        "x": jax.random.normal(ks[0], (BATCH, SEQ, D_MODEL), jnp.float32),
        "positions": positions,
        "g_mix": gain(ks[2], (DEPTH, D_MODEL)),
        "w_in": dense(ks[3], (DEPTH, D_MODEL, IN_WIDTH), D_MODEL),
        "g_cq": gain(ks[4], (DEPTH, MLA_Q_LORA)),
        "w_uq": dense(ks[5], (DEPTH, MLA_Q_LORA, MLA_HEADS * MLA_QK_DIM), MLA_Q_LORA),
        "g_ckv": gain(ks[6], (DEPTH, MLA_KV_LORA)),
        "w_ukv": dense(ks[7], (DEPTH, MLA_KV_LORA, MLA_HEADS * (MLA_NOPE_DIM + MLA_V_DIM)), MLA_KV_LORA),
        "g_qnorm": gain(ks[8], (DEPTH, MLA_QK_DIM)),
        "g_knorm": gain(ks[9], (DEPTH, MLA_QK_DIM)),
        "w_o_sb": dense(ks[10], (DEPTH, SB_WIDTH, D_MODEL), SB_WIDTH),
        "w_o_mla": dense(ks[11], (DEPTH, MLA_WIDTH, D_MODEL), MLA_WIDTH),
        "w_out": dense(ks[12], (DEPTH, D_MODEL, D_MODEL), D_MODEL),
        "g_ffn": gain(ks[13], (DEPTH, D_MODEL)),
        "w_router": dense(ks[14], (DEPTH, D_MODEL, N_EXPERTS), D_MODEL),
        "b_router": small(ks[15], (DEPTH, N_EXPERTS)),
        "w_up": dense(ks[16], (DEPTH, N_EXPERTS, D_MODEL, 2 * D_FF), D_MODEL),
        "b_up": small(ks[17], (DEPTH, N_EXPERTS, 2 * D_FF)),
        "w_down": dense(ks[18], (DEPTH, N_EXPERTS, D_FF, D_MODEL), D_FF),
        "b_down": small(ks[19], (DEPTH, N_EXPERTS, D_MODEL)),
    }


def reference(x, positions, g_mix, w_in, g_cq, w_uq, g_ckv, w_ukv, g_qnorm, g_knorm,
              w_o_sb, w_o_mla, w_out, g_ffn, w_router, b_router, w_up, b_up, w_down, b_down):
    bsz, seq, d = x.shape
    for l in range(DEPTH):
        h = rmsnorm(x, g_mix[l])
        proj = h @ w_in[l]
        sb_q, sb_k, sb_v, c_q, c_kv, k_rope, gate_sb, gate_mla = jnp.split(proj, IN_SPLITS, axis=-1)

        def sb_heads(t):
            return t.reshape(bsz, seq, SB_HEADS, SB_HEAD_DIM).transpose(0, 2, 1, 3)
        o_sb = stick_breaking_attention(sb_heads(sb_q), sb_heads(sb_k), sb_heads(sb_v))
        o_sb = o_sb.transpose(0, 2, 1, 3).reshape(bsz, seq, SB_WIDTH)

        q = (rmsnorm(c_q, g_cq[l]) @ w_uq[l]).reshape(bsz, seq, MLA_HEADS, MLA_QK_DIM)
        q = rmsnorm(q, g_qnorm[l])
        q = jnp.concatenate([q[..., :MLA_NOPE_DIM], apply_rope(q[..., MLA_NOPE_DIM:], positions)], axis=-1)
        kv = (rmsnorm(c_kv, g_ckv[l]) @ w_ukv[l]).reshape(bsz, seq, MLA_HEADS, MLA_NOPE_DIM + MLA_V_DIM)
        k_nope, v = kv[..., :MLA_NOPE_DIM], kv[..., MLA_NOPE_DIM:]
        k_r = jnp.broadcast_to(k_rope[:, :, None, :], (bsz, seq, MLA_HEADS, MLA_ROPE_DIM))
        k = rmsnorm(jnp.concatenate([k_nope, k_r], axis=-1), g_knorm[l])
        k = jnp.concatenate([k[..., :MLA_NOPE_DIM], apply_rope(k[..., MLA_NOPE_DIM:], positions)], axis=-1)
        o_mla = chunk_causal_softmax_attention(q.transpose(0, 2, 1, 3), k.transpose(0, 2, 1, 3),
                                               v.transpose(0, 2, 1, 3))
        o_mla = o_mla.transpose(0, 2, 1, 3).reshape(bsz, seq, MLA_WIDTH)

        mixed = (jax.nn.sigmoid(gate_sb) * (o_sb @ w_o_sb[l])
                 + jax.nn.sigmoid(gate_mla) * (o_mla @ w_o_mla[l]))
        x = x + mixed @ w_out[l]

        h2 = rmsnorm(x, g_ffn[l]).reshape(bsz * seq, d)
        y = moe_ffn(h2, w_router[l], b_router[l], w_up[l], b_up[l], w_down[l], b_down[l])
        x = x + y.reshape(bsz, seq, d)
    return x
```

```cpp
#define N_LAUNCH_SPLIT 0
#include <hip/hip_runtime.h>
#include <hip/hip_bf16.h>
#include <cstdio>
#include <cstdint>
#include <cstring>
#include <cmath>

constexpr int B_ = 4, S_ = 4096, D_ = 1024, M_ = B_ * S_;
constexpr int INW = 4256, INWP = 4352;
constexpr int C_SBQ = 0, C_SBK = 512, C_SBV = 1024, C_CQ = 1536, C_CKV = 1920, C_KR = 2176, C_GSB = 2208, C_GMLA = 3232;
constexpr int NE = 32, TOPK = 4, DFF = 1024;
constexpr float EPS = 1e-6f;
constexpr float LOG2E = 1.4426950408889634f;
constexpr float SB_QSCALE = 0.125f * LOG2E;
constexpr float MLA_QSCALE = 0.10206207261596577f * LOG2E;
constexpr int NWAVES = 8, NTHR = 512;

#define LAS __attribute__((address_space(3)))
#define GAS __attribute__((address_space(1)))
typedef unsigned short bf16_t;
typedef short bf16x8 __attribute__((ext_vector_type(8)));
typedef short s16x4 __attribute__((ext_vector_type(4)));
typedef float f32x4 __attribute__((ext_vector_type(4)));
typedef float f32x16 __attribute__((ext_vector_type(16)));
typedef unsigned u32x4 __attribute__((ext_vector_type(4)));
typedef unsigned u32x2 __attribute__((ext_vector_type(2)));
typedef float f32x2_t __attribute__((ext_vector_type(2)));
typedef __bf16 bf16x2_t __attribute__((ext_vector_type(2)));

__device__ __forceinline__ unsigned cvtpk(float lo, float hi) { f32x2_t v = {lo, hi}; bf16x2_t b = __builtin_convertvector(v, bf16x2_t); return __builtin_bit_cast(unsigned, b); }
__device__ __forceinline__ float bf2f(unsigned short h) { return __uint_as_float(((unsigned)h) << 16); }
__device__ __forceinline__ float bflo(unsigned w) { return __uint_as_float(w << 16); }
__device__ __forceinline__ float bfhi(unsigned w) { return __uint_as_float(w & 0xffff0000u); }
__device__ __forceinline__ float wave_sum(float v) {
#pragma unroll
    for (int o = 1; o < 64; o <<= 1) v += __shfl_xor(v, o);
    return v;
}
__device__ __forceinline__ float sigmoidf_(float x) { return __builtin_amdgcn_rcpf(1.f + __builtin_amdgcn_exp2f(-x * LOG2E)); }

namespace pg8 {
constexpr int BM = 256, BK = 64, HALF = 128, HTB = HALF * BK * 2, STAGE_BYTES = 8 * HTB, NXCD = 8, WGM = 8;
__host__ __device__ __forceinline__ int lds_byte(int r, int c) { const int st = (r >> 4) * 2 + (c >> 5), rr = r & 15, cc = c & 31, ob = rr * 64 + cc * 2; return st * 1024 + (ob ^ (((ob >> 9) & 1) << 5)); }
__host__ __device__ __forceinline__ void stage_rc(int b, int& R, int& C) { const int st = b / 1024, sb = b % 1024, swz = sb ^ (((sb >> 9) & 1) << 5); R = (st >> 1) * 16 + swz / 64; C = (st & 1) * 32 + (swz % 64) / 2; }
__host__ __device__ __forceinline__ int perm32(int rho) { const int n = rho >> 4, i = rho & 15; return 8 * (i >> 2) + 4 * n + (i & 3); }

struct Unit { int pm, pn, e, rows, rt; };
struct Gemm { const bf16_t* A; int lda, ldb, K; };

struct StaticOrder {
    const bf16_t* A; const bf16_t* Bt; int lda, ldb;
    int nM, nN, nwg, G, c;
    __device__ void init(const bf16_t* A_, int lda_, const bf16_t* Bt_, int ldb_, int M, int N, int G_, int c_) { A = A_; Bt = Bt_; lda = lda_; ldb = ldb_; nM = M / BM; nN = N / BM; nwg = nM * nN; G = G_; c = c_; }
    __device__ __forceinline__ bool next(int i, Unit& u) const {
        const long L = (long)i * G + c; if (L >= nwg) return false;
        int wgid = (int)L; { const int q = nwg / NXCD, r = nwg % NXCD, xcd = wgid % NXCD, off = wgid / NXCD; wgid = (xcd < r ? xcd * (q + 1) : r * (q + 1) + (xcd - r) * q) + off; }
        const int nig = WGM * nN, gid = wgid / nig, fm = gid * WGM, gsz = (nM - fm) < WGM ? (nM - fm) : WGM;
        u.pm = fm + ((wgid % nig) % gsz); u.pn = (wgid % nig) / gsz; u.e = 0; u.rows = 256; u.rt = 0; return true;
    }
    __device__ __forceinline__ unsigned a_off(const Unit& u, int r, int C) const { return (unsigned)(((u.pm * BM + r) * lda + C) * 2); }
    __device__ __forceinline__ const char* b_base(const Unit& u) const { return (const char*)(Bt + (size_t)u.pn * BM * ldb); }
};

template <class Epi, class Sched>
__device__ __forceinline__ void gemm_phase(LAS unsigned char* lds, const Gemm g, const Sched& S, const Epi& E) {
    const int tid = threadIdx.x, wid = __builtin_amdgcn_readfirstlane(tid >> 6), lane = tid & 63, wr = wid >> 2, wc = wid & 3, fr = lane & 15, fq = lane >> 4;
    const int K = g.K, nt = K / BK;
    int Rs[2], Cs[2]; unsigned voffB[2];
#pragma unroll
    for (int i = 0; i < 2; ++i) { int R, C; stage_rc(tid * 16 + i * 8192, R, C); Rs[i] = R; Cs[i] = C; const int Rb = Epi::PERM ? ((R & ~31) + perm32(R & 31)) : R; voffB[i] = (unsigned)(Rb * g.ldb + C) * 2u; }
    const size_t kstep = (size_t)(BK * 2);
    const size_t hstepB = (size_t)HALF * g.ldb * 2;
    const unsigned ldsw = (unsigned)wid * 1024u;
    const int aoff = lds_byte(wr * 64 + fr, fq * 8), boff = lds_byte(wc * 32 + fr, fq * 8);
#define PG8_SA(b, h) (((b) * 2 + (h)) * HTB)
#define PG8_SB(b, h) ((4 + (b) * 2 + (h)) * HTB)
#define PG8_STAGE(bufoff, gbase, voff) do { _Pragma("unroll") for (int _i = 0; _i < 2; ++_i) \
        __builtin_amdgcn_global_load_lds((const unsigned*)((const char*)(gbase) + (voff)[_i]), (LAS unsigned*)(lds + (bufoff) + ldsw + _i * 8192), 16, 0, 0); } while (0)
#define PG8_LDA(dst, b, h) do { _Pragma("unroll") for (int m = 0; m < 4; ++m) _Pragma("unroll") for (int k = 0; k < 2; ++k) dst[m][k] = *(const LAS bf16x8*)(lds + PG8_SA(b, h) + aoff + m * 2048 + k * 1024); } while (0)
#define PG8_LDB(dst, b, h) do { _Pragma("unroll") for (int n = 0; n < 2; ++n) _Pragma("unroll") for (int k = 0; k < 2; ++k) dst[n][k] = *(const LAS bf16x8*)(lds + PG8_SB(b, h) + boff + n * 2048 + k * 1024); } while (0)
#define PG8_MMA(ai, bj, At, Bt) do { __builtin_amdgcn_s_setprio(1); _Pragma("unroll") for (int m = 0; m < 4; ++m) _Pragma("unroll") for (int n = 0; n < 2; ++n) _Pragma("unroll") for (int k = 0; k < 2; ++k) \
        acc[ai][bj][m][n] = __builtin_amdgcn_mfma_f32_16x16x32_bf16(Bt[n][k], At[m][k], acc[ai][bj][m][n], 0, 0, 0); __builtin_amdgcn_s_setprio(0); } while (0)
#define PG8_WAIT_V(n) asm volatile("s_waitcnt vmcnt(" #n ")" ::: "memory")
#define PG8_WAIT_L(n) asm volatile("s_waitcnt lgkmcnt(" #n ")" ::: "memory")
#define PG8_BAR __builtin_amdgcn_s_barrier()
#define PG8_SCHED __builtin_amdgcn_sched_barrier(0)
    Unit cur, nxt; int ui = 0;
    if (!S.next(0, cur)) return;
    f32x4 acc[2][2][4][2];
#pragma unroll
    for (int a = 0; a < 2; ++a)
#pragma unroll
        for (int b = 0; b < 2; ++b)
#pragma unroll
            for (int m = 0; m < 4; ++m)
#pragma unroll
                for (int n = 0; n < 2; ++n) acc[a][b][m][n] = (f32x4){0.f, 0.f, 0.f, 0.f};
    bf16x8 At[4][2], B0[2][2], B1[2][2];
    const char* Ab = (const char*)g.A;
    const char* cB = S.b_base(cur);
    unsigned vaC[2][2], vaN[2][2];
#pragma unroll
    for (int h = 0; h < 2; ++h)
#pragma unroll
        for (int i = 0; i < 2; ++i) vaC[h][i] = S.a_off(cur, h * HALF + Rs[i], Cs[i]);
    PG8_STAGE(PG8_SB(0, 0), cB, voffB); PG8_STAGE(PG8_SB(0, 1), cB + hstepB, voffB); PG8_STAGE(PG8_SA(0, 0), Ab, vaC[0]); PG8_STAGE(PG8_SA(0, 1), Ab, vaC[1]);
    if (wr == 1) PG8_BAR;
    PG8_WAIT_V(2); PG8_BAR;
    PG8_STAGE(PG8_SB(1, 0), cB + kstep, voffB); PG8_STAGE(PG8_SA(1, 0), Ab + kstep, vaC[0]); PG8_STAGE(PG8_SB(1, 1), cB + hstepB + kstep, voffB);
    PG8_WAIT_V(6); PG8_BAR;
    for (;;) {
        const bool has_next = S.next(ui + 1, nxt);
        const char* nB = has_next ? S.b_base(nxt) : cB;
#pragma unroll
        for (int h = 0; h < 2; ++h)
#pragma unroll
            for (int i = 0; i < 2; ++i) vaN[h][i] = has_next ? S.a_off(nxt, h * HALF + Rs[i], Cs[i]) : vaC[h][i];
        for (int t = 0; t < nt; t += 2) {
            const bool last = (t == nt - 2);
            const char* kA1 = Ab + (size_t)(t + 1) * kstep;
            const char* kA2 = last ? Ab : Ab + (size_t)(t + 2) * kstep; const char* b2 = last ? nB : cB + (size_t)(t + 2) * kstep;
            const char* kA3 = kA2 + kstep; const char* b3 = b2 + kstep;
            unsigned o2[2][2];
#pragma unroll
            for (int h = 0; h < 2; ++h)
#pragma unroll
                for (int i = 0; i < 2; ++i) o2[h][i] = last ? vaN[h][i] : vaC[h][i];
            PG8_LDB(B0, 0, 0); PG8_LDB(B1, 0, 1); PG8_SCHED; PG8_LDA(At, 0, 0); PG8_STAGE(PG8_SA(1, 1), kA1, vaC[1]);
            PG8_WAIT_V(8); PG8_WAIT_L(0); PG8_BAR; PG8_MMA(0, 0, At, B0); PG8_MMA(0, 1, At, B1); PG8_BAR; PG8_SCHED;
            PG8_LDA(At, 0, 1); PG8_STAGE(PG8_SB(0, 0), b2, voffB); PG8_STAGE(PG8_SB(0, 1), b2 + hstepB, voffB); PG8_STAGE(PG8_SA(0, 0), kA2, o2[0]);
            PG8_WAIT_V(8); PG8_WAIT_L(0); PG8_BAR; PG8_MMA(1, 0, At, B0); PG8_MMA(1, 1, At, B1); PG8_BAR; PG8_SCHED;
            PG8_LDB(B0, 1, 0); PG8_LDB(B1, 1, 1); PG8_SCHED; PG8_LDA(At, 1, 0); PG8_STAGE(PG8_SA(0, 1), kA2, o2[1]);
            PG8_WAIT_V(8); PG8_WAIT_L(0); PG8_BAR; PG8_MMA(0, 0, At, B0); PG8_MMA(0, 1, At, B1); PG8_BAR; PG8_SCHED;
            PG8_LDA(At, 1, 1); PG8_STAGE(PG8_SB(1, 0), b3, voffB); PG8_STAGE(PG8_SB(1, 1), b3 + hstepB, voffB); PG8_STAGE(PG8_SA(1, 0), kA3, o2[0]);
            PG8_WAIT_V(8); PG8_WAIT_L(0); PG8_BAR; PG8_MMA(1, 0, At, B0); PG8_MMA(1, 1, At, B1); PG8_BAR; PG8_SCHED;
        }
        if (wr == 0) PG8_BAR;
        E(acc, cur, wr, wc, fr, fq);
        if (!has_next) break;
#pragma unroll
        for (int a = 0; a < 2; ++a)
#pragma unroll
            for (int b = 0; b < 2; ++b)
#pragma unroll
                for (int m = 0; m < 4; ++m)
#pragma unroll
                    for (int n = 0; n < 2; ++n) acc[a][b][m][n] = (f32x4){0.f, 0.f, 0.f, 0.f};
        cur = nxt; cB = nB; ++ui;
#pragma unroll
        for (int h = 0; h < 2; ++h)
#pragma unroll
            for (int i = 0; i < 2; ++i) vaC[h][i] = vaN[h][i];
        if (wr == 1) PG8_BAR;
    }
    PG8_WAIT_V(0);
    PG8_BAR;
#undef PG8_SA
#undef PG8_SB
#undef PG8_STAGE
#undef PG8_LDA
#undef PG8_LDB
#undef PG8_MMA
#undef PG8_WAIT_V
#undef PG8_WAIT_L
#undef PG8_BAR
#undef PG8_SCHED
}

struct EpiBf16 {
    static constexpr bool PERM = true;
    bf16_t* O; int ldc;
    __device__ __forceinline__ void operator()(const f32x4 (&acc)[2][2][4][2], const Unit& u, int wr, int wc, int fr, int fq) const {
        const int row0 = u.pm * BM + wr * 64 + fr, col0 = u.pn * BM + wc * 32 + 8 * fq;
#pragma unroll
        for (int ai = 0; ai < 2; ++ai)
#pragma unroll
            for (int m = 0; m < 4; ++m) { bf16_t* rowp = O + (size_t)(row0 + ai * HALF + m * 16) * ldc + col0;
#pragma unroll
                for (int bj = 0; bj < 2; ++bj) { const f32x4 v0 = acc[ai][bj][m][0], v1 = acc[ai][bj][m][1];
                    u32x4 w; w.x = cvtpk(v0[0], v0[1]); w.y = cvtpk(v0[2], v0[3]); w.z = cvtpk(v1[0], v1[1]); w.w = cvtpk(v1[2], v1[3]);
                    *(u32x4*)(rowp + bj * HALF) = w; } }
    }
};
template <bool FIRST> struct EpiGate {
    static constexpr bool PERM = true;
    bf16_t* O; const bf16_t* G; int ldg, gcol;
    __device__ __forceinline__ void operator()(const f32x4 (&acc)[2][2][4][2], const Unit& u, int wr, int wc, int fr, int fq) const {
        const int row0 = u.pm * BM + wr * 64 + fr, col0 = u.pn * BM + wc * 32 + 8 * fq;
#pragma unroll
        for (int ai = 0; ai < 2; ++ai)
#pragma unroll
            for (int m = 0; m < 4; ++m) { const size_t r = (size_t)(row0 + ai * HALF + m * 16);
#pragma unroll
                for (int bj = 0; bj < 2; ++bj) { const f32x4 v0 = acc[ai][bj][m][0], v1 = acc[ai][bj][m][1];
                    const int c = col0 + bj * HALF;
                    const u32x4 gw = *(const u32x4*)(G + r * ldg + gcol + c);
                    float o[8];
                    o[0] = sigmoidf_(bflo(gw.x)) * v0[0]; o[1] = sigmoidf_(bfhi(gw.x)) * v0[1]; o[2] = sigmoidf_(bflo(gw.y)) * v0[2]; o[3] = sigmoidf_(bfhi(gw.y)) * v0[3];
                    o[4] = sigmoidf_(bflo(gw.z)) * v1[0]; o[5] = sigmoidf_(bfhi(gw.z)) * v1[1]; o[6] = sigmoidf_(bflo(gw.w)) * v1[2]; o[7] = sigmoidf_(bfhi(gw.w)) * v1[3];
                    bf16_t* op = O + r * D_ + c;
                    if (!FIRST) { const u32x4 pw = *(const u32x4*)op;
                        o[0] += bflo(pw.x); o[1] += bfhi(pw.x); o[2] += bflo(pw.y); o[3] += bfhi(pw.y); o[4] += bflo(pw.z); o[5] += bfhi(pw.z); o[6] += bflo(pw.w); o[7] += bfhi(pw.w); }
                    u32x4 w; w.x = cvtpk(o[0], o[1]); w.y = cvtpk(o[2], o[3]); w.z = cvtpk(o[4], o[5]); w.w = cvtpk(o[6], o[7]);
                    *(u32x4*)op = w; } }
    }
};
struct EpiRes {
    static constexpr bool PERM = false;
    const float* base; float* out;
    __device__ __forceinline__ void operator()(const f32x4 (&acc)[2][2][4][2], const Unit& u, int wr, int wc, int fr, int fq) const {
        const int row0 = u.pm * BM + wr * 64 + fr, col0 = u.pn * BM + wc * 32 + 4 * fq;
#pragma unroll
        for (int ai = 0; ai < 2; ++ai)
#pragma unroll
            for (int m = 0; m < 4; ++m) { const size_t off = (size_t)(row0 + ai * HALF + m * 16) * D_ + col0;
#pragma unroll
                for (int bj = 0; bj < 2; ++bj)
#pragma unroll
                    for (int n = 0; n < 2; ++n) { const f32x4 b = *(const f32x4*)(base + off + bj * HALF + n * 16); *(f32x4*)(out + off + bj * HALF + n * 16) = b + acc[ai][bj][m][n]; } }
    }
};
struct EpiSwiglu {
    static constexpr bool PERM = true;
    bf16_t* act; const float* b_up;
    __device__ __forceinline__ void operator()(const f32x4 (&acc)[2][2][4][2], const Unit& u, int wr, int wc, int fr, int fq) const {
        const int row0 = u.pm * BM + wr * 64 + fr, col0 = u.pn * BM + wc * 32 + 8 * fq;
        const float* bb = b_up + (size_t)u.e * (2 * DFF);
        f32x4 bv[2][2];
#pragma unroll
        for (int bj = 0; bj < 2; ++bj)
#pragma unroll
            for (int n = 0; n < 2; ++n) bv[bj][n] = *(const f32x4*)(bb + col0 + bj * HALF + 4 * n);
#pragma unroll
        for (int ai = 0; ai < 2; ++ai)
#pragma unroll
            for (int m = 0; m < 4; ++m) { bf16_t* rowp = act + (size_t)(row0 + ai * HALF + m * 16) * DFF + (col0 >> 1);
#pragma unroll
                for (int bj = 0; bj < 2; ++bj) { const f32x4 v0 = acc[ai][bj][m][0] + bv[bj][0], v1 = acc[ai][bj][m][1] + bv[bj][1];
                    float a[4];
#pragma unroll
                    for (int p = 0; p < 4; ++p) { float gl = (p < 2) ? v0[2 * p] : v1[2 * p - 4], li = (p < 2) ? v0[2 * p + 1] : v1[2 * p - 3];
                        gl = fminf(gl, 7.f); li = fminf(fmaxf(li, -7.f), 7.f);
                        a[p] = gl * sigmoidf_(1.702f * gl) * (li + 1.f); }
                    u32x2 w; w.x = cvtpk(a[0], a[1]); w.y = cvtpk(a[2], a[3]);
                    *(u32x2*)(rowp + bj * (HALF / 2)) = w; } }
    }
};
struct EpiDown {
    static constexpr bool PERM = true;
    bf16_t* y; const float* b_down; const int* list; const float* topw;
    __device__ __forceinline__ void operator()(const f32x4 (&acc)[2][2][4][2], const Unit& u, int wr, int wc, int fr, int fq) const {
        const int col0 = u.pn * BM + wc * 32 + 8 * fq;
        const float* bb = b_down + (size_t)u.e * D_;
        f32x4 bv[2][2];
#pragma unroll
        for (int bj = 0; bj < 2; ++bj)
#pragma unroll
            for (int n = 0; n < 2; ++n) bv[bj][n] = *(const f32x4*)(bb + col0 + bj * HALF + 4 * n);
        const int* lp = list + (size_t)u.e * M_ + u.rt * BM;
#pragma unroll
        for (int ai = 0; ai < 2; ++ai)
#pragma unroll
            for (int m = 0; m < 4; ++m) { const int r = ai * HALF + wr * 64 + m * 16 + fr;
                if (r < u.rows) { const int slot = lp[r]; const float w = topw[slot]; bf16_t* rowp = y + (size_t)slot * D_ + col0;
#pragma unroll
                    for (int bj = 0; bj < 2; ++bj) { const f32x4 v0 = (acc[ai][bj][m][0] + bv[bj][0]) * w, v1 = (acc[ai][bj][m][1] + bv[bj][1]) * w;
                        u32x4 o; o.x = cvtpk(v0[0], v0[1]); o.y = cvtpk(v0[2], v0[3]); o.z = cvtpk(v1[0], v1[1]); o.w = cvtpk(v1[2], v1[3]);
                        *(u32x4*)(rowp + bj * HALF) = o; } } }
    }
};
}
constexpr size_t MiB = 1ull << 20;
constexpr size_t WS_CTL = 0, CTL_ZERO_BYTES = 64 * 1024;
constexpr size_t WS_ROPE = 256 * 1024;
constexpr size_t WS_WR = 3 * MiB;
constexpr size_t WS_LIST = 4 * MiB;
constexpr size_t WS_TOPW = 6 * MiB;
constexpr size_t WS_SEL = 6 * MiB + 512 * 1024;
constexpr size_t WS_WIN = 8 * MiB;
constexpr size_t WS_WUQ = 17 * MiB;
constexpr size_t WS_WUKV = 18 * MiB;
constexpr size_t WS_WOSB = 19 * MiB;
constexpr size_t WS_WOMLA = 20 * MiB;
constexpr size_t WS_WOUT = 21 * MiB;
constexpr size_t WS_WUP = 24 * MiB;
constexpr size_t WS_WDN = 152 * MiB;
constexpr size_t WS_HB = 216 * MiB;
constexpr size_t WS_PROJ = 249 * MiB;
constexpr size_t WS_ACT = WS_PROJ;
constexpr size_t WS_QRAW = 393 * MiB;
constexpr size_t WS_KVRAW = WS_QRAW + 24 * MiB;
constexpr size_t WS_QB = WS_KVRAW + 32 * MiB;
constexpr size_t WS_KB = WS_QB + 24 * MiB;
constexpr size_t WS_VB = WS_KB + 24 * MiB;
constexpr size_t WS_OSB = WS_VB + 16 * MiB;
constexpr size_t WS_OMLA = WS_OSB + 16 * MiB;
constexpr size_t WS_YB = WS_QRAW;
constexpr size_t WS_MIX = 545 * MiB;
constexpr size_t WS_OPT_END = 577 * MiB;
constexpr int CW_CNT = 0;
constexpr int CW_BAR = 1024;
constexpr int LDS_STAGE = 131072;
constexpr int LDS_MISC = LDS_STAGE;
constexpr int LDS_BYTES = 147456;
constexpr int MI_BAR = 0, MI_TPFX = 16, MI_CNT = 64, MI_FLAG = 128, MI_LCNT = 160, MI_BASE = 192, MI_RSTD = 256;

typedef GAS unsigned gu32;
#define RLX_AGENT __ATOMIC_RELAXED, __HIP_MEMORY_SCOPE_AGENT

#define XB_TMO      128
#define XB_XCNT(j)  (256  + 64 * (j))
#define XB_XSUB(j)  (1280 + 64 * (j))
#define XB_XGEN(j)  (2304 + 64 * (j))
#define XB_TOP      3328
#define XB_TOPGEN   3392
#define XCD_BAR_WORDS 3456
#define XB_SPIN_CAP (1u << 18)
__device__ __forceinline__ unsigned xb_ld(unsigned* p)              { return __hip_atomic_load(p, __ATOMIC_RELAXED, __HIP_MEMORY_SCOPE_AGENT); }
__device__ __forceinline__ unsigned xb_add(unsigned* p, unsigned v) { return __hip_atomic_fetch_add(p, v, __ATOMIC_RELAXED, __HIP_MEMORY_SCOPE_AGENT); }
__device__ __forceinline__ unsigned xb_xcc_id() { return (unsigned)__builtin_amdgcn_s_getreg((3 << 11) | 20) & 0xFu; }
#define XB_SPIN(cond, bar) do { unsigned _sp = 0; while (cond) { __builtin_amdgcn_s_sleep(1); \
    if ((++_sp & 255u) == 0u) { if (xb_ld(&(bar)[XB_TMO])) break; if (_sp > XB_SPIN_CAP) { atomicAdd(&(bar)[XB_TMO], 1u); break; } } } } while (0)
struct XcdBarrier { unsigned* bar; unsigned x; volatile LAS unsigned* st; };
__device__ __forceinline__ XcdBarrier xcd_barrier_post(unsigned* bar, volatile LAS unsigned* st) {
    XcdBarrier b; b.bar = bar; b.x = xb_xcc_id(); b.st = st;
    if (threadIdx.x == 0) (void)xb_add(&bar[XB_XCNT(b.x)], 1u);
    return b;
}
__device__ __forceinline__ void xcd_barrier_complete(unsigned* bar, unsigned x, unsigned& nloc, unsigned& nx) {
    const unsigned G = gridDim.x * gridDim.y * gridDim.z;
    unsigned sum, cnt, mine, sp = 0u;
    for (;;) {
        sum = 0u; cnt = 0u; mine = 0u;
#pragma unroll
        for (unsigned j = 0; j < 16; ++j) { const unsigned c = xb_ld(&bar[XB_XCNT(j)]); sum += c; cnt += (c > 0u) ? 1u : 0u; mine = (j == x) ? c : mine; }
        if (sum == G) break;
        __builtin_amdgcn_s_sleep(1);
        if ((++sp & 255u) == 0u) { if (xb_ld(&bar[XB_TMO])) break; if (sp > XB_SPIN_CAP) { atomicAdd(&bar[XB_TMO], 1u); break; } }
    }
    nloc = mine > 0u ? mine : 1u; nx = cnt > 0u ? cnt : 1u;
}
__device__ __forceinline__ void xcd_barrier(const XcdBarrier& b) {
    asm volatile("s_waitcnt vmcnt(0)" ::: "memory");
    __syncthreads();
    if (threadIdx.x == 0) {
        unsigned* bar = b.bar;
        __builtin_amdgcn_s_waitcnt(0);
        unsigned nloc = b.st[0], nx = b.st[1];
        if (nloc == 0u) { xcd_barrier_complete(bar, b.x, nloc, nx); b.st[0] = nloc; b.st[1] = nx; }
        const unsigned old = xb_add(&bar[XB_XSUB(b.x)], 1u);
        const unsigned gen = old / nloc;
        if (old + 1u == (gen + 1u) * nloc) {
            __builtin_amdgcn_fence(__ATOMIC_RELEASE, "agent");
            asm volatile("s_waitcnt vmcnt(0)" ::: "memory");
            const unsigned og = xb_add(&bar[XB_TOP], 1u);
            const unsigned tg = og / nx;
            if (og + 1u == (tg + 1u) * nx) xb_add(&bar[XB_TOPGEN], 1u);
            else XB_SPIN(xb_ld(&bar[XB_TOPGEN]) == tg, bar);
            __builtin_amdgcn_fence(__ATOMIC_ACQUIRE, "agent");
            xb_add(&bar[XB_XGEN(b.x)], 1u);
            asm volatile("s_waitcnt vmcnt(0)" ::: "memory");
        } else {
            XB_SPIN(xb_ld(&bar[XB_XGEN(b.x)]) == gen, bar);
            __builtin_amdgcn_fence(__ATOMIC_ACQUIRE, "agent");
            asm volatile("s_waitcnt vmcnt(0)" ::: "memory");
        }
    }
    __syncthreads();
}

struct Args {
    const float* in[20]; float* out; unsigned char* ws;
    int ph_lo, ph_hi;
};

struct Frame {
    LAS unsigned char* lds; volatile LAS unsigned* MISC;
    int tid, lane, wave, vcu, G;
    unsigned char* ws;
};

__device__ __forceinline__ void p0_transpose_item(const float* W, int K, int N, bf16_t* WT, LAS float* scr, int item, int lane, const float* gk, float cs, int csn) {
    const int nblk = N / 32, kb = item / nblk, nb = item % nblk, k0 = 64 * kb, n0 = 32 * nb;
    const float colsc = (n0 < csn) ? cs : 1.f;
#pragma unroll 8
    for (int i = 0; i < 32; ++i) { const int kk = 2 * i + (lane >> 5); float v = W[(size_t)(k0 + kk) * N + n0 + (lane & 31)] * colsc; if (gk) v *= gk[k0 + kk]; scr[kk * 33 + (lane & 31)] = v; }
    asm volatile("s_waitcnt lgkmcnt(0)" ::: "memory");
    const int c = lane & 7;
#pragma unroll
    for (int j = 0; j < 4; ++j) { const int n = (lane >> 3) + 8 * j; const LAS float* s = scr + (8 * c) * 33 + n;
        u32x4 o; o.x = cvtpk(s[0 * 33], s[1 * 33]); o.y = cvtpk(s[2 * 33], s[3 * 33]); o.z = cvtpk(s[4 * 33], s[5 * 33]); o.w = cvtpk(s[6 * 33], s[7 * 33]);
        *(u32x4*)(WT + (size_t)(n0 + n) * K + k0 + 8 * c) = o; }
    asm volatile("s_waitcnt lgkmcnt(0)" ::: "memory");
}
__device__ __forceinline__ void rms_row_to_bf16(const float* xrow, const float* g, bf16_t* orow, int lane) {
    const f32x4* xr = (const f32x4*)xrow + lane; const f32x4* gr = (const f32x4*)g + lane;
    f32x4 v[4]; float s = 0.f;
#pragma unroll
    for (int j = 0; j < 4; ++j) { v[j] = xr[64 * j]; s += (v[j].x * v[j].x + v[j].y * v[j].y) + (v[j].z * v[j].z + v[j].w * v[j].w); }
    const float rstd = rsqrtf(wave_sum(s) * (1.f / D_) + EPS);
    u32x2* o8 = (u32x2*)orow + lane;
#pragma unroll
    for (int j = 0; j < 4; ++j) { const f32x4 gg = gr[64 * j]; u32x2 w; w.x = cvtpk(v[j].x * rstd * gg.x, v[j].y * rstd * gg.y); w.y = cvtpk(v[j].z * rstd * gg.z, v[j].w * rstd * gg.w); o8[64 * j] = w; }
}
__device__ __forceinline__ void p0_prologue(Frame& F, const Args& a, int do_moe_w, int do_rest) {
    LAS float* scr = (LAS float*)(F.lds + F.wave * 16384);
    const int gw = F.vcu * NWAVES + F.wave, NGW = F.G * NWAVES;
    unsigned char* ws = F.ws;
    const float* w_in = a.in[3]; const float* g_cq = a.in[4]; const float* w_uq = a.in[5]; const float* g_ckv = a.in[6]; const float* w_ukv = a.in[7];
    const float* w_o_sb = a.in[10]; const float* w_o_mla = a.in[11]; const float* w_out = a.in[12]; const float* g_ffn = a.in[13]; const float* w_router = a.in[14];
    const float* w_up = a.in[16]; const float* w_down = a.in[18];
    constexpr int I_IN = (D_ / 64) * (INW / 32), I_UQ = (384 / 64) * (768 / 32), I_UKV = (256 / 64) * (1024 / 32), I_O = (512 / 64) * (1024 / 32), I_OUT = (1024 / 64) * (1024 / 32);
    constexpr int I_UP1 = (1024 / 64) * (2048 / 32), I_DN1 = (1024 / 64) * (1024 / 32);
    if (do_rest) {
        constexpr int NI = I_IN + I_UQ + I_UKV + 2 * I_O + I_OUT;
        for (int it = gw; it < NI; it += NGW) {
            int r = it;
            if (r < I_IN) { p0_transpose_item(w_in, D_, INW, (bf16_t*)(ws + WS_WIN), scr, r, F.lane, nullptr, SB_QSCALE, 512); continue; } r -= I_IN;
            if (r < I_UQ) { p0_transpose_item(w_uq, 384, 768, (bf16_t*)(ws + WS_WUQ), scr, r, F.lane, g_cq, 1.f, 0); continue; } r -= I_UQ;
            if (r < I_UKV) { p0_transpose_item(w_ukv, 256, 1024, (bf16_t*)(ws + WS_WUKV), scr, r, F.lane, g_ckv, 1.f, 0); continue; } r -= I_UKV;
            if (r < I_O) { p0_transpose_item(w_o_sb, 512, 1024, (bf16_t*)(ws + WS_WOSB), scr, r, F.lane, nullptr, 1.f, 0); continue; } r -= I_O;
            if (r < I_O) { p0_transpose_item(w_o_mla, 512, 1024, (bf16_t*)(ws + WS_WOMLA), scr, r, F.lane, nullptr, 1.f, 0); continue; } r -= I_O;
            p0_transpose_item(w_out, 1024, 1024, (bf16_t*)(ws + WS_WOUT), scr, r, F.lane, nullptr, 1.f, 0);
        }
        { const int gt = gw * 64 + F.lane, NGT = NGW * 64;
          u32x4 z = {0u, 0u, 0u, 0u};
          u32x4* pz = (u32x4*)((bf16_t*)(ws + WS_WIN) + (size_t)INW * D_);
          for (int i = gt; i < (INWP - INW) * D_ * 2 / 16; i += NGT) pz[i] = z;
          u32x4* hz = (u32x4*)((bf16_t*)(ws + WS_HB) + (size_t)M_ * D_);
          for (int i = gt; i < D_ * 2 / 16; i += NGT) hz[i] = z;
          const int* pos = (const int*)a.in[1]; float* rt = (float*)(ws + WS_ROPE);
          for (int i = gt; i < M_ * 16; i += NGT) { const int row = i >> 4, k = i & 15; const float inv = powf(10000.f, -(float)k / 16.f); const float ang = (float)pos[row] * inv; rt[row * 32 + k] = cosf(ang); rt[row * 32 + 16 + k] = sinf(ang); }
          float* wr = (float*)(ws + WS_WR);
          for (int i = gt; i < D_ * NE; i += NGT) wr[i] = w_router[i] * g_ffn[i >> 5];
        }
        for (int m = gw; m < M_; m += NGW) rms_row_to_bf16(a.in[0] + (size_t)m * D_, a.in[2], (bf16_t*)(ws + WS_HB) + (size_t)m * D_, F.lane);
    }
    if (do_moe_w) {
        constexpr int NI = NE * (I_UP1 + I_DN1);
        for (int it = gw; it < NI; it += NGW) {
            int r = it;
            if (r < NE * I_UP1) { const int e = r / I_UP1; p0_transpose_item(w_up + (size_t)e * D_ * 2 * DFF, D_, 2 * DFF, (bf16_t*)(ws + WS_WUP) + (size_t)e * 2 * DFF * D_, scr, r % I_UP1, F.lane, nullptr, 1.f, 0); continue; }
            r -= NE * I_UP1;
            { const int e = r / I_DN1; p0_transpose_item(w_down + (size_t)e * DFF * D_, DFF, D_, (bf16_t*)(ws + WS_WDN) + (size_t)e * D_ * DFF, scr, r % I_DN1, F.lane, nullptr, 1.f, 0); }
        }
    }
}

__device__ __forceinline__ void ld16bf(const bf16_t* p, float (&v)[16]) {
    const u32x4 a = *(const u32x4*)p, b = *(const u32x4*)(p + 8);
    v[0] = bflo(a.x); v[1] = bfhi(a.x); v[2] = bflo(a.y); v[3] = bfhi(a.y); v[4] = bflo(a.z); v[5] = bfhi(a.z); v[6] = bflo(a.w); v[7] = bfhi(a.w);
    v[8] = bflo(b.x); v[9] = bfhi(b.x); v[10] = bflo(b.y); v[11] = bfhi(b.y); v[12] = bflo(b.z); v[13] = bfhi(b.z); v[14] = bflo(b.w); v[15] = bfhi(b.w);
}
__device__ __forceinline__ void st16bf(bf16_t* p, const float (&v)[16]) {
    u32x4 a, b; a.x = cvtpk(v[0], v[1]); a.y = cvtpk(v[2], v[3]); a.z = cvtpk(v[4], v[5]); a.w = cvtpk(v[6], v[7]);
    b.x = cvtpk(v[8], v[9]); b.y = cvtpk(v[10], v[11]); b.z = cvtpk(v[12], v[13]); b.w = cvtpk(v[14], v[15]);
    *(u32x4*)p = a; *(u32x4*)(p + 8) = b;
}
__device__ __forceinline__ void p4_prep(Frame& F, const Args& a) {
    unsigned char* ws = F.ws;
    const bf16_t* proj = (const bf16_t*)(ws + WS_PROJ); const bf16_t* qraw = (const bf16_t*)(ws + WS_QRAW); const bf16_t* kvraw = (const bf16_t*)(ws + WS_KVRAW);
    bf16_t* QB = (bf16_t*)(ws + WS_QB); bf16_t* KB = (bf16_t*)(ws + WS_KB); bf16_t* VB = (bf16_t*)(ws + WS_VB);
    const float* rope = (const float*)(ws + WS_ROPE); const float* gq = a.in[8]; const float* gk = a.in[9];
    const int gw = F.vcu * NWAVES + F.wave, NGW = F.G * NWAVES, lane = F.lane, h = lane >> 3, s = lane & 7;
    float gqv[16], gkv[16];
#pragma unroll
    for (int j = 0; j < 16; ++j) { gqv[j] = (s < 6) ? gq[s * 16 + j] : 0.f; gkv[j] = (s < 6) ? gk[s * 16 + j] : 0.f; }
    for (int row = gw; row < M_; row += NGW) {
        const bf16_t* pr = proj + (size_t)row * INWP;
        float sq = 0.f, skv = 0.f;
        { const bf16_t* p = pr + C_CQ + lane * 6; const unsigned w0 = *(const unsigned*)p, w1 = *(const unsigned*)(p + 2), w2 = *(const unsigned*)(p + 4);
          sq = bflo(w0) * bflo(w0) + bfhi(w0) * bfhi(w0) + bflo(w1) * bflo(w1) + bfhi(w1) * bfhi(w1) + bflo(w2) * bflo(w2) + bfhi(w2) * bfhi(w2);
          const u32x2 k2 = *(const u32x2*)(pr + C_CKV + lane * 4);
          skv = bflo(k2.x) * bflo(k2.x) + bfhi(k2.x) * bfhi(k2.x) + bflo(k2.y) * bflo(k2.y) + bfhi(k2.y) * bfhi(k2.y); }
        sq = wave_sum(sq); skv = wave_sum(skv);
        const float var_cq = sq * (1.f / 384.f) + EPS;
        const float rstd_ckv = rsqrtf(skv * (1.f / 256.f) + EPS);
        const float* rp = rope + (size_t)row * 32;
        {
            float v[16];
            if (s < 6) ld16bf(qraw + (size_t)row * 768 + h * 96 + s * 16, v); else {
#pragma unroll
                for (int j = 0; j < 16; ++j) v[j] = 0.f; }
            float ss = 0.f;
#pragma unroll
            for (int j = 0; j < 16; ++j) ss += v[j] * v[j];
            ss += __shfl_xor(ss, 1); ss += __shfl_xor(ss, 2); ss += __shfl_xor(ss, 4);
            const float r = rsqrtf(ss * (1.f / 96.f) + EPS * var_cq);
#pragma unroll
            for (int j = 0; j < 16; ++j) v[j] = v[j] * r * gqv[j];
            float o[16];
#pragma unroll
            for (int j = 0; j < 16; ++j) { const float pv = __shfl_xor(v[j], 1); const float c = rp[j], sn = rp[16 + j];
                o[j] = (s == 4) ? (v[j] * c - pv * sn) : (s == 5) ? (v[j] * c + pv * sn) : v[j]; o[j] *= MLA_QSCALE; }
            if (s < 6) st16bf(QB + (size_t)row * 768 + h * 96 + s * 16, o);
        }
        {
            float v[16];
            if (s < 4) { ld16bf(kvraw + (size_t)row * 1024 + h * 128 + s * 16, v);
#pragma unroll
                for (int j = 0; j < 16; ++j) v[j] *= rstd_ckv; }
            else if (s < 6) ld16bf(pr + C_KR + (s - 4) * 16, v);
            else {
#pragma unroll
                for (int j = 0; j < 16; ++j) v[j] = 0.f; }
            float ss = 0.f;
#pragma unroll
            for (int j = 0; j < 16; ++j) ss += v[j] * v[j];
            ss += __shfl_xor(ss, 1); ss += __shfl_xor(ss, 2); ss += __shfl_xor(ss, 4);
            const float r = rsqrtf(ss * (1.f / 96.f) + EPS);
#pragma unroll
            for (int j = 0; j < 16; ++j) v[j] = v[j] * r * gkv[j];
            float o[16];
#pragma unroll
            for (int j = 0; j < 16; ++j) { const float pv = __shfl_xor(v[j], 1); const float c = rp[j], sn = rp[16 + j];
                o[j] = (s == 4) ? (v[j] * c - pv * sn) : (s == 5) ? (v[j] * c + pv * sn) : v[j]; }
            if (s < 6) st16bf(KB + (size_t)row * 768 + h * 96 + s * 16, o);
            const u32x4 vw = *(const u32x4*)(kvraw + (size_t)row * 1024 + (lane >> 3) * 128 + 64 + (lane & 7) * 8);
            u32x4 ow; ow.x = cvtpk(bflo(vw.x) * rstd_ckv, bfhi(vw.x) * rstd_ckv); ow.y = cvtpk(bflo(vw.y) * rstd_ckv, bfhi(vw.y) * rstd_ckv);
            ow.z = cvtpk(bflo(vw.z) * rstd_ckv, bfhi(vw.z) * rstd_ckv); ow.w = cvtpk(bflo(vw.w) * rstd_ckv, bfhi(vw.w) * rstd_ckv);
            *(u32x4*)(VB + (size_t)row * 512 + lane * 8) = ow;
        }
    }
}
namespace att {
constexpr int BUFB = 20480;
constexpr int OST_OFF = 2 * BUFB;
constexpr int WSF_OFF = OST_OFF + 8 * 4096;
constexpr int FLG_OFF = WSF_OFF + 8 * 256;
__device__ __forceinline__ int crow(int r, int hi) { return (r & 3) + 8 * (r >> 2) + 4 * hi; }
__device__ __forceinline__ s16x4 vtr(const LAS char* p) { typedef short v4i16_t __attribute__((ext_vector_type(4))); return __builtin_bit_cast(s16x4, __builtin_amdgcn_ds_read_tr16_b64_v4i16((LAS v4i16_t*)p)); }
#define ATT_MFMA(a, b, c) __builtin_amdgcn_mfma_f32_32x32x16_bf16((a), (b), (c), 0, 0, 0)

template <int NCH> struct Stage {
    u32x4 k0, k1, v0;
    __device__ __forceinline__ void load(const bf16_t* Kb, int pitchK, const bf16_t* Vb, int pitchV, int key0, int wid, int lane) {
        k0 = *(const u32x4*)(Kb + (size_t)(key0 + lane) * pitchK + wid * 8);
        if (NCH > 8) { if (wid < NCH - 8) k1 = *(const u32x4*)(Kb + (size_t)(key0 + lane) * pitchK + (8 + wid) * 8); }
        v0 = *(const u32x4*)(Vb + (size_t)(key0 + 16 * (wid & 3) + (lane >> 2)) * pitchV + (wid >> 2) * 32 + (lane & 3) * 8);
    }
    __device__ __forceinline__ void write(LAS unsigned char* buf, int wid, int lane) const {
        *(LAS u32x4*)(buf + wid * 1024 + lane * 16) = k0;
        if (NCH > 8) { if (wid < NCH - 8) *(LAS u32x4*)(buf + (8 + wid) * 1024 + lane * 16) = k1; }
        *(LAS u32x4*)(buf + NCH * 1024 + wid * 1024 + lane * 16) = v0;
    }
};

__device__ __forceinline__ void pv_tile(f32x16 (&o)[2], const LAS char* vp, const bf16x8 (&pa)[4]) {
#pragma unroll
    for (int d0 = 0; d0 < 2; ++d0)
#pragma unroll
        for (int ks = 0; ks < 4; ++ks) {
            const s16x4 lo = vtr(vp + d0 * 4096 + ks * 1024), hi = vtr(vp + d0 * 4096 + ks * 1024 + 512);
            const bf16x8 vf = __builtin_shufflevector(lo, hi, 0, 1, 2, 3, 4, 5, 6, 7);
            o[d0] = ATT_MFMA(pa[ks], vf, o[d0]);
        }
}
__device__ __forceinline__ bf16x8 pack8(const f32x16& p, int base) {
    u32x4 w; w.x = cvtpk(p[base], p[base + 1]); w.y = cvtpk(p[base + 2], p[base + 3]); w.z = cvtpk(p[base + 4], p[base + 5]); w.w = cvtpk(p[base + 6], p[base + 7]);
    return __builtin_bit_cast(bf16x8, w);
}
__device__ __forceinline__ void store_o(const f32x16 (&o)[2], const float (&rs)[16], LAS unsigned char* lds, int wid, int lane, bf16_t* Ow) {
    const int r32 = lane & 31, hi = lane >> 5;
    LAS bf16_t* stg = (LAS bf16_t*)(lds + OST_OFF + wid * 4096);
#pragma unroll
    for (int r = 0; r < 16; ++r) { const int orow = crow(r, hi);
#pragma unroll
        for (int d0 = 0; d0 < 2; ++d0) { const unsigned w = cvtpk(o[d0][r] * rs[r], 0.f); stg[orow * 64 + d0 * 32 + r32] = (bf16_t)(w & 0xffffu); } }
    asm volatile("s_waitcnt lgkmcnt(0)" ::: "memory");
#pragma unroll
    for (int i = 0; i < 4; ++i) { const int row = i * 8 + (lane >> 3), ch = lane & 7; const u32x4 v = *(const LAS u32x4*)(stg + row * 64 + ch * 8); *(u32x4*)(Ow + (size_t)row * 512 + ch * 8) = v; }
    asm volatile("s_waitcnt lgkmcnt(0)" ::: "memory");
}

__device__ __forceinline__ void mla_unit(LAS unsigned char* lds, int b, int h, int qb, const bf16_t* QB, const bf16_t* KB, const bf16_t* VB, bf16_t* O, float m0) {
    const int tid = threadIdx.x, lane = tid & 63, r32 = lane & 31, hi = lane >> 5; const int wid = __builtin_amdgcn_readfirstlane(tid >> 6);
    const size_t rb = (size_t)b * S_; const int q0 = qb * 256;
    const bf16_t* Kh = KB + rb * 768 + h * 96; const bf16_t* Vh = VB + rb * 512 + h * 64;
    bf16x8 qr[6];
    { const bf16_t* qp = QB + (rb + q0 + wid * 32 + r32) * 768 + h * 96 + hi * 8;
#pragma unroll
      for (int d0 = 0; d0 < 6; ++d0) qr[d0] = *(const bf16x8*)(qp + d0 * 16); }
    const int NT = 4 * qb + 4, my_last = 4 * qb + (wid >> 1);
    f32x16 o[2]; float l = 0.f;
#pragma unroll
    for (int r = 0; r < 16; ++r) { o[0][r] = 0.f; o[1][r] = 0.f; }
    Stage<12> st;
    st.load(Kh, 768, Vh, 512, 0, wid, lane); st.write(lds, wid, lane);
    __syncthreads();
    for (int t = 0; t < NT; ++t) {
        if (t + 1 < NT) st.load(Kh, 768, Vh, 512, (t + 1) * 64, wid, lane);
        if (t <= my_last) {
            const LAS char* buf = (const LAS char*)(lds + (t & 1) * BUFB);
            const LAS char* kp = buf + hi * 1024 + r32 * 16;
            f32x16 p0, p1;
#pragma unroll
            for (int r = 0; r < 16; ++r) { p0[r] = -m0; p1[r] = -m0; }
#pragma unroll
            for (int d0 = 0; d0 < 6; ++d0) { const bf16x8 a0 = *(const LAS bf16x8*)(kp + d0 * 2048), a1 = *(const LAS bf16x8*)(kp + d0 * 2048 + 512);
                p0 = ATT_MFMA(a0, qr[d0], p0); p1 = ATT_MFMA(a1, qr[d0], p1); }
            float ls = 0.f;
#pragma unroll
            for (int r = 0; r < 16; ++r) { p0[r] = __builtin_amdgcn_exp2f(p0[r]); p1[r] = __builtin_amdgcn_exp2f(p1[r]); ls += p0[r] + p1[r]; }
            l += ls;
            bf16x8 pa[4]; pa[0] = pack8(p0, 0); pa[1] = pack8(p0, 8); pa[2] = pack8(p1, 0); pa[3] = pack8(p1, 8);
            const LAS char* vp = buf + 12 * 1024 + ((lane >> 4) & 1) * 32 + (lane & 3) * 8 + (4 * hi + ((lane & 15) >> 2)) * 64;
            pv_tile(o, vp, pa);
        }
        if (t + 1 < NT) st.write(lds + ((t + 1) & 1) * BUFB, wid, lane);
        __syncthreads();
    }
    l += __shfl_xor(l, 32);
    LAS float* wsf = (LAS float*)(lds + WSF_OFF) + wid * 64;
    if (hi == 0) wsf[r32] = l;
    asm volatile("s_waitcnt lgkmcnt(0)" ::: "memory");
    float rs[16];
#pragma unroll
    for (int r = 0; r < 16; ++r) rs[r] = __builtin_amdgcn_rcpf(wsf[crow(r, hi)]);
    store_o(o, rs, lds, wid, lane, O + (rb + q0 + wid * 32) * 512 + h * 64);
}

constexpr float SB_THR = -152.f;
__device__ __forceinline__ void sb_unit(LAS unsigned char* lds, int b, int h, int qb, const bf16_t* proj, bf16_t* O) {
    const int tid = threadIdx.x, lane = tid & 63, r32 = lane & 31, hi = lane >> 5; const int wid = __builtin_amdgcn_readfirstlane(tid >> 6);
    const size_t rb = (size_t)b * S_; const int q0 = qb * 256;
    const bf16_t* Kh = proj + rb * INWP + C_SBK + h * 64; const bf16_t* Vh = proj + rb * INWP + C_SBV + h * 64;
    bf16x8 qr[4];
    { const bf16_t* qp = proj + (rb + q0 + wid * 32 + r32) * INWP + C_SBQ + h * 64 + hi * 8;
#pragma unroll
      for (int d0 = 0; d0 < 4; ++d0) qr[d0] = *(const bf16x8*)(qp + d0 * 16); }
    const int Ttop = 4 * qb + 3, qw0 = q0 + wid * 32, qabs = qw0 + r32;
    f32x16 o[2]; float carry = 0.f;
#pragma unroll
    for (int r = 0; r < 16; ++r) { o[0][r] = 0.f; o[1][r] = 0.f; }
    volatile LAS int* flg = (volatile LAS int*)(lds + FLG_OFF);
    Stage<8> st;
    st.load(Kh, INWP, Vh, INWP, Ttop * 64, wid, lane); st.write(lds, wid, lane);
    __syncthreads();
    bool alive = true;
    for (int it = 0;; ++it) {
        const int t = Ttop - it;
        if (t > 0) st.load(Kh, INWP, Vh, INWP, (t - 1) * 64, wid, lane);
        if (alive && (64 * t <= qw0 + 30)) {
            const LAS char* buf = (const LAS char*)(lds + (it & 1) * BUFB);
            const LAS char* kp = buf + hi * 1024 + r32 * 16;
            f32x16 p0, p1;
#pragma unroll
            for (int r = 0; r < 16; ++r) { p0[r] = 0.f; p1[r] = 0.f; }
#pragma unroll
            for (int d0 = 0; d0 < 4; ++d0) { const bf16x8 a0 = *(const LAS bf16x8*)(kp + d0 * 2048), a1 = *(const LAS bf16x8*)(kp + d0 * 2048 + 512);
                p0 = ATT_MFMA(a0, qr[d0], p0); p1 = ATT_MFMA(a1, qr[d0], p1); }
            const bool need_mask = (64 * t + 63 >= qw0);
            const int kb0 = 64 * t + 4 * hi;
            f32x16 s0, s1;
#pragma unroll
            for (int r = 0; r < 16; ++r) {
                const int key = kb0 + (r & 3) + 8 * (r >> 2);
                { const float z = p0[r]; const float e = __builtin_amdgcn_exp2f(-fabsf(z)); const float tt = __builtin_amdgcn_logf(1.f + e); float lsv = fminf(-z, 0.f) - tt;
                  if (need_mask && !(key < qabs)) { lsv = 0.f; p0[r] = -INFINITY; } s0[r] = lsv; }
                { const float z = p1[r]; const float e = __builtin_amdgcn_exp2f(-fabsf(z)); const float tt = __builtin_amdgcn_logf(1.f + e); float lsv = fminf(-z, 0.f) - tt;
                  if (need_mask && !(key + 32 < qabs)) { lsv = 0.f; p1[r] = -INFINITY; } s1[r] = lsv; }
            }
            float T[9]; T[8] = 0.f;
#pragma unroll
            for (int j = 7; j >= 0; --j) { const int i = j & 3; const float qs = (j >= 4) ? ((s1[4 * i] + s1[4 * i + 1]) + (s1[4 * i + 2] + s1[4 * i + 3])) : ((s0[4 * i] + s0[4 * i + 1]) + (s0[4 * i + 2] + s0[4 * i + 3])); T[j] = T[j + 1] + qs; }
            float Tp[9]; Tp[8] = 0.f;
#pragma unroll
            for (int j = 0; j < 8; ++j) Tp[j] = __shfl_xor(T[j], 32);
#pragma unroll
            for (int j = 7; j >= 0; --j) {
                const int i = j & 3;
                float lat = carry + T[j + 1] + (hi ? Tp[j + 1] : Tp[j]);
#pragma unroll
                for (int e3 = 3; e3 >= 0; --e3) {
                    const int r = 4 * i + e3;
                    if (j >= 4) { const float lsv = s1[r]; p1[r] = __builtin_amdgcn_exp2f(lsv + p1[r] + lat); lat += lsv; }
                    else        { const float lsv = s0[r]; p0[r] = __builtin_amdgcn_exp2f(lsv + p0[r] + lat); lat += lsv; }
                }
            }
            carry += T[0] + Tp[0];
            bf16x8 pa[4]; pa[0] = pack8(p0, 0); pa[1] = pack8(p0, 8); pa[2] = pack8(p1, 0); pa[3] = pack8(p1, 8);
            const LAS char* vp = buf + 8 * 1024 + ((lane >> 4) & 1) * 32 + (lane & 3) * 8 + (4 * hi + ((lane & 15) >> 2)) * 64;
            pv_tile(o, vp, pa);
            alive = __any(carry > SB_THR);
        }
        if (lane == 0) flg[(it & 1) * 8 + wid] = alive ? 1 : 0;
        if (t > 0) st.write(lds + ((it + 1) & 1) * BUFB, wid, lane);
        __syncthreads();
        if (t == 0) break;
        int any = 0;
#pragma unroll
        for (int w = 0; w < 8; ++w) any |= flg[(it & 1) * 8 + w];
        if (!any) break;
    }
    float rs[16];
#pragma unroll
    for (int r = 0; r < 16; ++r) rs[r] = 1.f;
    store_o(o, rs, lds, wid, lane, O + (rb + q0 + wid * 32) * 512 + h * 64);
}
}

__device__ __forceinline__ void p5_attention(Frame& F, const Args& a) {
    unsigned char* ws = F.ws;
    float gm;
    { const float* gq = a.in[8]; const float* gk = a.in[9]; float mq = 0.f, mk = 0.f;
      for (int i = F.lane; i < 96; i += 64) { mq = fmaxf(mq, fabsf(gq[i])); mk = fmaxf(mk, fabsf(gk[i])); }
#pragma unroll
      for (int o = 1; o < 64; o <<= 1) { mq = fmaxf(mq, __shfl_xor(mq, o)); mk = fmaxf(mk, __shfl_xor(mk, o)); }
      gm = 9.79795897f * LOG2E * mq * mk; }
    for (int v = F.vcu; v < 256; v += F.G) {
        const int bh = v >> 3, s = v & 7, b = bh >> 3, h = bh & 7;
        for (int i = 0; i < 2; ++i) { const int qb = i ? 15 - s : s;
            att::mla_unit(F.lds, b, h, qb, (const bf16_t*)(ws + WS_QB), (const bf16_t*)(ws + WS_KB), (const bf16_t*)(ws + WS_VB), (bf16_t*)(ws + WS_OMLA), gm);
            __syncthreads(); }
        for (int i = 0; i < 2; ++i) { const int qb = i ? 15 - s : s;
            att::sb_unit(F.lds, b, h, qb, (const bf16_t*)(ws + WS_PROJ), (bf16_t*)(ws + WS_OSB));
            __syncthreads(); }
    }
}

__device__ __forceinline__ void p8_router(Frame& F, const Args& a) {
    unsigned char* ws = F.ws;
    const float* x1 = a.out; const float* wr = (const float*)(ws + WS_WR); const float* br = a.in[15]; const float* g = a.in[13];
    bf16_t* H2 = (bf16_t*)(ws + WS_HB); int* list = (int*)(ws + WS_LIST); float* topw = (float*)(ws + WS_TOPW); int* selo = (int*)(ws + WS_SEL);
    int* cnt = (int*)(ws + WS_CTL) + CW_CNT;
    volatile LAS int* lcnt = (volatile LAS int*)(F.MISC + MI_LCNT); volatile LAS int* lbase = (volatile LAS int*)(F.MISC + MI_BASE); volatile LAS float* lrstd = (volatile LAS float*)(F.MISC + MI_RSTD);
    const int lane = F.lane, wave = F.wave, tid = F.tid;
    for (int task = F.vcu; task < M_ / 64; task += F.G) {
        const int T0 = task * 64;
        if (tid < 32) lcnt[tid] = 0;
        __syncthreads();
        int my_e = 0, my_rank = 0; float my_w = 0.f;
        if (wave < 4) {
            const int tk = lane & 15, kp = lane >> 4, tok = T0 + wave * 16 + tk;
            const float* xp = x1 + (size_t)tok * D_ + kp * 256;
            const float* wp = wr + (size_t)(kp * 256) * NE + tk;
            f32x4 acc0 = {0.f, 0.f, 0.f, 0.f}, acc1 = {0.f, 0.f, 0.f, 0.f}; float ssq = 0.f;
            for (int i = 0; i < 256; i += 4) {
                const f32x4 a4 = *(const f32x4*)(xp + i);
                ssq += (a4.x * a4.x + a4.y * a4.y) + (a4.z * a4.z + a4.w * a4.w);
#pragma unroll
                for (int j = 0; j < 4; ++j) { const float b0 = wp[(i + j) * NE], b1 = wp[(i + j) * NE + 16];
                    acc0 = __builtin_amdgcn_mfma_f32_16x16x4f32(a4[j], b0, acc0, 0, 0, 0); acc1 = __builtin_amdgcn_mfma_f32_16x16x4f32(a4[j], b1, acc1, 0, 0, 0); }
            }
            ssq += __shfl_xor(ssq, 16); ssq += __shfl_xor(ssq, 32);
            const float rstd = rsqrtf(ssq * (1.f / D_) + EPS);
            if (lane < 16) lrstd[wave * 16 + lane] = rstd;
            const int e0 = lane & 15, grp = lane >> 4;
            const float bia0 = br[e0], bia1 = br[e0 + 16];
#pragma unroll
            for (int j = 0; j < 4; ++j) {
                const float rs = __shfl(rstd, 4 * grp + j);
                float c0 = acc0[j] * rs + bia0, c1 = acc1[j] * rs + bia1;
                float sv[4]; int si[4];
#pragma unroll
                for (int k = 0; k < 4; ++k) {
                    float best = c0; int bi = e0;
                    if (c1 > best) { best = c1; bi = e0 + 16; }
#pragma unroll
                    for (int o = 1; o < 16; o <<= 1) { const float ob = __shfl_xor(best, o); const int oi = __shfl_xor(bi, o); if (ob > best || (ob == best && oi < bi)) { best = ob; bi = oi; } }
                    sv[k] = best; si[k] = bi;
                    if (bi == e0) c0 = -INFINITY; if (bi == e0 + 16) c1 = -INFINITY;
                }
                float ex[4], sum = 0.f;
#pragma unroll
                for (int k = 0; k < 4; ++k) { ex[k] = __expf(sv[k] - sv[0]); sum += ex[k]; }
                const float inv = 1.f / sum;
                if (((lane >> 2) & 3) == j) {
#pragma unroll
                    for (int k = 0; k < 4; ++k) if ((lane & 3) == k) { my_e = si[k]; my_w = ex[k] * inv; }
                }
            }
            my_rank = atomicAdd((int*)&lcnt[my_e], 1);
        }
        __syncthreads();
        if (tid < 32) lbase[tid] = lcnt[tid] ? atomicAdd(&cnt[tid], lcnt[tid]) : 0;
        {
            const f32x4* gr = (const f32x4*)g + lane;
            for (int rr = 0; rr < 8; ++rr) { const int tl = wave * 8 + rr; const float rs = lrstd[tl];
                const f32x4* xr = (const f32x4*)(x1 + (size_t)(T0 + tl) * D_) + lane; u32x2* o8 = (u32x2*)(H2 + (size_t)(T0 + tl) * D_) + lane;
#pragma unroll
                for (int j = 0; j < 4; ++j) { const f32x4 v = xr[64 * j], gg = gr[64 * j]; u32x2 w; w.x = cvtpk(v.x * rs * gg.x, v.y * rs * gg.y); w.y = cvtpk(v.z * rs * gg.z, v.w * rs * gg.w); o8[64 * j] = w; } }
        }
        __syncthreads();
        if (wave < 4) {
            const int grp = lane >> 4, jj = (lane >> 2) & 3, kk = lane & 3;
            const int tok = T0 + wave * 16 + 4 * grp + jj, slot = tok * 4 + kk;
            list[(size_t)my_e * M_ + lbase[my_e] + my_rank] = slot;
            topw[slot] = my_w; selo[slot] = my_e;
        }
        __syncthreads();
    }
}

struct MoeOrder {
    const bf16_t* A; const bf16_t* Bt; const int* list; volatile LAS unsigned* tab;
    int lda, ldb, nN, nwg, G, c, gather; size_t estride;
    __device__ void init(const bf16_t* A_, int lda_, const bf16_t* Bt_, int ldb_, size_t estride_, int nN_, const int* list_, volatile LAS unsigned* tab_, int gather_, int G_, int c_) {
        A = A_; lda = lda_; Bt = Bt_; ldb = ldb_; estride = estride_; nN = nN_; list = list_; tab = tab_; gather = gather_; G = G_; c = c_; nwg = (int)tab[MI_TPFX + NE] * nN_; }
    __device__ __forceinline__ bool next(int i, pg8::Unit& u) const {
        const long L = (long)i * G + c; if (L >= nwg) return false;
        int wgid = (int)L; { const int q = nwg / 8, r = nwg % 8, xcd = wgid % 8, off = wgid / 8; wgid = (xcd < r ? xcd * (q + 1) : r * (q + 1) + (xcd - r) * q) + off; }
        int e = 0;
        for (int k = 1; k < NE; ++k) if ((int)tab[MI_TPFX + k] * nN <= wgid) e = k;
        const int t0 = (int)tab[MI_TPFX + e], nt = (int)tab[MI_TPFX + e + 1] - t0, idx = wgid - t0 * nN;
        u.e = e; u.pn = idx / nt; u.rt = idx % nt; u.pm = t0 + u.rt; const int left = (int)tab[MI_CNT + e] - u.rt * 256; u.rows = left < 256 ? left : 256; return true;
    }
    __device__ __forceinline__ unsigned a_off(const pg8::Unit& u, int r, int C) const {
        int row;
        if (gather) row = (r < u.rows) ? (list[(size_t)u.e * M_ + u.rt * 256 + r] >> 2) : M_;
        else row = u.pm * 256 + r;
        return (unsigned)((row * lda + C) * 2);
    }
    __device__ __forceinline__ const char* b_base(const pg8::Unit& u) const { return (const char*)(Bt + (size_t)u.e * estride + (size_t)u.pn * 256 * ldb); }
};
__device__ __forceinline__ void moe_table(Frame& F) {
    int* cnt = (int*)(F.ws + WS_CTL) + CW_CNT;
    if (F.tid < NE) F.MISC[MI_CNT + F.tid] = __hip_atomic_load((unsigned*)cnt + F.tid, RLX_AGENT);
    __syncthreads();
    if (F.tid == 0) { unsigned p = 0; for (int e = 0; e < NE; ++e) { F.MISC[MI_TPFX + e] = p; p += (F.MISC[MI_CNT + e] + 255u) >> 8; } F.MISC[MI_TPFX + NE] = p; }
    __syncthreads();
}

__device__ __forceinline__ void p12_combine(Frame& F, const Args& a) {
    const bf16_t* Y = (const bf16_t*)(F.ws + WS_YB); float* out = a.out;
    const int gt = (F.vcu * NWAVES + F.wave) * 64 + F.lane, NGT = F.G * NTHR;
    for (int i = gt; i < M_ * D_ / 8; i += NGT) {
        const int t = i >> 7, c = (i & 127) * 8;
        f32x4 v0 = *(const f32x4*)(out + (size_t)t * D_ + c), v1 = *(const f32x4*)(out + (size_t)t * D_ + c + 4);
#pragma unroll
        for (int k = 0; k < 4; ++k) { const u32x4 w = *(const u32x4*)(Y + (size_t)(t * 4 + k) * D_ + c);
            v0.x += bflo(w.x); v0.y += bfhi(w.x); v0.z += bflo(w.y); v0.w += bfhi(w.y); v1.x += bflo(w.z); v1.y += bfhi(w.z); v1.z += bflo(w.w); v1.w += bfhi(w.w); }
        *(f32x4*)(out + (size_t)t * D_ + c) = v0; *(f32x4*)(out + (size_t)t * D_ + c + 4) = v1;
    }
}

constexpr int N_PHASES = 11;
__global__ void __launch_bounds__(NTHR, 2) mega(Args args) {
    extern __shared__ __attribute__((aligned(16))) unsigned char lds_raw[];
    Frame F;
    F.lds = (LAS unsigned char*)lds_raw; F.MISC = (volatile LAS unsigned*)(F.lds + LDS_MISC);
    F.tid = threadIdx.x; F.lane = F.tid & 63; F.wave = __builtin_amdgcn_readfirstlane(F.tid >> 6);
    F.G = gridDim.x; { const int bx = blockIdx.x; F.vcu = (F.G % 8 == 0) ? (bx % 8) * (F.G / 8) + bx / 8 : bx; }
    F.ws = args.ws;
    unsigned char* ws = args.ws;
    for (int u = F.tid; u < (LDS_BYTES - LDS_MISC) / 4; u += NTHR) F.MISC[u] = 0u;
    __syncthreads();
    const int lo = args.ph_lo, hi = args.ph_hi;
    XcdBarrier bar; bar.bar = (unsigned*)(ws + WS_CTL) + CW_BAR; bar.x = 0; bar.st = nullptr;
    if (hi - lo > 1) bar = xcd_barrier_post((unsigned*)(ws + WS_CTL) + CW_BAR, F.MISC + MI_BAR);
#define IN(k) (lo <= (k) && (k) < hi)
#define SEAM(k) do { if (IN(k) && IN((k) + 1)) xcd_barrier(bar); } while (0)
    const int cid = (int)blockIdx.x;

    if (IN(0)) { p0_prologue(F, args, 1, 1); SEAM(0); }
    if (IN(1)) {
        pg8::Gemm g{(const bf16_t*)(ws + WS_HB), D_, D_, D_};
        pg8::StaticOrder S; S.init(g.A, D_, (const bf16_t*)(ws + WS_WIN), D_, M_, INWP, F.G, cid);
        pg8::EpiBf16 E{(bf16_t*)(ws + WS_PROJ), INWP};
        pg8::gemm_phase(F.lds, g, S, E);
        SEAM(1);
    }
    if (IN(2)) {
        { pg8::Gemm g{(const bf16_t*)(ws + WS_PROJ) + C_CQ, INWP, 384, 384};
          pg8::StaticOrder S; S.init(g.A, INWP, (const bf16_t*)(ws + WS_WUQ), 384, M_, 768, F.G, cid);
          pg8::EpiBf16 E{(bf16_t*)(ws + WS_QRAW), 768};
          pg8::gemm_phase(F.lds, g, S, E); }
        { pg8::Gemm g{(const bf16_t*)(ws + WS_PROJ) + C_CKV, INWP, 256, 256};
          pg8::StaticOrder S; S.init(g.A, INWP, (const bf16_t*)(ws + WS_WUKV), 256, M_, 1024, F.G, cid);
          pg8::EpiBf16 E{(bf16_t*)(ws + WS_KVRAW), 1024};
          pg8::gemm_phase(F.lds, g, S, E); }
        SEAM(2);
    }
    if (IN(3)) { p4_prep(F, args); SEAM(3); }
    if (IN(4)) { p5_attention(F, args); SEAM(4); }
    if (IN(5)) {
        { pg8::Gemm g{(const bf16_t*)(ws + WS_OSB), 512, 512, 512};
          pg8::StaticOrder S; S.init(g.A, 512, (const bf16_t*)(ws + WS_WOSB), 512, M_, D_, F.G, cid);
          pg8::EpiGate<true> E{(bf16_t*)(ws + WS_MIX), (const bf16_t*)(ws + WS_PROJ), INWP, C_GSB};
          pg8::gemm_phase(F.lds, g, S, E); }
        { pg8::Gemm g{(const bf16_t*)(ws + WS_OMLA), 512, 512, 512};
          pg8::StaticOrder S; S.init(g.A, 512, (const bf16_t*)(ws + WS_WOMLA), 512, M_, D_, F.G, cid);
          pg8::EpiGate<false> E{(bf16_t*)(ws + WS_MIX), (const bf16_t*)(ws + WS_PROJ), INWP, C_GMLA};
          pg8::gemm_phase(F.lds, g, S, E); }
        SEAM(5);
    }
    if (IN(6)) {
        pg8::Gemm g{(const bf16_t*)(ws + WS_MIX), D_, D_, D_};
        pg8::StaticOrder S; S.init(g.A, D_, (const bf16_t*)(ws + WS_WOUT), D_, M_, D_, F.G, cid);
        pg8::EpiRes E{args.in[0], args.out};
        pg8::gemm_phase(F.lds, g, S, E);
        SEAM(6);
    }
    if (IN(7)) { p8_router(F, args); SEAM(7); }
    if (IN(8)) {
        moe_table(F);
        pg8::Gemm g{(const bf16_t*)(ws + WS_HB), D_, D_, D_};
        MoeOrder S; S.init(g.A, D_, (const bf16_t*)(ws + WS_WUP), D_, (size_t)2 * DFF * D_, 8, (const int*)(ws + WS_LIST), F.MISC, 1, F.G, cid);
        pg8::EpiSwiglu E{(bf16_t*)(ws + WS_ACT), args.in[17]};
        pg8::gemm_phase(F.lds, g, S, E);
        SEAM(8);
    }
    if (IN(9)) {
        moe_table(F);
        pg8::Gemm g{(const bf16_t*)(ws + WS_ACT), DFF, DFF, DFF};
        MoeOrder S; S.init(g.A, DFF, (const bf16_t*)(ws + WS_WDN), DFF, (size_t)D_ * DFF, 4, (const int*)(ws + WS_LIST), F.MISC, 0, F.G, cid);
        pg8::EpiDown E{(bf16_t*)(ws + WS_YB), args.in[19], (const int*)(ws + WS_LIST), (const float*)(ws + WS_TOPW)};
        pg8::gemm_phase(F.lds, g, S, E);
        SEAM(9);
    }
    if (IN(10)) { p12_combine(F, args); }
#undef IN
#undef SEAM
}
static int g_grid = 0;
static int setup_grid() {
    if (g_grid == 0) {
        int dev = 0, cus = 0;
        if (hipGetDevice(&dev) != hipSuccess || hipDeviceGetAttribute(&cus, hipDeviceAttributeMultiprocessorCount, dev) != hipSuccess) { g_grid = -1; return g_grid; }
        if (hipFuncSetAttribute((const void*)mega, hipFuncAttributeMaxDynamicSharedMemorySize, LDS_BYTES) != hipSuccess) { g_grid = -1; return g_grid; }
        int per_cu = 0;
        (void)hipOccupancyMaxActiveBlocksPerMultiprocessor(&per_cu, (const void*)mega, NTHR, LDS_BYTES);
        (void)hipGetLastError();
        g_grid = cus;
    }
    return g_grid;
}
static void launch_mega(void* const* d_in, void* d_out, void* d_ws, int lo, int hi, hipStream_t stream) {
    Args a; memset(&a, 0, sizeof(a));
    for (int i = 0; i < 20; ++i) a.in[i] = (const float*)d_in[i];
    a.out = (float*)d_out; a.ws = (unsigned char*)d_ws; a.ph_lo = lo; a.ph_hi = hi;
    hipLaunchKernelGGL(mega, dim3(g_grid), dim3(NTHR), LDS_BYTES, stream, a);
}
extern "C" void kernel_launch(void* const* d_in, const int* in_sizes, int n_in, void* d_out, int out_size, void* d_ws, size_t ws_size, hipStream_t stream) {
    if (n_in != 20 || ws_size < WS_OPT_END || out_size != M_ * D_) { fprintf(stderr, "kernel_launch: unexpected arguments\n"); return; }
    if (setup_grid() <= 0) return;
    (void)hipMemsetAsync((char*)d_ws + WS_CTL, 0, CTL_ZERO_BYTES, stream);
#if N_LAUNCH_SPLIT
    for (int p = 0; p < N_PHASES; ++p) launch_mega(d_in, d_out, d_ws, p, p + 1, stream);
#else
    launch_mega(d_in, d_out, d_ws, 0, N_PHASES, stream);
#endif
}
```

```cpp
#define N_LAUNCH_SPLIT 0
#include <hip/hip_runtime.h>
#include <hip/hip_bf16.h>
#include <cstdio>
#include <cstdint>
#include <cstring>
#include <cmath>

constexpr int B_ = 4, S_ = 4096, D_ = 1024, M_ = B_ * S_;
constexpr int INW = 4256, INWP = 4352;
constexpr int C_SBQ = 0, C_SBK = 512, C_SBV = 1024, C_CQ = 1536, C_CKV = 1920, C_KR = 2176, C_GSB = 2208, C_GMLA = 3232;
constexpr int NE = 32, TOPK = 4, DFF = 1024;
constexpr float EPS = 1e-6f;
constexpr float LOG2E = 1.4426950408889634f;
constexpr float SB_QSCALE = 0.125f * LOG2E;
constexpr float MLA_QSCALE = 0.10206207261596577f * LOG2E;
constexpr int NWAVES = 8, NTHR = 512;

#define LAS __attribute__((address_space(3)))
#define GAS __attribute__((address_space(1)))
typedef unsigned short bf16_t;
typedef short bf16x8 __attribute__((ext_vector_type(8)));
typedef short s16x4 __attribute__((ext_vector_type(4)));
typedef float f32x4 __attribute__((ext_vector_type(4)));
typedef float f32x16 __attribute__((ext_vector_type(16)));
typedef unsigned u32x4 __attribute__((ext_vector_type(4)));
typedef unsigned u32x2 __attribute__((ext_vector_type(2)));
typedef float f32x2_t __attribute__((ext_vector_type(2)));
typedef __bf16 bf16x2_t __attribute__((ext_vector_type(2)));
typedef int v8i_t __attribute__((ext_vector_type(8)));
constexpr float W8_SCALE = 8.f, X8_SCALE = 8.f;
__device__ __forceinline__ unsigned pk_fp8x4(float a, float b, float c, float d) { unsigned w = 0; w = __builtin_amdgcn_cvt_pk_fp8_f32(a, b, w, false); w = __builtin_amdgcn_cvt_pk_fp8_f32(c, d, w, true); return w; }

__device__ __forceinline__ unsigned cvtpk(float lo, float hi) { f32x2_t v = {lo, hi}; bf16x2_t b = __builtin_convertvector(v, bf16x2_t); return __builtin_bit_cast(unsigned, b); }
__device__ __forceinline__ float bf2f(unsigned short h) { return __uint_as_float(((unsigned)h) << 16); }
__device__ __forceinline__ float bflo(unsigned w) { return __uint_as_float(w << 16); }
__device__ __forceinline__ float bfhi(unsigned w) { return __uint_as_float(w & 0xffff0000u); }
__device__ __forceinline__ float wave_sum(float v) {
#pragma unroll
    for (int o = 1; o < 64; o <<= 1) v += __shfl_xor(v, o);
    return v;
}
__device__ __forceinline__ float sigmoidf_(float x) { return __builtin_amdgcn_rcpf(1.f + __builtin_amdgcn_exp2f(-x * LOG2E)); }

namespace pg8 {
constexpr int BM = 256, BK = 64, HALF = 128, HTB = HALF * BK * 2, STAGE_BYTES = 8 * HTB, NXCD = 8, WGM = 8;
__host__ __device__ __forceinline__ int lds_byte(int r, int c) { const int st = (r >> 4) * 2 + (c >> 5), rr = r & 15, cc = c & 31, ob = rr * 64 + cc * 2; return st * 1024 + (ob ^ (((ob >> 9) & 1) << 5)); }
__host__ __device__ __forceinline__ void stage_rc(int b, int& R, int& C) { const int st = b / 1024, sb = b % 1024, swz = sb ^ (((sb >> 9) & 1) << 5); R = (st >> 1) * 16 + swz / 64; C = (st & 1) * 32 + (swz % 64) / 2; }
__host__ __device__ __forceinline__ int perm32(int rho) { const int n = rho >> 4, i = rho & 15; return 8 * (i >> 2) + 4 * n + (i & 3); }

struct Unit { int pm, pn, e, rows, rt; };
struct Gemm { const bf16_t* A; int lda, ldb, K; };

struct StaticOrder {
    const bf16_t* A; const bf16_t* Bt; int lda, ldb;
    int nM, nN, nwg, G, c;
    __device__ void init(const bf16_t* A_, int lda_, const bf16_t* Bt_, int ldb_, int M, int N, int G_, int c_) { A = A_; Bt = Bt_; lda = lda_; ldb = ldb_; nM = M / BM; nN = N / BM; nwg = nM * nN; G = G_; c = c_; }
    __device__ __forceinline__ bool next(int i, Unit& u) const {
        const long L = (long)i * G + c; if (L >= nwg) return false;
        int wgid = (int)L; { const int q = nwg / NXCD, r = nwg % NXCD, xcd = wgid % NXCD, off = wgid / NXCD; wgid = (xcd < r ? xcd * (q + 1) : r * (q + 1) + (xcd - r) * q) + off; }
        const int nig = WGM * nN, gid = wgid / nig, fm = gid * WGM, gsz = (nM - fm) < WGM ? (nM - fm) : WGM;
        u.pm = fm + ((wgid % nig) % gsz); u.pn = (wgid % nig) / gsz; u.e = 0; u.rows = 256; u.rt = 0; return true;
    }
    __device__ __forceinline__ unsigned a_off(const Unit& u, int r, int C) const { return (unsigned)(((u.pm * BM + r) * lda + C) * 2); }
    __device__ __forceinline__ const char* b_base(const Unit& u) const { return (const char*)(Bt + (size_t)u.pn * BM * ldb); }
};

__device__ __forceinline__ v8i_t ld32_lds(const LAS unsigned char* p) { const u32x4 lo_ = *(const LAS u32x4*)p, hi_ = *(const LAS u32x4*)(p + 16); return (v8i_t){(int)lo_.x, (int)lo_.y, (int)lo_.z, (int)lo_.w, (int)hi_.x, (int)hi_.y, (int)hi_.z, (int)hi_.w}; }
__device__ __forceinline__ void mfma_f8(f32x4& c, const v8i_t a, const v8i_t b, int sa, int sb) {
    asm volatile("v_mfma_scale_f32_16x16x128_f8f6f4 %0, %1, %2, %0, %3, %4 op_sel_hi:[0,0,0]" : "+v"(c) : "v"(a), "v"(b), "v"(sa), "v"(sb));
}
template <bool F8> struct FragT { typedef bf16x8 type; };
template <> struct FragT<true> { typedef v8i_t type; };
template <class Epi, class Sched, bool FP8 = false>
__device__ __forceinline__ void gemm_phase(LAS unsigned char* lds, const Gemm g, const Sched& S, const Epi& E) {
    const int tid = threadIdx.x, wid = __builtin_amdgcn_readfirstlane(tid >> 6), lane = tid & 63, wr = wid >> 2, wc = wid & 3, fr = lane & 15, fq = lane >> 4;
    const int K = g.K, nt = K / BK;
    unsigned voffB[2];
#pragma unroll
    for (int i = 0; i < 2; ++i) { int R, C; stage_rc(tid * 16 + i * 8192, R, C); const int Rb = Epi::PERM ? ((R & ~31) + perm32(R & 31)) : R; voffB[i] = (unsigned)(Rb * g.ldb + C) * 2u; }
#define PG8_AOFF(dst, unit) do { int t_ = tid; asm volatile("" : "+v"(t_)); _Pragma("unroll") for (int i = 0; i < 2; ++i) { int R, C; stage_rc(t_ * 16 + i * 8192, R, C); \
        _Pragma("unroll") for (int h = 0; h < 2; ++h) dst[h][i] = S.a_off(unit, h * HALF + R, C); } } while (0)
    const size_t kstep = (size_t)(BK * 2);
    const size_t hstepB = (size_t)HALF * g.ldb * 2;
    const unsigned ldsw = (unsigned)wid * 1024u;
    const int aoff = FP8 ? lds_byte(wr * 64 + fr, 16 * (fq & 1)) + (fq >> 1) * 1024 : lds_byte(wr * 64 + fr, fq * 8);
    const int boff = FP8 ? lds_byte(wc * 32 + fr, 16 * (fq & 1)) + (fq >> 1) * 1024 : lds_byte(wc * 32 + fr, fq * 8);
#define PG8_SA(b, h) (((b) * 2 + (h)) * HTB)
#define PG8_SB(b, h) ((4 + (b) * 2 + (h)) * HTB)
#define PG8_STAGE(bufoff, gbase, voff) do { _Pragma("unroll") for (int _i = 0; _i < 2; ++_i) \
        __builtin_amdgcn_global_load_lds((const unsigned*)((const char*)(gbase) + (voff)[_i]), (LAS unsigned*)(lds + (bufoff) + ldsw + _i * 8192), 16, 0, 0); } while (0)
#define PG8_LD32(p) ld32_lds((const LAS unsigned char*)(p))
#define PG8_LDA(dst, b, h) do { if constexpr (FP8) { _Pragma("unroll") for (int m = 0; m < 4; ++m) dst[m][0] = __builtin_bit_cast(FT, PG8_LD32(lds + PG8_SA(b, h) + aoff + m * 2048)); } \
        else { _Pragma("unroll") for (int m = 0; m < 4; ++m) _Pragma("unroll") for (int k = 0; k < 2; ++k) dst[m][k] = __builtin_bit_cast(FT, *(const LAS FT*)(lds + PG8_SA(b, h) + aoff + m * 2048 + k * 1024)); } } while (0)
#define PG8_LDB(dst, b, h) do { if constexpr (FP8) { _Pragma("unroll") for (int n = 0; n < 2; ++n) dst[n][0] = __builtin_bit_cast(FT, PG8_LD32(lds + PG8_SB(b, h) + boff + n * 2048)); } \
        else { _Pragma("unroll") for (int n = 0; n < 2; ++n) _Pragma("unroll") for (int k = 0; k < 2; ++k) dst[n][k] = __builtin_bit_cast(FT, *(const LAS FT*)(lds + PG8_SB(b, h) + boff + n * 2048 + k * 1024)); } } while (0)
#define PG8_MMA(ai, bj, At, Bt) do { __builtin_amdgcn_s_setprio(1); \
        if constexpr (FP8) { _Pragma("unroll") for (int m = 0; m < 4; ++m) _Pragma("unroll") for (int n = 0; n < 2; ++n) \
            mfma_f8(acc[ai][bj][m][n], __builtin_bit_cast(v8i_t, Bt[n][0]), __builtin_bit_cast(v8i_t, At[m][0]), 0x7c7c7c7c, 0x7c7c7c7c); } \
        else { _Pragma("unroll") for (int m = 0; m < 4; ++m) _Pragma("unroll") for (int n = 0; n < 2; ++n) _Pragma("unroll") for (int k = 0; k < 2; ++k) \
            acc[ai][bj][m][n] = __builtin_amdgcn_mfma_f32_16x16x32_bf16(__builtin_bit_cast(bf16x8, Bt[n][k]), __builtin_bit_cast(bf16x8, At[m][k]), acc[ai][bj][m][n], 0, 0, 0); } \
        __builtin_amdgcn_s_setprio(0); } while (0)
#define PG8_WAIT_V(n) asm volatile("s_waitcnt vmcnt(" #n ")" ::: "memory")
#define PG8_WAIT_L(n) asm volatile("s_waitcnt lgkmcnt(" #n ")" ::: "memory")
#define PG8_BAR __builtin_amdgcn_s_barrier()
#define PG8_SCHED __builtin_amdgcn_sched_barrier(0)
    Unit cur, nxt; int ui = 0;
    if (!S.next(0, cur)) return;
    f32x4 acc[2][2][4][2];
#pragma unroll
    for (int a = 0; a < 2; ++a)
#pragma unroll
        for (int b = 0; b < 2; ++b)
#pragma unroll
            for (int m = 0; m < 4; ++m)
#pragma unroll
                for (int n = 0; n < 2; ++n) acc[a][b][m][n] = (f32x4){0.f, 0.f, 0.f, 0.f};
    typedef typename FragT<FP8>::type FT; constexpr int NK = FP8 ? 1 : 2;
    FT At[4][NK], B0[2][NK], B1[2][NK];
    const char* Ab = (const char*)g.A;
    const char* cB = S.b_base(cur);
    unsigned vaC[2][2], vaN[2][2];
    PG8_AOFF(vaC, cur);
    PG8_STAGE(PG8_SB(0, 0), cB, voffB); PG8_STAGE(PG8_SB(0, 1), cB + hstepB, voffB); PG8_STAGE(PG8_SA(0, 0), Ab, vaC[0]); PG8_STAGE(PG8_SA(0, 1), Ab, vaC[1]);
    if (wr == 1) PG8_BAR;
    PG8_WAIT_V(2); PG8_BAR;
    PG8_STAGE(PG8_SB(1, 0), cB + kstep, voffB); PG8_STAGE(PG8_SA(1, 0), Ab + kstep, vaC[0]); PG8_STAGE(PG8_SB(1, 1), cB + hstepB + kstep, voffB);
    PG8_WAIT_V(6); PG8_BAR;
    for (;;) {
        const bool has_next = S.next(ui + 1, nxt);
        const char* nB = has_next ? S.b_base(nxt) : cB;
        if (has_next) PG8_AOFF(vaN, nxt);
        else {
#pragma unroll
            for (int h = 0; h < 2; ++h)
#pragma unroll
                for (int i = 0; i < 2; ++i) vaN[h][i] = vaC[h][i]; }
        for (int t = 0; t < nt; t += 2) {
            const bool last = (t == nt - 2);
            const char* kA1 = Ab + (size_t)(t + 1) * kstep;
            const char* kA2 = last ? Ab : Ab + (size_t)(t + 2) * kstep; const char* b2 = last ? nB : cB + (size_t)(t + 2) * kstep;
            const char* kA3 = kA2 + kstep; const char* b3 = b2 + kstep;
            unsigned o2[2][2];
#pragma unroll
            for (int h = 0; h < 2; ++h)
#pragma unroll
                for (int i = 0; i < 2; ++i) o2[h][i] = last ? vaN[h][i] : vaC[h][i];
            PG8_LDB(B0, 0, 0); PG8_LDB(B1, 0, 1); PG8_SCHED; PG8_LDA(At, 0, 0); PG8_STAGE(PG8_SA(1, 1), kA1, vaC[1]);
            PG8_WAIT_V(8); PG8_WAIT_L(0); PG8_BAR; PG8_MMA(0, 0, At, B0); PG8_MMA(0, 1, At, B1); PG8_BAR; PG8_SCHED;
            PG8_LDA(At, 0, 1); PG8_STAGE(PG8_SB(0, 0), b2, voffB); PG8_STAGE(PG8_SB(0, 1), b2 + hstepB, voffB); PG8_STAGE(PG8_SA(0, 0), kA2, o2[0]);
            PG8_WAIT_V(8); PG8_WAIT_L(0); PG8_BAR; PG8_MMA(1, 0, At, B0); PG8_MMA(1, 1, At, B1); PG8_BAR; PG8_SCHED;
            PG8_LDB(B0, 1, 0); PG8_LDB(B1, 1, 1); PG8_SCHED; PG8_LDA(At, 1, 0); PG8_STAGE(PG8_SA(0, 1), kA2, o2[1]);
            PG8_WAIT_V(8); PG8_WAIT_L(0); PG8_BAR; PG8_MMA(0, 0, At, B0); PG8_MMA(0, 1, At, B1); PG8_BAR; PG8_SCHED;
            PG8_LDA(At, 1, 1); PG8_STAGE(PG8_SB(1, 0), b3, voffB); PG8_STAGE(PG8_SB(1, 1), b3 + hstepB, voffB); PG8_STAGE(PG8_SA(1, 0), kA3, o2[0]);
            PG8_WAIT_V(8); PG8_WAIT_L(0); PG8_BAR; PG8_MMA(1, 0, At, B0); PG8_MMA(1, 1, At, B1); PG8_BAR; PG8_SCHED;
        }
        if (wr == 0) PG8_BAR;
        if constexpr (FP8) asm volatile("s_nop 15\n\ts_nop 15" ::: "memory");
        E(acc, cur, wr, wc, fr, fq);
        if (!has_next) break;
#pragma unroll
        for (int a = 0; a < 2; ++a)
#pragma unroll
            for (int b = 0; b < 2; ++b)
#pragma unroll
                for (int m = 0; m < 4; ++m)
#pragma unroll
                    for (int n = 0; n < 2; ++n) acc[a][b][m][n] = (f32x4){0.f, 0.f, 0.f, 0.f};
        cur = nxt; cB = nB; ++ui;
#pragma unroll
        for (int h = 0; h < 2; ++h)
#pragma unroll
            for (int i = 0; i < 2; ++i) vaC[h][i] = vaN[h][i];
        if (wr == 1) PG8_BAR;
    }
    PG8_WAIT_V(0);
    PG8_BAR;
#undef PG8_SA
#undef PG8_AOFF
#undef PG8_SB
#undef PG8_STAGE
#undef PG8_LDA
#undef PG8_LDB
#undef PG8_MMA
#undef PG8_LD32
#undef PG8_WAIT_V
#undef PG8_WAIT_L
#undef PG8_BAR
#undef PG8_SCHED
}

struct EpiBf16 {
    static constexpr bool PERM = true;
    bf16_t* O; int ldc;
    __device__ __forceinline__ void operator()(const f32x4 (&acc)[2][2][4][2], const Unit& u, int wr, int wc, int fr, int fq) const {
        const int row0 = u.pm * BM + wr * 64 + fr, col0 = u.pn * BM + wc * 32 + 8 * fq;
#pragma unroll
        for (int ai = 0; ai < 2; ++ai)
#pragma unroll
            for (int m = 0; m < 4; ++m) { bf16_t* rowp = O + (size_t)(row0 + ai * HALF + m * 16) * ldc + col0;
#pragma unroll
                for (int bj = 0; bj < 2; ++bj) { const f32x4 v0 = acc[ai][bj][m][0], v1 = acc[ai][bj][m][1];
                    u32x4 w; w.x = cvtpk(v0[0], v0[1]); w.y = cvtpk(v0[2], v0[3]); w.z = cvtpk(v1[0], v1[1]); w.w = cvtpk(v1[2], v1[3]);
                    *(u32x4*)(rowp + bj * HALF) = w; } }
    }
};
template <bool FIRST> struct EpiGate {
    static constexpr bool PERM = true;
    bf16_t* O; const bf16_t* G; int ldg, gcol;
    __device__ __forceinline__ void operator()(const f32x4 (&acc)[2][2][4][2], const Unit& u, int wr, int wc, int fr, int fq) const {
        const int row0 = u.pm * BM + wr * 64 + fr, col0 = u.pn * BM + wc * 32 + 8 * fq;
#pragma unroll
        for (int ai = 0; ai < 2; ++ai)
#pragma unroll
            for (int m = 0; m < 4; ++m) { const size_t r = (size_t)(row0 + ai * HALF + m * 16);
#pragma unroll
                for (int bj = 0; bj < 2; ++bj) { const f32x4 v0 = acc[ai][bj][m][0], v1 = acc[ai][bj][m][1];
                    const int c = col0 + bj * HALF;
                    const u32x4 gw = *(const u32x4*)(G + r * ldg + gcol + c);
                    float o[8];
                    o[0] = sigmoidf_(bflo(gw.x)) * v0[0]; o[1] = sigmoidf_(bfhi(gw.x)) * v0[1]; o[2] = sigmoidf_(bflo(gw.y)) * v0[2]; o[3] = sigmoidf_(bfhi(gw.y)) * v0[3];
                    o[4] = sigmoidf_(bflo(gw.z)) * v1[0]; o[5] = sigmoidf_(bfhi(gw.z)) * v1[1]; o[6] = sigmoidf_(bflo(gw.w)) * v1[2]; o[7] = sigmoidf_(bfhi(gw.w)) * v1[3];
                    bf16_t* op = O + r * D_ + c;
                    if (!FIRST) { const u32x4 pw = *(const u32x4*)op;
                        o[0] += bflo(pw.x); o[1] += bfhi(pw.x); o[2] += bflo(pw.y); o[3] += bfhi(pw.y); o[4] += bflo(pw.z); o[5] += bfhi(pw.z); o[6] += bflo(pw.w); o[7] += bfhi(pw.w); }
                    u32x4 w; w.x = cvtpk(o[0], o[1]); w.y = cvtpk(o[2], o[3]); w.z = cvtpk(o[4], o[5]); w.w = cvtpk(o[6], o[7]);
                    *(u32x4*)op = w; } }
    }
};
struct EpiRes {
    static constexpr bool PERM = false;
    const float* base; float* out;
    __device__ __forceinline__ void operator()(const f32x4 (&acc)[2][2][4][2], const Unit& u, int wr, int wc, int fr, int fq) const {
        const int row0 = u.pm * BM + wr * 64 + fr, col0 = u.pn * BM + wc * 32 + 4 * fq;
#pragma unroll
        for (int ai = 0; ai < 2; ++ai)
#pragma unroll
            for (int m = 0; m < 4; ++m) { const size_t off = (size_t)(row0 + ai * HALF + m * 16) * D_ + col0;
#pragma unroll
                for (int bj = 0; bj < 2; ++bj)
#pragma unroll
                    for (int n = 0; n < 2; ++n) { const f32x4 b = *(const f32x4*)(base + off + bj * HALF + n * 16); *(f32x4*)(out + off + bj * HALF + n * 16) = b + acc[ai][bj][m][n]; } }
    }
};
struct EpiSwiglu {
    static constexpr bool PERM = true;
    bf16_t* act; const float* b_up;
    __device__ __forceinline__ void operator()(const f32x4 (&acc)[2][2][4][2], const Unit& u, int wr, int wc, int fr, int fq) const {
        const int row0 = u.pm * BM + wr * 64 + fr, col0 = u.pn * BM + wc * 32 + 8 * fq;
        const float* bb = b_up + (size_t)u.e * (2 * DFF);
        f32x4 bv[2][2];
#pragma unroll
        for (int bj = 0; bj < 2; ++bj)
#pragma unroll
            for (int n = 0; n < 2; ++n) bv[bj][n] = *(const f32x4*)(bb + col0 + bj * HALF + 4 * n);
#pragma unroll
        for (int ai = 0; ai < 2; ++ai)
#pragma unroll
            for (int m = 0; m < 4; ++m) { bf16_t* rowp = act + (size_t)(row0 + ai * HALF + m * 16) * DFF + (col0 >> 1);
#pragma unroll
                for (int bj = 0; bj < 2; ++bj) { const f32x4 v0 = acc[ai][bj][m][0] + bv[bj][0], v1 = acc[ai][bj][m][1] + bv[bj][1];
                    float a[4];
#pragma unroll
                    for (int p = 0; p < 4; ++p) { float gl = (p < 2) ? v0[2 * p] : v1[2 * p - 4], li = (p < 2) ? v0[2 * p + 1] : v1[2 * p - 3];
                        gl = fminf(gl, 7.f); li = fminf(fmaxf(li, -7.f), 7.f);
                        a[p] = gl * sigmoidf_(1.702f * gl) * (li + 1.f); }
                    u32x2 w; w.x = cvtpk(a[0], a[1]); w.y = cvtpk(a[2], a[3]);
                    *(u32x2*)(rowp + bj * (HALF / 2)) = w; } }
    }
};
struct EpiSwiglu8 {
    static constexpr bool PERM = true;
    unsigned char* act; const float* b_up;
    __device__ __forceinline__ void operator()(const f32x4 (&acc)[2][2][4][2], const Unit& u, int wr, int wc, int fr, int fq) const {
        const int row0 = u.pm * BM + wr * 64 + fr, col0 = u.pn * BM + wc * 32 + 8 * fq;
        const float* bb = b_up + (size_t)u.e * (2 * DFF);
        f32x4 bv[2][2];
#pragma unroll
        for (int bj = 0; bj < 2; ++bj)
#pragma unroll
            for (int n = 0; n < 2; ++n) bv[bj][n] = *(const f32x4*)(bb + col0 + bj * HALF + 4 * n);
#pragma unroll
        for (int ai = 0; ai < 2; ++ai)
#pragma unroll
            for (int m = 0; m < 4; ++m) { unsigned char* rowp = act + (size_t)(row0 + ai * HALF + m * 16) * DFF + (col0 >> 1);
#pragma unroll
                for (int bj = 0; bj < 2; ++bj) { const f32x4 v0 = acc[ai][bj][m][0] + bv[bj][0], v1 = acc[ai][bj][m][1] + bv[bj][1];
                    float a[4];
#pragma unroll
                    for (int p = 0; p < 4; ++p) { float gl = (p < 2) ? v0[2 * p] : v1[2 * p - 4], li = (p < 2) ? v0[2 * p + 1] : v1[2 * p - 3];
                        gl = fminf(gl, 7.f); li = fminf(fmaxf(li, -7.f), 7.f);
                        a[p] = gl * sigmoidf_(1.702f * gl) * (li + 1.f) * X8_SCALE; }
                    *(unsigned*)(rowp + bj * (HALF / 2)) = pk_fp8x4(a[0], a[1], a[2], a[3]); } }
    }
};
struct EpiDown {
    static constexpr bool PERM = true;
    bf16_t* y; const float* b_down; const int* list; const float* topw;
    __device__ __forceinline__ void operator()(const f32x4 (&acc)[2][2][4][2], const Unit& u, int wr, int wc, int fr, int fq) const {
        const int col0 = u.pn * BM + wc * 32 + 8 * fq;
        const float* bb = b_down + (size_t)u.e * D_;
        f32x4 bv[2][2];
#pragma unroll
        for (int bj = 0; bj < 2; ++bj)
#pragma unroll
            for (int n = 0; n < 2; ++n) bv[bj][n] = *(const f32x4*)(bb + col0 + bj * HALF + 4 * n);
        const int* lp = list + (size_t)u.e * M_ + u.rt * BM;
#pragma unroll
        for (int ai = 0; ai < 2; ++ai)
#pragma unroll
            for (int m = 0; m < 4; ++m) { const int r = ai * HALF + wr * 64 + m * 16 + fr;
                if (r < u.rows) { const int slot = lp[r]; const float w = topw[slot]; bf16_t* rowp = y + (size_t)slot * D_ + col0;
#pragma unroll
                    for (int bj = 0; bj < 2; ++bj) { const f32x4 v0 = (acc[ai][bj][m][0] + bv[bj][0]) * w, v1 = (acc[ai][bj][m][1] + bv[bj][1]) * w;
                        u32x4 o; o.x = cvtpk(v0[0], v0[1]); o.y = cvtpk(v0[2], v0[3]); o.z = cvtpk(v1[0], v1[1]); o.w = cvtpk(v1[2], v1[3]);
                        *(u32x4*)(rowp + bj * HALF) = o; } } }
    }
};
}
constexpr size_t MiB = 1ull << 20;
constexpr size_t WS_CTL = 0, CTL_ZERO_BYTES = 64 * 1024;
constexpr size_t WS_ROPE = 256 * 1024;
constexpr size_t WS_WR = 3 * MiB;
constexpr size_t WS_LIST = 4 * MiB;
constexpr size_t WS_TOPW = 6 * MiB;
constexpr size_t WS_SEL = 6 * MiB + 512 * 1024;
constexpr size_t WS_WIN = 8 * MiB;
constexpr size_t WS_WUQ = 17 * MiB;
constexpr size_t WS_WUKV = 18 * MiB;
constexpr size_t WS_WOSB = 19 * MiB;
constexpr size_t WS_WOMLA = 20 * MiB;
constexpr size_t WS_WOUT = 21 * MiB;
constexpr size_t WS_WUP = 24 * MiB;
constexpr size_t WS_WDN = 152 * MiB;
constexpr size_t WS_HB = 216 * MiB;
constexpr size_t WS_PROJ = 249 * MiB;
constexpr size_t WS_ACT = WS_PROJ;
constexpr size_t WS_QRAW = 393 * MiB;
constexpr size_t WS_KVRAW = WS_QRAW + 24 * MiB;
constexpr size_t WS_QB = WS_KVRAW + 32 * MiB;
constexpr size_t WS_KB = WS_QB + 24 * MiB;
constexpr size_t WS_VB = WS_KB + 24 * MiB;
constexpr size_t WS_OSB = WS_VB + 16 * MiB;
constexpr size_t WS_OMLA = WS_OSB + 16 * MiB;
constexpr size_t WS_YB = WS_QRAW;
constexpr size_t WS_MIX = 545 * MiB;
constexpr size_t WS_H2F8 = 577 * MiB;
constexpr size_t WS_OPT_END = 594 * MiB;
constexpr int CW_CNT = 0;
constexpr int CW_BAR = 1024;
constexpr int LDS_STAGE = 143360;
constexpr int LDS_MISC = LDS_STAGE;
constexpr int LDS_BYTES = 147456;
constexpr int MI_BAR = 0, MI_TPFX = 16, MI_CNT = 64, MI_FLAG = 128, MI_LCNT = 160, MI_BASE = 192, MI_RSTD = 256;

typedef GAS unsigned gu32;
#define RLX_AGENT __ATOMIC_RELAXED, __HIP_MEMORY_SCOPE_AGENT

#define XB_TMO      128
#define XB_XCNT(j)  (256  + 64 * (j))
#define XB_XSUB(j)  (1280 + 64 * (j))
#define XB_XGEN(j)  (2304 + 64 * (j))
#define XB_TOP      3328
#define XB_TOPGEN   3392
#define XCD_BAR_WORDS 3456
#define XB_SPIN_CAP (1u << 18)
__device__ __forceinline__ unsigned xb_ld(unsigned* p)              { return __hip_atomic_load(p, __ATOMIC_RELAXED, __HIP_MEMORY_SCOPE_AGENT); }
__device__ __forceinline__ unsigned xb_add(unsigned* p, unsigned v) { return __hip_atomic_fetch_add(p, v, __ATOMIC_RELAXED, __HIP_MEMORY_SCOPE_AGENT); }
__device__ __forceinline__ unsigned xb_xcc_id() { return (unsigned)__builtin_amdgcn_s_getreg((3 << 11) | 20) & 0xFu; }
#define XB_SPIN(cond, bar) do { unsigned _sp = 0; while (cond) { __builtin_amdgcn_s_sleep(1); \
    if ((++_sp & 255u) == 0u) { if (xb_ld(&(bar)[XB_TMO])) break; if (_sp > XB_SPIN_CAP) { atomicAdd(&(bar)[XB_TMO], 1u); break; } } } } while (0)
struct XcdBarrier { unsigned* bar; unsigned x; volatile LAS unsigned* st; };
__device__ __forceinline__ XcdBarrier xcd_barrier_post(unsigned* bar, volatile LAS unsigned* st) {
    XcdBarrier b; b.bar = bar; b.x = xb_xcc_id(); b.st = st;
    if (threadIdx.x == 0) (void)xb_add(&bar[XB_XCNT(b.x)], 1u);
    return b;
}
__device__ __forceinline__ void xcd_barrier_complete(unsigned* bar, unsigned x, unsigned& nloc, unsigned& nx) {
    const unsigned G = gridDim.x * gridDim.y * gridDim.z;
    unsigned sum, cnt, mine, sp = 0u;
    for (;;) {
        sum = 0u; cnt = 0u; mine = 0u;
#pragma unroll
        for (unsigned j = 0; j < 16; ++j) { const unsigned c = xb_ld(&bar[XB_XCNT(j)]); sum += c; cnt += (c > 0u) ? 1u : 0u; mine = (j == x) ? c : mine; }
        if (sum == G) break;
        __builtin_amdgcn_s_sleep(1);
        if ((++sp & 255u) == 0u) { if (xb_ld(&bar[XB_TMO])) break; if (sp > XB_SPIN_CAP) { atomicAdd(&bar[XB_TMO], 1u); break; } }
    }
    nloc = mine > 0u ? mine : 1u; nx = cnt > 0u ? cnt : 1u;
}
__device__ __forceinline__ void xcd_barrier(const XcdBarrier& b) {
    asm volatile("s_waitcnt vmcnt(0)" ::: "memory");
    __syncthreads();
    if (threadIdx.x == 0) {
        unsigned* bar = b.bar;
        __builtin_amdgcn_s_waitcnt(0);
        unsigned nloc = b.st[0], nx = b.st[1];
        if (nloc == 0u) { xcd_barrier_complete(bar, b.x, nloc, nx); b.st[0] = nloc; b.st[1] = nx; }
        const unsigned old = xb_add(&bar[XB_XSUB(b.x)], 1u);
        const unsigned gen = old / nloc;
        if (old + 1u == (gen + 1u) * nloc) {
            __builtin_amdgcn_fence(__ATOMIC_RELEASE, "agent");
            asm volatile("s_waitcnt vmcnt(0)" ::: "memory");
            const unsigned og = xb_add(&bar[XB_TOP], 1u);
            const unsigned tg = og / nx;
            if (og + 1u == (tg + 1u) * nx) xb_add(&bar[XB_TOPGEN], 1u);
            else XB_SPIN(xb_ld(&bar[XB_TOPGEN]) == tg, bar);
            __builtin_amdgcn_fence(__ATOMIC_ACQUIRE, "agent");
            xb_add(&bar[XB_XGEN(b.x)], 1u);
            asm volatile("s_waitcnt vmcnt(0)" ::: "memory");
        } else {
            XB_SPIN(xb_ld(&bar[XB_XGEN(b.x)]) == gen, bar);
            __builtin_amdgcn_fence(__ATOMIC_ACQUIRE, "agent");
            asm volatile("s_waitcnt vmcnt(0)" ::: "memory");
        }
    }
    __syncthreads();
}

struct Args {
    const float* in[20]; float* out; unsigned char* ws;
    int ph_lo, ph_hi;
};

struct Frame {
    LAS unsigned char* lds; volatile LAS unsigned* MISC;
    int tid, lane, wave, vcu, G;
    unsigned char* ws;
};

__device__ __forceinline__ void p0_transpose_item(const float* W, int K, int N, bf16_t* WT, LAS float* scr, int item, int lane, const float* gk, float cs, int csn) {
    const int nblk = N / 32, kb = item / nblk, nb = item % nblk, k0 = 64 * kb, n0 = 32 * nb;
    const float colsc = (n0 < csn) ? cs : 1.f;
    float tv[32];
#pragma unroll
    for (int i = 0; i < 32; ++i) { const int kk = 2 * i + (lane >> 5); tv[i] = W[(size_t)(k0 + kk) * N + n0 + (lane & 31)]; }
#pragma unroll
    for (int i = 0; i < 32; ++i) { const int kk = 2 * i + (lane >> 5); float v = tv[i] * colsc; if (gk) v *= gk[k0 + kk]; scr[kk * 33 + (lane & 31)] = v; }
    asm volatile("s_waitcnt lgkmcnt(0)" ::: "memory");
    const int c = lane & 7;
#pragma unroll
    for (int j = 0; j < 4; ++j) { const int n = (lane >> 3) + 8 * j; const LAS float* s = scr + (8 * c) * 33 + n;
        u32x4 o; o.x = cvtpk(s[0 * 33], s[1 * 33]); o.y = cvtpk(s[2 * 33], s[3 * 33]); o.z = cvtpk(s[4 * 33], s[5 * 33]); o.w = cvtpk(s[6 * 33], s[7 * 33]);
        *(u32x4*)(WT + (size_t)(n0 + n) * K + k0 + 8 * c) = o; }
    asm volatile("s_waitcnt lgkmcnt(0)" ::: "memory");
}
__device__ __forceinline__ void p0_transpose_item_fp8(const float* W, int K, int N, unsigned char* WT, LAS float* scr, int item, int lane, float cs) {
    const int nblk = N / 32, kb = item / nblk, nb = item % nblk, k0 = 64 * kb, n0 = 32 * nb;
    float tv[32];
#pragma unroll
    for (int i = 0; i < 32; ++i) { const int kk = 2 * i + (lane >> 5); tv[i] = W[(size_t)(k0 + kk) * N + n0 + (lane & 31)]; }
#pragma unroll
    for (int i = 0; i < 32; ++i) { const int kk = 2 * i + (lane >> 5); scr[kk * 33 + (lane & 31)] = tv[i] * cs; }
    asm volatile("s_waitcnt lgkmcnt(0)" ::: "memory");
    const int c = lane & 7;
#pragma unroll
    for (int j = 0; j < 4; ++j) { const int n = (lane >> 3) + 8 * j; const LAS float* s = scr + (8 * c) * 33 + n;
        u32x2 o; o.x = pk_fp8x4(s[0 * 33], s[1 * 33], s[2 * 33], s[3 * 33]); o.y = pk_fp8x4(s[4 * 33], s[5 * 33], s[6 * 33], s[7 * 33]);
        *(u32x2*)(WT + (size_t)(n0 + n) * K + k0 + 8 * c) = o; }
    asm volatile("s_waitcnt lgkmcnt(0)" ::: "memory");
}
__device__ __forceinline__ void rms_row_to_bf16(const float* xrow, const float* g, bf16_t* orow, int lane) {
    const f32x4* xr = (const f32x4*)xrow + lane; const f32x4* gr = (const f32x4*)g + lane;
    f32x4 v[4]; float s = 0.f;
#pragma unroll
    for (int j = 0; j < 4; ++j) { v[j] = xr[64 * j]; s += (v[j].x * v[j].x + v[j].y * v[j].y) + (v[j].z * v[j].z + v[j].w * v[j].w); }
    const float rstd = rsqrtf(wave_sum(s) * (1.f / D_) + EPS);
    u32x2* o8 = (u32x2*)orow + lane;
#pragma unroll
    for (int j = 0; j < 4; ++j) { const f32x4 gg = gr[64 * j]; u32x2 w; w.x = cvtpk(v[j].x * rstd * gg.x, v[j].y * rstd * gg.y); w.y = cvtpk(v[j].z * rstd * gg.z, v[j].w * rstd * gg.w); o8[64 * j] = w; }
}
__device__ __forceinline__ void p0_prologue(Frame& F, const Args& a, int do_moe_w, int do_rest) {
    LAS float* scr = (LAS float*)(F.lds + F.wave * 16384);
    const int gw = F.vcu * NWAVES + F.wave, NGW = F.G * NWAVES;
    unsigned char* ws = F.ws;
    const float* w_in = a.in[3]; const float* g_cq = a.in[4]; const float* w_uq = a.in[5]; const float* g_ckv = a.in[6]; const float* w_ukv = a.in[7];
    const float* w_o_sb = a.in[10]; const float* w_o_mla = a.in[11]; const float* w_out = a.in[12]; const float* g_ffn = a.in[13]; const float* w_router = a.in[14];
    const float* w_up = a.in[16]; const float* w_down = a.in[18];
    constexpr int I_IN = (D_ / 64) * (INW / 32), I_UQ = (384 / 64) * (768 / 32), I_UKV = (256 / 64) * (1024 / 32), I_O = (512 / 64) * (1024 / 32), I_OUT = (1024 / 64) * (1024 / 32);
    constexpr int I_UP1 = (1024 / 64) * (2048 / 32), I_DN1 = (1024 / 64) * (1024 / 32);
    if (do_rest) {
        constexpr int NI = I_IN + I_UQ + I_UKV + 2 * I_O + I_OUT;
        for (int it = gw; it < NI; it += NGW) {
            int r = it;
            if (r < I_IN) { p0_transpose_item(w_in, D_, INW, (bf16_t*)(ws + WS_WIN), scr, r, F.lane, nullptr, SB_QSCALE, 512); continue; } r -= I_IN;
            if (r < I_UQ) { p0_transpose_item(w_uq, 384, 768, (bf16_t*)(ws + WS_WUQ), scr, r, F.lane, g_cq, 1.f, 0); continue; } r -= I_UQ;
            if (r < I_UKV) { p0_transpose_item(w_ukv, 256, 1024, (bf16_t*)(ws + WS_WUKV), scr, r, F.lane, g_ckv, 1.f, 0); continue; } r -= I_UKV;
            if (r < I_O) { p0_transpose_item(w_o_sb, 512, 1024, (bf16_t*)(ws + WS_WOSB), scr, r, F.lane, nullptr, 1.f, 0); continue; } r -= I_O;
            if (r < I_O) { p0_transpose_item(w_o_mla, 512, 1024, (bf16_t*)(ws + WS_WOMLA), scr, r, F.lane, nullptr, 1.f, 0); continue; } r -= I_O;
            p0_transpose_item(w_out, 1024, 1024, (bf16_t*)(ws + WS_WOUT), scr, r, F.lane, nullptr, 1.f, 0);
        }
        { const int gt = gw * 64 + F.lane, NGT = NGW * 64;
          u32x4 z = {0u, 0u, 0u, 0u};
          u32x4* pz = (u32x4*)((bf16_t*)(ws + WS_WIN) + (size_t)INW * D_);
          for (int i = gt; i < (INWP - INW) * D_ * 2 / 16; i += NGT) pz[i] = z;
          u32x4* hz = (u32x4*)((unsigned char*)(ws + WS_H2F8) + (size_t)M_ * D_);
          for (int i = gt; i < D_ / 16; i += NGT) hz[i] = z;
          const int* pos = (const int*)a.in[1]; float* rt = (float*)(ws + WS_ROPE);
          for (int i = gt; i < M_ * 16; i += NGT) { const int row = i >> 4, k = i & 15; const float inv = powf(10000.f, -(float)k / 16.f); const float ang = (float)pos[row] * inv; rt[row * 32 + k] = cosf(ang); rt[row * 32 + 16 + k] = sinf(ang); }
          float* wr = (float*)(ws + WS_WR);
          for (int i = gt; i < D_ * NE; i += NGT) wr[i] = w_router[i] * g_ffn[i >> 5];
        }
        for (int m = gw; m < M_; m += NGW) rms_row_to_bf16(a.in[0] + (size_t)m * D_, a.in[2], (bf16_t*)(ws + WS_HB) + (size_t)m * D_, F.lane);
    }
    if (do_moe_w) {
        constexpr int NI = NE * (I_UP1 + I_DN1);
        for (int it = gw; it < NI; it += NGW) {
            int r = it;
            if (r < NE * I_UP1) { const int e = r / I_UP1; p0_transpose_item_fp8(w_up + (size_t)e * D_ * 2 * DFF, D_, 2 * DFF, (unsigned char*)(ws + WS_WUP) + (size_t)e * 2 * DFF * D_, scr, r % I_UP1, F.lane, W8_SCALE); continue; }
            r -= NE * I_UP1;
            { const int e = r / I_DN1; p0_transpose_item_fp8(w_down + (size_t)e * DFF * D_, DFF, D_, (unsigned char*)(ws + WS_WDN) + (size_t)e * D_ * DFF, scr, r % I_DN1, F.lane, W8_SCALE); }
        }
    }
}

__device__ __forceinline__ void ld16bf(const bf16_t* p, float (&v)[16]) {
    const u32x4 a = *(const u32x4*)p, b = *(const u32x4*)(p + 8);
    v[0] = bflo(a.x); v[1] = bfhi(a.x); v[2] = bflo(a.y); v[3] = bfhi(a.y); v[4] = bflo(a.z); v[5] = bfhi(a.z); v[6] = bflo(a.w); v[7] = bfhi(a.w);
    v[8] = bflo(b.x); v[9] = bfhi(b.x); v[10] = bflo(b.y); v[11] = bfhi(b.y); v[12] = bflo(b.z); v[13] = bfhi(b.z); v[14] = bflo(b.w); v[15] = bfhi(b.w);
}
__device__ __forceinline__ void st16bf(bf16_t* p, const float (&v)[16]) {
    u32x4 a, b; a.x = cvtpk(v[0], v[1]); a.y = cvtpk(v[2], v[3]); a.z = cvtpk(v[4], v[5]); a.w = cvtpk(v[6], v[7]);
    b.x = cvtpk(v[8], v[9]); b.y = cvtpk(v[10], v[11]); b.z = cvtpk(v[12], v[13]); b.w = cvtpk(v[14], v[15]);
    *(u32x4*)p = a; *(u32x4*)(p + 8) = b;
}
struct PrepIn { unsigned cq0, cq1, cq2; u32x2 ckv; u32x4 qa, qb, ka, kb, vv; float rope; };
__device__ __forceinline__ void p4_load(PrepIn& in, int row, const bf16_t* proj, const bf16_t* qraw, const bf16_t* kvraw, const float* rope, int lane) {
    const int h = lane >> 3, s = lane & 7;
    const bf16_t* pr = proj + (size_t)row * INWP;
    { const bf16_t* p = pr + C_CQ + lane * 6; in.cq0 = *(const unsigned*)p; in.cq1 = *(const unsigned*)(p + 2); in.cq2 = *(const unsigned*)(p + 4); }
    in.ckv = *(const u32x2*)(pr + C_CKV + lane * 4);
    in.rope = rope[(size_t)row * 32 + (lane & 31)];
    const u32x4 z = {0u, 0u, 0u, 0u};
    in.qa = z; in.qb = z; in.ka = z; in.kb = z;
    if (s < 6) { const bf16_t* q = qraw + (size_t)row * 768 + h * 96 + s * 16; in.qa = *(const u32x4*)q; in.qb = *(const u32x4*)(q + 8);
        const bf16_t* k = (s < 4) ? (kvraw + (size_t)row * 1024 + h * 128 + s * 16) : (pr + C_KR + (s - 4) * 16); in.ka = *(const u32x4*)k; in.kb = *(const u32x4*)(k + 8); }
    in.vv = *(const u32x4*)(kvraw + (size_t)row * 1024 + (lane >> 3) * 128 + 64 + (lane & 7) * 8);
}
__device__ __forceinline__ void unpack16(const u32x4 a, const u32x4 b, float (&v)[16]) {
    v[0] = bflo(a.x); v[1] = bfhi(a.x); v[2] = bflo(a.y); v[3] = bfhi(a.y); v[4] = bflo(a.z); v[5] = bfhi(a.z); v[6] = bflo(a.w); v[7] = bfhi(a.w);
    v[8] = bflo(b.x); v[9] = bfhi(b.x); v[10] = bflo(b.y); v[11] = bfhi(b.y); v[12] = bflo(b.z); v[13] = bfhi(b.z); v[14] = bflo(b.w); v[15] = bfhi(b.w);
}
__device__ __forceinline__ void p4_prep(Frame& F, const Args& a) {
    unsigned char* ws = F.ws;
    const bf16_t* proj = (const bf16_t*)(ws + WS_PROJ); const bf16_t* qraw = (const bf16_t*)(ws + WS_QRAW); const bf16_t* kvraw = (const bf16_t*)(ws + WS_KVRAW);
    bf16_t* QB = (bf16_t*)(ws + WS_QB); bf16_t* KB = (bf16_t*)(ws + WS_KB); bf16_t* VB = (bf16_t*)(ws + WS_VB);
    const float* rope = (const float*)(ws + WS_ROPE); const float* gq = a.in[8]; const float* gk = a.in[9];
    const int gw = F.vcu * NWAVES + F.wave, NGW = F.G * NWAVES, lane = F.lane, h = lane >> 3, s = lane & 7;
    float gqv[16], gkv[16];
#pragma unroll
    for (int j = 0; j < 16; ++j) { gqv[j] = (s < 6) ? gq[s * 16 + j] : 0.f; gkv[j] = (s < 6) ? gk[s * 16 + j] : 0.f; }
    PrepIn cur, nxt;
    if (gw < M_) p4_load(cur, gw, proj, qraw, kvraw, rope, lane);
    for (int row = gw; row < M_; row += NGW) {
        const bool hn = row + NGW < M_;
        if (hn) p4_load(nxt, row + NGW, proj, qraw, kvraw, rope, lane);
        float sq = bflo(cur.cq0) * bflo(cur.cq0) + bfhi(cur.cq0) * bfhi(cur.cq0) + bflo(cur.cq1) * bflo(cur.cq1) + bfhi(cur.cq1) * bfhi(cur.cq1) + bflo(cur.cq2) * bflo(cur.cq2) + bfhi(cur.cq2) * bfhi(cur.cq2);
        float skv = bflo(cur.ckv.x) * bflo(cur.ckv.x) + bfhi(cur.ckv.x) * bfhi(cur.ckv.x) + bflo(cur.ckv.y) * bflo(cur.ckv.y) + bfhi(cur.ckv.y) * bfhi(cur.ckv.y);
        sq = wave_sum(sq); skv = wave_sum(skv);
        const float var_cq = sq * (1.f / 384.f) + EPS;
        const float rstd_ckv = rsqrtf(skv * (1.f / 256.f) + EPS);
        float cs[16], sn[16];
#pragma unroll
        for (int j = 0; j < 16; ++j) { cs[j] = __int_as_float(__builtin_amdgcn_readlane(__float_as_int(cur.rope), j)); sn[j] = __int_as_float(__builtin_amdgcn_readlane(__float_as_int(cur.rope), 16 + j)); }
        {
            float v[16]; unpack16(cur.qa, cur.qb, v);
            float ss = 0.f;
#pragma unroll
            for (int j = 0; j < 16; ++j) ss += v[j] * v[j];
            ss += __shfl_xor(ss, 1); ss += __shfl_xor(ss, 2); ss += __shfl_xor(ss, 4);
            const float r = rsqrtf(ss * (1.f / 96.f) + EPS * var_cq);
#pragma unroll
            for (int j = 0; j < 16; ++j) v[j] = v[j] * r * gqv[j];
            float o[16];
#pragma unroll
            for (int j = 0; j < 16; ++j) { const float pv = __shfl_xor(v[j], 1);
                o[j] = (s == 4) ? (v[j] * cs[j] - pv * sn[j]) : (s == 5) ? (v[j] * cs[j] + pv * sn[j]) : v[j]; o[j] *= MLA_QSCALE; }
            if (s < 6) st16bf(QB + (size_t)row * 768 + h * 96 + s * 16, o);
        }
        {
            float v[16]; unpack16(cur.ka, cur.kb, v);
            if (s < 4) {
#pragma unroll
                for (int j = 0; j < 16; ++j) v[j] *= rstd_ckv; }
            float ss = 0.f;
#pragma unroll
            for (int j = 0; j < 16; ++j) ss += v[j] * v[j];
            ss += __shfl_xor(ss, 1); ss += __shfl_xor(ss, 2); ss += __shfl_xor(ss, 4);
            const float r = rsqrtf(ss * (1.f / 96.f) + EPS);
#pragma unroll
            for (int j = 0; j < 16; ++j) v[j] = v[j] * r * gkv[j];
            float o[16];
#pragma unroll
            for (int j = 0; j < 16; ++j) { const float pv = __shfl_xor(v[j], 1);
                o[j] = (s == 4) ? (v[j] * cs[j] - pv * sn[j]) : (s == 5) ? (v[j] * cs[j] + pv * sn[j]) : v[j]; }
            if (s < 6) st16bf(KB + (size_t)row * 768 + h * 96 + s * 16, o);
            const u32x4 vw = cur.vv;
            u32x4 ow; ow.x = cvtpk(bflo(vw.x) * rstd_ckv, bfhi(vw.x) * rstd_ckv); ow.y = cvtpk(bflo(vw.y) * rstd_ckv, bfhi(vw.y) * rstd_ckv);
            ow.z = cvtpk(bflo(vw.z) * rstd_ckv, bfhi(vw.z) * rstd_ckv); ow.w = cvtpk(bflo(vw.w) * rstd_ckv, bfhi(vw.w) * rstd_ckv);
            *(u32x4*)(VB + (size_t)row * 512 + lane * 8) = ow;
        }
        if (hn) cur = nxt;
    }
}
namespace att {
constexpr int BUFB = 20480;
constexpr int OST_OFF = 2 * BUFB;
constexpr int WSF_OFF = OST_OFF + 8 * 4096;
constexpr int FLG_OFF = WSF_OFF + 8 * 256;
__device__ __forceinline__ int crow(int r, int hi) { return (r & 3) + 8 * (r >> 2) + 4 * hi; }
__device__ __forceinline__ s16x4 vtr(const LAS char* p) { typedef short v4i16_t __attribute__((ext_vector_type(4))); return __builtin_bit_cast(s16x4, __builtin_amdgcn_ds_read_tr16_b64_v4i16((LAS v4i16_t*)p)); }
#define ATT_MFMA(a, b, c) __builtin_amdgcn_mfma_f32_32x32x16_bf16((a), (b), (c), 0, 0, 0)

template <int NCH> struct Stage {
    u32x4 k0, k1, v0;
    __device__ __forceinline__ void load(const bf16_t* Kb, int pitchK, const bf16_t* Vb, int pitchV, int key0, int wid, int lane) {
        k0 = *(const u32x4*)(Kb + (size_t)(key0 + lane) * pitchK + wid * 8);
        if (NCH > 8) { if (wid < NCH - 8) k1 = *(const u32x4*)(Kb + (size_t)(key0 + lane) * pitchK + (8 + wid) * 8); }
        v0 = *(const u32x4*)(Vb + (size_t)(key0 + 16 * (wid & 3) + (lane >> 2)) * pitchV + (wid >> 2) * 32 + (lane & 3) * 8);
    }
    __device__ __forceinline__ void write(LAS unsigned char* buf, int wid, int lane) const {
        *(LAS u32x4*)(buf + wid * 1024 + lane * 16) = k0;
        if (NCH > 8) { if (wid < NCH - 8) *(LAS u32x4*)(buf + (8 + wid) * 1024 + lane * 16) = k1; }
        *(LAS u32x4*)(buf + NCH * 1024 + wid * 1024 + lane * 16) = v0;
    }
};

__device__ __forceinline__ void pv_tile(f32x16 (&o)[2], const LAS char* vp, const bf16x8 (&pa)[4]) {
#pragma unroll
    for (int d0 = 0; d0 < 2; ++d0)
#pragma unroll
        for (int ks = 0; ks < 4; ++ks) {
            const s16x4 lo = vtr(vp + d0 * 4096 + ks * 1024), hi = vtr(vp + d0 * 4096 + ks * 1024 + 512);
            const bf16x8 vf = __builtin_shufflevector(lo, hi, 0, 1, 2, 3, 4, 5, 6, 7);
            o[d0] = ATT_MFMA(pa[ks], vf, o[d0]);
        }
}
__device__ __forceinline__ bf16x8 pack8(const f32x16& p, int base) {
    u32x4 w; w.x = cvtpk(p[base], p[base + 1]); w.y = cvtpk(p[base + 2], p[base + 3]); w.z = cvtpk(p[base + 4], p[base + 5]); w.w = cvtpk(p[base + 6], p[base + 7]);
    return __builtin_bit_cast(bf16x8, w);
}
__device__ __forceinline__ void store_o(const f32x16 (&o)[2], const float (&rs)[16], LAS unsigned char* lds, int wid, int lane, bf16_t* Ow) {
    const int r32 = lane & 31, hi = lane >> 5;
    LAS bf16_t* stg = (LAS bf16_t*)(lds + OST_OFF + wid * 4096);
#pragma unroll
    for (int r = 0; r < 16; ++r) { const int orow = crow(r, hi);
#pragma unroll
        for (int d0 = 0; d0 < 2; ++d0) { const unsigned w = cvtpk(o[d0][r] * rs[r], 0.f); stg[orow * 64 + d0 * 32 + r32] = (bf16_t)(w & 0xffffu); } }
    asm volatile("s_waitcnt lgkmcnt(0)" ::: "memory");
#pragma unroll
    for (int i = 0; i < 4; ++i) { const int row = i * 8 + (lane >> 3), ch = lane & 7; const u32x4 v = *(const LAS u32x4*)(stg + row * 64 + ch * 8); *(u32x4*)(Ow + (size_t)row * 512 + ch * 8) = v; }
    asm volatile("s_waitcnt lgkmcnt(0)" ::: "memory");
}

__device__ __forceinline__ void mla_unit(LAS unsigned char* lds, int b, int h, int qb, const bf16_t* QB, const bf16_t* KB, const bf16_t* VB, bf16_t* O, float m0) {
    const int tid = threadIdx.x, lane = tid & 63, r32 = lane & 31, hi = lane >> 5; const int wid = __builtin_amdgcn_readfirstlane(tid >> 6);
    const size_t rb = (size_t)b * S_; const int q0 = qb * 256;
    const bf16_t* Kh = KB + rb * 768 + h * 96; const bf16_t* Vh = VB + rb * 512 + h * 64;
    bf16x8 qr[6];
    { const bf16_t* qp = QB + (rb + q0 + wid * 32 + r32) * 768 + h * 96 + hi * 8;
#pragma unroll
      for (int d0 = 0; d0 < 6; ++d0) qr[d0] = *(const bf16x8*)(qp + d0 * 16); }
    const int NT = 4 * qb + 4, my_last = 4 * qb + (wid >> 1);
    f32x16 o[2]; float l = 0.f;
#pragma unroll
    for (int r = 0; r < 16; ++r) { o[0][r] = 0.f; o[1][r] = 0.f; }
    Stage<12> st;
    st.load(Kh, 768, Vh, 512, 0, wid, lane); st.write(lds, wid, lane);
    __syncthreads();
    for (int t = 0; t < NT; ++t) {
        if (t + 1 < NT) st.load(Kh, 768, Vh, 512, (t + 1) * 64, wid, lane);
        if (t <= my_last) {
            const LAS char* buf = (const LAS char*)(lds + (t & 1) * BUFB);
            const LAS char* kp = buf + hi * 1024 + r32 * 16;
            f32x16 p0, p1;
#pragma unroll
            for (int r = 0; r < 16; ++r) { p0[r] = -m0; p1[r] = -m0; }
#pragma unroll
            for (int d0 = 0; d0 < 6; ++d0) { const bf16x8 a0 = *(const LAS bf16x8*)(kp + d0 * 2048), a1 = *(const LAS bf16x8*)(kp + d0 * 2048 + 512);
                p0 = ATT_MFMA(a0, qr[d0], p0); p1 = ATT_MFMA(a1, qr[d0], p1); }
            float ls = 0.f;
#pragma unroll
            for (int r = 0; r < 16; ++r) { p0[r] = __builtin_amdgcn_exp2f(p0[r]); p1[r] = __builtin_amdgcn_exp2f(p1[r]); ls += p0[r] + p1[r]; }
            l += ls;
            bf16x8 pa[4]; pa[0] = pack8(p0, 0); pa[1] = pack8(p0, 8); pa[2] = pack8(p1, 0); pa[3] = pack8(p1, 8);
            const LAS char* vp = buf + 12 * 1024 + ((lane >> 4) & 1) * 32 + (lane & 3) * 8 + (4 * hi + ((lane & 15) >> 2)) * 64;
            pv_tile(o, vp, pa);
        }
        if (t + 1 < NT) st.write(lds + ((t + 1) & 1) * BUFB, wid, lane);
        __syncthreads();
    }
    l += __shfl_xor(l, 32);
    LAS float* wsf = (LAS float*)(lds + WSF_OFF) + wid * 64;
    if (hi == 0) wsf[r32] = l;
    asm volatile("s_waitcnt lgkmcnt(0)" ::: "memory");
    float rs[16];
#pragma unroll
    for (int r = 0; r < 16; ++r) rs[r] = __builtin_amdgcn_rcpf(wsf[crow(r, hi)]);
    store_o(o, rs, lds, wid, lane, O + (rb + q0 + wid * 32) * 512 + h * 64);
}

constexpr float SB_THR = -152.f;
__device__ __forceinline__ void sb_unit(LAS unsigned char* lds, int b, int h, int qb, const bf16_t* proj, bf16_t* O) {
    const int tid = threadIdx.x, lane = tid & 63, r32 = lane & 31, hi = lane >> 5; const int wid = __builtin_amdgcn_readfirstlane(tid >> 6);
    const size_t rb = (size_t)b * S_; const int q0 = qb * 256;
    const bf16_t* Kh = proj + rb * INWP + C_SBK + h * 64; const bf16_t* Vh = proj + rb * INWP + C_SBV + h * 64;
    bf16x8 qr[4];
    { const bf16_t* qp = proj + (rb + q0 + wid * 32 + r32) * INWP + C_SBQ + h * 64 + hi * 8;
#pragma unroll
      for (int d0 = 0; d0 < 4; ++d0) qr[d0] = *(const bf16x8*)(qp + d0 * 16); }
    const int Ttop = 4 * qb + 3, qw0 = q0 + wid * 32, qabs = qw0 + r32;
    f32x16 o[2]; float carry = 0.f;
#pragma unroll
    for (int r = 0; r < 16; ++r) { o[0][r] = 0.f; o[1][r] = 0.f; }
    volatile LAS int* flg = (volatile LAS int*)(lds + FLG_OFF);
    Stage<8> st;
    st.load(Kh, INWP, Vh, INWP, Ttop * 64, wid, lane); st.write(lds, wid, lane);
    __syncthreads();
    bool alive = true;
    for (int it = 0;; ++it) {
        const int t = Ttop - it;
        if (t > 0) st.load(Kh, INWP, Vh, INWP, (t - 1) * 64, wid, lane);
        if (alive && (64 * t <= qw0 + 30)) {
            const LAS char* buf = (const LAS char*)(lds + (it & 1) * BUFB);
            const LAS char* kp = buf + hi * 1024 + r32 * 16;
            f32x16 p0, p1;
#pragma unroll
            for (int r = 0; r < 16; ++r) { p0[r] = 0.f; p1[r] = 0.f; }
#pragma unroll
            for (int d0 = 0; d0 < 4; ++d0) { const bf16x8 a0 = *(const LAS bf16x8*)(kp + d0 * 2048), a1 = *(const LAS bf16x8*)(kp + d0 * 2048 + 512);
                p0 = ATT_MFMA(a0, qr[d0], p0); p1 = ATT_MFMA(a1, qr[d0], p1); }
            const bool need_mask = (64 * t + 63 >= qw0);
            const int kb0 = 64 * t + 4 * hi;
            f32x16 s0, s1;
#pragma unroll
            for (int r = 0; r < 16; ++r) {
                const int key = kb0 + (r & 3) + 8 * (r >> 2);
                { const float z = p0[r]; const float e = __builtin_amdgcn_exp2f(-fabsf(z)); const float tt = __builtin_amdgcn_logf(1.f + e); float lsv = fminf(-z, 0.f) - tt;
                  if (need_mask && !(key < qabs)) { lsv = 0.f; p0[r] = -INFINITY; } s0[r] = lsv; }
                { const float z = p1[r]; const float e = __builtin_amdgcn_exp2f(-fabsf(z)); const float tt = __builtin_amdgcn_logf(1.f + e); float lsv = fminf(-z, 0.f) - tt;
                  if (need_mask && !(key + 32 < qabs)) { lsv = 0.f; p1[r] = -INFINITY; } s1[r] = lsv; }
            }
            float T[9]; T[8] = 0.f;
#pragma unroll
            for (int j = 7; j >= 0; --j) { const int i = j & 3; const float qs = (j >= 4) ? ((s1[4 * i] + s1[4 * i + 1]) + (s1[4 * i + 2] + s1[4 * i + 3])) : ((s0[4 * i] + s0[4 * i + 1]) + (s0[4 * i + 2] + s0[4 * i + 3])); T[j] = T[j + 1] + qs; }
            float Tp[9]; Tp[8] = 0.f;
#pragma unroll
            for (int j = 0; j < 8; ++j) Tp[j] = __shfl_xor(T[j], 32);
#pragma unroll
            for (int j = 7; j >= 0; --j) {
                const int i = j & 3;
                float lat = carry + T[j + 1] + (hi ? Tp[j + 1] : Tp[j]);
#pragma unroll
                for (int e3 = 3; e3 >= 0; --e3) {
                    const int r = 4 * i + e3;
                    if (j >= 4) { const float lsv = s1[r]; p1[r] = __builtin_amdgcn_exp2f(lsv + p1[r] + lat); lat += lsv; }
                    else        { const float lsv = s0[r]; p0[r] = __builtin_amdgcn_exp2f(lsv + p0[r] + lat); lat += lsv; }
                }
            }
            carry += T[0] + Tp[0];
            bf16x8 pa[4]; pa[0] = pack8(p0, 0); pa[1] = pack8(p0, 8); pa[2] = pack8(p1, 0); pa[3] = pack8(p1, 8);
            const LAS char* vp = buf + 8 * 1024 + ((lane >> 4) & 1) * 32 + (lane & 3) * 8 + (4 * hi + ((lane & 15) >> 2)) * 64;
            pv_tile(o, vp, pa);
            alive = __any(carry > SB_THR);
        }
        if (lane == 0) flg[(it & 1) * 8 + wid] = alive ? 1 : 0;
        if (t > 0) st.write(lds + ((it + 1) & 1) * BUFB, wid, lane);
        __syncthreads();
        if (t == 0) break;
        int any = 0;
#pragma unroll
        for (int w = 0; w < 8; ++w) any |= flg[(it & 1) * 8 + w];
        if (!any) break;
    }
    float rs[16];
#pragma unroll
    for (int r = 0; r < 16; ++r) rs[r] = 1.f;
    store_o(o, rs, lds, wid, lane, O + (rb + q0 + wid * 32) * 512 + h * 64);
}
}

__device__ __forceinline__ void p5_attention(Frame& F, const Args& a) {
    unsigned char* ws = F.ws;
    float gm;
    { const float* gq = a.in[8]; const float* gk = a.in[9]; float mq = 0.f, mk = 0.f;
      for (int i = F.lane; i < 96; i += 64) { mq = fmaxf(mq, fabsf(gq[i])); mk = fmaxf(mk, fabsf(gk[i])); }
#pragma unroll
      for (int o = 1; o < 64; o <<= 1) { mq = fmaxf(mq, __shfl_xor(mq, o)); mk = fmaxf(mk, __shfl_xor(mk, o)); }
      gm = 9.79795897f * LOG2E * mq * mk; }
    for (int v = F.vcu; v < 256; v += F.G) {
        const int bh = v >> 3, s = v & 7, b = bh >> 3, h = bh & 7;
        for (int i = 0; i < 2; ++i) { const int qb = i ? 15 - s : s;
            att::mla_unit(F.lds, b, h, qb, (const bf16_t*)(ws + WS_QB), (const bf16_t*)(ws + WS_KB), (const bf16_t*)(ws + WS_VB), (bf16_t*)(ws + WS_OMLA), gm);
            __syncthreads(); }
        for (int i = 0; i < 2; ++i) { const int qb = i ? 15 - s : s;
            att::sb_unit(F.lds, b, h, qb, (const bf16_t*)(ws + WS_PROJ), (bf16_t*)(ws + WS_OSB));
            __syncthreads(); }
    }
}

__device__ __forceinline__ void p8_router(Frame& F, const Args& a) {
    unsigned char* ws = F.ws;
    const float* x1 = a.out; const float* wr = (const float*)(ws + WS_WR); const float* br = a.in[15]; const float* g = a.in[13];
    unsigned char* H2 = (unsigned char*)(ws + WS_H2F8); int* list = (int*)(ws + WS_LIST); float* topw = (float*)(ws + WS_TOPW); int* selo = (int*)(ws + WS_SEL);
    int* cnt = (int*)(ws + WS_CTL) + CW_CNT;
    volatile LAS int* lcnt = (volatile LAS int*)(F.MISC + MI_LCNT); volatile LAS int* lbase = (volatile LAS int*)(F.MISC + MI_BASE);
    const int lane = F.lane, wave = F.wave, tid = F.tid;
    constexpr int WST = 1028;
    LAS float* wt = (LAS float*)F.lds;
    if (F.vcu < M_ / 64) {
        for (int i = tid; i < D_ * NE / 4; i += NTHR) { const f32x4 v = *(const f32x4*)(wr + (size_t)i * 4); const int k = i >> 3, e = (i & 7) * 4;
            wt[(e + 0) * WST + k] = v.x; wt[(e + 1) * WST + k] = v.y; wt[(e + 2) * WST + k] = v.z; wt[(e + 3) * WST + k] = v.w; }
    }
    __syncthreads();
    for (int task = F.vcu; task < M_ / 64; task += F.G) {
        const int T0 = task * 64;
        if (tid < 32) lcnt[tid] = 0;
        __syncthreads();
        int my_e = 0, my_rank = 0; float my_w = 0.f;
        if (wave < 4) {
            const int tk = lane & 15, kp = lane >> 4, tok = T0 + wave * 16 + tk;
            const float* xp = x1 + (size_t)tok * D_ + kp * 256;
            const LAS float* w0 = wt + tk * WST + kp * 256; const LAS float* w1 = w0 + 16 * WST;
            f32x4 acc0 = {0.f, 0.f, 0.f, 0.f}, acc1 = {0.f, 0.f, 0.f, 0.f}; float ssq = 0.f;
#pragma unroll 4
            for (int i = 0; i < 256; i += 4) {
                const f32x4 a4 = *(const f32x4*)(xp + i); const f32x4 b0 = *(const LAS f32x4*)(w0 + i), b1 = *(const LAS f32x4*)(w1 + i);
                ssq += (a4.x * a4.x + a4.y * a4.y) + (a4.z * a4.z + a4.w * a4.w);
#pragma unroll
                for (int j = 0; j < 4; ++j) { acc0 = __builtin_amdgcn_mfma_f32_16x16x4f32(a4[j], b0[j], acc0, 0, 0, 0); acc1 = __builtin_amdgcn_mfma_f32_16x16x4f32(a4[j], b1[j], acc1, 0, 0, 0); }
            }
            ssq += __shfl_xor(ssq, 16); ssq += __shfl_xor(ssq, 32);
            const float rstd = rsqrtf(ssq * (1.f / D_) + EPS);
            const int e0 = lane & 15, grp = lane >> 4;
            const float bia0 = br[e0], bia1 = br[e0 + 16];
#pragma unroll
            for (int j = 0; j < 4; ++j) {
                const float rs = __shfl(rstd, 4 * grp + j);
                float c0 = acc0[j] * rs + bia0, c1 = acc1[j] * rs + bia1;
                float sv[4]; int si[4];
#pragma unroll
                for (int k = 0; k < 4; ++k) {
                    float best = c0; int bi = e0;
                    if (c1 > best) { best = c1; bi = e0 + 16; }
#pragma unroll
                    for (int o = 1; o < 16; o <<= 1) { const float ob = __shfl_xor(best, o); const int oi = __shfl_xor(bi, o); if (ob > best || (ob == best && oi < bi)) { best = ob; bi = oi; } }
                    sv[k] = best; si[k] = bi;
                    if (bi == e0) c0 = -INFINITY; if (bi == e0 + 16) c1 = -INFINITY;
                }
                float ex[4], sum = 0.f;
#pragma unroll
                for (int k = 0; k < 4; ++k) { ex[k] = __expf(sv[k] - sv[0]); sum += ex[k]; }
                const float inv = 1.f / sum;
                if (((lane >> 2) & 3) == j) {
#pragma unroll
                    for (int k = 0; k < 4; ++k) if ((lane & 3) == k) { my_e = si[k]; my_w = ex[k] * inv; }
                }
            }
            my_rank = atomicAdd((int*)&lcnt[my_e], 1);
        } else {
            const f32x4* gr = (const f32x4*)g + lane;
            f32x4 gg[4];
#pragma unroll
            for (int j = 0; j < 4; ++j) gg[j] = gr[64 * j] * X8_SCALE;
            for (int rr = 0; rr < 16; rr += 2) {
                const int t0 = T0 + (wave - 4) * 16 + rr;
                const f32x4* xr0 = (const f32x4*)(x1 + (size_t)t0 * D_) + lane; const f32x4* xr1 = xr0 + D_ / 4;
                f32x4 v0[4], v1[4]; float s0 = 0.f, s1 = 0.f;
#pragma unroll
                for (int j = 0; j < 4; ++j) { v0[j] = xr0[64 * j]; v1[j] = xr1[64 * j]; }
#pragma unroll
                for (int j = 0; j < 4; ++j) { s0 += (v0[j].x * v0[j].x + v0[j].y * v0[j].y) + (v0[j].z * v0[j].z + v0[j].w * v0[j].w); s1 += (v1[j].x * v1[j].x + v1[j].y * v1[j].y) + (v1[j].z * v1[j].z + v1[j].w * v1[j].w); }
                const float r0 = rsqrtf(wave_sum(s0) * (1.f / D_) + EPS), r1 = rsqrtf(wave_sum(s1) * (1.f / D_) + EPS);
                unsigned* o0 = (unsigned*)(H2 + (size_t)t0 * D_) + lane; unsigned* o1 = o0 + D_ / 4;
#pragma unroll
                for (int j = 0; j < 4; ++j) { o0[64 * j] = pk_fp8x4(v0[j].x * r0 * gg[j].x, v0[j].y * r0 * gg[j].y, v0[j].z * r0 * gg[j].z, v0[j].w * r0 * gg[j].w);
                    o1[64 * j] = pk_fp8x4(v1[j].x * r1 * gg[j].x, v1[j].y * r1 * gg[j].y, v1[j].z * r1 * gg[j].z, v1[j].w * r1 * gg[j].w); }
            }
        }
        __syncthreads();
        if (tid < 32) lbase[tid] = lcnt[tid] ? atomicAdd(&cnt[tid], lcnt[tid]) : 0;
        __syncthreads();
        if (wave < 4) {
            const int grp = lane >> 4, jj = (lane >> 2) & 3, kk = lane & 3;
            const int tok = T0 + wave * 16 + 4 * grp + jj, slot = tok * 4 + kk;
            list[(size_t)my_e * M_ + lbase[my_e] + my_rank] = slot;
            topw[slot] = my_w; selo[slot] = my_e;
        }
        __syncthreads();
    }
}

struct MoeOrder {
    const bf16_t* A; const bf16_t* Bt; const int* list; volatile LAS unsigned* tab;
    int lda, ldb, nN, nwg, G, c, gather; size_t estride;
    __device__ void init(const bf16_t* A_, int lda_, const bf16_t* Bt_, int ldb_, size_t estride_, int nN_, const int* list_, volatile LAS unsigned* tab_, int gather_, int G_, int c_) {
        A = A_; lda = lda_; Bt = Bt_; ldb = ldb_; estride = estride_; nN = nN_; list = list_; tab = tab_; gather = gather_; G = G_; c = c_; nwg = (int)tab[MI_TPFX + NE] * nN_; }
    __device__ __forceinline__ bool next(int i, pg8::Unit& u) const {
        const long L = (long)i * G + c; if (L >= nwg) return false;
        int wgid = (int)L; { const int q = nwg / 8, r = nwg % 8, xcd = wgid % 8, off = wgid / 8; wgid = (xcd < r ? xcd * (q + 1) : r * (q + 1) + (xcd - r) * q) + off; }
        int e = 0;
        for (int k = 1; k < NE; ++k) if ((int)tab[MI_TPFX + k] * nN <= wgid) e = k;
        const int t0 = (int)tab[MI_TPFX + e], nt = (int)tab[MI_TPFX + e + 1] - t0, idx = wgid - t0 * nN;
        u.e = e; u.pn = idx / nt; u.rt = idx % nt; u.pm = t0 + u.rt; const int left = (int)tab[MI_CNT + e] - u.rt * 256; u.rows = left < 256 ? left : 256; return true;
    }
    __device__ __forceinline__ unsigned a_off(const pg8::Unit& u, int r, int C) const {
        int row;
        if (gather) row = (r < u.rows) ? (list[(size_t)u.e * M_ + u.rt * 256 + r] >> 2) : M_;
        else row = u.pm * 256 + r;
        return (unsigned)((row * lda + C) * 2);
    }
    __device__ __forceinline__ const char* b_base(const pg8::Unit& u) const { return (const char*)(Bt + (size_t)u.e * estride + (size_t)u.pn * 256 * ldb); }
};
__device__ __forceinline__ void moe_table(Frame& F) {
    int* cnt = (int*)(F.ws + WS_CTL) + CW_CNT;
    if (F.tid < NE) F.MISC[MI_CNT + F.tid] = __hip_atomic_load((unsigned*)cnt + F.tid, RLX_AGENT);
    __syncthreads();
    if (F.tid == 0) { unsigned p = 0; for (int e = 0; e < NE; ++e) { F.MISC[MI_TPFX + e] = p; p += (F.MISC[MI_CNT + e] + 255u) >> 8; } F.MISC[MI_TPFX + NE] = p; }
    __syncthreads();
}

__device__ __forceinline__ void p12_combine(Frame& F, const Args& a) {
    const bf16_t* Y = (const bf16_t*)(F.ws + WS_YB); float* out = a.out;
    const int gt = (F.vcu * NWAVES + F.wave) * 64 + F.lane, NGT = F.G * NTHR;
    for (int i = gt; i < M_ * D_ / 8; i += NGT) {
        const int t = i >> 7, c = (i & 127) * 8;
        f32x4 v0 = *(const f32x4*)(out + (size_t)t * D_ + c), v1 = *(const f32x4*)(out + (size_t)t * D_ + c + 4);
#pragma unroll
        for (int k = 0; k < 4; ++k) { const u32x4 w = *(const u32x4*)(Y + (size_t)(t * 4 + k) * D_ + c);
            v0.x += bflo(w.x); v0.y += bfhi(w.x); v0.z += bflo(w.y); v0.w += bfhi(w.y); v1.x += bflo(w.z); v1.y += bfhi(w.z); v1.z += bflo(w.w); v1.w += bfhi(w.w); }
        *(f32x4*)(out + (size_t)t * D_ + c) = v0; *(f32x4*)(out + (size_t)t * D_ + c + 4) = v1;
    }
}

constexpr int N_PHASES = 11;
#ifndef DUP_PHASE
#define DUP_PHASE -1
#endif
__global__ void __launch_bounds__(NTHR, 2) mega(Args args) {
    extern __shared__ __attribute__((aligned(16))) unsigned char lds_raw[];
    Frame F;
    F.lds = (LAS unsigned char*)lds_raw; F.MISC = (volatile LAS unsigned*)(F.lds + LDS_MISC);
    F.tid = threadIdx.x; F.lane = F.tid & 63; F.wave = __builtin_amdgcn_readfirstlane(F.tid >> 6);
    F.G = gridDim.x; { const int bx = blockIdx.x; F.vcu = (F.G % 8 == 0) ? (bx % 8) * (F.G / 8) + bx / 8 : bx; }
    F.ws = args.ws;
    unsigned char* ws = args.ws;
    for (int u = F.tid; u < (LDS_BYTES - LDS_MISC) / 4; u += NTHR) F.MISC[u] = 0u;
    __syncthreads();
    const int lo = args.ph_lo, hi = args.ph_hi;
    XcdBarrier bar; bar.bar = (unsigned*)(ws + WS_CTL) + CW_BAR; bar.x = 0; bar.st = nullptr;
    if (hi - lo > 1) bar = xcd_barrier_post((unsigned*)(ws + WS_CTL) + CW_BAR, F.MISC + MI_BAR);
#define IN(k) (lo <= (k) && (k) < hi)
#define SEAM(k) do { if (IN(k) && IN((k) + 1)) xcd_barrier(bar); } while (0)
    const int cid = (int)blockIdx.x;

    if (IN(0)) { p0_prologue(F, args, 1, 1); SEAM(0); }
    if (IN(1)) {
        pg8::Gemm g{(const bf16_t*)(ws + WS_HB), D_, D_, D_};
        pg8::StaticOrder S; S.init(g.A, D_, (const bf16_t*)(ws + WS_WIN), D_, M_, INWP, F.G, cid);
        pg8::EpiBf16 E{(bf16_t*)(ws + WS_PROJ), INWP};
        pg8::gemm_phase(F.lds, g, S, E);
        SEAM(1);
    }
    if (IN(2)) {
        { pg8::Gemm g{(const bf16_t*)(ws + WS_PROJ) + C_CQ, INWP, 384, 384};
          pg8::StaticOrder S; S.init(g.A, INWP, (const bf16_t*)(ws + WS_WUQ), 384, M_, 768, F.G, cid);
          pg8::EpiBf16 E{(bf16_t*)(ws + WS_QRAW), 768};
          pg8::gemm_phase(F.lds, g, S, E); }
        { pg8::Gemm g{(const bf16_t*)(ws + WS_PROJ) + C_CKV, INWP, 256, 256};
          pg8::StaticOrder S; S.init(g.A, INWP, (const bf16_t*)(ws + WS_WUKV), 256, M_, 1024, F.G, cid);
          pg8::EpiBf16 E{(bf16_t*)(ws + WS_KVRAW), 1024};
          pg8::gemm_phase(F.lds, g, S, E); }
        SEAM(2);
    }
    if (IN(3)) { p4_prep(F, args); SEAM(3); }
    if (IN(4)) { p5_attention(F, args); SEAM(4); }
    if (IN(5)) {
        { pg8::Gemm g{(const bf16_t*)(ws + WS_OSB), 512, 512, 512};
          pg8::StaticOrder S; S.init(g.A, 512, (const bf16_t*)(ws + WS_WOSB), 512, M_, D_, F.G, cid);
          pg8::EpiGate<true> E{(bf16_t*)(ws + WS_MIX), (const bf16_t*)(ws + WS_PROJ), INWP, C_GSB};
          pg8::gemm_phase(F.lds, g, S, E); }
        { pg8::Gemm g{(const bf16_t*)(ws + WS_OMLA), 512, 512, 512};
          pg8::StaticOrder S; S.init(g.A, 512, (const bf16_t*)(ws + WS_WOMLA), 512, M_, D_, F.G, cid);
          pg8::EpiGate<false> E{(bf16_t*)(ws + WS_MIX), (const bf16_t*)(ws + WS_PROJ), INWP, C_GMLA};
          pg8::gemm_phase(F.lds, g, S, E); }
        SEAM(5);
    }
    if (IN(6)) {
        pg8::Gemm g{(const bf16_t*)(ws + WS_MIX), D_, D_, D_};
        pg8::StaticOrder S; S.init(g.A, D_, (const bf16_t*)(ws + WS_WOUT), D_, M_, D_, F.G, cid);
        pg8::EpiRes E{args.in[0], args.out};
        pg8::gemm_phase(F.lds, g, S, E);
        SEAM(6);
    }
    if (IN(7)) { p8_router(F, args); SEAM(7); }
    if (IN(8)) {
        moe_table(F);
        pg8::Gemm g{(const bf16_t*)(ws + WS_H2F8), D_ / 2, D_ / 2, D_ / 2};
        MoeOrder S; S.init(g.A, D_ / 2, (const bf16_t*)(ws + WS_WUP), D_ / 2, (size_t)2 * DFF * D_ / 2, 8, (const int*)(ws + WS_LIST), F.MISC, 1, F.G, cid);
        pg8::EpiSwiglu8 E{(unsigned char*)(ws + WS_ACT), args.in[17]};
        pg8::gemm_phase<pg8::EpiSwiglu8, MoeOrder, true>(F.lds, g, S, E);
        SEAM(8);
    }
    if (IN(9)) {
        moe_table(F);
        pg8::Gemm g{(const bf16_t*)(ws + WS_ACT), DFF / 2, DFF / 2, DFF / 2};
        MoeOrder S; S.init(g.A, DFF / 2, (const bf16_t*)(ws + WS_WDN), DFF / 2, (size_t)D_ * DFF / 2, 4, (const int*)(ws + WS_LIST), F.MISC, 0, F.G, cid);
        pg8::EpiDown E{(bf16_t*)(ws + WS_YB), args.in[19], (const int*)(ws + WS_LIST), (const float*)(ws + WS_TOPW)};
        pg8::gemm_phase<pg8::EpiDown, MoeOrder, true>(F.lds, g, S, E);
        SEAM(9);
    }
    if (IN(10)) { p12_combine(F, args); }
#undef IN
#undef SEAM
}
static int g_grid = 0;
static int setup_grid() {
    if (g_grid == 0) {
        int dev = 0, cus = 0;
        if (hipGetDevice(&dev) != hipSuccess || hipDeviceGetAttribute(&cus, hipDeviceAttributeMultiprocessorCount, dev) != hipSuccess) { g_grid = -1; return g_grid; }
        if (hipFuncSetAttribute((const void*)mega, hipFuncAttributeMaxDynamicSharedMemorySize, LDS_BYTES) != hipSuccess) { g_grid = -1; return g_grid; }
        int per_cu = 0;
        (void)hipOccupancyMaxActiveBlocksPerMultiprocessor(&per_cu, (const void*)mega, NTHR, LDS_BYTES);
        (void)hipGetLastError();
        g_grid = cus;
    }
    return g_grid;
}
static void launch_mega(void* const* d_in, void* d_out, void* d_ws, int lo, int hi, hipStream_t stream) {
    Args a; memset(&a, 0, sizeof(a));
    for (int i = 0; i < 20; ++i) a.in[i] = (const float*)d_in[i];
    a.out = (float*)d_out; a.ws = (unsigned char*)d_ws; a.ph_lo = lo; a.ph_hi = hi;
    hipLaunchKernelGGL(mega, dim3(g_grid), dim3(NTHR), LDS_BYTES, stream, a);
}
extern "C" void kernel_launch(void* const* d_in, const int* in_sizes, int n_in, void* d_out, int out_size, void* d_ws, size_t ws_size, hipStream_t stream) {
    if (n_in != 20 || ws_size < WS_OPT_END || out_size != M_ * D_) { fprintf(stderr, "kernel_launch: unexpected arguments\n"); return; }
    if (setup_grid() <= 0) return;
    (void)hipMemsetAsync((char*)d_ws + WS_CTL, 0, CTL_ZERO_BYTES, stream);
#if N_LAUNCH_SPLIT
    for (int p = 0; p < N_PHASES; ++p) { launch_mega(d_in, d_out, d_ws, p, p + 1, stream); if (p == DUP_PHASE) { if (p == 7) (void)hipMemsetAsync((char*)d_ws + WS_CTL, 0, 128, stream); if (p == 10) launch_mega(d_in, d_out, d_ws, 6, 7, stream); launch_mega(d_in, d_out, d_ws, p, p + 1, stream); } }
#else
    launch_mega(d_in, d_out, d_ws, 0, N_PHASES, stream);
#endif
}
```

```cpp
#define N_LAUNCH_SPLIT 0
#include <hip/hip_runtime.h>
#include <hip/hip_bf16.h>
#include <cstdio>
#include <cstdint>
#include <cstring>
#include <cmath>

constexpr int B_ = 4, S_ = 4096, D_ = 1024, M_ = B_ * S_;
constexpr int INW = 4256, INWP = 4352;
constexpr int C_SBQ = 0, C_SBK = 512, C_SBV = 1024, C_CQ = 1536, C_CKV = 1920, C_KR = 2176, C_GSB = 2208, C_GMLA = 3232;
constexpr int NE = 32, TOPK = 4, DFF = 1024;
constexpr float EPS = 1e-6f;
constexpr float LOG2E = 1.4426950408889634f;
constexpr float SB_QSCALE = 0.125f * LOG2E;
constexpr float MLA_QSCALE = 0.10206207261596577f * LOG2E;
constexpr int NWAVES = 8, NTHR = 512;

#define LAS __attribute__((address_space(3)))
#define GAS __attribute__((address_space(1)))
typedef unsigned short bf16_t;
typedef short bf16x8 __attribute__((ext_vector_type(8)));
typedef short s16x4 __attribute__((ext_vector_type(4)));
typedef float f32x4 __attribute__((ext_vector_type(4)));
typedef float f32x16 __attribute__((ext_vector_type(16)));
typedef unsigned u32x4 __attribute__((ext_vector_type(4)));
typedef unsigned u32x2 __attribute__((ext_vector_type(2)));
typedef float f32x2_t __attribute__((ext_vector_type(2)));
typedef __bf16 bf16x2_t __attribute__((ext_vector_type(2)));
typedef int v8i_t __attribute__((ext_vector_type(8)));
constexpr float W8_SCALE = 8.f, X8_SCALE = 8.f;
__device__ __forceinline__ unsigned pk_fp8x4(float a, float b, float c, float d) { unsigned w = 0; w = __builtin_amdgcn_cvt_pk_fp8_f32(a, b, w, false); w = __builtin_amdgcn_cvt_pk_fp8_f32(c, d, w, true); return w; }

__device__ __forceinline__ unsigned cvtpk(float lo, float hi) { f32x2_t v = {lo, hi}; bf16x2_t b = __builtin_convertvector(v, bf16x2_t); return __builtin_bit_cast(unsigned, b); }
__device__ __forceinline__ float bf2f(unsigned short h) { return __uint_as_float(((unsigned)h) << 16); }
__device__ __forceinline__ float bflo(unsigned w) { return __uint_as_float(w << 16); }
__device__ __forceinline__ float bfhi(unsigned w) { return __uint_as_float(w & 0xffff0000u); }
__device__ __forceinline__ float wave_sum(float v) {
#pragma unroll
    for (int o = 1; o < 64; o <<= 1) v += __shfl_xor(v, o);
    return v;
}
__device__ __forceinline__ float sigmoidf_(float x) { return __builtin_amdgcn_rcpf(1.f + __builtin_amdgcn_exp2f(-x * LOG2E)); }

namespace pg8 {
constexpr int BM = 256, BK = 64, HALF = 128, HTB = HALF * BK * 2, STAGE_BYTES = 8 * HTB, NXCD = 8, WGM = 8;
__host__ __device__ __forceinline__ int lds_byte(int r, int c) { const int st = (r >> 4) * 2 + (c >> 5), rr = r & 15, cc = c & 31, ob = rr * 64 + cc * 2; return st * 1024 + (ob ^ (((ob >> 9) & 1) << 5)); }
__host__ __device__ __forceinline__ void stage_rc(int b, int& R, int& C) { const int st = b / 1024, sb = b % 1024, swz = sb ^ (((sb >> 9) & 1) << 5); R = (st >> 1) * 16 + swz / 64; C = (st & 1) * 32 + (swz % 64) / 2; }
__host__ __device__ __forceinline__ int perm32(int rho) { const int n = rho >> 4, i = rho & 15; return 8 * (i >> 2) + 4 * n + (i & 3); }

struct Unit { int pm, pn, e, rows, rt; };
struct Gemm { const bf16_t* A; int lda, ldb, K; };

struct StaticOrder {
    const bf16_t* A; const bf16_t* Bt; int lda, ldb;
    int nM, nN, nwg, G, c;
    __device__ void init(const bf16_t* A_, int lda_, const bf16_t* Bt_, int ldb_, int M, int N, int G_, int c_) { A = A_; Bt = Bt_; lda = lda_; ldb = ldb_; nM = M / BM; nN = N / BM; nwg = nM * nN; G = G_; c = c_; }
    __device__ __forceinline__ bool next(int i, Unit& u) const {
        const long L = (long)i * G + c; if (L >= nwg) return false;
        int wgid = (int)L; { const int q = nwg / NXCD, r = nwg % NXCD, xcd = wgid % NXCD, off = wgid / NXCD; wgid = (xcd < r ? xcd * (q + 1) : r * (q + 1) + (xcd - r) * q) + off; }
        const int nig = WGM * nN, gid = wgid / nig, fm = gid * WGM, gsz = (nM - fm) < WGM ? (nM - fm) : WGM;
        u.pm = fm + ((wgid % nig) % gsz); u.pn = (wgid % nig) / gsz; u.e = 0; u.rows = 256; u.rt = 0; return true;
    }
    __device__ __forceinline__ unsigned a_off(const Unit& u, int r, int C) const { return (unsigned)(((u.pm * BM + r) * lda + C) * 2); }
    __device__ __forceinline__ const char* b_base(const Unit& u) const { return (const char*)(Bt + (size_t)u.pn * BM * ldb); }
};

__device__ __forceinline__ v8i_t ld32_lds(const LAS unsigned char* p) { const u32x4 lo_ = *(const LAS u32x4*)p, hi_ = *(const LAS u32x4*)(p + 16); return (v8i_t){(int)lo_.x, (int)lo_.y, (int)lo_.z, (int)lo_.w, (int)hi_.x, (int)hi_.y, (int)hi_.z, (int)hi_.w}; }
__device__ __forceinline__ void mfma_f8(f32x4& c, const v8i_t a, const v8i_t b, int sa, int sb) {
    asm volatile("v_mfma_scale_f32_16x16x128_f8f6f4 %0, %1, %2, %0, %3, %4 op_sel_hi:[0,0,0]" : "+v"(c) : "v"(a), "v"(b), "v"(sa), "v"(sb));
}
template <bool F8> struct FragT { typedef bf16x8 type; };
template <> struct FragT<true> { typedef v8i_t type; };
template <class Epi, class Sched, bool FP8 = false>
__device__ __forceinline__ void gemm_phase(LAS unsigned char* lds, const Gemm g, const Sched& S, const Epi& E) {
    const int tid = threadIdx.x, wid = __builtin_amdgcn_readfirstlane(tid >> 6), lane = tid & 63, wr = wid >> 2, wc = wid & 3, fr = lane & 15, fq = lane >> 4;
    const int K = g.K, nt = K / BK;
    unsigned voffB[2];
#pragma unroll
    for (int i = 0; i < 2; ++i) { int R, C; stage_rc(tid * 16 + i * 8192, R, C); const int Rb = Epi::PERM ? ((R & ~31) + perm32(R & 31)) : R; voffB[i] = (unsigned)(Rb * g.ldb + C) * 2u; }
#define PG8_AOFF(dst, unit) do { int t_ = tid; asm volatile("" : "+v"(t_)); _Pragma("unroll") for (int i = 0; i < 2; ++i) { int R, C; stage_rc(t_ * 16 + i * 8192, R, C); \
        _Pragma("unroll") for (int h = 0; h < 2; ++h) dst[h][i] = S.a_off(unit, h * HALF + R, C); } } while (0)
    const size_t kstep = (size_t)(BK * 2);
    const size_t hstepB = (size_t)HALF * g.ldb * 2;
    const unsigned ldsw = (unsigned)wid * 1024u;
    const int aoff = FP8 ? lds_byte(wr * 64 + fr, 16 * (fq & 1)) + (fq >> 1) * 1024 : lds_byte(wr * 64 + fr, fq * 8);
    const int boff = FP8 ? lds_byte(wc * 32 + fr, 16 * (fq & 1)) + (fq >> 1) * 1024 : lds_byte(wc * 32 + fr, fq * 8);
#define PG8_SA(b, h) (((b) * 2 + (h)) * HTB)
#define PG8_SB(b, h) ((4 + (b) * 2 + (h)) * HTB)
#define PG8_STAGE(bufoff, gbase, voff) do { _Pragma("unroll") for (int _i = 0; _i < 2; ++_i) \
        __builtin_amdgcn_global_load_lds((const unsigned*)((const char*)(gbase) + (voff)[_i]), (LAS unsigned*)(lds + (bufoff) + ldsw + _i * 8192), 16, 0, 0); } while (0)
#define PG8_LD32(p) ld32_lds((const LAS unsigned char*)(p))
#define PG8_LDA(dst, b, h) do { if constexpr (FP8) { _Pragma("unroll") for (int m = 0; m < 4; ++m) dst[m][0] = __builtin_bit_cast(FT, PG8_LD32(lds + PG8_SA(b, h) + aoff + m * 2048)); } \
        else { _Pragma("unroll") for (int m = 0; m < 4; ++m) _Pragma("unroll") for (int k = 0; k < 2; ++k) dst[m][k] = __builtin_bit_cast(FT, *(const LAS FT*)(lds + PG8_SA(b, h) + aoff + m * 2048 + k * 1024)); } } while (0)
#define PG8_LDB(dst, b, h) do { if constexpr (FP8) { _Pragma("unroll") for (int n = 0; n < 2; ++n) dst[n][0] = __builtin_bit_cast(FT, PG8_LD32(lds + PG8_SB(b, h) + boff + n * 2048)); } \
        else { _Pragma("unroll") for (int n = 0; n < 2; ++n) _Pragma("unroll") for (int k = 0; k < 2; ++k) dst[n][k] = __builtin_bit_cast(FT, *(const LAS FT*)(lds + PG8_SB(b, h) + boff + n * 2048 + k * 1024)); } } while (0)
#define PG8_MMA(ai, bj, At, Bt) do { __builtin_amdgcn_s_setprio(1); \
        if constexpr (FP8) { _Pragma("unroll") for (int m = 0; m < 4; ++m) _Pragma("unroll") for (int n = 0; n < 2; ++n) \
            mfma_f8(acc[ai][bj][m][n], __builtin_bit_cast(v8i_t, Bt[n][0]), __builtin_bit_cast(v8i_t, At[m][0]), 0x7c7c7c7c, 0x7c7c7c7c); } \
        else { _Pragma("unroll") for (int m = 0; m < 4; ++m) _Pragma("unroll") for (int n = 0; n < 2; ++n) _Pragma("unroll") for (int k = 0; k < 2; ++k) \
            acc[ai][bj][m][n] = __builtin_amdgcn_mfma_f32_16x16x32_bf16(__builtin_bit_cast(bf16x8, Bt[n][k]), __builtin_bit_cast(bf16x8, At[m][k]), acc[ai][bj][m][n], 0, 0, 0); } \
        __builtin_amdgcn_s_setprio(0); } while (0)
#define PG8_WAIT_V(n) asm volatile("s_waitcnt vmcnt(" #n ")" ::: "memory")
#define PG8_WAIT_L(n) asm volatile("s_waitcnt lgkmcnt(" #n ")" ::: "memory")
#define PG8_BAR __builtin_amdgcn_s_barrier()
#define PG8_SCHED __builtin_amdgcn_sched_barrier(0)
    Unit cur, nxt; int ui = 0;
    if (!S.next(0, cur)) return;
    f32x4 acc[2][2][4][2];
#pragma unroll
    for (int a = 0; a < 2; ++a)
#pragma unroll
        for (int b = 0; b < 2; ++b)
#pragma unroll
            for (int m = 0; m < 4; ++m)
#pragma unroll
                for (int n = 0; n < 2; ++n) acc[a][b][m][n] = (f32x4){0.f, 0.f, 0.f, 0.f};
    typedef typename FragT<FP8>::type FT; constexpr int NK = FP8 ? 1 : 2;
    FT At[4][NK], B0[2][NK], B1[2][NK];
    const char* Ab = (const char*)g.A;
    const char* cB = S.b_base(cur);
    unsigned vaC[2][2], vaN[2][2];
    PG8_AOFF(vaC, cur);
    PG8_STAGE(PG8_SB(0, 0), cB, voffB); PG8_STAGE(PG8_SB(0, 1), cB + hstepB, voffB); PG8_STAGE(PG8_SA(0, 0), Ab, vaC[0]); PG8_STAGE(PG8_SA(0, 1), Ab, vaC[1]);
    if (wr == 1) PG8_BAR;
    PG8_WAIT_V(2); PG8_BAR;
    PG8_STAGE(PG8_SB(1, 0), cB + kstep, voffB); PG8_STAGE(PG8_SA(1, 0), Ab + kstep, vaC[0]); PG8_STAGE(PG8_SB(1, 1), cB + hstepB + kstep, voffB);
    PG8_WAIT_V(6); PG8_BAR;
    for (;;) {
        const bool has_next = S.next(ui + 1, nxt);
        const char* nB = has_next ? S.b_base(nxt) : cB;
        if (has_next) PG8_AOFF(vaN, nxt);
        else {
#pragma unroll
            for (int h = 0; h < 2; ++h)
#pragma unroll
                for (int i = 0; i < 2; ++i) vaN[h][i] = vaC[h][i]; }
        for (int t = 0; t < nt; t += 2) {
            const bool last = (t == nt - 2);
            const char* kA1 = Ab + (size_t)(t + 1) * kstep;
            const char* kA2 = last ? Ab : Ab + (size_t)(t + 2) * kstep; const char* b2 = last ? nB : cB + (size_t)(t + 2) * kstep;
            const char* kA3 = kA2 + kstep; const char* b3 = b2 + kstep;
            unsigned o2[2][2];
#pragma unroll
            for (int h = 0; h < 2; ++h)
#pragma unroll
                for (int i = 0; i < 2; ++i) o2[h][i] = last ? vaN[h][i] : vaC[h][i];
            PG8_LDB(B0, 0, 0); PG8_LDB(B1, 0, 1); PG8_SCHED; PG8_LDA(At, 0, 0); PG8_STAGE(PG8_SA(1, 1), kA1, vaC[1]);
            PG8_WAIT_V(8); PG8_WAIT_L(0); PG8_BAR; PG8_MMA(0, 0, At, B0); PG8_MMA(0, 1, At, B1); PG8_BAR; PG8_SCHED;
            PG8_LDA(At, 0, 1); PG8_STAGE(PG8_SB(0, 0), b2, voffB); PG8_STAGE(PG8_SB(0, 1), b2 + hstepB, voffB); PG8_STAGE(PG8_SA(0, 0), kA2, o2[0]);
            PG8_WAIT_V(8); PG8_WAIT_L(0); PG8_BAR; PG8_MMA(1, 0, At, B0); PG8_MMA(1, 1, At, B1); PG8_BAR; PG8_SCHED;
            PG8_LDB(B0, 1, 0); PG8_LDB(B1, 1, 1); PG8_SCHED; PG8_LDA(At, 1, 0); PG8_STAGE(PG8_SA(0, 1), kA2, o2[1]);
            PG8_WAIT_V(8); PG8_WAIT_L(0); PG8_BAR; PG8_MMA(0, 0, At, B0); PG8_MMA(0, 1, At, B1); PG8_BAR; PG8_SCHED;
            PG8_LDA(At, 1, 1); PG8_STAGE(PG8_SB(1, 0), b3, voffB); PG8_STAGE(PG8_SB(1, 1), b3 + hstepB, voffB); PG8_STAGE(PG8_SA(1, 0), kA3, o2[0]);
            PG8_WAIT_V(8); PG8_WAIT_L(0); PG8_BAR; PG8_MMA(1, 0, At, B0); PG8_MMA(1, 1, At, B1); PG8_BAR; PG8_SCHED;
        }
        if (wr == 0) PG8_BAR;
        if constexpr (FP8) asm volatile("s_nop 15\n\ts_nop 15" ::: "memory");
        E(acc, cur, wr, wc, fr, fq);
        if (!has_next) break;
#pragma unroll
        for (int a = 0; a < 2; ++a)
#pragma unroll
            for (int b = 0; b < 2; ++b)
#pragma unroll
                for (int m = 0; m < 4; ++m)
#pragma unroll
                    for (int n = 0; n < 2; ++n) acc[a][b][m][n] = (f32x4){0.f, 0.f, 0.f, 0.f};
        cur = nxt; cB = nB; ++ui;
#pragma unroll
        for (int h = 0; h < 2; ++h)
#pragma unroll
            for (int i = 0; i < 2; ++i) vaC[h][i] = vaN[h][i];
        if (wr == 1) PG8_BAR;
    }
    PG8_WAIT_V(0);
    PG8_BAR;
#undef PG8_SA
#undef PG8_AOFF
#undef PG8_SB
#undef PG8_STAGE
#undef PG8_LDA
#undef PG8_LDB
#undef PG8_MMA
#undef PG8_LD32
#undef PG8_WAIT_V
#undef PG8_WAIT_L
#undef PG8_BAR
#undef PG8_SCHED
}

struct EpiBf16 {
    static constexpr bool PERM = true;
    bf16_t* O; int ldc;
    __device__ __forceinline__ void operator()(const f32x4 (&acc)[2][2][4][2], const Unit& u, int wr, int wc, int fr, int fq) const {
        const int row0 = u.pm * BM + wr * 64 + fr, col0 = u.pn * BM + wc * 32 + 8 * fq;
#pragma unroll
        for (int ai = 0; ai < 2; ++ai)
#pragma unroll
            for (int m = 0; m < 4; ++m) { bf16_t* rowp = O + (size_t)(row0 + ai * HALF + m * 16) * ldc + col0;
#pragma unroll
                for (int bj = 0; bj < 2; ++bj) { const f32x4 v0 = acc[ai][bj][m][0], v1 = acc[ai][bj][m][1];
                    u32x4 w; w.x = cvtpk(v0[0], v0[1]); w.y = cvtpk(v0[2], v0[3]); w.z = cvtpk(v1[0], v1[1]); w.w = cvtpk(v1[2], v1[3]);
                    *(u32x4*)(rowp + bj * HALF) = w; } }
    }
};
template <bool FIRST> struct EpiGate {
    static constexpr bool PERM = true;
    bf16_t* O; const bf16_t* G; int ldg, gcol;
    __device__ __forceinline__ void operator()(const f32x4 (&acc)[2][2][4][2], const Unit& u, int wr, int wc, int fr, int fq) const {
        const int row0 = u.pm * BM + wr * 64 + fr, col0 = u.pn * BM + wc * 32 + 8 * fq;
#pragma unroll
        for (int ai = 0; ai < 2; ++ai)
#pragma unroll
            for (int m = 0; m < 4; ++m) { const size_t r = (size_t)(row0 + ai * HALF + m * 16);
#pragma unroll
                for (int bj = 0; bj < 2; ++bj) { const f32x4 v0 = acc[ai][bj][m][0], v1 = acc[ai][bj][m][1];
                    const int c = col0 + bj * HALF;
                    const u32x4 gw = *(const u32x4*)(G + r * ldg + gcol + c);
                    float o[8];
                    o[0] = sigmoidf_(bflo(gw.x)) * v0[0]; o[1] = sigmoidf_(bfhi(gw.x)) * v0[1]; o[2] = sigmoidf_(bflo(gw.y)) * v0[2]; o[3] = sigmoidf_(bfhi(gw.y)) * v0[3];
                    o[4] = sigmoidf_(bflo(gw.z)) * v1[0]; o[5] = sigmoidf_(bfhi(gw.z)) * v1[1]; o[6] = sigmoidf_(bflo(gw.w)) * v1[2]; o[7] = sigmoidf_(bfhi(gw.w)) * v1[3];
                    bf16_t* op = O + r * D_ + c;
                    if (!FIRST) { const u32x4 pw = *(const u32x4*)op;
                        o[0] += bflo(pw.x); o[1] += bfhi(pw.x); o[2] += bflo(pw.y); o[3] += bfhi(pw.y); o[4] += bflo(pw.z); o[5] += bfhi(pw.z); o[6] += bflo(pw.w); o[7] += bfhi(pw.w); }
                    u32x4 w; w.x = cvtpk(o[0], o[1]); w.y = cvtpk(o[2], o[3]); w.z = cvtpk(o[4], o[5]); w.w = cvtpk(o[6], o[7]);
                    *(u32x4*)op = w; } }
    }
};
struct EpiRes {
    static constexpr bool PERM = false;
    const float* base; float* out;
    __device__ __forceinline__ void operator()(const f32x4 (&acc)[2][2][4][2], const Unit& u, int wr, int wc, int fr, int fq) const {
        const int row0 = u.pm * BM + wr * 64 + fr, col0 = u.pn * BM + wc * 32 + 4 * fq;
#pragma unroll
        for (int ai = 0; ai < 2; ++ai)
#pragma unroll
            for (int m = 0; m < 4; ++m) { const size_t off = (size_t)(row0 + ai * HALF + m * 16) * D_ + col0;
#pragma unroll
                for (int bj = 0; bj < 2; ++bj)
#pragma unroll
                    for (int n = 0; n < 2; ++n) { const f32x4 b = *(const f32x4*)(base + off + bj * HALF + n * 16); *(f32x4*)(out + off + bj * HALF + n * 16) = b + acc[ai][bj][m][n]; } }
    }
};
struct EpiSwiglu {
    static constexpr bool PERM = true;
    bf16_t* act; const float* b_up;
    __device__ __forceinline__ void operator()(const f32x4 (&acc)[2][2][4][2], const Unit& u, int wr, int wc, int fr, int fq) const {
        const int row0 = u.pm * BM + wr * 64 + fr, col0 = u.pn * BM + wc * 32 + 8 * fq;
        const float* bb = b_up + (size_t)u.e * (2 * DFF);
        f32x4 bv[2][2];
#pragma unroll
        for (int bj = 0; bj < 2; ++bj)
#pragma unroll
            for (int n = 0; n < 2; ++n) bv[bj][n] = *(const f32x4*)(bb + col0 + bj * HALF + 4 * n);
#pragma unroll
        for (int ai = 0; ai < 2; ++ai)
#pragma unroll
            for (int m = 0; m < 4; ++m) { bf16_t* rowp = act + (size_t)(row0 + ai * HALF + m * 16) * DFF + (col0 >> 1);
#pragma unroll
                for (int bj = 0; bj < 2; ++bj) { const f32x4 v0 = acc[ai][bj][m][0] + bv[bj][0], v1 = acc[ai][bj][m][1] + bv[bj][1];
                    float a[4];
#pragma unroll
                    for (int p = 0; p < 4; ++p) { float gl = (p < 2) ? v0[2 * p] : v1[2 * p - 4], li = (p < 2) ? v0[2 * p + 1] : v1[2 * p - 3];
                        gl = fminf(gl, 7.f); li = fminf(fmaxf(li, -7.f), 7.f);
                        a[p] = gl * sigmoidf_(1.702f * gl) * (li + 1.f); }
                    u32x2 w; w.x = cvtpk(a[0], a[1]); w.y = cvtpk(a[2], a[3]);
                    *(u32x2*)(rowp + bj * (HALF / 2)) = w; } }
    }
};
struct EpiSwiglu8 {
    static constexpr bool PERM = true;
    unsigned char* act; const float* b_up;
    __device__ __forceinline__ void operator()(const f32x4 (&acc)[2][2][4][2], const Unit& u, int wr, int wc, int fr, int fq) const {
        const int row0 = u.pm * BM + wr * 64 + fr, col0 = u.pn * BM + wc * 32 + 8 * fq;
        const float* bb = b_up + (size_t)u.e * (2 * DFF);
        f32x4 bv[2][2];
#pragma unroll
        for (int bj = 0; bj < 2; ++bj)
#pragma unroll
            for (int n = 0; n < 2; ++n) bv[bj][n] = *(const f32x4*)(bb + col0 + bj * HALF + 4 * n);
#pragma unroll
        for (int ai = 0; ai < 2; ++ai)
#pragma unroll
            for (int m = 0; m < 4; ++m) { unsigned char* rowp = act + (size_t)(row0 + ai * HALF + m * 16) * DFF + (col0 >> 1);
#pragma unroll
                for (int bj = 0; bj < 2; ++bj) { const f32x4 v0 = acc[ai][bj][m][0] + bv[bj][0], v1 = acc[ai][bj][m][1] + bv[bj][1];
                    float a[4];
#pragma unroll
                    for (int p = 0; p < 4; ++p) { float gl = (p < 2) ? v0[2 * p] : v1[2 * p - 4], li = (p < 2) ? v0[2 * p + 1] : v1[2 * p - 3];
                        gl = fminf(gl, 7.f); li = fminf(fmaxf(li, -7.f), 7.f);
                        a[p] = gl * sigmoidf_(1.702f * gl) * (li + 1.f) * X8_SCALE; }
                    *(unsigned*)(rowp + bj * (HALF / 2)) = pk_fp8x4(a[0], a[1], a[2], a[3]); } }
    }
};
struct EpiDown {
    static constexpr bool PERM = true;
    bf16_t* y; const float* b_down; const int* list; const float* topw;
    __device__ __forceinline__ void operator()(const f32x4 (&acc)[2][2][4][2], const Unit& u, int wr, int wc, int fr, int fq) const {
        const int col0 = u.pn * BM + wc * 32 + 8 * fq;
        const float* bb = b_down + (size_t)u.e * D_;
        f32x4 bv[2][2];
#pragma unroll
        for (int bj = 0; bj < 2; ++bj)
#pragma unroll
            for (int n = 0; n < 2; ++n) bv[bj][n] = *(const f32x4*)(bb + col0 + bj * HALF + 4 * n);
        const int* lp = list + (size_t)u.e * M_ + u.rt * BM;
#pragma unroll
        for (int ai = 0; ai < 2; ++ai)
#pragma unroll
            for (int m = 0; m < 4; ++m) { const int r = ai * HALF + wr * 64 + m * 16 + fr;
                if (r < u.rows) { const int slot = lp[r]; const float w = topw[slot]; bf16_t* rowp = y + (size_t)slot * D_ + col0;
#pragma unroll
                    for (int bj = 0; bj < 2; ++bj) { const f32x4 v0 = (acc[ai][bj][m][0] + bv[bj][0]) * w, v1 = (acc[ai][bj][m][1] + bv[bj][1]) * w;
                        u32x4 o; o.x = cvtpk(v0[0], v0[1]); o.y = cvtpk(v0[2], v0[3]); o.z = cvtpk(v1[0], v1[1]); o.w = cvtpk(v1[2], v1[3]);
                        *(u32x4*)(rowp + bj * HALF) = o; } } }
    }
};
}
constexpr size_t MiB = 1ull << 20;
constexpr size_t WS_CTL = 0, CTL_ZERO_BYTES = 64 * 1024;
constexpr size_t WS_ROPE = 256 * 1024;
constexpr size_t WS_WR = 3 * MiB;
constexpr size_t WS_LIST = 4 * MiB;
constexpr size_t WS_TOPW = 6 * MiB;
constexpr size_t WS_SEL = 6 * MiB + 512 * 1024;
constexpr size_t WS_WIN = 8 * MiB;
constexpr size_t WS_WUQ = 17 * MiB;
constexpr size_t WS_WUKV = 18 * MiB;
constexpr size_t WS_WOSB = 19 * MiB;
constexpr size_t WS_WOMLA = 20 * MiB;
constexpr size_t WS_WOUT = 21 * MiB;
constexpr size_t WS_WUP = 24 * MiB;
constexpr size_t WS_WDN = 152 * MiB;
constexpr size_t WS_HB = 216 * MiB;
constexpr size_t WS_PROJ = 249 * MiB;
constexpr size_t WS_ACT = WS_PROJ;
constexpr size_t WS_QRAW = 393 * MiB;
constexpr size_t WS_KVRAW = WS_QRAW + 24 * MiB;
constexpr size_t WS_QB = WS_KVRAW + 32 * MiB;
constexpr size_t WS_KB = WS_QB + 24 * MiB;
constexpr size_t WS_VB = WS_KB + 24 * MiB;
constexpr size_t WS_OSB = WS_VB + 16 * MiB;
constexpr size_t WS_OMLA = WS_OSB + 16 * MiB;
constexpr size_t WS_YB = WS_QRAW;
constexpr size_t WS_MIX = 545 * MiB;
constexpr size_t WS_H2F8 = 577 * MiB;
constexpr size_t WS_OPT_END = 594 * MiB;
constexpr int CW_CNT = 0;
constexpr int CW_BAR = 1024;
constexpr int LDS_STAGE = 143360;
constexpr int LDS_MISC = LDS_STAGE;
constexpr int LDS_BYTES = 147456;
constexpr int MI_BAR = 0, MI_TPFX = 16, MI_CNT = 64, MI_FLAG = 128, MI_LCNT = 160, MI_BASE = 192, MI_RSTD = 256;

typedef GAS unsigned gu32;
#define RLX_AGENT __ATOMIC_RELAXED, __HIP_MEMORY_SCOPE_AGENT

#define XB_TMO      128
#define XB_XCNT(j)  (256  + 64 * (j))
#define XB_XSUB(j)  (1280 + 64 * (j))
#define XB_XGEN(j)  (2304 + 64 * (j))
#define XB_TOP      3328
#define XB_TOPGEN   3392
#define XCD_BAR_WORDS 3456
#define XB_SPIN_CAP (1u << 18)
__device__ __forceinline__ unsigned xb_ld(unsigned* p)              { return __hip_atomic_load(p, __ATOMIC_RELAXED, __HIP_MEMORY_SCOPE_AGENT); }
__device__ __forceinline__ unsigned xb_add(unsigned* p, unsigned v) { return __hip_atomic_fetch_add(p, v, __ATOMIC_RELAXED, __HIP_MEMORY_SCOPE_AGENT); }
__device__ __forceinline__ unsigned xb_xcc_id() { return (unsigned)__builtin_amdgcn_s_getreg((3 << 11) | 20) & 0xFu; }
#define XB_SPIN(cond, bar) do { unsigned _sp = 0; while (cond) { __builtin_amdgcn_s_sleep(1); \
    if ((++_sp & 255u) == 0u) { if (xb_ld(&(bar)[XB_TMO])) break; if (_sp > XB_SPIN_CAP) { atomicAdd(&(bar)[XB_TMO], 1u); break; } } } } while (0)
struct XcdBarrier { unsigned* bar; unsigned x; volatile LAS unsigned* st; };
__device__ __forceinline__ XcdBarrier xcd_barrier_post(unsigned* bar, volatile LAS unsigned* st) {
    XcdBarrier b; b.bar = bar; b.x = xb_xcc_id(); b.st = st;
    if (threadIdx.x == 0) (void)xb_add(&bar[XB_XCNT(b.x)], 1u);
    return b;
}
__device__ __forceinline__ void xcd_barrier_complete(unsigned* bar, unsigned x, unsigned& nloc, unsigned& nx) {
    const unsigned G = gridDim.x * gridDim.y * gridDim.z;
    unsigned sum, cnt, mine, sp = 0u;
    for (;;) {
        sum = 0u; cnt = 0u; mine = 0u;
#pragma unroll
        for (unsigned j = 0; j < 16; ++j) { const unsigned c = xb_ld(&bar[XB_XCNT(j)]); sum += c; cnt += (c > 0u) ? 1u : 0u; mine = (j == x) ? c : mine; }
        if (sum == G) break;
        __builtin_amdgcn_s_sleep(1);
        if ((++sp & 255u) == 0u) { if (xb_ld(&bar[XB_TMO])) break; if (sp > XB_SPIN_CAP) { atomicAdd(&bar[XB_TMO], 1u); break; } }
    }
    nloc = mine > 0u ? mine : 1u; nx = cnt > 0u ? cnt : 1u;
}
__device__ __forceinline__ void xcd_barrier(const XcdBarrier& b) {
    asm volatile("s_waitcnt vmcnt(0)" ::: "memory");
    __syncthreads();
    if (threadIdx.x == 0) {
        unsigned* bar = b.bar;
        __builtin_amdgcn_s_waitcnt(0);
        unsigned nloc = b.st[0], nx = b.st[1];
        if (nloc == 0u) { xcd_barrier_complete(bar, b.x, nloc, nx); b.st[0] = nloc; b.st[1] = nx; }
        const unsigned old = xb_add(&bar[XB_XSUB(b.x)], 1u);
        const unsigned gen = old / nloc;
        if (old + 1u == (gen + 1u) * nloc) {
            __builtin_amdgcn_fence(__ATOMIC_RELEASE, "agent");
            asm volatile("s_waitcnt vmcnt(0)" ::: "memory");
            const unsigned og = xb_add(&bar[XB_TOP], 1u);
            const unsigned tg = og / nx;
            if (og + 1u == (tg + 1u) * nx) xb_add(&bar[XB_TOPGEN], 1u);
            else XB_SPIN(xb_ld(&bar[XB_TOPGEN]) == tg, bar);
            __builtin_amdgcn_fence(__ATOMIC_ACQUIRE, "agent");
            xb_add(&bar[XB_XGEN(b.x)], 1u);
            asm volatile("s_waitcnt vmcnt(0)" ::: "memory");
        } else {
            XB_SPIN(xb_ld(&bar[XB_XGEN(b.x)]) == gen, bar);
            __builtin_amdgcn_fence(__ATOMIC_ACQUIRE, "agent");
            asm volatile("s_waitcnt vmcnt(0)" ::: "memory");
        }
    }
    __syncthreads();
}

struct Args {
    const float* in[20]; float* out; unsigned char* ws;
    int ph_lo, ph_hi;
};

struct Frame {
    LAS unsigned char* lds; volatile LAS unsigned* MISC;
    int tid, lane, wave, vcu, G;
    unsigned char* ws;
};

__device__ __forceinline__ void p0_transpose_item(const float* W, int K, int N, bf16_t* WT, LAS float* scr, int item, int lane, const float* gk, float cs, int csn) {
    const int nblk = N / 32, kb = item / nblk, nb = item % nblk, k0 = 64 * kb, n0 = 32 * nb;
    const float colsc = (n0 < csn) ? cs : 1.f;
    float tv[32];
#pragma unroll
    for (int i = 0; i < 32; ++i) { const int kk = 2 * i + (lane >> 5); tv[i] = W[(size_t)(k0 + kk) * N + n0 + (lane & 31)]; }
#pragma unroll
    for (int i = 0; i < 32; ++i) { const int kk = 2 * i + (lane >> 5); float v = tv[i] * colsc; if (gk) v *= gk[k0 + kk]; scr[kk * 33 + (lane & 31)] = v; }
    asm volatile("s_waitcnt lgkmcnt(0)" ::: "memory");
    const int c = lane & 7;
#pragma unroll
    for (int j = 0; j < 4; ++j) { const int n = (lane >> 3) + 8 * j; const LAS float* s = scr + (8 * c) * 33 + n;
        u32x4 o; o.x = cvtpk(s[0 * 33], s[1 * 33]); o.y = cvtpk(s[2 * 33], s[3 * 33]); o.z = cvtpk(s[4 * 33], s[5 * 33]); o.w = cvtpk(s[6 * 33], s[7 * 33]);
        *(u32x4*)(WT + (size_t)(n0 + n) * K + k0 + 8 * c) = o; }
    asm volatile("s_waitcnt lgkmcnt(0)" ::: "memory");
}
__device__ __forceinline__ void p0_transpose_item_fp8(const float* W, int K, int N, unsigned char* WT, LAS float* scr, int item, int lane, float cs) {
    const int nblk = N / 32, kb = item / nblk, nb = item % nblk, k0 = 64 * kb, n0 = 32 * nb;
    float tv[32];
#pragma unroll
    for (int i = 0; i < 32; ++i) { const int kk = 2 * i + (lane >> 5); tv[i] = W[(size_t)(k0 + kk) * N + n0 + (lane & 31)]; }
#pragma unroll
    for (int i = 0; i < 32; ++i) { const int kk = 2 * i + (lane >> 5); scr[kk * 33 + (lane & 31)] = tv[i] * cs; }
    asm volatile("s_waitcnt lgkmcnt(0)" ::: "memory");
    const int c = lane & 7;
#pragma unroll
    for (int j = 0; j < 4; ++j) { const int n = (lane >> 3) + 8 * j; const LAS float* s = scr + (8 * c) * 33 + n;
        u32x2 o; o.x = pk_fp8x4(s[0 * 33], s[1 * 33], s[2 * 33], s[3 * 33]); o.y = pk_fp8x4(s[4 * 33], s[5 * 33], s[6 * 33], s[7 * 33]);
        *(u32x2*)(WT + (size_t)(n0 + n) * K + k0 + 8 * c) = o; }
    asm volatile("s_waitcnt lgkmcnt(0)" ::: "memory");
}
__device__ __forceinline__ void rms_row_to_bf16(const float* xrow, const float* g, bf16_t* orow, int lane) {
    const f32x4* xr = (const f32x4*)xrow + lane; const f32x4* gr = (const f32x4*)g + lane;
    f32x4 v[4]; float s = 0.f;
#pragma unroll
    for (int j = 0; j < 4; ++j) { v[j] = xr[64 * j]; s += (v[j].x * v[j].x + v[j].y * v[j].y) + (v[j].z * v[j].z + v[j].w * v[j].w); }
    const float rstd = rsqrtf(wave_sum(s) * (1.f / D_) + EPS);
    u32x2* o8 = (u32x2*)orow + lane;
#pragma unroll
    for (int j = 0; j < 4; ++j) { const f32x4 gg = gr[64 * j]; u32x2 w; w.x = cvtpk(v[j].x * rstd * gg.x, v[j].y * rstd * gg.y); w.y = cvtpk(v[j].z * rstd * gg.z, v[j].w * rstd * gg.w); o8[64 * j] = w; }
}
__device__ __forceinline__ void p0_prologue(Frame& F, const Args& a, int do_moe_w, int do_rest) {
    LAS float* scr = (LAS float*)(F.lds + F.wave * 16384);
    const int gw = F.vcu * NWAVES + F.wave, NGW = F.G * NWAVES;
    unsigned char* ws = F.ws;
    const float* w_in = a.in[3]; const float* g_cq = a.in[4]; const float* w_uq = a.in[5]; const float* g_ckv = a.in[6]; const float* w_ukv = a.in[7];
    const float* w_o_sb = a.in[10]; const float* w_o_mla = a.in[11]; const float* w_out = a.in[12]; const float* g_ffn = a.in[13]; const float* w_router = a.in[14];
    const float* w_up = a.in[16]; const float* w_down = a.in[18];
    constexpr int I_IN = (D_ / 64) * (INW / 32), I_UQ = (384 / 64) * (768 / 32), I_UKV = (256 / 64) * (1024 / 32), I_O = (512 / 64) * (1024 / 32), I_OUT = (1024 / 64) * (1024 / 32);
    constexpr int I_UP1 = (1024 / 64) * (2048 / 32), I_DN1 = (1024 / 64) * (1024 / 32);
    if (do_rest) {
        constexpr int NI = I_IN + I_UQ + I_UKV + 2 * I_O + I_OUT;
        for (int it = gw; it < NI; it += NGW) {
            int r = it;
            if (r < I_IN) { p0_transpose_item(w_in, D_, INW, (bf16_t*)(ws + WS_WIN), scr, r, F.lane, nullptr, SB_QSCALE, 512); continue; } r -= I_IN;
            if (r < I_UQ) { p0_transpose_item(w_uq, 384, 768, (bf16_t*)(ws + WS_WUQ), scr, r, F.lane, g_cq, 1.f, 0); continue; } r -= I_UQ;
            if (r < I_UKV) { p0_transpose_item(w_ukv, 256, 1024, (bf16_t*)(ws + WS_WUKV), scr, r, F.lane, g_ckv, 1.f, 0); continue; } r -= I_UKV;
            if (r < I_O) { p0_transpose_item(w_o_sb, 512, 1024, (bf16_t*)(ws + WS_WOSB), scr, r, F.lane, nullptr, 1.f, 0); continue; } r -= I_O;
            if (r < I_O) { p0_transpose_item(w_o_mla, 512, 1024, (bf16_t*)(ws + WS_WOMLA), scr, r, F.lane, nullptr, 1.f, 0); continue; } r -= I_O;
            p0_transpose_item(w_out, 1024, 1024, (bf16_t*)(ws + WS_WOUT), scr, r, F.lane, nullptr, 1.f, 0);
        }
        { const int gt = gw * 64 + F.lane, NGT = NGW * 64;
          u32x4 z = {0u, 0u, 0u, 0u};
          u32x4* pz = (u32x4*)((bf16_t*)(ws + WS_WIN) + (size_t)INW * D_);
          for (int i = gt; i < (INWP - INW) * D_ * 2 / 16; i += NGT) pz[i] = z;
          u32x4* hz = (u32x4*)((unsigned char*)(ws + WS_H2F8) + (size_t)M_ * D_);
          for (int i = gt; i < D_ / 16; i += NGT) hz[i] = z;
          const int* pos = (const int*)a.in[1]; float* rt = (float*)(ws + WS_ROPE);
          for (int i = gt; i < M_ * 16; i += NGT) { const int row = i >> 4, k = i & 15; const float inv = powf(10000.f, -(float)k / 16.f); const float ang = (float)pos[row] * inv; rt[row * 32 + k] = cosf(ang); rt[row * 32 + 16 + k] = sinf(ang); }
          float* wr = (float*)(ws + WS_WR);
          for (int i = gt; i < D_ * NE; i += NGT) wr[i] = w_router[i] * g_ffn[i >> 5];
        }
        for (int m = gw; m < M_; m += NGW) rms_row_to_bf16(a.in[0] + (size_t)m * D_, a.in[2], (bf16_t*)(ws + WS_HB) + (size_t)m * D_, F.lane);
    }
    if (do_moe_w) {
        constexpr int NI = NE * (I_UP1 + I_DN1);
        for (int it = gw; it < NI; it += NGW) {
            int r = it;
            if (r < NE * I_UP1) { const int e = r / I_UP1; p0_transpose_item_fp8(w_up + (size_t)e * D_ * 2 * DFF, D_, 2 * DFF, (unsigned char*)(ws + WS_WUP) + (size_t)e * 2 * DFF * D_, scr, r % I_UP1, F.lane, W8_SCALE); continue; }
            r -= NE * I_UP1;
            { const int e = r / I_DN1; p0_transpose_item_fp8(w_down + (size_t)e * DFF * D_, DFF, D_, (unsigned char*)(ws + WS_WDN) + (size_t)e * D_ * DFF, scr, r % I_DN1, F.lane, W8_SCALE); }
        }
    }
}

__device__ __forceinline__ void ld16bf(const bf16_t* p, float (&v)[16]) {
    const u32x4 a = *(const u32x4*)p, b = *(const u32x4*)(p + 8);
    v[0] = bflo(a.x); v[1] = bfhi(a.x); v[2] = bflo(a.y); v[3] = bfhi(a.y); v[4] = bflo(a.z); v[5] = bfhi(a.z); v[6] = bflo(a.w); v[7] = bfhi(a.w);
    v[8] = bflo(b.x); v[9] = bfhi(b.x); v[10] = bflo(b.y); v[11] = bfhi(b.y); v[12] = bflo(b.z); v[13] = bfhi(b.z); v[14] = bflo(b.w); v[15] = bfhi(b.w);
}
__device__ __forceinline__ void st16bf(bf16_t* p, const float (&v)[16]) {
    u32x4 a, b; a.x = cvtpk(v[0], v[1]); a.y = cvtpk(v[2], v[3]); a.z = cvtpk(v[4], v[5]); a.w = cvtpk(v[6], v[7]);
    b.x = cvtpk(v[8], v[9]); b.y = cvtpk(v[10], v[11]); b.z = cvtpk(v[12], v[13]); b.w = cvtpk(v[14], v[15]);
    *(u32x4*)p = a; *(u32x4*)(p + 8) = b;
}
struct PrepIn { unsigned cq0, cq1, cq2; u32x2 ckv; u32x4 qa, qb, ka, kb, vv; float rope; };
__device__ __forceinline__ void p4_load(PrepIn& in, int row, const bf16_t* proj, const bf16_t* qraw, const bf16_t* kvraw, const float* rope, int lane) {
    const int h = lane >> 3, s = lane & 7;
    const bf16_t* pr = proj + (size_t)row * INWP;
    { const bf16_t* p = pr + C_CQ + lane * 6; in.cq0 = *(const unsigned*)p; in.cq1 = *(const unsigned*)(p + 2); in.cq2 = *(const unsigned*)(p + 4); }
    in.ckv = *(const u32x2*)(pr + C_CKV + lane * 4);
    in.rope = rope[(size_t)row * 32 + (lane & 31)];
    const u32x4 z = {0u, 0u, 0u, 0u};
    in.qa = z; in.qb = z; in.ka = z; in.kb = z;
    if (s < 6) { const bf16_t* q = qraw + (size_t)row * 768 + h * 96 + s * 16; in.qa = *(const u32x4*)q; in.qb = *(const u32x4*)(q + 8);
        const bf16_t* k = (s < 4) ? (kvraw + (size_t)row * 1024 + h * 128 + s * 16) : (pr + C_KR + (s - 4) * 16); in.ka = *(const u32x4*)k; in.kb = *(const u32x4*)(k + 8); }
    in.vv = *(const u32x4*)(kvraw + (size_t)row * 1024 + (lane >> 3) * 128 + 64 + (lane & 7) * 8);
}
__device__ __forceinline__ void unpack16(const u32x4 a, const u32x4 b, float (&v)[16]) {
    v[0] = bflo(a.x); v[1] = bfhi(a.x); v[2] = bflo(a.y); v[3] = bfhi(a.y); v[4] = bflo(a.z); v[5] = bfhi(a.z); v[6] = bflo(a.w); v[7] = bfhi(a.w);
    v[8] = bflo(b.x); v[9] = bfhi(b.x); v[10] = bflo(b.y); v[11] = bfhi(b.y); v[12] = bflo(b.z); v[13] = bfhi(b.z); v[14] = bflo(b.w); v[15] = bfhi(b.w);
}
__device__ __forceinline__ void p4_prep(Frame& F, const Args& a) {
    unsigned char* ws = F.ws;
    const bf16_t* proj = (const bf16_t*)(ws + WS_PROJ); const bf16_t* qraw = (const bf16_t*)(ws + WS_QRAW); const bf16_t* kvraw = (const bf16_t*)(ws + WS_KVRAW);
    bf16_t* QB = (bf16_t*)(ws + WS_QB); bf16_t* KB = (bf16_t*)(ws + WS_KB); bf16_t* VB = (bf16_t*)(ws + WS_VB);
    const float* rope = (const float*)(ws + WS_ROPE); const float* gq = a.in[8]; const float* gk = a.in[9];
    const int gw = F.vcu * NWAVES + F.wave, NGW = F.G * NWAVES, lane = F.lane, h = lane >> 3, s = lane & 7;
    float gqv[16], gkv[16];
#pragma unroll
    for (int j = 0; j < 16; ++j) { gqv[j] = (s < 6) ? gq[s * 16 + j] : 0.f; gkv[j] = (s < 6) ? gk[s * 16 + j] : 0.f; }
    PrepIn cur, nxt;
    if (gw < M_) p4_load(cur, gw, proj, qraw, kvraw, rope, lane);
    for (int row = gw; row < M_; row += NGW) {
        const bool hn = row + NGW < M_;
        if (hn) p4_load(nxt, row + NGW, proj, qraw, kvraw, rope, lane);
        float sq = bflo(cur.cq0) * bflo(cur.cq0) + bfhi(cur.cq0) * bfhi(cur.cq0) + bflo(cur.cq1) * bflo(cur.cq1) + bfhi(cur.cq1) * bfhi(cur.cq1) + bflo(cur.cq2) * bflo(cur.cq2) + bfhi(cur.cq2) * bfhi(cur.cq2);
        float skv = bflo(cur.ckv.x) * bflo(cur.ckv.x) + bfhi(cur.ckv.x) * bfhi(cur.ckv.x) + bflo(cur.ckv.y) * bflo(cur.ckv.y) + bfhi(cur.ckv.y) * bfhi(cur.ckv.y);
        sq = wave_sum(sq); skv = wave_sum(skv);
        const float var_cq = sq * (1.f / 384.f) + EPS;
        const float rstd_ckv = rsqrtf(skv * (1.f / 256.f) + EPS);
        float cs[16], sn[16];
#pragma unroll
        for (int j = 0; j < 16; ++j) { cs[j] = __int_as_float(__builtin_amdgcn_readlane(__float_as_int(cur.rope), j)); sn[j] = __int_as_float(__builtin_amdgcn_readlane(__float_as_int(cur.rope), 16 + j)); }
        {
            float v[16]; unpack16(cur.qa, cur.qb, v);
            float ss = 0.f;
#pragma unroll
            for (int j = 0; j < 16; ++j) ss += v[j] * v[j];
            ss += __shfl_xor(ss, 1); ss += __shfl_xor(ss, 2); ss += __shfl_xor(ss, 4);
            const float r = rsqrtf(ss * (1.f / 96.f) + EPS * var_cq);
#pragma unroll
            for (int j = 0; j < 16; ++j) v[j] = v[j] * r * gqv[j];
            float o[16];
#pragma unroll
            for (int j = 0; j < 16; ++j) { const float pv = __shfl_xor(v[j], 1);
                o[j] = (s == 4) ? (v[j] * cs[j] - pv * sn[j]) : (s == 5) ? (v[j] * cs[j] + pv * sn[j]) : v[j]; o[j] *= MLA_QSCALE; }
            if (s < 6) st16bf(QB + (size_t)row * 768 + h * 96 + s * 16, o);
        }
        {
            float v[16]; unpack16(cur.ka, cur.kb, v);
            if (s < 4) {
#pragma unroll
                for (int j = 0; j < 16; ++j) v[j] *= rstd_ckv; }
            float ss = 0.f;
#pragma unroll
            for (int j = 0; j < 16; ++j) ss += v[j] * v[j];
            ss += __shfl_xor(ss, 1); ss += __shfl_xor(ss, 2); ss += __shfl_xor(ss, 4);
            const float r = rsqrtf(ss * (1.f / 96.f) + EPS);
#pragma unroll
            for (int j = 0; j < 16; ++j) v[j] = v[j] * r * gkv[j];
            float o[16];
#pragma unroll
            for (int j = 0; j < 16; ++j) { const float pv = __shfl_xor(v[j], 1);
                o[j] = (s == 4) ? (v[j] * cs[j] - pv * sn[j]) : (s == 5) ? (v[j] * cs[j] + pv * sn[j]) : v[j]; }
            if (s < 6) st16bf(KB + (size_t)row * 768 + h * 96 + s * 16, o);
            const u32x4 vw = cur.vv;
            u32x4 ow; ow.x = cvtpk(bflo(vw.x) * rstd_ckv, bfhi(vw.x) * rstd_ckv); ow.y = cvtpk(bflo(vw.y) * rstd_ckv, bfhi(vw.y) * rstd_ckv);
            ow.z = cvtpk(bflo(vw.z) * rstd_ckv, bfhi(vw.z) * rstd_ckv); ow.w = cvtpk(bflo(vw.w) * rstd_ckv, bfhi(vw.w) * rstd_ckv);
            *(u32x4*)(VB + (size_t)row * 512 + lane * 8) = ow;
        }
        if (hn) cur = nxt;
    }
}
namespace att {
constexpr int BUFB = 20480;
constexpr int WREG = 8448;
constexpr int OST_OFF = 2 * BUFB;
constexpr int WSF_OFF = OST_OFF + 8 * WREG;
constexpr int FLG_OFF = WSF_OFF + 8 * 256;
__device__ __forceinline__ int crow(int r, int hi) { return (r & 3) + 8 * (r >> 2) + 4 * hi; }
__device__ __forceinline__ s16x4 vtr(const LAS char* p) { typedef short v4i16_t __attribute__((ext_vector_type(4))); return __builtin_bit_cast(s16x4, __builtin_amdgcn_ds_read_tr16_b64_v4i16((LAS v4i16_t*)p)); }
#define ATT_MFMA(a, b, c) __builtin_amdgcn_mfma_f32_32x32x16_bf16((a), (b), (c), 0, 0, 0)

template <int NCH> struct Stage {
    u32x4 k0, k1, v0;
    __device__ __forceinline__ void load(const bf16_t* Kb, int pitchK, const bf16_t* Vb, int pitchV, int key0, int wid, int lane) {
        k0 = *(const u32x4*)(Kb + (size_t)(key0 + lane) * pitchK + wid * 8);
        if (NCH > 8) { if (wid < NCH - 8) k1 = *(const u32x4*)(Kb + (size_t)(key0 + lane) * pitchK + (8 + wid) * 8); }
        v0 = *(const u32x4*)(Vb + (size_t)(key0 + 16 * (wid & 3) + (lane >> 2)) * pitchV + (wid >> 2) * 32 + (lane & 3) * 8);
    }
    __device__ __forceinline__ void write(LAS unsigned char* buf, int wid, int lane) const {
        *(LAS u32x4*)(buf + wid * 1024 + lane * 16) = k0;
        if (NCH > 8) { if (wid < NCH - 8) *(LAS u32x4*)(buf + (8 + wid) * 1024 + lane * 16) = k1; }
        *(LAS u32x4*)(buf + NCH * 1024 + wid * 1024 + lane * 16) = v0;
    }
};

__device__ __forceinline__ void pv_tile(f32x16 (&o)[2], const LAS char* vp, const bf16x8 (&pa)[4]) {
#pragma unroll
    for (int d0 = 0; d0 < 2; ++d0)
#pragma unroll
        for (int ks = 0; ks < 4; ++ks) {
            const s16x4 lo = vtr(vp + d0 * 4096 + ks * 1024), hi = vtr(vp + d0 * 4096 + ks * 1024 + 512);
            const bf16x8 vf = __builtin_shufflevector(lo, hi, 0, 1, 2, 3, 4, 5, 6, 7);
            o[d0] = ATT_MFMA(pa[ks], vf, o[d0]);
        }
}
__device__ __forceinline__ bf16x8 pack8(const f32x16& p, int base) {
    u32x4 w; w.x = cvtpk(p[base], p[base + 1]); w.y = cvtpk(p[base + 2], p[base + 3]); w.z = cvtpk(p[base + 4], p[base + 5]); w.w = cvtpk(p[base + 6], p[base + 7]);
    return __builtin_bit_cast(bf16x8, w);
}
__device__ __forceinline__ void store_o(const f32x16 (&o)[2], const float (&rs)[16], LAS unsigned char* lds, int wid, int lane, bf16_t* Ow) {
    const int r32 = lane & 31, hi = lane >> 5;
    LAS bf16_t* stg = (LAS bf16_t*)(lds + OST_OFF + wid * WREG);
#pragma unroll
    for (int r = 0; r < 16; ++r) { const int orow = crow(r, hi);
#pragma unroll
        for (int d0 = 0; d0 < 2; ++d0) { const unsigned w = cvtpk(o[d0][r] * rs[r], 0.f); stg[orow * 64 + d0 * 32 + r32] = (bf16_t)(w & 0xffffu); } }
    asm volatile("s_waitcnt lgkmcnt(0)" ::: "memory");
#pragma unroll
    for (int i = 0; i < 4; ++i) { const int row = i * 8 + (lane >> 3), ch = lane & 7; const u32x4 v = *(const LAS u32x4*)(stg + row * 64 + ch * 8); *(u32x4*)(Ow + (size_t)row * 512 + ch * 8) = v; }
    asm volatile("s_waitcnt lgkmcnt(0)" ::: "memory");
}


struct Conv {
    const float* w_up; const float* w_down; unsigned char* up8; unsigned char* dn8; int item, step;
    static constexpr int I_UP1 = (D_ / 64) * (2 * DFF / 32), I_DN1 = (DFF / 64) * (D_ / 32), NI = NE * (I_UP1 + I_DN1);
    const float* src; unsigned char* dst; int K, N;
    __device__ __forceinline__ bool pending() const { return item < NI; }
    __device__ __forceinline__ void load(float (&tv)[32], int lane) {
        int r = item;
        if (r < NE * I_UP1) { const int e = r / I_UP1; r %= I_UP1; K = D_; N = 2 * DFF; const int nblk = N / 32, kb = r / nblk, nb = r % nblk; src = w_up + (size_t)e * D_ * 2 * DFF + (size_t)(64 * kb) * N + 32 * nb; dst = up8 + (size_t)e * 2 * DFF * D_ + (size_t)(32 * nb) * K + 64 * kb; }
        else { r -= NE * I_UP1; const int e = r / I_DN1; r %= I_DN1; K = DFF; N = D_; const int nblk = N / 32, kb = r / nblk, nb = r % nblk; src = w_down + (size_t)e * DFF * D_ + (size_t)(64 * kb) * N + 32 * nb; dst = dn8 + (size_t)e * D_ * DFF + (size_t)(32 * nb) * K + 64 * kb; }
#pragma unroll
        for (int i = 0; i < 32; ++i) { const int kk = 2 * i + (lane >> 5); tv[i] = src[(size_t)kk * N + (lane & 31)]; }
    }
    __device__ __forceinline__ void finish(const float (&tv)[32], LAS float* scr, int lane) {
#pragma unroll
        for (int i = 0; i < 32; ++i) { const int kk = 2 * i + (lane >> 5); scr[kk * 33 + (lane & 31)] = tv[i] * W8_SCALE; }
        asm volatile("s_waitcnt lgkmcnt(0)" ::: "memory");
        const int cc = lane & 7;
#pragma unroll
        for (int j = 0; j < 4; ++j) { const int n = (lane >> 3) + 8 * j; const LAS float* s = scr + (8 * cc) * 33 + n;
            u32x2 o; o.x = pk_fp8x4(s[0 * 33], s[1 * 33], s[2 * 33], s[3 * 33]); o.y = pk_fp8x4(s[4 * 33], s[5 * 33], s[6 * 33], s[7 * 33]);
            *(u32x2*)(dst + (size_t)n * K + 8 * cc) = o; }
        asm volatile("s_waitcnt lgkmcnt(0)" ::: "memory");
        item += step;
    }
};
__device__ __forceinline__ void mla_unit(LAS unsigned char* lds, int b, int h, int qb, const bf16_t* QB, const bf16_t* KB, const bf16_t* VB, bf16_t* O, float m0, Conv& cv) {
    const int tid = threadIdx.x, lane = tid & 63, r32 = lane & 31, hi = lane >> 5; const int wid = __builtin_amdgcn_readfirstlane(tid >> 6);
    const size_t rb = (size_t)b * S_; const int q0 = qb * 256;
    const bf16_t* Kh = KB + rb * 768 + h * 96; const bf16_t* Vh = VB + rb * 512 + h * 64;
    bf16x8 qr[6];
    { const bf16_t* qp = QB + (rb + q0 + wid * 32 + r32) * 768 + h * 96 + hi * 8;
#pragma unroll
      for (int d0 = 0; d0 < 6; ++d0) qr[d0] = *(const bf16x8*)(qp + d0 * 16); }
    const int NT = 4 * qb + 4, my_last = 4 * qb + (wid >> 1);
    f32x16 o[2]; float l = 0.f;
#pragma unroll
    for (int r = 0; r < 16; ++r) { o[0][r] = 0.f; o[1][r] = 0.f; }
    Stage<12> st;
    st.load(Kh, 768, Vh, 512, 0, wid, lane); st.write(lds, wid, lane);
    __syncthreads();
    LAS float* cscr = (LAS float*)(lds + OST_OFF + wid * WREG);
    for (int t = 0; t < NT; ++t) {
        float tv[32]; const bool cvp = cv.pending();
        if (cvp) cv.load(tv, lane);
        if (t + 1 < NT) st.load(Kh, 768, Vh, 512, (t + 1) * 64, wid, lane);
        if (t <= my_last) {
            const LAS char* buf = (const LAS char*)(lds + (t & 1) * BUFB);
            const LAS char* kp = buf + hi * 1024 + r32 * 16;
            f32x16 p0, p1;
#pragma unroll
            for (int r = 0; r < 16; ++r) { p0[r] = -m0; p1[r] = -m0; }
#pragma unroll
            for (int d0 = 0; d0 < 6; ++d0) { const bf16x8 a0 = *(const LAS bf16x8*)(kp + d0 * 2048), a1 = *(const LAS bf16x8*)(kp + d0 * 2048 + 512);
                p0 = ATT_MFMA(a0, qr[d0], p0); p1 = ATT_MFMA(a1, qr[d0], p1); }
            float ls = 0.f;
#pragma unroll
            for (int r = 0; r < 16; ++r) { p0[r] = __builtin_amdgcn_exp2f(p0[r]); p1[r] = __builtin_amdgcn_exp2f(p1[r]); ls += p0[r] + p1[r]; }
            l += ls;
            bf16x8 pa[4]; pa[0] = pack8(p0, 0); pa[1] = pack8(p0, 8); pa[2] = pack8(p1, 0); pa[3] = pack8(p1, 8);
            const LAS char* vp = buf + 12 * 1024 + ((lane >> 4) & 1) * 32 + (lane & 3) * 8 + (4 * hi + ((lane & 15) >> 2)) * 64;
            pv_tile(o, vp, pa);
        }
        if (t + 1 < NT) st.write(lds + ((t + 1) & 1) * BUFB, wid, lane);
        if (cvp) cv.finish(tv, cscr, lane);
        __syncthreads();
    }
    l += __shfl_xor(l, 32);
    LAS float* wsf = (LAS float*)(lds + WSF_OFF) + wid * 64;
    if (hi == 0) wsf[r32] = l;
    asm volatile("s_waitcnt lgkmcnt(0)" ::: "memory");
    float rs[16];
#pragma unroll
    for (int r = 0; r < 16; ++r) rs[r] = __builtin_amdgcn_rcpf(wsf[crow(r, hi)]);
    store_o(o, rs, lds, wid, lane, O + (rb + q0 + wid * 32) * 512 + h * 64);
}

constexpr float SB_THR = -152.f;
__device__ __forceinline__ void sb_unit(LAS unsigned char* lds, int b, int h, int qb, const bf16_t* proj, bf16_t* O) {
    const int tid = threadIdx.x, lane = tid & 63, r32 = lane & 31, hi = lane >> 5; const int wid = __builtin_amdgcn_readfirstlane(tid >> 6);
    const size_t rb = (size_t)b * S_; const int q0 = qb * 256;
    const bf16_t* Kh = proj + rb * INWP + C_SBK + h * 64; const bf16_t* Vh = proj + rb * INWP + C_SBV + h * 64;
    bf16x8 qr[4];
    { const bf16_t* qp = proj + (rb + q0 + wid * 32 + r32) * INWP + C_SBQ + h * 64 + hi * 8;
#pragma unroll
      for (int d0 = 0; d0 < 4; ++d0) qr[d0] = *(const bf16x8*)(qp + d0 * 16); }
    const int Ttop = 4 * qb + 3, qw0 = q0 + wid * 32, qabs = qw0 + r32;
    f32x16 o[2]; float carry = 0.f;
#pragma unroll
    for (int r = 0; r < 16; ++r) { o[0][r] = 0.f; o[1][r] = 0.f; }
    volatile LAS int* flg = (volatile LAS int*)(lds + FLG_OFF);
    Stage<8> st;
    st.load(Kh, INWP, Vh, INWP, Ttop * 64, wid, lane); st.write(lds, wid, lane);
    __syncthreads();
    bool alive = true;
    for (int it = 0;; ++it) {
        const int t = Ttop - it;
        if (t > 0) st.load(Kh, INWP, Vh, INWP, (t - 1) * 64, wid, lane);
        if (alive && (64 * t <= qw0 + 30)) {
            const LAS char* buf = (const LAS char*)(lds + (it & 1) * BUFB);
            const LAS char* kp = buf + hi * 1024 + r32 * 16;
            f32x16 p0, p1;
#pragma unroll
            for (int r = 0; r < 16; ++r) { p0[r] = 0.f; p1[r] = 0.f; }
#pragma unroll
            for (int d0 = 0; d0 < 4; ++d0) { const bf16x8 a0 = *(const LAS bf16x8*)(kp + d0 * 2048), a1 = *(const LAS bf16x8*)(kp + d0 * 2048 + 512);
                p0 = ATT_MFMA(a0, qr[d0], p0); p1 = ATT_MFMA(a1, qr[d0], p1); }
            const bool need_mask = (64 * t + 63 >= qw0);
            const int kb0 = 64 * t + 4 * hi;
            f32x16 s0, s1;
#pragma unroll
            for (int r = 0; r < 16; ++r) {
                const int key = kb0 + (r & 3) + 8 * (r >> 2);
                { const float z = p0[r]; const float e = __builtin_amdgcn_exp2f(-fabsf(z)); const float tt = __builtin_amdgcn_logf(1.f + e); float lsv = fminf(-z, 0.f) - tt;
                  if (need_mask && !(key < qabs)) { lsv = 0.f; p0[r] = -INFINITY; } s0[r] = lsv; }
                { const float z = p1[r]; const float e = __builtin_amdgcn_exp2f(-fabsf(z)); const float tt = __builtin_amdgcn_logf(1.f + e); float lsv = fminf(-z, 0.f) - tt;
                  if (need_mask && !(key + 32 < qabs)) { lsv = 0.f; p1[r] = -INFINITY; } s1[r] = lsv; }
            }
            float T[9]; T[8] = 0.f;
#pragma unroll
            for (int j = 7; j >= 0; --j) { const int i = j & 3; const float qs = (j >= 4) ? ((s1[4 * i] + s1[4 * i + 1]) + (s1[4 * i + 2] + s1[4 * i + 3])) : ((s0[4 * i] + s0[4 * i + 1]) + (s0[4 * i + 2] + s0[4 * i + 3])); T[j] = T[j + 1] + qs; }
            float Tp[9]; Tp[8] = 0.f;
#pragma unroll
            for (int j = 0; j < 8; ++j) Tp[j] = __shfl_xor(T[j], 32);
#pragma unroll
            for (int j = 7; j >= 0; --j) {
                const int i = j & 3;
                float lat = carry + T[j + 1] + (hi ? Tp[j + 1] : Tp[j]);
#pragma unroll
                for (int e3 = 3; e3 >= 0; --e3) {
                    const int r = 4 * i + e3;
                    if (j >= 4) { const float lsv = s1[r]; p1[r] = __builtin_amdgcn_exp2f(lsv + p1[r] + lat); lat += lsv; }
                    else        { const float lsv = s0[r]; p0[r] = __builtin_amdgcn_exp2f(lsv + p0[r] + lat); lat += lsv; }
                }
            }
            carry += T[0] + Tp[0];
            bf16x8 pa[4]; pa[0] = pack8(p0, 0); pa[1] = pack8(p0, 8); pa[2] = pack8(p1, 0); pa[3] = pack8(p1, 8);
            const LAS char* vp = buf + 8 * 1024 + ((lane >> 4) & 1) * 32 + (lane & 3) * 8 + (4 * hi + ((lane & 15) >> 2)) * 64;
            pv_tile(o, vp, pa);
            alive = __any(carry > SB_THR);
        }
        if (lane == 0) flg[(it & 1) * 8 + wid] = alive ? 1 : 0;
        if (t > 0) st.write(lds + ((it + 1) & 1) * BUFB, wid, lane);
        __syncthreads();
        if (t == 0) break;
        int any = 0;
#pragma unroll
        for (int w = 0; w < 8; ++w) any |= flg[(it & 1) * 8 + w];
        if (!any) break;
    }
    float rs[16];
#pragma unroll
    for (int r = 0; r < 16; ++r) rs[r] = 1.f;
    store_o(o, rs, lds, wid, lane, O + (rb + q0 + wid * 32) * 512 + h * 64);
}
}

__device__ __forceinline__ void p5_attention(Frame& F, const Args& a) {
    unsigned char* ws = F.ws;
    float gm;
    { const float* gq = a.in[8]; const float* gk = a.in[9]; float mq = 0.f, mk = 0.f;
      for (int i = F.lane; i < 96; i += 64) { mq = fmaxf(mq, fabsf(gq[i])); mk = fmaxf(mk, fabsf(gk[i])); }
#pragma unroll
      for (int o = 1; o < 64; o <<= 1) { mq = fmaxf(mq, __shfl_xor(mq, o)); mk = fmaxf(mk, __shfl_xor(mk, o)); }
      gm = 9.79795897f * LOG2E * mq * mk; }
    att::Conv cv; cv.w_up = a.in[16]; cv.w_down = a.in[18]; cv.up8 = (unsigned char*)(ws + WS_WUP); cv.dn8 = (unsigned char*)(ws + WS_WDN);
    cv.item = F.vcu * NWAVES + F.wave; cv.step = F.G * NWAVES;
    for (int v = F.vcu; v < 256; v += F.G) {
        const int bh = v >> 3, s = v & 7, b = bh >> 3, h = bh & 7;
        for (int i = 0; i < 2; ++i) { const int qb = i ? 15 - s : s;
            att::mla_unit(F.lds, b, h, qb, (const bf16_t*)(ws + WS_QB), (const bf16_t*)(ws + WS_KB), (const bf16_t*)(ws + WS_VB), (bf16_t*)(ws + WS_OMLA), gm, cv);
            __syncthreads(); }
        for (int i = 0; i < 2; ++i) { const int qb = i ? 15 - s : s;
            att::sb_unit(F.lds, b, h, qb, (const bf16_t*)(ws + WS_PROJ), (bf16_t*)(ws + WS_OSB));
            __syncthreads(); }
    }
    { LAS float* cscr = (LAS float*)(F.lds + att::OST_OFF + F.wave * att::WREG);
      while (cv.pending()) { float tv[32]; cv.load(tv, F.lane); cv.finish(tv, cscr, F.lane); } }
}

__device__ __forceinline__ void p8_router(Frame& F, const Args& a) {
    unsigned char* ws = F.ws;
    const float* x1 = a.out; const float* wr = (const float*)(ws + WS_WR); const float* br = a.in[15]; const float* g = a.in[13];
    unsigned char* H2 = (unsigned char*)(ws + WS_H2F8); int* list = (int*)(ws + WS_LIST); float* topw = (float*)(ws + WS_TOPW); int* selo = (int*)(ws + WS_SEL);
    int* cnt = (int*)(ws + WS_CTL) + CW_CNT;
    volatile LAS int* lcnt = (volatile LAS int*)(F.MISC + MI_LCNT); volatile LAS int* lbase = (volatile LAS int*)(F.MISC + MI_BASE);
    const int lane = F.lane, wave = F.wave, tid = F.tid;
    constexpr int WST = 1028;
    LAS float* wt = (LAS float*)F.lds;
    if (F.vcu < M_ / 64) {
        for (int i = tid; i < D_ * NE / 4; i += NTHR) { const f32x4 v = *(const f32x4*)(wr + (size_t)i * 4); const int k = i >> 3, e = (i & 7) * 4;
            wt[(e + 0) * WST + k] = v.x; wt[(e + 1) * WST + k] = v.y; wt[(e + 2) * WST + k] = v.z; wt[(e + 3) * WST + k] = v.w; }
    }
    __syncthreads();
    for (int task = F.vcu; task < M_ / 64; task += F.G) {
        const int T0 = task * 64;
        if (tid < 32) lcnt[tid] = 0;
        __syncthreads();
        int my_e = 0, my_rank = 0; float my_w = 0.f;
        if (wave < 4) {
            const int tk = lane & 15, kp = lane >> 4, tok = T0 + wave * 16 + tk;
            const float* xp = x1 + (size_t)tok * D_ + kp * 256;
            const LAS float* w0 = wt + tk * WST + kp * 256; const LAS float* w1 = w0 + 16 * WST;
            f32x4 acc0 = {0.f, 0.f, 0.f, 0.f}, acc1 = {0.f, 0.f, 0.f, 0.f}; float ssq = 0.f;
#pragma unroll 4
            for (int i = 0; i < 256; i += 4) {
                const f32x4 a4 = *(const f32x4*)(xp + i); const f32x4 b0 = *(const LAS f32x4*)(w0 + i), b1 = *(const LAS f32x4*)(w1 + i);
                ssq += (a4.x * a4.x + a4.y * a4.y) + (a4.z * a4.z + a4.w * a4.w);
#pragma unroll
                for (int j = 0; j < 4; ++j) { acc0 = __builtin_amdgcn_mfma_f32_16x16x4f32(a4[j], b0[j], acc0, 0, 0, 0); acc1 = __builtin_amdgcn_mfma_f32_16x16x4f32(a4[j], b1[j], acc1, 0, 0, 0); }
            }
            ssq += __shfl_xor(ssq, 16); ssq += __shfl_xor(ssq, 32);
            const float rstd = rsqrtf(ssq * (1.f / D_) + EPS);
            const int e0 = lane & 15, grp = lane >> 4;
            const float bia0 = br[e0], bia1 = br[e0 + 16];
#pragma unroll
            for (int j = 0; j < 4; ++j) {
                const float rs = __shfl(rstd, 4 * grp + j);
                float c0 = acc0[j] * rs + bia0, c1 = acc1[j] * rs + bia1;
                float sv[4]; int si[4];
#pragma unroll
                for (int k = 0; k < 4; ++k) {
                    float best = c0; int bi = e0;
                    if (c1 > best) { best = c1; bi = e0 + 16; }
#pragma unroll
                    for (int o = 1; o < 16; o <<= 1) { const float ob = __shfl_xor(best, o); const int oi = __shfl_xor(bi, o); if (ob > best || (ob == best && oi < bi)) { best = ob; bi = oi; } }
                    sv[k] = best; si[k] = bi;
                    if (bi == e0) c0 = -INFINITY; if (bi == e0 + 16) c1 = -INFINITY;
                }
                float ex[4], sum = 0.f;
#pragma unroll
                for (int k = 0; k < 4; ++k) { ex[k] = __expf(sv[k] - sv[0]); sum += ex[k]; }
                const float inv = 1.f / sum;
                if (((lane >> 2) & 3) == j) {
#pragma unroll
                    for (int k = 0; k < 4; ++k) if ((lane & 3) == k) { my_e = si[k]; my_w = ex[k] * inv; }
                }
            }
            my_rank = atomicAdd((int*)&lcnt[my_e], 1);
        } else {
            const f32x4* gr = (const f32x4*)g + lane;
            f32x4 gg[4];
#pragma unroll
            for (int j = 0; j < 4; ++j) gg[j] = gr[64 * j] * X8_SCALE;
            for (int rr = 0; rr < 16; rr += 2) {
                const int t0 = T0 + (wave - 4) * 16 + rr;
                const f32x4* xr0 = (const f32x4*)(x1 + (size_t)t0 * D_) + lane; const f32x4* xr1 = xr0 + D_ / 4;
                f32x4 v0[4], v1[4]; float s0 = 0.f, s1 = 0.f;
#pragma unroll
                for (int j = 0; j < 4; ++j) { v0[j] = xr0[64 * j]; v1[j] = xr1[64 * j]; }
#pragma unroll
                for (int j = 0; j < 4; ++j) { s0 += (v0[j].x * v0[j].x + v0[j].y * v0[j].y) + (v0[j].z * v0[j].z + v0[j].w * v0[j].w); s1 += (v1[j].x * v1[j].x + v1[j].y * v1[j].y) + (v1[j].z * v1[j].z + v1[j].w * v1[j].w); }
                const float r0 = rsqrtf(wave_sum(s0) * (1.f / D_) + EPS), r1 = rsqrtf(wave_sum(s1) * (1.f / D_) + EPS);
                unsigned* o0 = (unsigned*)(H2 + (size_t)t0 * D_) + lane; unsigned* o1 = o0 + D_ / 4;
#pragma unroll
                for (int j = 0; j < 4; ++j) { o0[64 * j] = pk_fp8x4(v0[j].x * r0 * gg[j].x, v0[j].y * r0 * gg[j].y, v0[j].z * r0 * gg[j].z, v0[j].w * r0 * gg[j].w);
                    o1[64 * j] = pk_fp8x4(v1[j].x * r1 * gg[j].x, v1[j].y * r1 * gg[j].y, v1[j].z * r1 * gg[j].z, v1[j].w * r1 * gg[j].w); }
            }
        }
        __syncthreads();
        if (tid < 32) lbase[tid] = lcnt[tid] ? atomicAdd(&cnt[tid], lcnt[tid]) : 0;
        __syncthreads();
        if (wave < 4) {
            const int grp = lane >> 4, jj = (lane >> 2) & 3, kk = lane & 3;
            const int tok = T0 + wave * 16 + 4 * grp + jj, slot = tok * 4 + kk;
            list[(size_t)my_e * M_ + lbase[my_e] + my_rank] = slot;
            topw[slot] = my_w; selo[slot] = my_e;
        }
        __syncthreads();
    }
}

struct MoeOrder {
    const bf16_t* A; const bf16_t* Bt; const int* list; volatile LAS unsigned* tab;
    int lda, ldb, nN, nwg, G, c, gather; size_t estride;
    __device__ void init(const bf16_t* A_, int lda_, const bf16_t* Bt_, int ldb_, size_t estride_, int nN_, const int* list_, volatile LAS unsigned* tab_, int gather_, int G_, int c_) {
        A = A_; lda = lda_; Bt = Bt_; ldb = ldb_; estride = estride_; nN = nN_; list = list_; tab = tab_; gather = gather_; G = G_; c = c_; nwg = (int)tab[MI_TPFX + NE] * nN_; }
    __device__ __forceinline__ bool next(int i, pg8::Unit& u) const {
        const long L = (long)i * G + c; if (L >= nwg) return false;
        int wgid = (int)L; { const int q = nwg / 8, r = nwg % 8, xcd = wgid % 8, off = wgid / 8; wgid = (xcd < r ? xcd * (q + 1) : r * (q + 1) + (xcd - r) * q) + off; }
        int e = 0;
        for (int k = 1; k < NE; ++k) if ((int)tab[MI_TPFX + k] * nN <= wgid) e = k;
        const int t0 = (int)tab[MI_TPFX + e], nt = (int)tab[MI_TPFX + e + 1] - t0, idx = wgid - t0 * nN;
        u.e = e; u.pn = idx / nt; u.rt = idx % nt; u.pm = t0 + u.rt; const int left = (int)tab[MI_CNT + e] - u.rt * 256; u.rows = left < 256 ? left : 256; return true;
    }
    __device__ __forceinline__ unsigned a_off(const pg8::Unit& u, int r, int C) const {
        int row;
        if (gather) row = (r < u.rows) ? (list[(size_t)u.e * M_ + u.rt * 256 + r] >> 2) : M_;
        else row = u.pm * 256 + r;
        return (unsigned)((row * lda + C) * 2);
    }
    __device__ __forceinline__ const char* b_base(const pg8::Unit& u) const { return (const char*)(Bt + (size_t)u.e * estride + (size_t)u.pn * 256 * ldb); }
};
__device__ __forceinline__ void moe_table(Frame& F) {
    int* cnt = (int*)(F.ws + WS_CTL) + CW_CNT;
    if (F.tid < NE) F.MISC[MI_CNT + F.tid] = __hip_atomic_load((unsigned*)cnt + F.tid, RLX_AGENT);
    __syncthreads();
    if (F.tid == 0) { unsigned p = 0; for (int e = 0; e < NE; ++e) { F.MISC[MI_TPFX + e] = p; p += (F.MISC[MI_CNT + e] + 255u) >> 8; } F.MISC[MI_TPFX + NE] = p; }
    __syncthreads();
}

__device__ __forceinline__ void p12_combine(Frame& F, const Args& a) {
    const bf16_t* Y = (const bf16_t*)(F.ws + WS_YB); float* out = a.out;
    const int gt = (F.vcu * NWAVES + F.wave) * 64 + F.lane, NGT = F.G * NTHR;
    for (int i = gt; i < M_ * D_ / 8; i += NGT) {
        const int t = i >> 7, c = (i & 127) * 8;
        f32x4 v0 = *(const f32x4*)(out + (size_t)t * D_ + c), v1 = *(const f32x4*)(out + (size_t)t * D_ + c + 4);
#pragma unroll
        for (int k = 0; k < 4; ++k) { const u32x4 w = *(const u32x4*)(Y + (size_t)(t * 4 + k) * D_ + c);
            v0.x += bflo(w.x); v0.y += bfhi(w.x); v0.z += bflo(w.y); v0.w += bfhi(w.y); v1.x += bflo(w.z); v1.y += bfhi(w.z); v1.z += bflo(w.w); v1.w += bfhi(w.w); }
        *(f32x4*)(out + (size_t)t * D_ + c) = v0; *(f32x4*)(out + (size_t)t * D_ + c + 4) = v1;
    }
}

constexpr int N_PHASES = 11;
#ifndef DUP_PHASE
#define DUP_PHASE -1
#endif
__global__ void __launch_bounds__(NTHR, 2) mega(Args args) {
    extern __shared__ __attribute__((aligned(16))) unsigned char lds_raw[];
    Frame F;
    F.lds = (LAS unsigned char*)lds_raw; F.MISC = (volatile LAS unsigned*)(F.lds + LDS_MISC);
    F.tid = threadIdx.x; F.lane = F.tid & 63; F.wave = __builtin_amdgcn_readfirstlane(F.tid >> 6);
    F.G = gridDim.x; { const int bx = blockIdx.x; F.vcu = (F.G % 8 == 0) ? (bx % 8) * (F.G / 8) + bx / 8 : bx; }
    F.ws = args.ws;
    unsigned char* ws = args.ws;
    for (int u = F.tid; u < (LDS_BYTES - LDS_MISC) / 4; u += NTHR) F.MISC[u] = 0u;
    __syncthreads();
    const int lo = args.ph_lo, hi = args.ph_hi;
    XcdBarrier bar; bar.bar = (unsigned*)(ws + WS_CTL) + CW_BAR; bar.x = 0; bar.st = nullptr;
    if (hi - lo > 1) bar = xcd_barrier_post((unsigned*)(ws + WS_CTL) + CW_BAR, F.MISC + MI_BAR);
#define IN(k) (lo <= (k) && (k) < hi)
#define SEAM(k) do { if (IN(k) && IN((k) + 1)) xcd_barrier(bar); } while (0)
    const int cid = (int)blockIdx.x;

    if (IN(0)) { p0_prologue(F, args, 0, 1); SEAM(0); }
    if (IN(1)) {
        pg8::Gemm g{(const bf16_t*)(ws + WS_HB), D_, D_, D_};
        pg8::StaticOrder S; S.init(g.A, D_, (const bf16_t*)(ws + WS_WIN), D_, M_, INWP, F.G, cid);
        pg8::EpiBf16 E{(bf16_t*)(ws + WS_PROJ), INWP};
        pg8::gemm_phase(F.lds, g, S, E);
        SEAM(1);
    }
    if (IN(2)) {
        { pg8::Gemm g{(const bf16_t*)(ws + WS_PROJ) + C_CQ, INWP, 384, 384};
          pg8::StaticOrder S; S.init(g.A, INWP, (const bf16_t*)(ws + WS_WUQ), 384, M_, 768, F.G, cid);
          pg8::EpiBf16 E{(bf16_t*)(ws + WS_QRAW), 768};
          pg8::gemm_phase(F.lds, g, S, E); }
        { pg8::Gemm g{(const bf16_t*)(ws + WS_PROJ) + C_CKV, INWP, 256, 256};
          pg8::StaticOrder S; S.init(g.A, INWP, (const bf16_t*)(ws + WS_WUKV), 256, M_, 1024, F.G, cid);
          pg8::EpiBf16 E{(bf16_t*)(ws + WS_KVRAW), 1024};
          pg8::gemm_phase(F.lds, g, S, E); }
        SEAM(2);
    }
    if (IN(3)) { p4_prep(F, args); SEAM(3); }
    if (IN(4)) { p5_attention(F, args); SEAM(4); }
    if (IN(5)) {
        { pg8::Gemm g{(const bf16_t*)(ws + WS_OSB), 512, 512, 512};
          pg8::StaticOrder S; S.init(g.A, 512, (const bf16_t*)(ws + WS_WOSB), 512, M_, D_, F.G, cid);
          pg8::EpiGate<true> E{(bf16_t*)(ws + WS_MIX), (const bf16_t*)(ws + WS_PROJ), INWP, C_GSB};
          pg8::gemm_phase(F.lds, g, S, E); }
        { pg8::Gemm g{(const bf16_t*)(ws + WS_OMLA), 512, 512, 512};
          pg8::StaticOrder S; S.init(g.A, 512, (const bf16_t*)(ws + WS_WOMLA), 512, M_, D_, F.G, cid);
          pg8::EpiGate<false> E{(bf16_t*)(ws + WS_MIX), (const bf16_t*)(ws + WS_PROJ), INWP, C_GMLA};
          pg8::gemm_phase(F.lds, g, S, E); }
        SEAM(5);
    }
    if (IN(6)) {
        pg8::Gemm g{(const bf16_t*)(ws + WS_MIX), D_, D_, D_};
        pg8::StaticOrder S; S.init(g.A, D_, (const bf16_t*)(ws + WS_WOUT), D_, M_, D_, F.G, cid);
        pg8::EpiRes E{args.in[0], args.out};
        pg8::gemm_phase(F.lds, g, S, E);
        SEAM(6);
    }
    if (IN(7)) { p8_router(F, args); SEAM(7); }
    if (IN(8)) {
        moe_table(F);
        pg8::Gemm g{(const bf16_t*)(ws + WS_H2F8), D_ / 2, D_ / 2, D_ / 2};
        MoeOrder S; S.init(g.A, D_ / 2, (const bf16_t*)(ws + WS_WUP), D_ / 2, (size_t)2 * DFF * D_ / 2, 8, (const int*)(ws + WS_LIST), F.MISC, 1, F.G, cid);
        pg8::EpiSwiglu8 E{(unsigned char*)(ws + WS_ACT), args.in[17]};
        pg8::gemm_phase<pg8::EpiSwiglu8, MoeOrder, true>(F.lds, g, S, E);
        SEAM(8);
    }
    if (IN(9)) {
        moe_table(F);
        pg8::Gemm g{(const bf16_t*)(ws + WS_ACT), DFF / 2, DFF / 2, DFF / 2};
        MoeOrder S; S.init(g.A, DFF / 2, (const bf16_t*)(ws + WS_WDN), DFF / 2, (size_t)D_ * DFF / 2, 4, (const int*)(ws + WS_LIST), F.MISC, 0, F.G, cid);
        pg8::EpiDown E{(bf16_t*)(ws + WS_YB), args.in[19], (const int*)(ws + WS_LIST), (const float*)(ws + WS_TOPW)};
        pg8::gemm_phase<pg8::EpiDown, MoeOrder, true>(F.lds, g, S, E);
        SEAM(9);
    }
    if (IN(10)) { p12_combine(F, args); }
#undef IN
#undef SEAM
}
static int g_grid = 0;
static int setup_grid() {
    if (g_grid == 0) {
        int dev = 0, cus = 0;
        if (hipGetDevice(&dev) != hipSuccess || hipDeviceGetAttribute(&cus, hipDeviceAttributeMultiprocessorCount, dev) != hipSuccess) { g_grid = -1; return g_grid; }
        if (hipFuncSetAttribute((const void*)mega, hipFuncAttributeMaxDynamicSharedMemorySize, LDS_BYTES) != hipSuccess) { g_grid = -1; return g_grid; }
        int per_cu = 0;
        (void)hipOccupancyMaxActiveBlocksPerMultiprocessor(&per_cu, (const void*)mega, NTHR, LDS_BYTES);
        (void)hipGetLastError();
        g_grid = cus;
    }
    return g_grid;
}
static void launch_mega(void* const* d_in, void* d_out, void* d_ws, int lo, int hi, hipStream_t stream) {
    Args a; memset(&a, 0, sizeof(a));
    for (int i = 0; i < 20; ++i) a.in[i] = (const float*)d_in[i];
    a.out = (float*)d_out; a.ws = (unsigned char*)d_ws; a.ph_lo = lo; a.ph_hi = hi;
    hipLaunchKernelGGL(mega, dim3(g_grid), dim3(NTHR), LDS_BYTES, stream, a);
}
extern "C" void kernel_launch(void* const* d_in, const int* in_sizes, int n_in, void* d_out, int out_size, void* d_ws, size_t ws_size, hipStream_t stream) {
    if (n_in != 20 || ws_size < WS_OPT_END || out_size != M_ * D_) { fprintf(stderr, "kernel_launch: unexpected arguments\n"); return; }
    if (setup_grid() <= 0) return;
    (void)hipMemsetAsync((char*)d_ws + WS_CTL, 0, CTL_ZERO_BYTES, stream);
#if N_LAUNCH_SPLIT
    for (int p = 0; p < N_PHASES; ++p) { launch_mega(d_in, d_out, d_ws, p, p + 1, stream); if (p == DUP_PHASE) { if (p == 7) (void)hipMemsetAsync((char*)d_ws + WS_CTL, 0, 128, stream); if (p == 10) launch_mega(d_in, d_out, d_ws, 6, 7, stream); launch_mega(d_in, d_out, d_ws, p, p + 1, stream); } }
#else
    launch_mega(d_in, d_out, d_ws, 0, N_PHASES, stream);
#endif
}
```

```cpp
#define N_LAUNCH_SPLIT 0
#include <hip/hip_runtime.h>
#include <hip/hip_bf16.h>
#include <cstdio>
#include <cstdint>
#include <cstring>
#include <cmath>

constexpr int B_ = 4, S_ = 4096, D_ = 1024, M_ = B_ * S_;
constexpr int INW = 4256, INWP = 4352;
constexpr int C_SBQ = 0, C_SBK = 512, C_SBV = 1024, C_CQ = 1536, C_CKV = 1920, C_KR = 2176, C_GSB = 2208, C_GMLA = 3232;
constexpr int NE = 32, TOPK = 4, DFF = 1024;
constexpr float EPS = 1e-6f;
constexpr float LOG2E = 1.4426950408889634f;
constexpr float SB_QSCALE = 0.125f * LOG2E;
constexpr float MLA_QSCALE = 0.10206207261596577f * LOG2E;
constexpr int NWAVES = 8, NTHR = 512;

#define LAS __attribute__((address_space(3)))
#define GAS __attribute__((address_space(1)))
typedef unsigned short bf16_t;
typedef short bf16x8 __attribute__((ext_vector_type(8)));
typedef short s16x4 __attribute__((ext_vector_type(4)));
typedef float f32x4 __attribute__((ext_vector_type(4)));
typedef float f32x16 __attribute__((ext_vector_type(16)));
typedef unsigned u32x4 __attribute__((ext_vector_type(4)));
typedef unsigned u32x2 __attribute__((ext_vector_type(2)));
typedef float f32x2_t __attribute__((ext_vector_type(2)));
typedef __bf16 bf16x2_t __attribute__((ext_vector_type(2)));
typedef int v8i_t __attribute__((ext_vector_type(8)));
constexpr float W8_SCALE = 8.f, X8_SCALE = 8.f;
__device__ __forceinline__ unsigned pk_fp8x4(float a, float b, float c, float d) { unsigned w = 0; w = __builtin_amdgcn_cvt_pk_fp8_f32(a, b, w, false); w = __builtin_amdgcn_cvt_pk_fp8_f32(c, d, w, true); return w; }

__device__ __forceinline__ unsigned cvtpk(float lo, float hi) { f32x2_t v = {lo, hi}; bf16x2_t b = __builtin_convertvector(v, bf16x2_t); return __builtin_bit_cast(unsigned, b); }
__device__ __forceinline__ float bf2f(unsigned short h) { return __uint_as_float(((unsigned)h) << 16); }
__device__ __forceinline__ float bflo(unsigned w) { return __uint_as_float(w << 16); }
__device__ __forceinline__ float bfhi(unsigned w) { return __uint_as_float(w & 0xffff0000u); }
__device__ __forceinline__ float wave_sum(float v) {
#pragma unroll
    for (int o = 1; o < 64; o <<= 1) v += __shfl_xor(v, o);
    return v;
}
__device__ __forceinline__ float sigmoidf_(float x) { return __builtin_amdgcn_rcpf(1.f + __builtin_amdgcn_exp2f(-x * LOG2E)); }

namespace pg8 {
constexpr int BM = 256, BK = 64, HALF = 128, HTB = HALF * BK * 2, STAGE_BYTES = 8 * HTB, NXCD = 8, WGM = 8;
__host__ __device__ __forceinline__ int lds_byte(int r, int c) { const int st = (r >> 4) * 2 + (c >> 5), rr = r & 15, cc = c & 31, ob = rr * 64 + cc * 2; return st * 1024 + (ob ^ (((ob >> 9) & 1) << 5)); }
__host__ __device__ __forceinline__ void stage_rc(int b, int& R, int& C) { const int st = b / 1024, sb = b % 1024, swz = sb ^ (((sb >> 9) & 1) << 5); R = (st >> 1) * 16 + swz / 64; C = (st & 1) * 32 + (swz % 64) / 2; }
__host__ __device__ __forceinline__ int perm32(int rho) { const int n = rho >> 4, i = rho & 15; return 8 * (i >> 2) + 4 * n + (i & 3); }

struct Unit { int pm, pn, e, rows, rt; };
struct Gemm { const bf16_t* A; int lda, ldb, K; };

struct StaticOrder {
    const bf16_t* A; const bf16_t* Bt; int lda, ldb;
    int nM, nN, nwg, G, c;
    __device__ void init(const bf16_t* A_, int lda_, const bf16_t* Bt_, int ldb_, int M, int N, int G_, int c_) { A = A_; Bt = Bt_; lda = lda_; ldb = ldb_; nM = M / BM; nN = N / BM; nwg = nM * nN; G = G_; c = c_; }
    __device__ __forceinline__ bool next(int i, Unit& u) const {
        const long L = (long)i * G + c; if (L >= nwg) return false;
        int wgid = (int)L; { const int q = nwg / NXCD, r = nwg % NXCD, xcd = wgid % NXCD, off = wgid / NXCD; wgid = (xcd < r ? xcd * (q + 1) : r * (q + 1) + (xcd - r) * q) + off; }
        const int nig = WGM * nN, gid = wgid / nig, fm = gid * WGM, gsz = (nM - fm) < WGM ? (nM - fm) : WGM;
        u.pm = fm + ((wgid % nig) % gsz); u.pn = (wgid % nig) / gsz; u.e = 0; u.rows = 256; u.rt = 0; return true;
    }
    __device__ __forceinline__ unsigned a_off(const Unit& u, int r, int C) const { return (unsigned)(((u.pm * BM + r) * lda + C) * 2); }
    __device__ __forceinline__ const char* b_base(const Unit& u) const { return (const char*)(Bt + (size_t)u.pn * BM * ldb); }
};

__device__ __forceinline__ v8i_t ld32_lds(const LAS unsigned char* p) { const u32x4 lo_ = *(const LAS u32x4*)p, hi_ = *(const LAS u32x4*)(p + 1024); return (v8i_t){(int)lo_.x, (int)lo_.y, (int)lo_.z, (int)lo_.w, (int)hi_.x, (int)hi_.y, (int)hi_.z, (int)hi_.w}; }
__device__ __forceinline__ void mfma_f8(f32x4& c, const v8i_t a, const v8i_t b, int sa, int sb) {
    asm volatile("v_mfma_scale_f32_16x16x128_f8f6f4 %0, %1, %2, %0, %3, %4 op_sel_hi:[0,0,0]" : "+v"(c) : "v"(a), "v"(b), "v"(sa), "v"(sb));
}
template <bool F8> struct FragT { typedef bf16x8 type; };
template <> struct FragT<true> { typedef v8i_t type; };
template <class Epi, class Sched, bool FP8 = false>
__device__ __forceinline__ void gemm_phase(LAS unsigned char* lds, const Gemm g, const Sched& S, const Epi& E) {
    const int tid = threadIdx.x, wid = __builtin_amdgcn_readfirstlane(tid >> 6), lane = tid & 63, wr = wid >> 2, wc = wid & 3, fr = lane & 15, fq = lane >> 4;
    const int K = g.K, nt = K / BK;
    unsigned voffB[2];
#pragma unroll
    for (int i = 0; i < 2; ++i) { int R, C; stage_rc(tid * 16 + i * 8192, R, C); const int Rb = Epi::PERM ? ((R & ~31) + perm32(R & 31)) : R; voffB[i] = (unsigned)(Rb * g.ldb + C) * 2u; }
#define PG8_AOFF(dst, unit) do { int t_ = tid; asm volatile("" : "+v"(t_)); _Pragma("unroll") for (int i = 0; i < 2; ++i) { int R, C; stage_rc(t_ * 16 + i * 8192, R, C); \
        _Pragma("unroll") for (int h = 0; h < 2; ++h) dst[h][i] = S.a_off(unit, h * HALF + R, C); } } while (0)
    const size_t kstep = (size_t)(BK * 2);
    const size_t hstepB = (size_t)HALF * g.ldb * 2;
    const unsigned ldsw = (unsigned)wid * 1024u;
    const int aoff = lds_byte(wr * 64 + fr, fq * 8), boff = lds_byte(wc * 32 + fr, fq * 8);
#define PG8_SA(b, h) (((b) * 2 + (h)) * HTB)
#define PG8_SB(b, h) ((4 + (b) * 2 + (h)) * HTB)
#define PG8_STAGE(bufoff, gbase, voff) do { _Pragma("unroll") for (int _i = 0; _i < 2; ++_i) \
        __builtin_amdgcn_global_load_lds((const unsigned*)((const char*)(gbase) + (voff)[_i]), (LAS unsigned*)(lds + (bufoff) + ldsw + _i * 8192), 16, 0, 0); } while (0)
#define PG8_LD32(p) ld32_lds((const LAS unsigned char*)(p))
#define PG8_LDA(dst, b, h) do { if constexpr (FP8) { _Pragma("unroll") for (int m = 0; m < 4; ++m) dst[m][0] = __builtin_bit_cast(FT, PG8_LD32(lds + PG8_SA(b, h) + aoff + m * 2048)); } \
        else { _Pragma("unroll") for (int m = 0; m < 4; ++m) _Pragma("unroll") for (int k = 0; k < 2; ++k) dst[m][k] = __builtin_bit_cast(FT, *(const LAS FT*)(lds + PG8_SA(b, h) + aoff + m * 2048 + k * 1024)); } } while (0)
#define PG8_LDB(dst, b, h) do { if constexpr (FP8) { _Pragma("unroll") for (int n = 0; n < 2; ++n) dst[n][0] = __builtin_bit_cast(FT, PG8_LD32(lds + PG8_SB(b, h) + boff + n * 2048)); } \
        else { _Pragma("unroll") for (int n = 0; n < 2; ++n) _Pragma("unroll") for (int k = 0; k < 2; ++k) dst[n][k] = __builtin_bit_cast(FT, *(const LAS FT*)(lds + PG8_SB(b, h) + boff + n * 2048 + k * 1024)); } } while (0)
#define PG8_MMA(ai, bj, At, Bt) do { __builtin_amdgcn_s_setprio(1); \
        if constexpr (FP8) { _Pragma("unroll") for (int m = 0; m < 4; ++m) _Pragma("unroll") for (int n = 0; n < 2; ++n) \
            mfma_f8(acc[ai][bj][m][n], __builtin_bit_cast(v8i_t, Bt[n][0]), __builtin_bit_cast(v8i_t, At[m][0]), 0x7c7c7c7c, 0x7c7c7c7c); } \
        else { _Pragma("unroll") for (int m = 0; m < 4; ++m) _Pragma("unroll") for (int n = 0; n < 2; ++n) _Pragma("unroll") for (int k = 0; k < 2; ++k) \
            acc[ai][bj][m][n] = __builtin_amdgcn_mfma_f32_16x16x32_bf16(__builtin_bit_cast(bf16x8, Bt[n][k]), __builtin_bit_cast(bf16x8, At[m][k]), acc[ai][bj][m][n], 0, 0, 0); } \
        __builtin_amdgcn_s_setprio(0); } while (0)
#define PG8_WAIT_V(n) asm volatile("s_waitcnt vmcnt(" #n ")" ::: "memory")
#define PG8_WAIT_L(n) asm volatile("s_waitcnt lgkmcnt(" #n ")" ::: "memory")
#define PG8_BAR __builtin_amdgcn_s_barrier()
#define PG8_SCHED __builtin_amdgcn_sched_barrier(0)
    Unit cur, nxt; int ui = 0;
    if (!S.next(0, cur)) return;
    f32x4 acc[2][2][4][2];
#pragma unroll
    for (int a = 0; a < 2; ++a)
#pragma unroll
        for (int b = 0; b < 2; ++b)
#pragma unroll
            for (int m = 0; m < 4; ++m)
#pragma unroll
                for (int n = 0; n < 2; ++n) acc[a][b][m][n] = (f32x4){0.f, 0.f, 0.f, 0.f};
    typedef typename FragT<FP8>::type FT; constexpr int NK = FP8 ? 1 : 2;
    FT At[4][NK], B0[2][NK], B1[2][NK];
    const char* Ab = (const char*)g.A;
    const char* cB = S.b_base(cur);
    unsigned vaC[2][2], vaN[2][2];
    PG8_AOFF(vaC, cur);
    PG8_STAGE(PG8_SB(0, 0), cB, voffB); PG8_STAGE(PG8_SB(0, 1), cB + hstepB, voffB); PG8_STAGE(PG8_SA(0, 0), Ab, vaC[0]); PG8_STAGE(PG8_SA(0, 1), Ab, vaC[1]);
    if (wr == 1) PG8_BAR;
    PG8_WAIT_V(2); PG8_BAR;
    PG8_STAGE(PG8_SB(1, 0), cB + kstep, voffB); PG8_STAGE(PG8_SA(1, 0), Ab + kstep, vaC[0]); PG8_STAGE(PG8_SB(1, 1), cB + hstepB + kstep, voffB);
    PG8_WAIT_V(6); PG8_BAR;
    for (;;) {
        const bool has_next = S.next(ui + 1, nxt);
        const char* nB = has_next ? S.b_base(nxt) : cB;
        if (has_next) PG8_AOFF(vaN, nxt);
        else {
#pragma unroll
            for (int h = 0; h < 2; ++h)
#pragma unroll
                for (int i = 0; i < 2; ++i) vaN[h][i] = vaC[h][i]; }
        for (int t = 0; t < nt; t += 2) {
            const bool last = (t == nt - 2);
            const char* kA1 = Ab + (size_t)(t + 1) * kstep;
            const char* kA2 = last ? Ab : Ab + (size_t)(t + 2) * kstep; const char* b2 = last ? nB : cB + (size_t)(t + 2) * kstep;
            const char* kA3 = kA2 + kstep; const char* b3 = b2 + kstep;
            unsigned o2[2][2];
#pragma unroll
            for (int h = 0; h < 2; ++h)
#pragma unroll
                for (int i = 0; i < 2; ++i) o2[h][i] = last ? vaN[h][i] : vaC[h][i];
            PG8_LDB(B0, 0, 0); PG8_LDB(B1, 0, 1); PG8_SCHED; PG8_LDA(At, 0, 0); PG8_STAGE(PG8_SA(1, 1), kA1, vaC[1]);
            PG8_WAIT_V(8); PG8_WAIT_L(0); PG8_BAR; PG8_MMA(0, 0, At, B0); PG8_MMA(0, 1, At, B1); PG8_BAR; PG8_SCHED;
            PG8_LDA(At, 0, 1); PG8_STAGE(PG8_SB(0, 0), b2, voffB); PG8_STAGE(PG8_SB(0, 1), b2 + hstepB, voffB); PG8_STAGE(PG8_SA(0, 0), kA2, o2[0]);
            PG8_WAIT_V(8); PG8_WAIT_L(0); PG8_BAR; PG8_MMA(1, 0, At, B0); PG8_MMA(1, 1, At, B1); PG8_BAR; PG8_SCHED;
            PG8_LDB(B0, 1, 0); PG8_LDB(B1, 1, 1); PG8_SCHED; PG8_LDA(At, 1, 0); PG8_STAGE(PG8_SA(0, 1), kA2, o2[1]);
            PG8_WAIT_V(8); PG8_WAIT_L(0); PG8_BAR; PG8_MMA(0, 0, At, B0); PG8_MMA(0, 1, At, B1); PG8_BAR; PG8_SCHED;
            PG8_LDA(At, 1, 1); PG8_STAGE(PG8_SB(1, 0), b3, voffB); PG8_STAGE(PG8_SB(1, 1), b3 + hstepB, voffB); PG8_STAGE(PG8_SA(1, 0), kA3, o2[0]);
            PG8_WAIT_V(8); PG8_WAIT_L(0); PG8_BAR; PG8_MMA(1, 0, At, B0); PG8_MMA(1, 1, At, B1); PG8_BAR; PG8_SCHED;
        }
        if (wr == 0) PG8_BAR;
        if constexpr (FP8) asm volatile("s_nop 15\n\ts_nop 15" ::: "memory");
        E(acc, cur, wr, wc, fr, fq);
        if (!has_next) break;
#pragma unroll
        for (int a = 0; a < 2; ++a)
#pragma unroll
            for (int b = 0; b < 2; ++b)
#pragma unroll
                for (int m = 0; m < 4; ++m)
#pragma unroll
                    for (int n = 0; n < 2; ++n) acc[a][b][m][n] = (f32x4){0.f, 0.f, 0.f, 0.f};
        cur = nxt; cB = nB; ++ui;
#pragma unroll
        for (int h = 0; h < 2; ++h)
#pragma unroll
            for (int i = 0; i < 2; ++i) vaC[h][i] = vaN[h][i];
        if (wr == 1) PG8_BAR;
    }
    PG8_WAIT_V(0);
    PG8_BAR;
#undef PG8_SA
#undef PG8_AOFF
#undef PG8_SB
#undef PG8_STAGE
#undef PG8_LDA
#undef PG8_LDB
#undef PG8_MMA
#undef PG8_LD32
#undef PG8_WAIT_V
#undef PG8_WAIT_L
#undef PG8_BAR
#undef PG8_SCHED
}

struct EpiBf16 {
    static constexpr bool PERM = true;
    bf16_t* O; int ldc;
    __device__ __forceinline__ void operator()(const f32x4 (&acc)[2][2][4][2], const Unit& u, int wr, int wc, int fr, int fq) const {
        const int row0 = u.pm * BM + wr * 64 + fr, col0 = u.pn * BM + wc * 32 + 8 * fq;
#pragma unroll
        for (int ai = 0; ai < 2; ++ai)
#pragma unroll
            for (int m = 0; m < 4; ++m) { bf16_t* rowp = O + (size_t)(row0 + ai * HALF + m * 16) * ldc + col0;
#pragma unroll
                for (int bj = 0; bj < 2; ++bj) { const f32x4 v0 = acc[ai][bj][m][0], v1 = acc[ai][bj][m][1];
                    u32x4 w; w.x = cvtpk(v0[0], v0[1]); w.y = cvtpk(v0[2], v0[3]); w.z = cvtpk(v1[0], v1[1]); w.w = cvtpk(v1[2], v1[3]);
                    *(u32x4*)(rowp + bj * HALF) = w; } }
    }
};
template <bool FIRST> struct EpiGate {
    static constexpr bool PERM = true;
    bf16_t* O; const bf16_t* G; int ldg, gcol;
    __device__ __forceinline__ void operator()(const f32x4 (&acc)[2][2][4][2], const Unit& u, int wr, int wc, int fr, int fq) const {
        const int row0 = u.pm * BM + wr * 64 + fr, col0 = u.pn * BM + wc * 32 + 8 * fq;
#pragma unroll
        for (int ai = 0; ai < 2; ++ai)
#pragma unroll
            for (int m = 0; m < 4; ++m) { const size_t r = (size_t)(row0 + ai * HALF + m * 16);
#pragma unroll
                for (int bj = 0; bj < 2; ++bj) { const f32x4 v0 = acc[ai][bj][m][0], v1 = acc[ai][bj][m][1];
                    const int c = col0 + bj * HALF;
                    const u32x4 gw = *(const u32x4*)(G + r * ldg + gcol + c);
                    float o[8];
                    o[0] = sigmoidf_(bflo(gw.x)) * v0[0]; o[1] = sigmoidf_(bfhi(gw.x)) * v0[1]; o[2] = sigmoidf_(bflo(gw.y)) * v0[2]; o[3] = sigmoidf_(bfhi(gw.y)) * v0[3];
                    o[4] = sigmoidf_(bflo(gw.z)) * v1[0]; o[5] = sigmoidf_(bfhi(gw.z)) * v1[1]; o[6] = sigmoidf_(bflo(gw.w)) * v1[2]; o[7] = sigmoidf_(bfhi(gw.w)) * v1[3];
                    bf16_t* op = O + r * D_ + c;
                    if (!FIRST) { const u32x4 pw = *(const u32x4*)op;
                        o[0] += bflo(pw.x); o[1] += bfhi(pw.x); o[2] += bflo(pw.y); o[3] += bfhi(pw.y); o[4] += bflo(pw.z); o[5] += bfhi(pw.z); o[6] += bflo(pw.w); o[7] += bfhi(pw.w); }
                    u32x4 w; w.x = cvtpk(o[0], o[1]); w.y = cvtpk(o[2], o[3]); w.z = cvtpk(o[4], o[5]); w.w = cvtpk(o[6], o[7]);
                    *(u32x4*)op = w; } }
    }
};
struct EpiRes {
    static constexpr bool PERM = false;
    const float* base; float* out;
    __device__ __forceinline__ void operator()(const f32x4 (&acc)[2][2][4][2], const Unit& u, int wr, int wc, int fr, int fq) const {
        const int row0 = u.pm * BM + wr * 64 + fr, col0 = u.pn * BM + wc * 32 + 4 * fq;
#pragma unroll
        for (int ai = 0; ai < 2; ++ai)
#pragma unroll
            for (int m = 0; m < 4; ++m) { const size_t off = (size_t)(row0 + ai * HALF + m * 16) * D_ + col0;
#pragma unroll
                for (int bj = 0; bj < 2; ++bj)
#pragma unroll
                    for (int n = 0; n < 2; ++n) { const f32x4 b = *(const f32x4*)(base + off + bj * HALF + n * 16); *(f32x4*)(out + off + bj * HALF + n * 16) = b + acc[ai][bj][m][n]; } }
    }
};
struct EpiSwiglu {
    static constexpr bool PERM = true;
    bf16_t* act; const float* b_up;
    __device__ __forceinline__ void operator()(const f32x4 (&acc)[2][2][4][2], const Unit& u, int wr, int wc, int fr, int fq) const {
        const int row0 = u.pm * BM + wr * 64 + fr, col0 = u.pn * BM + wc * 32 + 8 * fq;
        const float* bb = b_up + (size_t)u.e * (2 * DFF);
        f32x4 bv[2][2];
#pragma unroll
        for (int bj = 0; bj < 2; ++bj)
#pragma unroll
            for (int n = 0; n < 2; ++n) bv[bj][n] = *(const f32x4*)(bb + col0 + bj * HALF + 4 * n);
#pragma unroll
        for (int ai = 0; ai < 2; ++ai)
#pragma unroll
            for (int m = 0; m < 4; ++m) { bf16_t* rowp = act + (size_t)(row0 + ai * HALF + m * 16) * DFF + (col0 >> 1);
#pragma unroll
                for (int bj = 0; bj < 2; ++bj) { const f32x4 v0 = acc[ai][bj][m][0] + bv[bj][0], v1 = acc[ai][bj][m][1] + bv[bj][1];
                    float a[4];
#pragma unroll
                    for (int p = 0; p < 4; ++p) { float gl = (p < 2) ? v0[2 * p] : v1[2 * p - 4], li = (p < 2) ? v0[2 * p + 1] : v1[2 * p - 3];
                        gl = fminf(gl, 7.f); li = fminf(fmaxf(li, -7.f), 7.f);
                        a[p] = gl * sigmoidf_(1.702f * gl) * (li + 1.f); }
                    u32x2 w; w.x = cvtpk(a[0], a[1]); w.y = cvtpk(a[2], a[3]);
                    *(u32x2*)(rowp + bj * (HALF / 2)) = w; } }
    }
};
struct EpiSwiglu8 {
    static constexpr bool PERM = true;
    unsigned char* act; const float* b_up;
    __device__ __forceinline__ void operator()(const f32x4 (&acc)[2][2][4][2], const Unit& u, int wr, int wc, int fr, int fq) const {
        const int row0 = u.pm * BM + wr * 64 + fr, col0 = u.pn * BM + wc * 32 + 8 * fq;
        const float* bb = b_up + (size_t)u.e * (2 * DFF);
        f32x4 bv[2][2];
#pragma unroll
        for (int bj = 0; bj < 2; ++bj)
#pragma unroll
            for (int n = 0; n < 2; ++n) bv[bj][n] = *(const f32x4*)(bb + col0 + bj * HALF + 4 * n);
#pragma unroll
        for (int ai = 0; ai < 2; ++ai)
#pragma unroll
            for (int m = 0; m < 4; ++m) { unsigned char* rowp = act + (size_t)(row0 + ai * HALF + m * 16) * DFF + (col0 >> 1);
#pragma unroll
                for (int bj = 0; bj < 2; ++bj) { const f32x4 v0 = acc[ai][bj][m][0] + bv[bj][0], v1 = acc[ai][bj][m][1] + bv[bj][1];
                    float a[4];
#pragma unroll
                    for (int p = 0; p < 4; ++p) { float gl = (p < 2) ? v0[2 * p] : v1[2 * p - 4], li = (p < 2) ? v0[2 * p + 1] : v1[2 * p - 3];
                        gl = fminf(gl, 7.f); li = fminf(fmaxf(li, -7.f), 7.f);
                        a[p] = gl * sigmoidf_(1.702f * gl) * (li + 1.f) * X8_SCALE; }
                    *(unsigned*)(rowp + bj * (HALF / 2)) = pk_fp8x4(a[0], a[1], a[2], a[3]); } }
    }
};
struct EpiDown {
    static constexpr bool PERM = true;
    bf16_t* y; const float* b_down; const int* list; const float* topw;
    __device__ __forceinline__ void operator()(const f32x4 (&acc)[2][2][4][2], const Unit& u, int wr, int wc, int fr, int fq) const {
        const int col0 = u.pn * BM + wc * 32 + 8 * fq;
        const float* bb = b_down + (size_t)u.e * D_;
        f32x4 bv[2][2];
#pragma unroll
        for (int bj = 0; bj < 2; ++bj)
#pragma unroll
            for (int n = 0; n < 2; ++n) bv[bj][n] = *(const f32x4*)(bb + col0 + bj * HALF + 4 * n);
        const int* lp = list + (size_t)u.e * M_ + u.rt * BM;
#pragma unroll
        for (int ai = 0; ai < 2; ++ai)
#pragma unroll
            for (int m = 0; m < 4; ++m) { const int r = ai * HALF + wr * 64 + m * 16 + fr;
                if (r < u.rows) { const int slot = lp[r]; const float w = topw[slot]; bf16_t* rowp = y + (size_t)slot * D_ + col0;
#pragma unroll
                    for (int bj = 0; bj < 2; ++bj) { const f32x4 v0 = (acc[ai][bj][m][0] + bv[bj][0]) * w, v1 = (acc[ai][bj][m][1] + bv[bj][1]) * w;
                        u32x4 o; o.x = cvtpk(v0[0], v0[1]); o.y = cvtpk(v0[2], v0[3]); o.z = cvtpk(v1[0], v1[1]); o.w = cvtpk(v1[2], v1[3]);
                        *(u32x4*)(rowp + bj * HALF) = o; } } }
    }
};
}
constexpr size_t MiB = 1ull << 20;
constexpr size_t WS_CTL = 0, CTL_ZERO_BYTES = 64 * 1024;
constexpr size_t WS_ROPE = 256 * 1024;
constexpr size_t WS_WR = 3 * MiB;
constexpr size_t WS_LIST = 4 * MiB;
constexpr size_t WS_TOPW = 6 * MiB;
constexpr size_t WS_SEL = 6 * MiB + 512 * 1024;
constexpr size_t WS_WIN = 8 * MiB;
constexpr size_t WS_WUQ = 17 * MiB;
constexpr size_t WS_WUKV = 18 * MiB;
constexpr size_t WS_WOSB = 19 * MiB;
constexpr size_t WS_WOMLA = 20 * MiB;
constexpr size_t WS_WOUT = 21 * MiB;
constexpr size_t WS_WUP = 24 * MiB;
constexpr size_t WS_WDN = 152 * MiB;
constexpr size_t WS_HB = 216 * MiB;
constexpr size_t WS_PROJ = 249 * MiB;
constexpr size_t WS_ACT = WS_PROJ;
constexpr size_t WS_QRAW = 393 * MiB;
constexpr size_t WS_KVRAW = WS_QRAW + 24 * MiB;
constexpr size_t WS_QB = WS_KVRAW + 32 * MiB;
constexpr size_t WS_KB = WS_QB + 24 * MiB;
constexpr size_t WS_VB = WS_KB + 24 * MiB;
constexpr size_t WS_OSB = WS_VB + 16 * MiB;
constexpr size_t WS_OMLA = WS_OSB + 16 * MiB;
constexpr size_t WS_YB = WS_QRAW;
constexpr size_t WS_MIX = 545 * MiB;
constexpr size_t WS_H2F8 = 577 * MiB;
constexpr size_t WS_OPT_END = 594 * MiB;
constexpr int CW_CNT = 0;
constexpr int CW_BAR = 1024;
constexpr int LDS_STAGE = 143360;
constexpr int LDS_MISC = LDS_STAGE;
constexpr int LDS_BYTES = 147456;
constexpr int MI_BAR = 0, MI_TPFX = 16, MI_CNT = 64, MI_FLAG = 128, MI_LCNT = 160, MI_BASE = 192, MI_RSTD = 256;

typedef GAS unsigned gu32;
#define RLX_AGENT __ATOMIC_RELAXED, __HIP_MEMORY_SCOPE_AGENT

#define XB_TMO      128
#define XB_XCNT(j)  (256  + 64 * (j))
#define XB_XSUB(j)  (1280 + 64 * (j))
#define XB_XGEN(j)  (2304 + 64 * (j))
#define XB_TOP      3328
#define XB_TOPGEN   3392
#define XCD_BAR_WORDS 3456
#define XB_SPIN_CAP (1u << 18)
__device__ __forceinline__ unsigned xb_ld(unsigned* p)              { return __hip_atomic_load(p, __ATOMIC_RELAXED, __HIP_MEMORY_SCOPE_AGENT); }
__device__ __forceinline__ unsigned xb_add(unsigned* p, unsigned v) { return __hip_atomic_fetch_add(p, v, __ATOMIC_RELAXED, __HIP_MEMORY_SCOPE_AGENT); }
__device__ __forceinline__ unsigned xb_xcc_id() { return (unsigned)__builtin_amdgcn_s_getreg((3 << 11) | 20) & 0xFu; }
#define XB_SPIN(cond, bar) do { unsigned _sp = 0; while (cond) { __builtin_amdgcn_s_sleep(1); \
    if ((++_sp & 255u) == 0u) { if (xb_ld(&(bar)[XB_TMO])) break; if (_sp > XB_SPIN_CAP) { atomicAdd(&(bar)[XB_TMO], 1u); break; } } } } while (0)
struct XcdBarrier { unsigned* bar; unsigned x; volatile LAS unsigned* st; };
__device__ __forceinline__ XcdBarrier xcd_barrier_post(unsigned* bar, volatile LAS unsigned* st) {
    XcdBarrier b; b.bar = bar; b.x = xb_xcc_id(); b.st = st;
    if (threadIdx.x == 0) (void)xb_add(&bar[XB_XCNT(b.x)], 1u);
    return b;
}
__device__ __forceinline__ void xcd_barrier_complete(unsigned* bar, unsigned x, unsigned& nloc, unsigned& nx) {
    const unsigned G = gridDim.x * gridDim.y * gridDim.z;
    unsigned sum, cnt, mine, sp = 0u;
    for (;;) {
        sum = 0u; cnt = 0u; mine = 0u;
#pragma unroll
        for (unsigned j = 0; j < 16; ++j) { const unsigned c = xb_ld(&bar[XB_XCNT(j)]); sum += c; cnt += (c > 0u) ? 1u : 0u; mine = (j == x) ? c : mine; }
        if (sum == G) break;
        __builtin_amdgcn_s_sleep(1);
        if ((++sp & 255u) == 0u) { if (xb_ld(&bar[XB_TMO])) break; if (sp > XB_SPIN_CAP) { atomicAdd(&bar[XB_TMO], 1u); break; } }
    }
    nloc = mine > 0u ? mine : 1u; nx = cnt > 0u ? cnt : 1u;
}
__device__ __forceinline__ void xcd_barrier(const XcdBarrier& b) {
    asm volatile("s_waitcnt vmcnt(0)" ::: "memory");
    __syncthreads();
    if (threadIdx.x == 0) {
        unsigned* bar = b.bar;
        __builtin_amdgcn_s_waitcnt(0);
        unsigned nloc = b.st[0], nx = b.st[1];
        if (nloc == 0u) { xcd_barrier_complete(bar, b.x, nloc, nx); b.st[0] = nloc; b.st[1] = nx; }
        const unsigned old = xb_add(&bar[XB_XSUB(b.x)], 1u);
        const unsigned gen = old / nloc;
        if (old + 1u == (gen + 1u) * nloc) {
            __builtin_amdgcn_fence(__ATOMIC_RELEASE, "agent");
            asm volatile("s_waitcnt vmcnt(0)" ::: "memory");
            const unsigned og = xb_add(&bar[XB_TOP], 1u);
            const unsigned tg = og / nx;
            if (og + 1u == (tg + 1u) * nx) xb_add(&bar[XB_TOPGEN], 1u);
            else XB_SPIN(xb_ld(&bar[XB_TOPGEN]) == tg, bar);
            __builtin_amdgcn_fence(__ATOMIC_ACQUIRE, "agent");
            xb_add(&bar[XB_XGEN(b.x)], 1u);
            asm volatile("s_waitcnt vmcnt(0)" ::: "memory");
        } else {
            XB_SPIN(xb_ld(&bar[XB_XGEN(b.x)]) == gen, bar);
            __builtin_amdgcn_fence(__ATOMIC_ACQUIRE, "agent");
            asm volatile("s_waitcnt vmcnt(0)" ::: "memory");
        }
    }
    __syncthreads();
}

struct Args {
    const float* in[20]; float* out; unsigned char* ws;
    int ph_lo, ph_hi;
};

struct Frame {
    LAS unsigned char* lds; volatile LAS unsigned* MISC;
    int tid, lane, wave, vcu, G;
    unsigned char* ws;
};

__device__ __forceinline__ void p0_transpose_item(const float* W, int K, int N, bf16_t* WT, LAS float* scr, int item, int lane, const float* gk, float cs, int csn) {
    const int nblk = N / 32, kb = item / nblk, nb = item % nblk, k0 = 64 * kb, n0 = 32 * nb;
    const float colsc = (n0 < csn) ? cs : 1.f;
    float tv[32];
#pragma unroll
    for (int i = 0; i < 32; ++i) { const int kk = 2 * i + (lane >> 5); tv[i] = W[(size_t)(k0 + kk) * N + n0 + (lane & 31)]; }
#pragma unroll
    for (int i = 0; i < 32; ++i) { const int kk = 2 * i + (lane >> 5); float v = tv[i] * colsc; if (gk) v *= gk[k0 + kk]; scr[kk * 33 + (lane & 31)] = v; }
    asm volatile("s_waitcnt lgkmcnt(0)" ::: "memory");
    const int c = lane & 7;
#pragma unroll
    for (int j = 0; j < 4; ++j) { const int n = (lane >> 3) + 8 * j; const LAS float* s = scr + (8 * c) * 33 + n;
        u32x4 o; o.x = cvtpk(s[0 * 33], s[1 * 33]); o.y = cvtpk(s[2 * 33], s[3 * 33]); o.z = cvtpk(s[4 * 33], s[5 * 33]); o.w = cvtpk(s[6 * 33], s[7 * 33]);
        *(u32x4*)(WT + (size_t)(n0 + n) * K + k0 + 8 * c) = o; }
    asm volatile("s_waitcnt lgkmcnt(0)" ::: "memory");
}
__device__ __forceinline__ void p0_transpose_item_fp8(const float* W, int K, int N, unsigned char* WT, LAS float* scr, int item, int lane, float cs) {
    const int nblk = N / 32, kb = item / nblk, nb = item % nblk, k0 = 64 * kb, n0 = 32 * nb;
    float tv[32];
#pragma unroll
    for (int i = 0; i < 32; ++i) { const int kk = 2 * i + (lane >> 5); tv[i] = W[(size_t)(k0 + kk) * N + n0 + (lane & 31)]; }
#pragma unroll
    for (int i = 0; i < 32; ++i) { const int kk = 2 * i + (lane >> 5); scr[kk * 33 + (lane & 31)] = tv[i] * cs; }
    asm volatile("s_waitcnt lgkmcnt(0)" ::: "memory");
    const int c = lane & 7;
#pragma unroll
    for (int j = 0; j < 4; ++j) { const int n = (lane >> 3) + 8 * j; const LAS float* s = scr + (8 * c) * 33 + n;
        u32x2 o; o.x = pk_fp8x4(s[0 * 33], s[1 * 33], s[2 * 33], s[3 * 33]); o.y = pk_fp8x4(s[4 * 33], s[5 * 33], s[6 * 33], s[7 * 33]);
        *(u32x2*)(WT + (size_t)(n0 + n) * K + k0 + 8 * c) = o; }
    asm volatile("s_waitcnt lgkmcnt(0)" ::: "memory");
}
__device__ __forceinline__ void rms_row_to_bf16(const float* xrow, const float* g, bf16_t* orow, int lane) {
    const f32x4* xr = (const f32x4*)xrow + lane; const f32x4* gr = (const f32x4*)g + lane;
    f32x4 v[4]; float s = 0.f;
#pragma unroll
    for (int j = 0; j < 4; ++j) { v[j] = xr[64 * j]; s += (v[j].x * v[j].x + v[j].y * v[j].y) + (v[j].z * v[j].z + v[j].w * v[j].w); }
    const float rstd = rsqrtf(wave_sum(s) * (1.f / D_) + EPS);
    u32x2* o8 = (u32x2*)orow + lane;
#pragma unroll
    for (int j = 0; j < 4; ++j) { const f32x4 gg = gr[64 * j]; u32x2 w; w.x = cvtpk(v[j].x * rstd * gg.x, v[j].y * rstd * gg.y); w.y = cvtpk(v[j].z * rstd * gg.z, v[j].w * rstd * gg.w); o8[64 * j] = w; }
}
__device__ __forceinline__ void p0_prologue(Frame& F, const Args& a, int do_moe_w, int do_rest) {
    LAS float* scr = (LAS float*)(F.lds + F.wave * 16384);
    const int gw = F.vcu * NWAVES + F.wave, NGW = F.G * NWAVES;
    unsigned char* ws = F.ws;
    const float* w_in = a.in[3]; const float* g_cq = a.in[4]; const float* w_uq = a.in[5]; const float* g_ckv = a.in[6]; const float* w_ukv = a.in[7];
    const float* w_o_sb = a.in[10]; const float* w_o_mla = a.in[11]; const float* w_out = a.in[12]; const float* g_ffn = a.in[13]; const float* w_router = a.in[14];
    const float* w_up = a.in[16]; const float* w_down = a.in[18];
    constexpr int I_IN = (D_ / 64) * (INW / 32), I_UQ = (384 / 64) * (768 / 32), I_UKV = (256 / 64) * (1024 / 32), I_O = (512 / 64) * (1024 / 32), I_OUT = (1024 / 64) * (1024 / 32);
    constexpr int I_UP1 = (1024 / 64) * (2048 / 32), I_DN1 = (1024 / 64) * (1024 / 32);
    if (do_rest) {
        constexpr int NI = I_IN + I_UQ + I_UKV + 2 * I_O + I_OUT;
        for (int it = gw; it < NI; it += NGW) {
            int r = it;
            if (r < I_IN) { p0_transpose_item(w_in, D_, INW, (bf16_t*)(ws + WS_WIN), scr, r, F.lane, nullptr, SB_QSCALE, 512); continue; } r -= I_IN;
            if (r < I_UQ) { p0_transpose_item(w_uq, 384, 768, (bf16_t*)(ws + WS_WUQ), scr, r, F.lane, g_cq, 1.f, 0); continue; } r -= I_UQ;
            if (r < I_UKV) { p0_transpose_item(w_ukv, 256, 1024, (bf16_t*)(ws + WS_WUKV), scr, r, F.lane, g_ckv, 1.f, 0); continue; } r -= I_UKV;
            if (r < I_O) { p0_transpose_item(w_o_sb, 512, 1024, (bf16_t*)(ws + WS_WOSB), scr, r, F.lane, nullptr, 1.f, 0); continue; } r -= I_O;
            if (r < I_O) { p0_transpose_item(w_o_mla, 512, 1024, (bf16_t*)(ws + WS_WOMLA), scr, r, F.lane, nullptr, 1.f, 0); continue; } r -= I_O;
            p0_transpose_item(w_out, 1024, 1024, (bf16_t*)(ws + WS_WOUT), scr, r, F.lane, nullptr, 1.f, 0);
        }
        { const int gt = gw * 64 + F.lane, NGT = NGW * 64;
          u32x4 z = {0u, 0u, 0u, 0u};
          u32x4* pz = (u32x4*)((bf16_t*)(ws + WS_WIN) + (size_t)INW * D_);
          for (int i = gt; i < (INWP - INW) * D_ * 2 / 16; i += NGT) pz[i] = z;
          u32x4* hz = (u32x4*)((unsigned char*)(ws + WS_H2F8) + (size_t)M_ * D_);
          for (int i = gt; i < D_ / 16; i += NGT) hz[i] = z;
          const int* pos = (const int*)a.in[1]; float* rt = (float*)(ws + WS_ROPE);
          for (int i = gt; i < M_ * 16; i += NGT) { const int row = i >> 4, k = i & 15; const float inv = powf(10000.f, -(float)k / 16.f); const float ang = (float)pos[row] * inv; rt[row * 32 + k] = cosf(ang); rt[row * 32 + 16 + k] = sinf(ang); }
          float* wr = (float*)(ws + WS_WR);
          for (int i = gt; i < D_ * NE; i += NGT) wr[i] = w_router[i] * g_ffn[i >> 5];
        }
        for (int m = gw; m < M_; m += NGW) rms_row_to_bf16(a.in[0] + (size_t)m * D_, a.in[2], (bf16_t*)(ws + WS_HB) + (size_t)m * D_, F.lane);
    }
    if (do_moe_w) {
        constexpr int NI = NE * (I_UP1 + I_DN1);
        for (int it = gw; it < NI; it += NGW) {
            int r = it;
            if (r < NE * I_UP1) { const int e = r / I_UP1; p0_transpose_item_fp8(w_up + (size_t)e * D_ * 2 * DFF, D_, 2 * DFF, (unsigned char*)(ws + WS_WUP) + (size_t)e * 2 * DFF * D_, scr, r % I_UP1, F.lane, W8_SCALE); continue; }
            r -= NE * I_UP1;
            { const int e = r / I_DN1; p0_transpose_item_fp8(w_down + (size_t)e * DFF * D_, DFF, D_, (unsigned char*)(ws + WS_WDN) + (size_t)e * D_ * DFF, scr, r % I_DN1, F.lane, W8_SCALE); }
        }
    }
}

__device__ __forceinline__ void ld16bf(const bf16_t* p, float (&v)[16]) {
    const u32x4 a = *(const u32x4*)p, b = *(const u32x4*)(p + 8);
    v[0] = bflo(a.x); v[1] = bfhi(a.x); v[2] = bflo(a.y); v[3] = bfhi(a.y); v[4] = bflo(a.z); v[5] = bfhi(a.z); v[6] = bflo(a.w); v[7] = bfhi(a.w);
    v[8] = bflo(b.x); v[9] = bfhi(b.x); v[10] = bflo(b.y); v[11] = bfhi(b.y); v[12] = bflo(b.z); v[13] = bfhi(b.z); v[14] = bflo(b.w); v[15] = bfhi(b.w);
}
__device__ __forceinline__ void st16bf(bf16_t* p, const float (&v)[16]) {
    u32x4 a, b; a.x = cvtpk(v[0], v[1]); a.y = cvtpk(v[2], v[3]); a.z = cvtpk(v[4], v[5]); a.w = cvtpk(v[6], v[7]);
    b.x = cvtpk(v[8], v[9]); b.y = cvtpk(v[10], v[11]); b.z = cvtpk(v[12], v[13]); b.w = cvtpk(v[14], v[15]);
    *(u32x4*)p = a; *(u32x4*)(p + 8) = b;
}
struct PrepIn { unsigned cq0, cq1, cq2; u32x2 ckv; u32x4 qa, qb, ka, kb, vv; float rope; };
__device__ __forceinline__ void p4_load(PrepIn& in, int row, const bf16_t* proj, const bf16_t* qraw, const bf16_t* kvraw, const float* rope, int lane) {
    const int h = lane >> 3, s = lane & 7;
    const bf16_t* pr = proj + (size_t)row * INWP;
    { const bf16_t* p = pr + C_CQ + lane * 6; in.cq0 = *(const unsigned*)p; in.cq1 = *(const unsigned*)(p + 2); in.cq2 = *(const unsigned*)(p + 4); }
    in.ckv = *(const u32x2*)(pr + C_CKV + lane * 4);
    in.rope = rope[(size_t)row * 32 + (lane & 31)];
    const u32x4 z = {0u, 0u, 0u, 0u};
    in.qa = z; in.qb = z; in.ka = z; in.kb = z;
    if (s < 6) { const bf16_t* q = qraw + (size_t)row * 768 + h * 96 + s * 16; in.qa = *(const u32x4*)q; in.qb = *(const u32x4*)(q + 8);
        const bf16_t* k = (s < 4) ? (kvraw + (size_t)row * 1024 + h * 128 + s * 16) : (pr + C_KR + (s - 4) * 16); in.ka = *(const u32x4*)k; in.kb = *(const u32x4*)(k + 8); }
    in.vv = *(const u32x4*)(kvraw + (size_t)row * 1024 + (lane >> 3) * 128 + 64 + (lane & 7) * 8);
}
__device__ __forceinline__ void unpack16(const u32x4 a, const u32x4 b, float (&v)[16]) {
    v[0] = bflo(a.x); v[1] = bfhi(a.x); v[2] = bflo(a.y); v[3] = bfhi(a.y); v[4] = bflo(a.z); v[5] = bfhi(a.z); v[6] = bflo(a.w); v[7] = bfhi(a.w);
    v[8] = bflo(b.x); v[9] = bfhi(b.x); v[10] = bflo(b.y); v[11] = bfhi(b.y); v[12] = bflo(b.z); v[13] = bfhi(b.z); v[14] = bflo(b.w); v[15] = bfhi(b.w);
}
__device__ __forceinline__ void p4_prep(Frame& F, const Args& a) {
    unsigned char* ws = F.ws;
    const bf16_t* proj = (const bf16_t*)(ws + WS_PROJ); const bf16_t* qraw = (const bf16_t*)(ws + WS_QRAW); const bf16_t* kvraw = (const bf16_t*)(ws + WS_KVRAW);
    bf16_t* QB = (bf16_t*)(ws + WS_QB); bf16_t* KB = (bf16_t*)(ws + WS_KB); bf16_t* VB = (bf16_t*)(ws + WS_VB);
    const float* rope = (const float*)(ws + WS_ROPE); const float* gq = a.in[8]; const float* gk = a.in[9];
    const int gw = F.vcu * NWAVES + F.wave, NGW = F.G * NWAVES, lane = F.lane, h = lane >> 3, s = lane & 7;
    float gqv[16], gkv[16];
#pragma unroll
    for (int j = 0; j < 16; ++j) { gqv[j] = (s < 6) ? gq[s * 16 + j] : 0.f; gkv[j] = (s < 6) ? gk[s * 16 + j] : 0.f; }
    PrepIn cur, nxt;
    if (gw < M_) p4_load(cur, gw, proj, qraw, kvraw, rope, lane);
    for (int row = gw; row < M_; row += NGW) {
        const bool hn = row + NGW < M_;
        if (hn) p4_load(nxt, row + NGW, proj, qraw, kvraw, rope, lane);
        float sq = bflo(cur.cq0) * bflo(cur.cq0) + bfhi(cur.cq0) * bfhi(cur.cq0) + bflo(cur.cq1) * bflo(cur.cq1) + bfhi(cur.cq1) * bfhi(cur.cq1) + bflo(cur.cq2) * bflo(cur.cq2) + bfhi(cur.cq2) * bfhi(cur.cq2);
        float skv = bflo(cur.ckv.x) * bflo(cur.ckv.x) + bfhi(cur.ckv.x) * bfhi(cur.ckv.x) + bflo(cur.ckv.y) * bflo(cur.ckv.y) + bfhi(cur.ckv.y) * bfhi(cur.ckv.y);
        sq = wave_sum(sq); skv = wave_sum(skv);
        const float var_cq = sq * (1.f / 384.f) + EPS;
        const float rstd_ckv = rsqrtf(skv * (1.f / 256.f) + EPS);
        float cs[16], sn[16];
#pragma unroll
        for (int j = 0; j < 16; ++j) { cs[j] = __int_as_float(__builtin_amdgcn_readlane(__float_as_int(cur.rope), j)); sn[j] = __int_as_float(__builtin_amdgcn_readlane(__float_as_int(cur.rope), 16 + j)); }
        {
            float v[16]; unpack16(cur.qa, cur.qb, v);
            float ss = 0.f;
#pragma unroll
            for (int j = 0; j < 16; ++j) ss += v[j] * v[j];
            ss += __shfl_xor(ss, 1); ss += __shfl_xor(ss, 2); ss += __shfl_xor(ss, 4);
            const float r = rsqrtf(ss * (1.f / 96.f) + EPS * var_cq);
#pragma unroll
            for (int j = 0; j < 16; ++j) v[j] = v[j] * r * gqv[j];
            float o[16];
#pragma unroll
            for (int j = 0; j < 16; ++j) { const float pv = __shfl_xor(v[j], 1);
                o[j] = (s == 4) ? (v[j] * cs[j] - pv * sn[j]) : (s == 5) ? (v[j] * cs[j] + pv * sn[j]) : v[j]; o[j] *= MLA_QSCALE; }
            if (s < 6) st16bf(QB + (size_t)row * 768 + h * 96 + s * 16, o);
        }
        {
            float v[16]; unpack16(cur.ka, cur.kb, v);
            if (s < 4) {
#pragma unroll
                for (int j = 0; j < 16; ++j) v[j] *= rstd_ckv; }
            float ss = 0.f;
#pragma unroll
            for (int j = 0; j < 16; ++j) ss += v[j] * v[j];
            ss += __shfl_xor(ss, 1); ss += __shfl_xor(ss, 2); ss += __shfl_xor(ss, 4);
            const float r = rsqrtf(ss * (1.f / 96.f) + EPS);
#pragma unroll
            for (int j = 0; j < 16; ++j) v[j] = v[j] * r * gkv[j];
            float o[16];
#pragma unroll
            for (int j = 0; j < 16; ++j) { const float pv = __shfl_xor(v[j], 1);
                o[j] = (s == 4) ? (v[j] * cs[j] - pv * sn[j]) : (s == 5) ? (v[j] * cs[j] + pv * sn[j]) : v[j]; }
            if (s < 6) st16bf(KB + (size_t)row * 768 + h * 96 + s * 16, o);
            const u32x4 vw = cur.vv;
            u32x4 ow; ow.x = cvtpk(bflo(vw.x) * rstd_ckv, bfhi(vw.x) * rstd_ckv); ow.y = cvtpk(bflo(vw.y) * rstd_ckv, bfhi(vw.y) * rstd_ckv);
            ow.z = cvtpk(bflo(vw.z) * rstd_ckv, bfhi(vw.z) * rstd_ckv); ow.w = cvtpk(bflo(vw.w) * rstd_ckv, bfhi(vw.w) * rstd_ckv);
            *(u32x4*)(VB + (size_t)row * 512 + lane * 8) = ow;
        }
        if (hn) cur = nxt;
    }
}
namespace att {
constexpr int BUFB = 20480;
constexpr int WREG = 8448;
constexpr int OST_OFF = 2 * BUFB;
constexpr int WSF_OFF = OST_OFF + 8 * WREG;
constexpr int FLG_OFF = WSF_OFF + 8 * 256;
__device__ __forceinline__ int crow(int r, int hi) { return (r & 3) + 8 * (r >> 2) + 4 * hi; }
__device__ __forceinline__ s16x4 vtr(const LAS char* p) { typedef short v4i16_t __attribute__((ext_vector_type(4))); return __builtin_bit_cast(s16x4, __builtin_amdgcn_ds_read_tr16_b64_v4i16((LAS v4i16_t*)p)); }
#define ATT_MFMA(a, b, c) __builtin_amdgcn_mfma_f32_32x32x16_bf16((a), (b), (c), 0, 0, 0)

template <int NCH> struct Stage {
    u32x4 k0, k1, v0;
    __device__ __forceinline__ void load(const bf16_t* Kb, int pitchK, const bf16_t* Vb, int pitchV, int key0, int wid, int lane) {
        k0 = *(const u32x4*)(Kb + (size_t)(key0 + lane) * pitchK + wid * 8);
        if (NCH > 8) { if (wid < NCH - 8) k1 = *(const u32x4*)(Kb + (size_t)(key0 + lane) * pitchK + (8 + wid) * 8); }
        v0 = *(const u32x4*)(Vb + (size_t)(key0 + 16 * (wid & 3) + (lane >> 2)) * pitchV + (wid >> 2) * 32 + (lane & 3) * 8);
    }
    __device__ __forceinline__ void write(LAS unsigned char* buf, int wid, int lane) const {
        *(LAS u32x4*)(buf + wid * 1024 + lane * 16) = k0;
        if (NCH > 8) { if (wid < NCH - 8) *(LAS u32x4*)(buf + (8 + wid) * 1024 + lane * 16) = k1; }
        *(LAS u32x4*)(buf + NCH * 1024 + wid * 1024 + lane * 16) = v0;
    }
};

__device__ __forceinline__ void pv_tile(f32x16 (&o)[2], const LAS char* vp, const bf16x8 (&pa)[4]) {
#pragma unroll
    for (int d0 = 0; d0 < 2; ++d0)
#pragma unroll
        for (int ks = 0; ks < 4; ++ks) {
            const s16x4 lo = vtr(vp + d0 * 4096 + ks * 1024), hi = vtr(vp + d0 * 4096 + ks * 1024 + 512);
            const bf16x8 vf = __builtin_shufflevector(lo, hi, 0, 1, 2, 3, 4, 5, 6, 7);
            o[d0] = ATT_MFMA(pa[ks], vf, o[d0]);
        }
}
__device__ __forceinline__ bf16x8 pack8(const f32x16& p, int base) {
    u32x4 w; w.x = cvtpk(p[base], p[base + 1]); w.y = cvtpk(p[base + 2], p[base + 3]); w.z = cvtpk(p[base + 4], p[base + 5]); w.w = cvtpk(p[base + 6], p[base + 7]);
    return __builtin_bit_cast(bf16x8, w);
}
__device__ __forceinline__ void store_o(const f32x16 (&o)[2], const float (&rs)[16], LAS unsigned char* lds, int wid, int lane, bf16_t* Ow) {
    const int r32 = lane & 31, hi = lane >> 5;
    LAS bf16_t* stg = (LAS bf16_t*)(lds + OST_OFF + wid * WREG);
#pragma unroll
    for (int r = 0; r < 16; ++r) { const int orow = crow(r, hi);
#pragma unroll
        for (int d0 = 0; d0 < 2; ++d0) { const unsigned w = cvtpk(o[d0][r] * rs[r], 0.f); stg[orow * 64 + d0 * 32 + r32] = (bf16_t)(w & 0xffffu); } }
    asm volatile("s_waitcnt lgkmcnt(0)" ::: "memory");
#pragma unroll
    for (int i = 0; i < 4; ++i) { const int row = i * 8 + (lane >> 3), ch = lane & 7; const u32x4 v = *(const LAS u32x4*)(stg + row * 64 + ch * 8); *(u32x4*)(Ow + (size_t)row * 512 + ch * 8) = v; }
    asm volatile("s_waitcnt lgkmcnt(0)" ::: "memory");
}


struct Conv {
    const float* w_up; const float* w_down; unsigned char* up8; unsigned char* dn8; int item, step, ctr; bool inflight; float tv[32];
    static constexpr int I_UP1 = (D_ / 64) * (2 * DFF / 32), I_DN1 = (DFF / 64) * (D_ / 32), NI = NE * (I_UP1 + I_DN1);
    const float* src; unsigned char* dst; int K, N;
    __device__ __forceinline__ bool pending() const { return item < NI; }
    __device__ __forceinline__ void load(int lane) {
        int r = item;
        if (r < NE * I_UP1) { const int e = r / I_UP1; r %= I_UP1; K = D_; N = 2 * DFF; const int nblk = N / 32, kb = r / nblk, nb = r % nblk; src = w_up + (size_t)e * D_ * 2 * DFF + (size_t)(64 * kb) * N + 32 * nb; dst = up8 + (size_t)e * 2 * DFF * D_ + (size_t)(32 * nb) * K + 64 * kb; }
        else { r -= NE * I_UP1; const int e = r / I_DN1; r %= I_DN1; K = DFF; N = D_; const int nblk = N / 32, kb = r / nblk, nb = r % nblk; src = w_down + (size_t)e * DFF * D_ + (size_t)(64 * kb) * N + 32 * nb; dst = dn8 + (size_t)e * D_ * DFF + (size_t)(32 * nb) * K + 64 * kb; }
#pragma unroll
        for (int i = 0; i < 32; ++i) { const int kk = 2 * i + (lane >> 5); tv[i] = src[(size_t)kk * N + (lane & 31)]; }
    }
    __device__ __forceinline__ void finish(LAS float* scr, int lane) {
#pragma unroll
        for (int i = 0; i < 32; ++i) { const int kk = 2 * i + (lane >> 5); scr[kk * 33 + (lane & 31)] = tv[i] * W8_SCALE; }
        asm volatile("s_waitcnt lgkmcnt(0)" ::: "memory");
        const int cc = lane & 7;
#pragma unroll
        for (int j = 0; j < 4; ++j) { const int n = (lane >> 3) + 8 * j; const LAS float* s = scr + (8 * cc) * 33 + n;
            u32x2 o; o.x = pk_fp8x4(s[0 * 33], s[1 * 33], s[2 * 33], s[3 * 33]); o.y = pk_fp8x4(s[4 * 33], s[5 * 33], s[6 * 33], s[7 * 33]);
            *(u32x2*)(dst + (size_t)n * K + 8 * cc) = o; }
        asm volatile("s_waitcnt lgkmcnt(0)" ::: "memory");
        item += step;
    }
    __device__ __forceinline__ void tick_begin(int lane) { if (!inflight && ctr == 0 && pending()) { load(lane); inflight = true; } }
    __device__ __forceinline__ void tick_end(LAS float* scr, int lane) { if (inflight && ctr == 2) { finish(scr, lane); inflight = false; } ctr = (ctr == 2) ? 0 : ctr + 1; }
    __device__ __forceinline__ void drain(LAS float* scr, int lane) { if (inflight) { finish(scr, lane); inflight = false; } while (pending()) { load(lane); finish(scr, lane); } }
};
__device__ __forceinline__ void mla_unit(LAS unsigned char* lds, int b, int h, int qb, const bf16_t* QB, const bf16_t* KB, const bf16_t* VB, bf16_t* O, float m0, Conv& cv) {
    const int tid = threadIdx.x, lane = tid & 63, r32 = lane & 31, hi = lane >> 5; const int wid = __builtin_amdgcn_readfirstlane(tid >> 6);
    const size_t rb = (size_t)b * S_; const int q0 = qb * 256;
    const bf16_t* Kh = KB + rb * 768 + h * 96; const bf16_t* Vh = VB + rb * 512 + h * 64;
    bf16x8 qr[6];
    { const bf16_t* qp = QB + (rb + q0 + wid * 32 + r32) * 768 + h * 96 + hi * 8;
#pragma unroll
      for (int d0 = 0; d0 < 6; ++d0) qr[d0] = *(const bf16x8*)(qp + d0 * 16); }
    const int NT = 4 * qb + 4, my_last = 4 * qb + (wid >> 1);
    f32x16 o[2]; float l = 0.f;
#pragma unroll
    for (int r = 0; r < 16; ++r) { o[0][r] = 0.f; o[1][r] = 0.f; }
    Stage<12> st;
    st.load(Kh, 768, Vh, 512, 0, wid, lane); st.write(lds, wid, lane);
    __syncthreads();
    LAS float* cscr = (LAS float*)(lds + OST_OFF + wid * WREG);
    for (int t = 0; t < NT; ++t) {
        if (t + 1 < NT) st.load(Kh, 768, Vh, 512, (t + 1) * 64, wid, lane);
        asm volatile("" ::: "memory");
        cv.tick_begin(lane);
        if (t <= my_last) {
            const LAS char* buf = (const LAS char*)(lds + (t & 1) * BUFB);
            const LAS char* kp = buf + hi * 1024 + r32 * 16;
            f32x16 p0, p1;
#pragma unroll
            for (int r = 0; r < 16; ++r) { p0[r] = -m0; p1[r] = -m0; }
#pragma unroll
            for (int d0 = 0; d0 < 6; ++d0) { const bf16x8 a0 = *(const LAS bf16x8*)(kp + d0 * 2048), a1 = *(const LAS bf16x8*)(kp + d0 * 2048 + 512);
                p0 = ATT_MFMA(a0, qr[d0], p0); p1 = ATT_MFMA(a1, qr[d0], p1); }
            float ls = 0.f;
#pragma unroll
            for (int r = 0; r < 16; ++r) { p0[r] = __builtin_amdgcn_exp2f(p0[r]); p1[r] = __builtin_amdgcn_exp2f(p1[r]); ls += p0[r] + p1[r]; }
            l += ls;
            bf16x8 pa[4]; pa[0] = pack8(p0, 0); pa[1] = pack8(p0, 8); pa[2] = pack8(p1, 0); pa[3] = pack8(p1, 8);
            const LAS char* vp = buf + 12 * 1024 + ((lane >> 4) & 1) * 32 + (lane & 3) * 8 + (4 * hi + ((lane & 15) >> 2)) * 64;
            pv_tile(o, vp, pa);
        }
        if (t + 1 < NT) st.write(lds + ((t + 1) & 1) * BUFB, wid, lane);
        cv.tick_end(cscr, lane);
        __syncthreads();
    }
    l += __shfl_xor(l, 32);
    LAS float* wsf = (LAS float*)(lds + WSF_OFF) + wid * 64;
    if (hi == 0) wsf[r32] = l;
    asm volatile("s_waitcnt lgkmcnt(0)" ::: "memory");
    float rs[16];
#pragma unroll
    for (int r = 0; r < 16; ++r) rs[r] = __builtin_amdgcn_rcpf(wsf[crow(r, hi)]);
    store_o(o, rs, lds, wid, lane, O + (rb + q0 + wid * 32) * 512 + h * 64);
}

constexpr float SB_THR = -152.f;
__device__ __forceinline__ void sb_unit(LAS unsigned char* lds, int b, int h, int qb, const bf16_t* proj, bf16_t* O) {
    const int tid = threadIdx.x, lane = tid & 63, r32 = lane & 31, hi = lane >> 5; const int wid = __builtin_amdgcn_readfirstlane(tid >> 6);
    const size_t rb = (size_t)b * S_; const int q0 = qb * 256;
    const bf16_t* Kh = proj + rb * INWP + C_SBK + h * 64; const bf16_t* Vh = proj + rb * INWP + C_SBV + h * 64;
    bf16x8 qr[4];
    { const bf16_t* qp = proj + (rb + q0 + wid * 32 + r32) * INWP + C_SBQ + h * 64 + hi * 8;
#pragma unroll
      for (int d0 = 0; d0 < 4; ++d0) qr[d0] = *(const bf16x8*)(qp + d0 * 16); }
    const int Ttop = 4 * qb + 3, qw0 = q0 + wid * 32, qabs = qw0 + r32;
    f32x16 o[2]; float carry = 0.f;
#pragma unroll
    for (int r = 0; r < 16; ++r) { o[0][r] = 0.f; o[1][r] = 0.f; }
    volatile LAS int* flg = (volatile LAS int*)(lds + FLG_OFF);
    Stage<8> st;
    st.load(Kh, INWP, Vh, INWP, Ttop * 64, wid, lane); st.write(lds, wid, lane);
    __syncthreads();
    bool alive = true;
    for (int it = 0;; ++it) {
        const int t = Ttop - it;
        if (t > 0) st.load(Kh, INWP, Vh, INWP, (t - 1) * 64, wid, lane);
        if (alive && (64 * t <= qw0 + 30)) {
            const LAS char* buf = (const LAS char*)(lds + (it & 1) * BUFB);
            const LAS char* kp = buf + hi * 1024 + r32 * 16;
            f32x16 p0, p1;
#pragma unroll
            for (int r = 0; r < 16; ++r) { p0[r] = 0.f; p1[r] = 0.f; }
#pragma unroll
            for (int d0 = 0; d0 < 4; ++d0) { const bf16x8 a0 = *(const LAS bf16x8*)(kp + d0 * 2048), a1 = *(const LAS bf16x8*)(kp + d0 * 2048 + 512);
                p0 = ATT_MFMA(a0, qr[d0], p0); p1 = ATT_MFMA(a1, qr[d0], p1); }
            const bool need_mask = (64 * t + 63 >= qw0);
            const int kb0 = 64 * t + 4 * hi;
            f32x16 s0, s1;
#pragma unroll
            for (int r = 0; r < 16; ++r) {
                const int key = kb0 + (r & 3) + 8 * (r >> 2);
                { const float z = p0[r]; const float e = __builtin_amdgcn_exp2f(-fabsf(z)); const float tt = __builtin_amdgcn_logf(1.f + e); float lsv = fminf(-z, 0.f) - tt;
                  if (need_mask && !(key < qabs)) { lsv = 0.f; p0[r] = -INFINITY; } s0[r] = lsv; }
                { const float z = p1[r]; const float e = __builtin_amdgcn_exp2f(-fabsf(z)); const float tt = __builtin_amdgcn_logf(1.f + e); float lsv = fminf(-z, 0.f) - tt;
                  if (need_mask && !(key + 32 < qabs)) { lsv = 0.f; p1[r] = -INFINITY; } s1[r] = lsv; }
            }
            float T[9]; T[8] = 0.f;
#pragma unroll
            for (int j = 7; j >= 0; --j) { const int i = j & 3; const float qs = (j >= 4) ? ((s1[4 * i] + s1[4 * i + 1]) + (s1[4 * i + 2] + s1[4 * i + 3])) : ((s0[4 * i] + s0[4 * i + 1]) + (s0[4 * i + 2] + s0[4 * i + 3])); T[j] = T[j + 1] + qs; }
            float Tp[9]; Tp[8] = 0.f;
#pragma unroll
            for (int j = 0; j < 8; ++j) Tp[j] = __shfl_xor(T[j], 32);
#pragma unroll
            for (int j = 7; j >= 0; --j) {
                const int i = j & 3;
                float lat = carry + T[j + 1] + (hi ? Tp[j + 1] : Tp[j]);
#pragma unroll
                for (int e3 = 3; e3 >= 0; --e3) {
                    const int r = 4 * i + e3;
                    if (j >= 4) { const float lsv = s1[r]; p1[r] = __builtin_amdgcn_exp2f(lsv + p1[r] + lat); lat += lsv; }
                    else        { const float lsv = s0[r]; p0[r] = __builtin_amdgcn_exp2f(lsv + p0[r] + lat); lat += lsv; }
                }
            }
            carry += T[0] + Tp[0];
            bf16x8 pa[4]; pa[0] = pack8(p0, 0); pa[1] = pack8(p0, 8); pa[2] = pack8(p1, 0); pa[3] = pack8(p1, 8);
            const LAS char* vp = buf + 8 * 1024 + ((lane >> 4) & 1) * 32 + (lane & 3) * 8 + (4 * hi + ((lane & 15) >> 2)) * 64;
            pv_tile(o, vp, pa);
            alive = __any(carry > SB_THR);
        }
        if (lane == 0) flg[(it & 1) * 8 + wid] = alive ? 1 : 0;
        if (t > 0) st.write(lds + ((it + 1) & 1) * BUFB, wid, lane);
        __syncthreads();
        if (t == 0) break;
        int any = 0;
#pragma unroll
        for (int w = 0; w < 8; ++w) any |= flg[(it & 1) * 8 + w];
        if (!any) break;
    }
    float rs[16];
#pragma unroll
    for (int r = 0; r < 16; ++r) rs[r] = 1.f;
    store_o(o, rs, lds, wid, lane, O + (rb + q0 + wid * 32) * 512 + h * 64);
}
}

__device__ __forceinline__ void p5_attention(Frame& F, const Args& a) {
    unsigned char* ws = F.ws;
    float gm;
    { const float* gq = a.in[8]; const float* gk = a.in[9]; float mq = 0.f, mk = 0.f;
      for (int i = F.lane; i < 96; i += 64) { mq = fmaxf(mq, fabsf(gq[i])); mk = fmaxf(mk, fabsf(gk[i])); }
#pragma unroll
      for (int o = 1; o < 64; o <<= 1) { mq = fmaxf(mq, __shfl_xor(mq, o)); mk = fmaxf(mk, __shfl_xor(mk, o)); }
      gm = 9.79795897f * LOG2E * mq * mk; }
    att::Conv cv; cv.w_up = a.in[16]; cv.w_down = a.in[18]; cv.up8 = (unsigned char*)(ws + WS_WUP); cv.dn8 = (unsigned char*)(ws + WS_WDN);
    cv.item = F.vcu * NWAVES + F.wave; cv.step = F.G * NWAVES; cv.ctr = 0; cv.inflight = false;
    for (int v = F.vcu; v < 256; v += F.G) {
        const int bh = v >> 3, s = v & 7, b = bh >> 3, h = bh & 7;
        for (int i = 0; i < 2; ++i) { const int qb = i ? 15 - s : s;
            att::mla_unit(F.lds, b, h, qb, (const bf16_t*)(ws + WS_QB), (const bf16_t*)(ws + WS_KB), (const bf16_t*)(ws + WS_VB), (bf16_t*)(ws + WS_OMLA), gm, cv);
            __syncthreads(); }
        for (int i = 0; i < 2; ++i) { const int qb = i ? 15 - s : s;
            att::sb_unit(F.lds, b, h, qb, (const bf16_t*)(ws + WS_PROJ), (bf16_t*)(ws + WS_OSB));
            __syncthreads(); }
    }
    { LAS float* cscr = (LAS float*)(F.lds + att::OST_OFF + F.wave * att::WREG);
      cv.drain(cscr, F.lane); }
}

__device__ __forceinline__ void p8_router(Frame& F, const Args& a) {
    unsigned char* ws = F.ws;
    const float* x1 = a.out; const float* wr = (const float*)(ws + WS_WR); const float* br = a.in[15]; const float* g = a.in[13];
    unsigned char* H2 = (unsigned char*)(ws + WS_H2F8); int* list = (int*)(ws + WS_LIST); float* topw = (float*)(ws + WS_TOPW); int* selo = (int*)(ws + WS_SEL);
    int* cnt = (int*)(ws + WS_CTL) + CW_CNT;
    volatile LAS int* lcnt = (volatile LAS int*)(F.MISC + MI_LCNT); volatile LAS int* lbase = (volatile LAS int*)(F.MISC + MI_BASE);
    const int lane = F.lane, wave = F.wave, tid = F.tid;
    constexpr int WST = 1028;
    LAS float* wt = (LAS float*)F.lds;
    if (F.vcu < M_ / 64) {
        for (int i = tid; i < D_ * NE / 4; i += NTHR) { const f32x4 v = *(const f32x4*)(wr + (size_t)i * 4); const int k = i >> 3, e = (i & 7) * 4;
            wt[(e + 0) * WST + k] = v.x; wt[(e + 1) * WST + k] = v.y; wt[(e + 2) * WST + k] = v.z; wt[(e + 3) * WST + k] = v.w; }
    }
    __syncthreads();
    for (int task = F.vcu; task < M_ / 64; task += F.G) {
        const int T0 = task * 64;
        if (tid < 32) lcnt[tid] = 0;
        __syncthreads();
        int my_e = 0, my_rank = 0; float my_w = 0.f;
        if (wave < 4) {
            const int tk = lane & 15, kp = lane >> 4, tok = T0 + wave * 16 + tk;
            const float* xp = x1 + (size_t)tok * D_ + kp * 256;
            const LAS float* w0 = wt + tk * WST + kp * 256; const LAS float* w1 = w0 + 16 * WST;
            f32x4 acc0 = {0.f, 0.f, 0.f, 0.f}, acc1 = {0.f, 0.f, 0.f, 0.f}; float ssq = 0.f;
#pragma unroll 4
            for (int i = 0; i < 256; i += 4) {
                const f32x4 a4 = *(const f32x4*)(xp + i); const f32x4 b0 = *(const LAS f32x4*)(w0 + i), b1 = *(const LAS f32x4*)(w1 + i);
                ssq += (a4.x * a4.x + a4.y * a4.y) + (a4.z * a4.z + a4.w * a4.w);
#pragma unroll
                for (int j = 0; j < 4; ++j) { acc0 = __builtin_amdgcn_mfma_f32_16x16x4f32(a4[j], b0[j], acc0, 0, 0, 0); acc1 = __builtin_amdgcn_mfma_f32_16x16x4f32(a4[j], b1[j], acc1, 0, 0, 0); }
            }
            ssq += __shfl_xor(ssq, 16); ssq += __shfl_xor(ssq, 32);
            const float rstd = rsqrtf(ssq * (1.f / D_) + EPS);
            const int e0 = lane & 15, grp = lane >> 4;
            const float bia0 = br[e0], bia1 = br[e0 + 16];
#pragma unroll
            for (int j = 0; j < 4; ++j) {
                const float rs = __shfl(rstd, 4 * grp + j);
                float c0 = acc0[j] * rs + bia0, c1 = acc1[j] * rs + bia1;
                float sv[4]; int si[4];
#pragma unroll
                for (int k = 0; k < 4; ++k) {
                    float best = c0; int bi = e0;
                    if (c1 > best) { best = c1; bi = e0 + 16; }
#pragma unroll
                    for (int o = 1; o < 16; o <<= 1) { const float ob = __shfl_xor(best, o); const int oi = __shfl_xor(bi, o); if (ob > best || (ob == best && oi < bi)) { best = ob; bi = oi; } }
                    sv[k] = best; si[k] = bi;
                    if (bi == e0) c0 = -INFINITY; if (bi == e0 + 16) c1 = -INFINITY;
                }
                float ex[4], sum = 0.f;
#pragma unroll
                for (int k = 0; k < 4; ++k) { ex[k] = __expf(sv[k] - sv[0]); sum += ex[k]; }
                const float inv = 1.f / sum;
                if (((lane >> 2) & 3) == j) {
#pragma unroll
                    for (int k = 0; k < 4; ++k) if ((lane & 3) == k) { my_e = si[k]; my_w = ex[k] * inv; }
                }
            }
            my_rank = atomicAdd((int*)&lcnt[my_e], 1);
        } else {
            const f32x4* gr = (const f32x4*)g + lane;
            f32x4 gg[4];
#pragma unroll
            for (int j = 0; j < 4; ++j) gg[j] = gr[64 * j] * X8_SCALE;
            for (int rr = 0; rr < 16; rr += 2) {
                const int t0 = T0 + (wave - 4) * 16 + rr;
                const f32x4* xr0 = (const f32x4*)(x1 + (size_t)t0 * D_) + lane; const f32x4* xr1 = xr0 + D_ / 4;
                f32x4 v0[4], v1[4]; float s0 = 0.f, s1 = 0.f;
#pragma unroll
                for (int j = 0; j < 4; ++j) { v0[j] = xr0[64 * j]; v1[j] = xr1[64 * j]; }
#pragma unroll
                for (int j = 0; j < 4; ++j) { s0 += (v0[j].x * v0[j].x + v0[j].y * v0[j].y) + (v0[j].z * v0[j].z + v0[j].w * v0[j].w); s1 += (v1[j].x * v1[j].x + v1[j].y * v1[j].y) + (v1[j].z * v1[j].z + v1[j].w * v1[j].w); }
                const float r0 = rsqrtf(wave_sum(s0) * (1.f / D_) + EPS), r1 = rsqrtf(wave_sum(s1) * (1.f / D_) + EPS);
                unsigned* o0 = (unsigned*)(H2 + (size_t)t0 * D_) + lane; unsigned* o1 = o0 + D_ / 4;
#pragma unroll
                for (int j = 0; j < 4; ++j) { o0[64 * j] = pk_fp8x4(v0[j].x * r0 * gg[j].x, v0[j].y * r0 * gg[j].y, v0[j].z * r0 * gg[j].z, v0[j].w * r0 * gg[j].w);
                    o1[64 * j] = pk_fp8x4(v1[j].x * r1 * gg[j].x, v1[j].y * r1 * gg[j].y, v1[j].z * r1 * gg[j].z, v1[j].w * r1 * gg[j].w); }
            }
        }
        __syncthreads();
        if (tid < 32) lbase[tid] = lcnt[tid] ? atomicAdd(&cnt[tid], lcnt[tid]) : 0;
        __syncthreads();
        if (wave < 4) {
            const int grp = lane >> 4, jj = (lane >> 2) & 3, kk = lane & 3;
            const int tok = T0 + wave * 16 + 4 * grp + jj, slot = tok * 4 + kk;
            list[(size_t)my_e * M_ + lbase[my_e] + my_rank] = slot;
            topw[slot] = my_w; selo[slot] = my_e;
        }
        __syncthreads();
    }
}

struct MoeOrder {
    const bf16_t* A; const bf16_t* Bt; const int* list; volatile LAS unsigned* tab;
    int lda, ldb, nN, nwg, G, c, gather; size_t estride;
    __device__ void init(const bf16_t* A_, int lda_, const bf16_t* Bt_, int ldb_, size_t estride_, int nN_, const int* list_, volatile LAS unsigned* tab_, int gather_, int G_, int c_) {
        A = A_; lda = lda_; Bt = Bt_; ldb = ldb_; estride = estride_; nN = nN_; list = list_; tab = tab_; gather = gather_; G = G_; c = c_; nwg = (int)tab[MI_TPFX + NE] * nN_; }
    __device__ __forceinline__ bool next(int i, pg8::Unit& u) const {
        const long L = (long)i * G + c; if (L >= nwg) return false;
        int wgid = (int)L; { const int q = nwg / 8, r = nwg % 8, xcd = wgid % 8, off = wgid / 8; wgid = (xcd < r ? xcd * (q + 1) : r * (q + 1) + (xcd - r) * q) + off; }
        int e = 0;
        for (int k = 1; k < NE; ++k) if ((int)tab[MI_TPFX + k] * nN <= wgid) e = k;
        const int t0 = (int)tab[MI_TPFX + e], nt = (int)tab[MI_TPFX + e + 1] - t0, idx = wgid - t0 * nN;
        u.e = e; u.pn = idx / nt; u.rt = idx % nt; u.pm = t0 + u.rt; const int left = (int)tab[MI_CNT + e] - u.rt * 256; u.rows = left < 256 ? left : 256; return true;
    }
    __device__ __forceinline__ unsigned a_off(const pg8::Unit& u, int r, int C) const {
        int row;
        if (gather) row = (r < u.rows) ? (list[(size_t)u.e * M_ + u.rt * 256 + r] >> 2) : M_;
        else row = u.pm * 256 + r;
        return (unsigned)((row * lda + C) * 2);
    }
    __device__ __forceinline__ const char* b_base(const pg8::Unit& u) const { return (const char*)(Bt + (size_t)u.e * estride + (size_t)u.pn * 256 * ldb); }
};
__device__ __forceinline__ void moe_table(Frame& F) {
    int* cnt = (int*)(F.ws + WS_CTL) + CW_CNT;
    if (F.tid < NE) F.MISC[MI_CNT + F.tid] = __hip_atomic_load((unsigned*)cnt + F.tid, RLX_AGENT);
    __syncthreads();
    if (F.tid == 0) { unsigned p = 0; for (int e = 0; e < NE; ++e) { F.MISC[MI_TPFX + e] = p; p += (F.MISC[MI_CNT + e] + 255u) >> 8; } F.MISC[MI_TPFX + NE] = p; }
    __syncthreads();
}

__device__ __forceinline__ void p12_combine(Frame& F, const Args& a) {
    const bf16_t* Y = (const bf16_t*)(F.ws + WS_YB); float* out = a.out;
    const int gt = (F.vcu * NWAVES + F.wave) * 64 + F.lane, NGT = F.G * NTHR;
    for (int i = gt; i < M_ * D_ / 8; i += NGT) {
        const int t = i >> 7, c = (i & 127) * 8;
        f32x4 v0 = *(const f32x4*)(out + (size_t)t * D_ + c), v1 = *(const f32x4*)(out + (size_t)t * D_ + c + 4);
#pragma unroll
        for (int k = 0; k < 4; ++k) { const u32x4 w = *(const u32x4*)(Y + (size_t)(t * 4 + k) * D_ + c);
            v0.x += bflo(w.x); v0.y += bfhi(w.x); v0.z += bflo(w.y); v0.w += bfhi(w.y); v1.x += bflo(w.z); v1.y += bfhi(w.z); v1.z += bflo(w.w); v1.w += bfhi(w.w); }
        *(f32x4*)(out + (size_t)t * D_ + c) = v0; *(f32x4*)(out + (size_t)t * D_ + c + 4) = v1;
    }
}

constexpr int N_PHASES = 11;
#ifndef DUP_PHASE
#define DUP_PHASE -1
#endif
__global__ void __launch_bounds__(NTHR, 2) mega(Args args) {
    extern __shared__ __attribute__((aligned(16))) unsigned char lds_raw[];
    Frame F;
    F.lds = (LAS unsigned char*)lds_raw; F.MISC = (volatile LAS unsigned*)(F.lds + LDS_MISC);
    F.tid = threadIdx.x; F.lane = F.tid & 63; F.wave = __builtin_amdgcn_readfirstlane(F.tid >> 6);
    F.G = gridDim.x; { const int bx = blockIdx.x; F.vcu = (F.G % 8 == 0) ? (bx % 8) * (F.G / 8) + bx / 8 : bx; }
    F.ws = args.ws;
    unsigned char* ws = args.ws;
    for (int u = F.tid; u < (LDS_BYTES - LDS_MISC) / 4; u += NTHR) F.MISC[u] = 0u;
    __syncthreads();
    const int lo = args.ph_lo, hi = args.ph_hi;
    XcdBarrier bar; bar.bar = (unsigned*)(ws + WS_CTL) + CW_BAR; bar.x = 0; bar.st = nullptr;
    if (hi - lo > 1) bar = xcd_barrier_post((unsigned*)(ws + WS_CTL) + CW_BAR, F.MISC + MI_BAR);
#define IN(k) (lo <= (k) && (k) < hi)
#define SEAM(k) do { if (IN(k) && IN((k) + 1)) xcd_barrier(bar); } while (0)
    const int cid = (int)blockIdx.x;

    if (IN(0)) { p0_prologue(F, args, 0, 1); SEAM(0); }
    if (IN(1)) {
        pg8::Gemm g{(const bf16_t*)(ws + WS_HB), D_, D_, D_};
        pg8::StaticOrder S; S.init(g.A, D_, (const bf16_t*)(ws + WS_WIN), D_, M_, INWP, F.G, cid);
        pg8::EpiBf16 E{(bf16_t*)(ws + WS_PROJ), INWP};
        pg8::gemm_phase(F.lds, g, S, E);
        SEAM(1);
    }
    if (IN(2)) {
        { pg8::Gemm g{(const bf16_t*)(ws + WS_PROJ) + C_CQ, INWP, 384, 384};
          pg8::StaticOrder S; S.init(g.A, INWP, (const bf16_t*)(ws + WS_WUQ), 384, M_, 768, F.G, cid);
          pg8::EpiBf16 E{(bf16_t*)(ws + WS_QRAW), 768};
          pg8::gemm_phase(F.lds, g, S, E); }
        { pg8::Gemm g{(const bf16_t*)(ws + WS_PROJ) + C_CKV, INWP, 256, 256};
          pg8::StaticOrder S; S.init(g.A, INWP, (const bf16_t*)(ws + WS_WUKV), 256, M_, 1024, F.G, cid);
          pg8::EpiBf16 E{(bf16_t*)(ws + WS_KVRAW), 1024};
          pg8::gemm_phase(F.lds, g, S, E); }
        SEAM(2);
    }
    if (IN(3)) { p4_prep(F, args); SEAM(3); }
    if (IN(4)) { p5_attention(F, args); SEAM(4); }
    if (IN(5)) {
        { pg8::Gemm g{(const bf16_t*)(ws + WS_OSB), 512, 512, 512};
          pg8::StaticOrder S; S.init(g.A, 512, (const bf16_t*)(ws + WS_WOSB), 512, M_, D_, F.G, cid);
          pg8::EpiGate<true> E{(bf16_t*)(ws + WS_MIX), (const bf16_t*)(ws + WS_PROJ), INWP, C_GSB};
          pg8::gemm_phase(F.lds, g, S, E); }
        { pg8::Gemm g{(const bf16_t*)(ws + WS_OMLA), 512, 512, 512};
          pg8::StaticOrder S; S.init(g.A, 512, (const bf16_t*)(ws + WS_WOMLA), 512, M_, D_, F.G, cid);
          pg8::EpiGate<false> E{(bf16_t*)(ws + WS_MIX), (const bf16_t*)(ws + WS_PROJ), INWP, C_GMLA};
          pg8::gemm_phase(F.lds, g, S, E); }
        SEAM(5);
    }
    if (IN(6)) {
        pg8::Gemm g{(const bf16_t*)(ws + WS_MIX), D_, D_, D_};
        pg8::StaticOrder S; S.init(g.A, D_, (const bf16_t*)(ws + WS_WOUT), D_, M_, D_, F.G, cid);
        pg8::EpiRes E{args.in[0], args.out};
        pg8::gemm_phase(F.lds, g, S, E);
        SEAM(6);
    }
    if (IN(7)) { p8_router(F, args); SEAM(7); }
    if (IN(8)) {
        moe_table(F);
        pg8::Gemm g{(const bf16_t*)(ws + WS_H2F8), D_ / 2, D_ / 2, D_ / 2};
        MoeOrder S; S.init(g.A, D_ / 2, (const bf16_t*)(ws + WS_WUP), D_ / 2, (size_t)2 * DFF * D_ / 2, 8, (const int*)(ws + WS_LIST), F.MISC, 1, F.G, cid);
        pg8::EpiSwiglu8 E{(unsigned char*)(ws + WS_ACT), args.in[17]};
        pg8::gemm_phase<pg8::EpiSwiglu8, MoeOrder, true>(F.lds, g, S, E);
        SEAM(8);
    }
    if (IN(9)) {
        moe_table(F);
        pg8::Gemm g{(const bf16_t*)(ws + WS_ACT), DFF / 2, DFF / 2, DFF / 2};
        MoeOrder S; S.init(g.A, DFF / 2, (const bf16_t*)(ws + WS_WDN), DFF / 2, (size_t)D_ * DFF / 2, 4, (const int*)(ws + WS_LIST), F.MISC, 0, F.G, cid);
        pg8::EpiDown E{(bf16_t*)(ws + WS_YB), args.in[19], (const int*)(ws + WS_LIST), (const float*)(ws + WS_TOPW)};
        pg8::gemm_phase<pg8::EpiDown, MoeOrder, true>(F.lds, g, S, E);
        SEAM(9);
    }
    if (IN(10)) { p12_combine(F, args); }
#undef IN
#undef SEAM
}
static int g_grid = 0;
static int setup_grid() {
    if (g_grid == 0) {
        int dev = 0, cus = 0;
        if (hipGetDevice(&dev) != hipSuccess || hipDeviceGetAttribute(&cus, hipDeviceAttributeMultiprocessorCount, dev) != hipSuccess) { g_grid = -1; return g_grid; }
        if (hipFuncSetAttribute((const void*)mega, hipFuncAttributeMaxDynamicSharedMemorySize, LDS_BYTES) != hipSuccess) { g_grid = -1; return g_grid; }
        int per_cu = 0;
        (void)hipOccupancyMaxActiveBlocksPerMultiprocessor(&per_cu, (const void*)mega, NTHR, LDS_BYTES);
        (void)hipGetLastError();
        g_grid = cus;
    }
    return g_grid;
}
static void launch_mega(void* const* d_in, void* d_out, void* d_ws, int lo, int hi, hipStream_t stream) {
    Args a; memset(&a, 0, sizeof(a));
    for (int i = 0; i < 20; ++i) a.in[i] = (const float*)d_in[i];
    a.out = (float*)d_out; a.ws = (unsigned char*)d_ws; a.ph_lo = lo; a.ph_hi = hi;
    hipLaunchKernelGGL(mega, dim3(g_grid), dim3(NTHR), LDS_BYTES, stream, a);
}
extern "C" void kernel_launch(void* const* d_in, const int* in_sizes, int n_in, void* d_out, int out_size, void* d_ws, size_t ws_size, hipStream_t stream) {
    if (n_in != 20 || ws_size < WS_OPT_END || out_size != M_ * D_) { fprintf(stderr, "kernel_launch: unexpected arguments\n"); return; }
    if (setup_grid() <= 0) return;
    (void)hipMemsetAsync((char*)d_ws + WS_CTL, 0, CTL_ZERO_BYTES, stream);
#if N_LAUNCH_SPLIT
    for (int p = 0; p < N_PHASES; ++p) { launch_mega(d_in, d_out, d_ws, p, p + 1, stream); if (p == DUP_PHASE) { if (p == 7) (void)hipMemsetAsync((char*)d_ws + WS_CTL, 0, 128, stream); if (p == 10) launch_mega(d_in, d_out, d_ws, 6, 7, stream); launch_mega(d_in, d_out, d_ws, p, p + 1, stream); } }
#else
    launch_mega(d_in, d_out, d_ws, 0, N_PHASES, stream);
#endif
}
```

```cpp
#define N_LAUNCH_SPLIT 0
#include <hip/hip_runtime.h>
#include <hip/hip_bf16.h>
#include <cstdio>
#include <cstdint>
#include <cstring>
#include <cmath>

constexpr int B_ = 4, S_ = 4096, D_ = 1024, M_ = B_ * S_;
constexpr int INW = 4256, INWP = 4352;
constexpr int C_SBQ = 0, C_SBK = 512, C_SBV = 1024, C_CQ = 1536, C_CKV = 1920, C_KR = 2176, C_GSB = 2208, C_GMLA = 3232;
constexpr int NE = 32, TOPK = 4, DFF = 1024;
constexpr float EPS = 1e-6f;
constexpr float LOG2E = 1.4426950408889634f;
constexpr float SB_QSCALE = 0.125f * LOG2E;
constexpr float MLA_QSCALE = 0.10206207261596577f * LOG2E;
constexpr int NWAVES = 8, NTHR = 512;

#define LAS __attribute__((address_space(3)))
#define GAS __attribute__((address_space(1)))
typedef unsigned short bf16_t;
typedef short bf16x8 __attribute__((ext_vector_type(8)));
typedef short s16x4 __attribute__((ext_vector_type(4)));
typedef float f32x4 __attribute__((ext_vector_type(4)));
typedef float f32x16 __attribute__((ext_vector_type(16)));
typedef unsigned u32x4 __attribute__((ext_vector_type(4)));
typedef unsigned u32x2 __attribute__((ext_vector_type(2)));
typedef float f32x2_t __attribute__((ext_vector_type(2)));
typedef __bf16 bf16x2_t __attribute__((ext_vector_type(2)));
typedef int v8i_t __attribute__((ext_vector_type(8)));
constexpr float W8_SCALE = 8.f, X8_SCALE = 8.f;
__device__ __forceinline__ unsigned pk_fp8x4(float a, float b, float c, float d) { unsigned w = 0; w = __builtin_amdgcn_cvt_pk_fp8_f32(a, b, w, false); w = __builtin_amdgcn_cvt_pk_fp8_f32(c, d, w, true); return w; }

__device__ __forceinline__ unsigned cvtpk(float lo, float hi) { f32x2_t v = {lo, hi}; bf16x2_t b = __builtin_convertvector(v, bf16x2_t); return __builtin_bit_cast(unsigned, b); }
__device__ __forceinline__ float bf2f(unsigned short h) { return __uint_as_float(((unsigned)h) << 16); }
__device__ __forceinline__ float bflo(unsigned w) { return __uint_as_float(w << 16); }
__device__ __forceinline__ float bfhi(unsigned w) { return __uint_as_float(w & 0xffff0000u); }
__device__ __forceinline__ float wave_sum(float v) {
#pragma unroll
    for (int o = 1; o < 64; o <<= 1) v += __shfl_xor(v, o);
    return v;
}
__device__ __forceinline__ float sigmoidf_(float x) { return __builtin_amdgcn_rcpf(1.f + __builtin_amdgcn_exp2f(-x * LOG2E)); }

namespace pg8 {
constexpr int BM = 256, BK = 64, HALF = 128, HTB = HALF * BK * 2, STAGE_BYTES = 8 * HTB, NXCD = 8, WGM = 8;
__host__ __device__ __forceinline__ int lds_byte(int r, int c) { const int st = (r >> 4) * 2 + (c >> 5), rr = r & 15, cc = c & 31, ob = rr * 64 + cc * 2; return st * 1024 + (ob ^ (((ob >> 9) & 1) << 5)); }
__host__ __device__ __forceinline__ void stage_rc(int b, int& R, int& C) { const int st = b / 1024, sb = b % 1024, swz = sb ^ (((sb >> 9) & 1) << 5); R = (st >> 1) * 16 + swz / 64; C = (st & 1) * 32 + (swz % 64) / 2; }
__host__ __device__ __forceinline__ int perm32(int rho) { const int n = rho >> 4, i = rho & 15; return 8 * (i >> 2) + 4 * n + (i & 3); }

struct Unit { int pm, pn, e, rows, rt; };
struct Gemm { const bf16_t* A; int lda, ldb, K; };

struct StaticOrder {
    const bf16_t* A; const bf16_t* Bt; int lda, ldb;
    int nM, nN, nwg, G, c;
    __device__ void init(const bf16_t* A_, int lda_, const bf16_t* Bt_, int ldb_, int M, int N, int G_, int c_, int cshift = 0) { A = A_; Bt = Bt_; lda = lda_; ldb = ldb_; nM = M / BM; nN = N / BM; nwg = nM * nN; G = G_; c = (c_ + cshift) % G_; }
    __device__ __forceinline__ bool next(int i, Unit& u) const {
        const long L = (long)i * G + c; if (L >= nwg) return false;
        int wgid = (int)L; { const int q = nwg / NXCD, r = nwg % NXCD, xcd = wgid % NXCD, off = wgid / NXCD; wgid = (xcd < r ? xcd * (q + 1) : r * (q + 1) + (xcd - r) * q) + off; }
        const int nig = WGM * nN, gid = wgid / nig, fm = gid * WGM, gsz = (nM - fm) < WGM ? (nM - fm) : WGM;
        u.pm = fm + ((wgid % nig) % gsz); u.pn = (wgid % nig) / gsz; u.e = 0; u.rows = 256; u.rt = 0; return true;
    }
    __device__ __forceinline__ unsigned a_off(const Unit& u, int r, int C) const { return (unsigned)(((u.pm * BM + r) * lda + C) * 2); }
    __device__ __forceinline__ const char* b_base(const Unit& u) const { return (const char*)(Bt + (size_t)u.pn * BM * ldb); }
};

__device__ __forceinline__ v8i_t ld32_lds(const LAS unsigned char* p) { const u32x4 lo_ = *(const LAS u32x4*)p, hi_ = *(const LAS u32x4*)(p + 1024); return (v8i_t){(int)lo_.x, (int)lo_.y, (int)lo_.z, (int)lo_.w, (int)hi_.x, (int)hi_.y, (int)hi_.z, (int)hi_.w}; }
struct PairOrder {
    StaticOrder S; size_t a1, b1;
    __device__ __forceinline__ bool next(int i, Unit& u) const { if (!S.next(i >> 1, u)) return false; u.e = i & 1; return true; }
    __device__ __forceinline__ unsigned a_off(const Unit& u, int r, int C) const { return S.a_off(u, r, C) + (unsigned)(u.e ? a1 * 2 : 0); }
    __device__ __forceinline__ const char* b_base(const Unit& u) const { return S.b_base(u) + (u.e ? b1 * 2 : 0); }
};
__device__ __forceinline__ void mfma_f8(f32x4& c, const v8i_t a, const v8i_t b, int sa, int sb) {
    asm volatile("v_mfma_scale_f32_16x16x128_f8f6f4 %0, %1, %2, %0, %3, %4 op_sel_hi:[0,0,0]" : "+v"(c) : "v"(a), "v"(b), "v"(sa), "v"(sb));
}
template <bool F8> struct FragT { typedef bf16x8 type; };
template <> struct FragT<true> { typedef v8i_t type; };
template <class Epi, class Sched, bool FP8 = false>
__device__ __forceinline__ void gemm_phase(LAS unsigned char* lds, const Gemm g, const Sched& S, const Epi& E) {
    const int tid = threadIdx.x, wid = __builtin_amdgcn_readfirstlane(tid >> 6), lane = tid & 63, wr = wid >> 2, wc = wid & 3, fr = lane & 15, fq = lane >> 4;
    const int K = g.K, nt = K / BK;
    unsigned voffB[2];
#pragma unroll
    for (int i = 0; i < 2; ++i) { int R, C; stage_rc(tid * 16 + i * 8192, R, C); const int Rb = Epi::PERM ? ((R & ~31) + perm32(R & 31)) : R; voffB[i] = (unsigned)(Rb * g.ldb + C) * 2u; }
#define PG8_AOFF(dst, unit) do { int t_ = tid; asm volatile("" : "+v"(t_)); _Pragma("unroll") for (int i = 0; i < 2; ++i) { int R, C; stage_rc(t_ * 16 + i * 8192, R, C); \
        _Pragma("unroll") for (int h = 0; h < 2; ++h) dst[h][i] = S.a_off(unit, h * HALF + R, C); } } while (0)
    const size_t kstep = (size_t)(BK * 2);
    const size_t hstepB = (size_t)HALF * g.ldb * 2;
    const unsigned ldsw = (unsigned)wid * 1024u;
    const int aoff = lds_byte(wr * 64 + fr, fq * 8), boff = lds_byte(wc * 32 + fr, fq * 8);
#define PG8_SA(b, h) (((b) * 2 + (h)) * HTB)
#define PG8_SB(b, h) ((4 + (b) * 2 + (h)) * HTB)
#define PG8_STAGE(bufoff, gbase, voff) do { _Pragma("unroll") for (int _i = 0; _i < 2; ++_i) \
        __builtin_amdgcn_global_load_lds((const unsigned*)((const char*)(gbase) + (voff)[_i]), (LAS unsigned*)(lds + (bufoff) + ldsw + _i * 8192), 16, 0, 0); } while (0)
#define PG8_LD32(p) ld32_lds((const LAS unsigned char*)(p))
#define PG8_LDA(dst, b, h) do { if constexpr (FP8) { _Pragma("unroll") for (int m = 0; m < 4; ++m) dst[m][0] = __builtin_bit_cast(FT, PG8_LD32(lds + PG8_SA(b, h) + aoff + m * 2048)); } \
        else { _Pragma("unroll") for (int m = 0; m < 4; ++m) _Pragma("unroll") for (int k = 0; k < 2; ++k) dst[m][k] = __builtin_bit_cast(FT, *(const LAS FT*)(lds + PG8_SA(b, h) + aoff + m * 2048 + k * 1024)); } } while (0)
#define PG8_LDB(dst, b, h) do { if constexpr (FP8) { _Pragma("unroll") for (int n = 0; n < 2; ++n) dst[n][0] = __builtin_bit_cast(FT, PG8_LD32(lds + PG8_SB(b, h) + boff + n * 2048)); } \
        else { _Pragma("unroll") for (int n = 0; n < 2; ++n) _Pragma("unroll") for (int k = 0; k < 2; ++k) dst[n][k] = __builtin_bit_cast(FT, *(const LAS FT*)(lds + PG8_SB(b, h) + boff + n * 2048 + k * 1024)); } } while (0)
#define PG8_MMA(ai, bj, At, Bt) do { __builtin_amdgcn_s_setprio(1); \
        if constexpr (FP8) { _Pragma("unroll") for (int m = 0; m < 4; ++m) _Pragma("unroll") for (int n = 0; n < 2; ++n) \
            mfma_f8(acc[ai][bj][m][n], __builtin_bit_cast(v8i_t, Bt[n][0]), __builtin_bit_cast(v8i_t, At[m][0]), 0x7c7c7c7c, 0x7c7c7c7c); } \
        else { _Pragma("unroll") for (int m = 0; m < 4; ++m) _Pragma("unroll") for (int n = 0; n < 2; ++n) _Pragma("unroll") for (int k = 0; k < 2; ++k) \
            acc[ai][bj][m][n] = __builtin_amdgcn_mfma_f32_16x16x32_bf16(__builtin_bit_cast(bf16x8, Bt[n][k]), __builtin_bit_cast(bf16x8, At[m][k]), acc[ai][bj][m][n], 0, 0, 0); } \
        __builtin_amdgcn_s_setprio(0); } while (0)
#define PG8_WAIT_V(n) asm volatile("s_waitcnt vmcnt(" #n ")" ::: "memory")
#define PG8_WAIT_L(n) asm volatile("s_waitcnt lgkmcnt(" #n ")" ::: "memory")
#define PG8_BAR __builtin_amdgcn_s_barrier()
#define PG8_SCHED __builtin_amdgcn_sched_barrier(0)
    Unit cur, nxt; int ui = 0;
    if (!S.next(0, cur)) return;
    f32x4 acc[2][2][4][2];
#pragma unroll
    for (int a = 0; a < 2; ++a)
#pragma unroll
        for (int b = 0; b < 2; ++b)
#pragma unroll
            for (int m = 0; m < 4; ++m)
#pragma unroll
                for (int n = 0; n < 2; ++n) acc[a][b][m][n] = (f32x4){0.f, 0.f, 0.f, 0.f};
    typedef typename FragT<FP8>::type FT; constexpr int NK = FP8 ? 1 : 2;
    FT At[4][NK], B0[2][NK], B1[2][NK];
    const char* Ab = (const char*)g.A;
    const char* cB = S.b_base(cur);
    unsigned vaC[2][2], vaN[2][2];
    PG8_AOFF(vaC, cur);
    PG8_STAGE(PG8_SB(0, 0), cB, voffB); PG8_STAGE(PG8_SB(0, 1), cB + hstepB, voffB); PG8_STAGE(PG8_SA(0, 0), Ab, vaC[0]); PG8_STAGE(PG8_SA(0, 1), Ab, vaC[1]);
    if (wr == 1) PG8_BAR;
    PG8_WAIT_V(2); PG8_BAR;
    PG8_STAGE(PG8_SB(1, 0), cB + kstep, voffB); PG8_STAGE(PG8_SA(1, 0), Ab + kstep, vaC[0]); PG8_STAGE(PG8_SB(1, 1), cB + hstepB + kstep, voffB);
    PG8_WAIT_V(6); PG8_BAR;
    for (;;) {
        const bool has_next = S.next(ui + 1, nxt);
        const char* nB = has_next ? S.b_base(nxt) : cB;
        if (has_next) PG8_AOFF(vaN, nxt);
        else {
#pragma unroll
            for (int h = 0; h < 2; ++h)
#pragma unroll
                for (int i = 0; i < 2; ++i) vaN[h][i] = vaC[h][i]; }
        for (int t = 0; t < nt; t += 2) {
            const bool last = (t == nt - 2);
            const char* kA1 = Ab + (size_t)(t + 1) * kstep;
            const char* kA2 = last ? Ab : Ab + (size_t)(t + 2) * kstep; const char* b2 = last ? nB : cB + (size_t)(t + 2) * kstep;
            const char* kA3 = kA2 + kstep; const char* b3 = b2 + kstep;
            unsigned o2[2][2];
#pragma unroll
            for (int h = 0; h < 2; ++h)
#pragma unroll
                for (int i = 0; i < 2; ++i) o2[h][i] = last ? vaN[h][i] : vaC[h][i];
            PG8_LDB(B0, 0, 0); PG8_LDB(B1, 0, 1); PG8_SCHED; PG8_LDA(At, 0, 0); PG8_STAGE(PG8_SA(1, 1), kA1, vaC[1]);
            PG8_WAIT_V(8); PG8_WAIT_L(0); PG8_BAR; PG8_MMA(0, 0, At, B0); PG8_MMA(0, 1, At, B1); PG8_BAR; PG8_SCHED;
            PG8_LDA(At, 0, 1); PG8_STAGE(PG8_SB(0, 0), b2, voffB); PG8_STAGE(PG8_SB(0, 1), b2 + hstepB, voffB); PG8_STAGE(PG8_SA(0, 0), kA2, o2[0]);
            PG8_WAIT_V(8); PG8_WAIT_L(0); PG8_BAR; PG8_MMA(1, 0, At, B0); PG8_MMA(1, 1, At, B1); PG8_BAR; PG8_SCHED;
            PG8_LDB(B0, 1, 0); PG8_LDB(B1, 1, 1); PG8_SCHED; PG8_LDA(At, 1, 0); PG8_STAGE(PG8_SA(0, 1), kA2, o2[1]);
            PG8_WAIT_V(8); PG8_WAIT_L(0); PG8_BAR; PG8_MMA(0, 0, At, B0); PG8_MMA(0, 1, At, B1); PG8_BAR; PG8_SCHED;
            PG8_LDA(At, 1, 1); PG8_STAGE(PG8_SB(1, 0), b3, voffB); PG8_STAGE(PG8_SB(1, 1), b3 + hstepB, voffB); PG8_STAGE(PG8_SA(1, 0), kA3, o2[0]);
            PG8_WAIT_V(8); PG8_WAIT_L(0); PG8_BAR; PG8_MMA(1, 0, At, B0); PG8_MMA(1, 1, At, B1); PG8_BAR; PG8_SCHED;
        }
        if (wr == 0) PG8_BAR;
        if constexpr (FP8) asm volatile("s_nop 15\n\ts_nop 15" ::: "memory");
        E(acc, cur, wr, wc, fr, fq);
        if (!has_next) break;
#pragma unroll
        for (int a = 0; a < 2; ++a)
#pragma unroll
            for (int b = 0; b < 2; ++b)
#pragma unroll
                for (int m = 0; m < 4; ++m)
#pragma unroll
                    for (int n = 0; n < 2; ++n) acc[a][b][m][n] = (f32x4){0.f, 0.f, 0.f, 0.f};
        cur = nxt; cB = nB; ++ui;
#pragma unroll
        for (int h = 0; h < 2; ++h)
#pragma unroll
            for (int i = 0; i < 2; ++i) vaC[h][i] = vaN[h][i];
        if (wr == 1) PG8_BAR;
    }
    PG8_WAIT_V(0);
    PG8_BAR;
#undef PG8_SA
#undef PG8_AOFF
#undef PG8_SB
#undef PG8_STAGE
#undef PG8_LDA
#undef PG8_LDB
#undef PG8_MMA
#undef PG8_LD32
#undef PG8_WAIT_V
#undef PG8_WAIT_L
#undef PG8_BAR
#undef PG8_SCHED
}

struct EpiBf16 {
    static constexpr bool PERM = true;
    bf16_t* O; int ldc;
    __device__ __forceinline__ void operator()(const f32x4 (&acc)[2][2][4][2], const Unit& u, int wr, int wc, int fr, int fq) const {
        const int row0 = u.pm * BM + wr * 64 + fr, col0 = u.pn * BM + wc * 32 + 8 * fq;
#pragma unroll
        for (int ai = 0; ai < 2; ++ai)
#pragma unroll
            for (int m = 0; m < 4; ++m) { bf16_t* rowp = O + (size_t)(row0 + ai * HALF + m * 16) * ldc + col0;
#pragma unroll
                for (int bj = 0; bj < 2; ++bj) { const f32x4 v0 = acc[ai][bj][m][0], v1 = acc[ai][bj][m][1];
                    u32x4 w; w.x = cvtpk(v0[0], v0[1]); w.y = cvtpk(v0[2], v0[3]); w.z = cvtpk(v1[0], v1[1]); w.w = cvtpk(v1[2], v1[3]);
                    *(u32x4*)(rowp + bj * HALF) = w; } }
    }
};
struct EpiGate2 {
    static constexpr bool PERM = true;
    bf16_t* O; const bf16_t* G; int ldg, gcol0, gcol1;
    __device__ __forceinline__ void operator()(const f32x4 (&acc)[2][2][4][2], const Unit& u, int wr, int wc, int fr, int fq) const {
        const int row0 = u.pm * BM + wr * 64 + fr, col0 = u.pn * BM + wc * 32 + 8 * fq;
        const bool second = u.e != 0; const int gcol = second ? gcol1 : gcol0;
#pragma unroll
        for (int ai = 0; ai < 2; ++ai)
#pragma unroll
            for (int m = 0; m < 4; ++m) { const size_t r = (size_t)(row0 + ai * HALF + m * 16);
#pragma unroll
                for (int bj = 0; bj < 2; ++bj) { const f32x4 v0 = acc[ai][bj][m][0], v1 = acc[ai][bj][m][1];
                    const int c = col0 + bj * HALF;
                    const u32x4 gw = *(const u32x4*)(G + r * ldg + gcol + c);
                    bf16_t* op = O + r * D_ + c;
                    u32x4 pw = {0u, 0u, 0u, 0u}; if (second) pw = *(const u32x4*)op;
                    float o[8];
                    o[0] = sigmoidf_(bflo(gw.x)) * v0[0]; o[1] = sigmoidf_(bfhi(gw.x)) * v0[1]; o[2] = sigmoidf_(bflo(gw.y)) * v0[2]; o[3] = sigmoidf_(bfhi(gw.y)) * v0[3];
                    o[4] = sigmoidf_(bflo(gw.z)) * v1[0]; o[5] = sigmoidf_(bfhi(gw.z)) * v1[1]; o[6] = sigmoidf_(bflo(gw.w)) * v1[2]; o[7] = sigmoidf_(bfhi(gw.w)) * v1[3];
                    o[0] += bflo(pw.x); o[1] += bfhi(pw.x); o[2] += bflo(pw.y); o[3] += bfhi(pw.y); o[4] += bflo(pw.z); o[5] += bfhi(pw.z); o[6] += bflo(pw.w); o[7] += bfhi(pw.w);
                    u32x4 w; w.x = cvtpk(o[0], o[1]); w.y = cvtpk(o[2], o[3]); w.z = cvtpk(o[4], o[5]); w.w = cvtpk(o[6], o[7]);
                    *(u32x4*)op = w; } }
    }
};
struct EpiRes {
    static constexpr bool PERM = false;
    const float* base; float* out;
    __device__ __forceinline__ void operator()(const f32x4 (&acc)[2][2][4][2], const Unit& u, int wr, int wc, int fr, int fq) const {
        const int row0 = u.pm * BM + wr * 64 + fr, col0 = u.pn * BM + wc * 32 + 4 * fq;
#pragma unroll
        for (int ai = 0; ai < 2; ++ai)
#pragma unroll
            for (int m = 0; m < 4; ++m) { const size_t off = (size_t)(row0 + ai * HALF + m * 16) * D_ + col0;
#pragma unroll
                for (int bj = 0; bj < 2; ++bj)
#pragma unroll
                    for (int n = 0; n < 2; ++n) { const f32x4 b = *(const f32x4*)(base + off + bj * HALF + n * 16); *(f32x4*)(out + off + bj * HALF + n * 16) = b + acc[ai][bj][m][n]; } }
    }
};
struct EpiSwiglu {
    static constexpr bool PERM = true;
    bf16_t* act; const float* b_up;
    __device__ __forceinline__ void operator()(const f32x4 (&acc)[2][2][4][2], const Unit& u, int wr, int wc, int fr, int fq) const {
        const int row0 = u.pm * BM + wr * 64 + fr, col0 = u.pn * BM + wc * 32 + 8 * fq;
        const float* bb = b_up + (size_t)u.e * (2 * DFF);
        f32x4 bv[2][2];
#pragma unroll
        for (int bj = 0; bj < 2; ++bj)
#pragma unroll
            for (int n = 0; n < 2; ++n) bv[bj][n] = *(const f32x4*)(bb + col0 + bj * HALF + 4 * n);
#pragma unroll
        for (int ai = 0; ai < 2; ++ai)
#pragma unroll
            for (int m = 0; m < 4; ++m) { bf16_t* rowp = act + (size_t)(row0 + ai * HALF + m * 16) * DFF + (col0 >> 1);
#pragma unroll
                for (int bj = 0; bj < 2; ++bj) { const f32x4 v0 = acc[ai][bj][m][0] + bv[bj][0], v1 = acc[ai][bj][m][1] + bv[bj][1];
                    float a[4];
#pragma unroll
                    for (int p = 0; p < 4; ++p) { float gl = (p < 2) ? v0[2 * p] : v1[2 * p - 4], li = (p < 2) ? v0[2 * p + 1] : v1[2 * p - 3];
                        gl = fminf(gl, 7.f); li = fminf(fmaxf(li, -7.f), 7.f);
                        a[p] = gl * sigmoidf_(1.702f * gl) * (li + 1.f); }
                    u32x2 w; w.x = cvtpk(a[0], a[1]); w.y = cvtpk(a[2], a[3]);
                    *(u32x2*)(rowp + bj * (HALF / 2)) = w; } }
    }
};
struct EpiSwiglu8 {
    static constexpr bool PERM = true;
    unsigned char* act; const float* b_up;
    __device__ __forceinline__ void operator()(const f32x4 (&acc)[2][2][4][2], const Unit& u, int wr, int wc, int fr, int fq) const {
        const int row0 = u.pm * BM + wr * 64 + fr, col0 = u.pn * BM + wc * 32 + 8 * fq;
        const float* bb = b_up + (size_t)u.e * (2 * DFF);
        f32x4 bv[2][2];
#pragma unroll
        for (int bj = 0; bj < 2; ++bj)
#pragma unroll
            for (int n = 0; n < 2; ++n) bv[bj][n] = *(const f32x4*)(bb + col0 + bj * HALF + 4 * n);
#pragma unroll
        for (int ai = 0; ai < 2; ++ai)
#pragma unroll
            for (int m = 0; m < 4; ++m) { unsigned char* rowp = act + (size_t)(row0 + ai * HALF + m * 16) * DFF + (col0 >> 1);
#pragma unroll
                for (int bj = 0; bj < 2; ++bj) { const f32x4 v0 = acc[ai][bj][m][0] + bv[bj][0], v1 = acc[ai][bj][m][1] + bv[bj][1];
                    float a[4];
#pragma unroll
                    for (int p = 0; p < 4; ++p) { float gl = (p < 2) ? v0[2 * p] : v1[2 * p - 4], li = (p < 2) ? v0[2 * p + 1] : v1[2 * p - 3];
                        gl = fminf(gl, 7.f); li = fminf(fmaxf(li, -7.f), 7.f);
                        a[p] = gl * sigmoidf_(1.702f * gl) * (li + 1.f) * X8_SCALE; }
                    *(unsigned*)(rowp + bj * (HALF / 2)) = pk_fp8x4(a[0], a[1], a[2], a[3]); } }
    }
};
struct EpiDown {
    static constexpr bool PERM = true;
    bf16_t* y; const float* b_down; const int* list; const float* topw;
    __device__ __forceinline__ void operator()(const f32x4 (&acc)[2][2][4][2], const Unit& u, int wr, int wc, int fr, int fq) const {
        const int col0 = u.pn * BM + wc * 32 + 8 * fq;
        const float* bb = b_down + (size_t)u.e * D_;
        f32x4 bv[2][2];
#pragma unroll
        for (int bj = 0; bj < 2; ++bj)
#pragma unroll
            for (int n = 0; n < 2; ++n) bv[bj][n] = *(const f32x4*)(bb + col0 + bj * HALF + 4 * n);
        const int* lp = list + (size_t)u.e * M_ + u.rt * BM;
#pragma unroll
        for (int ai = 0; ai < 2; ++ai)
#pragma unroll
            for (int m = 0; m < 4; ++m) { const int r = ai * HALF + wr * 64 + m * 16 + fr;
                if (r < u.rows) { const int slot = lp[r]; const float w = topw[slot]; bf16_t* rowp = y + (size_t)slot * D_ + col0;
#pragma unroll
                    for (int bj = 0; bj < 2; ++bj) { const f32x4 v0 = (acc[ai][bj][m][0] + bv[bj][0]) * w, v1 = (acc[ai][bj][m][1] + bv[bj][1]) * w;
                        u32x4 o; o.x = cvtpk(v0[0], v0[1]); o.y = cvtpk(v0[2], v0[3]); o.z = cvtpk(v1[0], v1[1]); o.w = cvtpk(v1[2], v1[3]);
                        *(u32x4*)(rowp + bj * HALF) = o; } } }
    }
};
}
constexpr size_t MiB = 1ull << 20;
constexpr size_t WS_CTL = 0, CTL_ZERO_BYTES = 64 * 1024;
constexpr size_t WS_ROPE = 256 * 1024;
constexpr size_t WS_WR = 3 * MiB;
constexpr size_t WS_LIST = 4 * MiB;
constexpr size_t WS_TOPW = 6 * MiB;
constexpr size_t WS_SEL = 6 * MiB + 512 * 1024;
constexpr size_t WS_WIN = 8 * MiB;
constexpr size_t WS_WUQ = 17 * MiB;
constexpr size_t WS_WUKV = 18 * MiB;
constexpr size_t WS_WOSB = 19 * MiB;
constexpr size_t WS_WOMLA = 20 * MiB;
constexpr size_t WS_WOUT = 21 * MiB;
constexpr size_t WS_WUP = 24 * MiB;
constexpr size_t WS_WDN = 152 * MiB;
constexpr size_t WS_HB = 216 * MiB;
constexpr size_t WS_PROJ = 249 * MiB;
constexpr size_t WS_ACT = WS_PROJ;
constexpr size_t WS_QRAW = 393 * MiB;
constexpr size_t WS_KVRAW = WS_QRAW + 24 * MiB;
constexpr size_t WS_QB = WS_KVRAW + 32 * MiB;
constexpr size_t WS_KB = WS_QB + 24 * MiB;
constexpr size_t WS_VB = WS_KB + 24 * MiB;
constexpr size_t WS_OSB = WS_VB + 16 * MiB;
constexpr size_t WS_OMLA = WS_OSB + 16 * MiB;
constexpr size_t WS_YB = WS_QRAW;
constexpr size_t WS_MIX = 545 * MiB;
constexpr size_t WS_H2F8 = 577 * MiB;
constexpr size_t WS_OPT_END = 594 * MiB;
constexpr int CW_CNT = 0;
constexpr int CW_BAR = 1024;
constexpr int LDS_STAGE = 143360;
constexpr int LDS_MISC = LDS_STAGE;
constexpr int LDS_BYTES = 147456;
constexpr int MI_BAR = 0, MI_TPFX = 16, MI_CNT = 64, MI_FLAG = 128, MI_LCNT = 160, MI_BASE = 192, MI_RSTD = 256, MI_CITEM = 320;

typedef GAS unsigned gu32;
#define RLX_AGENT __ATOMIC_RELAXED, __HIP_MEMORY_SCOPE_AGENT

#define XB_TMO      128
#define XB_XCNT(j)  (256  + 64 * (j))
#define XB_XSUB(j)  (1280 + 64 * (j))
#define XB_XGEN(j)  (2304 + 64 * (j))
#define XB_TOP      3328
#define XB_TOPGEN   3392
#define XCD_BAR_WORDS 3456
#define XB_SPIN_CAP (1u << 18)
__device__ __forceinline__ unsigned xb_ld(unsigned* p)              { return __hip_atomic_load(p, __ATOMIC_RELAXED, __HIP_MEMORY_SCOPE_AGENT); }
__device__ __forceinline__ unsigned xb_add(unsigned* p, unsigned v) { return __hip_atomic_fetch_add(p, v, __ATOMIC_RELAXED, __HIP_MEMORY_SCOPE_AGENT); }
__device__ __forceinline__ unsigned xb_xcc_id() { return (unsigned)__builtin_amdgcn_s_getreg((3 << 11) | 20) & 0xFu; }
#define XB_SPIN(cond, bar) do { unsigned _sp = 0; while (cond) { __builtin_amdgcn_s_sleep(1); \
    if ((++_sp & 255u) == 0u) { if (xb_ld(&(bar)[XB_TMO])) break; if (_sp > XB_SPIN_CAP) { atomicAdd(&(bar)[XB_TMO], 1u); break; } } } } while (0)
struct XcdBarrier { unsigned* bar; unsigned x; volatile LAS unsigned* st; };
__device__ __forceinline__ XcdBarrier xcd_barrier_post(unsigned* bar, volatile LAS unsigned* st) {
    XcdBarrier b; b.bar = bar; b.x = xb_xcc_id(); b.st = st;
    if (threadIdx.x == 0) (void)xb_add(&bar[XB_XCNT(b.x)], 1u);
    return b;
}
__device__ __forceinline__ void xcd_barrier_complete(unsigned* bar, unsigned x, unsigned& nloc, unsigned& nx) {
    const unsigned G = gridDim.x * gridDim.y * gridDim.z;
    unsigned sum, cnt, mine, sp = 0u;
    for (;;) {
        sum = 0u; cnt = 0u; mine = 0u;
#pragma unroll
        for (unsigned j = 0; j < 16; ++j) { const unsigned c = xb_ld(&bar[XB_XCNT(j)]); sum += c; cnt += (c > 0u) ? 1u : 0u; mine = (j == x) ? c : mine; }
        if (sum == G) break;
        __builtin_amdgcn_s_sleep(1);
        if ((++sp & 255u) == 0u) { if (xb_ld(&bar[XB_TMO])) break; if (sp > XB_SPIN_CAP) { atomicAdd(&bar[XB_TMO], 1u); break; } }
    }
    nloc = mine > 0u ? mine : 1u; nx = cnt > 0u ? cnt : 1u;
}
__device__ __forceinline__ void xcd_barrier(const XcdBarrier& b) {
    asm volatile("s_waitcnt vmcnt(0)" ::: "memory");
    __syncthreads();
    if (threadIdx.x == 0) {
        unsigned* bar = b.bar;
        __builtin_amdgcn_s_waitcnt(0);
        unsigned nloc = b.st[0], nx = b.st[1];
        if (nloc == 0u) { xcd_barrier_complete(bar, b.x, nloc, nx); b.st[0] = nloc; b.st[1] = nx; }
        const unsigned old = xb_add(&bar[XB_XSUB(b.x)], 1u);
        const unsigned gen = old / nloc;
        if (old + 1u == (gen + 1u) * nloc) {
            __builtin_amdgcn_fence(__ATOMIC_RELEASE, "agent");
            asm volatile("s_waitcnt vmcnt(0)" ::: "memory");
            const unsigned og = xb_add(&bar[XB_TOP], 1u);
            const unsigned tg = og / nx;
            if (og + 1u == (tg + 1u) * nx) xb_add(&bar[XB_TOPGEN], 1u);
            else XB_SPIN(xb_ld(&bar[XB_TOPGEN]) == tg, bar);
            __builtin_amdgcn_fence(__ATOMIC_ACQUIRE, "agent");
            xb_add(&bar[XB_XGEN(b.x)], 1u);
            asm volatile("s_waitcnt vmcnt(0)" ::: "memory");
        } else {
            XB_SPIN(xb_ld(&bar[XB_XGEN(b.x)]) == gen, bar);
            __builtin_amdgcn_fence(__ATOMIC_ACQUIRE, "agent");
            asm volatile("s_waitcnt vmcnt(0)" ::: "memory");
        }
    }
    __syncthreads();
}

struct Args {
    const float* in[20]; float* out; unsigned char* ws;
    int ph_lo, ph_hi;
};

struct Frame {
    LAS unsigned char* lds; volatile LAS unsigned* MISC;
    int tid, lane, wave, vcu, G;
    unsigned char* ws;
};

__device__ __forceinline__ void p0_transpose_item(const float* W, int K, int N, bf16_t* WT, LAS float* scr, int item, int lane, const float* gk, float cs, int csn) {
    const int nblk = N / 32, kb = item / nblk, nb = item % nblk, k0 = 64 * kb, n0 = 32 * nb;
    const float colsc = (n0 < csn) ? cs : 1.f;
    float tv[32];
#pragma unroll
    for (int i = 0; i < 32; ++i) { const int kk = 2 * i + (lane >> 5); tv[i] = W[(size_t)(k0 + kk) * N + n0 + (lane & 31)]; }
#pragma unroll
    for (int i = 0; i < 32; ++i) { const int kk = 2 * i + (lane >> 5); float v = tv[i] * colsc; if (gk) v *= gk[k0 + kk]; scr[kk * 33 + (lane & 31)] = v; }
    asm volatile("s_waitcnt lgkmcnt(0)" ::: "memory");
    const int c = lane & 7;
#pragma unroll
    for (int j = 0; j < 4; ++j) { const int n = (lane >> 3) + 8 * j; const LAS float* s = scr + (8 * c) * 33 + n;
        u32x4 o; o.x = cvtpk(s[0 * 33], s[1 * 33]); o.y = cvtpk(s[2 * 33], s[3 * 33]); o.z = cvtpk(s[4 * 33], s[5 * 33]); o.w = cvtpk(s[6 * 33], s[7 * 33]);
        *(u32x4*)(WT + (size_t)(n0 + n) * K + k0 + 8 * c) = o; }
    asm volatile("s_waitcnt lgkmcnt(0)" ::: "memory");
}
__device__ __forceinline__ void p0_transpose_item_fp8(const float* W, int K, int N, unsigned char* WT, LAS float* scr, int item, int lane, float cs) {
    const int nblk = N / 32, kb = item / nblk, nb = item % nblk, k0 = 64 * kb, n0 = 32 * nb;
    float tv[32];
#pragma unroll
    for (int i = 0; i < 32; ++i) { const int kk = 2 * i + (lane >> 5); tv[i] = W[(size_t)(k0 + kk) * N + n0 + (lane & 31)]; }
#pragma unroll
    for (int i = 0; i < 32; ++i) { const int kk = 2 * i + (lane >> 5); scr[kk * 33 + (lane & 31)] = tv[i] * cs; }
    asm volatile("s_waitcnt lgkmcnt(0)" ::: "memory");
    const int c = lane & 7;
#pragma unroll
    for (int j = 0; j < 4; ++j) { const int n = (lane >> 3) + 8 * j; const LAS float* s = scr + (8 * c) * 33 + n;
        u32x2 o; o.x = pk_fp8x4(s[0 * 33], s[1 * 33], s[2 * 33], s[3 * 33]); o.y = pk_fp8x4(s[4 * 33], s[5 * 33], s[6 * 33], s[7 * 33]);
        *(u32x2*)(WT + (size_t)(n0 + n) * K + k0 + 8 * c) = o; }
    asm volatile("s_waitcnt lgkmcnt(0)" ::: "memory");
}
__device__ __forceinline__ void rms_row_to_bf16(const float* xrow, const float* g, bf16_t* orow, int lane) {
    const f32x4* xr = (const f32x4*)xrow + lane; const f32x4* gr = (const f32x4*)g + lane;
    f32x4 v[4]; float s = 0.f;
#pragma unroll
    for (int j = 0; j < 4; ++j) { v[j] = xr[64 * j]; s += (v[j].x * v[j].x + v[j].y * v[j].y) + (v[j].z * v[j].z + v[j].w * v[j].w); }
    const float rstd = rsqrtf(wave_sum(s) * (1.f / D_) + EPS);
    u32x2* o8 = (u32x2*)orow + lane;
#pragma unroll
    for (int j = 0; j < 4; ++j) { const f32x4 gg = gr[64 * j]; u32x2 w; w.x = cvtpk(v[j].x * rstd * gg.x, v[j].y * rstd * gg.y); w.y = cvtpk(v[j].z * rstd * gg.z, v[j].w * rstd * gg.w); o8[64 * j] = w; }
}
__device__ __forceinline__ void p0_prologue(Frame& F, const Args& a, int do_moe_w, int do_rest) {
    LAS float* scr = (LAS float*)(F.lds + F.wave * 16384);
    const int gw = F.vcu * NWAVES + F.wave, NGW = F.G * NWAVES;
    unsigned char* ws = F.ws;
    const float* w_in = a.in[3]; const float* g_cq = a.in[4]; const float* w_uq = a.in[5]; const float* g_ckv = a.in[6]; const float* w_ukv = a.in[7];
    const float* w_o_sb = a.in[10]; const float* w_o_mla = a.in[11]; const float* w_out = a.in[12]; const float* g_ffn = a.in[13]; const float* w_router = a.in[14];
    const float* w_up = a.in[16]; const float* w_down = a.in[18];
    constexpr int I_IN = (D_ / 64) * (INW / 32), I_UQ = (384 / 64) * (768 / 32), I_UKV = (256 / 64) * (1024 / 32), I_O = (512 / 64) * (1024 / 32), I_OUT = (1024 / 64) * (1024 / 32);
    constexpr int I_UP1 = (1024 / 64) * (2048 / 32), I_DN1 = (1024 / 64) * (1024 / 32);
    if (do_rest) {
        constexpr int NI = I_IN + I_UQ + I_UKV + 2 * I_O + I_OUT;
        for (int it = gw; it < NI; it += NGW) {
            int r = it;
            if (r < I_IN) { p0_transpose_item(w_in, D_, INW, (bf16_t*)(ws + WS_WIN), scr, r, F.lane, nullptr, SB_QSCALE, 512); continue; } r -= I_IN;
            if (r < I_UQ) { p0_transpose_item(w_uq, 384, 768, (bf16_t*)(ws + WS_WUQ), scr, r, F.lane, g_cq, 1.f, 0); continue; } r -= I_UQ;
            if (r < I_UKV) { p0_transpose_item(w_ukv, 256, 1024, (bf16_t*)(ws + WS_WUKV), scr, r, F.lane, g_ckv, 1.f, 0); continue; } r -= I_UKV;
            if (r < I_O) { p0_transpose_item(w_o_sb, 512, 1024, (bf16_t*)(ws + WS_WOSB), scr, r, F.lane, nullptr, 1.f, 0); continue; } r -= I_O;
            if (r < I_O) { p0_transpose_item(w_o_mla, 512, 1024, (bf16_t*)(ws + WS_WOMLA), scr, r, F.lane, nullptr, 1.f, 0); continue; } r -= I_O;
            p0_transpose_item(w_out, 1024, 1024, (bf16_t*)(ws + WS_WOUT), scr, r, F.lane, nullptr, 1.f, 0);
        }
        { const int gt = gw * 64 + F.lane, NGT = NGW * 64;
          u32x4 z = {0u, 0u, 0u, 0u};
          u32x4* pz = (u32x4*)((bf16_t*)(ws + WS_WIN) + (size_t)INW * D_);
          for (int i = gt; i < (INWP - INW) * D_ * 2 / 16; i += NGT) pz[i] = z;
          u32x4* hz = (u32x4*)((unsigned char*)(ws + WS_H2F8) + (size_t)M_ * D_);
          for (int i = gt; i < D_ / 16; i += NGT) hz[i] = z;
          const int* pos = (const int*)a.in[1]; float* rt = (float*)(ws + WS_ROPE);
          for (int i = gt; i < M_ * 16; i += NGT) { const int row = i >> 4, k = i & 15; const float inv = powf(10000.f, -(float)k / 16.f); const float ang = (float)pos[row] * inv; rt[row * 32 + k] = cosf(ang); rt[row * 32 + 16 + k] = sinf(ang); }
          float* wr = (float*)(ws + WS_WR);
          for (int i = gt; i < D_ * NE; i += NGT) wr[i] = w_router[i] * g_ffn[i >> 5];
        }
        for (int m = gw; m < M_; m += NGW) rms_row_to_bf16(a.in[0] + (size_t)m * D_, a.in[2], (bf16_t*)(ws + WS_HB) + (size_t)m * D_, F.lane);
    }
    if (do_moe_w) {
        constexpr int NI = NE * (I_UP1 + I_DN1);
        for (int it = gw; it < NI; it += NGW) {
            int r = it;
            if (r < NE * I_UP1) { const int e = r / I_UP1; p0_transpose_item_fp8(w_up + (size_t)e * D_ * 2 * DFF, D_, 2 * DFF, (unsigned char*)(ws + WS_WUP) + (size_t)e * 2 * DFF * D_, scr, r % I_UP1, F.lane, W8_SCALE); continue; }
            r -= NE * I_UP1;
            { const int e = r / I_DN1; p0_transpose_item_fp8(w_down + (size_t)e * DFF * D_, DFF, D_, (unsigned char*)(ws + WS_WDN) + (size_t)e * D_ * DFF, scr, r % I_DN1, F.lane, W8_SCALE); }
        }
    }
}

__device__ __forceinline__ void ld16bf(const bf16_t* p, float (&v)[16]) {
    const u32x4 a = *(const u32x4*)p, b = *(const u32x4*)(p + 8);
    v[0] = bflo(a.x); v[1] = bfhi(a.x); v[2] = bflo(a.y); v[3] = bfhi(a.y); v[4] = bflo(a.z); v[5] = bfhi(a.z); v[6] = bflo(a.w); v[7] = bfhi(a.w);
    v[8] = bflo(b.x); v[9] = bfhi(b.x); v[10] = bflo(b.y); v[11] = bfhi(b.y); v[12] = bflo(b.z); v[13] = bfhi(b.z); v[14] = bflo(b.w); v[15] = bfhi(b.w);
}
__device__ __forceinline__ void st16bf(bf16_t* p, const float (&v)[16]) {
    u32x4 a, b; a.x = cvtpk(v[0], v[1]); a.y = cvtpk(v[2], v[3]); a.z = cvtpk(v[4], v[5]); a.w = cvtpk(v[6], v[7]);
    b.x = cvtpk(v[8], v[9]); b.y = cvtpk(v[10], v[11]); b.z = cvtpk(v[12], v[13]); b.w = cvtpk(v[14], v[15]);
    *(u32x4*)p = a; *(u32x4*)(p + 8) = b;
}
struct PrepIn { unsigned cq0, cq1, cq2; u32x2 ckv; u32x4 qa, qb, ka, kb, vv; float rope; };
__device__ __forceinline__ void p4_load(PrepIn& in, int row, const bf16_t* proj, const bf16_t* qraw, const bf16_t* kvraw, const float* rope, int lane) {
    const int h = lane >> 3, s = lane & 7;
    const bf16_t* pr = proj + (size_t)row * INWP;
    { const bf16_t* p = pr + C_CQ + lane * 6; in.cq0 = *(const unsigned*)p; in.cq1 = *(const unsigned*)(p + 2); in.cq2 = *(const unsigned*)(p + 4); }
    in.ckv = *(const u32x2*)(pr + C_CKV + lane * 4);
    in.rope = rope[(size_t)row * 32 + (lane & 31)];
    const u32x4 z = {0u, 0u, 0u, 0u};
    in.qa = z; in.qb = z; in.ka = z; in.kb = z;
    if (s < 6) { const bf16_t* q = qraw + (size_t)row * 768 + h * 96 + s * 16; in.qa = *(const u32x4*)q; in.qb = *(const u32x4*)(q + 8);
        const bf16_t* k = (s < 4) ? (kvraw + (size_t)row * 1024 + h * 128 + s * 16) : (pr + C_KR + (s - 4) * 16); in.ka = *(const u32x4*)k; in.kb = *(const u32x4*)(k + 8); }
    in.vv = *(const u32x4*)(kvraw + (size_t)row * 1024 + (lane >> 3) * 128 + 64 + (lane & 7) * 8);
}
__device__ __forceinline__ void unpack16(const u32x4 a, const u32x4 b, float (&v)[16]) {
    v[0] = bflo(a.x); v[1] = bfhi(a.x); v[2] = bflo(a.y); v[3] = bfhi(a.y); v[4] = bflo(a.z); v[5] = bfhi(a.z); v[6] = bflo(a.w); v[7] = bfhi(a.w);
    v[8] = bflo(b.x); v[9] = bfhi(b.x); v[10] = bflo(b.y); v[11] = bfhi(b.y); v[12] = bflo(b.z); v[13] = bfhi(b.z); v[14] = bflo(b.w); v[15] = bfhi(b.w);
}
__device__ __forceinline__ void p4_prep(Frame& F, const Args& a) {
    unsigned char* ws = F.ws;
    const bf16_t* proj = (const bf16_t*)(ws + WS_PROJ); const bf16_t* qraw = (const bf16_t*)(ws + WS_QRAW); const bf16_t* kvraw = (const bf16_t*)(ws + WS_KVRAW);
    bf16_t* QB = (bf16_t*)(ws + WS_QB); bf16_t* KB = (bf16_t*)(ws + WS_KB); bf16_t* VB = (bf16_t*)(ws + WS_VB);
    const float* rope = (const float*)(ws + WS_ROPE); const float* gq = a.in[8]; const float* gk = a.in[9];
    const int gw = F.vcu * NWAVES + F.wave, NGW = F.G * NWAVES, lane = F.lane, h = lane >> 3, s = lane & 7;
    float gqv[16], gkv[16];
#pragma unroll
    for (int j = 0; j < 16; ++j) { gqv[j] = (s < 6) ? gq[s * 16 + j] : 0.f; gkv[j] = (s < 6) ? gk[s * 16 + j] : 0.f; }
    PrepIn cur, nxt;
    if (gw < M_) p4_load(cur, gw, proj, qraw, kvraw, rope, lane);
    for (int row = gw; row < M_; row += NGW) {
        const bool hn = row + NGW < M_;
        if (hn) p4_load(nxt, row + NGW, proj, qraw, kvraw, rope, lane);
        float sq = bflo(cur.cq0) * bflo(cur.cq0) + bfhi(cur.cq0) * bfhi(cur.cq0) + bflo(cur.cq1) * bflo(cur.cq1) + bfhi(cur.cq1) * bfhi(cur.cq1) + bflo(cur.cq2) * bflo(cur.cq2) + bfhi(cur.cq2) * bfhi(cur.cq2);
        float skv = bflo(cur.ckv.x) * bflo(cur.ckv.x) + bfhi(cur.ckv.x) * bfhi(cur.ckv.x) + bflo(cur.ckv.y) * bflo(cur.ckv.y) + bfhi(cur.ckv.y) * bfhi(cur.ckv.y);
        sq = wave_sum(sq); skv = wave_sum(skv);
        const float var_cq = sq * (1.f / 384.f) + EPS;
        const float rstd_ckv = rsqrtf(skv * (1.f / 256.f) + EPS);
        float cs[16], sn[16];
#pragma unroll
        for (int j = 0; j < 16; ++j) { cs[j] = __int_as_float(__builtin_amdgcn_readlane(__float_as_int(cur.rope), j)); sn[j] = __int_as_float(__builtin_amdgcn_readlane(__float_as_int(cur.rope), 16 + j)); }
        {
            float v[16]; unpack16(cur.qa, cur.qb, v);
            float ss = 0.f;
#pragma unroll
            for (int j = 0; j < 16; ++j) ss += v[j] * v[j];
            ss += __shfl_xor(ss, 1); ss += __shfl_xor(ss, 2); ss += __shfl_xor(ss, 4);
            const float r = rsqrtf(ss * (1.f / 96.f) + EPS * var_cq);
#pragma unroll
            for (int j = 0; j < 16; ++j) v[j] = v[j] * r * gqv[j];
            float o[16];
#pragma unroll
            for (int j = 0; j < 16; ++j) { const float pv = __shfl_xor(v[j], 1);
                o[j] = (s == 4) ? (v[j] * cs[j] - pv * sn[j]) : (s == 5) ? (v[j] * cs[j] + pv * sn[j]) : v[j]; o[j] *= MLA_QSCALE; }
            if (s < 6) st16bf(QB + (size_t)row * 768 + h * 96 + s * 16, o);
        }
        {
            float v[16]; unpack16(cur.ka, cur.kb, v);
            if (s < 4) {
#pragma unroll
                for (int j = 0; j < 16; ++j) v[j] *= rstd_ckv; }
            float ss = 0.f;
#pragma unroll
            for (int j = 0; j < 16; ++j) ss += v[j] * v[j];
            ss += __shfl_xor(ss, 1); ss += __shfl_xor(ss, 2); ss += __shfl_xor(ss, 4);
            const float r = rsqrtf(ss * (1.f / 96.f) + EPS);
#pragma unroll
            for (int j = 0; j < 16; ++j) v[j] = v[j] * r * gkv[j];
            float o[16];
#pragma unroll
            for (int j = 0; j < 16; ++j) { const float pv = __shfl_xor(v[j], 1);
                o[j] = (s == 4) ? (v[j] * cs[j] - pv * sn[j]) : (s == 5) ? (v[j] * cs[j] + pv * sn[j]) : v[j]; }
            if (s < 6) st16bf(KB + (size_t)row * 768 + h * 96 + s * 16, o);
            const u32x4 vw = cur.vv;
            u32x4 ow; ow.x = cvtpk(bflo(vw.x) * rstd_ckv, bfhi(vw.x) * rstd_ckv); ow.y = cvtpk(bflo(vw.y) * rstd_ckv, bfhi(vw.y) * rstd_ckv);
            ow.z = cvtpk(bflo(vw.z) * rstd_ckv, bfhi(vw.z) * rstd_ckv); ow.w = cvtpk(bflo(vw.w) * rstd_ckv, bfhi(vw.w) * rstd_ckv);
            *(u32x4*)(VB + (size_t)row * 512 + lane * 8) = ow;
        }
        if (hn) cur = nxt;
    }
}
namespace att {
constexpr int BUFB = 20480;
constexpr int WREG = 8448;
constexpr int OST_OFF = 2 * BUFB;
constexpr int WSF_OFF = OST_OFF + 8 * WREG;
constexpr int FLG_OFF = WSF_OFF + 8 * 256;
__device__ __forceinline__ int crow(int r, int hi) { return (r & 3) + 8 * (r >> 2) + 4 * hi; }
__device__ __forceinline__ s16x4 vtr(const LAS char* p) { typedef short v4i16_t __attribute__((ext_vector_type(4))); return __builtin_bit_cast(s16x4, __builtin_amdgcn_ds_read_tr16_b64_v4i16((LAS v4i16_t*)p)); }
#define ATT_MFMA(a, b, c) __builtin_amdgcn_mfma_f32_32x32x16_bf16((a), (b), (c), 0, 0, 0)

template <int NCH> struct Stage {
    u32x4 k0, k1, v0;
    __device__ __forceinline__ void load(const bf16_t* Kb, int pitchK, const bf16_t* Vb, int pitchV, int key0, int wid, int lane) {
        k0 = *(const u32x4*)(Kb + (size_t)(key0 + lane) * pitchK + wid * 8);
        if (NCH > 8) { if (wid < NCH - 8) k1 = *(const u32x4*)(Kb + (size_t)(key0 + lane) * pitchK + (8 + wid) * 8); }
        v0 = *(const u32x4*)(Vb + (size_t)(key0 + 16 * (wid & 3) + (lane >> 2)) * pitchV + (wid >> 2) * 32 + (lane & 3) * 8);
    }
    __device__ __forceinline__ void write(LAS unsigned char* buf, int wid, int lane) const {
        *(LAS u32x4*)(buf + wid * 1024 + lane * 16) = k0;
        if (NCH > 8) { if (wid < NCH - 8) *(LAS u32x4*)(buf + (8 + wid) * 1024 + lane * 16) = k1; }
        *(LAS u32x4*)(buf + NCH * 1024 + wid * 1024 + lane * 16) = v0;
    }
};

__device__ __forceinline__ void pv_tile(f32x16 (&o)[2], const LAS char* vp, const bf16x8 (&pa)[4]) {
#pragma unroll
    for (int d0 = 0; d0 < 2; ++d0)
#pragma unroll
        for (int ks = 0; ks < 4; ++ks) {
            const s16x4 lo = vtr(vp + d0 * 4096 + ks * 1024), hi = vtr(vp + d0 * 4096 + ks * 1024 + 512);
            const bf16x8 vf = __builtin_shufflevector(lo, hi, 0, 1, 2, 3, 4, 5, 6, 7);
            o[d0] = ATT_MFMA(pa[ks], vf, o[d0]);
        }
}
__device__ __forceinline__ bf16x8 pack8(const f32x16& p, int base) {
    u32x4 w; w.x = cvtpk(p[base], p[base + 1]); w.y = cvtpk(p[base + 2], p[base + 3]); w.z = cvtpk(p[base + 4], p[base + 5]); w.w = cvtpk(p[base + 6], p[base + 7]);
    return __builtin_bit_cast(bf16x8, w);
}
__device__ __forceinline__ void store_o(const f32x16 (&o)[2], const float (&rs)[16], LAS unsigned char* lds, int wid, int lane, bf16_t* Ow) {
    const int r32 = lane & 31, hi = lane >> 5;
    LAS bf16_t* stg = (LAS bf16_t*)(lds + OST_OFF + wid * WREG);
#pragma unroll
    for (int r = 0; r < 16; ++r) { const int orow = crow(r, hi);
#pragma unroll
        for (int d0 = 0; d0 < 2; ++d0) { const unsigned w = cvtpk(o[d0][r] * rs[r], 0.f); stg[orow * 64 + d0 * 32 + r32] = (bf16_t)(w & 0xffffu); } }
    asm volatile("s_waitcnt lgkmcnt(0)" ::: "memory");
#pragma unroll
    for (int i = 0; i < 4; ++i) { const int row = i * 8 + (lane >> 3), ch = lane & 7; const u32x4 v = *(const LAS u32x4*)(stg + row * 64 + ch * 8); *(u32x4*)(Ow + (size_t)row * 512 + ch * 8) = v; }
    asm volatile("s_waitcnt lgkmcnt(0)" ::: "memory");
}


constexpr int MLA_CONV_PERIOD = 6;
struct Conv {
    const float* w_up; const float* w_down; unsigned char* up8; unsigned char* dn8; int item, step, ctr; bool inflight; float tv[32];
    static constexpr int I_UP1 = (D_ / 64) * (2 * DFF / 32), I_DN1 = (DFF / 64) * (D_ / 32), NI = NE * (I_UP1 + I_DN1);
    const float* src; unsigned char* dst; int K, N;
    __device__ __forceinline__ bool pending() const { return item < NI; }
    __device__ __forceinline__ void load(int lane) { load_to(tv, lane); }
    __device__ __forceinline__ void load_to(float (&tv)[32], int lane) {
        int r = item;
        if (r < NE * I_UP1) { const int e = r / I_UP1; r %= I_UP1; K = D_; N = 2 * DFF; const int nblk = N / 32, kb = r / nblk, nb = r % nblk; src = w_up + (size_t)e * D_ * 2 * DFF + (size_t)(64 * kb) * N + 32 * nb; dst = up8 + (size_t)e * 2 * DFF * D_ + (size_t)(32 * nb) * K + 64 * kb; }
        else { r -= NE * I_UP1; const int e = r / I_DN1; r %= I_DN1; K = DFF; N = D_; const int nblk = N / 32, kb = r / nblk, nb = r % nblk; src = w_down + (size_t)e * DFF * D_ + (size_t)(64 * kb) * N + 32 * nb; dst = dn8 + (size_t)e * D_ * DFF + (size_t)(32 * nb) * K + 64 * kb; }
#pragma unroll
        for (int i = 0; i < 32; ++i) { const int kk = 2 * i + (lane >> 5); tv[i] = src[(size_t)kk * N + (lane & 31)]; }
    }
    __device__ __forceinline__ void finish(LAS float* scr, int lane) { finish_from(tv, scr, lane); }
    __device__ __forceinline__ void finish_from(const float (&tv)[32], LAS float* scr, int lane) {
#pragma unroll
        for (int i = 0; i < 32; ++i) { const int kk = 2 * i + (lane >> 5); scr[kk * 33 + (lane & 31)] = tv[i] * W8_SCALE; }
        asm volatile("s_waitcnt lgkmcnt(0)" ::: "memory");
        const int cc = lane & 7;
#pragma unroll
        for (int j = 0; j < 4; ++j) { const int n = (lane >> 3) + 8 * j; const LAS float* s = scr + (8 * cc) * 33 + n;
            u32x2 o; o.x = pk_fp8x4(s[0 * 33], s[1 * 33], s[2 * 33], s[3 * 33]); o.y = pk_fp8x4(s[4 * 33], s[5 * 33], s[6 * 33], s[7 * 33]);
            *(u32x2*)(dst + (size_t)n * K + 8 * cc) = o; }
        asm volatile("s_waitcnt lgkmcnt(0)" ::: "memory");
        item += step;
    }
    __device__ __forceinline__ void tick_begin(int lane) { if (!inflight && ctr == 0 && pending()) { load(lane); inflight = true; } }
    __device__ __forceinline__ void tick_end(LAS float* scr, int lane) { if (inflight && ctr == 2) { finish(scr, lane); inflight = false; } ctr = (ctr == MLA_CONV_PERIOD - 1) ? 0 : ctr + 1; }
    __device__ __forceinline__ void flush(LAS float* scr, int lane) { if (inflight) { finish(scr, lane); inflight = false; } ctr = 0; }
    __device__ __forceinline__ void drain(LAS float* scr, int lane) { while (pending()) { float t2[32]; load_to(t2, lane); finish_from(t2, scr, lane); } }
};
__device__ __forceinline__ void mla_unit(LAS unsigned char* lds, int b, int h, int qb, const bf16_t* QB, const bf16_t* KB, const bf16_t* VB, bf16_t* O, float m0, Conv& cv) {
    const int tid = threadIdx.x, lane = tid & 63, r32 = lane & 31, hi = lane >> 5; const int wid = __builtin_amdgcn_readfirstlane(tid >> 6);
    const size_t rb = (size_t)b * S_; const int q0 = qb * 256;
    const bf16_t* Kh = KB + rb * 768 + h * 96; const bf16_t* Vh = VB + rb * 512 + h * 64;
    bf16x8 qr[6];
    { const bf16_t* qp = QB + (rb + q0 + wid * 32 + r32) * 768 + h * 96 + hi * 8;
#pragma unroll
      for (int d0 = 0; d0 < 6; ++d0) qr[d0] = *(const bf16x8*)(qp + d0 * 16); }
    const int NT = 4 * qb + 4, my_last = 4 * qb + (wid >> 1);
    f32x16 o[2]; float l = 0.f;
#pragma unroll
    for (int r = 0; r < 16; ++r) { o[0][r] = 0.f; o[1][r] = 0.f; }
    Stage<12> st;
    st.load(Kh, 768, Vh, 512, 0, wid, lane); st.write(lds, wid, lane);
    __syncthreads();
    LAS float* cscr = (LAS float*)(lds + OST_OFF + wid * WREG);
    for (int t = 0; t < NT; ++t) {
        if (t + 1 < NT) st.load(Kh, 768, Vh, 512, (t + 1) * 64, wid, lane);
        asm volatile("" ::: "memory");
        cv.tick_begin(lane);
        if (t <= my_last) {
            const LAS char* buf = (const LAS char*)(lds + (t & 1) * BUFB);
            const LAS char* kp = buf + hi * 1024 + r32 * 16;
            f32x16 p0, p1;
#pragma unroll
            for (int r = 0; r < 16; ++r) { p0[r] = -m0; p1[r] = -m0; }
#pragma unroll
            for (int d0 = 0; d0 < 6; ++d0) { const bf16x8 a0 = *(const LAS bf16x8*)(kp + d0 * 2048), a1 = *(const LAS bf16x8*)(kp + d0 * 2048 + 512);
                p0 = ATT_MFMA(a0, qr[d0], p0); p1 = ATT_MFMA(a1, qr[d0], p1); }
            float ls = 0.f;
#pragma unroll
            for (int r = 0; r < 16; ++r) { p0[r] = __builtin_amdgcn_exp2f(p0[r]); p1[r] = __builtin_amdgcn_exp2f(p1[r]); ls += p0[r] + p1[r]; }
            l += ls;
            bf16x8 pa[4]; pa[0] = pack8(p0, 0); pa[1] = pack8(p0, 8); pa[2] = pack8(p1, 0); pa[3] = pack8(p1, 8);
            const LAS char* vp = buf + 12 * 1024 + ((lane >> 4) & 1) * 32 + (lane & 3) * 8 + (4 * hi + ((lane & 15) >> 2)) * 64;
            pv_tile(o, vp, pa);
        }
        if (t + 1 < NT) st.write(lds + ((t + 1) & 1) * BUFB, wid, lane);
        cv.tick_end(cscr, lane);
        __syncthreads();
    }
    l += __shfl_xor(l, 32);
    LAS float* wsf = (LAS float*)(lds + WSF_OFF) + wid * 64;
    if (hi == 0) wsf[r32] = l;
    asm volatile("s_waitcnt lgkmcnt(0)" ::: "memory");
    float rs[16];
#pragma unroll
    for (int r = 0; r < 16; ++r) rs[r] = __builtin_amdgcn_rcpf(wsf[crow(r, hi)]);
    store_o(o, rs, lds, wid, lane, O + (rb + q0 + wid * 32) * 512 + h * 64);
}

constexpr float SB_THR = -152.f;
__device__ __forceinline__ void sb_unit(LAS unsigned char* lds, int b, int h, int qb, const bf16_t* proj, bf16_t* O, Conv& cv) {
    const int tid = threadIdx.x, lane = tid & 63, r32 = lane & 31, hi = lane >> 5; const int wid = __builtin_amdgcn_readfirstlane(tid >> 6);
    const size_t rb = (size_t)b * S_; const int q0 = qb * 256;
    const bf16_t* Kh = proj + rb * INWP + C_SBK + h * 64; const bf16_t* Vh = proj + rb * INWP + C_SBV + h * 64;
    bf16x8 qr[4];
    { const bf16_t* qp = proj + (rb + q0 + wid * 32 + r32) * INWP + C_SBQ + h * 64 + hi * 8;
#pragma unroll
      for (int d0 = 0; d0 < 4; ++d0) qr[d0] = *(const bf16x8*)(qp + d0 * 16); }
    const int Ttop = 4 * qb + 3, qw0 = q0 + wid * 32, qabs = qw0 + r32;
    f32x16 o[2]; float carry = 0.f;
#pragma unroll
    for (int r = 0; r < 16; ++r) { o[0][r] = 0.f; o[1][r] = 0.f; }
    volatile LAS int* flg = (volatile LAS int*)(lds + FLG_OFF);
    Stage<8> st;
    st.load(Kh, INWP, Vh, INWP, Ttop * 64, wid, lane); st.write(lds, wid, lane);
    __syncthreads();
    bool alive = true;
    for (int it = 0;; ++it) {
        const int t = Ttop - it;
        if (t > 0) st.load(Kh, INWP, Vh, INWP, (t - 1) * 64, wid, lane);
        asm volatile("" ::: "memory");
        float ctv[32]; const bool cvp = cv.pending();
        if (cvp) cv.load_to(ctv, lane);
        if (alive && (64 * t <= qw0 + 30)) {
            const LAS char* buf = (const LAS char*)(lds + (it & 1) * BUFB);
            const LAS char* kp = buf + hi * 1024 + r32 * 16;
            const bool need_mask = (64 * t + 63 >= qw0);
            bf16x8 pa[4];
#pragma unroll
            for (int blk = 1; blk >= 0; --blk) {
                f32x16 p;
#pragma unroll
                for (int r = 0; r < 16; ++r) p[r] = 0.f;
#pragma unroll
                for (int d0 = 0; d0 < 4; ++d0) { const bf16x8 a0 = *(const LAS bf16x8*)(kp + d0 * 2048 + blk * 512); p = ATT_MFMA(a0, qr[d0], p); }
                const int kb0 = 64 * t + 32 * blk + 4 * hi;
                f32x16 s;
#pragma unroll
                for (int r = 0; r < 16; ++r) {
                    const int key = kb0 + (r & 3) + 8 * (r >> 2);
                    const float z = p[r]; const float e = __builtin_amdgcn_exp2f(-fabsf(z)); const float tt = __builtin_amdgcn_logf(1.f + e); float lsv = fminf(-z, 0.f) - tt;
                    if (need_mask && !(key < qabs)) { lsv = 0.f; p[r] = -INFINITY; }
                    s[r] = lsv;
                }
                float T[5]; T[4] = 0.f;
#pragma unroll
                for (int i = 3; i >= 0; --i) T[i] = T[i + 1] + ((s[4 * i] + s[4 * i + 1]) + (s[4 * i + 2] + s[4 * i + 3]));
                float Tp[5]; Tp[4] = 0.f;
#pragma unroll
                for (int i = 0; i < 4; ++i) Tp[i] = __shfl_xor(T[i], 32);
#pragma unroll
                for (int i = 3; i >= 0; --i) {
                    float lat = carry + T[i + 1] + (hi ? Tp[i + 1] : Tp[i]);
#pragma unroll
                    for (int e3 = 3; e3 >= 0; --e3) { const int r = 4 * i + e3; const float lsv = s[r]; p[r] = __builtin_amdgcn_exp2f(lsv + p[r] + lat); lat += lsv; }
                }
                carry += T[0] + Tp[0];
                pa[2 * blk] = pack8(p, 0); pa[2 * blk + 1] = pack8(p, 8);
            }
            const LAS char* vp = buf + 8 * 1024 + ((lane >> 4) & 1) * 32 + (lane & 3) * 8 + (4 * hi + ((lane & 15) >> 2)) * 64;
            pv_tile(o, vp, pa);
            alive = __any(carry > SB_THR);
        }
        if (lane == 0) flg[(it & 1) * 8 + wid] = alive ? 1 : 0;
        if (t > 0) st.write(lds + ((it + 1) & 1) * BUFB, wid, lane);
        if (cvp) cv.finish_from(ctv, (LAS float*)(lds + OST_OFF + wid * WREG), lane);
        __syncthreads();
        if (t == 0) break;
        int any = 0;
#pragma unroll
        for (int w = 0; w < 8; ++w) any |= flg[(it & 1) * 8 + w];
        if (!any) break;
    }
    float rs[16];
#pragma unroll
    for (int r = 0; r < 16; ++r) rs[r] = 1.f;
    store_o(o, rs, lds, wid, lane, O + (rb + q0 + wid * 32) * 512 + h * 64);
}
}

__device__ __forceinline__ void p5_attention(Frame& F, const Args& a) {
    unsigned char* ws = F.ws;
    volatile LAS int* citem = (volatile LAS int*)(F.MISC + MI_CITEM) + F.wave;
    {
        float gm;
        { const float* gq = a.in[8]; const float* gk = a.in[9]; float mq = 0.f, mk = 0.f;
          for (int i = F.lane; i < 96; i += 64) { mq = fmaxf(mq, fabsf(gq[i])); mk = fmaxf(mk, fabsf(gk[i])); }
#pragma unroll
          for (int o = 1; o < 64; o <<= 1) { mq = fmaxf(mq, __shfl_xor(mq, o)); mk = fmaxf(mk, __shfl_xor(mk, o)); }
          gm = 9.79795897f * LOG2E * mq * mk; }
        att::Conv cv; cv.w_up = a.in[16]; cv.w_down = a.in[18]; cv.up8 = (unsigned char*)(ws + WS_WUP); cv.dn8 = (unsigned char*)(ws + WS_WDN);
        cv.item = F.vcu * NWAVES + F.wave; cv.step = F.G * NWAVES; cv.ctr = 0; cv.inflight = false;
        for (int v = F.vcu; v < 256; v += F.G) {
            const int bh = v >> 3, s = v & 7, b = bh >> 3, h = bh & 7;
            for (int i = 0; i < 2; ++i) { const int qb = i ? 15 - s : s;
                att::mla_unit(F.lds, b, h, qb, (const bf16_t*)(ws + WS_QB), (const bf16_t*)(ws + WS_KB), (const bf16_t*)(ws + WS_VB), (bf16_t*)(ws + WS_OMLA), gm, cv);
                __syncthreads(); }
        }
        cv.flush((LAS float*)(F.lds + att::OST_OFF + F.wave * att::WREG), F.lane);
        if (F.lane == 0) *citem = cv.item;
    }
    __syncthreads();
    {
        att::Conv cv; cv.w_up = a.in[16]; cv.w_down = a.in[18]; cv.up8 = (unsigned char*)(ws + WS_WUP); cv.dn8 = (unsigned char*)(ws + WS_WDN);
        cv.item = __builtin_amdgcn_readfirstlane(*citem); cv.step = F.G * NWAVES; cv.ctr = 0; cv.inflight = false;
        for (int v = F.vcu; v < 256; v += F.G) {
            const int bh = v >> 3, s = v & 7, b = bh >> 3, h = bh & 7;
            for (int i = 0; i < 2; ++i) { const int qb = i ? 15 - s : s;
                att::sb_unit(F.lds, b, h, qb, (const bf16_t*)(ws + WS_PROJ), (bf16_t*)(ws + WS_OSB), cv);
                __syncthreads(); }
        }
        cv.drain((LAS float*)(F.lds + att::OST_OFF + F.wave * att::WREG), F.lane);
    }
}

__device__ __forceinline__ void p8_router(Frame& F, const Args& a) {
    unsigned char* ws = F.ws;
    const float* x1 = a.out; const float* wr = (const float*)(ws + WS_WR); const float* br = a.in[15]; const float* g = a.in[13];
    unsigned char* H2 = (unsigned char*)(ws + WS_H2F8); int* list = (int*)(ws + WS_LIST); float* topw = (float*)(ws + WS_TOPW); int* selo = (int*)(ws + WS_SEL);
    int* cnt = (int*)(ws + WS_CTL) + CW_CNT;
    volatile LAS int* lcnt = (volatile LAS int*)(F.MISC + MI_LCNT); volatile LAS int* lbase = (volatile LAS int*)(F.MISC + MI_BASE);
    const int lane = F.lane, wave = F.wave, tid = F.tid;
    constexpr int WST = 1028;
    LAS float* wt = (LAS float*)F.lds;
    if (F.vcu < M_ / 64) {
        for (int i = tid; i < D_ * NE / 4; i += NTHR) { const f32x4 v = *(const f32x4*)(wr + (size_t)i * 4); const int k = i >> 3, e = (i & 7) * 4;
            wt[(e + 0) * WST + k] = v.x; wt[(e + 1) * WST + k] = v.y; wt[(e + 2) * WST + k] = v.z; wt[(e + 3) * WST + k] = v.w; }
    }
    __syncthreads();
    for (int task = F.vcu; task < M_ / 64; task += F.G) {
        const int T0 = task * 64;
        if (tid < 32) lcnt[tid] = 0;
        __syncthreads();
        int my_e = 0, my_rank = 0; float my_w = 0.f;
        if (wave < 4) {
            const int tk = lane & 15, kp = lane >> 4, tok = T0 + wave * 16 + tk;
            const float* xp = x1 + (size_t)tok * D_ + kp * 256;
            const LAS float* w0 = wt + tk * WST + kp * 256; const LAS float* w1 = w0 + 16 * WST;
            f32x4 acc0 = {0.f, 0.f, 0.f, 0.f}, acc1 = {0.f, 0.f, 0.f, 0.f}; float ssq = 0.f;
#pragma unroll 4
            for (int i = 0; i < 256; i += 4) {
                const f32x4 a4 = *(const f32x4*)(xp + i); const f32x4 b0 = *(const LAS f32x4*)(w0 + i), b1 = *(const LAS f32x4*)(w1 + i);
                ssq += (a4.x * a4.x + a4.y * a4.y) + (a4.z * a4.z + a4.w * a4.w);
#pragma unroll
                for (int j = 0; j < 4; ++j) { acc0 = __builtin_amdgcn_mfma_f32_16x16x4f32(a4[j], b0[j], acc0, 0, 0, 0); acc1 = __builtin_amdgcn_mfma_f32_16x16x4f32(a4[j], b1[j], acc1, 0, 0, 0); }
            }
            ssq += __shfl_xor(ssq, 16); ssq += __shfl_xor(ssq, 32);
            const float rstd = rsqrtf(ssq * (1.f / D_) + EPS);
            const int e0 = lane & 15, grp = lane >> 4;
            const float bia0 = br[e0], bia1 = br[e0 + 16];
#pragma unroll
            for (int j = 0; j < 4; ++j) {
                const float rs = __shfl(rstd, 4 * grp + j);
                float c0 = acc0[j] * rs + bia0, c1 = acc1[j] * rs + bia1;
                float sv[4]; int si[4];
#pragma unroll
                for (int k = 0; k < 4; ++k) {
                    float best = c0; int bi = e0;
                    if (c1 > best) { best = c1; bi = e0 + 16; }
#pragma unroll
                    for (int o = 1; o < 16; o <<= 1) { const float ob = __shfl_xor(best, o); const int oi = __shfl_xor(bi, o); if (ob > best || (ob == best && oi < bi)) { best = ob; bi = oi; } }
                    sv[k] = best; si[k] = bi;
                    if (bi == e0) c0 = -INFINITY; if (bi == e0 + 16) c1 = -INFINITY;
                }
                float ex[4], sum = 0.f;
#pragma unroll
                for (int k = 0; k < 4; ++k) { ex[k] = __expf(sv[k] - sv[0]); sum += ex[k]; }
                const float inv = 1.f / sum;
                if (((lane >> 2) & 3) == j) {
#pragma unroll
                    for (int k = 0; k < 4; ++k) if ((lane & 3) == k) { my_e = si[k]; my_w = ex[k] * inv; }
                }
            }
            my_rank = atomicAdd((int*)&lcnt[my_e], 1);
        } else {
            const f32x4* gr = (const f32x4*)g + lane;
            f32x4 gg[4];
#pragma unroll
            for (int j = 0; j < 4; ++j) gg[j] = gr[64 * j] * X8_SCALE;
            for (int rr = 0; rr < 16; rr += 2) {
                const int t0 = T0 + (wave - 4) * 16 + rr;
                const f32x4* xr0 = (const f32x4*)(x1 + (size_t)t0 * D_) + lane; const f32x4* xr1 = xr0 + D_ / 4;
                f32x4 v0[4], v1[4]; float s0 = 0.f, s1 = 0.f;
#pragma unroll
                for (int j = 0; j < 4; ++j) { v0[j] = xr0[64 * j]; v1[j] = xr1[64 * j]; }
#pragma unroll
                for (int j = 0; j < 4; ++j) { s0 += (v0[j].x * v0[j].x + v0[j].y * v0[j].y) + (v0[j].z * v0[j].z + v0[j].w * v0[j].w); s1 += (v1[j].x * v1[j].x + v1[j].y * v1[j].y) + (v1[j].z * v1[j].z + v1[j].w * v1[j].w); }
                const float r0 = rsqrtf(wave_sum(s0) * (1.f / D_) + EPS), r1 = rsqrtf(wave_sum(s1) * (1.f / D_) + EPS);
                unsigned* o0 = (unsigned*)(H2 + (size_t)t0 * D_) + lane; unsigned* o1 = o0 + D_ / 4;
#pragma unroll
                for (int j = 0; j < 4; ++j) { o0[64 * j] = pk_fp8x4(v0[j].x * r0 * gg[j].x, v0[j].y * r0 * gg[j].y, v0[j].z * r0 * gg[j].z, v0[j].w * r0 * gg[j].w);
                    o1[64 * j] = pk_fp8x4(v1[j].x * r1 * gg[j].x, v1[j].y * r1 * gg[j].y, v1[j].z * r1 * gg[j].z, v1[j].w * r1 * gg[j].w); }
            }
        }
        __syncthreads();
        if (tid < 32) lbase[tid] = lcnt[tid] ? atomicAdd(&cnt[tid], lcnt[tid]) : 0;
        __syncthreads();
        if (wave < 4) {
            const int grp = lane >> 4, jj = (lane >> 2) & 3, kk = lane & 3;
            const int tok = T0 + wave * 16 + 4 * grp + jj, slot = tok * 4 + kk;
            list[(size_t)my_e * M_ + lbase[my_e] + my_rank] = slot;
            topw[slot] = my_w; selo[slot] = my_e;
        }
        __syncthreads();
    }
}

struct MoeOrder {
    const bf16_t* A; const bf16_t* Bt; const int* list; volatile LAS unsigned* tab;
    int lda, ldb, nN, nwg, G, c, gather; size_t estride;
    __device__ void init(const bf16_t* A_, int lda_, const bf16_t* Bt_, int ldb_, size_t estride_, int nN_, const int* list_, volatile LAS unsigned* tab_, int gather_, int G_, int c_) {
        A = A_; lda = lda_; Bt = Bt_; ldb = ldb_; estride = estride_; nN = nN_; list = list_; tab = tab_; gather = gather_; G = G_; c = c_; nwg = (int)tab[MI_TPFX + NE] * nN_; }
    __device__ __forceinline__ bool next(int i, pg8::Unit& u) const {
        const long L = (long)i * G + c; if (L >= nwg) return false;
        int wgid = (int)L; { const int q = nwg / 8, r = nwg % 8, xcd = wgid % 8, off = wgid / 8; wgid = (xcd < r ? xcd * (q + 1) : r * (q + 1) + (xcd - r) * q) + off; }
        int e = 0;
        for (int k = 1; k < NE; ++k) if ((int)tab[MI_TPFX + k] * nN <= wgid) e = k;
        const int t0 = (int)tab[MI_TPFX + e], nt = (int)tab[MI_TPFX + e + 1] - t0, idx = wgid - t0 * nN;
        u.e = e; u.pn = idx / nt; u.rt = idx % nt; u.pm = t0 + u.rt; const int left = (int)tab[MI_CNT + e] - u.rt * 256; u.rows = left < 256 ? left : 256; return true;
    }
    __device__ __forceinline__ unsigned a_off(const pg8::Unit& u, int r, int C) const {
        int row;
        if (gather) row = (r < u.rows) ? (list[(size_t)u.e * M_ + u.rt * 256 + r] >> 2) : M_;
        else row = u.pm * 256 + r;
        return (unsigned)((row * lda + C) * 2);
    }
    __device__ __forceinline__ const char* b_base(const pg8::Unit& u) const { return (const char*)(Bt + (size_t)u.e * estride + (size_t)u.pn * 256 * ldb); }
};
__device__ __forceinline__ void moe_table(Frame& F) {
    int* cnt = (int*)(F.ws + WS_CTL) + CW_CNT;
    if (F.tid < NE) F.MISC[MI_CNT + F.tid] = __hip_atomic_load((unsigned*)cnt + F.tid, RLX_AGENT);
    __syncthreads();
    if (F.tid == 0) { unsigned p = 0; for (int e = 0; e < NE; ++e) { F.MISC[MI_TPFX + e] = p; p += (F.MISC[MI_CNT + e] + 255u) >> 8; } F.MISC[MI_TPFX + NE] = p; }
    __syncthreads();
}

__device__ __forceinline__ void p12_combine(Frame& F, const Args& a) {
    const bf16_t* Y = (const bf16_t*)(F.ws + WS_YB); float* out = a.out;
    const int gt = (F.vcu * NWAVES + F.wave) * 64 + F.lane, NGT = F.G * NTHR;
    for (int i = gt; i < M_ * D_ / 8; i += NGT) {
        const int t = i >> 7, c = (i & 127) * 8;
        f32x4 v0 = *(const f32x4*)(out + (size_t)t * D_ + c), v1 = *(const f32x4*)(out + (size_t)t * D_ + c + 4);
#pragma unroll
        for (int k = 0; k < 4; ++k) { const u32x4 w = *(const u32x4*)(Y + (size_t)(t * 4 + k) * D_ + c);
            v0.x += bflo(w.x); v0.y += bfhi(w.x); v0.z += bflo(w.y); v0.w += bfhi(w.y); v1.x += bflo(w.z); v1.y += bfhi(w.z); v1.z += bflo(w.w); v1.w += bfhi(w.w); }
        *(f32x4*)(out + (size_t)t * D_ + c) = v0; *(f32x4*)(out + (size_t)t * D_ + c + 4) = v1;
    }
}

constexpr int N_PHASES = 11;
#ifndef DUP_PHASE
#define DUP_PHASE -1
#endif
__global__ void __launch_bounds__(NTHR, 2) mega(Args args) {
    extern __shared__ __attribute__((aligned(16))) unsigned char lds_raw[];
    Frame F;
    F.lds = (LAS unsigned char*)lds_raw; F.MISC = (volatile LAS unsigned*)(F.lds + LDS_MISC);
    F.tid = threadIdx.x; F.lane = F.tid & 63; F.wave = __builtin_amdgcn_readfirstlane(F.tid >> 6);
    F.G = gridDim.x; { const int bx = blockIdx.x; F.vcu = (F.G % 8 == 0) ? (bx % 8) * (F.G / 8) + bx / 8 : bx; }
    F.ws = args.ws;
    unsigned char* ws = args.ws;
    for (int u = F.tid; u < (LDS_BYTES - LDS_MISC) / 4; u += NTHR) F.MISC[u] = 0u;
    __syncthreads();
    const int lo = args.ph_lo, hi = args.ph_hi;
    XcdBarrier bar; bar.bar = (unsigned*)(ws + WS_CTL) + CW_BAR; bar.x = 0; bar.st = nullptr;
    if (hi - lo > 1) bar = xcd_barrier_post((unsigned*)(ws + WS_CTL) + CW_BAR, F.MISC + MI_BAR);
#define IN(k) (lo <= (k) && (k) < hi)
#ifdef MEGA_STAMPS
#define STAMP(k) do { if (blockIdx.x == 0 && F.tid == 0) ((unsigned long long*)(ws + WS_CTL + 32768))[(k)] = __builtin_amdgcn_s_memrealtime(); } while (0)
#else
#define STAMP(k) do { } while (0)
#endif
#define SEAM(k) do { if (IN(k) && IN((k) + 1)) xcd_barrier(bar); STAMP((k) + 1); } while (0)
    const int cid = (int)blockIdx.x;
    STAMP(0);

    if (IN(0)) { p0_prologue(F, args, 0, 1); SEAM(0); }
    if (IN(1)) {
        pg8::Gemm g{(const bf16_t*)(ws + WS_HB), D_, D_, D_};
        pg8::StaticOrder S; S.init(g.A, D_, (const bf16_t*)(ws + WS_WIN), D_, M_, 4096, F.G, cid);
        pg8::EpiBf16 E{(bf16_t*)(ws + WS_PROJ), INWP};
        pg8::gemm_phase(F.lds, g, S, E);
        SEAM(1);
    }
    if (IN(2)) {
        { pg8::Gemm g{(const bf16_t*)(ws + WS_HB), D_, D_, D_};
          pg8::StaticOrder S; S.init(g.A, D_, (const bf16_t*)(ws + WS_WIN) + (size_t)4096 * D_, D_, M_, 256, F.G, cid);
          pg8::EpiBf16 E{(bf16_t*)(ws + WS_PROJ) + 4096, INWP};
          pg8::gemm_phase(F.lds, g, S, E); }
        { pg8::Gemm g{(const bf16_t*)(ws + WS_PROJ) + C_CQ, INWP, 384, 384};
          pg8::StaticOrder S; S.init(g.A, INWP, (const bf16_t*)(ws + WS_WUQ), 384, M_, 768, F.G, cid, F.G - 64);
          pg8::EpiBf16 E{(bf16_t*)(ws + WS_QRAW), 768};
          pg8::gemm_phase(F.lds, g, S, E); }
        { pg8::Gemm g{(const bf16_t*)(ws + WS_PROJ) + C_CKV, INWP, 256, 256};
          pg8::StaticOrder S; S.init(g.A, INWP, (const bf16_t*)(ws + WS_WUKV), 256, M_, 1024, F.G, cid);
          pg8::EpiBf16 E{(bf16_t*)(ws + WS_KVRAW), 1024};
          pg8::gemm_phase(F.lds, g, S, E); }
        SEAM(2);
    }
    if (IN(3)) { p4_prep(F, args); SEAM(3); }
    if (IN(4)) { p5_attention(F, args); SEAM(4); }
    if (IN(5)) {
        pg8::Gemm g{(const bf16_t*)(ws + WS_OSB), 512, 512, 512};
        pg8::PairOrder S; S.S.init(g.A, 512, (const bf16_t*)(ws + WS_WOSB), 512, M_, D_, F.G, cid); S.a1 = (WS_OMLA - WS_OSB) / 2; S.b1 = (WS_WOMLA - WS_WOSB) / 2;
        pg8::EpiGate2 E{(bf16_t*)(ws + WS_MIX), (const bf16_t*)(ws + WS_PROJ), INWP, C_GSB, C_GMLA};
        pg8::gemm_phase(F.lds, g, S, E);
        SEAM(5);
    }
    if (IN(6)) {
        pg8::Gemm g{(const bf16_t*)(ws + WS_MIX), D_, D_, D_};
        pg8::StaticOrder S; S.init(g.A, D_, (const bf16_t*)(ws + WS_WOUT), D_, M_, D_, F.G, cid);
        pg8::EpiRes E{args.in[0], args.out};
        pg8::gemm_phase(F.lds, g, S, E);
        SEAM(6);
    }
    if (IN(7)) { p8_router(F, args); SEAM(7); }
    if (IN(8)) {
        moe_table(F);
        pg8::Gemm g{(const bf16_t*)(ws + WS_H2F8), D_ / 2, D_ / 2, D_ / 2};
        MoeOrder S; S.init(g.A, D_ / 2, (const bf16_t*)(ws + WS_WUP), D_ / 2, (size_t)2 * DFF * D_ / 2, 8, (const int*)(ws + WS_LIST), F.MISC, 1, F.G, cid);
        pg8::EpiSwiglu8 E{(unsigned char*)(ws + WS_ACT), args.in[17]};
        pg8::gemm_phase<pg8::EpiSwiglu8, MoeOrder, true>(F.lds, g, S, E);
        SEAM(8);
    }
    if (IN(9)) {
        moe_table(F);
        pg8::Gemm g{(const bf16_t*)(ws + WS_ACT), DFF / 2, DFF / 2, DFF / 2};
        MoeOrder S; S.init(g.A, DFF / 2, (const bf16_t*)(ws + WS_WDN), DFF / 2, (size_t)D_ * DFF / 2, 4, (const int*)(ws + WS_LIST), F.MISC, 0, F.G, cid);
        pg8::EpiDown E{(bf16_t*)(ws + WS_YB), args.in[19], (const int*)(ws + WS_LIST), (const float*)(ws + WS_TOPW)};
        pg8::gemm_phase<pg8::EpiDown, MoeOrder, true>(F.lds, g, S, E);
        SEAM(9);
    }
    if (IN(10)) { p12_combine(F, args); STAMP(11); }
#undef IN
#undef SEAM
}
static int g_grid = 0;
static int setup_grid() {
    if (g_grid == 0) {
        int dev = 0, cus = 0;
        if (hipGetDevice(&dev) != hipSuccess || hipDeviceGetAttribute(&cus, hipDeviceAttributeMultiprocessorCount, dev) != hipSuccess) { g_grid = -1; return g_grid; }
        if (hipFuncSetAttribute((const void*)mega, hipFuncAttributeMaxDynamicSharedMemorySize, LDS_BYTES) != hipSuccess) { g_grid = -1; return g_grid; }
        int per_cu = 0;
        (void)hipOccupancyMaxActiveBlocksPerMultiprocessor(&per_cu, (const void*)mega, NTHR, LDS_BYTES);
        (void)hipGetLastError();
        g_grid = cus;
    }
    return g_grid;
}
static void launch_mega(void* const* d_in, void* d_out, void* d_ws, int lo, int hi, hipStream_t stream) {
    Args a; memset(&a, 0, sizeof(a));
    for (int i = 0; i < 20; ++i) a.in[i] = (const float*)d_in[i];
    a.out = (float*)d_out; a.ws = (unsigned char*)d_ws; a.ph_lo = lo; a.ph_hi = hi;
    hipLaunchKernelGGL(mega, dim3(g_grid), dim3(NTHR), LDS_BYTES, stream, a);
}
extern "C" void kernel_launch(void* const* d_in, const int* in_sizes, int n_in, void* d_out, int out_size, void* d_ws, size_t ws_size, hipStream_t stream) {
    if (n_in != 20 || ws_size < WS_OPT_END || out_size != M_ * D_) { fprintf(stderr, "kernel_launch: unexpected arguments\n"); return; }
    if (setup_grid() <= 0) return;
    (void)hipMemsetAsync((char*)d_ws + WS_CTL, 0, CTL_ZERO_BYTES, stream);
#if N_LAUNCH_SPLIT
    for (int p = 0; p < N_PHASES; ++p) { launch_mega(d_in, d_out, d_ws, p, p + 1, stream); if (p == DUP_PHASE) { if (p == 7) (void)hipMemsetAsync((char*)d_ws + WS_CTL, 0, 128, stream); if (p == 10) launch_mega(d_in, d_out, d_ws, 6, 7, stream); launch_mega(d_in, d_out, d_ws, p, p + 1, stream); } }
#else
    launch_mega(d_in, d_out, d_ws, 0, N_PHASES, stream);
#endif
}
```

```cpp
#define N_LAUNCH_SPLIT 0
#include <hip/hip_runtime.h>
#include <hip/hip_bf16.h>
#include <cstdio>
#include <cstdint>
#include <cstring>
#include <cmath>

constexpr int B_ = 4, S_ = 4096, D_ = 1024, M_ = B_ * S_;
constexpr int INW = 4256, INWP = 4352;
constexpr int C_SBQ = 0, C_SBK = 512, C_SBV = 1024, C_CQ = 1536, C_CKV = 1920, C_KR = 2176, C_GSB = 2208, C_GMLA = 3232;
constexpr int NE = 32, TOPK = 4, DFF = 1024;
constexpr float EPS = 1e-6f;
constexpr float LOG2E = 1.4426950408889634f;
constexpr float SB_QSCALE = 0.125f * LOG2E;
constexpr float MLA_QSCALE = 0.10206207261596577f * LOG2E;
constexpr int NWAVES = 8, NTHR = 512;

#define LAS __attribute__((address_space(3)))
#define GAS __attribute__((address_space(1)))
typedef unsigned short bf16_t;
typedef short bf16x8 __attribute__((ext_vector_type(8)));
typedef short s16x4 __attribute__((ext_vector_type(4)));
typedef float f32x4 __attribute__((ext_vector_type(4)));
typedef float f32x16 __attribute__((ext_vector_type(16)));
typedef unsigned u32x4 __attribute__((ext_vector_type(4)));
typedef unsigned u32x2 __attribute__((ext_vector_type(2)));
typedef float f32x2_t __attribute__((ext_vector_type(2)));
typedef __bf16 bf16x2_t __attribute__((ext_vector_type(2)));
typedef int v8i_t __attribute__((ext_vector_type(8)));
constexpr float W8_SCALE = 8.f, X8_SCALE = 8.f;
__device__ __forceinline__ unsigned pk_fp8x4(float a, float b, float c, float d) { unsigned w = 0; w = __builtin_amdgcn_cvt_pk_fp8_f32(a, b, w, false); w = __builtin_amdgcn_cvt_pk_fp8_f32(c, d, w, true); return w; }

__device__ __forceinline__ unsigned cvtpk(float lo, float hi) { f32x2_t v = {lo, hi}; bf16x2_t b = __builtin_convertvector(v, bf16x2_t); return __builtin_bit_cast(unsigned, b); }
__device__ __forceinline__ float bf2f(unsigned short h) { return __uint_as_float(((unsigned)h) << 16); }
__device__ __forceinline__ float bflo(unsigned w) { return __uint_as_float(w << 16); }
__device__ __forceinline__ float bfhi(unsigned w) { return __uint_as_float(w & 0xffff0000u); }
__device__ __forceinline__ float dpp_f(float v, int ctrl) { return v; }
#define DPP_F(v, ctrl) __int_as_float(__builtin_amdgcn_update_dpp(0, __float_as_int(v), (ctrl), 0xF, 0xF, true))
#define DPP_I(v, ctrl) __builtin_amdgcn_update_dpp(0, (v), (ctrl), 0xF, 0xF, true)
#define DPP_X1 0xB1
#define DPP_X2 0x4E
#define DPP_HM 0x141
#define DPP_RM 0x140
__device__ __forceinline__ float wave_sum(float v) {
    v += DPP_F(v, DPP_X1); v += DPP_F(v, DPP_X2); v += DPP_F(v, DPP_HM); v += DPP_F(v, DPP_RM);
    return (__int_as_float(__builtin_amdgcn_readlane(__float_as_int(v), 0)) + __int_as_float(__builtin_amdgcn_readlane(__float_as_int(v), 16)))
         + (__int_as_float(__builtin_amdgcn_readlane(__float_as_int(v), 32)) + __int_as_float(__builtin_amdgcn_readlane(__float_as_int(v), 48)));
}
__device__ __forceinline__ float sum8(float v) { v += DPP_F(v, DPP_X1); v += DPP_F(v, DPP_X2); v += DPP_F(v, DPP_HM); return v; }
__device__ __forceinline__ float sigmoidf_(float x) { return __builtin_amdgcn_rcpf(1.f + __builtin_amdgcn_exp2f(-x * LOG2E)); }

namespace pg8 {
constexpr int BM = 256, BK = 64, HALF = 128, HTB = HALF * BK * 2, STAGE_BYTES = 8 * HTB, NXCD = 8, WGM = 8;
__host__ __device__ __forceinline__ int lds_byte(int r, int c) { const int st = (r >> 4) * 2 + (c >> 5), rr = r & 15, cc = c & 31, ob = rr * 64 + cc * 2; return st * 1024 + (ob ^ (((ob >> 9) & 1) << 5)); }
__host__ __device__ __forceinline__ void stage_rc(int b, int& R, int& C) { const int st = b / 1024, sb = b % 1024, swz = sb ^ (((sb >> 9) & 1) << 5); R = (st >> 1) * 16 + swz / 64; C = (st & 1) * 32 + (swz % 64) / 2; }
__host__ __device__ __forceinline__ int perm32(int rho) { const int n = rho >> 4, i = rho & 15; return 8 * (i >> 2) + 4 * n + (i & 3); }

struct Unit { int pm, pn, e, rows, rt; };
struct Gemm { const bf16_t* A; int lda, ldb, K; };

struct StaticOrder {
    const bf16_t* A; const bf16_t* Bt; int lda, ldb;
    int nM, nN, nwg, G, c;
    __device__ void init(const bf16_t* A_, int lda_, const bf16_t* Bt_, int ldb_, int M, int N, int G_, int c_, int cshift = 0) { A = A_; Bt = Bt_; lda = lda_; ldb = ldb_; nM = M / BM; nN = N / BM; nwg = nM * nN; G = G_; c = (c_ + cshift) % G_; }
    __device__ __forceinline__ bool next(int i, Unit& u) const {
        const long L = (long)i * G + c; if (L >= nwg) return false;
        int wgid = (int)L; { const int q = nwg / NXCD, r = nwg % NXCD, xcd = wgid % NXCD, off = wgid / NXCD; wgid = (xcd < r ? xcd * (q + 1) : r * (q + 1) + (xcd - r) * q) + off; }
        const int nig = WGM * nN, gid = wgid / nig, fm = gid * WGM, gsz = (nM - fm) < WGM ? (nM - fm) : WGM;
        u.pm = fm + ((wgid % nig) % gsz); u.pn = (wgid % nig) / gsz; u.e = 0; u.rows = 256; u.rt = 0; return true;
    }
    __device__ __forceinline__ unsigned a_off(const Unit& u, int r, int C) const { return (unsigned)(((u.pm * BM + r) * lda + C) * 2); }
    __device__ __forceinline__ const char* b_base(const Unit& u) const { return (const char*)(Bt + (size_t)u.pn * BM * ldb); }
};

__device__ __forceinline__ v8i_t ld32_lds(const LAS unsigned char* p) { const u32x4 lo_ = *(const LAS u32x4*)p, hi_ = *(const LAS u32x4*)(p + 1024); return (v8i_t){(int)lo_.x, (int)lo_.y, (int)lo_.z, (int)lo_.w, (int)hi_.x, (int)hi_.y, (int)hi_.z, (int)hi_.w}; }
struct PairOrder {
    StaticOrder S; size_t a1, b1;
    __device__ __forceinline__ bool next(int i, Unit& u) const { if (!S.next(i >> 1, u)) return false; u.e = i & 1; return true; }
    __device__ __forceinline__ unsigned a_off(const Unit& u, int r, int C) const { return S.a_off(u, r, C) + (unsigned)(u.e ? a1 * 2 : 0); }
    __device__ __forceinline__ const char* b_base(const Unit& u) const { return S.b_base(u) + (u.e ? b1 * 2 : 0); }
};
__device__ __forceinline__ void mfma_f8(f32x4& c, const v8i_t a, const v8i_t b, int sa, int sb) {
    asm volatile("v_mfma_scale_f32_16x16x128_f8f6f4 %0, %1, %2, %0, %3, %4 op_sel_hi:[0,0,0]" : "+v"(c) : "v"(a), "v"(b), "v"(sa), "v"(sb));
}
template <bool F8> struct FragT { typedef bf16x8 type; };
template <> struct FragT<true> { typedef v8i_t type; };
template <class Epi, class Sched, bool FP8 = false>
__device__ __forceinline__ void gemm_phase(LAS unsigned char* lds, const Gemm g, const Sched& S, const Epi& E) {
    const int tid = threadIdx.x, wid = __builtin_amdgcn_readfirstlane(tid >> 6), lane = tid & 63, wr = wid >> 2, wc = wid & 3, fr = lane & 15, fq = lane >> 4;
    const int K = g.K, nt = K / BK;
    unsigned voffB[2];
#pragma unroll
    for (int i = 0; i < 2; ++i) { int R, C; stage_rc(tid * 16 + i * 8192, R, C); const int Rb = Epi::PERM ? ((R & ~31) + perm32(R & 31)) : R; voffB[i] = (unsigned)(Rb * g.ldb + C) * 2u; }
#define PG8_AOFF(dst, unit) do { int t_ = tid; asm volatile("" : "+v"(t_)); _Pragma("unroll") for (int i = 0; i < 2; ++i) { int R, C; stage_rc(t_ * 16 + i * 8192, R, C); \
        _Pragma("unroll") for (int h = 0; h < 2; ++h) dst[h][i] = S.a_off(unit, h * HALF + R, C); } } while (0)
    const size_t kstep = (size_t)(BK * 2);
    const size_t hstepB = (size_t)HALF * g.ldb * 2;
    const unsigned ldsw = (unsigned)wid * 1024u;
    const int aoff = lds_byte(wr * 64 + fr, fq * 8), boff = lds_byte(wc * 32 + fr, fq * 8);
#define PG8_SA(b, h) (((b) * 2 + (h)) * HTB)
#define PG8_SB(b, h) ((4 + (b) * 2 + (h)) * HTB)
#define PG8_STAGE(bufoff, gbase, voff) do { _Pragma("unroll") for (int _i = 0; _i < 2; ++_i) \
        __builtin_amdgcn_global_load_lds((const unsigned*)((const char*)(gbase) + (voff)[_i]), (LAS unsigned*)(lds + (bufoff) + ldsw + _i * 8192), 16, 0, 0); } while (0)
#define PG8_LD32(p) ld32_lds((const LAS unsigned char*)(p))
#define PG8_LDA(dst, b, h) do { if constexpr (FP8) { _Pragma("unroll") for (int m = 0; m < 4; ++m) dst[m][0] = __builtin_bit_cast(FT, PG8_LD32(lds + PG8_SA(b, h) + aoff + m * 2048)); } \
        else { _Pragma("unroll") for (int m = 0; m < 4; ++m) _Pragma("unroll") for (int k = 0; k < 2; ++k) dst[m][k] = __builtin_bit_cast(FT, *(const LAS FT*)(lds + PG8_SA(b, h) + aoff + m * 2048 + k * 1024)); } } while (0)
#define PG8_LDB(dst, b, h) do { if constexpr (FP8) { _Pragma("unroll") for (int n = 0; n < 2; ++n) dst[n][0] = __builtin_bit_cast(FT, PG8_LD32(lds + PG8_SB(b, h) + boff + n * 2048)); } \
        else { _Pragma("unroll") for (int n = 0; n < 2; ++n) _Pragma("unroll") for (int k = 0; k < 2; ++k) dst[n][k] = __builtin_bit_cast(FT, *(const LAS FT*)(lds + PG8_SB(b, h) + boff + n * 2048 + k * 1024)); } } while (0)
#define PG8_MMA(ai, bj, At, Bt) do { __builtin_amdgcn_s_setprio(1); \
        if constexpr (FP8) { _Pragma("unroll") for (int m = 0; m < 4; ++m) _Pragma("unroll") for (int n = 0; n < 2; ++n) \
            mfma_f8(acc[ai][bj][m][n], __builtin_bit_cast(v8i_t, Bt[n][0]), __builtin_bit_cast(v8i_t, At[m][0]), 0x7c7c7c7c, 0x7c7c7c7c); } \
        else { _Pragma("unroll") for (int m = 0; m < 4; ++m) _Pragma("unroll") for (int n = 0; n < 2; ++n) _Pragma("unroll") for (int k = 0; k < 2; ++k) \
            acc[ai][bj][m][n] = __builtin_amdgcn_mfma_f32_16x16x32_bf16(__builtin_bit_cast(bf16x8, Bt[n][k]), __builtin_bit_cast(bf16x8, At[m][k]), acc[ai][bj][m][n], 0, 0, 0); } \
        __builtin_amdgcn_s_setprio(0); } while (0)
#define PG8_WAIT_V(n) asm volatile("s_waitcnt vmcnt(" #n ")" ::: "memory")
#define PG8_WAIT_L(n) asm volatile("s_waitcnt lgkmcnt(" #n ")" ::: "memory")
#define PG8_BAR __builtin_amdgcn_s_barrier()
#define PG8_SCHED __builtin_amdgcn_sched_barrier(0)
    Unit cur, nxt; int ui = 0;
    if (!S.next(0, cur)) return;
    f32x4 acc[2][2][4][2];
#pragma unroll
    for (int a = 0; a < 2; ++a)
#pragma unroll
        for (int b = 0; b < 2; ++b)
#pragma unroll
            for (int m = 0; m < 4; ++m)
#pragma unroll
                for (int n = 0; n < 2; ++n) acc[a][b][m][n] = (f32x4){0.f, 0.f, 0.f, 0.f};
    typedef typename FragT<FP8>::type FT; constexpr int NK = FP8 ? 1 : 2;
    FT At[4][NK], B0[2][NK], B1[2][NK];
    const char* Ab = (const char*)g.A;
    const char* cB = S.b_base(cur);
    unsigned vaC[2][2], vaN[2][2];
    PG8_AOFF(vaC, cur);
    PG8_STAGE(PG8_SB(0, 0), cB, voffB); PG8_STAGE(PG8_SB(0, 1), cB + hstepB, voffB); PG8_STAGE(PG8_SA(0, 0), Ab, vaC[0]); PG8_STAGE(PG8_SA(0, 1), Ab, vaC[1]);
    if (wr == 1) PG8_BAR;
    PG8_WAIT_V(2); PG8_BAR;
    PG8_STAGE(PG8_SB(1, 0), cB + kstep, voffB); PG8_STAGE(PG8_SA(1, 0), Ab + kstep, vaC[0]); PG8_STAGE(PG8_SB(1, 1), cB + hstepB + kstep, voffB);
    PG8_WAIT_V(6); PG8_BAR;
    for (;;) {
        const bool has_next = S.next(ui + 1, nxt);
        const char* nB = has_next ? S.b_base(nxt) : cB;
        if (has_next) PG8_AOFF(vaN, nxt);
        else {
#pragma unroll
            for (int h = 0; h < 2; ++h)
#pragma unroll
                for (int i = 0; i < 2; ++i) vaN[h][i] = vaC[h][i]; }
        for (int t = 0; t < nt; t += 2) {
            const bool last = (t == nt - 2);
            const char* kA1 = Ab + (size_t)(t + 1) * kstep;
            const char* kA2 = last ? Ab : Ab + (size_t)(t + 2) * kstep; const char* b2 = last ? nB : cB + (size_t)(t + 2) * kstep;
            const char* kA3 = kA2 + kstep; const char* b3 = b2 + kstep;
            unsigned o2[2][2];
#pragma unroll
            for (int h = 0; h < 2; ++h)
#pragma unroll
                for (int i = 0; i < 2; ++i) o2[h][i] = last ? vaN[h][i] : vaC[h][i];
            PG8_LDB(B0, 0, 0); PG8_LDB(B1, 0, 1); PG8_SCHED; PG8_LDA(At, 0, 0); PG8_STAGE(PG8_SA(1, 1), kA1, vaC[1]);
            PG8_WAIT_V(8); PG8_WAIT_L(0); PG8_BAR; PG8_MMA(0, 0, At, B0); PG8_MMA(0, 1, At, B1); PG8_BAR; PG8_SCHED;
            PG8_LDA(At, 0, 1); PG8_STAGE(PG8_SB(0, 0), b2, voffB); PG8_STAGE(PG8_SB(0, 1), b2 + hstepB, voffB); PG8_STAGE(PG8_SA(0, 0), kA2, o2[0]);
            PG8_WAIT_V(8); PG8_WAIT_L(0); PG8_BAR; PG8_MMA(1, 0, At, B0); PG8_MMA(1, 1, At, B1); PG8_BAR; PG8_SCHED;
            PG8_LDB(B0, 1, 0); PG8_LDB(B1, 1, 1); PG8_SCHED; PG8_LDA(At, 1, 0); PG8_STAGE(PG8_SA(0, 1), kA2, o2[1]);
            PG8_WAIT_V(8); PG8_WAIT_L(0); PG8_BAR; PG8_MMA(0, 0, At, B0); PG8_MMA(0, 1, At, B1); PG8_BAR; PG8_SCHED;
            PG8_LDA(At, 1, 1); PG8_STAGE(PG8_SB(1, 0), b3, voffB); PG8_STAGE(PG8_SB(1, 1), b3 + hstepB, voffB); PG8_STAGE(PG8_SA(1, 0), kA3, o2[0]);
            PG8_WAIT_V(8); PG8_WAIT_L(0); PG8_BAR; PG8_MMA(1, 0, At, B0); PG8_MMA(1, 1, At, B1); PG8_BAR; PG8_SCHED;
        }
        if (wr == 0) PG8_BAR;
        if constexpr (FP8) asm volatile("s_nop 15\n\ts_nop 15" ::: "memory");
        E(acc, cur, wr, wc, fr, fq);
        if (!has_next) break;
#pragma unroll
        for (int a = 0; a < 2; ++a)
#pragma unroll
            for (int b = 0; b < 2; ++b)
#pragma unroll
                for (int m = 0; m < 4; ++m)
#pragma unroll
                    for (int n = 0; n < 2; ++n) acc[a][b][m][n] = (f32x4){0.f, 0.f, 0.f, 0.f};
        cur = nxt; cB = nB; ++ui;
#pragma unroll
        for (int h = 0; h < 2; ++h)
#pragma unroll
            for (int i = 0; i < 2; ++i) vaC[h][i] = vaN[h][i];
        if (wr == 1) PG8_BAR;
    }
    PG8_WAIT_V(0);
    PG8_BAR;
#undef PG8_SA
#undef PG8_AOFF
#undef PG8_SB
#undef PG8_STAGE
#undef PG8_LDA
#undef PG8_LDB
#undef PG8_MMA
#undef PG8_LD32
#undef PG8_WAIT_V
#undef PG8_WAIT_L
#undef PG8_BAR
#undef PG8_SCHED
}

struct EpiBf16 {
    static constexpr bool PERM = true;
    bf16_t* O; int ldc;
    __device__ __forceinline__ void operator()(const f32x4 (&acc)[2][2][4][2], const Unit& u, int wr, int wc, int fr, int fq) const {
        const int row0 = u.pm * BM + wr * 64 + fr, col0 = u.pn * BM + wc * 32 + 8 * fq;
#pragma unroll
        for (int ai = 0; ai < 2; ++ai)
#pragma unroll
            for (int m = 0; m < 4; ++m) { bf16_t* rowp = O + (size_t)(row0 + ai * HALF + m * 16) * ldc + col0;
#pragma unroll
                for (int bj = 0; bj < 2; ++bj) { const f32x4 v0 = acc[ai][bj][m][0], v1 = acc[ai][bj][m][1];
                    u32x4 w; w.x = cvtpk(v0[0], v0[1]); w.y = cvtpk(v0[2], v0[3]); w.z = cvtpk(v1[0], v1[1]); w.w = cvtpk(v1[2], v1[3]);
                    *(u32x4*)(rowp + bj * HALF) = w; } }
    }
};
struct EpiGate2 {
    static constexpr bool PERM = true;
    bf16_t* O; const bf16_t* G; int ldg, gcol0, gcol1;
    __device__ __forceinline__ void operator()(const f32x4 (&acc)[2][2][4][2], const Unit& u, int wr, int wc, int fr, int fq) const {
        const int row0 = u.pm * BM + wr * 64 + fr, col0 = u.pn * BM + wc * 32 + 8 * fq;
        const bool second = u.e != 0; const int gcol = second ? gcol1 : gcol0;
#pragma unroll
        for (int ai = 0; ai < 2; ++ai)
#pragma unroll
            for (int m = 0; m < 4; ++m) { const size_t r = (size_t)(row0 + ai * HALF + m * 16);
#pragma unroll
                for (int bj = 0; bj < 2; ++bj) { const f32x4 v0 = acc[ai][bj][m][0], v1 = acc[ai][bj][m][1];
                    const int c = col0 + bj * HALF;
                    const u32x4 gw = *(const u32x4*)(G + r * ldg + gcol + c);
                    bf16_t* op = O + r * D_ + c;
                    u32x4 pw = {0u, 0u, 0u, 0u}; if (second) pw = *(const u32x4*)op;
                    float o[8];
                    o[0] = sigmoidf_(bflo(gw.x)) * v0[0]; o[1] = sigmoidf_(bfhi(gw.x)) * v0[1]; o[2] = sigmoidf_(bflo(gw.y)) * v0[2]; o[3] = sigmoidf_(bfhi(gw.y)) * v0[3];
                    o[4] = sigmoidf_(bflo(gw.z)) * v1[0]; o[5] = sigmoidf_(bfhi(gw.z)) * v1[1]; o[6] = sigmoidf_(bflo(gw.w)) * v1[2]; o[7] = sigmoidf_(bfhi(gw.w)) * v1[3];
                    o[0] += bflo(pw.x); o[1] += bfhi(pw.x); o[2] += bflo(pw.y); o[3] += bfhi(pw.y); o[4] += bflo(pw.z); o[5] += bfhi(pw.z); o[6] += bflo(pw.w); o[7] += bfhi(pw.w);
                    u32x4 w; w.x = cvtpk(o[0], o[1]); w.y = cvtpk(o[2], o[3]); w.z = cvtpk(o[4], o[5]); w.w = cvtpk(o[6], o[7]);
                    *(u32x4*)op = w; } }
    }
};
struct EpiRes {
    static constexpr bool PERM = false;
    const float* base; float* out;
    __device__ __forceinline__ void operator()(const f32x4 (&acc)[2][2][4][2], const Unit& u, int wr, int wc, int fr, int fq) const {
        const int row0 = u.pm * BM + wr * 64 + fr, col0 = u.pn * BM + wc * 32 + 4 * fq;
#pragma unroll
        for (int ai = 0; ai < 2; ++ai)
#pragma unroll
            for (int m = 0; m < 4; ++m) { const size_t off = (size_t)(row0 + ai * HALF + m * 16) * D_ + col0;
#pragma unroll
                for (int bj = 0; bj < 2; ++bj)
#pragma unroll
                    for (int n = 0; n < 2; ++n) { const f32x4 b = *(const f32x4*)(base + off + bj * HALF + n * 16); *(f32x4*)(out + off + bj * HALF + n * 16) = b + acc[ai][bj][m][n]; } }
    }
};
struct EpiSwiglu {
    static constexpr bool PERM = true;
    bf16_t* act; const float* b_up;
    __device__ __forceinline__ void operator()(const f32x4 (&acc)[2][2][4][2], const Unit& u, int wr, int wc, int fr, int fq) const {
        const int row0 = u.pm * BM + wr * 64 + fr, col0 = u.pn * BM + wc * 32 + 8 * fq;
        const float* bb = b_up + (size_t)u.e * (2 * DFF);
        f32x4 bv[2][2];
#pragma unroll
        for (int bj = 0; bj < 2; ++bj)
#pragma unroll
            for (int n = 0; n < 2; ++n) bv[bj][n] = *(const f32x4*)(bb + col0 + bj * HALF + 4 * n);
#pragma unroll
        for (int ai = 0; ai < 2; ++ai)
#pragma unroll
            for (int m = 0; m < 4; ++m) { bf16_t* rowp = act + (size_t)(row0 + ai * HALF + m * 16) * DFF + (col0 >> 1);
#pragma unroll
                for (int bj = 0; bj < 2; ++bj) { const f32x4 v0 = acc[ai][bj][m][0] + bv[bj][0], v1 = acc[ai][bj][m][1] + bv[bj][1];
                    float a[4];
#pragma unroll
                    for (int p = 0; p < 4; ++p) { float gl = (p < 2) ? v0[2 * p] : v1[2 * p - 4], li = (p < 2) ? v0[2 * p + 1] : v1[2 * p - 3];
                        gl = fminf(gl, 7.f); li = fminf(fmaxf(li, -7.f), 7.f);
                        a[p] = gl * sigmoidf_(1.702f * gl) * (li + 1.f); }
                    u32x2 w; w.x = cvtpk(a[0], a[1]); w.y = cvtpk(a[2], a[3]);
                    *(u32x2*)(rowp + bj * (HALF / 2)) = w; } }
    }
};
struct EpiSwiglu8 {
    static constexpr bool PERM = true;
    unsigned char* act; const float* b_up;
    __device__ __forceinline__ void operator()(const f32x4 (&acc)[2][2][4][2], const Unit& u, int wr, int wc, int fr, int fq) const {
        const int row0 = u.pm * BM + wr * 64 + fr, col0 = u.pn * BM + wc * 32 + 8 * fq;
        const float* bb = b_up + (size_t)u.e * (2 * DFF);
        f32x4 bv[2][2];
#pragma unroll
        for (int bj = 0; bj < 2; ++bj)
#pragma unroll
            for (int n = 0; n < 2; ++n) bv[bj][n] = *(const f32x4*)(bb + col0 + bj * HALF + 4 * n);
#pragma unroll
        for (int ai = 0; ai < 2; ++ai)
#pragma unroll
            for (int m = 0; m < 4; ++m) { unsigned char* rowp = act + (size_t)(row0 + ai * HALF + m * 16) * DFF + (col0 >> 1);
#pragma unroll
                for (int bj = 0; bj < 2; ++bj) { const f32x4 v0 = acc[ai][bj][m][0] + bv[bj][0], v1 = acc[ai][bj][m][1] + bv[bj][1];
                    float a[4];
#pragma unroll
                    for (int p = 0; p < 4; ++p) { float gl = (p < 2) ? v0[2 * p] : v1[2 * p - 4], li = (p < 2) ? v0[2 * p + 1] : v1[2 * p - 3];
                        gl = fminf(gl, 7.f); li = fminf(fmaxf(li, -7.f), 7.f);
                        a[p] = gl * sigmoidf_(1.702f * gl) * (li + 1.f) * X8_SCALE; }
                    *(unsigned*)(rowp + bj * (HALF / 2)) = pk_fp8x4(a[0], a[1], a[2], a[3]); } }
    }
};
struct EpiDown {
    static constexpr bool PERM = true;
    bf16_t* y; const float* b_down; const int* list; const float* topw;
    __device__ __forceinline__ void operator()(const f32x4 (&acc)[2][2][4][2], const Unit& u, int wr, int wc, int fr, int fq) const {
        const int col0 = u.pn * BM + wc * 32 + 8 * fq;
        const float* bb = b_down + (size_t)u.e * D_;
        f32x4 bv[2][2];
#pragma unroll
        for (int bj = 0; bj < 2; ++bj)
#pragma unroll
            for (int n = 0; n < 2; ++n) bv[bj][n] = *(const f32x4*)(bb + col0 + bj * HALF + 4 * n);
        const int* lp = list + (size_t)u.e * M_ + u.rt * BM;
#pragma unroll
        for (int ai = 0; ai < 2; ++ai)
#pragma unroll
            for (int m = 0; m < 4; ++m) { const int r = ai * HALF + wr * 64 + m * 16 + fr;
                if (r < u.rows) { const int slot = lp[r]; const float w = topw[slot]; bf16_t* rowp = y + (size_t)slot * D_ + col0;
#pragma unroll
                    for (int bj = 0; bj < 2; ++bj) { const f32x4 v0 = (acc[ai][bj][m][0] + bv[bj][0]) * w, v1 = (acc[ai][bj][m][1] + bv[bj][1]) * w;
                        u32x4 o; o.x = cvtpk(v0[0], v0[1]); o.y = cvtpk(v0[2], v0[3]); o.z = cvtpk(v1[0], v1[1]); o.w = cvtpk(v1[2], v1[3]);
                        *(u32x4*)(rowp + bj * HALF) = o; } } }
    }
};
}
constexpr size_t MiB = 1ull << 20;
constexpr size_t WS_CTL = 0, CTL_ZERO_BYTES = 64 * 1024;
constexpr size_t WS_ROPE = 256 * 1024;
constexpr size_t WS_WR = 3 * MiB;
constexpr size_t WS_LIST = 4 * MiB;
constexpr size_t WS_TOPW = 6 * MiB;
constexpr size_t WS_SEL = 6 * MiB + 512 * 1024;
constexpr size_t WS_WIN = 8 * MiB;
constexpr size_t WS_WUQ = 17 * MiB;
constexpr size_t WS_WUKV = 18 * MiB;
constexpr size_t WS_WOSB = 19 * MiB;
constexpr size_t WS_WOMLA = 20 * MiB;
constexpr size_t WS_WOUT = 21 * MiB;
constexpr size_t WS_WUP = 24 * MiB;
constexpr size_t WS_WDN = 152 * MiB;
constexpr size_t WS_HB = 216 * MiB;
constexpr size_t WS_PROJ = 249 * MiB;
constexpr size_t WS_ACT = WS_PROJ;
constexpr size_t WS_QRAW = 393 * MiB;
constexpr size_t WS_KVRAW = WS_QRAW + 24 * MiB;
constexpr size_t WS_QB = WS_KVRAW + 32 * MiB;
constexpr size_t WS_KB = WS_QB + 24 * MiB;
constexpr size_t WS_VB = WS_KB + 24 * MiB;
constexpr size_t WS_OSB = WS_VB + 16 * MiB;
constexpr size_t WS_OMLA = WS_OSB + 16 * MiB;
constexpr size_t WS_YB = WS_QRAW;
constexpr size_t WS_MIX = 545 * MiB;
constexpr size_t WS_H2F8 = 577 * MiB;
constexpr size_t WS_OPT_END = 594 * MiB;
constexpr int CW_CNT = 0;
constexpr int CW_BAR = 1024;
constexpr int LDS_STAGE = 143360;
constexpr int LDS_MISC = LDS_STAGE;
constexpr int LDS_BYTES = 147456;
constexpr int MI_BAR = 0, MI_TPFX = 16, MI_CNT = 64, MI_FLAG = 128, MI_LCNT = 160, MI_BASE = 192, MI_RSTD = 256, MI_CITEM = 320;

typedef GAS unsigned gu32;
#define RLX_AGENT __ATOMIC_RELAXED, __HIP_MEMORY_SCOPE_AGENT

#define XB_TMO      128
#define XB_XCNT(j)  (256  + 64 * (j))
#define XB_XSUB(j)  (1280 + 64 * (j))
#define XB_XGEN(j)  (2304 + 64 * (j))
#define XB_TOP      3328
#define XB_TOPGEN   3392
#define XCD_BAR_WORDS 3456
#define XB_SPIN_CAP (1u << 18)
__device__ __forceinline__ unsigned xb_ld(unsigned* p)              { return __hip_atomic_load(p, __ATOMIC_RELAXED, __HIP_MEMORY_SCOPE_AGENT); }
__device__ __forceinline__ unsigned xb_add(unsigned* p, unsigned v) { return __hip_atomic_fetch_add(p, v, __ATOMIC_RELAXED, __HIP_MEMORY_SCOPE_AGENT); }
__device__ __forceinline__ unsigned xb_xcc_id() { return (unsigned)__builtin_amdgcn_s_getreg((3 << 11) | 20) & 0xFu; }
#define XB_SPIN(cond, bar) do { unsigned _sp = 0; while (cond) { __builtin_amdgcn_s_sleep(1); \
    if ((++_sp & 255u) == 0u) { if (xb_ld(&(bar)[XB_TMO])) break; if (_sp > XB_SPIN_CAP) { atomicAdd(&(bar)[XB_TMO], 1u); break; } } } } while (0)
struct XcdBarrier { unsigned* bar; unsigned x; volatile LAS unsigned* st; };
__device__ __forceinline__ XcdBarrier xcd_barrier_post(unsigned* bar, volatile LAS unsigned* st) {
    XcdBarrier b; b.bar = bar; b.x = xb_xcc_id(); b.st = st;
    if (threadIdx.x == 0) (void)xb_add(&bar[XB_XCNT(b.x)], 1u);
    return b;
}
__device__ __forceinline__ void xcd_barrier_complete(unsigned* bar, unsigned x, unsigned& nloc, unsigned& nx) {
    const unsigned G = gridDim.x * gridDim.y * gridDim.z;
    unsigned sum, cnt, mine, sp = 0u;
    for (;;) {
        sum = 0u; cnt = 0u; mine = 0u;
#pragma unroll
        for (unsigned j = 0; j < 16; ++j) { const unsigned c = xb_ld(&bar[XB_XCNT(j)]); sum += c; cnt += (c > 0u) ? 1u : 0u; mine = (j == x) ? c : mine; }
        if (sum == G) break;
        __builtin_amdgcn_s_sleep(1);
        if ((++sp & 255u) == 0u) { if (xb_ld(&bar[XB_TMO])) break; if (sp > XB_SPIN_CAP) { atomicAdd(&bar[XB_TMO], 1u); break; } }
    }
    nloc = mine > 0u ? mine : 1u; nx = cnt > 0u ? cnt : 1u;
}
__device__ __forceinline__ void xcd_barrier(const XcdBarrier& b) {
    asm volatile("s_waitcnt vmcnt(0)" ::: "memory");
    __syncthreads();
    if (threadIdx.x == 0) {
        unsigned* bar = b.bar;
        __builtin_amdgcn_s_waitcnt(0);
        unsigned nloc = b.st[0], nx = b.st[1];
        if (nloc == 0u) { xcd_barrier_complete(bar, b.x, nloc, nx); b.st[0] = nloc; b.st[1] = nx; }
        const unsigned old = xb_add(&bar[XB_XSUB(b.x)], 1u);
        const unsigned gen = old / nloc;
        if (old + 1u == (gen + 1u) * nloc) {
            __builtin_amdgcn_fence(__ATOMIC_RELEASE, "agent");
            asm volatile("s_waitcnt vmcnt(0)" ::: "memory");
            const unsigned og = xb_add(&bar[XB_TOP], 1u);
            const unsigned tg = og / nx;
            if (og + 1u == (tg + 1u) * nx) xb_add(&bar[XB_TOPGEN], 1u);
            else XB_SPIN(xb_ld(&bar[XB_TOPGEN]) == tg, bar);
            __builtin_amdgcn_fence(__ATOMIC_ACQUIRE, "agent");
            xb_add(&bar[XB_XGEN(b.x)], 1u);
            asm volatile("s_waitcnt vmcnt(0)" ::: "memory");
        } else {
            XB_SPIN(xb_ld(&bar[XB_XGEN(b.x)]) == gen, bar);
            __builtin_amdgcn_fence(__ATOMIC_ACQUIRE, "agent");
            asm volatile("s_waitcnt vmcnt(0)" ::: "memory");
        }
    }
    __syncthreads();
}

struct Args {
    const float* in[20]; float* out; unsigned char* ws;
    int ph_lo, ph_hi;
};

struct Frame {
    LAS unsigned char* lds; volatile LAS unsigned* MISC;
    int tid, lane, wave, vcu, G;
    unsigned char* ws;
};

__device__ __forceinline__ void p0_transpose_item(const float* W, int K, int N, bf16_t* WT, LAS float* scr, int item, int lane, const float* gk, float cs, int csn) {
    const int nblk = N / 32, kb = item / nblk, nb = item % nblk, k0 = 64 * kb, n0 = 32 * nb;
    const float colsc = (n0 < csn) ? cs : 1.f;
    float tv[32];
#pragma unroll
    for (int i = 0; i < 32; ++i) { const int kk = 2 * i + (lane >> 5); tv[i] = W[(size_t)(k0 + kk) * N + n0 + (lane & 31)]; }
#pragma unroll
    for (int i = 0; i < 32; ++i) { const int kk = 2 * i + (lane >> 5); float v = tv[i] * colsc; if (gk) v *= gk[k0 + kk]; scr[kk * 33 + (lane & 31)] = v; }
    asm volatile("s_waitcnt lgkmcnt(0)" ::: "memory");
    const int c = lane & 7;
#pragma unroll
    for (int j = 0; j < 4; ++j) { const int n = (lane >> 3) + 8 * j; const LAS float* s = scr + (8 * c) * 33 + n;
        u32x4 o; o.x = cvtpk(s[0 * 33], s[1 * 33]); o.y = cvtpk(s[2 * 33], s[3 * 33]); o.z = cvtpk(s[4 * 33], s[5 * 33]); o.w = cvtpk(s[6 * 33], s[7 * 33]);
        *(u32x4*)(WT + (size_t)(n0 + n) * K + k0 + 8 * c) = o; }
    asm volatile("s_waitcnt lgkmcnt(0)" ::: "memory");
}
__device__ __forceinline__ void p0_transpose_item_fp8(const float* W, int K, int N, unsigned char* WT, LAS float* scr, int item, int lane, float cs) {
    const int nblk = N / 32, kb = item / nblk, nb = item % nblk, k0 = 64 * kb, n0 = 32 * nb;
    float tv[32];
#pragma unroll
    for (int i = 0; i < 32; ++i) { const int kk = 2 * i + (lane >> 5); tv[i] = W[(size_t)(k0 + kk) * N + n0 + (lane & 31)]; }
#pragma unroll
    for (int i = 0; i < 32; ++i) { const int kk = 2 * i + (lane >> 5); scr[kk * 33 + (lane & 31)] = tv[i] * cs; }
    asm volatile("s_waitcnt lgkmcnt(0)" ::: "memory");
    const int c = lane & 7;
#pragma unroll
    for (int j = 0; j < 4; ++j) { const int n = (lane >> 3) + 8 * j; const LAS float* s = scr + (8 * c) * 33 + n;
        u32x2 o; o.x = pk_fp8x4(s[0 * 33], s[1 * 33], s[2 * 33], s[3 * 33]); o.y = pk_fp8x4(s[4 * 33], s[5 * 33], s[6 * 33], s[7 * 33]);
        *(u32x2*)(WT + (size_t)(n0 + n) * K + k0 + 8 * c) = o; }
    asm volatile("s_waitcnt lgkmcnt(0)" ::: "memory");
}
__device__ __forceinline__ void rms_row_to_bf16(const float* xrow, const float* g, bf16_t* orow, int lane) {
    const f32x4* xr = (const f32x4*)xrow + lane; const f32x4* gr = (const f32x4*)g + lane;
    f32x4 v[4]; float s = 0.f;
#pragma unroll
    for (int j = 0; j < 4; ++j) { v[j] = xr[64 * j]; s += (v[j].x * v[j].x + v[j].y * v[j].y) + (v[j].z * v[j].z + v[j].w * v[j].w); }
    const float rstd = rsqrtf(wave_sum(s) * (1.f / D_) + EPS);
    u32x2* o8 = (u32x2*)orow + lane;
#pragma unroll
    for (int j = 0; j < 4; ++j) { const f32x4 gg = gr[64 * j]; u32x2 w; w.x = cvtpk(v[j].x * rstd * gg.x, v[j].y * rstd * gg.y); w.y = cvtpk(v[j].z * rstd * gg.z, v[j].w * rstd * gg.w); o8[64 * j] = w; }
}
__device__ __forceinline__ void p0_prologue(Frame& F, const Args& a, int do_moe_w, int do_rest) {
    LAS float* scr = (LAS float*)(F.lds + F.wave * 16384);
    const int gw = F.vcu * NWAVES + F.wave, NGW = F.G * NWAVES;
    unsigned char* ws = F.ws;
    const float* w_in = a.in[3]; const float* g_cq = a.in[4]; const float* w_uq = a.in[5]; const float* g_ckv = a.in[6]; const float* w_ukv = a.in[7];
    const float* w_o_sb = a.in[10]; const float* w_o_mla = a.in[11]; const float* w_out = a.in[12]; const float* g_ffn = a.in[13]; const float* w_router = a.in[14];
    const float* w_up = a.in[16]; const float* w_down = a.in[18];
    constexpr int I_IN = (D_ / 64) * (INW / 32), I_UQ = (384 / 64) * (768 / 32), I_UKV = (256 / 64) * (1024 / 32), I_O = (512 / 64) * (1024 / 32), I_OUT = (1024 / 64) * (1024 / 32);
    constexpr int I_UP1 = (1024 / 64) * (2048 / 32), I_DN1 = (1024 / 64) * (1024 / 32);
    if (do_rest) {
        constexpr int NI = I_IN + I_UQ + I_UKV + 2 * I_O + I_OUT;
        for (int it = gw; it < NI; it += NGW) {
            int r = it;
            if (r < I_IN) { p0_transpose_item(w_in, D_, INW, (bf16_t*)(ws + WS_WIN), scr, r, F.lane, nullptr, SB_QSCALE, 512); continue; } r -= I_IN;
            if (r < I_UQ) { p0_transpose_item(w_uq, 384, 768, (bf16_t*)(ws + WS_WUQ), scr, r, F.lane, g_cq, 1.f, 0); continue; } r -= I_UQ;
            if (r < I_UKV) { p0_transpose_item(w_ukv, 256, 1024, (bf16_t*)(ws + WS_WUKV), scr, r, F.lane, g_ckv, 1.f, 0); continue; } r -= I_UKV;
            if (r < I_O) { p0_transpose_item(w_o_sb, 512, 1024, (bf16_t*)(ws + WS_WOSB), scr, r, F.lane, nullptr, 1.f, 0); continue; } r -= I_O;
            if (r < I_O) { p0_transpose_item(w_o_mla, 512, 1024, (bf16_t*)(ws + WS_WOMLA), scr, r, F.lane, nullptr, 1.f, 0); continue; } r -= I_O;
            p0_transpose_item(w_out, 1024, 1024, (bf16_t*)(ws + WS_WOUT), scr, r, F.lane, nullptr, 1.f, 0);
        }
        { const int gt = gw * 64 + F.lane, NGT = NGW * 64;
          u32x4 z = {0u, 0u, 0u, 0u};
          u32x4* pz = (u32x4*)((bf16_t*)(ws + WS_WIN) + (size_t)INW * D_);
          for (int i = gt; i < (INWP - INW) * D_ * 2 / 16; i += NGT) pz[i] = z;
          u32x4* hz = (u32x4*)((unsigned char*)(ws + WS_H2F8) + (size_t)M_ * D_);
          for (int i = gt; i < D_ / 16; i += NGT) hz[i] = z;
          const int* pos = (const int*)a.in[1]; float* rt = (float*)(ws + WS_ROPE);
          for (int i = gt; i < M_ * 16; i += NGT) { const int row = i >> 4, k = i & 15; const float inv = powf(10000.f, -(float)k / 16.f); const float ang = (float)pos[row] * inv; rt[row * 32 + k] = cosf(ang); rt[row * 32 + 16 + k] = sinf(ang); }
          float* wr = (float*)(ws + WS_WR);
          for (int i = gt; i < D_ * NE; i += NGT) wr[i] = w_router[i] * g_ffn[i >> 5];
        }
        for (int m = gw; m < M_; m += NGW) rms_row_to_bf16(a.in[0] + (size_t)m * D_, a.in[2], (bf16_t*)(ws + WS_HB) + (size_t)m * D_, F.lane);
    }
    if (do_moe_w) {
        constexpr int NI = NE * (I_UP1 + I_DN1);
        for (int it = gw; it < NI; it += NGW) {
            int r = it;
            if (r < NE * I_UP1) { const int e = r / I_UP1; p0_transpose_item_fp8(w_up + (size_t)e * D_ * 2 * DFF, D_, 2 * DFF, (unsigned char*)(ws + WS_WUP) + (size_t)e * 2 * DFF * D_, scr, r % I_UP1, F.lane, W8_SCALE); continue; }
            r -= NE * I_UP1;
            { const int e = r / I_DN1; p0_transpose_item_fp8(w_down + (size_t)e * DFF * D_, DFF, D_, (unsigned char*)(ws + WS_WDN) + (size_t)e * D_ * DFF, scr, r % I_DN1, F.lane, W8_SCALE); }
        }
    }
}

__device__ __forceinline__ void ld16bf(const bf16_t* p, float (&v)[16]) {
    const u32x4 a = *(const u32x4*)p, b = *(const u32x4*)(p + 8);
    v[0] = bflo(a.x); v[1] = bfhi(a.x); v[2] = bflo(a.y); v[3] = bfhi(a.y); v[4] = bflo(a.z); v[5] = bfhi(a.z); v[6] = bflo(a.w); v[7] = bfhi(a.w);
    v[8] = bflo(b.x); v[9] = bfhi(b.x); v[10] = bflo(b.y); v[11] = bfhi(b.y); v[12] = bflo(b.z); v[13] = bfhi(b.z); v[14] = bflo(b.w); v[15] = bfhi(b.w);
}
__device__ __forceinline__ void st16bf(bf16_t* p, const float (&v)[16]) {
    u32x4 a, b; a.x = cvtpk(v[0], v[1]); a.y = cvtpk(v[2], v[3]); a.z = cvtpk(v[4], v[5]); a.w = cvtpk(v[6], v[7]);
    b.x = cvtpk(v[8], v[9]); b.y = cvtpk(v[10], v[11]); b.z = cvtpk(v[12], v[13]); b.w = cvtpk(v[14], v[15]);
    *(u32x4*)p = a; *(u32x4*)(p + 8) = b;
}
struct PrepIn { unsigned cq0, cq1, cq2; u32x2 ckv; u32x4 qa, qb, ka, kb, vv; float rope; };
__device__ __forceinline__ void p4_load(PrepIn& in, int row, const bf16_t* proj, const bf16_t* qraw, const bf16_t* kvraw, const float* rope, int lane) {
    const int h = lane >> 3, s = lane & 7;
    const bf16_t* pr = proj + (size_t)row * INWP;
    { const bf16_t* p = pr + C_CQ + lane * 6; in.cq0 = *(const unsigned*)p; in.cq1 = *(const unsigned*)(p + 2); in.cq2 = *(const unsigned*)(p + 4); }
    in.ckv = *(const u32x2*)(pr + C_CKV + lane * 4);
    in.rope = rope[(size_t)row * 32 + (lane & 31)];
    const u32x4 z = {0u, 0u, 0u, 0u};
    in.qa = z; in.qb = z; in.ka = z; in.kb = z;
    if (s < 6) { const bf16_t* q = qraw + (size_t)row * 768 + h * 96 + s * 16; in.qa = *(const u32x4*)q; in.qb = *(const u32x4*)(q + 8);
        const bf16_t* k = (s < 4) ? (kvraw + (size_t)row * 1024 + h * 128 + s * 16) : (pr + C_KR + (s - 4) * 16); in.ka = *(const u32x4*)k; in.kb = *(const u32x4*)(k + 8); }
    in.vv = *(const u32x4*)(kvraw + (size_t)row * 1024 + (lane >> 3) * 128 + 64 + (lane & 7) * 8);
}
__device__ __forceinline__ void unpack16(const u32x4 a, const u32x4 b, float (&v)[16]) {
    v[0] = bflo(a.x); v[1] = bfhi(a.x); v[2] = bflo(a.y); v[3] = bfhi(a.y); v[4] = bflo(a.z); v[5] = bfhi(a.z); v[6] = bflo(a.w); v[7] = bfhi(a.w);
    v[8] = bflo(b.x); v[9] = bfhi(b.x); v[10] = bflo(b.y); v[11] = bfhi(b.y); v[12] = bflo(b.z); v[13] = bfhi(b.z); v[14] = bflo(b.w); v[15] = bfhi(b.w);
}
__device__ __forceinline__ void p4_prep(Frame& F, const Args& a) {
    unsigned char* ws = F.ws;
    const bf16_t* proj = (const bf16_t*)(ws + WS_PROJ); const bf16_t* qraw = (const bf16_t*)(ws + WS_QRAW); const bf16_t* kvraw = (const bf16_t*)(ws + WS_KVRAW);
    bf16_t* QB = (bf16_t*)(ws + WS_QB); bf16_t* KB = (bf16_t*)(ws + WS_KB); bf16_t* VB = (bf16_t*)(ws + WS_VB);
    const float* rope = (const float*)(ws + WS_ROPE); const float* gq = a.in[8]; const float* gk = a.in[9];
    const int gw = F.vcu * NWAVES + F.wave, NGW = F.G * NWAVES, lane = F.lane, h = lane >> 3, s = lane & 7;
    float gqv[16], gkv[16];
#pragma unroll
    for (int j = 0; j < 16; ++j) { gqv[j] = (s < 6) ? gq[s * 16 + j] : 0.f; gkv[j] = (s < 6) ? gk[s * 16 + j] : 0.f; }
    PrepIn cur, nxt;
    if (gw < M_) p4_load(cur, gw, proj, qraw, kvraw, rope, lane);
    for (int row = gw; row < M_; row += NGW) {
        const bool hn = row + NGW < M_;
        if (hn) p4_load(nxt, row + NGW, proj, qraw, kvraw, rope, lane);
        float sq = bflo(cur.cq0) * bflo(cur.cq0) + bfhi(cur.cq0) * bfhi(cur.cq0) + bflo(cur.cq1) * bflo(cur.cq1) + bfhi(cur.cq1) * bfhi(cur.cq1) + bflo(cur.cq2) * bflo(cur.cq2) + bfhi(cur.cq2) * bfhi(cur.cq2);
        float skv = bflo(cur.ckv.x) * bflo(cur.ckv.x) + bfhi(cur.ckv.x) * bfhi(cur.ckv.x) + bflo(cur.ckv.y) * bflo(cur.ckv.y) + bfhi(cur.ckv.y) * bfhi(cur.ckv.y);
        sq = wave_sum(sq); skv = wave_sum(skv);
        const float var_cq = sq * (1.f / 384.f) + EPS;
        const float rstd_ckv = rsqrtf(skv * (1.f / 256.f) + EPS);
        float cs[16], sn[16];
#pragma unroll
        for (int j = 0; j < 16; ++j) { cs[j] = __int_as_float(__builtin_amdgcn_readlane(__float_as_int(cur.rope), j)); sn[j] = __int_as_float(__builtin_amdgcn_readlane(__float_as_int(cur.rope), 16 + j)); }
        {
            float v[16]; unpack16(cur.qa, cur.qb, v);
            float ss = 0.f;
#pragma unroll
            for (int j = 0; j < 16; ++j) ss += v[j] * v[j];
            ss = sum8(ss);
            const float r = rsqrtf(ss * (1.f / 96.f) + EPS * var_cq);
#pragma unroll
            for (int j = 0; j < 16; ++j) v[j] = v[j] * r * gqv[j];
            float o[16];
#pragma unroll
            for (int j = 0; j < 16; ++j) { const float pv = DPP_F(v[j], DPP_X1);
                o[j] = (s == 4) ? (v[j] * cs[j] - pv * sn[j]) : (s == 5) ? (v[j] * cs[j] + pv * sn[j]) : v[j]; o[j] *= MLA_QSCALE; }
            if (s < 6) st16bf(QB + (size_t)row * 768 + h * 96 + s * 16, o);
        }
        {
            float v[16]; unpack16(cur.ka, cur.kb, v);
            if (s < 4) {
#pragma unroll
                for (int j = 0; j < 16; ++j) v[j] *= rstd_ckv; }
            float ss = 0.f;
#pragma unroll
            for (int j = 0; j < 16; ++j) ss += v[j] * v[j];
            ss = sum8(ss);
            const float r = rsqrtf(ss * (1.f / 96.f) + EPS);
#pragma unroll
            for (int j = 0; j < 16; ++j) v[j] = v[j] * r * gkv[j];
            float o[16];
#pragma unroll
            for (int j = 0; j < 16; ++j) { const float pv = DPP_F(v[j], DPP_X1);
                o[j] = (s == 4) ? (v[j] * cs[j] - pv * sn[j]) : (s == 5) ? (v[j] * cs[j] + pv * sn[j]) : v[j]; }
            if (s < 6) st16bf(KB + (size_t)row * 768 + h * 96 + s * 16, o);
            const u32x4 vw = cur.vv;
            u32x4 ow; ow.x = cvtpk(bflo(vw.x) * rstd_ckv, bfhi(vw.x) * rstd_ckv); ow.y = cvtpk(bflo(vw.y) * rstd_ckv, bfhi(vw.y) * rstd_ckv);
            ow.z = cvtpk(bflo(vw.z) * rstd_ckv, bfhi(vw.z) * rstd_ckv); ow.w = cvtpk(bflo(vw.w) * rstd_ckv, bfhi(vw.w) * rstd_ckv);
            *(u32x4*)(VB + (size_t)row * 512 + lane * 8) = ow;
        }
        if (hn) cur = nxt;
    }
}
namespace att {
constexpr int BUFB = 20480;
constexpr int WREG = 8448;
constexpr int OST_OFF = 2 * BUFB;
constexpr int WSF_OFF = OST_OFF + 8 * WREG;
constexpr int FLG_OFF = WSF_OFF + 8 * 256;
__device__ __forceinline__ int crow(int r, int hi) { return (r & 3) + 8 * (r >> 2) + 4 * hi; }
__device__ __forceinline__ s16x4 vtr(const LAS char* p) { typedef short v4i16_t __attribute__((ext_vector_type(4))); return __builtin_bit_cast(s16x4, __builtin_amdgcn_ds_read_tr16_b64_v4i16((LAS v4i16_t*)p)); }
#define ATT_MFMA(a, b, c) __builtin_amdgcn_mfma_f32_32x32x16_bf16((a), (b), (c), 0, 0, 0)

template <int NCH> struct Stage {
    u32x4 k0, k1, v0;
    __device__ __forceinline__ void load(const bf16_t* Kb, int pitchK, const bf16_t* Vb, int pitchV, int key0, int wid, int lane) {
        k0 = *(const u32x4*)(Kb + (size_t)(key0 + lane) * pitchK + wid * 8);
        if (NCH > 8) { if (wid < NCH - 8) k1 = *(const u32x4*)(Kb + (size_t)(key0 + lane) * pitchK + (8 + wid) * 8); }
        v0 = *(const u32x4*)(Vb + (size_t)(key0 + 16 * (wid & 3) + (lane >> 2)) * pitchV + (wid >> 2) * 32 + (lane & 3) * 8);
    }
    __device__ __forceinline__ void write(LAS unsigned char* buf, int wid, int lane) const {
        *(LAS u32x4*)(buf + wid * 1024 + lane * 16) = k0;
        if (NCH > 8) { if (wid < NCH - 8) *(LAS u32x4*)(buf + (8 + wid) * 1024 + lane * 16) = k1; }
        *(LAS u32x4*)(buf + NCH * 1024 + wid * 1024 + lane * 16) = v0;
    }
};

__device__ __forceinline__ void pv_tile(f32x16 (&o)[2], const LAS char* vp, const bf16x8 (&pa)[4]) {
    __builtin_amdgcn_s_setprio(1);
#pragma unroll
    for (int d0 = 0; d0 < 2; ++d0)
#pragma unroll
        for (int ks = 0; ks < 4; ++ks) {
            const s16x4 lo = vtr(vp + d0 * 4096 + ks * 1024), hi = vtr(vp + d0 * 4096 + ks * 1024 + 512);
            const bf16x8 vf = __builtin_shufflevector(lo, hi, 0, 1, 2, 3, 4, 5, 6, 7);
            o[d0] = ATT_MFMA(pa[ks], vf, o[d0]);
        }
    __builtin_amdgcn_s_setprio(0);
}
__device__ __forceinline__ bf16x8 pack8(const f32x16& p, int base) {
    u32x4 w; w.x = cvtpk(p[base], p[base + 1]); w.y = cvtpk(p[base + 2], p[base + 3]); w.z = cvtpk(p[base + 4], p[base + 5]); w.w = cvtpk(p[base + 6], p[base + 7]);
    return __builtin_bit_cast(bf16x8, w);
}
__device__ __forceinline__ void store_o(const f32x16 (&o)[2], const float (&rs)[16], LAS unsigned char* lds, int wid, int lane, bf16_t* Ow) {
    const int r32 = lane & 31, hi = lane >> 5;
    LAS bf16_t* stg = (LAS bf16_t*)(lds + OST_OFF + wid * WREG);
#pragma unroll
    for (int r = 0; r < 16; ++r) { const int orow = crow(r, hi);
#pragma unroll
        for (int d0 = 0; d0 < 2; ++d0) { const unsigned w = cvtpk(o[d0][r] * rs[r], 0.f); stg[orow * 64 + d0 * 32 + r32] = (bf16_t)(w & 0xffffu); } }
    asm volatile("s_waitcnt lgkmcnt(0)" ::: "memory");
#pragma unroll
    for (int i = 0; i < 4; ++i) { const int row = i * 8 + (lane >> 3), ch = lane & 7; const u32x4 v = *(const LAS u32x4*)(stg + row * 64 + ch * 8); *(u32x4*)(Ow + (size_t)row * 512 + ch * 8) = v; }
    asm volatile("s_waitcnt lgkmcnt(0)" ::: "memory");
}


constexpr int MLA_CONV_PERIOD = 6;
struct Conv {
    const float* w_up; const float* w_down; unsigned char* up8; unsigned char* dn8; int item, step, ctr; bool inflight; float tv[32];
    static constexpr int I_UP1 = (D_ / 64) * (2 * DFF / 32), I_DN1 = (DFF / 64) * (D_ / 32), NI = NE * (I_UP1 + I_DN1);
    const float* src; unsigned char* dst; int K, N;
    __device__ __forceinline__ bool pending() const { return item < NI; }
    __device__ __forceinline__ void load(int lane) { load_to(tv, lane); }
    __device__ __forceinline__ void load_to(float (&tv)[32], int lane) {
        int r = item;
        if (r < NE * I_UP1) { const int e = r / I_UP1; r %= I_UP1; K = D_; N = 2 * DFF; const int nblk = N / 32, kb = r / nblk, nb = r % nblk; src = w_up + (size_t)e * D_ * 2 * DFF + (size_t)(64 * kb) * N + 32 * nb; dst = up8 + (size_t)e * 2 * DFF * D_ + (size_t)(32 * nb) * K + 64 * kb; }
        else { r -= NE * I_UP1; const int e = r / I_DN1; r %= I_DN1; K = DFF; N = D_; const int nblk = N / 32, kb = r / nblk, nb = r % nblk; src = w_down + (size_t)e * DFF * D_ + (size_t)(64 * kb) * N + 32 * nb; dst = dn8 + (size_t)e * D_ * DFF + (size_t)(32 * nb) * K + 64 * kb; }
#pragma unroll
        for (int i = 0; i < 32; ++i) { const int kk = 2 * i + (lane >> 5); tv[i] = src[(size_t)kk * N + (lane & 31)]; }
    }
    __device__ __forceinline__ void finish(LAS float* scr, int lane) { finish_from(tv, scr, lane); }
    __device__ __forceinline__ void finish_from(const float (&tv)[32], LAS float* scr, int lane) {
#pragma unroll
        for (int i = 0; i < 32; ++i) { const int kk = 2 * i + (lane >> 5); scr[kk * 33 + (lane & 31)] = tv[i] * W8_SCALE; }
        asm volatile("s_waitcnt lgkmcnt(0)" ::: "memory");
        const int cc = lane & 7;
#pragma unroll
        for (int j = 0; j < 4; ++j) { const int n = (lane >> 3) + 8 * j; const LAS float* s = scr + (8 * cc) * 33 + n;
            u32x2 o; o.x = pk_fp8x4(s[0 * 33], s[1 * 33], s[2 * 33], s[3 * 33]); o.y = pk_fp8x4(s[4 * 33], s[5 * 33], s[6 * 33], s[7 * 33]);
            *(u32x2*)(dst + (size_t)n * K + 8 * cc) = o; }
        asm volatile("s_waitcnt lgkmcnt(0)" ::: "memory");
        item += step;
    }
    __device__ __forceinline__ void tick_begin(int lane) { if (!inflight && ctr == 0 && pending()) { load(lane); inflight = true; } }
    __device__ __forceinline__ void tick_end(LAS float* scr, int lane) { if (inflight && ctr == 2) { finish(scr, lane); inflight = false; } ctr = (ctr == MLA_CONV_PERIOD - 1) ? 0 : ctr + 1; }
    __device__ __forceinline__ void flush(LAS float* scr, int lane) { if (inflight) { finish(scr, lane); inflight = false; } ctr = 0; }
    __device__ __forceinline__ void drain(LAS float* scr, int lane) { while (pending()) { float t2[32]; load_to(t2, lane); finish_from(t2, scr, lane); } }
};
__device__ __forceinline__ void mla_unit(LAS unsigned char* lds, int b, int h, int qb, const bf16_t* QB, const bf16_t* KB, const bf16_t* VB, bf16_t* O, float m0, Conv& cv) {
    const int tid = threadIdx.x, lane = tid & 63, r32 = lane & 31, hi = lane >> 5; const int wid = __builtin_amdgcn_readfirstlane(tid >> 6);
    const size_t rb = (size_t)b * S_; const int q0 = qb * 256;
    const bf16_t* Kh = KB + rb * 768 + h * 96; const bf16_t* Vh = VB + rb * 512 + h * 64;
    bf16x8 qr[6];
    { const bf16_t* qp = QB + (rb + q0 + wid * 32 + r32) * 768 + h * 96 + hi * 8;
#pragma unroll
      for (int d0 = 0; d0 < 6; ++d0) qr[d0] = *(const bf16x8*)(qp + d0 * 16); }
    const int NT = 4 * qb + 4, my_last = 4 * qb + (wid >> 1);
    f32x16 o[2]; float l = 0.f;
#pragma unroll
    for (int r = 0; r < 16; ++r) { o[0][r] = 0.f; o[1][r] = 0.f; }
    f32x16 negm;
#pragma unroll
    for (int r = 0; r < 16; ++r) negm[r] = -m0;
    asm volatile("" : "+v"(negm));
    Stage<12> st;
    st.load(Kh, 768, Vh, 512, 0, wid, lane); st.write(lds, wid, lane);
    __syncthreads();
    LAS float* cscr = (LAS float*)(lds + OST_OFF + wid * WREG);
    for (int t = 0; t < NT; ++t) {
        if (t + 1 < NT) st.load(Kh, 768, Vh, 512, (t + 1) * 64, wid, lane);
        asm volatile("" ::: "memory");
        cv.tick_begin(lane);
        if (t <= my_last) {
            const LAS char* buf = (const LAS char*)(lds + (t & 1) * BUFB);
            const LAS char* kp = buf + hi * 1024 + r32 * 16;
            f32x16 p0, p1;
            __builtin_amdgcn_s_setprio(1);
#pragma unroll
            for (int d0 = 0; d0 < 6; ++d0) { const bf16x8 a0 = *(const LAS bf16x8*)(kp + d0 * 2048), a1 = *(const LAS bf16x8*)(kp + d0 * 2048 + 512);
                if (d0 == 0) { p0 = ATT_MFMA(a0, qr[0], negm); p1 = ATT_MFMA(a1, qr[0], negm); }
                else { p0 = ATT_MFMA(a0, qr[d0], p0); p1 = ATT_MFMA(a1, qr[d0], p1); } }
            __builtin_amdgcn_s_setprio(0);
            float ls = 0.f;
#pragma unroll
            for (int r = 0; r < 16; ++r) { p0[r] = __builtin_amdgcn_exp2f(p0[r]); p1[r] = __builtin_amdgcn_exp2f(p1[r]); ls += p0[r] + p1[r]; }
            l += ls;
            bf16x8 pa[4]; pa[0] = pack8(p0, 0); pa[1] = pack8(p0, 8); pa[2] = pack8(p1, 0); pa[3] = pack8(p1, 8);
            const LAS char* vp = buf + 12 * 1024 + ((lane >> 4) & 1) * 32 + (lane & 3) * 8 + (4 * hi + ((lane & 15) >> 2)) * 64;
            pv_tile(o, vp, pa);
        }
        if (t + 1 < NT) st.write(lds + ((t + 1) & 1) * BUFB, wid, lane);
        cv.tick_end(cscr, lane);
        __syncthreads();
    }
    l += __shfl_xor(l, 32);
    LAS float* wsf = (LAS float*)(lds + WSF_OFF) + wid * 64;
    if (hi == 0) wsf[r32] = l;
    asm volatile("s_waitcnt lgkmcnt(0)" ::: "memory");
    float rs[16];
#pragma unroll
    for (int r = 0; r < 16; ++r) rs[r] = __builtin_amdgcn_rcpf(wsf[crow(r, hi)]);
    store_o(o, rs, lds, wid, lane, O + (rb + q0 + wid * 32) * 512 + h * 64);
}

constexpr float SB_THR = -152.f;
__device__ __forceinline__ void sb_unit(LAS unsigned char* lds, int b, int h, int qb, const bf16_t* proj, bf16_t* O, Conv& cv) {
    const int tid = threadIdx.x, lane = tid & 63, r32 = lane & 31, hi = lane >> 5; const int wid = __builtin_amdgcn_readfirstlane(tid >> 6);
    const size_t rb = (size_t)b * S_; const int q0 = qb * 256;
    const bf16_t* Kh = proj + rb * INWP + C_SBK + h * 64; const bf16_t* Vh = proj + rb * INWP + C_SBV + h * 64;
    bf16x8 qr[4];
    { const bf16_t* qp = proj + (rb + q0 + wid * 32 + r32) * INWP + C_SBQ + h * 64 + hi * 8;
#pragma unroll
      for (int d0 = 0; d0 < 4; ++d0) qr[d0] = *(const bf16x8*)(qp + d0 * 16); }
    const int Ttop = 4 * qb + 3, qw0 = q0 + wid * 32, qabs = qw0 + r32;
    f32x16 o[2]; float carry = 0.f;
#pragma unroll
    for (int r = 0; r < 16; ++r) { o[0][r] = 0.f; o[1][r] = 0.f; }
    volatile LAS int* flg = (volatile LAS int*)(lds + FLG_OFF);
    Stage<8> st;
    st.load(Kh, INWP, Vh, INWP, Ttop * 64, wid, lane); st.write(lds, wid, lane);
    __syncthreads();
    bool alive = true;
    for (int it = 0;; ++it) {
        const int t = Ttop - it;
        if (t > 0) st.load(Kh, INWP, Vh, INWP, (t - 1) * 64, wid, lane);
        asm volatile("" ::: "memory");
        float ctv[32]; const bool cvp = cv.pending();
        if (cvp) cv.load_to(ctv, lane);
        if (alive && (64 * t <= qw0 + 30)) {
            const LAS char* buf = (const LAS char*)(lds + (it & 1) * BUFB);
            const LAS char* kp = buf + hi * 1024 + r32 * 16;
            const bool need_mask = (64 * t + 63 >= qw0);
            bf16x8 pa[4];
#pragma unroll
            for (int blk = 1; blk >= 0; --blk) {
                f32x16 p;
#pragma unroll
                for (int r = 0; r < 16; ++r) p[r] = 0.f;
#pragma unroll
                for (int d0 = 0; d0 < 4; ++d0) { const bf16x8 a0 = *(const LAS bf16x8*)(kp + d0 * 2048 + blk * 512); p = ATT_MFMA(a0, qr[d0], p); }
                const int kb0 = 64 * t + 32 * blk + 4 * hi;
                f32x16 s;
#pragma unroll
                for (int r = 0; r < 16; ++r) {
                    const int key = kb0 + (r & 3) + 8 * (r >> 2);
                    const float z = p[r]; const float e = __builtin_amdgcn_exp2f(-fabsf(z)); const float tt = __builtin_amdgcn_logf(1.f + e); float lsv = fminf(-z, 0.f) - tt;
                    if (need_mask && !(key < qabs)) { lsv = 0.f; p[r] = -INFINITY; }
                    s[r] = lsv;
                }
                float T[5]; T[4] = 0.f;
#pragma unroll
                for (int i = 3; i >= 0; --i) T[i] = T[i + 1] + ((s[4 * i] + s[4 * i + 1]) + (s[4 * i + 2] + s[4 * i + 3]));
                float Tp[5]; Tp[4] = 0.f;
#pragma unroll
                for (int i = 0; i < 4; ++i) Tp[i] = __shfl_xor(T[i], 32);
#pragma unroll
                for (int i = 3; i >= 0; --i) {
                    float lat = carry + T[i + 1] + (hi ? Tp[i + 1] : Tp[i]);
#pragma unroll
                    for (int e3 = 3; e3 >= 0; --e3) { const int r = 4 * i + e3; const float lsv = s[r]; p[r] = __builtin_amdgcn_exp2f(lsv + p[r] + lat); lat += lsv; }
                }
                carry += T[0] + Tp[0];
                pa[2 * blk] = pack8(p, 0); pa[2 * blk + 1] = pack8(p, 8);
            }
            const LAS char* vp = buf + 8 * 1024 + ((lane >> 4) & 1) * 32 + (lane & 3) * 8 + (4 * hi + ((lane & 15) >> 2)) * 64;
            pv_tile(o, vp, pa);
            alive = __any(carry > SB_THR);
        }
        if (lane == 0) flg[(it & 1) * 8 + wid] = alive ? 1 : 0;
        if (t > 0) st.write(lds + ((it + 1) & 1) * BUFB, wid, lane);
        if (cvp) cv.finish_from(ctv, (LAS float*)(lds + OST_OFF + wid * WREG), lane);
        __syncthreads();
        if (t == 0) break;
        int any = 0;
#pragma unroll
        for (int w = 0; w < 8; ++w) any |= flg[(it & 1) * 8 + w];
        if (!any) break;
    }
    float rs[16];
#pragma unroll
    for (int r = 0; r < 16; ++r) rs[r] = 1.f;
    store_o(o, rs, lds, wid, lane, O + (rb + q0 + wid * 32) * 512 + h * 64);
}
}

__device__ __forceinline__ void p5_attention(Frame& F, const Args& a) {
    unsigned char* ws = F.ws;
    volatile LAS int* citem = (volatile LAS int*)(F.MISC + MI_CITEM) + F.wave;
    {
        float gm;
        { const float* gq = a.in[8]; const float* gk = a.in[9]; float mq = 0.f, mk = 0.f;
          for (int i = F.lane; i < 96; i += 64) { mq = fmaxf(mq, fabsf(gq[i])); mk = fmaxf(mk, fabsf(gk[i])); }
#pragma unroll
          for (int o = 1; o < 64; o <<= 1) { mq = fmaxf(mq, __shfl_xor(mq, o)); mk = fmaxf(mk, __shfl_xor(mk, o)); }
          gm = 9.79795897f * LOG2E * mq * mk; }
        att::Conv cv; cv.w_up = a.in[16]; cv.w_down = a.in[18]; cv.up8 = (unsigned char*)(ws + WS_WUP); cv.dn8 = (unsigned char*)(ws + WS_WDN);
        cv.item = F.vcu * NWAVES + F.wave; cv.step = F.G * NWAVES; cv.ctr = 0; cv.inflight = false;
        for (int v = F.vcu; v < 256; v += F.G) {
            const int bh = v >> 3, s = v & 7, b = bh >> 3, h = bh & 7;
            for (int i = 0; i < 2; ++i) { const int qb = i ? 15 - s : s;
                att::mla_unit(F.lds, b, h, qb, (const bf16_t*)(ws + WS_QB), (const bf16_t*)(ws + WS_KB), (const bf16_t*)(ws + WS_VB), (bf16_t*)(ws + WS_OMLA), gm, cv);
                __syncthreads(); }
        }
        cv.flush((LAS float*)(F.lds + att::OST_OFF + F.wave * att::WREG), F.lane);
        if (F.lane == 0) *citem = cv.item;
    }
    __syncthreads();
    {
        att::Conv cv; cv.w_up = a.in[16]; cv.w_down = a.in[18]; cv.up8 = (unsigned char*)(ws + WS_WUP); cv.dn8 = (unsigned char*)(ws + WS_WDN);
        cv.item = __builtin_amdgcn_readfirstlane(*citem); cv.step = F.G * NWAVES; cv.ctr = 0; cv.inflight = false;
        for (int v = F.vcu; v < 256; v += F.G) {
            const int bh = v >> 3, s = v & 7, b = bh >> 3, h = bh & 7;
            for (int i = 0; i < 2; ++i) { const int qb = i ? 15 - s : s;
                att::sb_unit(F.lds, b, h, qb, (const bf16_t*)(ws + WS_PROJ), (bf16_t*)(ws + WS_OSB), cv);
                __syncthreads(); }
        }
        cv.drain((LAS float*)(F.lds + att::OST_OFF + F.wave * att::WREG), F.lane);
    }
}

__device__ __forceinline__ void p8_router(Frame& F, const Args& a) {
    unsigned char* ws = F.ws;
    const float* x1 = a.out; const float* wr = (const float*)(ws + WS_WR); const float* br = a.in[15]; const float* g = a.in[13];
    unsigned char* H2 = (unsigned char*)(ws + WS_H2F8); int* list = (int*)(ws + WS_LIST); float* topw = (float*)(ws + WS_TOPW); int* selo = (int*)(ws + WS_SEL);
    int* cnt = (int*)(ws + WS_CTL) + CW_CNT;
    volatile LAS int* lcnt = (volatile LAS int*)(F.MISC + MI_LCNT); volatile LAS int* lbase = (volatile LAS int*)(F.MISC + MI_BASE);
    const int lane = F.lane, wave = F.wave, tid = F.tid;
    constexpr int WST = 1028;
    LAS float* wt = (LAS float*)F.lds;
    if (F.vcu < M_ / 64) {
        for (int i = tid; i < D_ * NE / 4; i += NTHR) { const f32x4 v = *(const f32x4*)(wr + (size_t)i * 4); const int k = i >> 3, e = (i & 7) * 4;
            wt[(e + 0) * WST + k] = v.x; wt[(e + 1) * WST + k] = v.y; wt[(e + 2) * WST + k] = v.z; wt[(e + 3) * WST + k] = v.w; }
    }
    __syncthreads();
    for (int task = F.vcu; task < M_ / 64; task += F.G) {
        const int T0 = task * 64;
        if (tid < 32) lcnt[tid] = 0;
        __syncthreads();
        int my_e = 0, my_rank = 0; float my_w = 0.f;
        if (wave < 4) {
            const int tk = lane & 15, kp = lane >> 4, tok = T0 + wave * 16 + tk;
            const float* xp = x1 + (size_t)tok * D_ + kp * 256;
            const LAS float* w0 = wt + tk * WST + kp * 256; const LAS float* w1 = w0 + 16 * WST;
            f32x4 acc0 = {0.f, 0.f, 0.f, 0.f}, acc1 = {0.f, 0.f, 0.f, 0.f}; float ssq = 0.f;
#pragma unroll 4
            for (int i = 0; i < 256; i += 4) {
                const f32x4 a4 = *(const f32x4*)(xp + i); const f32x4 b0 = *(const LAS f32x4*)(w0 + i), b1 = *(const LAS f32x4*)(w1 + i);
                ssq += (a4.x * a4.x + a4.y * a4.y) + (a4.z * a4.z + a4.w * a4.w);
#pragma unroll
                for (int j = 0; j < 4; ++j) { acc0 = __builtin_amdgcn_mfma_f32_16x16x4f32(a4[j], b0[j], acc0, 0, 0, 0); acc1 = __builtin_amdgcn_mfma_f32_16x16x4f32(a4[j], b1[j], acc1, 0, 0, 0); }
            }
            ssq += __shfl_xor(ssq, 16); ssq += __shfl_xor(ssq, 32);
            const float rstd = rsqrtf(ssq * (1.f / D_) + EPS);
            const int e0 = lane & 15, grp = lane >> 4;
            const float bia0 = br[e0], bia1 = br[e0 + 16];
#pragma unroll
            for (int j = 0; j < 4; ++j) {
                const float rs = __shfl(rstd, 4 * grp + j);
                float c0 = acc0[j] * rs + bia0, c1 = acc1[j] * rs + bia1;
                float sv[4]; int si[4];
#pragma unroll
                for (int k = 0; k < 4; ++k) {
                    float best = c0; int bi = e0;
                    if (c1 > best) { best = c1; bi = e0 + 16; }
#pragma unroll
                    for (int st_ = 0; st_ < 4; ++st_) { const int ctl = st_ == 0 ? DPP_X1 : st_ == 1 ? DPP_X2 : st_ == 2 ? DPP_HM : DPP_RM;
                        float ob; int oi;
                        if (st_ == 0) { ob = DPP_F(best, DPP_X1); oi = DPP_I(bi, DPP_X1); } else if (st_ == 1) { ob = DPP_F(best, DPP_X2); oi = DPP_I(bi, DPP_X2); } else if (st_ == 2) { ob = DPP_F(best, DPP_HM); oi = DPP_I(bi, DPP_HM); } else { ob = DPP_F(best, DPP_RM); oi = DPP_I(bi, DPP_RM); }
                        (void)ctl; if (ob > best || (ob == best && oi < bi)) { best = ob; bi = oi; } }
                    sv[k] = best; si[k] = bi;
                    if (bi == e0) c0 = -INFINITY; if (bi == e0 + 16) c1 = -INFINITY;
                }
                float ex[4], sum = 0.f;
#pragma unroll
                for (int k = 0; k < 4; ++k) { ex[k] = __expf(sv[k] - sv[0]); sum += ex[k]; }
                const float inv = 1.f / sum;
                if (((lane >> 2) & 3) == j) {
#pragma unroll
                    for (int k = 0; k < 4; ++k) if ((lane & 3) == k) { my_e = si[k]; my_w = ex[k] * inv; }
                }
            }
            my_rank = atomicAdd((int*)&lcnt[my_e], 1);
        } else {
            const f32x4* gr = (const f32x4*)g + lane;
            f32x4 gg[4];
#pragma unroll
            for (int j = 0; j < 4; ++j) gg[j] = gr[64 * j] * X8_SCALE;
            for (int rr = 0; rr < 16; rr += 2) {
                const int t0 = T0 + (wave - 4) * 16 + rr;
                const f32x4* xr0 = (const f32x4*)(x1 + (size_t)t0 * D_) + lane; const f32x4* xr1 = xr0 + D_ / 4;
                f32x4 v0[4], v1[4]; float s0 = 0.f, s1 = 0.f;
#pragma unroll
                for (int j = 0; j < 4; ++j) { v0[j] = xr0[64 * j]; v1[j] = xr1[64 * j]; }
#pragma unroll
                for (int j = 0; j < 4; ++j) { s0 += (v0[j].x * v0[j].x + v0[j].y * v0[j].y) + (v0[j].z * v0[j].z + v0[j].w * v0[j].w); s1 += (v1[j].x * v1[j].x + v1[j].y * v1[j].y) + (v1[j].z * v1[j].z + v1[j].w * v1[j].w); }
                const float r0 = rsqrtf(wave_sum(s0) * (1.f / D_) + EPS), r1 = rsqrtf(wave_sum(s1) * (1.f / D_) + EPS);
                unsigned* o0 = (unsigned*)(H2 + (size_t)t0 * D_) + lane; unsigned* o1 = o0 + D_ / 4;
#pragma unroll
                for (int j = 0; j < 4; ++j) { o0[64 * j] = pk_fp8x4(v0[j].x * r0 * gg[j].x, v0[j].y * r0 * gg[j].y, v0[j].z * r0 * gg[j].z, v0[j].w * r0 * gg[j].w);
                    o1[64 * j] = pk_fp8x4(v1[j].x * r1 * gg[j].x, v1[j].y * r1 * gg[j].y, v1[j].z * r1 * gg[j].z, v1[j].w * r1 * gg[j].w); }
            }
        }
        __syncthreads();
        if (tid < 32) lbase[tid] = lcnt[tid] ? atomicAdd(&cnt[tid], lcnt[tid]) : 0;
        __syncthreads();
        if (wave < 4) {
            const int grp = lane >> 4, jj = (lane >> 2) & 3, kk = lane & 3;
            const int tok = T0 + wave * 16 + 4 * grp + jj, slot = tok * 4 + kk;
            list[(size_t)my_e * M_ + lbase[my_e] + my_rank] = slot;
            topw[slot] = my_w; selo[slot] = my_e;
        }
        __syncthreads();
    }
}

struct MoeOrder {
    const bf16_t* A; const bf16_t* Bt; const int* list; volatile LAS unsigned* tab;
    int lda, ldb, nN, nwg, G, c, gather; size_t estride;
    __device__ void init(const bf16_t* A_, int lda_, const bf16_t* Bt_, int ldb_, size_t estride_, int nN_, const int* list_, volatile LAS unsigned* tab_, int gather_, int G_, int c_) {
        A = A_; lda = lda_; Bt = Bt_; ldb = ldb_; estride = estride_; nN = nN_; list = list_; tab = tab_; gather = gather_; G = G_; c = c_; nwg = (int)tab[MI_TPFX + NE] * nN_; }
    __device__ __forceinline__ bool next(int i, pg8::Unit& u) const {
        const long L = (long)i * G + c; if (L >= nwg) return false;
        int wgid = (int)L; { const int q = nwg / 8, r = nwg % 8, xcd = wgid % 8, off = wgid / 8; wgid = (xcd < r ? xcd * (q + 1) : r * (q + 1) + (xcd - r) * q) + off; }
        int e = 0;
        for (int k = 1; k < NE; ++k) if ((int)tab[MI_TPFX + k] * nN <= wgid) e = k;
        const int t0 = (int)tab[MI_TPFX + e], nt = (int)tab[MI_TPFX + e + 1] - t0, idx = wgid - t0 * nN;
        u.e = e; u.pn = idx / nt; u.rt = idx % nt; u.pm = t0 + u.rt; const int left = (int)tab[MI_CNT + e] - u.rt * 256; u.rows = left < 256 ? left : 256; return true;
    }
    __device__ __forceinline__ unsigned a_off(const pg8::Unit& u, int r, int C) const {
        int row;
        if (gather) row = (r < u.rows) ? (list[(size_t)u.e * M_ + u.rt * 256 + r] >> 2) : M_;
        else row = u.pm * 256 + r;
        return (unsigned)((row * lda + C) * 2);
    }
    __device__ __forceinline__ const char* b_base(const pg8::Unit& u) const { return (const char*)(Bt + (size_t)u.e * estride + (size_t)u.pn * 256 * ldb); }
};
__device__ __forceinline__ void moe_table(Frame& F) {
    int* cnt = (int*)(F.ws + WS_CTL) + CW_CNT;
    if (F.tid < NE) F.MISC[MI_CNT + F.tid] = __hip_atomic_load((unsigned*)cnt + F.tid, RLX_AGENT);
    __syncthreads();
    if (F.tid == 0) { unsigned p = 0; for (int e = 0; e < NE; ++e) { F.MISC[MI_TPFX + e] = p; p += (F.MISC[MI_CNT + e] + 255u) >> 8; } F.MISC[MI_TPFX + NE] = p; }
    __syncthreads();
}

__device__ __forceinline__ void p12_combine(Frame& F, const Args& a) {
    const bf16_t* Y = (const bf16_t*)(F.ws + WS_YB); float* out = a.out;
    const int gt = (F.vcu * NWAVES + F.wave) * 64 + F.lane, NGT = F.G * NTHR;
    for (int i = gt; i < M_ * D_ / 8; i += NGT) {
        const int t = i >> 7, c = (i & 127) * 8;
        f32x4 v0 = *(const f32x4*)(out + (size_t)t * D_ + c), v1 = *(const f32x4*)(out + (size_t)t * D_ + c + 4);
#pragma unroll
        for (int k = 0; k < 4; ++k) { const u32x4 w = *(const u32x4*)(Y + (size_t)(t * 4 + k) * D_ + c);
            v0.x += bflo(w.x); v0.y += bfhi(w.x); v0.z += bflo(w.y); v0.w += bfhi(w.y); v1.x += bflo(w.z); v1.y += bfhi(w.z); v1.z += bflo(w.w); v1.w += bfhi(w.w); }
        *(f32x4*)(out + (size_t)t * D_ + c) = v0; *(f32x4*)(out + (size_t)t * D_ + c + 4) = v1;
    }
}

constexpr int N_PHASES = 11;
#ifndef DUP_PHASE
#define DUP_PHASE -1
#endif
__global__ void __launch_bounds__(NTHR, 2) mega(Args args) {
    extern __shared__ __attribute__((aligned(16))) unsigned char lds_raw[];
    Frame F;
    F.lds = (LAS unsigned char*)lds_raw; F.MISC = (volatile LAS unsigned*)(F.lds + LDS_MISC);
    F.tid = threadIdx.x; F.lane = F.tid & 63; F.wave = __builtin_amdgcn_readfirstlane(F.tid >> 6);
    F.G = gridDim.x; { const int bx = blockIdx.x; F.vcu = (F.G % 8 == 0) ? (bx % 8) * (F.G / 8) + bx / 8 : bx; }
    F.ws = args.ws;
    unsigned char* ws = args.ws;
    for (int u = F.tid; u < (LDS_BYTES - LDS_MISC) / 4; u += NTHR) F.MISC[u] = 0u;
    __syncthreads();
    const int lo = args.ph_lo, hi = args.ph_hi;
    XcdBarrier bar; bar.bar = (unsigned*)(ws + WS_CTL) + CW_BAR; bar.x = 0; bar.st = nullptr;
    if (hi - lo > 1) bar = xcd_barrier_post((unsigned*)(ws + WS_CTL) + CW_BAR, F.MISC + MI_BAR);
#define IN(k) (lo <= (k) && (k) < hi)
#ifdef MEGA_STAMPS
#define STAMP(k) do { if (blockIdx.x == 0 && F.tid == 0) ((unsigned long long*)(ws + WS_CTL + 32768))[(k)] = __builtin_amdgcn_s_memrealtime(); } while (0)
#else
#define STAMP(k) do { } while (0)
#endif
#define SEAM(k) do { if (IN(k) && IN((k) + 1)) xcd_barrier(bar); STAMP((k) + 1); } while (0)
    const int cid = (int)blockIdx.x;
    STAMP(0);

    if (IN(0)) { p0_prologue(F, args, 0, 1); SEAM(0); }
    if (IN(1)) {
        pg8::Gemm g{(const bf16_t*)(ws + WS_HB), D_, D_, D_};
        pg8::StaticOrder S; S.init(g.A, D_, (const bf16_t*)(ws + WS_WIN), D_, M_, 4096, F.G, cid);
        pg8::EpiBf16 E{(bf16_t*)(ws + WS_PROJ), INWP};
        pg8::gemm_phase(F.lds, g, S, E);
        SEAM(1);
    }
    if (IN(2)) {
        { pg8::Gemm g{(const bf16_t*)(ws + WS_HB), D_, D_, D_};
          pg8::StaticOrder S; S.init(g.A, D_, (const bf16_t*)(ws + WS_WIN) + (size_t)4096 * D_, D_, M_, 256, F.G, cid);
          pg8::EpiBf16 E{(bf16_t*)(ws + WS_PROJ) + 4096, INWP};
          pg8::gemm_phase(F.lds, g, S, E); }
        { pg8::Gemm g{(const bf16_t*)(ws + WS_PROJ) + C_CQ, INWP, 384, 384};
          pg8::StaticOrder S; S.init(g.A, INWP, (const bf16_t*)(ws + WS_WUQ), 384, M_, 768, F.G, cid, F.G - 64);
          pg8::EpiBf16 E{(bf16_t*)(ws + WS_QRAW), 768};
          pg8::gemm_phase(F.lds, g, S, E); }
        { pg8::Gemm g{(const bf16_t*)(ws + WS_PROJ) + C_CKV, INWP, 256, 256};
          pg8::StaticOrder S; S.init(g.A, INWP, (const bf16_t*)(ws + WS_WUKV), 256, M_, 1024, F.G, cid);
          pg8::EpiBf16 E{(bf16_t*)(ws + WS_KVRAW), 1024};
          pg8::gemm_phase(F.lds, g, S, E); }
        SEAM(2);
    }
    if (IN(3)) { p4_prep(F, args); SEAM(3); }
    if (IN(4)) { p5_attention(F, args); SEAM(4); }
    if (IN(5)) {
        pg8::Gemm g{(const bf16_t*)(ws + WS_OSB), 512, 512, 512};
        pg8::PairOrder S; S.S.init(g.A, 512, (const bf16_t*)(ws + WS_WOSB), 512, M_, D_, F.G, cid); S.a1 = (WS_OMLA - WS_OSB) / 2; S.b1 = (WS_WOMLA - WS_WOSB) / 2;
        pg8::EpiGate2 E{(bf16_t*)(ws + WS_MIX), (const bf16_t*)(ws + WS_PROJ), INWP, C_GSB, C_GMLA};
        pg8::gemm_phase(F.lds, g, S, E);
        SEAM(5);
    }
    if (IN(6)) {
        pg8::Gemm g{(const bf16_t*)(ws + WS_MIX), D_, D_, D_};
        pg8::StaticOrder S; S.init(g.A, D_, (const bf16_t*)(ws + WS_WOUT), D_, M_, D_, F.G, cid);
        pg8::EpiRes E{args.in[0], args.out};
        pg8::gemm_phase(F.lds, g, S, E);
        SEAM(6);
    }
    if (IN(7)) { p8_router(F, args); SEAM(7); }
    if (IN(8)) {
        moe_table(F);
        pg8::Gemm g{(const bf16_t*)(ws + WS_H2F8), D_ / 2, D_ / 2, D_ / 2};
        MoeOrder S; S.init(g.A, D_ / 2, (const bf16_t*)(ws + WS_WUP), D_ / 2, (size_t)2 * DFF * D_ / 2, 8, (const int*)(ws + WS_LIST), F.MISC, 1, F.G, cid);
        pg8::EpiSwiglu8 E{(unsigned char*)(ws + WS_ACT), args.in[17]};
        pg8::gemm_phase<pg8::EpiSwiglu8, MoeOrder, true>(F.lds, g, S, E);
        SEAM(8);
    }
    if (IN(9)) {
        moe_table(F);
        pg8::Gemm g{(const bf16_t*)(ws + WS_ACT), DFF / 2, DFF / 2, DFF / 2};
        MoeOrder S; S.init(g.A, DFF / 2, (const bf16_t*)(ws + WS_WDN), DFF / 2, (size_t)D_ * DFF / 2, 4, (const int*)(ws + WS_LIST), F.MISC, 0, F.G, cid);
        pg8::EpiDown E{(bf16_t*)(ws + WS_YB), args.in[19], (const int*)(ws + WS_LIST), (const float*)(ws + WS_TOPW)};
        pg8::gemm_phase<pg8::EpiDown, MoeOrder, true>(F.lds, g, S, E);
        SEAM(9);
    }
    if (IN(10)) { p12_combine(F, args); STAMP(11); }
#undef IN
#undef SEAM
}
static int g_grid = 0;
static int setup_grid() {
    if (g_grid == 0) {
        int dev = 0, cus = 0;
        if (hipGetDevice(&dev) != hipSuccess || hipDeviceGetAttribute(&cus, hipDeviceAttributeMultiprocessorCount, dev) != hipSuccess) { g_grid = -1; return g_grid; }
        if (hipFuncSetAttribute((const void*)mega, hipFuncAttributeMaxDynamicSharedMemorySize, LDS_BYTES) != hipSuccess) { g_grid = -1; return g_grid; }
        int per_cu = 0;
        (void)hipOccupancyMaxActiveBlocksPerMultiprocessor(&per_cu, (const void*)mega, NTHR, LDS_BYTES);
        (void)hipGetLastError();
        g_grid = cus;
    }
    return g_grid;
}
static void launch_mega(void* const* d_in, void* d_out, void* d_ws, int lo, int hi, hipStream_t stream) {
    Args a; memset(&a, 0, sizeof(a));
    for (int i = 0; i < 20; ++i) a.in[i] = (const float*)d_in[i];
    a.out = (float*)d_out; a.ws = (unsigned char*)d_ws; a.ph_lo = lo; a.ph_hi = hi;
    hipLaunchKernelGGL(mega, dim3(g_grid), dim3(NTHR), LDS_BYTES, stream, a);
}
extern "C" void kernel_launch(void* const* d_in, const int* in_sizes, int n_in, void* d_out, int out_size, void* d_ws, size_t ws_size, hipStream_t stream) {
    if (n_in != 20 || ws_size < WS_OPT_END || out_size != M_ * D_) { fprintf(stderr, "kernel_launch: unexpected arguments\n"); return; }
    if (setup_grid() <= 0) return;
    (void)hipMemsetAsync((char*)d_ws + WS_CTL, 0, CTL_ZERO_BYTES, stream);
#if N_LAUNCH_SPLIT
    for (int p = 0; p < N_PHASES; ++p) { launch_mega(d_in, d_out, d_ws, p, p + 1, stream); if (p == DUP_PHASE) { if (p == 7) (void)hipMemsetAsync((char*)d_ws + WS_CTL, 0, 128, stream); if (p == 10) launch_mega(d_in, d_out, d_ws, 6, 7, stream); launch_mega(d_in, d_out, d_ws, p, p + 1, stream); } }
#else
    launch_mega(d_in, d_out, d_ws, 0, N_PHASES, stream);
#endif
}
```

```cpp
#define N_LAUNCH_SPLIT 0
#include <hip/hip_runtime.h>
#include <hip/hip_bf16.h>
#include <cstdio>
#include <cstdint>
#include <cstring>
#include <cmath>

constexpr int B_ = 4, S_ = 4096, D_ = 1024, M_ = B_ * S_;
constexpr int INW = 4256, INWP = 4352;
constexpr int C_SBQ = 0, C_SBK = 512, C_SBV = 1024, C_CQ = 1536, C_CKV = 1920, C_KR = 2176, C_GSB = 2208, C_GMLA = 3232;
constexpr int NE = 32, TOPK = 4, DFF = 1024;
constexpr float EPS = 1e-6f;
constexpr float LOG2E = 1.4426950408889634f;
constexpr float SB_QSCALE = 0.125f * LOG2E;
constexpr float MLA_QSCALE = 0.10206207261596577f * LOG2E;
constexpr int NWAVES = 8, NTHR = 512;

#define LAS __attribute__((address_space(3)))
#define GAS __attribute__((address_space(1)))
typedef unsigned short bf16_t;
typedef short bf16x8 __attribute__((ext_vector_type(8)));
typedef short s16x4 __attribute__((ext_vector_type(4)));
typedef float f32x4 __attribute__((ext_vector_type(4)));
typedef float f32x16 __attribute__((ext_vector_type(16)));
typedef unsigned u32x4 __attribute__((ext_vector_type(4)));
typedef unsigned u32x2 __attribute__((ext_vector_type(2)));
typedef float f32x2_t __attribute__((ext_vector_type(2)));
typedef __bf16 bf16x2_t __attribute__((ext_vector_type(2)));
typedef int v8i_t __attribute__((ext_vector_type(8)));
constexpr float W8_SCALE = 8.f, X8_SCALE = 8.f;
__device__ __forceinline__ unsigned pk_fp8x4(float a, float b, float c, float d) { unsigned w = 0; w = __builtin_amdgcn_cvt_pk_fp8_f32(a, b, w, false); w = __builtin_amdgcn_cvt_pk_fp8_f32(c, d, w, true); return w; }

__device__ __forceinline__ unsigned cvtpk(float lo, float hi) { f32x2_t v = {lo, hi}; bf16x2_t b = __builtin_convertvector(v, bf16x2_t); return __builtin_bit_cast(unsigned, b); }
__device__ __forceinline__ float bf2f(unsigned short h) { return __uint_as_float(((unsigned)h) << 16); }
__device__ __forceinline__ float bflo(unsigned w) { return __uint_as_float(w << 16); }
__device__ __forceinline__ float bfhi(unsigned w) { return __uint_as_float(w & 0xffff0000u); }
__device__ __forceinline__ float dpp_f(float v, int ctrl) { return v; }
#define DPP_F(v, ctrl) __int_as_float(__builtin_amdgcn_update_dpp(0, __float_as_int(v), (ctrl), 0xF, 0xF, true))
#define DPP_I(v, ctrl) __builtin_amdgcn_update_dpp(0, (v), (ctrl), 0xF, 0xF, true)
#define DPP_X1 0xB1
#define DPP_X2 0x4E
#define DPP_HM 0x141
#define DPP_RM 0x140
__device__ __forceinline__ float wave_sum(float v) {
    v += DPP_F(v, DPP_X1); v += DPP_F(v, DPP_X2); v += DPP_F(v, DPP_HM); v += DPP_F(v, DPP_RM);
    return (__int_as_float(__builtin_amdgcn_readlane(__float_as_int(v), 0)) + __int_as_float(__builtin_amdgcn_readlane(__float_as_int(v), 16)))
         + (__int_as_float(__builtin_amdgcn_readlane(__float_as_int(v), 32)) + __int_as_float(__builtin_amdgcn_readlane(__float_as_int(v), 48)));
}
__device__ __forceinline__ float sum8(float v) { v += DPP_F(v, DPP_X1); v += DPP_F(v, DPP_X2); v += DPP_F(v, DPP_HM); return v; }
__device__ __forceinline__ float sigmoidf_(float x) { return __builtin_amdgcn_rcpf(1.f + __builtin_amdgcn_exp2f(-x * LOG2E)); }

namespace pg8 {
constexpr int BM = 256, BK = 64, HALF = 128, HTB = HALF * BK * 2, STAGE_BYTES = 8 * HTB, NXCD = 8, WGM = 8;
__host__ __device__ __forceinline__ int lds_byte(int r, int c) { const int st = (r >> 4) * 2 + (c >> 5), rr = r & 15, cc = c & 31, ob = rr * 64 + cc * 2; return st * 1024 + (ob ^ (((ob >> 9) & 1) << 5)); }
__host__ __device__ __forceinline__ void stage_rc(int b, int& R, int& C) { const int st = b / 1024, sb = b % 1024, swz = sb ^ (((sb >> 9) & 1) << 5); R = (st >> 1) * 16 + swz / 64; C = (st & 1) * 32 + (swz % 64) / 2; }
__host__ __device__ __forceinline__ int perm32(int rho) { const int n = rho >> 4, i = rho & 15; return 8 * (i >> 2) + 4 * n + (i & 3); }

struct Unit { int pm, pn, e, rows, rt; };
struct Gemm { const bf16_t* A; int lda, ldb, K; };

struct StaticOrder {
    const bf16_t* A; const bf16_t* Bt; int lda, ldb;
    int nM, nN, nwg, G, c;
    __device__ void init(const bf16_t* A_, int lda_, const bf16_t* Bt_, int ldb_, int M, int N, int G_, int c_, int cshift = 0) { A = A_; Bt = Bt_; lda = lda_; ldb = ldb_; nM = M / BM; nN = N / BM; nwg = nM * nN; G = G_; c = (c_ + cshift) % G_; }
    __device__ __forceinline__ bool next(int i, Unit& u) const {
        const long L = (long)i * G + c; if (L >= nwg) return false;
        int wgid = (int)L; { const int q = nwg / NXCD, r = nwg % NXCD, xcd = wgid % NXCD, off = wgid / NXCD; wgid = (xcd < r ? xcd * (q + 1) : r * (q + 1) + (xcd - r) * q) + off; }
        const int nig = WGM * nN, gid = wgid / nig, fm = gid * WGM, gsz = (nM - fm) < WGM ? (nM - fm) : WGM;
        u.pm = fm + ((wgid % nig) % gsz); u.pn = (wgid % nig) / gsz; u.e = 0; u.rows = 256; u.rt = 0; return true;
    }
    __device__ __forceinline__ unsigned a_off(const Unit& u, int r, int C) const { return (unsigned)(((u.pm * BM + r) * lda + C) * 2); }
    __device__ __forceinline__ const char* b_base(const Unit& u) const { return (const char*)(Bt + (size_t)u.pn * BM * ldb); }
};

__device__ __forceinline__ v8i_t ld32_lds(const LAS unsigned char* p) { const u32x4 lo_ = *(const LAS u32x4*)p, hi_ = *(const LAS u32x4*)(p + 1024); return (v8i_t){(int)lo_.x, (int)lo_.y, (int)lo_.z, (int)lo_.w, (int)hi_.x, (int)hi_.y, (int)hi_.z, (int)hi_.w}; }
struct PairOrder {
    StaticOrder S; size_t a1, b1;
    __device__ __forceinline__ bool next(int i, Unit& u) const { if (!S.next(i >> 1, u)) return false; u.e = i & 1; return true; }
    __device__ __forceinline__ unsigned a_off(const Unit& u, int r, int C) const { return S.a_off(u, r, C) + (unsigned)(u.e ? a1 * 2 : 0); }
    __device__ __forceinline__ const char* b_base(const Unit& u) const { return S.b_base(u) + (u.e ? b1 * 2 : 0); }
};
__device__ __forceinline__ void mfma_f8(f32x4& c, const v8i_t a, const v8i_t b, int sa, int sb) {
    asm volatile("v_mfma_scale_f32_16x16x128_f8f6f4 %0, %1, %2, %0, %3, %4 op_sel_hi:[0,0,0]" : "+v"(c) : "v"(a), "v"(b), "v"(sa), "v"(sb));
}
template <bool F8> struct FragT { typedef bf16x8 type; };
template <> struct FragT<true> { typedef v8i_t type; };
template <class Epi, class Sched, bool FP8 = false>
__device__ __forceinline__ void gemm_phase(LAS unsigned char* lds, const Gemm g, const Sched& S, const Epi& E) {
    const int tid = threadIdx.x, wid = __builtin_amdgcn_readfirstlane(tid >> 6), lane = tid & 63, wr = wid >> 2, wc = wid & 3, fr = lane & 15, fq = lane >> 4;
    const int K = g.K, nt = K / BK;
    unsigned voffB[2];
#pragma unroll
    for (int i = 0; i < 2; ++i) { int R, C; stage_rc(tid * 16 + i * 8192, R, C); const int Rb = Epi::PERM ? ((R & ~31) + perm32(R & 31)) : R; voffB[i] = (unsigned)(Rb * g.ldb + C) * 2u; }
#define PG8_AOFF(dst, unit) do { int t_ = tid; asm volatile("" : "+v"(t_)); _Pragma("unroll") for (int i = 0; i < 2; ++i) { int R, C; stage_rc(t_ * 16 + i * 8192, R, C); \
        _Pragma("unroll") for (int h = 0; h < 2; ++h) dst[h][i] = S.a_off(unit, h * HALF + R, C); } } while (0)
    const size_t kstep = (size_t)(BK * 2);
    const size_t hstepB = (size_t)HALF * g.ldb * 2;
    const unsigned ldsw = (unsigned)wid * 1024u;
    const int aoff = lds_byte(wr * 64 + fr, fq * 8), boff = lds_byte(wc * 32 + fr, fq * 8);
#define PG8_SA(b, h) (((b) * 2 + (h)) * HTB)
#define PG8_SB(b, h) ((4 + (b) * 2 + (h)) * HTB)
#define PG8_STAGE(bufoff, gbase, voff) do { _Pragma("unroll") for (int _i = 0; _i < 2; ++_i) \
        __builtin_amdgcn_global_load_lds((const unsigned*)((const char*)(gbase) + (voff)[_i]), (LAS unsigned*)(lds + (bufoff) + ldsw + _i * 8192), 16, 0, 0); } while (0)
#define PG8_LD32(p) ld32_lds((const LAS unsigned char*)(p))
#define PG8_LDA(dst, b, h) do { if constexpr (FP8) { _Pragma("unroll") for (int m = 0; m < 4; ++m) dst[m][0] = __builtin_bit_cast(FT, PG8_LD32(lds + PG8_SA(b, h) + aoff + m * 2048)); } \
        else { _Pragma("unroll") for (int m = 0; m < 4; ++m) _Pragma("unroll") for (int k = 0; k < 2; ++k) dst[m][k] = __builtin_bit_cast(FT, *(const LAS FT*)(lds + PG8_SA(b, h) + aoff + m * 2048 + k * 1024)); } } while (0)
#define PG8_LDB(dst, b, h) do { if constexpr (FP8) { _Pragma("unroll") for (int n = 0; n < 2; ++n) dst[n][0] = __builtin_bit_cast(FT, PG8_LD32(lds + PG8_SB(b, h) + boff + n * 2048)); } \
        else { _Pragma("unroll") for (int n = 0; n < 2; ++n) _Pragma("unroll") for (int k = 0; k < 2; ++k) dst[n][k] = __builtin_bit_cast(FT, *(const LAS FT*)(lds + PG8_SB(b, h) + boff + n * 2048 + k * 1024)); } } while (0)
#define PG8_MMA(ai, bj, At, Bt) do { __builtin_amdgcn_s_setprio(1); \
        if constexpr (FP8) { _Pragma("unroll") for (int m = 0; m < 4; ++m) _Pragma("unroll") for (int n = 0; n < 2; ++n) \
            mfma_f8(acc[ai][bj][m][n], __builtin_bit_cast(v8i_t, Bt[n][0]), __builtin_bit_cast(v8i_t, At[m][0]), 0x7c7c7c7c, 0x7c7c7c7c); } \
        else { _Pragma("unroll") for (int m = 0; m < 4; ++m) _Pragma("unroll") for (int n = 0; n < 2; ++n) _Pragma("unroll") for (int k = 0; k < 2; ++k) \
            acc[ai][bj][m][n] = __builtin_amdgcn_mfma_f32_16x16x32_bf16(__builtin_bit_cast(bf16x8, Bt[n][k]), __builtin_bit_cast(bf16x8, At[m][k]), acc[ai][bj][m][n], 0, 0, 0); } \
        __builtin_amdgcn_s_setprio(0); } while (0)
#define PG8_WAIT_V(n) asm volatile("s_waitcnt vmcnt(" #n ")" ::: "memory")
#define PG8_WAIT_L(n) asm volatile("s_waitcnt lgkmcnt(" #n ")" ::: "memory")
#define PG8_BAR __builtin_amdgcn_s_barrier()
#define PG8_SCHED __builtin_amdgcn_sched_barrier(0)
    Unit cur, nxt; int ui = 0;
    if (!S.next(0, cur)) return;
    f32x4 acc[2][2][4][2];
#pragma unroll
    for (int a = 0; a < 2; ++a)
#pragma unroll
        for (int b = 0; b < 2; ++b)
#pragma unroll
            for (int m = 0; m < 4; ++m)
#pragma unroll
                for (int n = 0; n < 2; ++n) acc[a][b][m][n] = (f32x4){0.f, 0.f, 0.f, 0.f};
    typedef typename FragT<FP8>::type FT; constexpr int NK = FP8 ? 1 : 2;
    FT At[4][NK], B0[2][NK], B1[2][NK];
    const char* Ab = (const char*)g.A;
    const char* cB = S.b_base(cur);
    unsigned vaC[2][2], vaN[2][2];
    PG8_AOFF(vaC, cur);
    PG8_STAGE(PG8_SB(0, 0), cB, voffB); PG8_STAGE(PG8_SB(0, 1), cB + hstepB, voffB); PG8_STAGE(PG8_SA(0, 0), Ab, vaC[0]); PG8_STAGE(PG8_SA(0, 1), Ab, vaC[1]);
    if (wr == 1) PG8_BAR;
    PG8_WAIT_V(2); PG8_BAR;
    PG8_STAGE(PG8_SB(1, 0), cB + kstep, voffB); PG8_STAGE(PG8_SA(1, 0), Ab + kstep, vaC[0]); PG8_STAGE(PG8_SB(1, 1), cB + hstepB + kstep, voffB);
    PG8_WAIT_V(6); PG8_BAR;
    for (;;) {
        const bool has_next = S.next(ui + 1, nxt);
        const char* nB = has_next ? S.b_base(nxt) : cB;
        if (has_next) PG8_AOFF(vaN, nxt);
        else {
#pragma unroll
            for (int h = 0; h < 2; ++h)
#pragma unroll
                for (int i = 0; i < 2; ++i) vaN[h][i] = vaC[h][i]; }
        for (int t = 0; t < nt; t += 2) {
            const bool last = (t == nt - 2);
            const char* kA1 = Ab + (size_t)(t + 1) * kstep;
            const char* kA2 = last ? Ab : Ab + (size_t)(t + 2) * kstep; const char* b2 = last ? nB : cB + (size_t)(t + 2) * kstep;
            const char* kA3 = kA2 + kstep; const char* b3 = b2 + kstep;
            unsigned o2[2][2];
#pragma unroll
            for (int h = 0; h < 2; ++h)
#pragma unroll
                for (int i = 0; i < 2; ++i) o2[h][i] = last ? vaN[h][i] : vaC[h][i];
            PG8_LDB(B0, 0, 0); PG8_LDB(B1, 0, 1); PG8_SCHED; PG8_LDA(At, 0, 0); PG8_STAGE(PG8_SA(1, 1), kA1, vaC[1]);
            PG8_WAIT_V(8); PG8_WAIT_L(0); PG8_BAR; PG8_MMA(0, 0, At, B0); PG8_MMA(0, 1, At, B1); PG8_BAR; PG8_SCHED;
            PG8_LDA(At, 0, 1); PG8_STAGE(PG8_SB(0, 0), b2, voffB); PG8_STAGE(PG8_SB(0, 1), b2 + hstepB, voffB); PG8_STAGE(PG8_SA(0, 0), kA2, o2[0]);
            PG8_WAIT_V(8); PG8_WAIT_L(0); PG8_BAR; PG8_MMA(1, 0, At, B0); PG8_MMA(1, 1, At, B1); PG8_BAR; PG8_SCHED;
            PG8_LDB(B0, 1, 0); PG8_LDB(B1, 1, 1); PG8_SCHED; PG8_LDA(At, 1, 0); PG8_STAGE(PG8_SA(0, 1), kA2, o2[1]);
            PG8_WAIT_V(8); PG8_WAIT_L(0); PG8_BAR; PG8_MMA(0, 0, At, B0); PG8_MMA(0, 1, At, B1); PG8_BAR; PG8_SCHED;
            PG8_LDA(At, 1, 1); PG8_STAGE(PG8_SB(1, 0), b3, voffB); PG8_STAGE(PG8_SB(1, 1), b3 + hstepB, voffB); PG8_STAGE(PG8_SA(1, 0), kA3, o2[0]);
            PG8_WAIT_V(8); PG8_WAIT_L(0); PG8_BAR; PG8_MMA(1, 0, At, B0); PG8_MMA(1, 1, At, B1); PG8_BAR; PG8_SCHED;
        }
        if (wr == 0) PG8_BAR;
        if constexpr (FP8) asm volatile("s_nop 15\n\ts_nop 15" ::: "memory");
        E(acc, cur, wr, wc, fr, fq);
        if (!has_next) break;
#pragma unroll
        for (int a = 0; a < 2; ++a)
#pragma unroll
            for (int b = 0; b < 2; ++b)
#pragma unroll
                for (int m = 0; m < 4; ++m)
#pragma unroll
                    for (int n = 0; n < 2; ++n) acc[a][b][m][n] = (f32x4){0.f, 0.f, 0.f, 0.f};
        cur = nxt; cB = nB; ++ui;
#pragma unroll
        for (int h = 0; h < 2; ++h)
#pragma unroll
            for (int i = 0; i < 2; ++i) vaC[h][i] = vaN[h][i];
        if (wr == 1) PG8_BAR;
    }
    PG8_WAIT_V(0);
    PG8_BAR;
#undef PG8_SA
#undef PG8_AOFF
#undef PG8_SB
#undef PG8_STAGE
#undef PG8_LDA
#undef PG8_LDB
#undef PG8_MMA
#undef PG8_LD32
#undef PG8_WAIT_V
#undef PG8_WAIT_L
#undef PG8_BAR
#undef PG8_SCHED
}

struct EpiBf16 {
    static constexpr bool PERM = true;
    bf16_t* O; int ldc;
    __device__ __forceinline__ void operator()(const f32x4 (&acc)[2][2][4][2], const Unit& u, int wr, int wc, int fr, int fq) const {
        const int row0 = u.pm * BM + wr * 64 + fr, col0 = u.pn * BM + wc * 32 + 8 * fq;
#pragma unroll
        for (int ai = 0; ai < 2; ++ai)
#pragma unroll
            for (int m = 0; m < 4; ++m) { bf16_t* rowp = O + (size_t)(row0 + ai * HALF + m * 16) * ldc + col0;
#pragma unroll
                for (int bj = 0; bj < 2; ++bj) { const f32x4 v0 = acc[ai][bj][m][0], v1 = acc[ai][bj][m][1];
                    u32x4 w; w.x = cvtpk(v0[0], v0[1]); w.y = cvtpk(v0[2], v0[3]); w.z = cvtpk(v1[0], v1[1]); w.w = cvtpk(v1[2], v1[3]);
                    *(u32x4*)(rowp + bj * HALF) = w; } }
    }
};
struct EpiGate2 {
    static constexpr bool PERM = true;
    bf16_t* O; const bf16_t* G; int ldg, gcol0, gcol1;
    __device__ __forceinline__ void operator()(const f32x4 (&acc)[2][2][4][2], const Unit& u, int wr, int wc, int fr, int fq) const {
        const int row0 = u.pm * BM + wr * 64 + fr, col0 = u.pn * BM + wc * 32 + 8 * fq;
        const bool second = u.e != 0; const int gcol = second ? gcol1 : gcol0;
#pragma unroll
        for (int ai = 0; ai < 2; ++ai)
#pragma unroll
            for (int m = 0; m < 4; ++m) { const size_t r = (size_t)(row0 + ai * HALF + m * 16);
#pragma unroll
                for (int bj = 0; bj < 2; ++bj) { const f32x4 v0 = acc[ai][bj][m][0], v1 = acc[ai][bj][m][1];
                    const int c = col0 + bj * HALF;
                    const u32x4 gw = *(const u32x4*)(G + r * ldg + gcol + c);
                    bf16_t* op = O + r * D_ + c;
                    u32x4 pw = {0u, 0u, 0u, 0u}; if (second) pw = *(const u32x4*)op;
                    float o[8];
                    o[0] = sigmoidf_(bflo(gw.x)) * v0[0]; o[1] = sigmoidf_(bfhi(gw.x)) * v0[1]; o[2] = sigmoidf_(bflo(gw.y)) * v0[2]; o[3] = sigmoidf_(bfhi(gw.y)) * v0[3];
                    o[4] = sigmoidf_(bflo(gw.z)) * v1[0]; o[5] = sigmoidf_(bfhi(gw.z)) * v1[1]; o[6] = sigmoidf_(bflo(gw.w)) * v1[2]; o[7] = sigmoidf_(bfhi(gw.w)) * v1[3];
                    o[0] += bflo(pw.x); o[1] += bfhi(pw.x); o[2] += bflo(pw.y); o[3] += bfhi(pw.y); o[4] += bflo(pw.z); o[5] += bfhi(pw.z); o[6] += bflo(pw.w); o[7] += bfhi(pw.w);
                    u32x4 w; w.x = cvtpk(o[0], o[1]); w.y = cvtpk(o[2], o[3]); w.z = cvtpk(o[4], o[5]); w.w = cvtpk(o[6], o[7]);
                    *(u32x4*)op = w; } }
    }
};
struct EpiRes {
    static constexpr bool PERM = false;
    const float* base; float* out;
    __device__ __forceinline__ void operator()(const f32x4 (&acc)[2][2][4][2], const Unit& u, int wr, int wc, int fr, int fq) const {
        const int row0 = u.pm * BM + wr * 64 + fr, col0 = u.pn * BM + wc * 32 + 4 * fq;
#pragma unroll
        for (int ai = 0; ai < 2; ++ai)
#pragma unroll
            for (int m = 0; m < 4; ++m) { const size_t off = (size_t)(row0 + ai * HALF + m * 16) * D_ + col0;
#pragma unroll
                for (int bj = 0; bj < 2; ++bj)
#pragma unroll
                    for (int n = 0; n < 2; ++n) { const f32x4 b = *(const f32x4*)(base + off + bj * HALF + n * 16); *(f32x4*)(out + off + bj * HALF + n * 16) = b + acc[ai][bj][m][n]; } }
    }
};
struct EpiSwiglu {
    static constexpr bool PERM = true;
    bf16_t* act; const float* b_up;
    __device__ __forceinline__ void operator()(const f32x4 (&acc)[2][2][4][2], const Unit& u, int wr, int wc, int fr, int fq) const {
        const int row0 = u.pm * BM + wr * 64 + fr, col0 = u.pn * BM + wc * 32 + 8 * fq;
        const float* bb = b_up + (size_t)u.e * (2 * DFF);
        f32x4 bv[2][2];
#pragma unroll
        for (int bj = 0; bj < 2; ++bj)
#pragma unroll
            for (int n = 0; n < 2; ++n) bv[bj][n] = *(const f32x4*)(bb + col0 + bj * HALF + 4 * n);
#pragma unroll
        for (int ai = 0; ai < 2; ++ai)
#pragma unroll
            for (int m = 0; m < 4; ++m) { bf16_t* rowp = act + (size_t)(row0 + ai * HALF + m * 16) * DFF + (col0 >> 1);
#pragma unroll
                for (int bj = 0; bj < 2; ++bj) { const f32x4 v0 = acc[ai][bj][m][0] + bv[bj][0], v1 = acc[ai][bj][m][1] + bv[bj][1];
                    float a[4];
#pragma unroll
                    for (int p = 0; p < 4; ++p) { float gl = (p < 2) ? v0[2 * p] : v1[2 * p - 4], li = (p < 2) ? v0[2 * p + 1] : v1[2 * p - 3];
                        gl = fminf(gl, 7.f); li = fminf(fmaxf(li, -7.f), 7.f);
                        a[p] = gl * sigmoidf_(1.702f * gl) * (li + 1.f); }
                    u32x2 w; w.x = cvtpk(a[0], a[1]); w.y = cvtpk(a[2], a[3]);
                    *(u32x2*)(rowp + bj * (HALF / 2)) = w; } }
    }
};
struct EpiSwiglu8 {
    static constexpr bool PERM = true;
    unsigned char* act; const float* b_up;
    __device__ __forceinline__ void operator()(const f32x4 (&acc)[2][2][4][2], const Unit& u, int wr, int wc, int fr, int fq) const {
        const int row0 = u.pm * BM + wr * 64 + fr, col0 = u.pn * BM + wc * 32 + 8 * fq;
        const float* bb = b_up + (size_t)u.e * (2 * DFF);
        f32x4 bv[2][2];
#pragma unroll
        for (int bj = 0; bj < 2; ++bj)
#pragma unroll
            for (int n = 0; n < 2; ++n) bv[bj][n] = *(const f32x4*)(bb + col0 + bj * HALF + 4 * n);
#pragma unroll
        for (int ai = 0; ai < 2; ++ai)
#pragma unroll
            for (int m = 0; m < 4; ++m) { unsigned char* rowp = act + (size_t)(row0 + ai * HALF + m * 16) * DFF + (col0 >> 1);
#pragma unroll
                for (int bj = 0; bj < 2; ++bj) { const f32x4 v0 = acc[ai][bj][m][0] + bv[bj][0], v1 = acc[ai][bj][m][1] + bv[bj][1];
                    float a[4];
#pragma unroll
                    for (int p = 0; p < 4; ++p) { float gl = (p < 2) ? v0[2 * p] : v1[2 * p - 4], li = (p < 2) ? v0[2 * p + 1] : v1[2 * p - 3];
                        gl = fminf(gl, 7.f); li = fminf(fmaxf(li, -7.f), 7.f);
                        a[p] = gl * sigmoidf_(1.702f * gl) * (li + 1.f) * X8_SCALE; }
                    *(unsigned*)(rowp + bj * (HALF / 2)) = pk_fp8x4(a[0], a[1], a[2], a[3]); } }
    }
};
struct EpiDown {
    static constexpr bool PERM = true;
    bf16_t* y; const float* b_down; const int* list; const float* topw;
    __device__ __forceinline__ void operator()(const f32x4 (&acc)[2][2][4][2], const Unit& u, int wr, int wc, int fr, int fq) const {
        const int col0 = u.pn * BM + wc * 32 + 8 * fq;
        const float* bb = b_down + (size_t)u.e * D_;
        f32x4 bv[2][2];
#pragma unroll
        for (int bj = 0; bj < 2; ++bj)
#pragma unroll
            for (int n = 0; n < 2; ++n) bv[bj][n] = *(const f32x4*)(bb + col0 + bj * HALF + 4 * n);
        const int* lp = list + (size_t)u.e * M_ + u.rt * BM;
#pragma unroll
        for (int ai = 0; ai < 2; ++ai)
#pragma unroll
            for (int m = 0; m < 4; ++m) { const int r = ai * HALF + wr * 64 + m * 16 + fr;
                if (r < u.rows) { const int slot = lp[r]; const float w = topw[slot]; bf16_t* rowp = y + (size_t)slot * D_ + col0;
#pragma unroll
                    for (int bj = 0; bj < 2; ++bj) { const f32x4 v0 = (acc[ai][bj][m][0] + bv[bj][0]) * w, v1 = (acc[ai][bj][m][1] + bv[bj][1]) * w;
                        u32x4 o; o.x = cvtpk(v0[0], v0[1]); o.y = cvtpk(v0[2], v0[3]); o.z = cvtpk(v1[0], v1[1]); o.w = cvtpk(v1[2], v1[3]);
                        *(u32x4*)(rowp + bj * HALF) = o; } } }
    }
};
}
constexpr size_t MiB = 1ull << 20;
constexpr size_t WS_CTL = 0, CTL_ZERO_BYTES = 64 * 1024;
constexpr size_t WS_ROPE = 256 * 1024;
constexpr size_t WS_WR = 3 * MiB;
constexpr size_t WS_LIST = 4 * MiB;
constexpr size_t WS_TOPW = 6 * MiB;
constexpr size_t WS_SEL = 6 * MiB + 512 * 1024;
constexpr size_t WS_WIN = 8 * MiB;
constexpr size_t WS_WUQ = 17 * MiB;
constexpr size_t WS_WUKV = 18 * MiB;
constexpr size_t WS_WOSB = 19 * MiB;
constexpr size_t WS_WOMLA = 20 * MiB;
constexpr size_t WS_WOUT = 21 * MiB;
constexpr size_t WS_WUP = 24 * MiB;
constexpr size_t WS_WDN = 152 * MiB;
constexpr size_t WS_HB = 216 * MiB;
constexpr size_t WS_PROJ = 249 * MiB;
constexpr size_t WS_ACT = WS_PROJ;
constexpr size_t WS_QRAW = 393 * MiB;
constexpr size_t WS_KVRAW = WS_QRAW + 24 * MiB;
constexpr size_t WS_QB = WS_KVRAW + 32 * MiB;
constexpr size_t WS_KB = WS_QB + 24 * MiB;
constexpr size_t WS_VB = WS_KB + 24 * MiB;
constexpr size_t WS_OSB = WS_VB + 16 * MiB;
constexpr size_t WS_OMLA = WS_OSB + 16 * MiB;
constexpr size_t WS_YB = WS_QRAW;
constexpr size_t WS_MIX = 545 * MiB;
constexpr size_t WS_H2F8 = 577 * MiB;
constexpr size_t WS_OPT_END = 594 * MiB;
constexpr int CW_CNT = 0;
constexpr int CW_BAR = 1024;
constexpr int LDS_STAGE = 143360;
constexpr int LDS_MISC = LDS_STAGE;
constexpr int LDS_BYTES = 147456;
constexpr int MI_BAR = 0, MI_TPFX = 16, MI_CNT = 64, MI_FLAG = 128, MI_LCNT = 160, MI_BASE = 192, MI_RSTD = 256, MI_CITEM = 320;

typedef GAS unsigned gu32;
#define RLX_AGENT __ATOMIC_RELAXED, __HIP_MEMORY_SCOPE_AGENT

#define XB_TMO      128
#define XB_XCNT(j)  (256  + 64 * (j))
#define XB_XSUB(j)  (1280 + 64 * (j))
#define XB_XGEN(j)  (2304 + 64 * (j))
#define XB_TOP      3328
#define XB_TOPGEN   3392
#define XCD_BAR_WORDS 3456
#define XB_SPIN_CAP (1u << 18)
__device__ __forceinline__ unsigned xb_ld(unsigned* p)              { return __hip_atomic_load(p, __ATOMIC_RELAXED, __HIP_MEMORY_SCOPE_AGENT); }
__device__ __forceinline__ unsigned xb_add(unsigned* p, unsigned v) { return __hip_atomic_fetch_add(p, v, __ATOMIC_RELAXED, __HIP_MEMORY_SCOPE_AGENT); }
__device__ __forceinline__ unsigned xb_xcc_id() { return (unsigned)__builtin_amdgcn_s_getreg((3 << 11) | 20) & 0xFu; }
#define XB_SPIN(cond, bar) do { unsigned _sp = 0; while (cond) { __builtin_amdgcn_s_sleep(1); \
    if ((++_sp & 255u) == 0u) { if (xb_ld(&(bar)[XB_TMO])) break; if (_sp > XB_SPIN_CAP) { atomicAdd(&(bar)[XB_TMO], 1u); break; } } } } while (0)
struct XcdBarrier { unsigned* bar; unsigned x; volatile LAS unsigned* st; };
__device__ __forceinline__ XcdBarrier xcd_barrier_post(unsigned* bar, volatile LAS unsigned* st) {
    XcdBarrier b; b.bar = bar; b.x = xb_xcc_id(); b.st = st;
    if (threadIdx.x == 0) (void)xb_add(&bar[XB_XCNT(b.x)], 1u);
    return b;
}
__device__ __forceinline__ void xcd_barrier_complete(unsigned* bar, unsigned x, unsigned& nloc, unsigned& nx) {
    const unsigned G = gridDim.x * gridDim.y * gridDim.z;
    unsigned sum, cnt, mine, sp = 0u;
    for (;;) {
        sum = 0u; cnt = 0u; mine = 0u;
#pragma unroll
        for (unsigned j = 0; j < 16; ++j) { const unsigned c = xb_ld(&bar[XB_XCNT(j)]); sum += c; cnt += (c > 0u) ? 1u : 0u; mine = (j == x) ? c : mine; }
        if (sum == G) break;
        __builtin_amdgcn_s_sleep(1);
        if ((++sp & 255u) == 0u) { if (xb_ld(&bar[XB_TMO])) break; if (sp > XB_SPIN_CAP) { atomicAdd(&bar[XB_TMO], 1u); break; } }
    }
    nloc = mine > 0u ? mine : 1u; nx = cnt > 0u ? cnt : 1u;
}
__device__ __forceinline__ void xcd_barrier(const XcdBarrier& b) {
    asm volatile("s_waitcnt vmcnt(0)" ::: "memory");
    __syncthreads();
    if (threadIdx.x == 0) {
        unsigned* bar = b.bar;
        __builtin_amdgcn_s_waitcnt(0);
        unsigned nloc = b.st[0], nx = b.st[1];
        if (nloc == 0u) { xcd_barrier_complete(bar, b.x, nloc, nx); b.st[0] = nloc; b.st[1] = nx; }
        const unsigned old = xb_add(&bar[XB_XSUB(b.x)], 1u);
        const unsigned gen = old / nloc;
        if (old + 1u == (gen + 1u) * nloc) {
            __builtin_amdgcn_fence(__ATOMIC_RELEASE, "agent");
            asm volatile("s_waitcnt vmcnt(0)" ::: "memory");
            const unsigned og = xb_add(&bar[XB_TOP], 1u);
            const unsigned tg = og / nx;
            if (og + 1u == (tg + 1u) * nx) xb_add(&bar[XB_TOPGEN], 1u);
            else XB_SPIN(xb_ld(&bar[XB_TOPGEN]) == tg, bar);
            __builtin_amdgcn_fence(__ATOMIC_ACQUIRE, "agent");
            xb_add(&bar[XB_XGEN(b.x)], 1u);
            asm volatile("s_waitcnt vmcnt(0)" ::: "memory");
        } else {
            XB_SPIN(xb_ld(&bar[XB_XGEN(b.x)]) == gen, bar);
            __builtin_amdgcn_fence(__ATOMIC_ACQUIRE, "agent");
            asm volatile("s_waitcnt vmcnt(0)" ::: "memory");
        }
    }
    __syncthreads();
}

struct Args {
    const float* in[20]; float* out; unsigned char* ws;
    int ph_lo, ph_hi;
};

struct Frame {
    LAS unsigned char* lds; volatile LAS unsigned* MISC;
    int tid, lane, wave, vcu, G;
    unsigned char* ws;
};

__device__ __forceinline__ void p0_transpose_item(const float* W, int K, int N, bf16_t* WT, LAS float* scr, int item, int lane, const float* gk, float cs, int csn) {
    const int nblk = N / 32, kb = item / nblk, nb = item % nblk, k0 = 64 * kb, n0 = 32 * nb;
    const float colsc = (n0 < csn) ? cs : 1.f;
    float tv[32];
#pragma unroll
    for (int i = 0; i < 32; ++i) { const int kk = 2 * i + (lane >> 5); tv[i] = W[(size_t)(k0 + kk) * N + n0 + (lane & 31)]; }
#pragma unroll
    for (int i = 0; i < 32; ++i) { const int kk = 2 * i + (lane >> 5); float v = tv[i] * colsc; if (gk) v *= gk[k0 + kk]; scr[kk * 33 + (lane & 31)] = v; }
    asm volatile("s_waitcnt lgkmcnt(0)" ::: "memory");
    const int c = lane & 7;
#pragma unroll
    for (int j = 0; j < 4; ++j) { const int n = (lane >> 3) + 8 * j; const LAS float* s = scr + (8 * c) * 33 + n;
        u32x4 o; o.x = cvtpk(s[0 * 33], s[1 * 33]); o.y = cvtpk(s[2 * 33], s[3 * 33]); o.z = cvtpk(s[4 * 33], s[5 * 33]); o.w = cvtpk(s[6 * 33], s[7 * 33]);
        *(u32x4*)(WT + (size_t)(n0 + n) * K + k0 + 8 * c) = o; }
    asm volatile("s_waitcnt lgkmcnt(0)" ::: "memory");
}
__device__ __forceinline__ void p0_transpose_item_fp8(const float* W, int K, int N, unsigned char* WT, LAS float* scr, int item, int lane, float cs) {
    const int nblk = N / 32, kb = item / nblk, nb = item % nblk, k0 = 64 * kb, n0 = 32 * nb;
    float tv[32];
#pragma unroll
    for (int i = 0; i < 32; ++i) { const int kk = 2 * i + (lane >> 5); tv[i] = W[(size_t)(k0 + kk) * N + n0 + (lane & 31)]; }
#pragma unroll
    for (int i = 0; i < 32; ++i) { const int kk = 2 * i + (lane >> 5); scr[kk * 33 + (lane & 31)] = tv[i] * cs; }
    asm volatile("s_waitcnt lgkmcnt(0)" ::: "memory");
    const int c = lane & 7;
#pragma unroll
    for (int j = 0; j < 4; ++j) { const int n = (lane >> 3) + 8 * j; const LAS float* s = scr + (8 * c) * 33 + n;
        u32x2 o; o.x = pk_fp8x4(s[0 * 33], s[1 * 33], s[2 * 33], s[3 * 33]); o.y = pk_fp8x4(s[4 * 33], s[5 * 33], s[6 * 33], s[7 * 33]);
        *(u32x2*)(WT + (size_t)(n0 + n) * K + k0 + 8 * c) = o; }
    asm volatile("s_waitcnt lgkmcnt(0)" ::: "memory");
}
__device__ __forceinline__ void rms_row_to_bf16(const float* xrow, const float* g, bf16_t* orow, int lane) {
    const f32x4* xr = (const f32x4*)xrow + lane; const f32x4* gr = (const f32x4*)g + lane;
    f32x4 v[4]; float s = 0.f;
#pragma unroll
    for (int j = 0; j < 4; ++j) { v[j] = xr[64 * j]; s += (v[j].x * v[j].x + v[j].y * v[j].y) + (v[j].z * v[j].z + v[j].w * v[j].w); }
    const float rstd = rsqrtf(wave_sum(s) * (1.f / D_) + EPS);
    u32x2* o8 = (u32x2*)orow + lane;
#pragma unroll
    for (int j = 0; j < 4; ++j) { const f32x4 gg = gr[64 * j]; u32x2 w; w.x = cvtpk(v[j].x * rstd * gg.x, v[j].y * rstd * gg.y); w.y = cvtpk(v[j].z * rstd * gg.z, v[j].w * rstd * gg.w); o8[64 * j] = w; }
}
__device__ __forceinline__ void p0_prologue(Frame& F, const Args& a, int do_moe_w, int do_rest) {
    LAS float* scr = (LAS float*)(F.lds + F.wave * 16384);
    const int gw = F.vcu * NWAVES + F.wave, NGW = F.G * NWAVES;
    unsigned char* ws = F.ws;
    const float* w_in = a.in[3]; const float* g_cq = a.in[4]; const float* w_uq = a.in[5]; const float* g_ckv = a.in[6]; const float* w_ukv = a.in[7];
    const float* w_o_sb = a.in[10]; const float* w_o_mla = a.in[11]; const float* w_out = a.in[12]; const float* g_ffn = a.in[13]; const float* w_router = a.in[14];
    const float* w_up = a.in[16]; const float* w_down = a.in[18];
    constexpr int I_IN = (D_ / 64) * (INW / 32), I_UQ = (384 / 64) * (768 / 32), I_UKV = (256 / 64) * (1024 / 32), I_O = (512 / 64) * (1024 / 32), I_OUT = (1024 / 64) * (1024 / 32);
    constexpr int I_UP1 = (1024 / 64) * (2048 / 32), I_DN1 = (1024 / 64) * (1024 / 32);
    if (do_rest) {
        constexpr int NI = I_IN + I_UQ + I_UKV + 2 * I_O + I_OUT;
        for (int it = gw; it < NI; it += NGW) {
            int r = it;
            if (r < I_IN) { p0_transpose_item(w_in, D_, INW, (bf16_t*)(ws + WS_WIN), scr, r, F.lane, nullptr, SB_QSCALE, 512); continue; } r -= I_IN;
            if (r < I_UQ) { p0_transpose_item(w_uq, 384, 768, (bf16_t*)(ws + WS_WUQ), scr, r, F.lane, g_cq, 1.f, 0); continue; } r -= I_UQ;
            if (r < I_UKV) { p0_transpose_item(w_ukv, 256, 1024, (bf16_t*)(ws + WS_WUKV), scr, r, F.lane, g_ckv, 1.f, 0); continue; } r -= I_UKV;
            if (r < I_O) { p0_transpose_item(w_o_sb, 512, 1024, (bf16_t*)(ws + WS_WOSB), scr, r, F.lane, nullptr, 1.f, 0); continue; } r -= I_O;
            if (r < I_O) { p0_transpose_item(w_o_mla, 512, 1024, (bf16_t*)(ws + WS_WOMLA), scr, r, F.lane, nullptr, 1.f, 0); continue; } r -= I_O;
            p0_transpose_item(w_out, 1024, 1024, (bf16_t*)(ws + WS_WOUT), scr, r, F.lane, nullptr, 1.f, 0);
        }
        { const int gt = gw * 64 + F.lane, NGT = NGW * 64;
          u32x4 z = {0u, 0u, 0u, 0u};
          u32x4* pz = (u32x4*)((bf16_t*)(ws + WS_WIN) + (size_t)INW * D_);
          for (int i = gt; i < (INWP - INW) * D_ * 2 / 16; i += NGT) pz[i] = z;
          u32x4* hz = (u32x4*)((unsigned char*)(ws + WS_H2F8) + (size_t)M_ * D_);
          for (int i = gt; i < D_ / 16; i += NGT) hz[i] = z;
          const int* pos = (const int*)a.in[1]; float* rt = (float*)(ws + WS_ROPE);
          for (int i = gt; i < M_ * 16; i += NGT) { const int row = i >> 4, k = i & 15; const float inv = powf(10000.f, -(float)k / 16.f); const float ang = (float)pos[row] * inv; rt[row * 32 + k] = cosf(ang); rt[row * 32 + 16 + k] = sinf(ang); }
          float* wr = (float*)(ws + WS_WR);
          for (int i = gt; i < D_ * NE; i += NGT) wr[i] = w_router[i] * g_ffn[i >> 5];
        }
        for (int m = gw; m < M_; m += NGW) rms_row_to_bf16(a.in[0] + (size_t)m * D_, a.in[2], (bf16_t*)(ws + WS_HB) + (size_t)m * D_, F.lane);
    }
    if (do_moe_w) {
        constexpr int NI = NE * (I_UP1 + I_DN1);
        for (int it = gw; it < NI; it += NGW) {
            int r = it;
            if (r < NE * I_UP1) { const int e = r / I_UP1; p0_transpose_item_fp8(w_up + (size_t)e * D_ * 2 * DFF, D_, 2 * DFF, (unsigned char*)(ws + WS_WUP) + (size_t)e * 2 * DFF * D_, scr, r % I_UP1, F.lane, W8_SCALE); continue; }
            r -= NE * I_UP1;
            { const int e = r / I_DN1; p0_transpose_item_fp8(w_down + (size_t)e * DFF * D_, DFF, D_, (unsigned char*)(ws + WS_WDN) + (size_t)e * D_ * DFF, scr, r % I_DN1, F.lane, W8_SCALE); }
        }
    }
}

__device__ __forceinline__ void ld16bf(const bf16_t* p, float (&v)[16]) {
    const u32x4 a = *(const u32x4*)p, b = *(const u32x4*)(p + 8);
    v[0] = bflo(a.x); v[1] = bfhi(a.x); v[2] = bflo(a.y); v[3] = bfhi(a.y); v[4] = bflo(a.z); v[5] = bfhi(a.z); v[6] = bflo(a.w); v[7] = bfhi(a.w);
    v[8] = bflo(b.x); v[9] = bfhi(b.x); v[10] = bflo(b.y); v[11] = bfhi(b.y); v[12] = bflo(b.z); v[13] = bfhi(b.z); v[14] = bflo(b.w); v[15] = bfhi(b.w);
}
__device__ __forceinline__ void st16bf(bf16_t* p, const float (&v)[16]) {
    u32x4 a, b; a.x = cvtpk(v[0], v[1]); a.y = cvtpk(v[2], v[3]); a.z = cvtpk(v[4], v[5]); a.w = cvtpk(v[6], v[7]);
    b.x = cvtpk(v[8], v[9]); b.y = cvtpk(v[10], v[11]); b.z = cvtpk(v[12], v[13]); b.w = cvtpk(v[14], v[15]);
    *(u32x4*)p = a; *(u32x4*)(p + 8) = b;
}
struct PrepIn { unsigned cq0, cq1, cq2; u32x2 ckv; u32x4 qa, qb, ka, kb, vv; float rope; };
__device__ __forceinline__ void p4_load(PrepIn& in, int row, const bf16_t* proj, const bf16_t* qraw, const bf16_t* kvraw, const float* rope, int lane) {
    const int h = lane >> 3, s = lane & 7;
    const bf16_t* pr = proj + (size_t)row * INWP;
    { const bf16_t* p = pr + C_CQ + lane * 6; in.cq0 = *(const unsigned*)p; in.cq1 = *(const unsigned*)(p + 2); in.cq2 = *(const unsigned*)(p + 4); }
    in.ckv = *(const u32x2*)(pr + C_CKV + lane * 4);
    in.rope = rope[(size_t)row * 32 + (lane & 31)];
    const u32x4 z = {0u, 0u, 0u, 0u};
    in.qa = z; in.qb = z; in.ka = z; in.kb = z;
    if (s < 6) { const bf16_t* q = qraw + (size_t)row * 768 + h * 96 + s * 16; in.qa = *(const u32x4*)q; in.qb = *(const u32x4*)(q + 8);
        const bf16_t* k = (s < 4) ? (kvraw + (size_t)row * 1024 + h * 128 + s * 16) : (pr + C_KR + (s - 4) * 16); in.ka = *(const u32x4*)k; in.kb = *(const u32x4*)(k + 8); }
    in.vv = *(const u32x4*)(kvraw + (size_t)row * 1024 + (lane >> 3) * 128 + 64 + (lane & 7) * 8);
}
__device__ __forceinline__ void unpack16(const u32x4 a, const u32x4 b, float (&v)[16]) {
    v[0] = bflo(a.x); v[1] = bfhi(a.x); v[2] = bflo(a.y); v[3] = bfhi(a.y); v[4] = bflo(a.z); v[5] = bfhi(a.z); v[6] = bflo(a.w); v[7] = bfhi(a.w);
    v[8] = bflo(b.x); v[9] = bfhi(b.x); v[10] = bflo(b.y); v[11] = bfhi(b.y); v[12] = bflo(b.z); v[13] = bfhi(b.z); v[14] = bflo(b.w); v[15] = bfhi(b.w);
}
__device__ __forceinline__ void p4_prep(Frame& F, const Args& a) {
    unsigned char* ws = F.ws;
    const bf16_t* proj = (const bf16_t*)(ws + WS_PROJ); const bf16_t* qraw = (const bf16_t*)(ws + WS_QRAW); const bf16_t* kvraw = (const bf16_t*)(ws + WS_KVRAW);
    bf16_t* QB = (bf16_t*)(ws + WS_QB); bf16_t* KB = (bf16_t*)(ws + WS_KB); bf16_t* VB = (bf16_t*)(ws + WS_VB);
    const float* rope = (const float*)(ws + WS_ROPE); const float* gq = a.in[8]; const float* gk = a.in[9];
    const int gw = F.vcu * NWAVES + F.wave, NGW = F.G * NWAVES, lane = F.lane, h = lane >> 3, s = lane & 7;
    float gqv[16], gkv[16];
#pragma unroll
    for (int j = 0; j < 16; ++j) { gqv[j] = (s < 6) ? gq[s * 16 + j] : 0.f; gkv[j] = (s < 6) ? gk[s * 16 + j] : 0.f; }
    PrepIn cur, nxt;
    if (gw < M_) p4_load(cur, gw, proj, qraw, kvraw, rope, lane);
    for (int row = gw; row < M_; row += NGW) {
        const bool hn = row + NGW < M_;
        if (hn) p4_load(nxt, row + NGW, proj, qraw, kvraw, rope, lane);
        float sq = bflo(cur.cq0) * bflo(cur.cq0) + bfhi(cur.cq0) * bfhi(cur.cq0) + bflo(cur.cq1) * bflo(cur.cq1) + bfhi(cur.cq1) * bfhi(cur.cq1) + bflo(cur.cq2) * bflo(cur.cq2) + bfhi(cur.cq2) * bfhi(cur.cq2);
        float skv = bflo(cur.ckv.x) * bflo(cur.ckv.x) + bfhi(cur.ckv.x) * bfhi(cur.ckv.x) + bflo(cur.ckv.y) * bflo(cur.ckv.y) + bfhi(cur.ckv.y) * bfhi(cur.ckv.y);
        sq = wave_sum(sq); skv = wave_sum(skv);
        const float var_cq = sq * (1.f / 384.f) + EPS;
        const float rstd_ckv = rsqrtf(skv * (1.f / 256.f) + EPS);
        float cs[16], sn[16];
#pragma unroll
        for (int j = 0; j < 16; ++j) { cs[j] = __int_as_float(__builtin_amdgcn_readlane(__float_as_int(cur.rope), j)); sn[j] = __int_as_float(__builtin_amdgcn_readlane(__float_as_int(cur.rope), 16 + j)); }
        {
            float v[16]; unpack16(cur.qa, cur.qb, v);
            float ss = 0.f;
#pragma unroll
            for (int j = 0; j < 16; ++j) ss += v[j] * v[j];
            ss = sum8(ss);
            const float r = rsqrtf(ss * (1.f / 96.f) + EPS * var_cq);
#pragma unroll
            for (int j = 0; j < 16; ++j) v[j] = v[j] * r * gqv[j];
            float o[16];
#pragma unroll
            for (int j = 0; j < 16; ++j) { const float pv = DPP_F(v[j], DPP_X1);
                o[j] = (s == 4) ? (v[j] * cs[j] - pv * sn[j]) : (s == 5) ? (v[j] * cs[j] + pv * sn[j]) : v[j]; o[j] *= MLA_QSCALE; }
            if (s < 6) st16bf(QB + (size_t)row * 768 + h * 96 + s * 16, o);
        }
        {
            float v[16]; unpack16(cur.ka, cur.kb, v);
            if (s < 4) {
#pragma unroll
                for (int j = 0; j < 16; ++j) v[j] *= rstd_ckv; }
            float ss = 0.f;
#pragma unroll
            for (int j = 0; j < 16; ++j) ss += v[j] * v[j];
            ss = sum8(ss);
            const float r = rsqrtf(ss * (1.f / 96.f) + EPS);
#pragma unroll
            for (int j = 0; j < 16; ++j) v[j] = v[j] * r * gkv[j];
            float o[16];
#pragma unroll
            for (int j = 0; j < 16; ++j) { const float pv = DPP_F(v[j], DPP_X1);
                o[j] = (s == 4) ? (v[j] * cs[j] - pv * sn[j]) : (s == 5) ? (v[j] * cs[j] + pv * sn[j]) : v[j]; }
            if (s < 6) st16bf(KB + (size_t)row * 768 + h * 96 + s * 16, o);
            const u32x4 vw = cur.vv;
            u32x4 ow; ow.x = cvtpk(bflo(vw.x) * rstd_ckv, bfhi(vw.x) * rstd_ckv); ow.y = cvtpk(bflo(vw.y) * rstd_ckv, bfhi(vw.y) * rstd_ckv);
            ow.z = cvtpk(bflo(vw.z) * rstd_ckv, bfhi(vw.z) * rstd_ckv); ow.w = cvtpk(bflo(vw.w) * rstd_ckv, bfhi(vw.w) * rstd_ckv);
            *(u32x4*)(VB + (size_t)row * 512 + lane * 8) = ow;
        }
        if (hn) cur = nxt;
    }
}
namespace att {
constexpr int BUFB = 20480;
constexpr int WREG = 8448;
constexpr int OST_OFF = 2 * BUFB;
constexpr int WSF_OFF = OST_OFF + 8 * WREG;
constexpr int FLG_OFF = WSF_OFF + 8 * 256;
__device__ __forceinline__ int crow(int r, int hi) { return (r & 3) + 8 * (r >> 2) + 4 * hi; }
__device__ __forceinline__ s16x4 vtr(const LAS char* p) { typedef short v4i16_t __attribute__((ext_vector_type(4))); return __builtin_bit_cast(s16x4, __builtin_amdgcn_ds_read_tr16_b64_v4i16((LAS v4i16_t*)p)); }
#define ATT_MFMA(a, b, c) __builtin_amdgcn_mfma_f32_32x32x16_bf16((a), (b), (c), 0, 0, 0)

template <int NCH> struct Stage {
    u32x4 k0, k1, v0;
    __device__ __forceinline__ void load(const bf16_t* Kb, int pitchK, const bf16_t* Vb, int pitchV, int key0, int wid, int lane) {
        k0 = *(const u32x4*)(Kb + (size_t)(key0 + lane) * pitchK + wid * 8);
        if (NCH > 8) { if (wid < NCH - 8) k1 = *(const u32x4*)(Kb + (size_t)(key0 + lane) * pitchK + (8 + wid) * 8); }
        v0 = *(const u32x4*)(Vb + (size_t)(key0 + 16 * (wid & 3) + (lane >> 2)) * pitchV + (wid >> 2) * 32 + (lane & 3) * 8);
    }
    __device__ __forceinline__ void write(LAS unsigned char* buf, int wid, int lane) const {
        *(LAS u32x4*)(buf + wid * 1024 + lane * 16) = k0;
        if (NCH > 8) { if (wid < NCH - 8) *(LAS u32x4*)(buf + (8 + wid) * 1024 + lane * 16) = k1; }
        *(LAS u32x4*)(buf + NCH * 1024 + wid * 1024 + lane * 16) = v0;
    }
};

__device__ __forceinline__ void pv_tile(f32x16 (&o)[2], const LAS char* vp, const bf16x8 (&pa)[4]) {
    __builtin_amdgcn_s_setprio(1);
#pragma unroll
    for (int d0 = 0; d0 < 2; ++d0)
#pragma unroll
        for (int ks = 0; ks < 4; ++ks) {
            const s16x4 lo = vtr(vp + d0 * 4096 + ks * 1024), hi = vtr(vp + d0 * 4096 + ks * 1024 + 512);
            const bf16x8 vf = __builtin_shufflevector(lo, hi, 0, 1, 2, 3, 4, 5, 6, 7);
            o[d0] = ATT_MFMA(pa[ks], vf, o[d0]);
        }
    __builtin_amdgcn_s_setprio(0);
}
__device__ __forceinline__ bf16x8 pack8(const f32x16& p, int base) {
    u32x4 w; w.x = cvtpk(p[base], p[base + 1]); w.y = cvtpk(p[base + 2], p[base + 3]); w.z = cvtpk(p[base + 4], p[base + 5]); w.w = cvtpk(p[base + 6], p[base + 7]);
    return __builtin_bit_cast(bf16x8, w);
}
__device__ __forceinline__ void store_o(const f32x16 (&o)[2], const float (&rs)[16], LAS unsigned char* lds, int wid, int lane, bf16_t* Ow) {
    const int r32 = lane & 31, hi = lane >> 5;
    LAS bf16_t* stg = (LAS bf16_t*)(lds + OST_OFF + wid * WREG);
#pragma unroll
    for (int r = 0; r < 16; ++r) { const int orow = crow(r, hi);
#pragma unroll
        for (int d0 = 0; d0 < 2; ++d0) { const unsigned w = cvtpk(o[d0][r] * rs[r], 0.f); stg[orow * 64 + d0 * 32 + r32] = (bf16_t)(w & 0xffffu); } }
    asm volatile("s_waitcnt lgkmcnt(0)" ::: "memory");
#pragma unroll
    for (int i = 0; i < 4; ++i) { const int row = i * 8 + (lane >> 3), ch = lane & 7; const u32x4 v = *(const LAS u32x4*)(stg + row * 64 + ch * 8); *(u32x4*)(Ow + (size_t)row * 512 + ch * 8) = v; }
    asm volatile("s_waitcnt lgkmcnt(0)" ::: "memory");
}


constexpr int MLA_CONV_PERIOD = 4;
struct Conv {
    const float* w_up; const float* w_down; unsigned char* up8; unsigned char* dn8; int item, step, ctr; bool inflight; f32x4 tv[8];
    static constexpr int I_UP1 = (D_ / 64) * (2 * DFF / 32), I_DN1 = (DFF / 64) * (D_ / 32), NI = NE * (I_UP1 + I_DN1);
    const float* src; unsigned char* dst; int K, N;
    __device__ __forceinline__ bool pending() const { return item < NI; }
    __device__ __forceinline__ void load(int lane) { load_to(tv, lane); }
    __device__ __forceinline__ void load_to(f32x4 (&t)[8], int lane) {
        int r = item;
        if (r < NE * I_UP1) { const int e = r / I_UP1; r %= I_UP1; K = D_; N = 2 * DFF; const int nblk = N / 32, kb = r / nblk, nb = r % nblk; src = w_up + (size_t)e * D_ * 2 * DFF + (size_t)(64 * kb) * N + 32 * nb; dst = up8 + (size_t)e * 2 * DFF * D_ + (size_t)(32 * nb) * K + 64 * kb; }
        else { r -= NE * I_UP1; const int e = r / I_DN1; r %= I_DN1; K = DFF; N = D_; const int nblk = N / 32, kb = r / nblk, nb = r % nblk; src = w_down + (size_t)e * DFF * D_ + (size_t)(64 * kb) * N + 32 * nb; dst = dn8 + (size_t)e * D_ * DFF + (size_t)(32 * nb) * K + 64 * kb; }
        const float* p = src + (size_t)(8 * (lane >> 3)) * N + 4 * (lane & 7);
#pragma unroll
        for (int j = 0; j < 8; ++j) t[j] = *(const f32x4*)(p + (size_t)j * N);
    }
    __device__ __forceinline__ void finish(LAS float* scr, int lane) { finish_from(tv, scr, lane); }
    __device__ __forceinline__ void finish_from(const f32x4 (&t)[8], LAS float*, int lane) {
        unsigned char* q = dst + (size_t)(4 * (lane & 7)) * K + 8 * (lane >> 3);
#pragma unroll
        for (int c4 = 0; c4 < 4; ++c4) {
            u32x2 o; o.x = pk_fp8x4(t[0][c4] * W8_SCALE, t[1][c4] * W8_SCALE, t[2][c4] * W8_SCALE, t[3][c4] * W8_SCALE); o.y = pk_fp8x4(t[4][c4] * W8_SCALE, t[5][c4] * W8_SCALE, t[6][c4] * W8_SCALE, t[7][c4] * W8_SCALE);
            *(u32x2*)(q + (size_t)c4 * K) = o; }
        item += step;
    }
    __device__ __forceinline__ void tick_begin(int lane) { if (!inflight && ctr == 0 && pending()) { load(lane); inflight = true; } }
    __device__ __forceinline__ void tick_end(LAS float* scr, int lane) { if (inflight && ctr == 2) { finish(scr, lane); inflight = false; } ctr = (ctr == MLA_CONV_PERIOD - 1) ? 0 : ctr + 1; }
    __device__ __forceinline__ void flush(LAS float* scr, int lane) { if (inflight) { finish(scr, lane); inflight = false; } ctr = 0; }
    __device__ __forceinline__ void drain(LAS float* scr, int lane) { while (pending()) { f32x4 t2[8]; load_to(t2, lane); finish_from(t2, scr, lane); } }
};
__device__ __forceinline__ void mla_unit(LAS unsigned char* lds, int b, int h, int qb, const bf16_t* QB, const bf16_t* KB, const bf16_t* VB, bf16_t* O, float m0, Conv& cv) {
    const int tid = threadIdx.x, lane = tid & 63, r32 = lane & 31, hi = lane >> 5; const int wid = __builtin_amdgcn_readfirstlane(tid >> 6);
    const size_t rb = (size_t)b * S_; const int q0 = qb * 256;
    const bf16_t* Kh = KB + rb * 768 + h * 96; const bf16_t* Vh = VB + rb * 512 + h * 64;
    bf16x8 qr[6];
    { const bf16_t* qp = QB + (rb + q0 + wid * 32 + r32) * 768 + h * 96 + hi * 8;
#pragma unroll
      for (int d0 = 0; d0 < 6; ++d0) qr[d0] = *(const bf16x8*)(qp + d0 * 16); }
    const int NT = 4 * qb + 4, my_last = 4 * qb + (wid >> 1);
    f32x16 o[2]; float l = 0.f;
#pragma unroll
    for (int r = 0; r < 16; ++r) { o[0][r] = 0.f; o[1][r] = 0.f; }
    f32x16 negm;
#pragma unroll
    for (int r = 0; r < 16; ++r) negm[r] = -m0;
    asm volatile("" : "+v"(negm));
    Stage<12> st;
    st.load(Kh, 768, Vh, 512, 0, wid, lane); st.write(lds, wid, lane);
    __syncthreads();
    LAS float* cscr = (LAS float*)(lds + OST_OFF + wid * WREG);
    for (int t = 0; t < NT; ++t) {
        if (t + 1 < NT) st.load(Kh, 768, Vh, 512, (t + 1) * 64, wid, lane);
        asm volatile("" ::: "memory");
        cv.tick_begin(lane);
        if (t <= my_last) {
            const LAS char* buf = (const LAS char*)(lds + (t & 1) * BUFB);
            const LAS char* kp = buf + hi * 1024 + r32 * 16;
            f32x16 p0, p1;
            __builtin_amdgcn_s_setprio(1);
#pragma unroll
            for (int d0 = 0; d0 < 6; ++d0) { const bf16x8 a0 = *(const LAS bf16x8*)(kp + d0 * 2048), a1 = *(const LAS bf16x8*)(kp + d0 * 2048 + 512);
                if (d0 == 0) { p0 = ATT_MFMA(a0, qr[0], negm); p1 = ATT_MFMA(a1, qr[0], negm); }
                else { p0 = ATT_MFMA(a0, qr[d0], p0); p1 = ATT_MFMA(a1, qr[d0], p1); } }
            __builtin_amdgcn_s_setprio(0);
            float ls = 0.f;
#pragma unroll
            for (int r = 0; r < 16; ++r) { p0[r] = __builtin_amdgcn_exp2f(p0[r]); p1[r] = __builtin_amdgcn_exp2f(p1[r]); ls += p0[r] + p1[r]; }
            l += ls;
            bf16x8 pa[4]; pa[0] = pack8(p0, 0); pa[1] = pack8(p0, 8); pa[2] = pack8(p1, 0); pa[3] = pack8(p1, 8);
            const LAS char* vp = buf + 12 * 1024 + ((lane >> 4) & 1) * 32 + (lane & 3) * 8 + (4 * hi + ((lane & 15) >> 2)) * 64;
            pv_tile(o, vp, pa);
        }
        if (t + 1 < NT) st.write(lds + ((t + 1) & 1) * BUFB, wid, lane);
        cv.tick_end(cscr, lane);
        __syncthreads();
    }
    l += __shfl_xor(l, 32);
    LAS float* wsf = (LAS float*)(lds + WSF_OFF) + wid * 64;
    if (hi == 0) wsf[r32] = l;
    asm volatile("s_waitcnt lgkmcnt(0)" ::: "memory");
    float rs[16];
#pragma unroll
    for (int r = 0; r < 16; ++r) rs[r] = __builtin_amdgcn_rcpf(wsf[crow(r, hi)]);
    store_o(o, rs, lds, wid, lane, O + (rb + q0 + wid * 32) * 512 + h * 64);
}

constexpr float SB_THR = -152.f;
__device__ __forceinline__ void sb_unit(LAS unsigned char* lds, int b, int h, int qb, const bf16_t* proj, bf16_t* O, Conv& cv) {
    const int tid = threadIdx.x, lane = tid & 63, r32 = lane & 31, hi = lane >> 5; const int wid = __builtin_amdgcn_readfirstlane(tid >> 6);
    const size_t rb = (size_t)b * S_; const int q0 = qb * 256;
    const bf16_t* Kh = proj + rb * INWP + C_SBK + h * 64; const bf16_t* Vh = proj + rb * INWP + C_SBV + h * 64;
    bf16x8 qr[4];
    { const bf16_t* qp = proj + (rb + q0 + wid * 32 + r32) * INWP + C_SBQ + h * 64 + hi * 8;
#pragma unroll
      for (int d0 = 0; d0 < 4; ++d0) qr[d0] = *(const bf16x8*)(qp + d0 * 16); }
    const int Ttop = 4 * qb + 3, qw0 = q0 + wid * 32, qabs = qw0 + r32;
    f32x16 o[2]; float carry = 0.f;
#pragma unroll
    for (int r = 0; r < 16; ++r) { o[0][r] = 0.f; o[1][r] = 0.f; }
    volatile LAS int* flg = (volatile LAS int*)(lds + FLG_OFF);
    Stage<8> st;
    st.load(Kh, INWP, Vh, INWP, Ttop * 64, wid, lane); st.write(lds, wid, lane);
    __syncthreads();
    bool alive = true;
    for (int it = 0;; ++it) {
        const int t = Ttop - it;
        if (t > 0) st.load(Kh, INWP, Vh, INWP, (t - 1) * 64, wid, lane);
        asm volatile("" ::: "memory");
        f32x4 ctv[8]; const bool cvp = cv.pending() && (((it + wid) & 1) == 0);
        if (cvp) cv.load_to(ctv, lane);
        if (alive && (64 * t <= qw0 + 30)) {
            const LAS char* buf = (const LAS char*)(lds + (it & 1) * BUFB);
            const LAS char* kp = buf + hi * 1024 + r32 * 16;
            const bool need_mask = (64 * t + 63 >= qw0);
            bf16x8 pa[4];
#pragma unroll
            for (int blk = 1; blk >= 0; --blk) {
                f32x16 p;
#pragma unroll
                for (int r = 0; r < 16; ++r) p[r] = 0.f;
#pragma unroll
                for (int d0 = 0; d0 < 4; ++d0) { const bf16x8 a0 = *(const LAS bf16x8*)(kp + d0 * 2048 + blk * 512); p = ATT_MFMA(a0, qr[d0], p); }
                const int kb0 = 64 * t + 32 * blk + 4 * hi;
                f32x16 s;
#pragma unroll
                for (int r = 0; r < 16; ++r) {
                    const int key = kb0 + (r & 3) + 8 * (r >> 2);
                    const float z = p[r]; const float e = __builtin_amdgcn_exp2f(-fabsf(z)); const float tt = __builtin_amdgcn_logf(1.f + e); float lsv = fminf(-z, 0.f) - tt;
                    if (need_mask && !(key < qabs)) { lsv = 0.f; p[r] = -INFINITY; }
                    s[r] = lsv;
                }
                float T[5]; T[4] = 0.f;
#pragma unroll
                for (int i = 3; i >= 0; --i) T[i] = T[i + 1] + ((s[4 * i] + s[4 * i + 1]) + (s[4 * i + 2] + s[4 * i + 3]));
                float Tp[5]; Tp[4] = 0.f;
#pragma unroll
                for (int i = 0; i < 4; ++i) Tp[i] = __shfl_xor(T[i], 32);
#pragma unroll
                for (int i = 3; i >= 0; --i) {
                    float lat = carry + T[i + 1] + (hi ? Tp[i + 1] : Tp[i]);
#pragma unroll
                    for (int e3 = 3; e3 >= 0; --e3) { const int r = 4 * i + e3; const float lsv = s[r]; p[r] = __builtin_amdgcn_exp2f(lsv + p[r] + lat); lat += lsv; }
                }
                carry += T[0] + Tp[0];
                pa[2 * blk] = pack8(p, 0); pa[2 * blk + 1] = pack8(p, 8);
            }
            const LAS char* vp = buf + 8 * 1024 + ((lane >> 4) & 1) * 32 + (lane & 3) * 8 + (4 * hi + ((lane & 15) >> 2)) * 64;
            pv_tile(o, vp, pa);
            alive = __any(carry > SB_THR);
        }
        if (lane == 0) flg[(it & 1) * 8 + wid] = alive ? 1 : 0;
        if (t > 0) st.write(lds + ((it + 1) & 1) * BUFB, wid, lane);
        if (cvp) cv.finish_from(ctv, (LAS float*)(lds + OST_OFF + wid * WREG), lane);
        __syncthreads();
        if (t == 0) break;
        int any = 0;
#pragma unroll
        for (int w = 0; w < 8; ++w) any |= flg[(it & 1) * 8 + w];
        if (!any) break;
    }
    float rs[16];
#pragma unroll
    for (int r = 0; r < 16; ++r) rs[r] = 1.f;
    store_o(o, rs, lds, wid, lane, O + (rb + q0 + wid * 32) * 512 + h * 64);
}
}

__device__ __forceinline__ void p5_attention(Frame& F, const Args& a) {
    unsigned char* ws = F.ws;
    volatile LAS int* citem = (volatile LAS int*)(F.MISC + MI_CITEM) + F.wave;
    {
        float gm;
        { const float* gq = a.in[8]; const float* gk = a.in[9]; float mq = 0.f, mk = 0.f;
          for (int i = F.lane; i < 96; i += 64) { mq = fmaxf(mq, fabsf(gq[i])); mk = fmaxf(mk, fabsf(gk[i])); }
#pragma unroll
          for (int o = 1; o < 64; o <<= 1) { mq = fmaxf(mq, __shfl_xor(mq, o)); mk = fmaxf(mk, __shfl_xor(mk, o)); }
          gm = 9.79795897f * LOG2E * mq * mk; }
        att::Conv cv; cv.w_up = a.in[16]; cv.w_down = a.in[18]; cv.up8 = (unsigned char*)(ws + WS_WUP); cv.dn8 = (unsigned char*)(ws + WS_WDN);
        cv.item = F.vcu * NWAVES + F.wave; cv.step = F.G * NWAVES; cv.ctr = F.wave % att::MLA_CONV_PERIOD; cv.inflight = false;
        for (int v = F.vcu; v < 256; v += F.G) {
            const int bh = v >> 3, s = v & 7, b = bh >> 3, h = bh & 7;
            for (int i = 0; i < 2; ++i) { const int qb = i ? 15 - s : s;
                att::mla_unit(F.lds, b, h, qb, (const bf16_t*)(ws + WS_QB), (const bf16_t*)(ws + WS_KB), (const bf16_t*)(ws + WS_VB), (bf16_t*)(ws + WS_OMLA), gm, cv);
                __syncthreads(); }
        }
        cv.flush((LAS float*)(F.lds + att::OST_OFF + F.wave * att::WREG), F.lane);
        if (F.lane == 0) *citem = cv.item;
    }
    __syncthreads();
    {
        att::Conv cv; cv.w_up = a.in[16]; cv.w_down = a.in[18]; cv.up8 = (unsigned char*)(ws + WS_WUP); cv.dn8 = (unsigned char*)(ws + WS_WDN);
        cv.item = __builtin_amdgcn_readfirstlane(*citem); cv.step = F.G * NWAVES; cv.ctr = 0; cv.inflight = false;
        for (int v = F.vcu; v < 256; v += F.G) {
            const int bh = v >> 3, s = v & 7, b = bh >> 3, h = bh & 7;
            for (int i = 0; i < 2; ++i) { const int qb = i ? 15 - s : s;
                att::sb_unit(F.lds, b, h, qb, (const bf16_t*)(ws + WS_PROJ), (bf16_t*)(ws + WS_OSB), cv);
                __syncthreads(); }
        }
        cv.drain((LAS float*)(F.lds + att::OST_OFF + F.wave * att::WREG), F.lane);
    }
}

__device__ __forceinline__ void p8_router(Frame& F, const Args& a) {
    unsigned char* ws = F.ws;
    const float* x1 = a.out; const float* wr = (const float*)(ws + WS_WR); const float* br = a.in[15]; const float* g = a.in[13];
    unsigned char* H2 = (unsigned char*)(ws + WS_H2F8); int* list = (int*)(ws + WS_LIST); float* topw = (float*)(ws + WS_TOPW); int* selo = (int*)(ws + WS_SEL);
    int* cnt = (int*)(ws + WS_CTL) + CW_CNT;
    volatile LAS int* lcnt = (volatile LAS int*)(F.MISC + MI_LCNT); volatile LAS int* lbase = (volatile LAS int*)(F.MISC + MI_BASE);
    const int lane = F.lane, wave = F.wave, tid = F.tid;
    constexpr int WST = 1028;
    LAS float* wt = (LAS float*)F.lds;
    if (F.vcu < M_ / 64) {
        for (int i = tid; i < D_ * NE / 4; i += NTHR) { const f32x4 v = *(const f32x4*)(wr + (size_t)i * 4); const int k = i >> 3, e = (i & 7) * 4;
            wt[(e + 0) * WST + k] = v.x; wt[(e + 1) * WST + k] = v.y; wt[(e + 2) * WST + k] = v.z; wt[(e + 3) * WST + k] = v.w; }
    }
    __syncthreads();
    for (int task = F.vcu; task < M_ / 64; task += F.G) {
        const int T0 = task * 64;
        if (tid < 32) lcnt[tid] = 0;
        __syncthreads();
        int my_e = 0, my_rank = 0; float my_w = 0.f;
        if (wave < 4) {
            const int tk = lane & 15, kp = lane >> 4, tok = T0 + wave * 16 + tk;
            const float* xp = x1 + (size_t)tok * D_ + kp * 256;
            const LAS float* w0 = wt + tk * WST + kp * 256; const LAS float* w1 = w0 + 16 * WST;
            f32x4 acc0 = {0.f, 0.f, 0.f, 0.f}, acc1 = {0.f, 0.f, 0.f, 0.f}; float ssq = 0.f;
#pragma unroll 4
            for (int i = 0; i < 256; i += 4) {
                const f32x4 a4 = *(const f32x4*)(xp + i); const f32x4 b0 = *(const LAS f32x4*)(w0 + i), b1 = *(const LAS f32x4*)(w1 + i);
                ssq += (a4.x * a4.x + a4.y * a4.y) + (a4.z * a4.z + a4.w * a4.w);
#pragma unroll
                for (int j = 0; j < 4; ++j) { acc0 = __builtin_amdgcn_mfma_f32_16x16x4f32(a4[j], b0[j], acc0, 0, 0, 0); acc1 = __builtin_amdgcn_mfma_f32_16x16x4f32(a4[j], b1[j], acc1, 0, 0, 0); }
            }
            ssq += __shfl_xor(ssq, 16); ssq += __shfl_xor(ssq, 32);
            const float rstd = rsqrtf(ssq * (1.f / D_) + EPS);
            const int e0 = lane & 15, grp = lane >> 4;
            const float bia0 = br[e0], bia1 = br[e0 + 16];
#pragma unroll
            for (int j = 0; j < 4; ++j) {
                const float rs = __shfl(rstd, 4 * grp + j);
                float c0 = acc0[j] * rs + bia0, c1 = acc1[j] * rs + bia1;
                float sv[4]; int si[4];
#pragma unroll
                for (int k = 0; k < 4; ++k) {
                    float best = c0; int bi = e0;
                    if (c1 > best) { best = c1; bi = e0 + 16; }
#pragma unroll
                    for (int st_ = 0; st_ < 4; ++st_) { const int ctl = st_ == 0 ? DPP_X1 : st_ == 1 ? DPP_X2 : st_ == 2 ? DPP_HM : DPP_RM;
                        float ob; int oi;
                        if (st_ == 0) { ob = DPP_F(best, DPP_X1); oi = DPP_I(bi, DPP_X1); } else if (st_ == 1) { ob = DPP_F(best, DPP_X2); oi = DPP_I(bi, DPP_X2); } else if (st_ == 2) { ob = DPP_F(best, DPP_HM); oi = DPP_I(bi, DPP_HM); } else { ob = DPP_F(best, DPP_RM); oi = DPP_I(bi, DPP_RM); }
                        (void)ctl; if (ob > best || (ob == best && oi < bi)) { best = ob; bi = oi; } }
                    sv[k] = best; si[k] = bi;
                    if (bi == e0) c0 = -INFINITY; if (bi == e0 + 16) c1 = -INFINITY;
                }
                float ex[4], sum = 0.f;
#pragma unroll
                for (int k = 0; k < 4; ++k) { ex[k] = __expf(sv[k] - sv[0]); sum += ex[k]; }
                const float inv = 1.f / sum;
                if (((lane >> 2) & 3) == j) {
#pragma unroll
                    for (int k = 0; k < 4; ++k) if ((lane & 3) == k) { my_e = si[k]; my_w = ex[k] * inv; }
                }
            }
            my_rank = atomicAdd((int*)&lcnt[my_e], 1);
        } else {
            const f32x4* gr = (const f32x4*)g + lane;
            f32x4 gg[4];
#pragma unroll
            for (int j = 0; j < 4; ++j) gg[j] = gr[64 * j] * X8_SCALE;
            for (int rr = 0; rr < 16; rr += 2) {
                const int t0 = T0 + (wave - 4) * 16 + rr;
                const f32x4* xr0 = (const f32x4*)(x1 + (size_t)t0 * D_) + lane; const f32x4* xr1 = xr0 + D_ / 4;
                f32x4 v0[4], v1[4]; float s0 = 0.f, s1 = 0.f;
#pragma unroll
                for (int j = 0; j < 4; ++j) { v0[j] = xr0[64 * j]; v1[j] = xr1[64 * j]; }
#pragma unroll
                for (int j = 0; j < 4; ++j) { s0 += (v0[j].x * v0[j].x + v0[j].y * v0[j].y) + (v0[j].z * v0[j].z + v0[j].w * v0[j].w); s1 += (v1[j].x * v1[j].x + v1[j].y * v1[j].y) + (v1[j].z * v1[j].z + v1[j].w * v1[j].w); }
                const float r0 = rsqrtf(wave_sum(s0) * (1.f / D_) + EPS), r1 = rsqrtf(wave_sum(s1) * (1.f / D_) + EPS);
                unsigned* o0 = (unsigned*)(H2 + (size_t)t0 * D_) + lane; unsigned* o1 = o0 + D_ / 4;
#pragma unroll
                for (int j = 0; j < 4; ++j) { o0[64 * j] = pk_fp8x4(v0[j].x * r0 * gg[j].x, v0[j].y * r0 * gg[j].y, v0[j].z * r0 * gg[j].z, v0[j].w * r0 * gg[j].w);
                    o1[64 * j] = pk_fp8x4(v1[j].x * r1 * gg[j].x, v1[j].y * r1 * gg[j].y, v1[j].z * r1 * gg[j].z, v1[j].w * r1 * gg[j].w); }
            }
        }
        __syncthreads();
        if (tid < 32) lbase[tid] = lcnt[tid] ? atomicAdd(&cnt[tid], lcnt[tid]) : 0;
        __syncthreads();
        if (wave < 4) {
            const int grp = lane >> 4, jj = (lane >> 2) & 3, kk = lane & 3;
            const int tok = T0 + wave * 16 + 4 * grp + jj, slot = tok * 4 + kk;
            list[(size_t)my_e * M_ + lbase[my_e] + my_rank] = slot;
            topw[slot] = my_w; selo[slot] = my_e;
        }
        __syncthreads();
    }
}

struct MoeOrder {
    const bf16_t* A; const bf16_t* Bt; const int* list; volatile LAS unsigned* tab;
    int lda, ldb, nN, nwg, G, c, gather; size_t estride;
    __device__ void init(const bf16_t* A_, int lda_, const bf16_t* Bt_, int ldb_, size_t estride_, int nN_, const int* list_, volatile LAS unsigned* tab_, int gather_, int G_, int c_) {
        A = A_; lda = lda_; Bt = Bt_; ldb = ldb_; estride = estride_; nN = nN_; list = list_; tab = tab_; gather = gather_; G = G_; c = c_; nwg = (int)tab[MI_TPFX + NE] * nN_; }
    __device__ __forceinline__ bool next(int i, pg8::Unit& u) const {
        const long L = (long)i * G + c; if (L >= nwg) return false;
        int wgid = (int)L; { const int q = nwg / 8, r = nwg % 8, xcd = wgid % 8, off = wgid / 8; wgid = (xcd < r ? xcd * (q + 1) : r * (q + 1) + (xcd - r) * q) + off; }
        int e = 0;
        for (int k = 1; k < NE; ++k) if ((int)tab[MI_TPFX + k] * nN <= wgid) e = k;
        const int t0 = (int)tab[MI_TPFX + e], nt = (int)tab[MI_TPFX + e + 1] - t0, idx = wgid - t0 * nN;
        u.e = e; u.pn = idx / nt; u.rt = idx % nt; u.pm = t0 + u.rt; const int left = (int)tab[MI_CNT + e] - u.rt * 256; u.rows = left < 256 ? left : 256; return true;
    }
    __device__ __forceinline__ unsigned a_off(const pg8::Unit& u, int r, int C) const {
        int row;
        if (gather) row = (r < u.rows) ? (list[(size_t)u.e * M_ + u.rt * 256 + r] >> 2) : M_;
        else row = u.pm * 256 + r;
        return (unsigned)((row * lda + C) * 2);
    }
    __device__ __forceinline__ const char* b_base(const pg8::Unit& u) const { return (const char*)(Bt + (size_t)u.e * estride + (size_t)u.pn * 256 * ldb); }
};
__device__ __forceinline__ void moe_table(Frame& F) {
    int* cnt = (int*)(F.ws + WS_CTL) + CW_CNT;
    if (F.tid < NE) F.MISC[MI_CNT + F.tid] = __hip_atomic_load((unsigned*)cnt + F.tid, RLX_AGENT);
    __syncthreads();
    if (F.tid == 0) { unsigned p = 0; for (int e = 0; e < NE; ++e) { F.MISC[MI_TPFX + e] = p; p += (F.MISC[MI_CNT + e] + 255u) >> 8; } F.MISC[MI_TPFX + NE] = p; }
    __syncthreads();
}

__device__ __forceinline__ void p12_combine(Frame& F, const Args& a) {
    const bf16_t* Y = (const bf16_t*)(F.ws + WS_YB); float* out = a.out;
    const int gt = (F.vcu * NWAVES + F.wave) * 64 + F.lane, NGT = F.G * NTHR;
    for (int i = gt; i < M_ * D_ / 8; i += NGT) {
        const int t = i >> 7, c = (i & 127) * 8;
        f32x4 v0 = *(const f32x4*)(out + (size_t)t * D_ + c), v1 = *(const f32x4*)(out + (size_t)t * D_ + c + 4);
#pragma unroll
        for (int k = 0; k < 4; ++k) { const u32x4 w = *(const u32x4*)(Y + (size_t)(t * 4 + k) * D_ + c);
            v0.x += bflo(w.x); v0.y += bfhi(w.x); v0.z += bflo(w.y); v0.w += bfhi(w.y); v1.x += bflo(w.z); v1.y += bfhi(w.z); v1.z += bflo(w.w); v1.w += bfhi(w.w); }
        *(f32x4*)(out + (size_t)t * D_ + c) = v0; *(f32x4*)(out + (size_t)t * D_ + c + 4) = v1;
    }
}

constexpr int N_PHASES = 11;
#ifndef DUP_PHASE
#define DUP_PHASE -1
#endif
__global__ void __launch_bounds__(NTHR, 2) mega(Args args) {
    extern __shared__ __attribute__((aligned(16))) unsigned char lds_raw[];
    Frame F;
    F.lds = (LAS unsigned char*)lds_raw; F.MISC = (volatile LAS unsigned*)(F.lds + LDS_MISC);
    F.tid = threadIdx.x; F.lane = F.tid & 63; F.wave = __builtin_amdgcn_readfirstlane(F.tid >> 6);
    F.G = gridDim.x; { const int bx = blockIdx.x; F.vcu = (F.G % 8 == 0) ? (bx % 8) * (F.G / 8) + bx / 8 : bx; }
    F.ws = args.ws;
    unsigned char* ws = args.ws;
    for (int u = F.tid; u < (LDS_BYTES - LDS_MISC) / 4; u += NTHR) F.MISC[u] = 0u;
    __syncthreads();
    const int lo = args.ph_lo, hi = args.ph_hi;
    XcdBarrier bar; bar.bar = (unsigned*)(ws + WS_CTL) + CW_BAR; bar.x = 0; bar.st = nullptr;
    if (hi - lo > 1) bar = xcd_barrier_post((unsigned*)(ws + WS_CTL) + CW_BAR, F.MISC + MI_BAR);
#define IN(k) (lo <= (k) && (k) < hi)
#ifdef MEGA_STAMPS
#define STAMP(k) do { if (blockIdx.x == 0 && F.tid == 0) ((unsigned long long*)(ws + WS_CTL + 32768))[(k)] = __builtin_amdgcn_s_memrealtime(); } while (0)
#else
#define STAMP(k) do { } while (0)
#endif
#define SEAM(k) do { if (IN(k) && IN((k) + 1)) xcd_barrier(bar); STAMP((k) + 1); } while (0)
    const int cid = (int)blockIdx.x;
    STAMP(0);

    if (IN(0)) { p0_prologue(F, args, 0, 1); SEAM(0); }
    if (IN(1)) {
        pg8::Gemm g{(const bf16_t*)(ws + WS_HB), D_, D_, D_};
        pg8::StaticOrder S; S.init(g.A, D_, (const bf16_t*)(ws + WS_WIN), D_, M_, 4096, F.G, cid);
        pg8::EpiBf16 E{(bf16_t*)(ws + WS_PROJ), INWP};
        pg8::gemm_phase(F.lds, g, S, E);
        SEAM(1);
    }
    if (IN(2)) {
        { pg8::Gemm g{(const bf16_t*)(ws + WS_HB), D_, D_, D_};
          pg8::StaticOrder S; S.init(g.A, D_, (const bf16_t*)(ws + WS_WIN) + (size_t)4096 * D_, D_, M_, 256, F.G, cid);
          pg8::EpiBf16 E{(bf16_t*)(ws + WS_PROJ) + 4096, INWP};
          pg8::gemm_phase(F.lds, g, S, E); }
        { pg8::Gemm g{(const bf16_t*)(ws + WS_PROJ) + C_CQ, INWP, 384, 384};
          pg8::StaticOrder S; S.init(g.A, INWP, (const bf16_t*)(ws + WS_WUQ), 384, M_, 768, F.G, cid, F.G - 64);
          pg8::EpiBf16 E{(bf16_t*)(ws + WS_QRAW), 768};
          pg8::gemm_phase(F.lds, g, S, E); }
        { pg8::Gemm g{(const bf16_t*)(ws + WS_PROJ) + C_CKV, INWP, 256, 256};
          pg8::StaticOrder S; S.init(g.A, INWP, (const bf16_t*)(ws + WS_WUKV), 256, M_, 1024, F.G, cid);
          pg8::EpiBf16 E{(bf16_t*)(ws + WS_KVRAW), 1024};
          pg8::gemm_phase(F.lds, g, S, E); }
        SEAM(2);
    }
    if (IN(3)) { p4_prep(F, args); SEAM(3); }
    if (IN(4)) { p5_attention(F, args); SEAM(4); }
    if (IN(5)) {
        pg8::Gemm g{(const bf16_t*)(ws + WS_OSB), 512, 512, 512};
        pg8::PairOrder S; S.S.init(g.A, 512, (const bf16_t*)(ws + WS_WOSB), 512, M_, D_, F.G, cid); S.a1 = (WS_OMLA - WS_OSB) / 2; S.b1 = (WS_WOMLA - WS_WOSB) / 2;
        pg8::EpiGate2 E{(bf16_t*)(ws + WS_MIX), (const bf16_t*)(ws + WS_PROJ), INWP, C_GSB, C_GMLA};
        pg8::gemm_phase(F.lds, g, S, E);
        SEAM(5);
    }
    if (IN(6)) {
        pg8::Gemm g{(const bf16_t*)(ws + WS_MIX), D_, D_, D_};
        pg8::StaticOrder S; S.init(g.A, D_, (const bf16_t*)(ws + WS_WOUT), D_, M_, D_, F.G, cid);
        pg8::EpiRes E{args.in[0], args.out};
        pg8::gemm_phase(F.lds, g, S, E);
        SEAM(6);
    }
    if (IN(7)) { p8_router(F, args); SEAM(7); }
    if (IN(8)) {
        moe_table(F);
        pg8::Gemm g{(const bf16_t*)(ws + WS_H2F8), D_ / 2, D_ / 2, D_ / 2};
        MoeOrder S; S.init(g.A, D_ / 2, (const bf16_t*)(ws + WS_WUP), D_ / 2, (size_t)2 * DFF * D_ / 2, 8, (const int*)(ws + WS_LIST), F.MISC, 1, F.G, cid);
        pg8::EpiSwiglu8 E{(unsigned char*)(ws + WS_ACT), args.in[17]};
        pg8::gemm_phase<pg8::EpiSwiglu8, MoeOrder, true>(F.lds, g, S, E);
        SEAM(8);
    }
    if (IN(9)) {
        moe_table(F);
        pg8::Gemm g{(const bf16_t*)(ws + WS_ACT), DFF / 2, DFF / 2, DFF / 2};
        MoeOrder S; S.init(g.A, DFF / 2, (const bf16_t*)(ws + WS_WDN), DFF / 2, (size_t)D_ * DFF / 2, 4, (const int*)(ws + WS_LIST), F.MISC, 0, F.G, cid);
        pg8::EpiDown E{(bf16_t*)(ws + WS_YB), args.in[19], (const int*)(ws + WS_LIST), (const float*)(ws + WS_TOPW)};
        pg8::gemm_phase<pg8::EpiDown, MoeOrder, true>(F.lds, g, S, E);
        SEAM(9);
    }
    if (IN(10)) { p12_combine(F, args); STAMP(11); }
#undef IN
#undef SEAM
}
static int g_grid = 0;
static int setup_grid() {
    if (g_grid == 0) {
        int dev = 0, cus = 0;
        if (hipGetDevice(&dev) != hipSuccess || hipDeviceGetAttribute(&cus, hipDeviceAttributeMultiprocessorCount, dev) != hipSuccess) { g_grid = -1; return g_grid; }
        if (hipFuncSetAttribute((const void*)mega, hipFuncAttributeMaxDynamicSharedMemorySize, LDS_BYTES) != hipSuccess) { g_grid = -1; return g_grid; }
        int per_cu = 0;
        (void)hipOccupancyMaxActiveBlocksPerMultiprocessor(&per_cu, (const void*)mega, NTHR, LDS_BYTES);
        (void)hipGetLastError();
        g_grid = cus;
    }
    return g_grid;
}
static void launch_mega(void* const* d_in, void* d_out, void* d_ws, int lo, int hi, hipStream_t stream) {
    Args a; memset(&a, 0, sizeof(a));
    for (int i = 0; i < 20; ++i) a.in[i] = (const float*)d_in[i];
    a.out = (float*)d_out; a.ws = (unsigned char*)d_ws; a.ph_lo = lo; a.ph_hi = hi;
    hipLaunchKernelGGL(mega, dim3(g_grid), dim3(NTHR), LDS_BYTES, stream, a);
}
extern "C" void kernel_launch(void* const* d_in, const int* in_sizes, int n_in, void* d_out, int out_size, void* d_ws, size_t ws_size, hipStream_t stream) {
    if (n_in != 20 || ws_size < WS_OPT_END || out_size != M_ * D_) { fprintf(stderr, "kernel_launch: unexpected arguments\n"); return; }
    if (setup_grid() <= 0) return;
    (void)hipMemsetAsync((char*)d_ws + WS_CTL, 0, CTL_ZERO_BYTES, stream);
#if N_LAUNCH_SPLIT
    for (int p = 0; p < N_PHASES; ++p) { launch_mega(d_in, d_out, d_ws, p, p + 1, stream); if (p == DUP_PHASE) { if (p == 7) (void)hipMemsetAsync((char*)d_ws + WS_CTL, 0, 128, stream); if (p == 10) launch_mega(d_in, d_out, d_ws, 6, 7, stream); launch_mega(d_in, d_out, d_ws, p, p + 1, stream); } }
#else
    launch_mega(d_in, d_out, d_ws, 0, N_PHASES, stream);
#endif
}
```

```cpp
#define N_LAUNCH_SPLIT 0
#include <hip/hip_runtime.h>
#include <hip/hip_bf16.h>
#include <cstdio>
#include <cstdint>
#include <cstring>
#include <cmath>

constexpr int B_ = 4, S_ = 4096, D_ = 1024, M_ = B_ * S_;
constexpr int INW = 4256, INWP = 4352;
constexpr int C_SBQ = 0, C_SBK = 512, C_SBV = 1024, C_CQ = 1536, C_CKV = 1920, C_KR = 2176, C_GSB = 2208, C_GMLA = 3232;
constexpr int NE = 32, TOPK = 4, DFF = 1024;
constexpr float EPS = 1e-6f;
constexpr float LOG2E = 1.4426950408889634f;
constexpr float SB_QSCALE = 0.125f * LOG2E;
constexpr float MLA_QSCALE = 0.10206207261596577f * LOG2E;
constexpr int NWAVES = 8, NTHR = 512;

#define LAS __attribute__((address_space(3)))
#define GAS __attribute__((address_space(1)))
typedef unsigned short bf16_t;
typedef short bf16x8 __attribute__((ext_vector_type(8)));
typedef short s16x4 __attribute__((ext_vector_type(4)));
typedef float f32x4 __attribute__((ext_vector_type(4)));
typedef float f32x16 __attribute__((ext_vector_type(16)));
typedef unsigned u32x4 __attribute__((ext_vector_type(4)));
typedef unsigned u32x2 __attribute__((ext_vector_type(2)));
typedef float f32x2_t __attribute__((ext_vector_type(2)));
typedef __bf16 bf16x2_t __attribute__((ext_vector_type(2)));
typedef int v8i_t __attribute__((ext_vector_type(8)));
constexpr float W8_SCALE = 8.f, X8_SCALE = 8.f;
__device__ __forceinline__ unsigned pk_fp8x4(float a, float b, float c, float d) { unsigned w = 0; w = __builtin_amdgcn_cvt_pk_fp8_f32(a, b, w, false); w = __builtin_amdgcn_cvt_pk_fp8_f32(c, d, w, true); return w; }

__device__ __forceinline__ unsigned cvtpk(float lo, float hi) { f32x2_t v = {lo, hi}; bf16x2_t b = __builtin_convertvector(v, bf16x2_t); return __builtin_bit_cast(unsigned, b); }
__device__ __forceinline__ float bf2f(unsigned short h) { return __uint_as_float(((unsigned)h) << 16); }
__device__ __forceinline__ float bflo(unsigned w) { return __uint_as_float(w << 16); }
__device__ __forceinline__ float bfhi(unsigned w) { return __uint_as_float(w & 0xffff0000u); }
__device__ __forceinline__ float dpp_f(float v, int ctrl) { return v; }
#define DPP_F(v, ctrl) __int_as_float(__builtin_amdgcn_update_dpp(0, __float_as_int(v), (ctrl), 0xF, 0xF, true))
#define DPP_I(v, ctrl) __builtin_amdgcn_update_dpp(0, (v), (ctrl), 0xF, 0xF, true)
#define DPP_X1 0xB1
#define DPP_X2 0x4E
#define DPP_HM 0x141
#define DPP_RM 0x140
__device__ __forceinline__ float wave_sum(float v) {
    v += DPP_F(v, DPP_X1); v += DPP_F(v, DPP_X2); v += DPP_F(v, DPP_HM); v += DPP_F(v, DPP_RM);
    return (__int_as_float(__builtin_amdgcn_readlane(__float_as_int(v), 0)) + __int_as_float(__builtin_amdgcn_readlane(__float_as_int(v), 16)))
         + (__int_as_float(__builtin_amdgcn_readlane(__float_as_int(v), 32)) + __int_as_float(__builtin_amdgcn_readlane(__float_as_int(v), 48)));
}
__device__ __forceinline__ float sum8(float v) { v += DPP_F(v, DPP_X1); v += DPP_F(v, DPP_X2); v += DPP_F(v, DPP_HM); return v; }
__device__ __forceinline__ float sigmoidf_(float x) { return __builtin_amdgcn_rcpf(1.f + __builtin_amdgcn_exp2f(-x * LOG2E)); }

namespace pg8 {
constexpr int BM = 256, BK = 64, HALF = 128, HTB = HALF * BK * 2, STAGE_BYTES = 8 * HTB, NXCD = 8, WGM = 8;
__host__ __device__ __forceinline__ int lds_byte(int r, int c) { const int st = (r >> 4) * 2 + (c >> 5), rr = r & 15, cc = c & 31, ob = rr * 64 + cc * 2; return st * 1024 + (ob ^ (((ob >> 9) & 1) << 5)); }
__host__ __device__ __forceinline__ void stage_rc(int b, int& R, int& C) { const int st = b / 1024, sb = b % 1024, swz = sb ^ (((sb >> 9) & 1) << 5); R = (st >> 1) * 16 + swz / 64; C = (st & 1) * 32 + (swz % 64) / 2; }
__host__ __device__ __forceinline__ int perm32(int rho) { const int n = rho >> 4, i = rho & 15; return 8 * (i >> 2) + 4 * n + (i & 3); }

struct Unit { int pm, pn, e, rows, rt; };
struct Gemm { const bf16_t* A; int lda, ldb, K; };

struct StaticOrder {
    const bf16_t* A; const bf16_t* Bt; int lda, ldb;
    int nM, nN, nwg, G, c;
    __device__ void init(const bf16_t* A_, int lda_, const bf16_t* Bt_, int ldb_, int M, int N, int G_, int c_, int cshift = 0) { A = A_; Bt = Bt_; lda = lda_; ldb = ldb_; nM = M / BM; nN = N / BM; nwg = nM * nN; G = G_; c = (c_ + cshift) % G_; }
    __device__ __forceinline__ bool next(int i, Unit& u) const {
        const long L = (long)i * G + c; if (L >= nwg) return false;
        int wgid = (int)L; { const int q = nwg / NXCD, r = nwg % NXCD, xcd = wgid % NXCD, off = wgid / NXCD; wgid = (xcd < r ? xcd * (q + 1) : r * (q + 1) + (xcd - r) * q) + off; }
        const int nig = WGM * nN, gid = wgid / nig, fm = gid * WGM, gsz = (nM - fm) < WGM ? (nM - fm) : WGM;
        u.pm = fm + ((wgid % nig) % gsz); u.pn = (wgid % nig) / gsz; u.e = 0; u.rows = 256; u.rt = 0; return true;
    }
    __device__ __forceinline__ unsigned a_off(const Unit& u, int r, int C) const { return (unsigned)(((u.pm * BM + r) * lda + C) * 2); }
    __device__ __forceinline__ const char* b_base(const Unit& u) const { return (const char*)(Bt + (size_t)u.pn * BM * ldb); }
};

__device__ __forceinline__ v8i_t ld32_lds(const LAS unsigned char* p) { const u32x4 lo_ = *(const LAS u32x4*)p, hi_ = *(const LAS u32x4*)(p + 1024); return (v8i_t){(int)lo_.x, (int)lo_.y, (int)lo_.z, (int)lo_.w, (int)hi_.x, (int)hi_.y, (int)hi_.z, (int)hi_.w}; }
struct PairOrder {
    StaticOrder S; size_t a1, b1;
    __device__ __forceinline__ bool next(int i, Unit& u) const { if (!S.next(i >> 1, u)) return false; u.e = i & 1; return true; }
    __device__ __forceinline__ unsigned a_off(const Unit& u, int r, int C) const { return S.a_off(u, r, C) + (unsigned)(u.e ? a1 * 2 : 0); }
    __device__ __forceinline__ const char* b_base(const Unit& u) const { return S.b_base(u) + (u.e ? b1 * 2 : 0); }
};
__device__ __forceinline__ void mfma_f8(f32x4& c, const v8i_t a, const v8i_t b, int sa, int sb) {
    asm volatile("v_mfma_scale_f32_16x16x128_f8f6f4 %0, %1, %2, %0, %3, %4 op_sel_hi:[0,0,0]" : "+v"(c) : "v"(a), "v"(b), "v"(sa), "v"(sb));
}
template <bool F8> struct FragT { typedef bf16x8 type; };
template <> struct FragT<true> { typedef v8i_t type; };
template <class Epi, class Sched, bool FP8 = false>
__device__ __forceinline__ void gemm_phase(LAS unsigned char* lds, const Gemm g, const Sched& S, const Epi& E) {
    const int tid = threadIdx.x, wid = __builtin_amdgcn_readfirstlane(tid >> 6), lane = tid & 63, wr = wid >> 2, wc = wid & 3, fr = lane & 15, fq = lane >> 4;
    const int K = g.K, nt = K / BK;
    unsigned voffB[2];
#pragma unroll
    for (int i = 0; i < 2; ++i) { int R, C; stage_rc(tid * 16 + i * 8192, R, C); const int Rb = Epi::PERM ? ((R & ~31) + perm32(R & 31)) : R; voffB[i] = (unsigned)(Rb * g.ldb + C) * 2u; }
#define PG8_AOFF(dst, unit) do { int t_ = tid; asm volatile("" : "+v"(t_)); _Pragma("unroll") for (int i = 0; i < 2; ++i) { int R, C; stage_rc(t_ * 16 + i * 8192, R, C); \
        _Pragma("unroll") for (int h = 0; h < 2; ++h) dst[h][i] = S.a_off(unit, h * HALF + R, C); } } while (0)
    const size_t kstep = (size_t)(BK * 2);
    const size_t hstepB = (size_t)HALF * g.ldb * 2;
    const unsigned ldsw = (unsigned)wid * 1024u;
    const int aoff = lds_byte(wr * 64 + fr, fq * 8), boff = lds_byte(wc * 32 + fr, fq * 8);
#define PG8_SA(b, h) (((b) * 2 + (h)) * HTB)
#define PG8_SB(b, h) ((4 + (b) * 2 + (h)) * HTB)
#define PG8_STAGE(bufoff, gbase, voff) do { _Pragma("unroll") for (int _i = 0; _i < 2; ++_i) \
        __builtin_amdgcn_global_load_lds((const unsigned*)((const char*)(gbase) + (voff)[_i]), (LAS unsigned*)(lds + (bufoff) + ldsw + _i * 8192), 16, 0, 0); } while (0)
#define PG8_LD32(p) ld32_lds((const LAS unsigned char*)(p))
#define PG8_LDA(dst, b, h) do { if constexpr (FP8) { _Pragma("unroll") for (int m = 0; m < 4; ++m) dst[m][0] = __builtin_bit_cast(FT, PG8_LD32(lds + PG8_SA(b, h) + aoff + m * 2048)); } \
        else { _Pragma("unroll") for (int m = 0; m < 4; ++m) _Pragma("unroll") for (int k = 0; k < 2; ++k) dst[m][k] = __builtin_bit_cast(FT, *(const LAS FT*)(lds + PG8_SA(b, h) + aoff + m * 2048 + k * 1024)); } } while (0)
#define PG8_LDB(dst, b, h) do { if constexpr (FP8) { _Pragma("unroll") for (int n = 0; n < 2; ++n) dst[n][0] = __builtin_bit_cast(FT, PG8_LD32(lds + PG8_SB(b, h) + boff + n * 2048)); } \
        else { _Pragma("unroll") for (int n = 0; n < 2; ++n) _Pragma("unroll") for (int k = 0; k < 2; ++k) dst[n][k] = __builtin_bit_cast(FT, *(const LAS FT*)(lds + PG8_SB(b, h) + boff + n * 2048 + k * 1024)); } } while (0)
#define PG8_MMA(ai, bj, At, Bt) do { __builtin_amdgcn_s_setprio(1); \
        if constexpr (FP8) { _Pragma("unroll") for (int m = 0; m < 4; ++m) _Pragma("unroll") for (int n = 0; n < 2; ++n) \
            mfma_f8(acc[ai][bj][m][n], __builtin_bit_cast(v8i_t, Bt[n][0]), __builtin_bit_cast(v8i_t, At[m][0]), 0x7c7c7c7c, 0x7c7c7c7c); } \
        else { _Pragma("unroll") for (int m = 0; m < 4; ++m) _Pragma("unroll") for (int n = 0; n < 2; ++n) _Pragma("unroll") for (int k = 0; k < 2; ++k) \
            acc[ai][bj][m][n] = __builtin_amdgcn_mfma_f32_16x16x32_bf16(__builtin_bit_cast(bf16x8, Bt[n][k]), __builtin_bit_cast(bf16x8, At[m][k]), acc[ai][bj][m][n], 0, 0, 0); } \
        __builtin_amdgcn_s_setprio(0); } while (0)
#define PG8_WAIT_V(n) asm volatile("s_waitcnt vmcnt(" #n ")" ::: "memory")
#define PG8_WAIT_L(n) asm volatile("s_waitcnt lgkmcnt(" #n ")" ::: "memory")
#define PG8_BAR __builtin_amdgcn_s_barrier()
#define PG8_SCHED __builtin_amdgcn_sched_barrier(0)
    Unit cur, nxt; int ui = 0;
    if (!S.next(0, cur)) return;
    f32x4 acc[2][2][4][2];
#pragma unroll
    for (int a = 0; a < 2; ++a)
#pragma unroll
        for (int b = 0; b < 2; ++b)
#pragma unroll
            for (int m = 0; m < 4; ++m)
#pragma unroll
                for (int n = 0; n < 2; ++n) acc[a][b][m][n] = (f32x4){0.f, 0.f, 0.f, 0.f};
    typedef typename FragT<FP8>::type FT; constexpr int NK = FP8 ? 1 : 2;
    FT At[4][NK], B0[2][NK], B1[2][NK];
    const char* Ab = (const char*)g.A;
    const char* cB = S.b_base(cur);
    unsigned vaC[2][2], vaN[2][2];
    PG8_AOFF(vaC, cur);
    PG8_STAGE(PG8_SB(0, 0), cB, voffB); PG8_STAGE(PG8_SB(0, 1), cB + hstepB, voffB); PG8_STAGE(PG8_SA(0, 0), Ab, vaC[0]); PG8_STAGE(PG8_SA(0, 1), Ab, vaC[1]);
    if (wr == 1) PG8_BAR;
    PG8_WAIT_V(2); PG8_BAR;
    PG8_STAGE(PG8_SB(1, 0), cB + kstep, voffB); PG8_STAGE(PG8_SA(1, 0), Ab + kstep, vaC[0]); PG8_STAGE(PG8_SB(1, 1), cB + hstepB + kstep, voffB);
    PG8_WAIT_V(6); PG8_BAR;
    for (;;) {
        const bool has_next = S.next(ui + 1, nxt);
        const char* nB = has_next ? S.b_base(nxt) : cB;
        if (has_next) PG8_AOFF(vaN, nxt);
        else {
#pragma unroll
            for (int h = 0; h < 2; ++h)
#pragma unroll
                for (int i = 0; i < 2; ++i) vaN[h][i] = vaC[h][i]; }
        for (int t = 0; t < nt; t += 2) {
            const bool last = (t == nt - 2);
            const char* kA1 = Ab + (size_t)(t + 1) * kstep;
            const char* kA2 = last ? Ab : Ab + (size_t)(t + 2) * kstep; const char* b2 = last ? nB : cB + (size_t)(t + 2) * kstep;
            const char* kA3 = kA2 + kstep; const char* b3 = b2 + kstep;
            unsigned o2[2][2];
#pragma unroll
            for (int h = 0; h < 2; ++h)
#pragma unroll
                for (int i = 0; i < 2; ++i) o2[h][i] = last ? vaN[h][i] : vaC[h][i];
            PG8_LDB(B0, 0, 0); PG8_LDB(B1, 0, 1); PG8_SCHED; PG8_LDA(At, 0, 0); PG8_STAGE(PG8_SA(1, 1), kA1, vaC[1]);
            PG8_WAIT_V(8); PG8_WAIT_L(0); PG8_BAR; PG8_MMA(0, 0, At, B0); PG8_MMA(0, 1, At, B1); PG8_BAR; PG8_SCHED;
            PG8_LDA(At, 0, 1); PG8_STAGE(PG8_SB(0, 0), b2, voffB); PG8_STAGE(PG8_SB(0, 1), b2 + hstepB, voffB); PG8_STAGE(PG8_SA(0, 0), kA2, o2[0]);
            PG8_WAIT_V(8); PG8_WAIT_L(0); PG8_BAR; PG8_MMA(1, 0, At, B0); PG8_MMA(1, 1, At, B1); PG8_BAR; PG8_SCHED;
            PG8_LDB(B0, 1, 0); PG8_LDB(B1, 1, 1); PG8_SCHED; PG8_LDA(At, 1, 0); PG8_STAGE(PG8_SA(0, 1), kA2, o2[1]);
            PG8_WAIT_V(8); PG8_WAIT_L(0); PG8_BAR; PG8_MMA(0, 0, At, B0); PG8_MMA(0, 1, At, B1); PG8_BAR; PG8_SCHED;
            PG8_LDA(At, 1, 1); PG8_STAGE(PG8_SB(1, 0), b3, voffB); PG8_STAGE(PG8_SB(1, 1), b3 + hstepB, voffB); PG8_STAGE(PG8_SA(1, 0), kA3, o2[0]);
            PG8_WAIT_V(8); PG8_WAIT_L(0); PG8_BAR; PG8_MMA(1, 0, At, B0); PG8_MMA(1, 1, At, B1); PG8_BAR; PG8_SCHED;
        }
        if (wr == 0) PG8_BAR;
        if constexpr (FP8) asm volatile("s_nop 15\n\ts_nop 15" ::: "memory");
        E(acc, cur, wr, wc, fr, fq);
        if (!has_next) break;
#pragma unroll
        for (int a = 0; a < 2; ++a)
#pragma unroll
            for (int b = 0; b < 2; ++b)
#pragma unroll
                for (int m = 0; m < 4; ++m)
#pragma unroll
                    for (int n = 0; n < 2; ++n) acc[a][b][m][n] = (f32x4){0.f, 0.f, 0.f, 0.f};
        cur = nxt; cB = nB; ++ui;
#pragma unroll
        for (int h = 0; h < 2; ++h)
#pragma unroll
            for (int i = 0; i < 2; ++i) vaC[h][i] = vaN[h][i];
        if (wr == 1) PG8_BAR;
    }
    PG8_WAIT_V(0);
    PG8_BAR;
#undef PG8_SA
#undef PG8_AOFF
#undef PG8_SB
#undef PG8_STAGE
#undef PG8_LDA
#undef PG8_LDB
#undef PG8_MMA
#undef PG8_LD32
#undef PG8_WAIT_V
#undef PG8_WAIT_L
#undef PG8_BAR
#undef PG8_SCHED
}

struct EpiBf16 {
    static constexpr bool PERM = true;
    bf16_t* O; int ldc;
    __device__ __forceinline__ void operator()(const f32x4 (&acc)[2][2][4][2], const Unit& u, int wr, int wc, int fr, int fq) const {
        const int row0 = u.pm * BM + wr * 64 + fr, col0 = u.pn * BM + wc * 32 + 8 * fq;
#pragma unroll
        for (int ai = 0; ai < 2; ++ai)
#pragma unroll
            for (int m = 0; m < 4; ++m) { bf16_t* rowp = O + (size_t)(row0 + ai * HALF + m * 16) * ldc + col0;
#pragma unroll
                for (int bj = 0; bj < 2; ++bj) { const f32x4 v0 = acc[ai][bj][m][0], v1 = acc[ai][bj][m][1];
                    u32x4 w; w.x = cvtpk(v0[0], v0[1]); w.y = cvtpk(v0[2], v0[3]); w.z = cvtpk(v1[0], v1[1]); w.w = cvtpk(v1[2], v1[3]);
                    *(u32x4*)(rowp + bj * HALF) = w; } }
    }
};
struct EpiGate2 {
    static constexpr bool PERM = true;
    bf16_t* O; const bf16_t* G; int ldg, gcol0, gcol1;
    __device__ __forceinline__ void operator()(const f32x4 (&acc)[2][2][4][2], const Unit& u, int wr, int wc, int fr, int fq) const {
        const int row0 = u.pm * BM + wr * 64 + fr, col0 = u.pn * BM + wc * 32 + 8 * fq;
        const bool second = u.e != 0; const int gcol = second ? gcol1 : gcol0;
#pragma unroll
        for (int ai = 0; ai < 2; ++ai)
#pragma unroll
            for (int m = 0; m < 4; ++m) { const size_t r = (size_t)(row0 + ai * HALF + m * 16);
#pragma unroll
                for (int bj = 0; bj < 2; ++bj) { const f32x4 v0 = acc[ai][bj][m][0], v1 = acc[ai][bj][m][1];
                    const int c = col0 + bj * HALF;
                    const u32x4 gw = *(const u32x4*)(G + r * ldg + gcol + c);
                    bf16_t* op = O + r * D_ + c;
                    u32x4 pw = {0u, 0u, 0u, 0u}; if (second) pw = *(const u32x4*)op;
                    float o[8];
                    o[0] = sigmoidf_(bflo(gw.x)) * v0[0]; o[1] = sigmoidf_(bfhi(gw.x)) * v0[1]; o[2] = sigmoidf_(bflo(gw.y)) * v0[2]; o[3] = sigmoidf_(bfhi(gw.y)) * v0[3];
                    o[4] = sigmoidf_(bflo(gw.z)) * v1[0]; o[5] = sigmoidf_(bfhi(gw.z)) * v1[1]; o[6] = sigmoidf_(bflo(gw.w)) * v1[2]; o[7] = sigmoidf_(bfhi(gw.w)) * v1[3];
                    o[0] += bflo(pw.x); o[1] += bfhi(pw.x); o[2] += bflo(pw.y); o[3] += bfhi(pw.y); o[4] += bflo(pw.z); o[5] += bfhi(pw.z); o[6] += bflo(pw.w); o[7] += bfhi(pw.w);
                    u32x4 w; w.x = cvtpk(o[0], o[1]); w.y = cvtpk(o[2], o[3]); w.z = cvtpk(o[4], o[5]); w.w = cvtpk(o[6], o[7]);
                    *(u32x4*)op = w; } }
    }
};
struct EpiRes {
    static constexpr bool PERM = false;
    const float* base; float* out;
    __device__ __forceinline__ void operator()(const f32x4 (&acc)[2][2][4][2], const Unit& u, int wr, int wc, int fr, int fq) const {
        const int row0 = u.pm * BM + wr * 64 + fr, col0 = u.pn * BM + wc * 32 + 4 * fq;
#pragma unroll
        for (int ai = 0; ai < 2; ++ai)
#pragma unroll
            for (int m = 0; m < 4; ++m) { const size_t off = (size_t)(row0 + ai * HALF + m * 16) * D_ + col0;
#pragma unroll
                for (int bj = 0; bj < 2; ++bj)
#pragma unroll
                    for (int n = 0; n < 2; ++n) { const f32x4 b = *(const f32x4*)(base + off + bj * HALF + n * 16); *(f32x4*)(out + off + bj * HALF + n * 16) = b + acc[ai][bj][m][n]; } }
    }
};
struct EpiSwiglu {
    static constexpr bool PERM = true;
    bf16_t* act; const float* b_up;
    __device__ __forceinline__ void operator()(const f32x4 (&acc)[2][2][4][2], const Unit& u, int wr, int wc, int fr, int fq) const {
        const int row0 = u.pm * BM + wr * 64 + fr, col0 = u.pn * BM + wc * 32 + 8 * fq;
        const float* bb = b_up + (size_t)u.e * (2 * DFF);
        f32x4 bv[2][2];
#pragma unroll
        for (int bj = 0; bj < 2; ++bj)
#pragma unroll
            for (int n = 0; n < 2; ++n) bv[bj][n] = *(const f32x4*)(bb + col0 + bj * HALF + 4 * n);
#pragma unroll
        for (int ai = 0; ai < 2; ++ai)
#pragma unroll
            for (int m = 0; m < 4; ++m) { bf16_t* rowp = act + (size_t)(row0 + ai * HALF + m * 16) * DFF + (col0 >> 1);
#pragma unroll
                for (int bj = 0; bj < 2; ++bj) { const f32x4 v0 = acc[ai][bj][m][0] + bv[bj][0], v1 = acc[ai][bj][m][1] + bv[bj][1];
                    float a[4];
#pragma unroll
                    for (int p = 0; p < 4; ++p) { float gl = (p < 2) ? v0[2 * p] : v1[2 * p - 4], li = (p < 2) ? v0[2 * p + 1] : v1[2 * p - 3];
                        gl = fminf(gl, 7.f); li = fminf(fmaxf(li, -7.f), 7.f);
                        a[p] = gl * sigmoidf_(1.702f * gl) * (li + 1.f); }
                    u32x2 w; w.x = cvtpk(a[0], a[1]); w.y = cvtpk(a[2], a[3]);
                    *(u32x2*)(rowp + bj * (HALF / 2)) = w; } }
    }
};
struct EpiSwiglu8 {
    static constexpr bool PERM = true;
    unsigned char* act; const float* b_up;
    __device__ __forceinline__ void operator()(const f32x4 (&acc)[2][2][4][2], const Unit& u, int wr, int wc, int fr, int fq) const {
        const int row0 = u.pm * BM + wr * 64 + fr, col0 = u.pn * BM + wc * 32 + 8 * fq;
        const float* bb = b_up + (size_t)u.e * (2 * DFF);
        f32x4 bv[2][2];
#pragma unroll
        for (int bj = 0; bj < 2; ++bj)
#pragma unroll
            for (int n = 0; n < 2; ++n) bv[bj][n] = *(const f32x4*)(bb + col0 + bj * HALF + 4 * n);
#pragma unroll
        for (int ai = 0; ai < 2; ++ai)
#pragma unroll
            for (int m = 0; m < 4; ++m) { unsigned char* rowp = act + (size_t)(row0 + ai * HALF + m * 16) * DFF + (col0 >> 1);
#pragma unroll
                for (int bj = 0; bj < 2; ++bj) { const f32x4 v0 = acc[ai][bj][m][0] + bv[bj][0], v1 = acc[ai][bj][m][1] + bv[bj][1];
                    float a[4];
#pragma unroll
                    for (int p = 0; p < 4; ++p) { float gl = (p < 2) ? v0[2 * p] : v1[2 * p - 4], li = (p < 2) ? v0[2 * p + 1] : v1[2 * p - 3];
                        gl = fminf(gl, 7.f); li = fminf(fmaxf(li, -7.f), 7.f);
                        a[p] = gl * sigmoidf_(1.702f * gl) * fmaf(li, X8_SCALE, X8_SCALE); }
                    *(unsigned*)(rowp + bj * (HALF / 2)) = pk_fp8x4(a[0], a[1], a[2], a[3]); } }
    }
};
struct EpiDown {
    static constexpr bool PERM = true;
    bf16_t* y; const float* b_down; const int* list; const float* listw;
    __device__ __forceinline__ void operator()(const f32x4 (&acc)[2][2][4][2], const Unit& u, int wr, int wc, int fr, int fq) const {
        const int col0 = u.pn * BM + wc * 32 + 8 * fq;
        const float* bb = b_down + (size_t)u.e * D_;
        f32x4 bv[2][2];
#pragma unroll
        for (int bj = 0; bj < 2; ++bj)
#pragma unroll
            for (int n = 0; n < 2; ++n) bv[bj][n] = *(const f32x4*)(bb + col0 + bj * HALF + 4 * n);
        const int* lp = list + (size_t)u.e * M_ + u.rt * BM; const float* lw = listw + (size_t)u.e * M_ + u.rt * BM;
#pragma unroll
        for (int ai = 0; ai < 2; ++ai)
#pragma unroll
            for (int m = 0; m < 4; ++m) { const int r = ai * HALF + wr * 64 + m * 16 + fr;
                if (r < u.rows) { const int slot = lp[r]; const float w = lw[r]; bf16_t* rowp = y + (size_t)slot * D_ + col0;
#pragma unroll
                    for (int bj = 0; bj < 2; ++bj) { const f32x4 v0 = (acc[ai][bj][m][0] + bv[bj][0]) * w, v1 = (acc[ai][bj][m][1] + bv[bj][1]) * w;
                        u32x4 o; o.x = cvtpk(v0[0], v0[1]); o.y = cvtpk(v0[2], v0[3]); o.z = cvtpk(v1[0], v1[1]); o.w = cvtpk(v1[2], v1[3]);
                        *(u32x4*)(rowp + bj * HALF) = o; } } }
    }
};
}
constexpr size_t MiB = 1ull << 20;
constexpr size_t WS_CTL = 0, CTL_ZERO_BYTES = 64 * 1024;
constexpr size_t WS_ROPE = 256 * 1024;
constexpr size_t WS_WR = 3 * MiB;
constexpr size_t WS_LIST = 4 * MiB;
constexpr size_t WS_TOPW = 6 * MiB;
constexpr size_t WS_SEL = 6 * MiB + 512 * 1024;
constexpr size_t WS_LISTW = 594 * MiB;
constexpr size_t WS_WIN = 8 * MiB;
constexpr size_t WS_WUQ = 17 * MiB;
constexpr size_t WS_WUKV = 18 * MiB;
constexpr size_t WS_WOSB = 19 * MiB;
constexpr size_t WS_WOMLA = 20 * MiB;
constexpr size_t WS_WOUT = 21 * MiB;
constexpr size_t WS_WUP = 24 * MiB;
constexpr size_t WS_WDN = 152 * MiB;
constexpr size_t WS_HB = 216 * MiB;
constexpr size_t WS_PROJ = 249 * MiB;
constexpr size_t WS_ACT = WS_PROJ;
constexpr size_t WS_QRAW = 393 * MiB;
constexpr size_t WS_KVRAW = WS_QRAW + 24 * MiB;
constexpr size_t WS_QB = WS_KVRAW + 32 * MiB;
constexpr size_t WS_KB = WS_QB + 24 * MiB;
constexpr size_t WS_VB = WS_KB + 24 * MiB;
constexpr size_t WS_OSB = WS_VB + 16 * MiB;
constexpr size_t WS_OMLA = WS_OSB + 16 * MiB;
constexpr size_t WS_YB = WS_QRAW;
constexpr size_t WS_MIX = 545 * MiB;
constexpr size_t WS_H2F8 = 577 * MiB;
constexpr size_t WS_OPT_END = 596 * MiB;
constexpr int CW_CNT = 0;
constexpr int CW_BAR = 1024;
constexpr int LDS_STAGE = 143360;
constexpr int LDS_MISC = LDS_STAGE;
constexpr int LDS_BYTES = 147456;
constexpr int MI_BAR = 0, MI_TPFX = 16, MI_CNT = 64, MI_FLAG = 128, MI_LCNT = 160, MI_BASE = 192, MI_RSTD = 256, MI_CITEM = 320;

typedef GAS unsigned gu32;
#define RLX_AGENT __ATOMIC_RELAXED, __HIP_MEMORY_SCOPE_AGENT

#define XB_TMO      128
#define XB_XCNT(j)  (256  + 64 * (j))
#define XB_XSUB(j)  (1280 + 64 * (j))
#define XB_XGEN(j)  (2304 + 64 * (j))
#define XB_TOP      3328
#define XB_TOPGEN   3392
#define XCD_BAR_WORDS 3456
#define XB_SPIN_CAP (1u << 18)
__device__ __forceinline__ unsigned xb_ld(unsigned* p)              { return __hip_atomic_load(p, __ATOMIC_RELAXED, __HIP_MEMORY_SCOPE_AGENT); }
__device__ __forceinline__ unsigned xb_add(unsigned* p, unsigned v) { return __hip_atomic_fetch_add(p, v, __ATOMIC_RELAXED, __HIP_MEMORY_SCOPE_AGENT); }
__device__ __forceinline__ unsigned xb_xcc_id() { return (unsigned)__builtin_amdgcn_s_getreg((3 << 11) | 20) & 0xFu; }
#define XB_SPIN(cond, bar) do { unsigned _sp = 0; while (cond) { __builtin_amdgcn_s_sleep(1); \
    if ((++_sp & 255u) == 0u) { if (xb_ld(&(bar)[XB_TMO])) break; if (_sp > XB_SPIN_CAP) { atomicAdd(&(bar)[XB_TMO], 1u); break; } } } } while (0)
struct XcdBarrier { unsigned* bar; unsigned x; volatile LAS unsigned* st; };
__device__ __forceinline__ XcdBarrier xcd_barrier_post(unsigned* bar, volatile LAS unsigned* st) {
    XcdBarrier b; b.bar = bar; b.x = xb_xcc_id(); b.st = st;
    if (threadIdx.x == 0) (void)xb_add(&bar[XB_XCNT(b.x)], 1u);
    return b;
}
__device__ __forceinline__ void xcd_barrier_complete(unsigned* bar, unsigned x, unsigned& nloc, unsigned& nx) {
    const unsigned G = gridDim.x * gridDim.y * gridDim.z;
    unsigned sum, cnt, mine, sp = 0u;
    for (;;) {
        sum = 0u; cnt = 0u; mine = 0u;
#pragma unroll
        for (unsigned j = 0; j < 16; ++j) { const unsigned c = xb_ld(&bar[XB_XCNT(j)]); sum += c; cnt += (c > 0u) ? 1u : 0u; mine = (j == x) ? c : mine; }
        if (sum == G) break;
        __builtin_amdgcn_s_sleep(1);
        if ((++sp & 255u) == 0u) { if (xb_ld(&bar[XB_TMO])) break; if (sp > XB_SPIN_CAP) { atomicAdd(&bar[XB_TMO], 1u); break; } }
    }
    nloc = mine > 0u ? mine : 1u; nx = cnt > 0u ? cnt : 1u;
}
__device__ __forceinline__ void xcd_barrier(const XcdBarrier& b) {
    asm volatile("s_waitcnt vmcnt(0)" ::: "memory");
    __syncthreads();
    if (threadIdx.x == 0) {
        unsigned* bar = b.bar;
        __builtin_amdgcn_s_waitcnt(0);
        unsigned nloc = b.st[0], nx = b.st[1];
        if (nloc == 0u) { xcd_barrier_complete(bar, b.x, nloc, nx); b.st[0] = nloc; b.st[1] = nx; }
        const unsigned old = xb_add(&bar[XB_XSUB(b.x)], 1u);
        const unsigned gen = old / nloc;
        if (old + 1u == (gen + 1u) * nloc) {
            __builtin_amdgcn_fence(__ATOMIC_RELEASE, "agent");
            asm volatile("s_waitcnt vmcnt(0)" ::: "memory");
            const unsigned og = xb_add(&bar[XB_TOP], 1u);
            const unsigned tg = og / nx;
            if (og + 1u == (tg + 1u) * nx) xb_add(&bar[XB_TOPGEN], 1u);
            else XB_SPIN(xb_ld(&bar[XB_TOPGEN]) == tg, bar);
            __builtin_amdgcn_fence(__ATOMIC_ACQUIRE, "agent");
            xb_add(&bar[XB_XGEN(b.x)], 1u);
            asm volatile("s_waitcnt vmcnt(0)" ::: "memory");
        } else {
            XB_SPIN(xb_ld(&bar[XB_XGEN(b.x)]) == gen, bar);
            __builtin_amdgcn_fence(__ATOMIC_ACQUIRE, "agent");
            asm volatile("s_waitcnt vmcnt(0)" ::: "memory");
        }
    }
    __syncthreads();
}

struct Args {
    const float* in[20]; float* out; unsigned char* ws;
    int ph_lo, ph_hi;
};

struct Frame {
    LAS unsigned char* lds; volatile LAS unsigned* MISC;
    int tid, lane, wave, vcu, G;
    unsigned char* ws;
};

__device__ __forceinline__ void p0_transpose_item(const float* W, int K, int N, bf16_t* WT, LAS float* scr, int item, int lane, const float* gk, float cs, int csn) {
    const int nblk = N / 32, kb = item / nblk, nb = item % nblk, k0 = 64 * kb, n0 = 32 * nb;
    const float colsc = (n0 < csn) ? cs : 1.f;
    float tv[32];
#pragma unroll
    for (int i = 0; i < 32; ++i) { const int kk = 2 * i + (lane >> 5); tv[i] = W[(size_t)(k0 + kk) * N + n0 + (lane & 31)]; }
#pragma unroll
    for (int i = 0; i < 32; ++i) { const int kk = 2 * i + (lane >> 5); float v = tv[i] * colsc; if (gk) v *= gk[k0 + kk]; scr[kk * 33 + (lane & 31)] = v; }
    asm volatile("s_waitcnt lgkmcnt(0)" ::: "memory");
    const int c = lane & 7;
#pragma unroll
    for (int j = 0; j < 4; ++j) { const int n = (lane >> 3) + 8 * j; const LAS float* s = scr + (8 * c) * 33 + n;
        u32x4 o; o.x = cvtpk(s[0 * 33], s[1 * 33]); o.y = cvtpk(s[2 * 33], s[3 * 33]); o.z = cvtpk(s[4 * 33], s[5 * 33]); o.w = cvtpk(s[6 * 33], s[7 * 33]);
        *(u32x4*)(WT + (size_t)(n0 + n) * K + k0 + 8 * c) = o; }
    asm volatile("s_waitcnt lgkmcnt(0)" ::: "memory");
}
__device__ __forceinline__ void p0_transpose_item_fp8(const float* W, int K, int N, unsigned char* WT, LAS float* scr, int item, int lane, float cs) {
    const int nblk = N / 32, kb = item / nblk, nb = item % nblk, k0 = 64 * kb, n0 = 32 * nb;
    float tv[32];
#pragma unroll
    for (int i = 0; i < 32; ++i) { const int kk = 2 * i + (lane >> 5); tv[i] = W[(size_t)(k0 + kk) * N + n0 + (lane & 31)]; }
#pragma unroll
    for (int i = 0; i < 32; ++i) { const int kk = 2 * i + (lane >> 5); scr[kk * 33 + (lane & 31)] = tv[i] * cs; }
    asm volatile("s_waitcnt lgkmcnt(0)" ::: "memory");
    const int c = lane & 7;
#pragma unroll
    for (int j = 0; j < 4; ++j) { const int n = (lane >> 3) + 8 * j; const LAS float* s = scr + (8 * c) * 33 + n;
        u32x2 o; o.x = pk_fp8x4(s[0 * 33], s[1 * 33], s[2 * 33], s[3 * 33]); o.y = pk_fp8x4(s[4 * 33], s[5 * 33], s[6 * 33], s[7 * 33]);
        *(u32x2*)(WT + (size_t)(n0 + n) * K + k0 + 8 * c) = o; }
    asm volatile("s_waitcnt lgkmcnt(0)" ::: "memory");
}
__device__ __forceinline__ void rms_row_to_bf16(const float* xrow, const float* g, bf16_t* orow, int lane) {
    const f32x4* xr = (const f32x4*)xrow + lane; const f32x4* gr = (const f32x4*)g + lane;
    f32x4 v[4]; float s = 0.f;
#pragma unroll
    for (int j = 0; j < 4; ++j) { v[j] = xr[64 * j]; s += (v[j].x * v[j].x + v[j].y * v[j].y) + (v[j].z * v[j].z + v[j].w * v[j].w); }
    const float rstd = rsqrtf(wave_sum(s) * (1.f / D_) + EPS);
    u32x2* o8 = (u32x2*)orow + lane;
#pragma unroll
    for (int j = 0; j < 4; ++j) { const f32x4 gg = gr[64 * j]; u32x2 w; w.x = cvtpk(v[j].x * rstd * gg.x, v[j].y * rstd * gg.y); w.y = cvtpk(v[j].z * rstd * gg.z, v[j].w * rstd * gg.w); o8[64 * j] = w; }
}
__device__ __forceinline__ void p0_prologue(Frame& F, const Args& a, int do_moe_w, int do_rest) {
    LAS float* scr = (LAS float*)(F.lds + F.wave * 16384);
    const int gw = F.vcu * NWAVES + F.wave, NGW = F.G * NWAVES;
    unsigned char* ws = F.ws;
    const float* w_in = a.in[3]; const float* g_cq = a.in[4]; const float* w_uq = a.in[5]; const float* g_ckv = a.in[6]; const float* w_ukv = a.in[7];
    const float* w_o_sb = a.in[10]; const float* w_o_mla = a.in[11]; const float* w_out = a.in[12]; const float* g_ffn = a.in[13]; const float* w_router = a.in[14];
    const float* w_up = a.in[16]; const float* w_down = a.in[18];
    constexpr int I_IN = (D_ / 64) * (INW / 32), I_UQ = (384 / 64) * (768 / 32), I_UKV = (256 / 64) * (1024 / 32), I_O = (512 / 64) * (1024 / 32), I_OUT = (1024 / 64) * (1024 / 32);
    constexpr int I_UP1 = (1024 / 64) * (2048 / 32), I_DN1 = (1024 / 64) * (1024 / 32);
    if (do_rest) {
        constexpr int NI = I_IN + I_UQ + I_UKV + 2 * I_O + I_OUT;
        for (int it = gw; it < NI; it += NGW) {
            int r = it;
            if (r < I_IN) { p0_transpose_item(w_in, D_, INW, (bf16_t*)(ws + WS_WIN), scr, r, F.lane, nullptr, SB_QSCALE, 512); continue; } r -= I_IN;
            if (r < I_UQ) { p0_transpose_item(w_uq, 384, 768, (bf16_t*)(ws + WS_WUQ), scr, r, F.lane, g_cq, 1.f, 0); continue; } r -= I_UQ;
            if (r < I_UKV) { p0_transpose_item(w_ukv, 256, 1024, (bf16_t*)(ws + WS_WUKV), scr, r, F.lane, g_ckv, 1.f, 0); continue; } r -= I_UKV;
            if (r < I_O) { p0_transpose_item(w_o_sb, 512, 1024, (bf16_t*)(ws + WS_WOSB), scr, r, F.lane, nullptr, 1.f, 0); continue; } r -= I_O;
            if (r < I_O) { p0_transpose_item(w_o_mla, 512, 1024, (bf16_t*)(ws + WS_WOMLA), scr, r, F.lane, nullptr, 1.f, 0); continue; } r -= I_O;
            p0_transpose_item(w_out, 1024, 1024, (bf16_t*)(ws + WS_WOUT), scr, r, F.lane, nullptr, 1.f, 0);
        }
        { const int gt = gw * 64 + F.lane, NGT = NGW * 64;
          u32x4 z = {0u, 0u, 0u, 0u};
          u32x4* pz = (u32x4*)((bf16_t*)(ws + WS_WIN) + (size_t)INW * D_);
          for (int i = gt; i < (INWP - INW) * D_ * 2 / 16; i += NGT) pz[i] = z;
          u32x4* hz = (u32x4*)((unsigned char*)(ws + WS_H2F8) + (size_t)M_ * D_);
          for (int i = gt; i < D_ / 16; i += NGT) hz[i] = z;
          const int* pos = (const int*)a.in[1]; float* rt = (float*)(ws + WS_ROPE);
          for (int i = gt; i < M_ * 16; i += NGT) { const int row = i >> 4, k = i & 15; const float inv = powf(10000.f, -(float)k / 16.f); const float ang = (float)pos[row] * inv; rt[row * 32 + k] = cosf(ang); rt[row * 32 + 16 + k] = sinf(ang); }
          float* wr = (float*)(ws + WS_WR);
          for (int i = gt; i < D_ * NE; i += NGT) wr[i] = w_router[i] * g_ffn[i >> 5];
        }
        {
            const f32x4* gr = (const f32x4*)a.in[2] + F.lane; f32x4 gg[4];
#pragma unroll
            for (int j = 0; j < 4; ++j) gg[j] = gr[64 * j];
            for (int m = gw; m < M_; m += 4 * NGW) {
                f32x4 v[4][4]; float s[4];
#pragma unroll
                for (int q = 0; q < 4; ++q) { const int row = m + q * NGW; const f32x4* xr = (const f32x4*)(a.in[0] + (size_t)(row < M_ ? row : m) * D_) + F.lane;
#pragma unroll
                    for (int j = 0; j < 4; ++j) v[q][j] = xr[64 * j]; }
#pragma unroll
                for (int q = 0; q < 4; ++q) { s[q] = 0.f;
#pragma unroll
                    for (int j = 0; j < 4; ++j) s[q] += (v[q][j].x * v[q][j].x + v[q][j].y * v[q][j].y) + (v[q][j].z * v[q][j].z + v[q][j].w * v[q][j].w); }
#pragma unroll
                for (int q = 0; q < 4; ++q) { const int row = m + q * NGW; const float r = rsqrtf(wave_sum(s[q]) * (1.f / D_) + EPS);
                    if (row < M_) { u32x2* o8 = (u32x2*)((bf16_t*)(ws + WS_HB) + (size_t)row * D_) + F.lane;
#pragma unroll
                        for (int j = 0; j < 4; ++j) { u32x2 w; w.x = cvtpk(v[q][j].x * r * gg[j].x, v[q][j].y * r * gg[j].y); w.y = cvtpk(v[q][j].z * r * gg[j].z, v[q][j].w * r * gg[j].w); o8[64 * j] = w; } } }
            }
        }
    }
    if (do_moe_w) {
        constexpr int NI = NE * (I_UP1 + I_DN1);
        for (int it = gw; it < NI; it += NGW) {
            int r = it;
            if (r < NE * I_UP1) { const int e = r / I_UP1; p0_transpose_item_fp8(w_up + (size_t)e * D_ * 2 * DFF, D_, 2 * DFF, (unsigned char*)(ws + WS_WUP) + (size_t)e * 2 * DFF * D_, scr, r % I_UP1, F.lane, W8_SCALE); continue; }
            r -= NE * I_UP1;
            { const int e = r / I_DN1; p0_transpose_item_fp8(w_down + (size_t)e * DFF * D_, DFF, D_, (unsigned char*)(ws + WS_WDN) + (size_t)e * D_ * DFF, scr, r % I_DN1, F.lane, W8_SCALE); }
        }
    }
}

__device__ __forceinline__ void ld16bf(const bf16_t* p, float (&v)[16]) {
    const u32x4 a = *(const u32x4*)p, b = *(const u32x4*)(p + 8);
    v[0] = bflo(a.x); v[1] = bfhi(a.x); v[2] = bflo(a.y); v[3] = bfhi(a.y); v[4] = bflo(a.z); v[5] = bfhi(a.z); v[6] = bflo(a.w); v[7] = bfhi(a.w);
    v[8] = bflo(b.x); v[9] = bfhi(b.x); v[10] = bflo(b.y); v[11] = bfhi(b.y); v[12] = bflo(b.z); v[13] = bfhi(b.z); v[14] = bflo(b.w); v[15] = bfhi(b.w);
}
__device__ __forceinline__ void st16bf(bf16_t* p, const float (&v)[16]) {
    u32x4 a, b; a.x = cvtpk(v[0], v[1]); a.y = cvtpk(v[2], v[3]); a.z = cvtpk(v[4], v[5]); a.w = cvtpk(v[6], v[7]);
    b.x = cvtpk(v[8], v[9]); b.y = cvtpk(v[10], v[11]); b.z = cvtpk(v[12], v[13]); b.w = cvtpk(v[14], v[15]);
    *(u32x4*)p = a; *(u32x4*)(p + 8) = b;
}
struct PrepIn { unsigned cq0, cq1, cq2; u32x2 ckv; u32x4 qa, qb, ka, kb, vv; float rope; };
__device__ __forceinline__ void p4_load(PrepIn& in, int row, const bf16_t* proj, const bf16_t* qraw, const bf16_t* kvraw, const float* rope, int lane) {
    const int h = lane >> 3, s = lane & 7;
    const bf16_t* pr = proj + (size_t)row * INWP;
    { const bf16_t* p = pr + C_CQ + lane * 6; in.cq0 = *(const unsigned*)p; in.cq1 = *(const unsigned*)(p + 2); in.cq2 = *(const unsigned*)(p + 4); }
    in.ckv = *(const u32x2*)(pr + C_CKV + lane * 4);
    in.rope = rope[(size_t)row * 32 + (lane & 31)];
    const u32x4 z = {0u, 0u, 0u, 0u};
    in.qa = z; in.qb = z; in.ka = z; in.kb = z;
    if (s < 6) { const bf16_t* q = qraw + (size_t)row * 768 + h * 96 + s * 16; in.qa = *(const u32x4*)q; in.qb = *(const u32x4*)(q + 8);
        const bf16_t* k = (s < 4) ? (kvraw + (size_t)row * 1024 + h * 128 + s * 16) : (pr + C_KR + (s - 4) * 16); in.ka = *(const u32x4*)k; in.kb = *(const u32x4*)(k + 8); }
    in.vv = *(const u32x4*)(kvraw + (size_t)row * 1024 + (lane >> 3) * 128 + 64 + (lane & 7) * 8);
}
__device__ __forceinline__ void unpack16(const u32x4 a, const u32x4 b, float (&v)[16]) {
    v[0] = bflo(a.x); v[1] = bfhi(a.x); v[2] = bflo(a.y); v[3] = bfhi(a.y); v[4] = bflo(a.z); v[5] = bfhi(a.z); v[6] = bflo(a.w); v[7] = bfhi(a.w);
    v[8] = bflo(b.x); v[9] = bfhi(b.x); v[10] = bflo(b.y); v[11] = bfhi(b.y); v[12] = bflo(b.z); v[13] = bfhi(b.z); v[14] = bflo(b.w); v[15] = bfhi(b.w);
}
__device__ __forceinline__ void p4_prep(Frame& F, const Args& a) {
    unsigned char* ws = F.ws;
    const bf16_t* proj = (const bf16_t*)(ws + WS_PROJ); const bf16_t* qraw = (const bf16_t*)(ws + WS_QRAW); const bf16_t* kvraw = (const bf16_t*)(ws + WS_KVRAW);
    bf16_t* QB = (bf16_t*)(ws + WS_QB); bf16_t* KB = (bf16_t*)(ws + WS_KB); bf16_t* VB = (bf16_t*)(ws + WS_VB);
    const float* rope = (const float*)(ws + WS_ROPE); const float* gq = a.in[8]; const float* gk = a.in[9];
    const int gw = F.vcu * NWAVES + F.wave, NGW = F.G * NWAVES, lane = F.lane, h = lane >> 3, s = lane & 7;
    float gqv[16], gkv[16];
#pragma unroll
    for (int j = 0; j < 16; ++j) { gqv[j] = (s < 6) ? gq[s * 16 + j] : 0.f; gkv[j] = (s < 6) ? gk[s * 16 + j] : 0.f; }
    PrepIn cur, nxt;
    if (gw < M_) p4_load(cur, gw, proj, qraw, kvraw, rope, lane);
    for (int row = gw; row < M_; row += NGW) {
        const bool hn = row + NGW < M_;
        if (hn) p4_load(nxt, row + NGW, proj, qraw, kvraw, rope, lane);
        float sq = bflo(cur.cq0) * bflo(cur.cq0) + bfhi(cur.cq0) * bfhi(cur.cq0) + bflo(cur.cq1) * bflo(cur.cq1) + bfhi(cur.cq1) * bfhi(cur.cq1) + bflo(cur.cq2) * bflo(cur.cq2) + bfhi(cur.cq2) * bfhi(cur.cq2);
        float skv = bflo(cur.ckv.x) * bflo(cur.ckv.x) + bfhi(cur.ckv.x) * bfhi(cur.ckv.x) + bflo(cur.ckv.y) * bflo(cur.ckv.y) + bfhi(cur.ckv.y) * bfhi(cur.ckv.y);
        sq = wave_sum(sq); skv = wave_sum(skv);
        const float var_cq = sq * (1.f / 384.f) + EPS;
        const float rstd_ckv = rsqrtf(skv * (1.f / 256.f) + EPS);
        float cs[16], sn[16];
#pragma unroll
        for (int j = 0; j < 16; ++j) { cs[j] = __int_as_float(__builtin_amdgcn_readlane(__float_as_int(cur.rope), j)); sn[j] = __int_as_float(__builtin_amdgcn_readlane(__float_as_int(cur.rope), 16 + j)); }
        {
            float v[16]; unpack16(cur.qa, cur.qb, v);
            float ss = 0.f;
#pragma unroll
            for (int j = 0; j < 16; ++j) ss += v[j] * v[j];
            ss = sum8(ss);
            const float r = rsqrtf(ss * (1.f / 96.f) + EPS * var_cq);
#pragma unroll
            for (int j = 0; j < 16; ++j) v[j] = v[j] * r * gqv[j];
            float o[16];
#pragma unroll
            for (int j = 0; j < 16; ++j) { const float pv = DPP_F(v[j], DPP_X1);
                o[j] = (s == 4) ? (v[j] * cs[j] - pv * sn[j]) : (s == 5) ? (v[j] * cs[j] + pv * sn[j]) : v[j]; o[j] *= MLA_QSCALE; }
            if (s < 6) st16bf(QB + (size_t)row * 768 + h * 96 + s * 16, o);
        }
        {
            float v[16]; unpack16(cur.ka, cur.kb, v);
            if (s < 4) {
#pragma unroll
                for (int j = 0; j < 16; ++j) v[j] *= rstd_ckv; }
            float ss = 0.f;
#pragma unroll
            for (int j = 0; j < 16; ++j) ss += v[j] * v[j];
            ss = sum8(ss);
            const float r = rsqrtf(ss * (1.f / 96.f) + EPS);
#pragma unroll
            for (int j = 0; j < 16; ++j) v[j] = v[j] * r * gkv[j];
            float o[16];
#pragma unroll
            for (int j = 0; j < 16; ++j) { const float pv = DPP_F(v[j], DPP_X1);
                o[j] = (s == 4) ? (v[j] * cs[j] - pv * sn[j]) : (s == 5) ? (v[j] * cs[j] + pv * sn[j]) : v[j]; }
            if (s < 6) st16bf(KB + (size_t)row * 768 + h * 96 + s * 16, o);
            const u32x4 vw = cur.vv;
            u32x4 ow; ow.x = cvtpk(bflo(vw.x) * rstd_ckv, bfhi(vw.x) * rstd_ckv); ow.y = cvtpk(bflo(vw.y) * rstd_ckv, bfhi(vw.y) * rstd_ckv);
            ow.z = cvtpk(bflo(vw.z) * rstd_ckv, bfhi(vw.z) * rstd_ckv); ow.w = cvtpk(bflo(vw.w) * rstd_ckv, bfhi(vw.w) * rstd_ckv);
            *(u32x4*)(VB + (size_t)row * 512 + lane * 8) = ow;
        }
        if (hn) cur = nxt;
    }
}
namespace att {
constexpr int BUFB = 20480;
constexpr int WREG = 8448;
constexpr int OST_OFF = 2 * BUFB;
constexpr int WSF_OFF = OST_OFF + 8 * WREG;
constexpr int FLG_OFF = WSF_OFF + 8 * 256;
__device__ __forceinline__ int crow(int r, int hi) { return (r & 3) + 8 * (r >> 2) + 4 * hi; }
__device__ __forceinline__ s16x4 vtr(const LAS char* p) { typedef short v4i16_t __attribute__((ext_vector_type(4))); return __builtin_bit_cast(s16x4, __builtin_amdgcn_ds_read_tr16_b64_v4i16((LAS v4i16_t*)p)); }
#define ATT_MFMA(a, b, c) __builtin_amdgcn_mfma_f32_32x32x16_bf16((a), (b), (c), 0, 0, 0)

template <int NCH> struct Stage {
    u32x4 k0, k1, v0;
    __device__ __forceinline__ void load(const bf16_t* Kb, int pitchK, const bf16_t* Vb, int pitchV, int key0, int wid, int lane) {
        k0 = *(const u32x4*)(Kb + (size_t)(key0 + lane) * pitchK + wid * 8);
        if (NCH > 8) { if (wid < NCH - 8) k1 = *(const u32x4*)(Kb + (size_t)(key0 + lane) * pitchK + (8 + wid) * 8); }
        v0 = *(const u32x4*)(Vb + (size_t)(key0 + 16 * (wid & 3) + (lane >> 2)) * pitchV + (wid >> 2) * 32 + (lane & 3) * 8);
    }
    __device__ __forceinline__ void write(LAS unsigned char* buf, int wid, int lane) const {
        *(LAS u32x4*)(buf + wid * 1024 + lane * 16) = k0;
        if (NCH > 8) { if (wid < NCH - 8) *(LAS u32x4*)(buf + (8 + wid) * 1024 + lane * 16) = k1; }
        *(LAS u32x4*)(buf + NCH * 1024 + wid * 1024 + lane * 16) = v0;
    }
};

__device__ __forceinline__ void pv_tile(f32x16 (&o)[2], const LAS char* vp, const bf16x8 (&pa)[4]) {
    __builtin_amdgcn_s_setprio(1);
#pragma unroll
    for (int d0 = 0; d0 < 2; ++d0)
#pragma unroll
        for (int ks = 0; ks < 4; ++ks) {
            const s16x4 lo = vtr(vp + d0 * 4096 + ks * 1024), hi = vtr(vp + d0 * 4096 + ks * 1024 + 512);
            const bf16x8 vf = __builtin_shufflevector(lo, hi, 0, 1, 2, 3, 4, 5, 6, 7);
            o[d0] = ATT_MFMA(pa[ks], vf, o[d0]);
        }
    __builtin_amdgcn_s_setprio(0);
}
__device__ __forceinline__ bf16x8 pack8(const f32x16& p, int base) {
    u32x4 w; w.x = cvtpk(p[base], p[base + 1]); w.y = cvtpk(p[base + 2], p[base + 3]); w.z = cvtpk(p[base + 4], p[base + 5]); w.w = cvtpk(p[base + 6], p[base + 7]);
    return __builtin_bit_cast(bf16x8, w);
}
__device__ __forceinline__ void store_o(const f32x16 (&o)[2], const float (&rs)[16], LAS unsigned char* lds, int wid, int lane, bf16_t* Ow) {
    const int r32 = lane & 31, hi = lane >> 5;
    LAS bf16_t* stg = (LAS bf16_t*)(lds + OST_OFF + wid * WREG);
#pragma unroll
    for (int r = 0; r < 16; ++r) { const int orow = crow(r, hi);
#pragma unroll
        for (int d0 = 0; d0 < 2; ++d0) { const unsigned w = cvtpk(o[d0][r] * rs[r], 0.f); stg[orow * 64 + d0 * 32 + r32] = (bf16_t)(w & 0xffffu); } }
    asm volatile("s_waitcnt lgkmcnt(0)" ::: "memory");
#pragma unroll
    for (int i = 0; i < 4; ++i) { const int row = i * 8 + (lane >> 3), ch = lane & 7; const u32x4 v = *(const LAS u32x4*)(stg + row * 64 + ch * 8); *(u32x4*)(Ow + (size_t)row * 512 + ch * 8) = v; }
    asm volatile("s_waitcnt lgkmcnt(0)" ::: "memory");
}


constexpr int MLA_CONV_PERIOD = 4;
struct Conv {
    const float* w_up; const float* w_down; unsigned char* up8; unsigned char* dn8; int item, step, ctr; bool inflight; f32x4 tv[8];
    static constexpr int I_UP1 = (D_ / 64) * (2 * DFF / 32), I_DN1 = (DFF / 64) * (D_ / 32), NI = NE * (I_UP1 + I_DN1);
    const float* src; unsigned char* dst; int K, N;
    __device__ __forceinline__ bool pending() const { return item < NI; }
    __device__ __forceinline__ void load(int lane) { load_to(tv, lane); }
    __device__ __forceinline__ void load_to(f32x4 (&t)[8], int lane) {
        int r = item;
        if (r < NE * I_UP1) { const int e = r / I_UP1; r %= I_UP1; K = D_; N = 2 * DFF; const int nblk = N / 32, kb = r / nblk, nb = r % nblk; src = w_up + (size_t)e * D_ * 2 * DFF + (size_t)(64 * kb) * N + 32 * nb; dst = up8 + (size_t)e * 2 * DFF * D_ + (size_t)(32 * nb) * K + 64 * kb; }
        else { r -= NE * I_UP1; const int e = r / I_DN1; r %= I_DN1; K = DFF; N = D_; const int nblk = N / 32, kb = r / nblk, nb = r % nblk; src = w_down + (size_t)e * DFF * D_ + (size_t)(64 * kb) * N + 32 * nb; dst = dn8 + (size_t)e * D_ * DFF + (size_t)(32 * nb) * K + 64 * kb; }
        const float* p = src + (size_t)(8 * (lane >> 3)) * N + 4 * (lane & 7);
#pragma unroll
        for (int j = 0; j < 8; ++j) t[j] = *(const f32x4*)(p + (size_t)j * N);
    }
    __device__ __forceinline__ void finish(LAS float* scr, int lane) { finish_from(tv, scr, lane); }
    __device__ __forceinline__ void finish_from(const f32x4 (&t)[8], LAS float*, int lane) {
        unsigned char* q = dst + (size_t)(4 * (lane & 7)) * K + 8 * (lane >> 3);
#pragma unroll
        for (int c4 = 0; c4 < 4; ++c4) {
            u32x2 o; o.x = pk_fp8x4(t[0][c4] * W8_SCALE, t[1][c4] * W8_SCALE, t[2][c4] * W8_SCALE, t[3][c4] * W8_SCALE); o.y = pk_fp8x4(t[4][c4] * W8_SCALE, t[5][c4] * W8_SCALE, t[6][c4] * W8_SCALE, t[7][c4] * W8_SCALE);
            *(u32x2*)(q + (size_t)c4 * K) = o; }
        item += step;
    }
    __device__ __forceinline__ void tick_begin(int lane) { if (!inflight && ctr == 0 && pending()) { load(lane); inflight = true; } }
    __device__ __forceinline__ void tick_end(LAS float* scr, int lane) { if (inflight && ctr == 2) { finish(scr, lane); inflight = false; } ctr = (ctr == MLA_CONV_PERIOD - 1) ? 0 : ctr + 1; }
    __device__ __forceinline__ void flush(LAS float* scr, int lane) { if (inflight) { finish(scr, lane); inflight = false; } ctr = 0; }
    __device__ __forceinline__ void drain(LAS float* scr, int lane) { while (pending()) { f32x4 t2[8]; load_to(t2, lane); finish_from(t2, scr, lane); } }
};
__device__ __forceinline__ void mla_unit(LAS unsigned char* lds, int b, int h, int qb, const bf16_t* QB, const bf16_t* KB, const bf16_t* VB, bf16_t* O, float m0, Conv& cv) {
    const int tid = threadIdx.x, lane = tid & 63, r32 = lane & 31, hi = lane >> 5; const int wid = __builtin_amdgcn_readfirstlane(tid >> 6);
    const size_t rb = (size_t)b * S_; const int q0 = qb * 256;
    const bf16_t* Kh = KB + rb * 768 + h * 96; const bf16_t* Vh = VB + rb * 512 + h * 64;
    bf16x8 qr[6];
    { const bf16_t* qp = QB + (rb + q0 + wid * 32 + r32) * 768 + h * 96 + hi * 8;
#pragma unroll
      for (int d0 = 0; d0 < 6; ++d0) qr[d0] = *(const bf16x8*)(qp + d0 * 16); }
    const int NT = 4 * qb + 4, my_last = 4 * qb + (wid >> 1);
    f32x16 o[2]; float l = 0.f;
#pragma unroll
    for (int r = 0; r < 16; ++r) { o[0][r] = 0.f; o[1][r] = 0.f; }
    f32x16 negm;
#pragma unroll
    for (int r = 0; r < 16; ++r) negm[r] = -m0;
    asm volatile("" : "+v"(negm));
    Stage<12> st;
    st.load(Kh, 768, Vh, 512, 0, wid, lane); st.write(lds, wid, lane);
    __syncthreads();
    LAS float* cscr = (LAS float*)(lds + OST_OFF + wid * WREG);
    for (int t = 0; t < NT; ++t) {
        if (t + 1 < NT) st.load(Kh, 768, Vh, 512, (t + 1) * 64, wid, lane);
        asm volatile("" ::: "memory");
        cv.tick_begin(lane);
        if (t <= my_last) {
            const LAS char* buf = (const LAS char*)(lds + (t & 1) * BUFB);
            const LAS char* kp = buf + hi * 1024 + r32 * 16;
            f32x16 p0, p1;
            __builtin_amdgcn_s_setprio(1);
#pragma unroll
            for (int d0 = 0; d0 < 6; ++d0) { const bf16x8 a0 = *(const LAS bf16x8*)(kp + d0 * 2048), a1 = *(const LAS bf16x8*)(kp + d0 * 2048 + 512);
#ifndef ABL_NOQK
                if (d0 == 0) { p0 = ATT_MFMA(a0, qr[0], negm); p1 = ATT_MFMA(a1, qr[0], negm); }
                else { p0 = ATT_MFMA(a0, qr[d0], p0); p1 = ATT_MFMA(a1, qr[d0], p1); }
#else
                if (d0 == 0) { p0 = negm; p1 = negm; } asm volatile("" :: "v"(a0), "v"(a1));
#endif
            }
            __builtin_amdgcn_s_setprio(0);
            float ls = 0.f;
#ifndef ABL_NOEXP
#pragma unroll
            for (int r = 0; r < 16; ++r) { p0[r] = __builtin_amdgcn_exp2f(p0[r]); p1[r] = __builtin_amdgcn_exp2f(p1[r]); ls += p0[r] + p1[r]; }
#endif
            l += ls;
            bf16x8 pa[4]; pa[0] = pack8(p0, 0); pa[1] = pack8(p0, 8); pa[2] = pack8(p1, 0); pa[3] = pack8(p1, 8);
            const LAS char* vp = buf + 12 * 1024 + ((lane >> 4) & 1) * 32 + (lane & 3) * 8 + (4 * hi + ((lane & 15) >> 2)) * 64;
#ifndef ABL_NOPV
            pv_tile(o, vp, pa);
#else
            asm volatile("" :: "v"(pa[0]), "v"(pa[1]), "v"(pa[2]), "v"(pa[3]), "v"(vp));
#endif
        }
        if (t + 1 < NT) st.write(lds + ((t + 1) & 1) * BUFB, wid, lane);
        cv.tick_end(cscr, lane);
        __syncthreads();
    }
    l += __shfl_xor(l, 32);
    LAS float* wsf = (LAS float*)(lds + WSF_OFF) + wid * 64;
    if (hi == 0) wsf[r32] = l;
    asm volatile("s_waitcnt lgkmcnt(0)" ::: "memory");
    float rs[16];
#pragma unroll
    for (int r = 0; r < 16; ++r) rs[r] = __builtin_amdgcn_rcpf(wsf[crow(r, hi)]);
    store_o(o, rs, lds, wid, lane, O + (rb + q0 + wid * 32) * 512 + h * 64);
}

constexpr float SB_THR = -152.f;
__device__ __forceinline__ void sb_unit(LAS unsigned char* lds, int b, int h, int qb, const bf16_t* proj, bf16_t* O, Conv& cv) {
    const int tid = threadIdx.x, lane = tid & 63, r32 = lane & 31, hi = lane >> 5; const int wid = __builtin_amdgcn_readfirstlane(tid >> 6);
    const size_t rb = (size_t)b * S_; const int q0 = qb * 256;
    const bf16_t* Kh = proj + rb * INWP + C_SBK + h * 64; const bf16_t* Vh = proj + rb * INWP + C_SBV + h * 64;
    bf16x8 qr[4];
    { const bf16_t* qp = proj + (rb + q0 + wid * 32 + r32) * INWP + C_SBQ + h * 64 + hi * 8;
#pragma unroll
      for (int d0 = 0; d0 < 4; ++d0) qr[d0] = *(const bf16x8*)(qp + d0 * 16); }
    const int Ttop = 4 * qb + 3, qw0 = q0 + wid * 32, qabs = qw0 + r32;
    f32x16 o[2]; float carry = 0.f;
#pragma unroll
    for (int r = 0; r < 16; ++r) { o[0][r] = 0.f; o[1][r] = 0.f; }
    volatile LAS int* flg = (volatile LAS int*)(lds + FLG_OFF);
    Stage<8> st;
    st.load(Kh, INWP, Vh, INWP, Ttop * 64, wid, lane); st.write(lds, wid, lane);
    __syncthreads();
    bool alive = true;
    for (int it = 0;; ++it) {
        const int t = Ttop - it;
        if (t > 0) st.load(Kh, INWP, Vh, INWP, (t - 1) * 64, wid, lane);
        asm volatile("" ::: "memory");
        f32x4 ctv[8]; const bool cvp = cv.pending() && (((it + wid) & 1) == 0);
        if (cvp) cv.load_to(ctv, lane);
        if (alive && (64 * t <= qw0 + 30)) {
            const LAS char* buf = (const LAS char*)(lds + (it & 1) * BUFB);
            const LAS char* kp = buf + hi * 1024 + r32 * 16;
            const bool need_mask = (64 * t + 63 >= qw0);
            bf16x8 pa[4];
#pragma unroll
            for (int blk = 1; blk >= 0; --blk) {
                f32x16 p;
#pragma unroll
                for (int r = 0; r < 16; ++r) p[r] = 0.f;
#pragma unroll
                for (int d0 = 0; d0 < 4; ++d0) { const bf16x8 a0 = *(const LAS bf16x8*)(kp + d0 * 2048 + blk * 512); p = ATT_MFMA(a0, qr[d0], p); }
                const int kb0 = 64 * t + 32 * blk + 4 * hi;
                f32x16 s;
#pragma unroll
                for (int r = 0; r < 16; ++r) {
                    const int key = kb0 + (r & 3) + 8 * (r >> 2);
                    const float z = p[r]; const float e = __builtin_amdgcn_exp2f(-fabsf(z)); const float tt = __builtin_amdgcn_logf(1.f + e); float lsv = fminf(-z, 0.f) - tt;
                    if (need_mask && !(key < qabs)) { lsv = 0.f; p[r] = -INFINITY; }
                    s[r] = lsv;
                }
                float T[5]; T[4] = 0.f;
#pragma unroll
                for (int i = 3; i >= 0; --i) T[i] = T[i + 1] + ((s[4 * i] + s[4 * i + 1]) + (s[4 * i + 2] + s[4 * i + 3]));
                float Tp[5]; Tp[4] = 0.f;
#pragma unroll
                for (int i = 0; i < 4; ++i) Tp[i] = __shfl_xor(T[i], 32);
#pragma unroll
                for (int i = 3; i >= 0; --i) {
                    float lat = carry + T[i + 1] + (hi ? Tp[i + 1] : Tp[i]);
#pragma unroll
                    for (int e3 = 3; e3 >= 0; --e3) { const int r = 4 * i + e3; const float lsv = s[r]; p[r] = __builtin_amdgcn_exp2f(lsv + p[r] + lat); lat += lsv; }
                }
                carry += T[0] + Tp[0];
                pa[2 * blk] = pack8(p, 0); pa[2 * blk + 1] = pack8(p, 8);
            }
            const LAS char* vp = buf + 8 * 1024 + ((lane >> 4) & 1) * 32 + (lane & 3) * 8 + (4 * hi + ((lane & 15) >> 2)) * 64;
            pv_tile(o, vp, pa);
            alive = __any(carry > SB_THR);
        }
        if (lane == 0) flg[(it & 1) * 8 + wid] = alive ? 1 : 0;
        if (t > 0) st.write(lds + ((it + 1) & 1) * BUFB, wid, lane);
        if (cvp) cv.finish_from(ctv, (LAS float*)(lds + OST_OFF + wid * WREG), lane);
        __syncthreads();
        if (t == 0) break;
        int any = 0;
#pragma unroll
        for (int w = 0; w < 8; ++w) any |= flg[(it & 1) * 8 + w];
        if (!any) break;
    }
    float rs[16];
#pragma unroll
    for (int r = 0; r < 16; ++r) rs[r] = 1.f;
    store_o(o, rs, lds, wid, lane, O + (rb + q0 + wid * 32) * 512 + h * 64);
}
}

__device__ __forceinline__ void p5_attention(Frame& F, const Args& a) {
    unsigned char* ws = F.ws;
    volatile LAS int* citem = (volatile LAS int*)(F.MISC + MI_CITEM) + F.wave;
    {
        float gm;
        { const float* gq = a.in[8]; const float* gk = a.in[9]; float mq = 0.f, mk = 0.f;
          for (int i = F.lane; i < 96; i += 64) { mq = fmaxf(mq, fabsf(gq[i])); mk = fmaxf(mk, fabsf(gk[i])); }
#pragma unroll
          for (int o = 1; o < 64; o <<= 1) { mq = fmaxf(mq, __shfl_xor(mq, o)); mk = fmaxf(mk, __shfl_xor(mk, o)); }
          gm = 9.79795897f * LOG2E * mq * mk; }
        att::Conv cv; cv.w_up = a.in[16]; cv.w_down = a.in[18]; cv.up8 = (unsigned char*)(ws + WS_WUP); cv.dn8 = (unsigned char*)(ws + WS_WDN);
        cv.item = F.vcu * NWAVES + F.wave; cv.step = F.G * NWAVES; cv.ctr = F.wave % att::MLA_CONV_PERIOD; cv.inflight = false;
#ifdef ABL_NOCONV
        cv.item = att::Conv::NI;
#endif
        for (int v = F.vcu; v < 256; v += F.G) {
            const int bh = v >> 3, s = v & 7, b = bh >> 3, h = bh & 7;
            for (int i = 0; i < 2; ++i) { const int qb = i ? 15 - s : s;
                att::mla_unit(F.lds, b, h, qb, (const bf16_t*)(ws + WS_QB), (const bf16_t*)(ws + WS_KB), (const bf16_t*)(ws + WS_VB), (bf16_t*)(ws + WS_OMLA), gm, cv);
                __syncthreads(); }
        }
        cv.flush((LAS float*)(F.lds + att::OST_OFF + F.wave * att::WREG), F.lane);
        if (F.lane == 0) *citem = cv.item;
    }
    __syncthreads();
#ifdef MEGA_STAMPS
    if (blockIdx.x == 0 && F.tid == 0) ((unsigned long long*)(ws + WS_CTL + 32768))[12] = __builtin_amdgcn_s_memrealtime();
#endif
    {
        att::Conv cv; cv.w_up = a.in[16]; cv.w_down = a.in[18]; cv.up8 = (unsigned char*)(ws + WS_WUP); cv.dn8 = (unsigned char*)(ws + WS_WDN);
        cv.item = __builtin_amdgcn_readfirstlane(*citem); cv.step = F.G * NWAVES; cv.ctr = 0; cv.inflight = false;
        for (int v = F.vcu; v < 256; v += F.G) {
            const int bh = v >> 3, s = v & 7, b = bh >> 3, h = bh & 7;
            for (int i = 0; i < 2; ++i) { const int qb = i ? 15 - s : s;
                att::sb_unit(F.lds, b, h, qb, (const bf16_t*)(ws + WS_PROJ), (bf16_t*)(ws + WS_OSB), cv);
                __syncthreads(); }
        }
        cv.drain((LAS float*)(F.lds + att::OST_OFF + F.wave * att::WREG), F.lane);
    }
}

__device__ __forceinline__ void p8_router(Frame& F, const Args& a) {
    unsigned char* ws = F.ws;
    const float* x1 = a.out; const float* wr = (const float*)(ws + WS_WR); const float* br = a.in[15]; const float* g = a.in[13];
    unsigned char* H2 = (unsigned char*)(ws + WS_H2F8); int* list = (int*)(ws + WS_LIST); float* topw = (float*)(ws + WS_TOPW); int* selo = (int*)(ws + WS_SEL);
    int* cnt = (int*)(ws + WS_CTL) + CW_CNT;
    volatile LAS int* lcnt = (volatile LAS int*)(F.MISC + MI_LCNT); volatile LAS int* lbase = (volatile LAS int*)(F.MISC + MI_BASE);
    const int lane = F.lane, wave = F.wave, tid = F.tid;
    constexpr int WST = 1028;
    LAS float* wt = (LAS float*)F.lds;
    if (F.vcu < M_ / 64) {
        for (int i = tid; i < D_ * NE / 4; i += NTHR) { const f32x4 v = *(const f32x4*)(wr + (size_t)i * 4); const int k = i >> 3, e = (i & 7) * 4;
            wt[(e + 0) * WST + k] = v.x; wt[(e + 1) * WST + k] = v.y; wt[(e + 2) * WST + k] = v.z; wt[(e + 3) * WST + k] = v.w; }
    }
    __syncthreads();
    for (int task = F.vcu; task < M_ / 64; task += F.G) {
        const int T0 = task * 64;
        if (tid < 32) lcnt[tid] = 0;
        __syncthreads();
        int my_e = 0, my_rank = 0; float my_w = 0.f;
        if (wave < 4) {
            const int tk = lane & 15, kp = lane >> 4, tok = T0 + wave * 16 + tk;
            const float* xp = x1 + (size_t)tok * D_ + kp * 256;
            const LAS float* w0 = wt + tk * WST + kp * 256; const LAS float* w1 = w0 + 16 * WST;
            f32x4 acc0 = {0.f, 0.f, 0.f, 0.f}, acc1 = {0.f, 0.f, 0.f, 0.f}; float ssq = 0.f;
#pragma unroll 4
            for (int i = 0; i < 256; i += 4) {
                const f32x4 a4 = *(const f32x4*)(xp + i); const f32x4 b0 = *(const LAS f32x4*)(w0 + i), b1 = *(const LAS f32x4*)(w1 + i);
                ssq += (a4.x * a4.x + a4.y * a4.y) + (a4.z * a4.z + a4.w * a4.w);
#pragma unroll
                for (int j = 0; j < 4; ++j) { acc0 = __builtin_amdgcn_mfma_f32_16x16x4f32(a4[j], b0[j], acc0, 0, 0, 0); acc1 = __builtin_amdgcn_mfma_f32_16x16x4f32(a4[j], b1[j], acc1, 0, 0, 0); }
            }
            ssq += __shfl_xor(ssq, 16); ssq += __shfl_xor(ssq, 32);
            const float rstd = rsqrtf(ssq * (1.f / D_) + EPS);
            const int e0 = lane & 15, grp = lane >> 4;
            const float bia0 = br[e0], bia1 = br[e0 + 16];
#pragma unroll
            for (int j = 0; j < 4; ++j) {
                const float rs = __shfl(rstd, 4 * grp + j);
                float c0 = acc0[j] * rs + bia0, c1 = acc1[j] * rs + bia1;
                float sv[4]; int si[4];
#pragma unroll
                for (int k = 0; k < 4; ++k) {
                    float best = c0; int bi = e0;
                    if (c1 > best) { best = c1; bi = e0 + 16; }
#pragma unroll
                    for (int st_ = 0; st_ < 4; ++st_) { const int ctl = st_ == 0 ? DPP_X1 : st_ == 1 ? DPP_X2 : st_ == 2 ? DPP_HM : DPP_RM;
                        float ob; int oi;
                        if (st_ == 0) { ob = DPP_F(best, DPP_X1); oi = DPP_I(bi, DPP_X1); } else if (st_ == 1) { ob = DPP_F(best, DPP_X2); oi = DPP_I(bi, DPP_X2); } else if (st_ == 2) { ob = DPP_F(best, DPP_HM); oi = DPP_I(bi, DPP_HM); } else { ob = DPP_F(best, DPP_RM); oi = DPP_I(bi, DPP_RM); }
                        (void)ctl; if (ob > best || (ob == best && oi < bi)) { best = ob; bi = oi; } }
                    sv[k] = best; si[k] = bi;
                    if (bi == e0) c0 = -INFINITY; if (bi == e0 + 16) c1 = -INFINITY;
                }
                float ex[4], sum = 0.f;
#pragma unroll
                for (int k = 0; k < 4; ++k) { ex[k] = __expf(sv[k] - sv[0]); sum += ex[k]; }
                const float inv = 1.f / sum;
                if (((lane >> 2) & 3) == j) {
#pragma unroll
                    for (int k = 0; k < 4; ++k) if ((lane & 3) == k) { my_e = si[k]; my_w = ex[k] * inv; }
                }
            }
            my_rank = atomicAdd((int*)&lcnt[my_e], 1);
        } else {
            const f32x4* gr = (const f32x4*)g + lane;
            f32x4 gg[4];
#pragma unroll
            for (int j = 0; j < 4; ++j) gg[j] = gr[64 * j] * X8_SCALE;
            for (int rr = 0; rr < 16; rr += 4) {
                const int t0 = T0 + (wave - 4) * 16 + rr;
                f32x4 v[4][4]; float s[4];
#pragma unroll
                for (int q = 0; q < 4; ++q) { const f32x4* xr = (const f32x4*)(x1 + (size_t)(t0 + q) * D_) + lane;
#pragma unroll
                    for (int j = 0; j < 4; ++j) v[q][j] = xr[64 * j]; }
#pragma unroll
                for (int q = 0; q < 4; ++q) { s[q] = 0.f;
#pragma unroll
                    for (int j = 0; j < 4; ++j) s[q] += (v[q][j].x * v[q][j].x + v[q][j].y * v[q][j].y) + (v[q][j].z * v[q][j].z + v[q][j].w * v[q][j].w); }
#pragma unroll
                for (int q = 0; q < 4; ++q) { const float r = rsqrtf(wave_sum(s[q]) * (1.f / D_) + EPS); unsigned* o = (unsigned*)(H2 + (size_t)(t0 + q) * D_) + lane;
#pragma unroll
                    for (int j = 0; j < 4; ++j) o[64 * j] = pk_fp8x4(v[q][j].x * r * gg[j].x, v[q][j].y * r * gg[j].y, v[q][j].z * r * gg[j].z, v[q][j].w * r * gg[j].w); }
            }
        }
        __syncthreads();
        if (tid < 32) lbase[tid] = lcnt[tid] ? atomicAdd(&cnt[tid], lcnt[tid]) : 0;
        __syncthreads();
        if (wave < 4) {
            const int grp = lane >> 4, jj = (lane >> 2) & 3, kk = lane & 3;
            const int tok = T0 + wave * 16 + 4 * grp + jj, slot = tok * 4 + kk;
            list[(size_t)my_e * M_ + lbase[my_e] + my_rank] = slot; ((float*)(ws + WS_LISTW))[(size_t)my_e * M_ + lbase[my_e] + my_rank] = my_w;
            topw[slot] = my_w; selo[slot] = my_e;
        }
        __syncthreads();
    }
}

struct MoeOrder {
    const bf16_t* A; const bf16_t* Bt; const int* list; volatile LAS unsigned* tab;
    int lda, ldb, nN, nwg, G, c, gather; size_t estride;
    __device__ void init(const bf16_t* A_, int lda_, const bf16_t* Bt_, int ldb_, size_t estride_, int nN_, const int* list_, volatile LAS unsigned* tab_, int gather_, int G_, int c_) {
        A = A_; lda = lda_; Bt = Bt_; ldb = ldb_; estride = estride_; nN = nN_; list = list_; tab = tab_; gather = gather_; G = G_; c = c_; nwg = (int)tab[MI_TPFX + NE] * nN_; }
    __device__ __forceinline__ bool next(int i, pg8::Unit& u) const {
        const long L = (long)i * G + c; if (L >= nwg) return false;
        int wgid = (int)L; { const int q = nwg / 8, r = nwg % 8, xcd = wgid % 8, off = wgid / 8; wgid = (xcd < r ? xcd * (q + 1) : r * (q + 1) + (xcd - r) * q) + off; }
        int e = 0;
        for (int k = 1; k < NE; ++k) if ((int)tab[MI_TPFX + k] * nN <= wgid) e = k;
        const int t0 = (int)tab[MI_TPFX + e], nt = (int)tab[MI_TPFX + e + 1] - t0, idx = wgid - t0 * nN;
        u.e = e; u.pn = idx / nt; u.rt = idx % nt; u.pm = t0 + u.rt; const int left = (int)tab[MI_CNT + e] - u.rt * 256; u.rows = left < 256 ? left : 256; return true;
    }
    __device__ __forceinline__ unsigned a_off(const pg8::Unit& u, int r, int C) const {
        int row;
        if (gather) row = (r < u.rows) ? (list[(size_t)u.e * M_ + u.rt * 256 + r] >> 2) : M_;
        else row = u.pm * 256 + r;
        return (unsigned)((row * lda + C) * 2);
    }
    __device__ __forceinline__ const char* b_base(const pg8::Unit& u) const { return (const char*)(Bt + (size_t)u.e * estride + (size_t)u.pn * 256 * ldb); }
};
__device__ __forceinline__ void moe_table(Frame& F) {
    int* cnt = (int*)(F.ws + WS_CTL) + CW_CNT;
    if (F.tid < NE) F.MISC[MI_CNT + F.tid] = __hip_atomic_load((unsigned*)cnt + F.tid, RLX_AGENT);
    __syncthreads();
    if (F.tid == 0) { unsigned p = 0; for (int e = 0; e < NE; ++e) { F.MISC[MI_TPFX + e] = p; p += (F.MISC[MI_CNT + e] + 255u) >> 8; } F.MISC[MI_TPFX + NE] = p; }
    __syncthreads();
}

__device__ __forceinline__ void p12_combine(Frame& F, const Args& a) {
    const bf16_t* Y = (const bf16_t*)(F.ws + WS_YB); float* out = a.out;
    const int gt = (F.vcu * NWAVES + F.wave) * 64 + F.lane, NGT = F.G * NTHR;
    for (int i = gt; i < M_ * D_ / 8; i += NGT) {
        const int t = i >> 7, c = (i & 127) * 8;
        f32x4 v0 = *(const f32x4*)(out + (size_t)t * D_ + c), v1 = *(const f32x4*)(out + (size_t)t * D_ + c + 4);
#pragma unroll
        for (int k = 0; k < 4; ++k) { const u32x4 w = *(const u32x4*)(Y + (size_t)(t * 4 + k) * D_ + c);
            v0.x += bflo(w.x); v0.y += bfhi(w.x); v0.z += bflo(w.y); v0.w += bfhi(w.y); v1.x += bflo(w.z); v1.y += bfhi(w.z); v1.z += bflo(w.w); v1.w += bfhi(w.w); }
        *(f32x4*)(out + (size_t)t * D_ + c) = v0; *(f32x4*)(out + (size_t)t * D_ + c + 4) = v1;
    }
}

constexpr int N_PHASES = 11;
#ifndef DUP_PHASE
#define DUP_PHASE -1
#endif
__global__ void __launch_bounds__(NTHR, 2) mega(Args args) {
    extern __shared__ __attribute__((aligned(16))) unsigned char lds_raw[];
    Frame F;
    F.lds = (LAS unsigned char*)lds_raw; F.MISC = (volatile LAS unsigned*)(F.lds + LDS_MISC);
    F.tid = threadIdx.x; F.lane = F.tid & 63; F.wave = __builtin_amdgcn_readfirstlane(F.tid >> 6);
    F.G = gridDim.x; { const int bx = blockIdx.x; F.vcu = (F.G % 8 == 0) ? (bx % 8) * (F.G / 8) + bx / 8 : bx; }
    F.ws = args.ws;
    unsigned char* ws = args.ws;
    for (int u = F.tid; u < (LDS_BYTES - LDS_MISC) / 4; u += NTHR) F.MISC[u] = 0u;
    __syncthreads();
    const int lo = args.ph_lo, hi = args.ph_hi;
    XcdBarrier bar; bar.bar = (unsigned*)(ws + WS_CTL) + CW_BAR; bar.x = 0; bar.st = nullptr;
    if (hi - lo > 1) bar = xcd_barrier_post((unsigned*)(ws + WS_CTL) + CW_BAR, F.MISC + MI_BAR);
#define IN(k) (lo <= (k) && (k) < hi)
#ifdef MEGA_STAMPS
#define STAMP(k) do { if (blockIdx.x == 0 && F.tid == 0) ((unsigned long long*)(ws + WS_CTL + 32768))[(k)] = __builtin_amdgcn_s_memrealtime(); } while (0)
#else
#define STAMP(k) do { } while (0)
#endif
#define SEAM(k) do { if (IN(k) && IN((k) + 1)) xcd_barrier(bar); STAMP((k) + 1); } while (0)
    const int cid = (int)blockIdx.x;
    STAMP(0);

    if (IN(0)) { p0_prologue(F, args, 0, 1); SEAM(0); }
    if (IN(1)) {
        pg8::Gemm g{(const bf16_t*)(ws + WS_HB), D_, D_, D_};
        pg8::StaticOrder S; S.init(g.A, D_, (const bf16_t*)(ws + WS_WIN), D_, M_, 4096, F.G, cid);
        pg8::EpiBf16 E{(bf16_t*)(ws + WS_PROJ), INWP};
        pg8::gemm_phase(F.lds, g, S, E);
        SEAM(1);
    }
    if (IN(2)) {
        { pg8::Gemm g{(const bf16_t*)(ws + WS_HB), D_, D_, D_};
          pg8::StaticOrder S; S.init(g.A, D_, (const bf16_t*)(ws + WS_WIN) + (size_t)4096 * D_, D_, M_, 256, F.G, cid);
          pg8::EpiBf16 E{(bf16_t*)(ws + WS_PROJ) + 4096, INWP};
          pg8::gemm_phase(F.lds, g, S, E); }
        { pg8::Gemm g{(const bf16_t*)(ws + WS_PROJ) + C_CQ, INWP, 384, 384};
          pg8::StaticOrder S; S.init(g.A, INWP, (const bf16_t*)(ws + WS_WUQ), 384, M_, 768, F.G, cid, F.G - 64);
          pg8::EpiBf16 E{(bf16_t*)(ws + WS_QRAW), 768};
          pg8::gemm_phase(F.lds, g, S, E); }
        { pg8::Gemm g{(const bf16_t*)(ws + WS_PROJ) + C_CKV, INWP, 256, 256};
          pg8::StaticOrder S; S.init(g.A, INWP, (const bf16_t*)(ws + WS_WUKV), 256, M_, 1024, F.G, cid);
          pg8::EpiBf16 E{(bf16_t*)(ws + WS_KVRAW), 1024};
          pg8::gemm_phase(F.lds, g, S, E); }
        SEAM(2);
    }
    if (IN(3)) { p4_prep(F, args); SEAM(3); }
    if (IN(4)) { p5_attention(F, args); SEAM(4); }
    if (IN(5)) {
        pg8::Gemm g{(const bf16_t*)(ws + WS_OSB), 512, 512, 512};
        pg8::PairOrder S; S.S.init(g.A, 512, (const bf16_t*)(ws + WS_WOSB), 512, M_, D_, F.G, cid); S.a1 = (WS_OMLA - WS_OSB) / 2; S.b1 = (WS_WOMLA - WS_WOSB) / 2;
        pg8::EpiGate2 E{(bf16_t*)(ws + WS_MIX), (const bf16_t*)(ws + WS_PROJ), INWP, C_GSB, C_GMLA};
        pg8::gemm_phase(F.lds, g, S, E);
        SEAM(5);
    }
    if (IN(6)) {
        pg8::Gemm g{(const bf16_t*)(ws + WS_MIX), D_, D_, D_};
        pg8::StaticOrder S; S.init(g.A, D_, (const bf16_t*)(ws + WS_WOUT), D_, M_, D_, F.G, cid);
        pg8::EpiRes E{args.in[0], args.out};
        pg8::gemm_phase(F.lds, g, S, E);
        SEAM(6);
    }
    if (IN(7)) { p8_router(F, args); SEAM(7); }
    if (IN(8)) {
        moe_table(F);
        pg8::Gemm g{(const bf16_t*)(ws + WS_H2F8), D_ / 2, D_ / 2, D_ / 2};
        MoeOrder S; S.init(g.A, D_ / 2, (const bf16_t*)(ws + WS_WUP), D_ / 2, (size_t)2 * DFF * D_ / 2, 8, (const int*)(ws + WS_LIST), F.MISC, 1, F.G, cid);
        pg8::EpiSwiglu8 E{(unsigned char*)(ws + WS_ACT), args.in[17]};
        pg8::gemm_phase<pg8::EpiSwiglu8, MoeOrder, true>(F.lds, g, S, E);
        SEAM(8);
    }
    if (IN(9)) {
        moe_table(F);
        pg8::Gemm g{(const bf16_t*)(ws + WS_ACT), DFF / 2, DFF / 2, DFF / 2};
        MoeOrder S; S.init(g.A, DFF / 2, (const bf16_t*)(ws + WS_WDN), DFF / 2, (size_t)D_ * DFF / 2, 4, (const int*)(ws + WS_LIST), F.MISC, 0, F.G, cid);
        pg8::EpiDown E{(bf16_t*)(ws + WS_YB), args.in[19], (const int*)(ws + WS_LIST), (const float*)(ws + WS_LISTW)};
        pg8::gemm_phase<pg8::EpiDown, MoeOrder, true>(F.lds, g, S, E);
        SEAM(9);
    }
    if (IN(10)) { p12_combine(F, args); STAMP(11); }
#undef IN
#undef SEAM
}
static int g_grid = 0;
static int setup_grid() {
    if (g_grid == 0) {
        int dev = 0, cus = 0;
        if (hipGetDevice(&dev) != hipSuccess || hipDeviceGetAttribute(&cus, hipDeviceAttributeMultiprocessorCount, dev) != hipSuccess) { g_grid = -1; return g_grid; }
        if (hipFuncSetAttribute((const void*)mega, hipFuncAttributeMaxDynamicSharedMemorySize, LDS_BYTES) != hipSuccess) { g_grid = -1; return g_grid; }
        int per_cu = 0;
        (void)hipOccupancyMaxActiveBlocksPerMultiprocessor(&per_cu, (const void*)mega, NTHR, LDS_BYTES);
        (void)hipGetLastError();
        g_grid = cus;
    }
    return g_grid;
}
static void launch_mega(void* const* d_in, void* d_out, void* d_ws, int lo, int hi, hipStream_t stream) {
    Args a; memset(&a, 0, sizeof(a));
    for (int i = 0; i < 20; ++i) a.in[i] = (const float*)d_in[i];
    a.out = (float*)d_out; a.ws = (unsigned char*)d_ws; a.ph_lo = lo; a.ph_hi = hi;
    hipLaunchKernelGGL(mega, dim3(g_grid), dim3(NTHR), LDS_BYTES, stream, a);
}
extern "C" void kernel_launch(void* const* d_in, const int* in_sizes, int n_in, void* d_out, int out_size, void* d_ws, size_t ws_size, hipStream_t stream) {
    if (n_in != 20 || ws_size < WS_OPT_END || out_size != M_ * D_) { fprintf(stderr, "kernel_launch: unexpected arguments\n"); return; }
    if (setup_grid() <= 0) return;
    (void)hipMemsetAsync((char*)d_ws + WS_CTL, 0, CTL_ZERO_BYTES, stream);
#if N_LAUNCH_SPLIT
    for (int p = 0; p < N_PHASES; ++p) { launch_mega(d_in, d_out, d_ws, p, p + 1, stream); if (p == DUP_PHASE) { if (p == 7) (void)hipMemsetAsync((char*)d_ws + WS_CTL, 0, 128, stream); if (p == 10) launch_mega(d_in, d_out, d_ws, 6, 7, stream); launch_mega(d_in, d_out, d_ws, p, p + 1, stream); } }
#else
    launch_mega(d_in, d_out, d_ws, 0, N_PHASES, stream);
#endif
}
```

```cpp
#define N_LAUNCH_SPLIT 0
#include <hip/hip_runtime.h>
#include <hip/hip_bf16.h>
#include <cstdio>
#include <cstdint>
#include <cstring>
#include <cmath>

constexpr int B_ = 4, S_ = 4096, D_ = 1024, M_ = B_ * S_;
constexpr int INW = 4256, INWP = 4352;
constexpr int C_SBQ = 0, C_SBK = 512, C_SBV = 1024, C_CQ = 1536, C_CKV = 1920, C_KR = 2176, C_GSB = 2208, C_GMLA = 3232;
constexpr int NE = 32, TOPK = 4, DFF = 1024;
constexpr float EPS = 1e-6f;
constexpr float LOG2E = 1.4426950408889634f;
constexpr float SB_QSCALE = 0.125f * LOG2E;
constexpr float MLA_QSCALE = 0.10206207261596577f * LOG2E;
constexpr int NWAVES = 8, NTHR = 512;

#define LAS __attribute__((address_space(3)))
#define GAS __attribute__((address_space(1)))
typedef unsigned short bf16_t;
typedef short bf16x8 __attribute__((ext_vector_type(8)));
typedef short s16x4 __attribute__((ext_vector_type(4)));
typedef float f32x4 __attribute__((ext_vector_type(4)));
typedef float f32x16 __attribute__((ext_vector_type(16)));
typedef unsigned u32x4 __attribute__((ext_vector_type(4)));
typedef unsigned u32x2 __attribute__((ext_vector_type(2)));
typedef float f32x2_t __attribute__((ext_vector_type(2)));
typedef __bf16 bf16x2_t __attribute__((ext_vector_type(2)));
typedef int v8i_t __attribute__((ext_vector_type(8)));
constexpr float W8_SCALE = 8.f, X8_SCALE = 8.f;
__device__ __forceinline__ unsigned pk_fp8x4(float a, float b, float c, float d) { unsigned w = 0; w = __builtin_amdgcn_cvt_pk_fp8_f32(a, b, w, false); w = __builtin_amdgcn_cvt_pk_fp8_f32(c, d, w, true); return w; }

__device__ __forceinline__ unsigned cvtpk(float lo, float hi) { f32x2_t v = {lo, hi}; bf16x2_t b = __builtin_convertvector(v, bf16x2_t); return __builtin_bit_cast(unsigned, b); }
__device__ __forceinline__ float bf2f(unsigned short h) { return __uint_as_float(((unsigned)h) << 16); }
__device__ __forceinline__ float bflo(unsigned w) { return __uint_as_float(w << 16); }
__device__ __forceinline__ float bfhi(unsigned w) { return __uint_as_float(w & 0xffff0000u); }
__device__ __forceinline__ float dpp_f(float v, int ctrl) { return v; }
#define DPP_F(v, ctrl) __int_as_float(__builtin_amdgcn_update_dpp(0, __float_as_int(v), (ctrl), 0xF, 0xF, true))
#define DPP_I(v, ctrl) __builtin_amdgcn_update_dpp(0, (v), (ctrl), 0xF, 0xF, true)
#define DPP_X1 0xB1
#define DPP_X2 0x4E
#define DPP_HM 0x141
#define DPP_RM 0x140
__device__ __forceinline__ float wave_sum(float v) {
    v += DPP_F(v, DPP_X1); v += DPP_F(v, DPP_X2); v += DPP_F(v, DPP_HM); v += DPP_F(v, DPP_RM);
    return (__int_as_float(__builtin_amdgcn_readlane(__float_as_int(v), 0)) + __int_as_float(__builtin_amdgcn_readlane(__float_as_int(v), 16)))
         + (__int_as_float(__builtin_amdgcn_readlane(__float_as_int(v), 32)) + __int_as_float(__builtin_amdgcn_readlane(__float_as_int(v), 48)));
}
__device__ __forceinline__ float sum8(float v) { v += DPP_F(v, DPP_X1); v += DPP_F(v, DPP_X2); v += DPP_F(v, DPP_HM); return v; }
__device__ __forceinline__ float sigmoidf_(float x) { return __builtin_amdgcn_rcpf(1.f + __builtin_amdgcn_exp2f(-x * LOG2E)); }

namespace pg8 {
constexpr int BM = 256, BK = 64, HALF = 128, HTB = HALF * BK * 2, STAGE_BYTES = 8 * HTB, NXCD = 8, WGM = 8;
__host__ __device__ __forceinline__ int lds_byte(int r, int c) { const int st = (r >> 4) * 2 + (c >> 5), rr = r & 15, cc = c & 31, ob = rr * 64 + cc * 2; return st * 1024 + (ob ^ (((ob >> 9) & 1) << 5)); }
__host__ __device__ __forceinline__ void stage_rc(int b, int& R, int& C) { const int st = b / 1024, sb = b % 1024, swz = sb ^ (((sb >> 9) & 1) << 5); R = (st >> 1) * 16 + swz / 64; C = (st & 1) * 32 + (swz % 64) / 2; }
__host__ __device__ __forceinline__ int perm32(int rho) { const int n = rho >> 4, i = rho & 15; return 8 * (i >> 2) + 4 * n + (i & 3); }

struct Unit { int pm, pn, e, rows, rt; };
struct Gemm { const bf16_t* A; int lda, ldb, K; };

struct StaticOrder {
    const bf16_t* A; const bf16_t* Bt; int lda, ldb;
    int nM, nN, nwg, G, c;
    __device__ void init(const bf16_t* A_, int lda_, const bf16_t* Bt_, int ldb_, int M, int N, int G_, int c_, int cshift = 0) { A = A_; Bt = Bt_; lda = lda_; ldb = ldb_; nM = M / BM; nN = N / BM; nwg = nM * nN; G = G_; c = (c_ + cshift) % G_; }
    __device__ __forceinline__ bool next(int i, Unit& u) const {
        const long L = (long)i * G + c; if (L >= nwg) return false;
        int wgid = (int)L; { const int q = nwg / NXCD, r = nwg % NXCD, xcd = wgid % NXCD, off = wgid / NXCD; wgid = (xcd < r ? xcd * (q + 1) : r * (q + 1) + (xcd - r) * q) + off; }
        const int nig = WGM * nN, gid = wgid / nig, fm = gid * WGM, gsz = (nM - fm) < WGM ? (nM - fm) : WGM;
        u.pm = fm + ((wgid % nig) % gsz); u.pn = (wgid % nig) / gsz; u.e = 0; u.rows = 256; u.rt = 0; return true;
    }
    __device__ __forceinline__ unsigned a_off(const Unit& u, int r, int C) const { return (unsigned)(((u.pm * BM + r) * lda + C) * 2); }
    __device__ __forceinline__ const char* b_base(const Unit& u) const { return (const char*)(Bt + (size_t)u.pn * BM * ldb); }
};

__device__ __forceinline__ v8i_t ld32_lds(const LAS unsigned char* p) { const u32x4 lo_ = *(const LAS u32x4*)p, hi_ = *(const LAS u32x4*)(p + 1024); return (v8i_t){(int)lo_.x, (int)lo_.y, (int)lo_.z, (int)lo_.w, (int)hi_.x, (int)hi_.y, (int)hi_.z, (int)hi_.w}; }
struct PairOrder {
    StaticOrder S; size_t a1, b1;
    __device__ __forceinline__ bool next(int i, Unit& u) const { if (!S.next(i >> 1, u)) return false; u.e = i & 1; return true; }
    __device__ __forceinline__ unsigned a_off(const Unit& u, int r, int C) const { return S.a_off(u, r, C) + (unsigned)(u.e ? a1 * 2 : 0); }
    __device__ __forceinline__ const char* b_base(const Unit& u) const { return S.b_base(u) + (u.e ? b1 * 2 : 0); }
};
__device__ __forceinline__ void mfma_f8(f32x4& c, const v8i_t a, const v8i_t b, int sa, int sb) {
    asm volatile("v_mfma_scale_f32_16x16x128_f8f6f4 %0, %1, %2, %0, %3, %4 op_sel_hi:[0,0,0]" : "+v"(c) : "v"(a), "v"(b), "v"(sa), "v"(sb));
}
template <bool F8> struct FragT { typedef bf16x8 type; };
template <> struct FragT<true> { typedef v8i_t type; };
template <class Epi, class Sched, bool FP8 = false>
__device__ __forceinline__ void gemm_phase(LAS unsigned char* lds, const Gemm g, const Sched& S, const Epi& E) {
    const int tid = threadIdx.x, wid = __builtin_amdgcn_readfirstlane(tid >> 6), lane = tid & 63, wr = wid >> 2, wc = wid & 3, fr = lane & 15, fq = lane >> 4;
    const int K = g.K, nt = K / BK;
    unsigned voffB[2];
#pragma unroll
    for (int i = 0; i < 2; ++i) { int R, C; stage_rc(tid * 16 + i * 8192, R, C); const int Rb = Epi::PERM ? ((R & ~31) + perm32(R & 31)) : R; voffB[i] = (unsigned)(Rb * g.ldb + C) * 2u; }
#define PG8_AOFF(dst, unit) do { int t_ = tid; asm volatile("" : "+v"(t_)); _Pragma("unroll") for (int i = 0; i < 2; ++i) { int R, C; stage_rc(t_ * 16 + i * 8192, R, C); \
        _Pragma("unroll") for (int h = 0; h < 2; ++h) dst[h][i] = S.a_off(unit, h * HALF + R, C); } } while (0)
    const size_t kstep = (size_t)(BK * 2);
    const size_t hstepB = (size_t)HALF * g.ldb * 2;
    const unsigned ldsw = (unsigned)wid * 1024u;
    const int aoff = lds_byte(wr * 64 + fr, fq * 8), boff = lds_byte(wc * 32 + fr, fq * 8);
#define PG8_SA(b, h) (((b) * 2 + (h)) * HTB)
#define PG8_SB(b, h) ((4 + (b) * 2 + (h)) * HTB)
#define PG8_STAGE(bufoff, gbase, voff) do { _Pragma("unroll") for (int _i = 0; _i < 2; ++_i) \
        __builtin_amdgcn_global_load_lds((const unsigned*)((const char*)(gbase) + (voff)[_i]), (LAS unsigned*)(lds + (bufoff) + ldsw + _i * 8192), 16, 0, 0); } while (0)
#define PG8_LD32(p) ld32_lds((const LAS unsigned char*)(p))
#define PG8_LDA(dst, b, h) do { if constexpr (FP8) { _Pragma("unroll") for (int m = 0; m < 4; ++m) dst[m][0] = __builtin_bit_cast(FT, PG8_LD32(lds + PG8_SA(b, h) + aoff + m * 2048)); } \
        else { _Pragma("unroll") for (int m = 0; m < 4; ++m) _Pragma("unroll") for (int k = 0; k < 2; ++k) dst[m][k] = __builtin_bit_cast(FT, *(const LAS FT*)(lds + PG8_SA(b, h) + aoff + m * 2048 + k * 1024)); } } while (0)
#define PG8_LDB(dst, b, h) do { if constexpr (FP8) { _Pragma("unroll") for (int n = 0; n < 2; ++n) dst[n][0] = __builtin_bit_cast(FT, PG8_LD32(lds + PG8_SB(b, h) + boff + n * 2048)); } \
        else { _Pragma("unroll") for (int n = 0; n < 2; ++n) _Pragma("unroll") for (int k = 0; k < 2; ++k) dst[n][k] = __builtin_bit_cast(FT, *(const LAS FT*)(lds + PG8_SB(b, h) + boff + n * 2048 + k * 1024)); } } while (0)
#define PG8_MMA(ai, bj, At, Bt) do { __builtin_amdgcn_s_setprio(1); \
        if constexpr (FP8) { _Pragma("unroll") for (int m = 0; m < 4; ++m) _Pragma("unroll") for (int n = 0; n < 2; ++n) \
            mfma_f8(acc[ai][bj][m][n], __builtin_bit_cast(v8i_t, Bt[n][0]), __builtin_bit_cast(v8i_t, At[m][0]), 0x7c7c7c7c, 0x7c7c7c7c); } \
        else { _Pragma("unroll") for (int m = 0; m < 4; ++m) _Pragma("unroll") for (int n = 0; n < 2; ++n) _Pragma("unroll") for (int k = 0; k < 2; ++k) \
            acc[ai][bj][m][n] = __builtin_amdgcn_mfma_f32_16x16x32_bf16(__builtin_bit_cast(bf16x8, Bt[n][k]), __builtin_bit_cast(bf16x8, At[m][k]), acc[ai][bj][m][n], 0, 0, 0); } \
        __builtin_amdgcn_s_setprio(0); } while (0)
#define PG8_WAIT_V(n) asm volatile("s_waitcnt vmcnt(" #n ")" ::: "memory")
#define PG8_WAIT_L(n) asm volatile("s_waitcnt lgkmcnt(" #n ")" ::: "memory")
#define PG8_BAR __builtin_amdgcn_s_barrier()
#define PG8_SCHED __builtin_amdgcn_sched_barrier(0)
    Unit cur, nxt; int ui = 0;
    if (!S.next(0, cur)) return;
    f32x4 acc[2][2][4][2];
#pragma unroll
    for (int a = 0; a < 2; ++a)
#pragma unroll
        for (int b = 0; b < 2; ++b)
#pragma unroll
            for (int m = 0; m < 4; ++m)
#pragma unroll
                for (int n = 0; n < 2; ++n) acc[a][b][m][n] = (f32x4){0.f, 0.f, 0.f, 0.f};
    typedef typename FragT<FP8>::type FT; constexpr int NK = FP8 ? 1 : 2;
    FT At[4][NK], B0[2][NK], B1[2][NK];
    const char* Ab = (const char*)g.A;
    const char* cB = S.b_base(cur);
    unsigned vaC[2][2], vaN[2][2];
    PG8_AOFF(vaC, cur);
    PG8_STAGE(PG8_SB(0, 0), cB, voffB); PG8_STAGE(PG8_SB(0, 1), cB + hstepB, voffB); PG8_STAGE(PG8_SA(0, 0), Ab, vaC[0]); PG8_STAGE(PG8_SA(0, 1), Ab, vaC[1]);
    if (wr == 1) PG8_BAR;
    PG8_WAIT_V(2); PG8_BAR;
    PG8_STAGE(PG8_SB(1, 0), cB + kstep, voffB); PG8_STAGE(PG8_SA(1, 0), Ab + kstep, vaC[0]); PG8_STAGE(PG8_SB(1, 1), cB + hstepB + kstep, voffB);
    PG8_WAIT_V(6); PG8_BAR;
    for (;;) {
        const bool has_next = S.next(ui + 1, nxt);
        const char* nB = has_next ? S.b_base(nxt) : cB;
        if (has_next) PG8_AOFF(vaN, nxt);
        else {
#pragma unroll
            for (int h = 0; h < 2; ++h)
#pragma unroll
                for (int i = 0; i < 2; ++i) vaN[h][i] = vaC[h][i]; }
        for (int t = 0; t < nt; t += 2) {
            const bool last = (t == nt - 2);
            const char* kA1 = Ab + (size_t)(t + 1) * kstep;
            const char* kA2 = last ? Ab : Ab + (size_t)(t + 2) * kstep; const char* b2 = last ? nB : cB + (size_t)(t + 2) * kstep;
            const char* kA3 = kA2 + kstep; const char* b3 = b2 + kstep;
            unsigned o2[2][2];
#pragma unroll
            for (int h = 0; h < 2; ++h)
#pragma unroll
                for (int i = 0; i < 2; ++i) o2[h][i] = last ? vaN[h][i] : vaC[h][i];
            PG8_LDB(B0, 0, 0); PG8_LDB(B1, 0, 1); PG8_SCHED; PG8_LDA(At, 0, 0); PG8_STAGE(PG8_SA(1, 1), kA1, vaC[1]);
            PG8_WAIT_V(8); PG8_WAIT_L(0); PG8_BAR; PG8_MMA(0, 0, At, B0); PG8_MMA(0, 1, At, B1); PG8_BAR; PG8_SCHED;
            PG8_LDA(At, 0, 1); PG8_STAGE(PG8_SB(0, 0), b2, voffB); PG8_STAGE(PG8_SB(0, 1), b2 + hstepB, voffB); PG8_STAGE(PG8_SA(0, 0), kA2, o2[0]);
            PG8_WAIT_V(8); PG8_WAIT_L(0); PG8_BAR; PG8_MMA(1, 0, At, B0); PG8_MMA(1, 1, At, B1); PG8_BAR; PG8_SCHED;
            PG8_LDB(B0, 1, 0); PG8_LDB(B1, 1, 1); PG8_SCHED; PG8_LDA(At, 1, 0); PG8_STAGE(PG8_SA(0, 1), kA2, o2[1]);
            PG8_WAIT_V(8); PG8_WAIT_L(0); PG8_BAR; PG8_MMA(0, 0, At, B0); PG8_MMA(0, 1, At, B1); PG8_BAR; PG8_SCHED;
            PG8_LDA(At, 1, 1); PG8_STAGE(PG8_SB(1, 0), b3, voffB); PG8_STAGE(PG8_SB(1, 1), b3 + hstepB, voffB); PG8_STAGE(PG8_SA(1, 0), kA3, o2[0]);
            PG8_WAIT_V(8); PG8_WAIT_L(0); PG8_BAR; PG8_MMA(1, 0, At, B0); PG8_MMA(1, 1, At, B1); PG8_BAR; PG8_SCHED;
        }
        if (wr == 0) PG8_BAR;
        if constexpr (FP8) asm volatile("s_nop 15\n\ts_nop 15" ::: "memory");
        E(acc, cur, wr, wc, fr, fq);
        if (!has_next) break;
#pragma unroll
        for (int a = 0; a < 2; ++a)
#pragma unroll
            for (int b = 0; b < 2; ++b)
#pragma unroll
                for (int m = 0; m < 4; ++m)
#pragma unroll
                    for (int n = 0; n < 2; ++n) acc[a][b][m][n] = (f32x4){0.f, 0.f, 0.f, 0.f};
        cur = nxt; cB = nB; ++ui;
#pragma unroll
        for (int h = 0; h < 2; ++h)
#pragma unroll
            for (int i = 0; i < 2; ++i) vaC[h][i] = vaN[h][i];
        if (wr == 1) PG8_BAR;
    }
    PG8_WAIT_V(0);
    PG8_BAR;
#undef PG8_SA
#undef PG8_AOFF
#undef PG8_SB
#undef PG8_STAGE
#undef PG8_LDA
#undef PG8_LDB
#undef PG8_MMA
#undef PG8_LD32
#undef PG8_WAIT_V
#undef PG8_WAIT_L
#undef PG8_BAR
#undef PG8_SCHED
}

struct EpiBf16 {
    static constexpr bool PERM = true;
    bf16_t* O; int ldc;
    __device__ __forceinline__ void operator()(const f32x4 (&acc)[2][2][4][2], const Unit& u, int wr, int wc, int fr, int fq) const {
        const int row0 = u.pm * BM + wr * 64 + fr, col0 = u.pn * BM + wc * 32 + 8 * fq;
#pragma unroll
        for (int ai = 0; ai < 2; ++ai)
#pragma unroll
            for (int m = 0; m < 4; ++m) { bf16_t* rowp = O + (size_t)(row0 + ai * HALF + m * 16) * ldc + col0;
#pragma unroll
                for (int bj = 0; bj < 2; ++bj) { const f32x4 v0 = acc[ai][bj][m][0], v1 = acc[ai][bj][m][1];
                    u32x4 w; w.x = cvtpk(v0[0], v0[1]); w.y = cvtpk(v0[2], v0[3]); w.z = cvtpk(v1[0], v1[1]); w.w = cvtpk(v1[2], v1[3]);
                    *(u32x4*)(rowp + bj * HALF) = w; } }
    }
};
struct EpiGate2 {
    static constexpr bool PERM = true;
    bf16_t* O; const bf16_t* G; int ldg, gcol0, gcol1;
    __device__ __forceinline__ void operator()(const f32x4 (&acc)[2][2][4][2], const Unit& u, int wr, int wc, int fr, int fq) const {
        const int row0 = u.pm * BM + wr * 64 + fr, col0 = u.pn * BM + wc * 32 + 8 * fq;
        const bool second = u.e != 0; const int gcol = second ? gcol1 : gcol0;
#pragma unroll
        for (int ai = 0; ai < 2; ++ai)
#pragma unroll
            for (int m = 0; m < 4; ++m) { const size_t r = (size_t)(row0 + ai * HALF + m * 16);
#pragma unroll
                for (int bj = 0; bj < 2; ++bj) { const f32x4 v0 = acc[ai][bj][m][0], v1 = acc[ai][bj][m][1];
                    const int c = col0 + bj * HALF;
                    const u32x4 gw = *(const u32x4*)(G + r * ldg + gcol + c);
                    bf16_t* op = O + r * D_ + c;
                    u32x4 pw = {0u, 0u, 0u, 0u}; if (second) pw = *(const u32x4*)op;
                    float o[8];
                    o[0] = sigmoidf_(bflo(gw.x)) * v0[0]; o[1] = sigmoidf_(bfhi(gw.x)) * v0[1]; o[2] = sigmoidf_(bflo(gw.y)) * v0[2]; o[3] = sigmoidf_(bfhi(gw.y)) * v0[3];
                    o[4] = sigmoidf_(bflo(gw.z)) * v1[0]; o[5] = sigmoidf_(bfhi(gw.z)) * v1[1]; o[6] = sigmoidf_(bflo(gw.w)) * v1[2]; o[7] = sigmoidf_(bfhi(gw.w)) * v1[3];
                    o[0] += bflo(pw.x); o[1] += bfhi(pw.x); o[2] += bflo(pw.y); o[3] += bfhi(pw.y); o[4] += bflo(pw.z); o[5] += bfhi(pw.z); o[6] += bflo(pw.w); o[7] += bfhi(pw.w);
                    u32x4 w; w.x = cvtpk(o[0], o[1]); w.y = cvtpk(o[2], o[3]); w.z = cvtpk(o[4], o[5]); w.w = cvtpk(o[6], o[7]);
                    *(u32x4*)op = w; } }
    }
};
struct EpiRes {
    static constexpr bool PERM = false;
    const float* base; float* out;
    __device__ __forceinline__ void operator()(const f32x4 (&acc)[2][2][4][2], const Unit& u, int wr, int wc, int fr, int fq) const {
        const int row0 = u.pm * BM + wr * 64 + fr, col0 = u.pn * BM + wc * 32 + 4 * fq;
#pragma unroll
        for (int ai = 0; ai < 2; ++ai)
#pragma unroll
            for (int m = 0; m < 4; ++m) { const size_t off = (size_t)(row0 + ai * HALF + m * 16) * D_ + col0;
#pragma unroll
                for (int bj = 0; bj < 2; ++bj)
#pragma unroll
                    for (int n = 0; n < 2; ++n) { const f32x4 b = *(const f32x4*)(base + off + bj * HALF + n * 16); *(f32x4*)(out + off + bj * HALF + n * 16) = b + acc[ai][bj][m][n]; } }
    }
};
struct EpiSwiglu {
    static constexpr bool PERM = true;
    bf16_t* act; const float* b_up;
    __device__ __forceinline__ void operator()(const f32x4 (&acc)[2][2][4][2], const Unit& u, int wr, int wc, int fr, int fq) const {
        const int row0 = u.pm * BM + wr * 64 + fr, col0 = u.pn * BM + wc * 32 + 8 * fq;
        const float* bb = b_up + (size_t)u.e * (2 * DFF);
        f32x4 bv[2][2];
#pragma unroll
        for (int bj = 0; bj < 2; ++bj)
#pragma unroll
            for (int n = 0; n < 2; ++n) bv[bj][n] = *(const f32x4*)(bb + col0 + bj * HALF + 4 * n);
#pragma unroll
        for (int ai = 0; ai < 2; ++ai)
#pragma unroll
            for (int m = 0; m < 4; ++m) { bf16_t* rowp = act + (size_t)(row0 + ai * HALF + m * 16) * DFF + (col0 >> 1);
#pragma unroll
                for (int bj = 0; bj < 2; ++bj) { const f32x4 v0 = acc[ai][bj][m][0] + bv[bj][0], v1 = acc[ai][bj][m][1] + bv[bj][1];
                    float a[4];
#pragma unroll
                    for (int p = 0; p < 4; ++p) { float gl = (p < 2) ? v0[2 * p] : v1[2 * p - 4], li = (p < 2) ? v0[2 * p + 1] : v1[2 * p - 3];
                        gl = fminf(gl, 7.f); li = fminf(fmaxf(li, -7.f), 7.f);
                        a[p] = gl * sigmoidf_(1.702f * gl) * (li + 1.f); }
                    u32x2 w; w.x = cvtpk(a[0], a[1]); w.y = cvtpk(a[2], a[3]);
                    *(u32x2*)(rowp + bj * (HALF / 2)) = w; } }
    }
};
struct EpiSwiglu8 {
    static constexpr bool PERM = true;
    unsigned char* act; const float* b_up;
    __device__ __forceinline__ void operator()(const f32x4 (&acc)[2][2][4][2], const Unit& u, int wr, int wc, int fr, int fq) const {
        const int row0 = u.pm * BM + wr * 64 + fr, col0 = u.pn * BM + wc * 32 + 8 * fq;
        const float* bb = b_up + (size_t)u.e * (2 * DFF);
        f32x4 bv[2][2];
#pragma unroll
        for (int bj = 0; bj < 2; ++bj)
#pragma unroll
            for (int n = 0; n < 2; ++n) bv[bj][n] = *(const f32x4*)(bb + col0 + bj * HALF + 4 * n);
#pragma unroll
        for (int ai = 0; ai < 2; ++ai)
#pragma unroll
            for (int m = 0; m < 4; ++m) { unsigned char* rowp = act + (size_t)(row0 + ai * HALF + m * 16) * DFF + (col0 >> 1);
#pragma unroll
                for (int bj = 0; bj < 2; ++bj) { const f32x4 v0 = acc[ai][bj][m][0] + bv[bj][0], v1 = acc[ai][bj][m][1] + bv[bj][1];
                    float a[4];
#pragma unroll
                    for (int p = 0; p < 4; ++p) { float gl = (p < 2) ? v0[2 * p] : v1[2 * p - 4], li = (p < 2) ? v0[2 * p + 1] : v1[2 * p - 3];
                        gl = fminf(gl, 7.f); li = fminf(fmaxf(li, -7.f), 7.f);
                        a[p] = gl * sigmoidf_(1.702f * gl) * fmaf(li, X8_SCALE, X8_SCALE); }
                    *(unsigned*)(rowp + bj * (HALF / 2)) = pk_fp8x4(a[0], a[1], a[2], a[3]); } }
    }
};
struct EpiDown {
    static constexpr bool PERM = true;
    bf16_t* y; const float* b_down; const int* list; const float* listw;
    __device__ __forceinline__ void operator()(const f32x4 (&acc)[2][2][4][2], const Unit& u, int wr, int wc, int fr, int fq) const {
        const int col0 = u.pn * BM + wc * 32 + 8 * fq;
        const float* bb = b_down + (size_t)u.e * D_;
        f32x4 bv[2][2];
#pragma unroll
        for (int bj = 0; bj < 2; ++bj)
#pragma unroll
            for (int n = 0; n < 2; ++n) bv[bj][n] = *(const f32x4*)(bb + col0 + bj * HALF + 4 * n);
        const int* lp = list + (size_t)u.e * M_ + u.rt * BM; const float* lw = listw + (size_t)u.e * M_ + u.rt * BM;
#pragma unroll
        for (int ai = 0; ai < 2; ++ai)
#pragma unroll
            for (int m = 0; m < 4; ++m) { const int r = ai * HALF + wr * 64 + m * 16 + fr;
                if (r < u.rows) { const int slot = lp[r]; const float w = lw[r]; bf16_t* rowp = y + (size_t)slot * D_ + col0;
#pragma unroll
                    for (int bj = 0; bj < 2; ++bj) { const f32x4 v0 = (acc[ai][bj][m][0] + bv[bj][0]) * w, v1 = (acc[ai][bj][m][1] + bv[bj][1]) * w;
                        u32x4 o; o.x = cvtpk(v0[0], v0[1]); o.y = cvtpk(v0[2], v0[3]); o.z = cvtpk(v1[0], v1[1]); o.w = cvtpk(v1[2], v1[3]);
                        *(u32x4*)(rowp + bj * HALF) = o; } } }
    }
};
}
constexpr size_t MiB = 1ull << 20;
constexpr size_t WS_CTL = 0, CTL_ZERO_BYTES = 64 * 1024;
constexpr size_t WS_ROPE = 256 * 1024;
constexpr size_t WS_WR = 3 * MiB;
constexpr size_t WS_LIST = 4 * MiB;
constexpr size_t WS_TOPW = 6 * MiB;
constexpr size_t WS_SEL = 6 * MiB + 512 * 1024;
constexpr size_t WS_LISTW = 594 * MiB;
constexpr size_t WS_WIN = 8 * MiB;
constexpr size_t WS_WUQ = 17 * MiB;
constexpr size_t WS_WUKV = 18 * MiB;
constexpr size_t WS_WOSB = 19 * MiB;
constexpr size_t WS_WOMLA = 20 * MiB;
constexpr size_t WS_WOUT = 21 * MiB;
constexpr size_t WS_WUP = 24 * MiB;
constexpr size_t WS_WDN = 152 * MiB;
constexpr size_t WS_HB = 216 * MiB;
constexpr size_t WS_PROJ = 249 * MiB;
constexpr size_t WS_ACT = WS_PROJ;
constexpr size_t WS_QRAW = 393 * MiB;
constexpr size_t WS_KVRAW = WS_QRAW + 24 * MiB;
constexpr size_t WS_QB = WS_KVRAW + 32 * MiB;
constexpr size_t WS_KB = WS_QB + 24 * MiB;
constexpr size_t WS_VB = WS_KB + 24 * MiB;
constexpr size_t WS_OSB = WS_VB + 16 * MiB;
constexpr size_t WS_OMLA = WS_OSB + 16 * MiB;
constexpr size_t WS_YB = WS_QRAW;
constexpr size_t WS_MIX = 545 * MiB;
constexpr size_t WS_H2F8 = 577 * MiB;
constexpr size_t WS_OPT_END = 596 * MiB;
constexpr int CW_CNT = 0;
constexpr int CW_BAR = 1024;
constexpr int LDS_STAGE = 143360;
constexpr int LDS_MISC = LDS_STAGE;
constexpr int LDS_BYTES = 147456;
constexpr int MI_BAR = 0, MI_TPFX = 16, MI_CNT = 64, MI_FLAG = 128, MI_LCNT = 160, MI_BASE = 192, MI_RSTD = 256, MI_CITEM = 320;

typedef GAS unsigned gu32;
#define RLX_AGENT __ATOMIC_RELAXED, __HIP_MEMORY_SCOPE_AGENT

#define XB_TMO      128
#define XB_XCNT(j)  (256  + 64 * (j))
#define XB_XSUB(j)  (1280 + 64 * (j))
#define XB_XGEN(j)  (2304 + 64 * (j))
#define XB_TOP      3328
#define XB_TOPGEN   3392
#define XCD_BAR_WORDS 3456
#define XB_SPIN_CAP (1u << 18)
__device__ __forceinline__ unsigned xb_ld(unsigned* p)              { return __hip_atomic_load(p, __ATOMIC_RELAXED, __HIP_MEMORY_SCOPE_AGENT); }
__device__ __forceinline__ unsigned xb_add(unsigned* p, unsigned v) { return __hip_atomic_fetch_add(p, v, __ATOMIC_RELAXED, __HIP_MEMORY_SCOPE_AGENT); }
__device__ __forceinline__ unsigned xb_xcc_id() { return (unsigned)__builtin_amdgcn_s_getreg((3 << 11) | 20) & 0xFu; }
#define XB_SPIN(cond, bar) do { unsigned _sp = 0; while (cond) { __builtin_amdgcn_s_sleep(1); \
    if ((++_sp & 255u) == 0u) { if (xb_ld(&(bar)[XB_TMO])) break; if (_sp > XB_SPIN_CAP) { atomicAdd(&(bar)[XB_TMO], 1u); break; } } } } while (0)
struct XcdBarrier { unsigned* bar; unsigned x; volatile LAS unsigned* st; };
__device__ __forceinline__ XcdBarrier xcd_barrier_post(unsigned* bar, volatile LAS unsigned* st) {
    XcdBarrier b; b.bar = bar; b.x = xb_xcc_id(); b.st = st;
    if (threadIdx.x == 0) (void)xb_add(&bar[XB_XCNT(b.x)], 1u);
    return b;
}
__device__ __forceinline__ void xcd_barrier_complete(unsigned* bar, unsigned x, unsigned& nloc, unsigned& nx) {
    const unsigned G = gridDim.x * gridDim.y * gridDim.z;
    unsigned sum, cnt, mine, sp = 0u;
    for (;;) {
        sum = 0u; cnt = 0u; mine = 0u;
#pragma unroll
        for (unsigned j = 0; j < 16; ++j) { const unsigned c = xb_ld(&bar[XB_XCNT(j)]); sum += c; cnt += (c > 0u) ? 1u : 0u; mine = (j == x) ? c : mine; }
        if (sum == G) break;
        __builtin_amdgcn_s_sleep(1);
        if ((++sp & 255u) == 0u) { if (xb_ld(&bar[XB_TMO])) break; if (sp > XB_SPIN_CAP) { atomicAdd(&bar[XB_TMO], 1u); break; } }
    }
    nloc = mine > 0u ? mine : 1u; nx = cnt > 0u ? cnt : 1u;
}
__device__ __forceinline__ void xcd_barrier(const XcdBarrier& b) {
    asm volatile("s_waitcnt vmcnt(0)" ::: "memory");
    __syncthreads();
    if (threadIdx.x == 0) {
        unsigned* bar = b.bar;
        __builtin_amdgcn_s_waitcnt(0);
        unsigned nloc = b.st[0], nx = b.st[1];
        if (nloc == 0u) { xcd_barrier_complete(bar, b.x, nloc, nx); b.st[0] = nloc; b.st[1] = nx; }
        const unsigned old = xb_add(&bar[XB_XSUB(b.x)], 1u);
        const unsigned gen = old / nloc;
        if (old + 1u == (gen + 1u) * nloc) {
            __builtin_amdgcn_fence(__ATOMIC_RELEASE, "agent");
            asm volatile("s_waitcnt vmcnt(0)" ::: "memory");
            const unsigned og = xb_add(&bar[XB_TOP], 1u);
            const unsigned tg = og / nx;
            if (og + 1u == (tg + 1u) * nx) xb_add(&bar[XB_TOPGEN], 1u);
            else XB_SPIN(xb_ld(&bar[XB_TOPGEN]) == tg, bar);
            __builtin_amdgcn_fence(__ATOMIC_ACQUIRE, "agent");
            xb_add(&bar[XB_XGEN(b.x)], 1u);
            asm volatile("s_waitcnt vmcnt(0)" ::: "memory");
        } else {
            XB_SPIN(xb_ld(&bar[XB_XGEN(b.x)]) == gen, bar);
            __builtin_amdgcn_fence(__ATOMIC_ACQUIRE, "agent");
            asm volatile("s_waitcnt vmcnt(0)" ::: "memory");
        }
    }
    __syncthreads();
}

struct Args {
    const float* in[20]; float* out; unsigned char* ws;
    int ph_lo, ph_hi;
};

struct Frame {
    LAS unsigned char* lds; volatile LAS unsigned* MISC;
    int tid, lane, wave, vcu, G;
    unsigned char* ws;
};

__device__ __forceinline__ void p0_transpose_item(const float* W, int K, int N, bf16_t* WT, LAS float* scr, int item, int lane, const float* gk, float cs, int csn) {
    const int nblk = N / 32, kb = item / nblk, nb = item % nblk, k0 = 64 * kb, n0 = 32 * nb;
    const float colsc = (n0 < csn) ? cs : 1.f;
    float tv[32];
#pragma unroll
    for (int i = 0; i < 32; ++i) { const int kk = 2 * i + (lane >> 5); tv[i] = W[(size_t)(k0 + kk) * N + n0 + (lane & 31)]; }
#pragma unroll
    for (int i = 0; i < 32; ++i) { const int kk = 2 * i + (lane >> 5); float v = tv[i] * colsc; if (gk) v *= gk[k0 + kk]; scr[kk * 33 + (lane & 31)] = v; }
    asm volatile("s_waitcnt lgkmcnt(0)" ::: "memory");
    const int c = lane & 7;
#pragma unroll
    for (int j = 0; j < 4; ++j) { const int n = (lane >> 3) + 8 * j; const LAS float* s = scr + (8 * c) * 33 + n;
        u32x4 o; o.x = cvtpk(s[0 * 33], s[1 * 33]); o.y = cvtpk(s[2 * 33], s[3 * 33]); o.z = cvtpk(s[4 * 33], s[5 * 33]); o.w = cvtpk(s[6 * 33], s[7 * 33]);
        *(u32x4*)(WT + (size_t)(n0 + n) * K + k0 + 8 * c) = o; }
    asm volatile("s_waitcnt lgkmcnt(0)" ::: "memory");
}
__device__ __forceinline__ void p0_transpose_item_fp8(const float* W, int K, int N, unsigned char* WT, LAS float* scr, int item, int lane, float cs) {
    const int nblk = N / 32, kb = item / nblk, nb = item % nblk, k0 = 64 * kb, n0 = 32 * nb;
    float tv[32];
#pragma unroll
    for (int i = 0; i < 32; ++i) { const int kk = 2 * i + (lane >> 5); tv[i] = W[(size_t)(k0 + kk) * N + n0 + (lane & 31)]; }
#pragma unroll
    for (int i = 0; i < 32; ++i) { const int kk = 2 * i + (lane >> 5); scr[kk * 33 + (lane & 31)] = tv[i] * cs; }
    asm volatile("s_waitcnt lgkmcnt(0)" ::: "memory");
    const int c = lane & 7;
#pragma unroll
    for (int j = 0; j < 4; ++j) { const int n = (lane >> 3) + 8 * j; const LAS float* s = scr + (8 * c) * 33 + n;
        u32x2 o; o.x = pk_fp8x4(s[0 * 33], s[1 * 33], s[2 * 33], s[3 * 33]); o.y = pk_fp8x4(s[4 * 33], s[5 * 33], s[6 * 33], s[7 * 33]);
        *(u32x2*)(WT + (size_t)(n0 + n) * K + k0 + 8 * c) = o; }
    asm volatile("s_waitcnt lgkmcnt(0)" ::: "memory");
}
__device__ __forceinline__ void rms_row_to_bf16(const float* xrow, const float* g, bf16_t* orow, int lane) {
    const f32x4* xr = (const f32x4*)xrow + lane; const f32x4* gr = (const f32x4*)g + lane;
    f32x4 v[4]; float s = 0.f;
#pragma unroll
    for (int j = 0; j < 4; ++j) { v[j] = xr[64 * j]; s += (v[j].x * v[j].x + v[j].y * v[j].y) + (v[j].z * v[j].z + v[j].w * v[j].w); }
    const float rstd = rsqrtf(wave_sum(s) * (1.f / D_) + EPS);
    u32x2* o8 = (u32x2*)orow + lane;
#pragma unroll
    for (int j = 0; j < 4; ++j) { const f32x4 gg = gr[64 * j]; u32x2 w; w.x = cvtpk(v[j].x * rstd * gg.x, v[j].y * rstd * gg.y); w.y = cvtpk(v[j].z * rstd * gg.z, v[j].w * rstd * gg.w); o8[64 * j] = w; }
}
__device__ __forceinline__ void p0_prologue(Frame& F, const Args& a, int do_moe_w, int do_rest) {
    LAS float* scr = (LAS float*)(F.lds + F.wave * 16384);
    const int gw = F.vcu * NWAVES + F.wave, NGW = F.G * NWAVES;
    unsigned char* ws = F.ws;
    const float* w_in = a.in[3]; const float* g_cq = a.in[4]; const float* w_uq = a.in[5]; const float* g_ckv = a.in[6]; const float* w_ukv = a.in[7];
    const float* w_o_sb = a.in[10]; const float* w_o_mla = a.in[11]; const float* w_out = a.in[12]; const float* g_ffn = a.in[13]; const float* w_router = a.in[14];
    const float* w_up = a.in[16]; const float* w_down = a.in[18];
    constexpr int I_IN = (D_ / 64) * (INW / 32), I_UQ = (384 / 64) * (768 / 32), I_UKV = (256 / 64) * (1024 / 32), I_O = (512 / 64) * (1024 / 32), I_OUT = (1024 / 64) * (1024 / 32);
    constexpr int I_UP1 = (1024 / 64) * (2048 / 32), I_DN1 = (1024 / 64) * (1024 / 32);
    if (do_rest) {
        constexpr int NI = I_IN + I_UQ + I_UKV + 2 * I_O + I_OUT;
        for (int it = gw; it < NI; it += NGW) {
            int r = it;
            if (r < I_IN) { p0_transpose_item(w_in, D_, INW, (bf16_t*)(ws + WS_WIN), scr, r, F.lane, nullptr, SB_QSCALE, 512); continue; } r -= I_IN;
            if (r < I_UQ) { p0_transpose_item(w_uq, 384, 768, (bf16_t*)(ws + WS_WUQ), scr, r, F.lane, g_cq, 1.f, 0); continue; } r -= I_UQ;
            if (r < I_UKV) { p0_transpose_item(w_ukv, 256, 1024, (bf16_t*)(ws + WS_WUKV), scr, r, F.lane, g_ckv, 1.f, 0); continue; } r -= I_UKV;
            if (r < I_O) { p0_transpose_item(w_o_sb, 512, 1024, (bf16_t*)(ws + WS_WOSB), scr, r, F.lane, nullptr, 1.f, 0); continue; } r -= I_O;
            if (r < I_O) { p0_transpose_item(w_o_mla, 512, 1024, (bf16_t*)(ws + WS_WOMLA), scr, r, F.lane, nullptr, 1.f, 0); continue; } r -= I_O;
            p0_transpose_item(w_out, 1024, 1024, (bf16_t*)(ws + WS_WOUT), scr, r, F.lane, nullptr, 1.f, 0);
        }
        { const int gt = gw * 64 + F.lane, NGT = NGW * 64;
          u32x4 z = {0u, 0u, 0u, 0u};
          u32x4* pz = (u32x4*)((bf16_t*)(ws + WS_WIN) + (size_t)INW * D_);
          for (int i = gt; i < (INWP - INW) * D_ * 2 / 16; i += NGT) pz[i] = z;
          u32x4* hz = (u32x4*)((unsigned char*)(ws + WS_H2F8) + (size_t)M_ * D_);
          for (int i = gt; i < D_ / 16; i += NGT) hz[i] = z;
          const int* pos = (const int*)a.in[1]; float* rt = (float*)(ws + WS_ROPE);
          for (int i = gt; i < M_ * 16; i += NGT) { const int row = i >> 4, k = i & 15; const float inv = powf(10000.f, -(float)k / 16.f); const float ang = (float)pos[row] * inv; rt[row * 32 + k] = cosf(ang); rt[row * 32 + 16 + k] = sinf(ang); }
          float* wr = (float*)(ws + WS_WR);
          for (int i = gt; i < D_ * NE; i += NGT) wr[i] = w_router[i] * g_ffn[i >> 5];
        }
        {
            const f32x4* gr = (const f32x4*)a.in[2] + F.lane; f32x4 gg[4];
#pragma unroll
            for (int j = 0; j < 4; ++j) gg[j] = gr[64 * j];
            for (int m = gw; m < M_; m += 4 * NGW) {
                f32x4 v[4][4]; float s[4];
#pragma unroll
                for (int q = 0; q < 4; ++q) { const int row = m + q * NGW; const f32x4* xr = (const f32x4*)(a.in[0] + (size_t)(row < M_ ? row : m) * D_) + F.lane;
#pragma unroll
                    for (int j = 0; j < 4; ++j) v[q][j] = xr[64 * j]; }
#pragma unroll
                for (int q = 0; q < 4; ++q) { s[q] = 0.f;
#pragma unroll
                    for (int j = 0; j < 4; ++j) s[q] += (v[q][j].x * v[q][j].x + v[q][j].y * v[q][j].y) + (v[q][j].z * v[q][j].z + v[q][j].w * v[q][j].w); }
#pragma unroll
                for (int q = 0; q < 4; ++q) { const int row = m + q * NGW; const float r = rsqrtf(wave_sum(s[q]) * (1.f / D_) + EPS);
                    if (row < M_) { u32x2* o8 = (u32x2*)((bf16_t*)(ws + WS_HB) + (size_t)row * D_) + F.lane;
#pragma unroll
                        for (int j = 0; j < 4; ++j) { u32x2 w; w.x = cvtpk(v[q][j].x * r * gg[j].x, v[q][j].y * r * gg[j].y); w.y = cvtpk(v[q][j].z * r * gg[j].z, v[q][j].w * r * gg[j].w); o8[64 * j] = w; } } }
            }
        }
    }
    if (do_moe_w) {
        constexpr int NI = NE * (I_UP1 + I_DN1);
        for (int it = gw; it < NI; it += NGW) {
            int r = it;
            if (r < NE * I_UP1) { const int e = r / I_UP1; p0_transpose_item_fp8(w_up + (size_t)e * D_ * 2 * DFF, D_, 2 * DFF, (unsigned char*)(ws + WS_WUP) + (size_t)e * 2 * DFF * D_, scr, r % I_UP1, F.lane, W8_SCALE); continue; }
            r -= NE * I_UP1;
            { const int e = r / I_DN1; p0_transpose_item_fp8(w_down + (size_t)e * DFF * D_, DFF, D_, (unsigned char*)(ws + WS_WDN) + (size_t)e * D_ * DFF, scr, r % I_DN1, F.lane, W8_SCALE); }
        }
    }
}

__device__ __forceinline__ void ld16bf(const bf16_t* p, float (&v)[16]) {
    const u32x4 a = *(const u32x4*)p, b = *(const u32x4*)(p + 8);
    v[0] = bflo(a.x); v[1] = bfhi(a.x); v[2] = bflo(a.y); v[3] = bfhi(a.y); v[4] = bflo(a.z); v[5] = bfhi(a.z); v[6] = bflo(a.w); v[7] = bfhi(a.w);
    v[8] = bflo(b.x); v[9] = bfhi(b.x); v[10] = bflo(b.y); v[11] = bfhi(b.y); v[12] = bflo(b.z); v[13] = bfhi(b.z); v[14] = bflo(b.w); v[15] = bfhi(b.w);
}
__device__ __forceinline__ void st16bf(bf16_t* p, const float (&v)[16]) {
    u32x4 a, b; a.x = cvtpk(v[0], v[1]); a.y = cvtpk(v[2], v[3]); a.z = cvtpk(v[4], v[5]); a.w = cvtpk(v[6], v[7]);
    b.x = cvtpk(v[8], v[9]); b.y = cvtpk(v[10], v[11]); b.z = cvtpk(v[12], v[13]); b.w = cvtpk(v[14], v[15]);
    *(u32x4*)p = a; *(u32x4*)(p + 8) = b;
}
struct PrepIn { unsigned cq0, cq1, cq2; u32x2 ckv; u32x4 qa, qb, ka, kb, vv; float rope; };
__device__ __forceinline__ void p4_load(PrepIn& in, int row, const bf16_t* proj, const bf16_t* qraw, const bf16_t* kvraw, const float* rope, int lane) {
    const int h = lane >> 3, s = lane & 7;
    const bf16_t* pr = proj + (size_t)row * INWP;
    { const bf16_t* p = pr + C_CQ + lane * 6; in.cq0 = *(const unsigned*)p; in.cq1 = *(const unsigned*)(p + 2); in.cq2 = *(const unsigned*)(p + 4); }
    in.ckv = *(const u32x2*)(pr + C_CKV + lane * 4);
    in.rope = rope[(size_t)row * 32 + (lane & 31)];
    const u32x4 z = {0u, 0u, 0u, 0u};
    in.qa = z; in.qb = z; in.ka = z; in.kb = z;
    if (s < 6) { const bf16_t* q = qraw + (size_t)row * 768 + h * 96 + s * 16; in.qa = *(const u32x4*)q; in.qb = *(const u32x4*)(q + 8);
        const bf16_t* k = (s < 4) ? (kvraw + (size_t)row * 1024 + h * 128 + s * 16) : (pr + C_KR + (s - 4) * 16); in.ka = *(const u32x4*)k; in.kb = *(const u32x4*)(k + 8); }
    in.vv = *(const u32x4*)(kvraw + (size_t)row * 1024 + (lane >> 3) * 128 + 64 + (lane & 7) * 8);
}
__device__ __forceinline__ void unpack16(const u32x4 a, const u32x4 b, float (&v)[16]) {
    v[0] = bflo(a.x); v[1] = bfhi(a.x); v[2] = bflo(a.y); v[3] = bfhi(a.y); v[4] = bflo(a.z); v[5] = bfhi(a.z); v[6] = bflo(a.w); v[7] = bfhi(a.w);
    v[8] = bflo(b.x); v[9] = bfhi(b.x); v[10] = bflo(b.y); v[11] = bfhi(b.y); v[12] = bflo(b.z); v[13] = bfhi(b.z); v[14] = bflo(b.w); v[15] = bfhi(b.w);
}
__device__ __forceinline__ void p4_prep(Frame& F, const Args& a) {
    unsigned char* ws = F.ws;
    const bf16_t* proj = (const bf16_t*)(ws + WS_PROJ); const bf16_t* qraw = (const bf16_t*)(ws + WS_QRAW); const bf16_t* kvraw = (const bf16_t*)(ws + WS_KVRAW);
    bf16_t* QB = (bf16_t*)(ws + WS_QB); bf16_t* KB = (bf16_t*)(ws + WS_KB); bf16_t* VB = (bf16_t*)(ws + WS_VB);
    const float* rope = (const float*)(ws + WS_ROPE); const float* gq = a.in[8]; const float* gk = a.in[9];
    const int gw = F.vcu * NWAVES + F.wave, NGW = F.G * NWAVES, lane = F.lane, h = lane >> 3, s = lane & 7;
    float gqv[16], gkv[16];
#pragma unroll
    for (int j = 0; j < 16; ++j) { gqv[j] = (s < 6) ? gq[s * 16 + j] : 0.f; gkv[j] = (s < 6) ? gk[s * 16 + j] : 0.f; }
    PrepIn cur, nxt;
    if (gw < M_) p4_load(cur, gw, proj, qraw, kvraw, rope, lane);
    for (int row = gw; row < M_; row += NGW) {
        const bool hn = row + NGW < M_;
        if (hn) p4_load(nxt, row + NGW, proj, qraw, kvraw, rope, lane);
        float sq = bflo(cur.cq0) * bflo(cur.cq0) + bfhi(cur.cq0) * bfhi(cur.cq0) + bflo(cur.cq1) * bflo(cur.cq1) + bfhi(cur.cq1) * bfhi(cur.cq1) + bflo(cur.cq2) * bflo(cur.cq2) + bfhi(cur.cq2) * bfhi(cur.cq2);
        float skv = bflo(cur.ckv.x) * bflo(cur.ckv.x) + bfhi(cur.ckv.x) * bfhi(cur.ckv.x) + bflo(cur.ckv.y) * bflo(cur.ckv.y) + bfhi(cur.ckv.y) * bfhi(cur.ckv.y);
        sq = wave_sum(sq); skv = wave_sum(skv);
        const float var_cq = sq * (1.f / 384.f) + EPS;
        const float rstd_ckv = rsqrtf(skv * (1.f / 256.f) + EPS);
        float cs[16], sn[16];
#pragma unroll
        for (int j = 0; j < 16; ++j) { cs[j] = __int_as_float(__builtin_amdgcn_readlane(__float_as_int(cur.rope), j)); sn[j] = __int_as_float(__builtin_amdgcn_readlane(__float_as_int(cur.rope), 16 + j)); }
        {
            float v[16]; unpack16(cur.qa, cur.qb, v);
            float ss = 0.f;
#pragma unroll
            for (int j = 0; j < 16; ++j) ss += v[j] * v[j];
            ss = sum8(ss);
            const float r = rsqrtf(ss * (1.f / 96.f) + EPS * var_cq);
#pragma unroll
            for (int j = 0; j < 16; ++j) v[j] = v[j] * r * gqv[j];
            float o[16];
#pragma unroll
            for (int j = 0; j < 16; ++j) { const float pv = DPP_F(v[j], DPP_X1);
                o[j] = (s == 4) ? (v[j] * cs[j] - pv * sn[j]) : (s == 5) ? (v[j] * cs[j] + pv * sn[j]) : v[j]; o[j] *= MLA_QSCALE; }
            if (s < 6) st16bf(QB + (size_t)row * 768 + h * 96 + s * 16, o);
        }
        {
            float v[16]; unpack16(cur.ka, cur.kb, v);
            if (s < 4) {
#pragma unroll
                for (int j = 0; j < 16; ++j) v[j] *= rstd_ckv; }
            float ss = 0.f;
#pragma unroll
            for (int j = 0; j < 16; ++j) ss += v[j] * v[j];
            ss = sum8(ss);
            const float r = rsqrtf(ss * (1.f / 96.f) + EPS);
#pragma unroll
            for (int j = 0; j < 16; ++j) v[j] = v[j] * r * gkv[j];
            float o[16];
#pragma unroll
            for (int j = 0; j < 16; ++j) { const float pv = DPP_F(v[j], DPP_X1);
                o[j] = (s == 4) ? (v[j] * cs[j] - pv * sn[j]) : (s == 5) ? (v[j] * cs[j] + pv * sn[j]) : v[j]; }
            if (s < 6) st16bf(KB + (size_t)row * 768 + h * 96 + s * 16, o);
            const u32x4 vw = cur.vv;
            u32x4 ow; ow.x = cvtpk(bflo(vw.x) * rstd_ckv, bfhi(vw.x) * rstd_ckv); ow.y = cvtpk(bflo(vw.y) * rstd_ckv, bfhi(vw.y) * rstd_ckv);
            ow.z = cvtpk(bflo(vw.z) * rstd_ckv, bfhi(vw.z) * rstd_ckv); ow.w = cvtpk(bflo(vw.w) * rstd_ckv, bfhi(vw.w) * rstd_ckv);
            *(u32x4*)(VB + (size_t)row * 512 + lane * 8) = ow;
        }
        if (hn) cur = nxt;
    }
}
namespace att {
constexpr int BUFB = 20480;
constexpr int WREG = 8448;
constexpr int OST_OFF = 2 * BUFB;
constexpr int WSF_OFF = OST_OFF + 8 * WREG;
constexpr int FLG_OFF = WSF_OFF + 8 * 256;
__device__ __forceinline__ int crow(int r, int hi) { return (r & 3) + 8 * (r >> 2) + 4 * hi; }
__device__ __forceinline__ s16x4 vtr(const LAS char* p) { typedef short v4i16_t __attribute__((ext_vector_type(4))); return __builtin_bit_cast(s16x4, __builtin_amdgcn_ds_read_tr16_b64_v4i16((LAS v4i16_t*)p)); }
#define ATT_MFMA(a, b, c) __builtin_amdgcn_mfma_f32_32x32x16_bf16((a), (b), (c), 0, 0, 0)

template <int NCH> struct Stage {
    u32x4 k0, k1, v0;
    __device__ __forceinline__ void load(const bf16_t* Kb, int pitchK, const bf16_t* Vb, int pitchV, int key0, int wid, int lane) {
        k0 = *(const u32x4*)(Kb + (size_t)(key0 + lane) * pitchK + wid * 8);
        if (NCH > 8) { if (wid < NCH - 8) k1 = *(const u32x4*)(Kb + (size_t)(key0 + lane) * pitchK + (8 + wid) * 8); }
        v0 = *(const u32x4*)(Vb + (size_t)(key0 + 16 * (wid & 3) + (lane >> 2)) * pitchV + (wid >> 2) * 32 + (lane & 3) * 8);
    }
    __device__ __forceinline__ void write(LAS unsigned char* buf, int wid, int lane) const {
        *(LAS u32x4*)(buf + wid * 1024 + lane * 16) = k0;
        if (NCH > 8) { if (wid < NCH - 8) *(LAS u32x4*)(buf + (8 + wid) * 1024 + lane * 16) = k1; }
        *(LAS u32x4*)(buf + NCH * 1024 + wid * 1024 + lane * 16) = v0;
    }
};

__device__ __forceinline__ void pv_tile(f32x16 (&o)[2], const LAS char* vp, const bf16x8 (&pa)[4]) {
    __builtin_amdgcn_s_setprio(1);
#pragma unroll
    for (int d0 = 0; d0 < 2; ++d0)
#pragma unroll
        for (int ks = 0; ks < 4; ++ks) {
            const s16x4 lo = vtr(vp + d0 * 4096 + ks * 1024), hi = vtr(vp + d0 * 4096 + ks * 1024 + 512);
            const bf16x8 vf = __builtin_shufflevector(lo, hi, 0, 1, 2, 3, 4, 5, 6, 7);
            o[d0] = ATT_MFMA(pa[ks], vf, o[d0]);
        }
    __builtin_amdgcn_s_setprio(0);
}
__device__ __forceinline__ bf16x8 pack8(const f32x16& p, int base) {
    u32x4 w; w.x = cvtpk(p[base], p[base + 1]); w.y = cvtpk(p[base + 2], p[base + 3]); w.z = cvtpk(p[base + 4], p[base + 5]); w.w = cvtpk(p[base + 6], p[base + 7]);
    return __builtin_bit_cast(bf16x8, w);
}
__device__ __forceinline__ void store_o(const f32x16 (&o)[2], const float (&rs)[16], LAS unsigned char* lds, int wid, int lane, bf16_t* Ow) {
    const int r32 = lane & 31, hi = lane >> 5;
    LAS bf16_t* stg = (LAS bf16_t*)(lds + OST_OFF + wid * WREG);
#pragma unroll
    for (int r = 0; r < 16; ++r) { const int orow = crow(r, hi);
#pragma unroll
        for (int d0 = 0; d0 < 2; ++d0) { const unsigned w = cvtpk(o[d0][r] * rs[r], 0.f); stg[orow * 64 + d0 * 32 + r32] = (bf16_t)(w & 0xffffu); } }
    asm volatile("s_waitcnt lgkmcnt(0)" ::: "memory");
#pragma unroll
    for (int i = 0; i < 4; ++i) { const int row = i * 8 + (lane >> 3), ch = lane & 7; const u32x4 v = *(const LAS u32x4*)(stg + row * 64 + ch * 8); *(u32x4*)(Ow + (size_t)row * 512 + ch * 8) = v; }
    asm volatile("s_waitcnt lgkmcnt(0)" ::: "memory");
}


constexpr int MLA_CONV_PERIOD = 4;
struct Conv {
    const float* w_up; const float* w_down; unsigned char* up8; unsigned char* dn8; int item, step, ctr; bool inflight; f32x4 tv[8];
    static constexpr int I_UP1 = (D_ / 64) * (2 * DFF / 32), I_DN1 = (DFF / 64) * (D_ / 32), NI = NE * (I_UP1 + I_DN1);
    const float* src; unsigned char* dst; int K, N;
    __device__ __forceinline__ bool pending() const { return item < NI; }
    __device__ __forceinline__ void load(int lane) { load_to(tv, lane); }
    __device__ __forceinline__ void load_to(f32x4 (&t)[8], int lane) {
        int r = item;
        if (r < NE * I_UP1) { const int e = r / I_UP1; r %= I_UP1; K = D_; N = 2 * DFF; const int nblk = N / 32, kb = r / nblk, nb = r % nblk; src = w_up + (size_t)e * D_ * 2 * DFF + (size_t)(64 * kb) * N + 32 * nb; dst = up8 + (size_t)e * 2 * DFF * D_ + (size_t)(32 * nb) * K + 64 * kb; }
        else { r -= NE * I_UP1; const int e = r / I_DN1; r %= I_DN1; K = DFF; N = D_; const int nblk = N / 32, kb = r / nblk, nb = r % nblk; src = w_down + (size_t)e * DFF * D_ + (size_t)(64 * kb) * N + 32 * nb; dst = dn8 + (size_t)e * D_ * DFF + (size_t)(32 * nb) * K + 64 * kb; }
        const float* p = src + (size_t)(8 * (lane >> 3)) * N + 4 * (lane & 7);
#pragma unroll
        for (int j = 0; j < 8; ++j) t[j] = *(const f32x4*)(p + (size_t)j * N);
    }
    __device__ __forceinline__ void finish(LAS float* scr, int lane) { finish_from(tv, scr, lane); }
    __device__ __forceinline__ void finish_from(const f32x4 (&t)[8], LAS float*, int lane) {
        unsigned char* q = dst + (size_t)(4 * (lane & 7)) * K + 8 * (lane >> 3);
#pragma unroll
        for (int c4 = 0; c4 < 4; ++c4) {
            u32x2 o; o.x = pk_fp8x4(t[0][c4] * W8_SCALE, t[1][c4] * W8_SCALE, t[2][c4] * W8_SCALE, t[3][c4] * W8_SCALE); o.y = pk_fp8x4(t[4][c4] * W8_SCALE, t[5][c4] * W8_SCALE, t[6][c4] * W8_SCALE, t[7][c4] * W8_SCALE);
            *(u32x2*)(q + (size_t)c4 * K) = o; }
        item += step;
    }
    __device__ __forceinline__ void tick_begin(int lane) { if (!inflight && ctr == 0 && pending()) { load(lane); inflight = true; } }
    __device__ __forceinline__ void tick_end(LAS float* scr, int lane) { if (inflight && ctr == 2) { finish(scr, lane); inflight = false; } ctr = (ctr == MLA_CONV_PERIOD - 1) ? 0 : ctr + 1; }
    __device__ __forceinline__ void flush(LAS float* scr, int lane) { if (inflight) { finish(scr, lane); inflight = false; } ctr = 0; }
    __device__ __forceinline__ void drain(LAS float* scr, int lane) { while (pending()) { f32x4 t2[8]; load_to(t2, lane); finish_from(t2, scr, lane); } }
};
__device__ __forceinline__ void mla_unit(LAS unsigned char* lds, int b, int h, int qb, const bf16_t* QB, const bf16_t* KB, const bf16_t* VB, bf16_t* O, float m0, Conv& cv) {
    const int tid = threadIdx.x, lane = tid & 63, r32 = lane & 31, hi = lane >> 5; const int wid = __builtin_amdgcn_readfirstlane(tid >> 6);
    const size_t rb = (size_t)b * S_; const int q0 = qb * 256;
    const bf16_t* Kh = KB + rb * 768 + h * 96; const bf16_t* Vh = VB + rb * 512 + h * 64;
    bf16x8 qr[6];
    { const bf16_t* qp = QB + (rb + q0 + wid * 32 + r32) * 768 + h * 96 + hi * 8;
#pragma unroll
      for (int d0 = 0; d0 < 6; ++d0) qr[d0] = *(const bf16x8*)(qp + d0 * 16); }
    const int NT = 4 * qb + 4, my_last = 4 * qb + (wid >> 1);
    f32x16 o[2]; float l = 0.f;
#pragma unroll
    for (int r = 0; r < 16; ++r) { o[0][r] = 0.f; o[1][r] = 0.f; }
    f32x16 negm;
#pragma unroll
    for (int r = 0; r < 16; ++r) negm[r] = -m0;
    asm volatile("" : "+v"(negm));
    Stage<12> st;
    st.load(Kh, 768, Vh, 512, 0, wid, lane); st.write(lds, wid, lane);
    __syncthreads();
    LAS float* cscr = (LAS float*)(lds + OST_OFF + wid * WREG);
    for (int t = 0; t < NT; ++t) {
        if (t + 1 < NT) st.load(Kh, 768, Vh, 512, (t + 1) * 64, wid, lane);
        asm volatile("" ::: "memory");
        cv.tick_begin(lane);
        if (t <= my_last) {
            const LAS char* buf = (const LAS char*)(lds + (t & 1) * BUFB);
            const LAS char* kp = buf + hi * 1024 + r32 * 16;
            f32x16 p0, p1;
            __builtin_amdgcn_s_setprio(1);
#pragma unroll
            for (int d0 = 0; d0 < 6; ++d0) { const bf16x8 a0 = *(const LAS bf16x8*)(kp + d0 * 2048), a1 = *(const LAS bf16x8*)(kp + d0 * 2048 + 512);
#ifndef ABL_NOQK
                if (d0 == 0) { p0 = ATT_MFMA(a0, qr[0], negm); p1 = ATT_MFMA(a1, qr[0], negm); }
                else { p0 = ATT_MFMA(a0, qr[d0], p0); p1 = ATT_MFMA(a1, qr[d0], p1); }
#else
                if (d0 == 0) { p0 = negm; p1 = negm; } asm volatile("" :: "v"(a0), "v"(a1));
#endif
            }
            __builtin_amdgcn_s_setprio(0);
            float ls = 0.f;
#ifndef ABL_NOEXP
#pragma unroll
            for (int r = 0; r < 16; ++r) { p0[r] = __builtin_amdgcn_exp2f(p0[r]); p1[r] = __builtin_amdgcn_exp2f(p1[r]); ls += p0[r] + p1[r]; }
#endif
            l += ls;
            bf16x8 pa[4]; pa[0] = pack8(p0, 0); pa[1] = pack8(p0, 8); pa[2] = pack8(p1, 0); pa[3] = pack8(p1, 8);
            const LAS char* vp = buf + 12 * 1024 + ((lane >> 4) & 1) * 32 + (lane & 3) * 8 + (4 * hi + ((lane & 15) >> 2)) * 64;
#ifndef ABL_NOPV
            pv_tile(o, vp, pa);
#else
            asm volatile("" :: "v"(pa[0]), "v"(pa[1]), "v"(pa[2]), "v"(pa[3]), "v"(vp));
#endif
        }
        if (t + 1 < NT) st.write(lds + ((t + 1) & 1) * BUFB, wid, lane);
        cv.tick_end(cscr, lane);
        __syncthreads();
    }
    l += __shfl_xor(l, 32);
    LAS float* wsf = (LAS float*)(lds + WSF_OFF) + wid * 64;
    if (hi == 0) wsf[r32] = l;
    asm volatile("s_waitcnt lgkmcnt(0)" ::: "memory");
    float rs[16];
#pragma unroll
    for (int r = 0; r < 16; ++r) rs[r] = __builtin_amdgcn_rcpf(wsf[crow(r, hi)]);
    store_o(o, rs, lds, wid, lane, O + (rb + q0 + wid * 32) * 512 + h * 64);
}

__device__ __forceinline__ void sb_unit(LAS unsigned char* lds, int b, int h, int qb, const bf16_t* proj, bf16_t* O, Conv& cv) {
    const int tid = threadIdx.x, lane = tid & 63, r32 = lane & 31, hi = lane >> 5; const int wid = __builtin_amdgcn_readfirstlane(tid >> 6);
    const size_t rb = (size_t)b * S_; const int q0 = qb * 256;
    const bf16_t* Kh = proj + rb * INWP + C_SBK + h * 64; const bf16_t* Vh = proj + rb * INWP + C_SBV + h * 64;
    bf16x8 qr[4];
    { const bf16_t* qp = proj + (rb + q0 + wid * 32 + r32) * INWP + C_SBQ + h * 64 + hi * 8;
#pragma unroll
      for (int d0 = 0; d0 < 4; ++d0) qr[d0] = *(const bf16x8*)(qp + d0 * 16); }
    const int Ttop = 4 * qb + 3, qw0 = q0 + wid * 32, qabs = qw0 + r32;
    f32x16 o[2]; float carry = 1.f;
#pragma unroll
    for (int r = 0; r < 16; ++r) { o[0][r] = 0.f; o[1][r] = 0.f; }
    volatile LAS int* flg = (volatile LAS int*)(lds + FLG_OFF);
    Stage<8> st;
    st.load(Kh, INWP, Vh, INWP, Ttop * 64, wid, lane); st.write(lds, wid, lane);
    __syncthreads();
    bool alive = true;
    for (int it = 0;; ++it) {
        const int t = Ttop - it;
        if (t > 0) st.load(Kh, INWP, Vh, INWP, (t - 1) * 64, wid, lane);
        asm volatile("" ::: "memory");
        f32x4 ctv[8]; const bool cvp = cv.pending() && (((it + wid) & 1) == 0);
        if (cvp) cv.load_to(ctv, lane);
        if (alive && (64 * t <= qw0 + 30)) {
            const LAS char* buf = (const LAS char*)(lds + (it & 1) * BUFB);
            const LAS char* kp = buf + hi * 1024 + r32 * 16;
            const bool need_mask = (64 * t + 63 >= qw0);
            bf16x8 pa[4];
#pragma unroll
            for (int blk = 1; blk >= 0; --blk) {
                f32x16 p;
#pragma unroll
                for (int r = 0; r < 16; ++r) p[r] = 0.f;
#pragma unroll
                for (int d0 = 0; d0 < 4; ++d0) { const bf16x8 a0 = *(const LAS bf16x8*)(kp + d0 * 2048 + blk * 512); p = ATT_MFMA(a0, qr[d0], p); }
                const int kb0 = 64 * t + 32 * blk + 4 * hi;
                f32x16 s;
#pragma unroll
                for (int r = 0; r < 16; ++r) {
                    const int key = kb0 + (r & 3) + 8 * (r >> 2);
                    const float tt = __builtin_amdgcn_exp2f(-fmaxf(p[r], -80.f)); float be = __builtin_amdgcn_rcpf(1.f + tt); float sy = tt * be;
                    if (need_mask && !(key < qabs)) { be = 0.f; sy = 1.f; }
                    p[r] = be; s[r] = sy;
                }
                float T[5]; T[4] = 1.f;
#pragma unroll
                for (int i = 3; i >= 0; --i) T[i] = T[i + 1] * ((s[4 * i] * s[4 * i + 1]) * (s[4 * i + 2] * s[4 * i + 3]));
                float Tp[5]; Tp[4] = 1.f;
#pragma unroll
                for (int i = 0; i < 4; ++i) Tp[i] = __shfl_xor(T[i], 32);
#pragma unroll
                for (int i = 3; i >= 0; --i) {
                    float lat = carry * (T[i + 1] * (hi ? Tp[i + 1] : Tp[i]));
#pragma unroll
                    for (int e3 = 3; e3 >= 0; --e3) { const int r = 4 * i + e3; const float sy = s[r]; p[r] = p[r] * lat; lat *= sy; }
                }
                carry *= T[0] * Tp[0];
                pa[2 * blk] = pack8(p, 0); pa[2 * blk + 1] = pack8(p, 8);
            }
            const LAS char* vp = buf + 8 * 1024 + ((lane >> 4) & 1) * 32 + (lane & 3) * 8 + (4 * hi + ((lane & 15) >> 2)) * 64;
            pv_tile(o, vp, pa);
            alive = __any(carry > 0.f);
        }
        if (lane == 0) flg[(it & 1) * 8 + wid] = alive ? 1 : 0;
        if (t > 0) st.write(lds + ((it + 1) & 1) * BUFB, wid, lane);
        if (cvp) cv.finish_from(ctv, (LAS float*)(lds + OST_OFF + wid * WREG), lane);
        __syncthreads();
        if (t == 0) break;
        int any = 0;
#pragma unroll
        for (int w = 0; w < 8; ++w) any |= flg[(it & 1) * 8 + w];
        if (!any) break;
    }
    float rs[16];
#pragma unroll
    for (int r = 0; r < 16; ++r) rs[r] = 1.f;
    store_o(o, rs, lds, wid, lane, O + (rb + q0 + wid * 32) * 512 + h * 64);
}
}

__device__ __forceinline__ void p5_attention(Frame& F, const Args& a) {
    unsigned char* ws = F.ws;
    volatile LAS int* citem = (volatile LAS int*)(F.MISC + MI_CITEM) + F.wave;
    {
        float gm;
        { const float* gq = a.in[8]; const float* gk = a.in[9]; float mq = 0.f, mk = 0.f;
          for (int i = F.lane; i < 96; i += 64) { mq = fmaxf(mq, fabsf(gq[i])); mk = fmaxf(mk, fabsf(gk[i])); }
#pragma unroll
          for (int o = 1; o < 64; o <<= 1) { mq = fmaxf(mq, __shfl_xor(mq, o)); mk = fmaxf(mk, __shfl_xor(mk, o)); }
          gm = 9.79795897f * LOG2E * mq * mk; }
        att::Conv cv; cv.w_up = a.in[16]; cv.w_down = a.in[18]; cv.up8 = (unsigned char*)(ws + WS_WUP); cv.dn8 = (unsigned char*)(ws + WS_WDN);
        cv.item = F.vcu * NWAVES + F.wave; cv.step = F.G * NWAVES; cv.ctr = F.wave % att::MLA_CONV_PERIOD; cv.inflight = false;
#ifdef ABL_NOCONV
        cv.item = att::Conv::NI;
#endif
        for (int v = F.vcu; v < 256; v += F.G) {
            const int bh = v >> 3, s = v & 7, b = bh >> 3, h = bh & 7;
            for (int i = 0; i < 2; ++i) { const int qb = i ? 15 - s : s;
                att::mla_unit(F.lds, b, h, qb, (const bf16_t*)(ws + WS_QB), (const bf16_t*)(ws + WS_KB), (const bf16_t*)(ws + WS_VB), (bf16_t*)(ws + WS_OMLA), gm, cv);
                __syncthreads(); }
        }
        cv.flush((LAS float*)(F.lds + att::OST_OFF + F.wave * att::WREG), F.lane);
        if (F.lane == 0) *citem = cv.item;
    }
    __syncthreads();
#ifdef MEGA_STAMPS
    if (blockIdx.x == 0 && F.tid == 0) ((unsigned long long*)(ws + WS_CTL + 32768))[12] = __builtin_amdgcn_s_memrealtime();
#endif
    {
        att::Conv cv; cv.w_up = a.in[16]; cv.w_down = a.in[18]; cv.up8 = (unsigned char*)(ws + WS_WUP); cv.dn8 = (unsigned char*)(ws + WS_WDN);
        cv.item = __builtin_amdgcn_readfirstlane(*citem); cv.step = F.G * NWAVES; cv.ctr = 0; cv.inflight = false;
        for (int v = F.vcu; v < 256; v += F.G) {
            const int bh = v >> 3, s = v & 7, b = bh >> 3, h = bh & 7;
            for (int i = 0; i < 2; ++i) { const int qb = i ? 15 - s : s;
                att::sb_unit(F.lds, b, h, qb, (const bf16_t*)(ws + WS_PROJ), (bf16_t*)(ws + WS_OSB), cv);
                __syncthreads(); }
        }
        cv.drain((LAS float*)(F.lds + att::OST_OFF + F.wave * att::WREG), F.lane);
    }
}

__device__ __forceinline__ void p8_router(Frame& F, const Args& a) {
    unsigned char* ws = F.ws;
    const float* x1 = a.out; const float* wr = (const float*)(ws + WS_WR); const float* br = a.in[15]; const float* g = a.in[13];
    unsigned char* H2 = (unsigned char*)(ws + WS_H2F8); int* list = (int*)(ws + WS_LIST); float* topw = (float*)(ws + WS_TOPW); int* selo = (int*)(ws + WS_SEL);
    int* cnt = (int*)(ws + WS_CTL) + CW_CNT;
    volatile LAS int* lcnt = (volatile LAS int*)(F.MISC + MI_LCNT); volatile LAS int* lbase = (volatile LAS int*)(F.MISC + MI_BASE);
    const int lane = F.lane, wave = F.wave, tid = F.tid;
    constexpr int WST = 1028;
    LAS float* wt = (LAS float*)F.lds;
    if (F.vcu < M_ / 64) {
        for (int i = tid; i < D_ * NE / 4; i += NTHR) { const f32x4 v = *(const f32x4*)(wr + (size_t)i * 4); const int k = i >> 3, e = (i & 7) * 4;
            wt[(e + 0) * WST + k] = v.x; wt[(e + 1) * WST + k] = v.y; wt[(e + 2) * WST + k] = v.z; wt[(e + 3) * WST + k] = v.w; }
    }
    __syncthreads();
    for (int task = F.vcu; task < M_ / 64; task += F.G) {
        const int T0 = task * 64;
        if (tid < 32) lcnt[tid] = 0;
        __syncthreads();
        int my_e = 0, my_rank = 0; float my_w = 0.f;
        if (wave < 4) {
            const int tk = lane & 15, kp = lane >> 4, tok = T0 + wave * 16 + tk;
            const float* xp = x1 + (size_t)tok * D_ + kp * 256;
            const LAS float* w0 = wt + tk * WST + kp * 256; const LAS float* w1 = w0 + 16 * WST;
            f32x4 acc0 = {0.f, 0.f, 0.f, 0.f}, acc1 = {0.f, 0.f, 0.f, 0.f}; float ssq = 0.f;
#pragma unroll 4
            for (int i = 0; i < 256; i += 4) {
                const f32x4 a4 = *(const f32x4*)(xp + i); const f32x4 b0 = *(const LAS f32x4*)(w0 + i), b1 = *(const LAS f32x4*)(w1 + i);
                ssq += (a4.x * a4.x + a4.y * a4.y) + (a4.z * a4.z + a4.w * a4.w);
#pragma unroll
                for (int j = 0; j < 4; ++j) { acc0 = __builtin_amdgcn_mfma_f32_16x16x4f32(a4[j], b0[j], acc0, 0, 0, 0); acc1 = __builtin_amdgcn_mfma_f32_16x16x4f32(a4[j], b1[j], acc1, 0, 0, 0); }
            }
            ssq += __shfl_xor(ssq, 16); ssq += __shfl_xor(ssq, 32);
            const float rstd = rsqrtf(ssq * (1.f / D_) + EPS);
            const int e0 = lane & 15, grp = lane >> 4;
            const float bia0 = br[e0], bia1 = br[e0 + 16];
#pragma unroll
            for (int j = 0; j < 4; ++j) {
                const float rs = __shfl(rstd, 4 * grp + j);
                float c0 = acc0[j] * rs + bia0, c1 = acc1[j] * rs + bia1;
                float sv[4]; int si[4];
#pragma unroll
                for (int k = 0; k < 4; ++k) {
                    float best = c0; int bi = e0;
                    if (c1 > best) { best = c1; bi = e0 + 16; }
#pragma unroll
                    for (int st_ = 0; st_ < 4; ++st_) { const int ctl = st_ == 0 ? DPP_X1 : st_ == 1 ? DPP_X2 : st_ == 2 ? DPP_HM : DPP_RM;
                        float ob; int oi;
                        if (st_ == 0) { ob = DPP_F(best, DPP_X1); oi = DPP_I(bi, DPP_X1); } else if (st_ == 1) { ob = DPP_F(best, DPP_X2); oi = DPP_I(bi, DPP_X2); } else if (st_ == 2) { ob = DPP_F(best, DPP_HM); oi = DPP_I(bi, DPP_HM); } else { ob = DPP_F(best, DPP_RM); oi = DPP_I(bi, DPP_RM); }
                        (void)ctl; if (ob > best || (ob == best && oi < bi)) { best = ob; bi = oi; } }
                    sv[k] = best; si[k] = bi;
                    if (bi == e0) c0 = -INFINITY; if (bi == e0 + 16) c1 = -INFINITY;
                }
                float ex[4], sum = 0.f;
#pragma unroll
                for (int k = 0; k < 4; ++k) { ex[k] = __expf(sv[k] - sv[0]); sum += ex[k]; }
                const float inv = 1.f / sum;
                if (((lane >> 2) & 3) == j) {
#pragma unroll
                    for (int k = 0; k < 4; ++k) if ((lane & 3) == k) { my_e = si[k]; my_w = ex[k] * inv; }
                }
            }
            my_rank = atomicAdd((int*)&lcnt[my_e], 1);
        } else {
            const f32x4* gr = (const f32x4*)g + lane;
            f32x4 gg[4];
#pragma unroll
            for (int j = 0; j < 4; ++j) gg[j] = gr[64 * j] * X8_SCALE;
            for (int rr = 0; rr < 16; rr += 4) {
                const int t0 = T0 + (wave - 4) * 16 + rr;
                f32x4 v[4][4]; float s[4];
#pragma unroll
                for (int q = 0; q < 4; ++q) { const f32x4* xr = (const f32x4*)(x1 + (size_t)(t0 + q) * D_) + lane;
#pragma unroll
                    for (int j = 0; j < 4; ++j) v[q][j] = xr[64 * j]; }
#pragma unroll
                for (int q = 0; q < 4; ++q) { s[q] = 0.f;
#pragma unroll
                    for (int j = 0; j < 4; ++j) s[q] += (v[q][j].x * v[q][j].x + v[q][j].y * v[q][j].y) + (v[q][j].z * v[q][j].z + v[q][j].w * v[q][j].w); }
#pragma unroll
                for (int q = 0; q < 4; ++q) { const float r = rsqrtf(wave_sum(s[q]) * (1.f / D_) + EPS); unsigned* o = (unsigned*)(H2 + (size_t)(t0 + q) * D_) + lane;
#pragma unroll
                    for (int j = 0; j < 4; ++j) o[64 * j] = pk_fp8x4(v[q][j].x * r * gg[j].x, v[q][j].y * r * gg[j].y, v[q][j].z * r * gg[j].z, v[q][j].w * r * gg[j].w); }
            }
        }
        __syncthreads();
        if (tid < 32) lbase[tid] = lcnt[tid] ? atomicAdd(&cnt[tid], lcnt[tid]) : 0;
        __syncthreads();
        if (wave < 4) {
            const int grp = lane >> 4, jj = (lane >> 2) & 3, kk = lane & 3;
            const int tok = T0 + wave * 16 + 4 * grp + jj, slot = tok * 4 + kk;
            list[(size_t)my_e * M_ + lbase[my_e] + my_rank] = slot; ((float*)(ws + WS_LISTW))[(size_t)my_e * M_ + lbase[my_e] + my_rank] = my_w;
            topw[slot] = my_w; selo[slot] = my_e;
        }
        __syncthreads();
    }
}

struct MoeOrder {
    const bf16_t* A; const bf16_t* Bt; const int* list; volatile LAS unsigned* tab;
    int lda, ldb, nN, nwg, G, c, gather; size_t estride;
    __device__ void init(const bf16_t* A_, int lda_, const bf16_t* Bt_, int ldb_, size_t estride_, int nN_, const int* list_, volatile LAS unsigned* tab_, int gather_, int G_, int c_) {
        A = A_; lda = lda_; Bt = Bt_; ldb = ldb_; estride = estride_; nN = nN_; list = list_; tab = tab_; gather = gather_; G = G_; c = c_; nwg = (int)tab[MI_TPFX + NE] * nN_; }
    __device__ __forceinline__ bool next(int i, pg8::Unit& u) const {
        const long L = (long)i * G + c; if (L >= nwg) return false;
        int wgid = (int)L; { const int q = nwg / 8, r = nwg % 8, xcd = wgid % 8, off = wgid / 8; wgid = (xcd < r ? xcd * (q + 1) : r * (q + 1) + (xcd - r) * q) + off; }
        int e = 0;
        for (int k = 1; k < NE; ++k) if ((int)tab[MI_TPFX + k] * nN <= wgid) e = k;
        const int t0 = (int)tab[MI_TPFX + e], nt = (int)tab[MI_TPFX + e + 1] - t0, idx = wgid - t0 * nN;
        u.e = e; u.pn = idx / nt; u.rt = idx % nt; u.pm = t0 + u.rt; const int left = (int)tab[MI_CNT + e] - u.rt * 256; u.rows = left < 256 ? left : 256; return true;
    }
    __device__ __forceinline__ unsigned a_off(const pg8::Unit& u, int r, int C) const {
        int row;
        if (gather) row = (r < u.rows) ? (list[(size_t)u.e * M_ + u.rt * 256 + r] >> 2) : M_;
        else row = u.pm * 256 + r;
        return (unsigned)((row * lda + C) * 2);
    }
    __device__ __forceinline__ const char* b_base(const pg8::Unit& u) const { return (const char*)(Bt + (size_t)u.e * estride + (size_t)u.pn * 256 * ldb); }
};
__device__ __forceinline__ void moe_table(Frame& F) {
    int* cnt = (int*)(F.ws + WS_CTL) + CW_CNT;
    if (F.tid < NE) F.MISC[MI_CNT + F.tid] = __hip_atomic_load((unsigned*)cnt + F.tid, RLX_AGENT);
    __syncthreads();
    if (F.tid == 0) { unsigned p = 0; for (int e = 0; e < NE; ++e) { F.MISC[MI_TPFX + e] = p; p += (F.MISC[MI_CNT + e] + 255u) >> 8; } F.MISC[MI_TPFX + NE] = p; }
    __syncthreads();
}

__device__ __forceinline__ void p12_combine(Frame& F, const Args& a) {
    const bf16_t* Y = (const bf16_t*)(F.ws + WS_YB); float* out = a.out;
    const int gt = (F.vcu * NWAVES + F.wave) * 64 + F.lane, NGT = F.G * NTHR;
    for (int i = gt; i < M_ * D_ / 8; i += NGT) {
        const int t = i >> 7, c = (i & 127) * 8;
        f32x4 v0 = *(const f32x4*)(out + (size_t)t * D_ + c), v1 = *(const f32x4*)(out + (size_t)t * D_ + c + 4);
#pragma unroll
        for (int k = 0; k < 4; ++k) { const u32x4 w = *(const u32x4*)(Y + (size_t)(t * 4 + k) * D_ + c);
            v0.x += bflo(w.x); v0.y += bfhi(w.x); v0.z += bflo(w.y); v0.w += bfhi(w.y); v1.x += bflo(w.z); v1.y += bfhi(w.z); v1.z += bflo(w.w); v1.w += bfhi(w.w); }
        *(f32x4*)(out + (size_t)t * D_ + c) = v0; *(f32x4*)(out + (size_t)t * D_ + c + 4) = v1;
    }
}

constexpr int N_PHASES = 11;
#ifndef DUP_PHASE
#define DUP_PHASE -1
#endif
__global__ void __launch_bounds__(NTHR, 2) mega(Args args) {
    extern __shared__ __attribute__((aligned(16))) unsigned char lds_raw[];
    Frame F;
    F.lds = (LAS unsigned char*)lds_raw; F.MISC = (volatile LAS unsigned*)(F.lds + LDS_MISC);
    F.tid = threadIdx.x; F.lane = F.tid & 63; F.wave = __builtin_amdgcn_readfirstlane(F.tid >> 6);
    F.G = gridDim.x; { const int bx = blockIdx.x; F.vcu = (F.G % 8 == 0) ? (bx % 8) * (F.G / 8) + bx / 8 : bx; }
    F.ws = args.ws;
    unsigned char* ws = args.ws;
    for (int u = F.tid; u < (LDS_BYTES - LDS_MISC) / 4; u += NTHR) F.MISC[u] = 0u;
    __syncthreads();
    const int lo = args.ph_lo, hi = args.ph_hi;
    XcdBarrier bar; bar.bar = (unsigned*)(ws + WS_CTL) + CW_BAR; bar.x = 0; bar.st = nullptr;
    if (hi - lo > 1) bar = xcd_barrier_post((unsigned*)(ws + WS_CTL) + CW_BAR, F.MISC + MI_BAR);
#define IN(k) (lo <= (k) && (k) < hi)
#ifdef MEGA_STAMPS
#define STAMP(k) do { if (blockIdx.x == 0 && F.tid == 0) ((unsigned long long*)(ws + WS_CTL + 32768))[(k)] = __builtin_amdgcn_s_memrealtime(); } while (0)
#else
#define STAMP(k) do { } while (0)
#endif
#define SEAM(k) do { if (IN(k) && IN((k) + 1)) xcd_barrier(bar); STAMP((k) + 1); } while (0)
    const int cid = (int)blockIdx.x;
    STAMP(0);

    if (IN(0)) { p0_prologue(F, args, 0, 1); SEAM(0); }
    if (IN(1)) {
        pg8::Gemm g{(const bf16_t*)(ws + WS_HB), D_, D_, D_};
        pg8::StaticOrder S; S.init(g.A, D_, (const bf16_t*)(ws + WS_WIN), D_, M_, 4096, F.G, cid);
        pg8::EpiBf16 E{(bf16_t*)(ws + WS_PROJ), INWP};
        pg8::gemm_phase(F.lds, g, S, E);
        SEAM(1);
    }
    if (IN(2)) {
        { pg8::Gemm g{(const bf16_t*)(ws + WS_HB), D_, D_, D_};
          pg8::StaticOrder S; S.init(g.A, D_, (const bf16_t*)(ws + WS_WIN) + (size_t)4096 * D_, D_, M_, 256, F.G, cid);
          pg8::EpiBf16 E{(bf16_t*)(ws + WS_PROJ) + 4096, INWP};
          pg8::gemm_phase(F.lds, g, S, E); }
        { pg8::Gemm g{(const bf16_t*)(ws + WS_PROJ) + C_CQ, INWP, 384, 384};
          pg8::StaticOrder S; S.init(g.A, INWP, (const bf16_t*)(ws + WS_WUQ), 384, M_, 768, F.G, cid, F.G - 64);
          pg8::EpiBf16 E{(bf16_t*)(ws + WS_QRAW), 768};
          pg8::gemm_phase(F.lds, g, S, E); }
        { pg8::Gemm g{(const bf16_t*)(ws + WS_PROJ) + C_CKV, INWP, 256, 256};
          pg8::StaticOrder S; S.init(g.A, INWP, (const bf16_t*)(ws + WS_WUKV), 256, M_, 1024, F.G, cid);
          pg8::EpiBf16 E{(bf16_t*)(ws + WS_KVRAW), 1024};
          pg8::gemm_phase(F.lds, g, S, E); }
        SEAM(2);
    }
    if (IN(3)) { p4_prep(F, args); SEAM(3); }
    if (IN(4)) { p5_attention(F, args); SEAM(4); }
    if (IN(5)) {
        pg8::Gemm g{(const bf16_t*)(ws + WS_OSB), 512, 512, 512};
        pg8::PairOrder S; S.S.init(g.A, 512, (const bf16_t*)(ws + WS_WOSB), 512, M_, D_, F.G, cid); S.a1 = (WS_OMLA - WS_OSB) / 2; S.b1 = (WS_WOMLA - WS_WOSB) / 2;
        pg8::EpiGate2 E{(bf16_t*)(ws + WS_MIX), (const bf16_t*)(ws + WS_PROJ), INWP, C_GSB, C_GMLA};
        pg8::gemm_phase(F.lds, g, S, E);
        SEAM(5);
    }
    if (IN(6)) {
        pg8::Gemm g{(const bf16_t*)(ws + WS_MIX), D_, D_, D_};
        pg8::StaticOrder S; S.init(g.A, D_, (const bf16_t*)(ws + WS_WOUT), D_, M_, D_, F.G, cid);
        pg8::EpiRes E{args.in[0], args.out};
        pg8::gemm_phase(F.lds, g, S, E);
        SEAM(6);
    }
    if (IN(7)) { p8_router(F, args); SEAM(7); }
    if (IN(8)) {
        moe_table(F);
        pg8::Gemm g{(const bf16_t*)(ws + WS_H2F8), D_ / 2, D_ / 2, D_ / 2};
        MoeOrder S; S.init(g.A, D_ / 2, (const bf16_t*)(ws + WS_WUP), D_ / 2, (size_t)2 * DFF * D_ / 2, 8, (const int*)(ws + WS_LIST), F.MISC, 1, F.G, cid);
        pg8::EpiSwiglu8 E{(unsigned char*)(ws + WS_ACT), args.in[17]};
        pg8::gemm_phase<pg8::EpiSwiglu8, MoeOrder, true>(F.lds, g, S, E);
        SEAM(8);
    }
    if (IN(9)) {
        moe_table(F);
        pg8::Gemm g{(const bf16_t*)(ws + WS_ACT), DFF / 2, DFF / 2, DFF / 2};
        MoeOrder S; S.init(g.A, DFF / 2, (const bf16_t*)(ws + WS_WDN), DFF / 2, (size_t)D_ * DFF / 2, 4, (const int*)(ws + WS_LIST), F.MISC, 0, F.G, cid);
        pg8::EpiDown E{(bf16_t*)(ws + WS_YB), args.in[19], (const int*)(ws + WS_LIST), (const float*)(ws + WS_LISTW)};
        pg8::gemm_phase<pg8::EpiDown, MoeOrder, true>(F.lds, g, S, E);
        SEAM(9);
    }
    if (IN(10)) { p12_combine(F, args); STAMP(11); }
#undef IN
#undef SEAM
}
static int g_grid = 0;
static int setup_grid() {
    if (g_grid == 0) {
        int dev = 0, cus = 0;
        if (hipGetDevice(&dev) != hipSuccess || hipDeviceGetAttribute(&cus, hipDeviceAttributeMultiprocessorCount, dev) != hipSuccess) { g_grid = -1; return g_grid; }
        if (hipFuncSetAttribute((const void*)mega, hipFuncAttributeMaxDynamicSharedMemorySize, LDS_BYTES) != hipSuccess) { g_grid = -1; return g_grid; }
        int per_cu = 0;
        (void)hipOccupancyMaxActiveBlocksPerMultiprocessor(&per_cu, (const void*)mega, NTHR, LDS_BYTES);
        (void)hipGetLastError();
        g_grid = cus;
    }
    return g_grid;
}
static void launch_mega(void* const* d_in, void* d_out, void* d_ws, int lo, int hi, hipStream_t stream) {
    Args a; memset(&a, 0, sizeof(a));
    for (int i = 0; i < 20; ++i) a.in[i] = (const float*)d_in[i];
    a.out = (float*)d_out; a.ws = (unsigned char*)d_ws; a.ph_lo = lo; a.ph_hi = hi;
    hipLaunchKernelGGL(mega, dim3(g_grid), dim3(NTHR), LDS_BYTES, stream, a);
}
extern "C" void kernel_launch(void* const* d_in, const int* in_sizes, int n_in, void* d_out, int out_size, void* d_ws, size_t ws_size, hipStream_t stream) {
    if (n_in != 20 || ws_size < WS_OPT_END || out_size != M_ * D_) { fprintf(stderr, "kernel_launch: unexpected arguments\n"); return; }
    if (setup_grid() <= 0) return;
    (void)hipMemsetAsync((char*)d_ws + WS_CTL, 0, CTL_ZERO_BYTES, stream);
#if N_LAUNCH_SPLIT
    for (int p = 0; p < N_PHASES; ++p) { launch_mega(d_in, d_out, d_ws, p, p + 1, stream); if (p == DUP_PHASE) { if (p == 7) (void)hipMemsetAsync((char*)d_ws + WS_CTL, 0, 128, stream); if (p == 10) launch_mega(d_in, d_out, d_ws, 6, 7, stream); launch_mega(d_in, d_out, d_ws, p, p + 1, stream); } }
#else
    launch_mega(d_in, d_out, d_ws, 0, N_PHASES, stream);
#endif
}
```

```cpp
#define N_LAUNCH_SPLIT 0
#include <hip/hip_runtime.h>
#include <hip/hip_bf16.h>
#include <cstdio>
#include <cstdint>
#include <cstring>
#include <cmath>

constexpr int B_ = 4, S_ = 4096, D_ = 1024, M_ = B_ * S_;
constexpr int INW = 4256, INWP = 4352;
constexpr int C_SBQ = 0, C_SBK = 512, C_SBV = 1024, C_CQ = 1536, C_CKV = 1920, C_KR = 2176, C_GSB = 2208, C_GMLA = 3232;
constexpr int NE = 32, TOPK = 4, DFF = 1024;
constexpr float EPS = 1e-6f;
constexpr float LOG2E = 1.4426950408889634f;
constexpr float SB_QSCALE = 0.125f * LOG2E;
constexpr float MLA_QSCALE = 0.10206207261596577f * LOG2E;
constexpr int NWAVES = 8, NTHR = 512;

#define LAS __attribute__((address_space(3)))
#define GAS __attribute__((address_space(1)))
typedef unsigned short bf16_t;
typedef short bf16x8 __attribute__((ext_vector_type(8)));
typedef short s16x4 __attribute__((ext_vector_type(4)));
typedef float f32x4 __attribute__((ext_vector_type(4)));
typedef float f32x16 __attribute__((ext_vector_type(16)));
typedef unsigned u32x4 __attribute__((ext_vector_type(4)));
typedef unsigned u32x2 __attribute__((ext_vector_type(2)));
typedef float f32x2_t __attribute__((ext_vector_type(2)));
typedef __bf16 bf16x2_t __attribute__((ext_vector_type(2)));
typedef int v8i_t __attribute__((ext_vector_type(8)));
constexpr float W8_SCALE = 8.f, X8_SCALE = 8.f;
__device__ __forceinline__ unsigned pk_fp8x4(float a, float b, float c, float d) { unsigned w = 0; w = __builtin_amdgcn_cvt_pk_fp8_f32(a, b, w, false); w = __builtin_amdgcn_cvt_pk_fp8_f32(c, d, w, true); return w; }

__device__ __forceinline__ unsigned cvtpk(float lo, float hi) { f32x2_t v = {lo, hi}; bf16x2_t b = __builtin_convertvector(v, bf16x2_t); return __builtin_bit_cast(unsigned, b); }
__device__ __forceinline__ float bf2f(unsigned short h) { return __uint_as_float(((unsigned)h) << 16); }
__device__ __forceinline__ float bflo(unsigned w) { return __uint_as_float(w << 16); }
__device__ __forceinline__ float bfhi(unsigned w) { return __uint_as_float(w & 0xffff0000u); }
__device__ __forceinline__ float dpp_f(float v, int ctrl) { return v; }
#define DPP_F(v, ctrl) __int_as_float(__builtin_amdgcn_update_dpp(0, __float_as_int(v), (ctrl), 0xF, 0xF, true))
#define DPP_I(v, ctrl) __builtin_amdgcn_update_dpp(0, (v), (ctrl), 0xF, 0xF, true)
#define DPP_X1 0xB1
#define DPP_X2 0x4E
#define DPP_HM 0x141
#define DPP_RM 0x140
__device__ __forceinline__ float wave_sum(float v) {
    v += DPP_F(v, DPP_X1); v += DPP_F(v, DPP_X2); v += DPP_F(v, DPP_HM); v += DPP_F(v, DPP_RM);
    return (__int_as_float(__builtin_amdgcn_readlane(__float_as_int(v), 0)) + __int_as_float(__builtin_amdgcn_readlane(__float_as_int(v), 16)))
         + (__int_as_float(__builtin_amdgcn_readlane(__float_as_int(v), 32)) + __int_as_float(__builtin_amdgcn_readlane(__float_as_int(v), 48)));
}
__device__ __forceinline__ float sum8(float v) { v += DPP_F(v, DPP_X1); v += DPP_F(v, DPP_X2); v += DPP_F(v, DPP_HM); return v; }
__device__ __forceinline__ float sigmoidf_(float x) { return __builtin_amdgcn_rcpf(1.f + __builtin_amdgcn_exp2f(-x * LOG2E)); }

namespace pg8 {
constexpr int BM = 256, BK = 64, HALF = 128, HTB = HALF * BK * 2, STAGE_BYTES = 8 * HTB, NXCD = 8, WGM = 8;
__host__ __device__ __forceinline__ int lds_byte(int r, int c) { const int st = (r >> 4) * 2 + (c >> 5), rr = r & 15, cc = c & 31, ob = rr * 64 + cc * 2; return st * 1024 + (ob ^ (((ob >> 9) & 1) << 5)); }
__host__ __device__ __forceinline__ void stage_rc(int b, int& R, int& C) { const int st = b / 1024, sb = b % 1024, swz = sb ^ (((sb >> 9) & 1) << 5); R = (st >> 1) * 16 + swz / 64; C = (st & 1) * 32 + (swz % 64) / 2; }
__host__ __device__ __forceinline__ int perm32(int rho) { const int n = rho >> 4, i = rho & 15; return 8 * (i >> 2) + 4 * n + (i & 3); }

struct Unit { int pm, pn, e, rows, rt; };
struct Gemm { const bf16_t* A; int lda, ldb, K; };

struct StaticOrder {
    const bf16_t* A; const bf16_t* Bt; int lda, ldb;
    int nM, nN, nwg, G, c;
    __device__ void init(const bf16_t* A_, int lda_, const bf16_t* Bt_, int ldb_, int M, int N, int G_, int c_, int cshift = 0) { A = A_; Bt = Bt_; lda = lda_; ldb = ldb_; nM = M / BM; nN = N / BM; nwg = nM * nN; G = G_; c = (c_ + cshift) % G_; }
    __device__ __forceinline__ bool next(int i, Unit& u) const {
        const long L = (long)i * G + c; if (L >= nwg) return false;
        int wgid = (int)L; { const int q = nwg / NXCD, r = nwg % NXCD, xcd = wgid % NXCD, off = wgid / NXCD; wgid = (xcd < r ? xcd * (q + 1) : r * (q + 1) + (xcd - r) * q) + off; }
        const int nig = WGM * nN, gid = wgid / nig, fm = gid * WGM, gsz = (nM - fm) < WGM ? (nM - fm) : WGM;
        u.pm = fm + ((wgid % nig) % gsz); u.pn = (wgid % nig) / gsz; u.e = 0; u.rows = 256; u.rt = 0; return true;
    }
    __device__ __forceinline__ unsigned a_off(const Unit& u, int r, int C) const { return (unsigned)(((u.pm * BM + r) * lda + C) * 2); }
    __device__ __forceinline__ const char* b_base(const Unit& u) const { return (const char*)(Bt + (size_t)u.pn * BM * ldb); }
};

__device__ __forceinline__ v8i_t ld32_lds(const LAS unsigned char* p) { const u32x4 lo_ = *(const LAS u32x4*)p, hi_ = *(const LAS u32x4*)(p + 1024); return (v8i_t){(int)lo_.x, (int)lo_.y, (int)lo_.z, (int)lo_.w, (int)hi_.x, (int)hi_.y, (int)hi_.z, (int)hi_.w}; }
struct PairOrder {
    StaticOrder S; size_t a1, b1;
    __device__ __forceinline__ bool next(int i, Unit& u) const { if (!S.next(i >> 1, u)) return false; u.e = i & 1; return true; }
    __device__ __forceinline__ unsigned a_off(const Unit& u, int r, int C) const { return S.a_off(u, r, C) + (unsigned)(u.e ? a1 * 2 : 0); }
    __device__ __forceinline__ const char* b_base(const Unit& u) const { return S.b_base(u) + (u.e ? b1 * 2 : 0); }
};
__device__ __forceinline__ void mfma_f8(f32x4& c, const v8i_t a, const v8i_t b, int sa, int sb) {
    asm volatile("v_mfma_scale_f32_16x16x128_f8f6f4 %0, %1, %2, %0, %3, %4 op_sel_hi:[0,0,0]" : "+v"(c) : "v"(a), "v"(b), "v"(sa), "v"(sb));
}
template <bool F8> struct FragT { typedef bf16x8 type; };
template <> struct FragT<true> { typedef v8i_t type; };
template <class Epi, class Sched, bool FP8 = false>
__device__ __forceinline__ void gemm_phase(LAS unsigned char* lds, const Gemm g, const Sched& S, const Epi& E) {
    const int tid = threadIdx.x, wid = __builtin_amdgcn_readfirstlane(tid >> 6), lane = tid & 63, wr = wid >> 2, wc = wid & 3, fr = lane & 15, fq = lane >> 4;
    const int K = g.K, nt = K / BK;
    unsigned voffB[2];
#pragma unroll
    for (int i = 0; i < 2; ++i) { int R, C; stage_rc(tid * 16 + i * 8192, R, C); const int Rb = Epi::PERM ? ((R & ~31) + perm32(R & 31)) : R; voffB[i] = (unsigned)(Rb * g.ldb + C) * 2u; }
#define PG8_AOFF(dst, unit) do { int t_ = tid; asm volatile("" : "+v"(t_)); _Pragma("unroll") for (int i = 0; i < 2; ++i) { int R, C; stage_rc(t_ * 16 + i * 8192, R, C); \
        _Pragma("unroll") for (int h = 0; h < 2; ++h) dst[h][i] = S.a_off(unit, h * HALF + R, C); } } while (0)
    const size_t kstep = (size_t)(BK * 2);
    const size_t hstepB = (size_t)HALF * g.ldb * 2;
    const unsigned ldsw = (unsigned)wid * 1024u;
    const int aoff = lds_byte(wr * 64 + fr, fq * 8), boff = lds_byte(wc * 32 + fr, fq * 8);
#define PG8_SA(b, h) (((b) * 2 + (h)) * HTB)
#define PG8_SB(b, h) ((4 + (b) * 2 + (h)) * HTB)
#define PG8_STAGE(bufoff, gbase, voff) do { _Pragma("unroll") for (int _i = 0; _i < 2; ++_i) \
        __builtin_amdgcn_global_load_lds((const unsigned*)((const char*)(gbase) + (voff)[_i]), (LAS unsigned*)(lds + (bufoff) + ldsw + _i * 8192), 16, 0, 0); } while (0)
#define PG8_LD32(p) ld32_lds((const LAS unsigned char*)(p))
#define PG8_LDA(dst, b, h) do { if constexpr (FP8) { _Pragma("unroll") for (int m = 0; m < 4; ++m) dst[m][0] = __builtin_bit_cast(FT, PG8_LD32(lds + PG8_SA(b, h) + aoff + m * 2048)); } \
        else { _Pragma("unroll") for (int m = 0; m < 4; ++m) _Pragma("unroll") for (int k = 0; k < 2; ++k) dst[m][k] = __builtin_bit_cast(FT, *(const LAS FT*)(lds + PG8_SA(b, h) + aoff + m * 2048 + k * 1024)); } } while (0)
#define PG8_LDB(dst, b, h) do { if constexpr (FP8) { _Pragma("unroll") for (int n = 0; n < 2; ++n) dst[n][0] = __builtin_bit_cast(FT, PG8_LD32(lds + PG8_SB(b, h) + boff + n * 2048)); } \
        else { _Pragma("unroll") for (int n = 0; n < 2; ++n) _Pragma("unroll") for (int k = 0; k < 2; ++k) dst[n][k] = __builtin_bit_cast(FT, *(const LAS FT*)(lds + PG8_SB(b, h) + boff + n * 2048 + k * 1024)); } } while (0)
#define PG8_MMA(ai, bj, At, Bt) do { __builtin_amdgcn_s_setprio(1); \
        if constexpr (FP8) { _Pragma("unroll") for (int m = 0; m < 4; ++m) _Pragma("unroll") for (int n = 0; n < 2; ++n) \
            mfma_f8(acc[ai][bj][m][n], __builtin_bit_cast(v8i_t, Bt[n][0]), __builtin_bit_cast(v8i_t, At[m][0]), 0x7c7c7c7c, 0x7c7c7c7c); } \
        else { _Pragma("unroll") for (int m = 0; m < 4; ++m) _Pragma("unroll") for (int n = 0; n < 2; ++n) _Pragma("unroll") for (int k = 0; k < 2; ++k) \
            acc[ai][bj][m][n] = __builtin_amdgcn_mfma_f32_16x16x32_bf16(__builtin_bit_cast(bf16x8, Bt[n][k]), __builtin_bit_cast(bf16x8, At[m][k]), acc[ai][bj][m][n], 0, 0, 0); } \
        __builtin_amdgcn_s_setprio(0); } while (0)
#define PG8_WAIT_V(n) asm volatile("s_waitcnt vmcnt(" #n ")" ::: "memory")
#define PG8_WAIT_L(n) asm volatile("s_waitcnt lgkmcnt(" #n ")" ::: "memory")
#define PG8_BAR __builtin_amdgcn_s_barrier()
#define PG8_SCHED __builtin_amdgcn_sched_barrier(0)
    Unit cur, nxt; int ui = 0;
    if (!S.next(0, cur)) return;
    f32x4 acc[2][2][4][2];
#pragma unroll
    for (int a = 0; a < 2; ++a)
#pragma unroll
        for (int b = 0; b < 2; ++b)
#pragma unroll
            for (int m = 0; m < 4; ++m)
#pragma unroll
                for (int n = 0; n < 2; ++n) acc[a][b][m][n] = (f32x4){0.f, 0.f, 0.f, 0.f};
    typedef typename FragT<FP8>::type FT; constexpr int NK = FP8 ? 1 : 2;
    FT At[4][NK], B0[2][NK], B1[2][NK];
    const char* Ab = (const char*)g.A;
    const char* cB = S.b_base(cur);
    unsigned vaC[2][2], vaN[2][2];
    PG8_AOFF(vaC, cur);
    PG8_STAGE(PG8_SB(0, 0), cB, voffB); PG8_STAGE(PG8_SB(0, 1), cB + hstepB, voffB); PG8_STAGE(PG8_SA(0, 0), Ab, vaC[0]); PG8_STAGE(PG8_SA(0, 1), Ab, vaC[1]);
    if (wr == 1) PG8_BAR;
    PG8_WAIT_V(2); PG8_BAR;
    PG8_STAGE(PG8_SB(1, 0), cB + kstep, voffB); PG8_STAGE(PG8_SA(1, 0), Ab + kstep, vaC[0]); PG8_STAGE(PG8_SB(1, 1), cB + hstepB + kstep, voffB);
    PG8_WAIT_V(6); PG8_BAR;
    for (;;) {
        const bool has_next = S.next(ui + 1, nxt);
        const char* nB = has_next ? S.b_base(nxt) : cB;
        if (has_next) PG8_AOFF(vaN, nxt);
        else {
#pragma unroll
            for (int h = 0; h < 2; ++h)
#pragma unroll
                for (int i = 0; i < 2; ++i) vaN[h][i] = vaC[h][i]; }
        for (int t = 0; t < nt; t += 2) {
            const bool last = (t == nt - 2);
            const char* kA1 = Ab + (size_t)(t + 1) * kstep;
            const char* kA2 = last ? Ab : Ab + (size_t)(t + 2) * kstep; const char* b2 = last ? nB : cB + (size_t)(t + 2) * kstep;
            const char* kA3 = kA2 + kstep; const char* b3 = b2 + kstep;
            unsigned o2[2][2];
#pragma unroll
            for (int h = 0; h < 2; ++h)
#pragma unroll
                for (int i = 0; i < 2; ++i) o2[h][i] = last ? vaN[h][i] : vaC[h][i];
            PG8_LDB(B0, 0, 0); PG8_LDB(B1, 0, 1); PG8_SCHED; PG8_LDA(At, 0, 0); PG8_STAGE(PG8_SA(1, 1), kA1, vaC[1]);
            PG8_WAIT_V(8); PG8_WAIT_L(0); PG8_BAR; PG8_MMA(0, 0, At, B0); PG8_MMA(0, 1, At, B1); PG8_BAR; PG8_SCHED;
            PG8_LDA(At, 0, 1); PG8_STAGE(PG8_SB(0, 0), b2, voffB); PG8_STAGE(PG8_SB(0, 1), b2 + hstepB, voffB); PG8_STAGE(PG8_SA(0, 0), kA2, o2[0]);
            PG8_WAIT_V(8); PG8_WAIT_L(0); PG8_BAR; PG8_MMA(1, 0, At, B0); PG8_MMA(1, 1, At, B1); PG8_BAR; PG8_SCHED;
            PG8_LDB(B0, 1, 0); PG8_LDB(B1, 1, 1); PG8_SCHED; PG8_LDA(At, 1, 0); PG8_STAGE(PG8_SA(0, 1), kA2, o2[1]);
            PG8_WAIT_V(8); PG8_WAIT_L(0); PG8_BAR; PG8_MMA(0, 0, At, B0); PG8_MMA(0, 1, At, B1); PG8_BAR; PG8_SCHED;
            PG8_LDA(At, 1, 1); PG8_STAGE(PG8_SB(1, 0), b3, voffB); PG8_STAGE(PG8_SB(1, 1), b3 + hstepB, voffB); PG8_STAGE(PG8_SA(1, 0), kA3, o2[0]);
            PG8_WAIT_V(8); PG8_WAIT_L(0); PG8_BAR; PG8_MMA(1, 0, At, B0); PG8_MMA(1, 1, At, B1); PG8_BAR; PG8_SCHED;
        }
        if (wr == 0) PG8_BAR;
        if constexpr (FP8) asm volatile("s_nop 15\n\ts_nop 15" ::: "memory");
        E(acc, cur, wr, wc, fr, fq);
        if (!has_next) break;
#pragma unroll
        for (int a = 0; a < 2; ++a)
#pragma unroll
            for (int b = 0; b < 2; ++b)
#pragma unroll
                for (int m = 0; m < 4; ++m)
#pragma unroll
                    for (int n = 0; n < 2; ++n) acc[a][b][m][n] = (f32x4){0.f, 0.f, 0.f, 0.f};
        cur = nxt; cB = nB; ++ui;
#pragma unroll
        for (int h = 0; h < 2; ++h)
#pragma unroll
            for (int i = 0; i < 2; ++i) vaC[h][i] = vaN[h][i];
        if (wr == 1) PG8_BAR;
    }
    PG8_WAIT_V(0);
    PG8_BAR;
#undef PG8_SA
#undef PG8_AOFF
#undef PG8_SB
#undef PG8_STAGE
#undef PG8_LDA
#undef PG8_LDB
#undef PG8_MMA
#undef PG8_LD32
#undef PG8_WAIT_V
#undef PG8_WAIT_L
#undef PG8_BAR
#undef PG8_SCHED
}

struct EpiBf16 {
    static constexpr bool PERM = true;
    bf16_t* O; int ldc;
    __device__ __forceinline__ void operator()(const f32x4 (&acc)[2][2][4][2], const Unit& u, int wr, int wc, int fr, int fq) const {
        const int row0 = u.pm * BM + wr * 64 + fr, col0 = u.pn * BM + wc * 32 + 8 * fq;
#pragma unroll
        for (int ai = 0; ai < 2; ++ai)
#pragma unroll
            for (int m = 0; m < 4; ++m) { bf16_t* rowp = O + (size_t)(row0 + ai * HALF + m * 16) * ldc + col0;
#pragma unroll
                for (int bj = 0; bj < 2; ++bj) { const f32x4 v0 = acc[ai][bj][m][0], v1 = acc[ai][bj][m][1];
                    u32x4 w; w.x = cvtpk(v0[0], v0[1]); w.y = cvtpk(v0[2], v0[3]); w.z = cvtpk(v1[0], v1[1]); w.w = cvtpk(v1[2], v1[3]);
                    *(u32x4*)(rowp + bj * HALF) = w; } }
    }
};
struct EpiGate2 {
    static constexpr bool PERM = true;
    bf16_t* O; const bf16_t* G; int ldg, gcol0, gcol1;
    __device__ __forceinline__ void operator()(const f32x4 (&acc)[2][2][4][2], const Unit& u, int wr, int wc, int fr, int fq) const {
        const int row0 = u.pm * BM + wr * 64 + fr, col0 = u.pn * BM + wc * 32 + 8 * fq;
        const bool second = u.e != 0; const int gcol = second ? gcol1 : gcol0;
#pragma unroll
        for (int ai = 0; ai < 2; ++ai)
#pragma unroll
            for (int m = 0; m < 4; ++m) { const size_t r = (size_t)(row0 + ai * HALF + m * 16);
#pragma unroll
                for (int bj = 0; bj < 2; ++bj) { const f32x4 v0 = acc[ai][bj][m][0], v1 = acc[ai][bj][m][1];
                    const int c = col0 + bj * HALF;
                    const u32x4 gw = *(const u32x4*)(G + r * ldg + gcol + c);
                    bf16_t* op = O + r * D_ + c;
                    u32x4 pw = {0u, 0u, 0u, 0u}; if (second) pw = *(const u32x4*)op;
                    float o[8];
                    o[0] = sigmoidf_(bflo(gw.x)) * v0[0]; o[1] = sigmoidf_(bfhi(gw.x)) * v0[1]; o[2] = sigmoidf_(bflo(gw.y)) * v0[2]; o[3] = sigmoidf_(bfhi(gw.y)) * v0[3];
                    o[4] = sigmoidf_(bflo(gw.z)) * v1[0]; o[5] = sigmoidf_(bfhi(gw.z)) * v1[1]; o[6] = sigmoidf_(bflo(gw.w)) * v1[2]; o[7] = sigmoidf_(bfhi(gw.w)) * v1[3];
                    o[0] += bflo(pw.x); o[1] += bfhi(pw.x); o[2] += bflo(pw.y); o[3] += bfhi(pw.y); o[4] += bflo(pw.z); o[5] += bfhi(pw.z); o[6] += bflo(pw.w); o[7] += bfhi(pw.w);
                    u32x4 w; w.x = cvtpk(o[0], o[1]); w.y = cvtpk(o[2], o[3]); w.z = cvtpk(o[4], o[5]); w.w = cvtpk(o[6], o[7]);
                    *(u32x4*)op = w; } }
    }
};
struct EpiRes {
    static constexpr bool PERM = true;
    const float* base; bf16_t* out;
    __device__ __forceinline__ void operator()(const f32x4 (&acc)[2][2][4][2], const Unit& u, int wr, int wc, int fr, int fq) const {
        const int row0 = u.pm * BM + wr * 64 + fr, col0 = u.pn * BM + wc * 32 + 8 * fq;
#pragma unroll
        for (int ai = 0; ai < 2; ++ai)
#pragma unroll
            for (int m = 0; m < 4; ++m) { const size_t off = (size_t)(row0 + ai * HALF + m * 16) * D_ + col0;
#pragma unroll
                for (int bj = 0; bj < 2; ++bj) { const f32x4 v0 = *(const f32x4*)(base + off + bj * HALF) + acc[ai][bj][m][0], v1 = *(const f32x4*)(base + off + bj * HALF + 4) + acc[ai][bj][m][1];
                    u32x4 w; w.x = cvtpk(v0[0], v0[1]); w.y = cvtpk(v0[2], v0[3]); w.z = cvtpk(v1[0], v1[1]); w.w = cvtpk(v1[2], v1[3]);
                    *(u32x4*)(out + off + bj * HALF) = w; } }
    }
};
struct EpiSwiglu {
    static constexpr bool PERM = true;
    bf16_t* act; const float* b_up;
    __device__ __forceinline__ void operator()(const f32x4 (&acc)[2][2][4][2], const Unit& u, int wr, int wc, int fr, int fq) const {
        const int row0 = u.pm * BM + wr * 64 + fr, col0 = u.pn * BM + wc * 32 + 8 * fq;
        const float* bb = b_up + (size_t)u.e * (2 * DFF);
        f32x4 bv[2][2];
#pragma unroll
        for (int bj = 0; bj < 2; ++bj)
#pragma unroll
            for (int n = 0; n < 2; ++n) bv[bj][n] = *(const f32x4*)(bb + col0 + bj * HALF + 4 * n);
#pragma unroll
        for (int ai = 0; ai < 2; ++ai)
#pragma unroll
            for (int m = 0; m < 4; ++m) { bf16_t* rowp = act + (size_t)(row0 + ai * HALF + m * 16) * DFF + (col0 >> 1);
#pragma unroll
                for (int bj = 0; bj < 2; ++bj) { const f32x4 v0 = acc[ai][bj][m][0] + bv[bj][0], v1 = acc[ai][bj][m][1] + bv[bj][1];
                    float a[4];
#pragma unroll
                    for (int p = 0; p < 4; ++p) { float gl = (p < 2) ? v0[2 * p] : v1[2 * p - 4], li = (p < 2) ? v0[2 * p + 1] : v1[2 * p - 3];
                        gl = fminf(gl, 7.f); li = fminf(fmaxf(li, -7.f), 7.f);
                        a[p] = gl * sigmoidf_(1.702f * gl) * (li + 1.f); }
                    u32x2 w; w.x = cvtpk(a[0], a[1]); w.y = cvtpk(a[2], a[3]);
                    *(u32x2*)(rowp + bj * (HALF / 2)) = w; } }
    }
};
struct EpiSwiglu8 {
    static constexpr bool PERM = true;
    unsigned char* act; const float* b_up;
    __device__ __forceinline__ void operator()(const f32x4 (&acc)[2][2][4][2], const Unit& u, int wr, int wc, int fr, int fq) const {
        const int row0 = u.pm * BM + wr * 64 + fr, col0 = u.pn * BM + wc * 32 + 8 * fq;
        const float* bb = b_up + (size_t)u.e * (2 * DFF);
        f32x4 bv[2][2];
#pragma unroll
        for (int bj = 0; bj < 2; ++bj)
#pragma unroll
            for (int n = 0; n < 2; ++n) bv[bj][n] = *(const f32x4*)(bb + col0 + bj * HALF + 4 * n);
#pragma unroll
        for (int ai = 0; ai < 2; ++ai)
#pragma unroll
            for (int m = 0; m < 4; ++m) { unsigned char* rowp = act + (size_t)(row0 + ai * HALF + m * 16) * DFF + (col0 >> 1);
#pragma unroll
                for (int bj = 0; bj < 2; ++bj) { const f32x4 v0 = acc[ai][bj][m][0] + bv[bj][0], v1 = acc[ai][bj][m][1] + bv[bj][1];
                    float a[4];
#pragma unroll
                    for (int p = 0; p < 4; ++p) { float gl = (p < 2) ? v0[2 * p] : v1[2 * p - 4], li = (p < 2) ? v0[2 * p + 1] : v1[2 * p - 3];
                        gl = fminf(gl, 7.f); li = fminf(fmaxf(li, -7.f), 7.f);
                        a[p] = gl * sigmoidf_(1.702f * gl) * fmaf(li, X8_SCALE, X8_SCALE); }
                    *(unsigned*)(rowp + bj * (HALF / 2)) = pk_fp8x4(a[0], a[1], a[2], a[3]); } }
    }
};
struct EpiDown {
    static constexpr bool PERM = true;
    bf16_t* y; const float* b_down; const int* list; const float* listw;
    __device__ __forceinline__ void operator()(const f32x4 (&acc)[2][2][4][2], const Unit& u, int wr, int wc, int fr, int fq) const {
        const int col0 = u.pn * BM + wc * 32 + 8 * fq;
        const float* bb = b_down + (size_t)u.e * D_;
        f32x4 bv[2][2];
#pragma unroll
        for (int bj = 0; bj < 2; ++bj)
#pragma unroll
            for (int n = 0; n < 2; ++n) bv[bj][n] = *(const f32x4*)(bb + col0 + bj * HALF + 4 * n);
        const int* lp = list + (size_t)u.e * M_ + u.rt * BM; const float* lw = listw + (size_t)u.e * M_ + u.rt * BM;
#pragma unroll
        for (int ai = 0; ai < 2; ++ai)
#pragma unroll
            for (int m = 0; m < 4; ++m) { const int r = ai * HALF + wr * 64 + m * 16 + fr;
                if (r < u.rows) { const int slot = lp[r]; const float w = lw[r]; bf16_t* rowp = y + (size_t)slot * D_ + col0;
#pragma unroll
                    for (int bj = 0; bj < 2; ++bj) { const f32x4 v0 = (acc[ai][bj][m][0] + bv[bj][0]) * w, v1 = (acc[ai][bj][m][1] + bv[bj][1]) * w;
                        u32x4 o; o.x = cvtpk(v0[0], v0[1]); o.y = cvtpk(v0[2], v0[3]); o.z = cvtpk(v1[0], v1[1]); o.w = cvtpk(v1[2], v1[3]);
                        *(u32x4*)(rowp + bj * HALF) = o; } } }
    }
};
}
constexpr size_t MiB = 1ull << 20;
constexpr size_t WS_CTL = 0, CTL_ZERO_BYTES = 64 * 1024;
constexpr size_t WS_ROPE = 256 * 1024;
constexpr size_t WS_WR = 3 * MiB;
constexpr size_t WS_LIST = 4 * MiB;
constexpr size_t WS_TOPW = 6 * MiB;
constexpr size_t WS_SEL = 6 * MiB + 512 * 1024;
constexpr size_t WS_LISTW = 594 * MiB;
constexpr size_t WS_WIN = 8 * MiB;
constexpr size_t WS_WUQ = 17 * MiB;
constexpr size_t WS_WUKV = 18 * MiB;
constexpr size_t WS_WOSB = 19 * MiB;
constexpr size_t WS_WOMLA = 20 * MiB;
constexpr size_t WS_WOUT = 21 * MiB;
constexpr size_t WS_WUP = 24 * MiB;
constexpr size_t WS_WDN = 152 * MiB;
constexpr size_t WS_HB = 216 * MiB;
constexpr size_t WS_PROJ = 249 * MiB;
constexpr size_t WS_ACT = WS_PROJ;
constexpr size_t WS_QRAW = 393 * MiB;
constexpr size_t WS_KVRAW = WS_QRAW + 24 * MiB;
constexpr size_t WS_QB = WS_KVRAW + 32 * MiB;
constexpr size_t WS_KB = WS_QB + 24 * MiB;
constexpr size_t WS_VB = WS_KB + 24 * MiB;
constexpr size_t WS_OSB = WS_VB + 16 * MiB;
constexpr size_t WS_OMLA = WS_OSB + 16 * MiB;
constexpr size_t WS_YB = WS_QRAW;
constexpr size_t WS_MIX = 545 * MiB;
constexpr size_t WS_H2F8 = 577 * MiB;
constexpr size_t WS_X1B = 596 * MiB;
constexpr size_t WS_OPT_END = 628 * MiB;
constexpr int CW_CNT = 0;
constexpr int CW_BAR = 1024;
constexpr int LDS_STAGE = 143360;
constexpr int LDS_MISC = LDS_STAGE;
constexpr int LDS_BYTES = 147456;
constexpr int MI_BAR = 0, MI_TPFX = 16, MI_CNT = 64, MI_FLAG = 128, MI_LCNT = 160, MI_BASE = 192, MI_RSTD = 256, MI_CITEM = 320;

typedef GAS unsigned gu32;
#define RLX_AGENT __ATOMIC_RELAXED, __HIP_MEMORY_SCOPE_AGENT

#define XB_TMO      128
#define XB_XCNT(j)  (256  + 64 * (j))
#define XB_XSUB(j)  (1280 + 64 * (j))
#define XB_XGEN(j)  (2304 + 64 * (j))
#define XB_TOP      3328
#define XB_TOPGEN   3392
#define XCD_BAR_WORDS 3456
#define XB_SPIN_CAP (1u << 18)
__device__ __forceinline__ unsigned xb_ld(unsigned* p)              { return __hip_atomic_load(p, __ATOMIC_RELAXED, __HIP_MEMORY_SCOPE_AGENT); }
__device__ __forceinline__ unsigned xb_add(unsigned* p, unsigned v) { return __hip_atomic_fetch_add(p, v, __ATOMIC_RELAXED, __HIP_MEMORY_SCOPE_AGENT); }
__device__ __forceinline__ unsigned xb_xcc_id() { return (unsigned)__builtin_amdgcn_s_getreg((3 << 11) | 20) & 0xFu; }
#define XB_SPIN(cond, bar) do { unsigned _sp = 0; while (cond) { __builtin_amdgcn_s_sleep(1); \
    if ((++_sp & 255u) == 0u) { if (xb_ld(&(bar)[XB_TMO])) break; if (_sp > XB_SPIN_CAP) { atomicAdd(&(bar)[XB_TMO], 1u); break; } } } } while (0)
struct XcdBarrier { unsigned* bar; unsigned x; volatile LAS unsigned* st; };
__device__ __forceinline__ XcdBarrier xcd_barrier_post(unsigned* bar, volatile LAS unsigned* st) {
    XcdBarrier b; b.bar = bar; b.x = xb_xcc_id(); b.st = st;
    if (threadIdx.x == 0) (void)xb_add(&bar[XB_XCNT(b.x)], 1u);
    return b;
}
__device__ __forceinline__ void xcd_barrier_complete(unsigned* bar, unsigned x, unsigned& nloc, unsigned& nx) {
    const unsigned G = gridDim.x * gridDim.y * gridDim.z;
    unsigned sum, cnt, mine, sp = 0u;
    for (;;) {
        sum = 0u; cnt = 0u; mine = 0u;
#pragma unroll
        for (unsigned j = 0; j < 16; ++j) { const unsigned c = xb_ld(&bar[XB_XCNT(j)]); sum += c; cnt += (c > 0u) ? 1u : 0u; mine = (j == x) ? c : mine; }
        if (sum == G) break;
        __builtin_amdgcn_s_sleep(1);
        if ((++sp & 255u) == 0u) { if (xb_ld(&bar[XB_TMO])) break; if (sp > XB_SPIN_CAP) { atomicAdd(&bar[XB_TMO], 1u); break; } }
    }
    nloc = mine > 0u ? mine : 1u; nx = cnt > 0u ? cnt : 1u;
}
__device__ __forceinline__ void xcd_barrier(const XcdBarrier& b) {
    asm volatile("s_waitcnt vmcnt(0)" ::: "memory");
    __syncthreads();
    if (threadIdx.x == 0) {
        unsigned* bar = b.bar;
        __builtin_amdgcn_s_waitcnt(0);
        unsigned nloc = b.st[0], nx = b.st[1];
        if (nloc == 0u) { xcd_barrier_complete(bar, b.x, nloc, nx); b.st[0] = nloc; b.st[1] = nx; }
        const unsigned old = xb_add(&bar[XB_XSUB(b.x)], 1u);
        const unsigned gen = old / nloc;
        if (old + 1u == (gen + 1u) * nloc) {
            __builtin_amdgcn_fence(__ATOMIC_RELEASE, "agent");
            asm volatile("s_waitcnt vmcnt(0)" ::: "memory");
            const unsigned og = xb_add(&bar[XB_TOP], 1u);
            const unsigned tg = og / nx;
            if (og + 1u == (tg + 1u) * nx) xb_add(&bar[XB_TOPGEN], 1u);
            else XB_SPIN(xb_ld(&bar[XB_TOPGEN]) == tg, bar);
            __builtin_amdgcn_fence(__ATOMIC_ACQUIRE, "agent");
            xb_add(&bar[XB_XGEN(b.x)], 1u);
            asm volatile("s_waitcnt vmcnt(0)" ::: "memory");
        } else {
            XB_SPIN(xb_ld(&bar[XB_XGEN(b.x)]) == gen, bar);
            __builtin_amdgcn_fence(__ATOMIC_ACQUIRE, "agent");
            asm volatile("s_waitcnt vmcnt(0)" ::: "memory");
        }
    }
    __syncthreads();
}

struct Args {
    const float* in[20]; float* out; unsigned char* ws;
    int ph_lo, ph_hi;
};

struct Frame {
    LAS unsigned char* lds; volatile LAS unsigned* MISC;
    int tid, lane, wave, vcu, G;
    unsigned char* ws;
};

__device__ __forceinline__ void p0_transpose_item(const float* W, int K, int N, bf16_t* WT, LAS float* scr, int item, int lane, const float* gk, float cs, int csn) {
    const int nblk = N / 32, kb = item / nblk, nb = item % nblk, k0 = 64 * kb, n0 = 32 * nb;
    const float colsc = (n0 < csn) ? cs : 1.f;
    float tv[32];
#pragma unroll
    for (int i = 0; i < 32; ++i) { const int kk = 2 * i + (lane >> 5); tv[i] = W[(size_t)(k0 + kk) * N + n0 + (lane & 31)]; }
#pragma unroll
    for (int i = 0; i < 32; ++i) { const int kk = 2 * i + (lane >> 5); float v = tv[i] * colsc; if (gk) v *= gk[k0 + kk]; scr[kk * 33 + (lane & 31)] = v; }
    asm volatile("s_waitcnt lgkmcnt(0)" ::: "memory");
    const int c = lane & 7;
#pragma unroll
    for (int j = 0; j < 4; ++j) { const int n = (lane >> 3) + 8 * j; const LAS float* s = scr + (8 * c) * 33 + n;
        u32x4 o; o.x = cvtpk(s[0 * 33], s[1 * 33]); o.y = cvtpk(s[2 * 33], s[3 * 33]); o.z = cvtpk(s[4 * 33], s[5 * 33]); o.w = cvtpk(s[6 * 33], s[7 * 33]);
        *(u32x4*)(WT + (size_t)(n0 + n) * K + k0 + 8 * c) = o; }
    asm volatile("s_waitcnt lgkmcnt(0)" ::: "memory");
}
__device__ __forceinline__ void p0_transpose_item_fp8(const float* W, int K, int N, unsigned char* WT, LAS float* scr, int item, int lane, float cs) {
    const int nblk = N / 32, kb = item / nblk, nb = item % nblk, k0 = 64 * kb, n0 = 32 * nb;
    float tv[32];
#pragma unroll
    for (int i = 0; i < 32; ++i) { const int kk = 2 * i + (lane >> 5); tv[i] = W[(size_t)(k0 + kk) * N + n0 + (lane & 31)]; }
#pragma unroll
    for (int i = 0; i < 32; ++i) { const int kk = 2 * i + (lane >> 5); scr[kk * 33 + (lane & 31)] = tv[i] * cs; }
    asm volatile("s_waitcnt lgkmcnt(0)" ::: "memory");
    const int c = lane & 7;
#pragma unroll
    for (int j = 0; j < 4; ++j) { const int n = (lane >> 3) + 8 * j; const LAS float* s = scr + (8 * c) * 33 + n;
        u32x2 o; o.x = pk_fp8x4(s[0 * 33], s[1 * 33], s[2 * 33], s[3 * 33]); o.y = pk_fp8x4(s[4 * 33], s[5 * 33], s[6 * 33], s[7 * 33]);
        *(u32x2*)(WT + (size_t)(n0 + n) * K + k0 + 8 * c) = o; }
    asm volatile("s_waitcnt lgkmcnt(0)" ::: "memory");
}
__device__ __forceinline__ void rms_row_to_bf16(const float* xrow, const float* g, bf16_t* orow, int lane) {
    const f32x4* xr = (const f32x4*)xrow + lane; const f32x4* gr = (const f32x4*)g + lane;
    f32x4 v[4]; float s = 0.f;
#pragma unroll
    for (int j = 0; j < 4; ++j) { v[j] = xr[64 * j]; s += (v[j].x * v[j].x + v[j].y * v[j].y) + (v[j].z * v[j].z + v[j].w * v[j].w); }
    const float rstd = rsqrtf(wave_sum(s) * (1.f / D_) + EPS);
    u32x2* o8 = (u32x2*)orow + lane;
#pragma unroll
    for (int j = 0; j < 4; ++j) { const f32x4 gg = gr[64 * j]; u32x2 w; w.x = cvtpk(v[j].x * rstd * gg.x, v[j].y * rstd * gg.y); w.y = cvtpk(v[j].z * rstd * gg.z, v[j].w * rstd * gg.w); o8[64 * j] = w; }
}
__device__ __forceinline__ void p0_prologue(Frame& F, const Args& a, int do_moe_w, int do_rest) {
    LAS float* scr = (LAS float*)(F.lds + F.wave * 16384);
    const int gw = F.vcu * NWAVES + F.wave, NGW = F.G * NWAVES;
    unsigned char* ws = F.ws;
    const float* w_in = a.in[3]; const float* g_cq = a.in[4]; const float* w_uq = a.in[5]; const float* g_ckv = a.in[6]; const float* w_ukv = a.in[7];
    const float* w_o_sb = a.in[10]; const float* w_o_mla = a.in[11]; const float* w_out = a.in[12]; const float* g_ffn = a.in[13]; const float* w_router = a.in[14];
    const float* w_up = a.in[16]; const float* w_down = a.in[18];
    constexpr int I_IN = (D_ / 64) * (INW / 32), I_UQ = (384 / 64) * (768 / 32), I_UKV = (256 / 64) * (1024 / 32), I_O = (512 / 64) * (1024 / 32), I_OUT = (1024 / 64) * (1024 / 32);
    constexpr int I_UP1 = (1024 / 64) * (2048 / 32), I_DN1 = (1024 / 64) * (1024 / 32);
    if (do_rest) {
        constexpr int NI = I_IN + I_UQ + I_UKV + 2 * I_O + I_OUT;
        for (int it = gw; it < NI; it += NGW) {
            int r = it;
            if (r < I_IN) { p0_transpose_item(w_in, D_, INW, (bf16_t*)(ws + WS_WIN), scr, r, F.lane, nullptr, SB_QSCALE, 512); continue; } r -= I_IN;
            if (r < I_UQ) { p0_transpose_item(w_uq, 384, 768, (bf16_t*)(ws + WS_WUQ), scr, r, F.lane, g_cq, 1.f, 0); continue; } r -= I_UQ;
            if (r < I_UKV) { p0_transpose_item(w_ukv, 256, 1024, (bf16_t*)(ws + WS_WUKV), scr, r, F.lane, g_ckv, 1.f, 0); continue; } r -= I_UKV;
            if (r < I_O) { p0_transpose_item(w_o_sb, 512, 1024, (bf16_t*)(ws + WS_WOSB), scr, r, F.lane, nullptr, 1.f, 0); continue; } r -= I_O;
            if (r < I_O) { p0_transpose_item(w_o_mla, 512, 1024, (bf16_t*)(ws + WS_WOMLA), scr, r, F.lane, nullptr, 1.f, 0); continue; } r -= I_O;
            p0_transpose_item(w_out, 1024, 1024, (bf16_t*)(ws + WS_WOUT), scr, r, F.lane, nullptr, 1.f, 0);
        }
        { const int gt = gw * 64 + F.lane, NGT = NGW * 64;
          u32x4 z = {0u, 0u, 0u, 0u};
          u32x4* pz = (u32x4*)((bf16_t*)(ws + WS_WIN) + (size_t)INW * D_);
          for (int i = gt; i < (INWP - INW) * D_ * 2 / 16; i += NGT) pz[i] = z;
          u32x4* hz = (u32x4*)((unsigned char*)(ws + WS_H2F8) + (size_t)M_ * D_);
          for (int i = gt; i < D_ / 16; i += NGT) hz[i] = z;
          const int* pos = (const int*)a.in[1]; float* rt = (float*)(ws + WS_ROPE);
          for (int i = gt; i < M_ * 16; i += NGT) { const int row = i >> 4, k = i & 15; const float inv = powf(10000.f, -(float)k / 16.f); const float ang = (float)pos[row] * inv; rt[row * 32 + k] = cosf(ang); rt[row * 32 + 16 + k] = sinf(ang); }
          float* wr = (float*)(ws + WS_WR);
          for (int i = gt; i < D_ * NE; i += NGT) wr[i] = w_router[i] * g_ffn[i >> 5];
        }
        {
            const f32x4* gr = (const f32x4*)a.in[2] + F.lane; f32x4 gg[4];
#pragma unroll
            for (int j = 0; j < 4; ++j) gg[j] = gr[64 * j];
            for (int m = gw; m < M_; m += 4 * NGW) {
                f32x4 v[4][4]; float s[4];
#pragma unroll
                for (int q = 0; q < 4; ++q) { const int row = m + q * NGW; const f32x4* xr = (const f32x4*)(a.in[0] + (size_t)(row < M_ ? row : m) * D_) + F.lane;
#pragma unroll
                    for (int j = 0; j < 4; ++j) v[q][j] = xr[64 * j]; }
#pragma unroll
                for (int q = 0; q < 4; ++q) { s[q] = 0.f;
#pragma unroll
                    for (int j = 0; j < 4; ++j) s[q] += (v[q][j].x * v[q][j].x + v[q][j].y * v[q][j].y) + (v[q][j].z * v[q][j].z + v[q][j].w * v[q][j].w); }
#pragma unroll
                for (int q = 0; q < 4; ++q) { const int row = m + q * NGW; const float r = rsqrtf(wave_sum(s[q]) * (1.f / D_) + EPS);
                    if (row < M_) { u32x2* o8 = (u32x2*)((bf16_t*)(ws + WS_HB) + (size_t)row * D_) + F.lane;
#pragma unroll
                        for (int j = 0; j < 4; ++j) { u32x2 w; w.x = cvtpk(v[q][j].x * r * gg[j].x, v[q][j].y * r * gg[j].y); w.y = cvtpk(v[q][j].z * r * gg[j].z, v[q][j].w * r * gg[j].w); o8[64 * j] = w; } } }
            }
        }
    }
    if (do_moe_w) {
        constexpr int NI = NE * (I_UP1 + I_DN1);
        for (int it = gw; it < NI; it += NGW) {
            int r = it;
            if (r < NE * I_UP1) { const int e = r / I_UP1; p0_transpose_item_fp8(w_up + (size_t)e * D_ * 2 * DFF, D_, 2 * DFF, (unsigned char*)(ws + WS_WUP) + (size_t)e * 2 * DFF * D_, scr, r % I_UP1, F.lane, W8_SCALE); continue; }
            r -= NE * I_UP1;
            { const int e = r / I_DN1; p0_transpose_item_fp8(w_down + (size_t)e * DFF * D_, DFF, D_, (unsigned char*)(ws + WS_WDN) + (size_t)e * D_ * DFF, scr, r % I_DN1, F.lane, W8_SCALE); }
        }
    }
}

__device__ __forceinline__ void ld16bf(const bf16_t* p, float (&v)[16]) {
    const u32x4 a = *(const u32x4*)p, b = *(const u32x4*)(p + 8);
    v[0] = bflo(a.x); v[1] = bfhi(a.x); v[2] = bflo(a.y); v[3] = bfhi(a.y); v[4] = bflo(a.z); v[5] = bfhi(a.z); v[6] = bflo(a.w); v[7] = bfhi(a.w);
    v[8] = bflo(b.x); v[9] = bfhi(b.x); v[10] = bflo(b.y); v[11] = bfhi(b.y); v[12] = bflo(b.z); v[13] = bfhi(b.z); v[14] = bflo(b.w); v[15] = bfhi(b.w);
}
__device__ __forceinline__ void st16bf(bf16_t* p, const float (&v)[16]) {
    u32x4 a, b; a.x = cvtpk(v[0], v[1]); a.y = cvtpk(v[2], v[3]); a.z = cvtpk(v[4], v[5]); a.w = cvtpk(v[6], v[7]);
    b.x = cvtpk(v[8], v[9]); b.y = cvtpk(v[10], v[11]); b.z = cvtpk(v[12], v[13]); b.w = cvtpk(v[14], v[15]);
    *(u32x4*)p = a; *(u32x4*)(p + 8) = b;
}
struct PrepIn { unsigned cq0, cq1, cq2; u32x2 ckv; u32x4 qa, qb, ka, kb, vv; float rope; };
__device__ __forceinline__ void p4_load(PrepIn& in, int row, const bf16_t* proj, const bf16_t* qraw, const bf16_t* kvraw, const float* rope, int lane) {
    const int h = lane >> 3, s = lane & 7;
    const bf16_t* pr = proj + (size_t)row * INWP;
    { const bf16_t* p = pr + C_CQ + lane * 6; in.cq0 = *(const unsigned*)p; in.cq1 = *(const unsigned*)(p + 2); in.cq2 = *(const unsigned*)(p + 4); }
    in.ckv = *(const u32x2*)(pr + C_CKV + lane * 4);
    in.rope = rope[(size_t)row * 32 + (lane & 31)];
    const u32x4 z = {0u, 0u, 0u, 0u};
    in.qa = z; in.qb = z; in.ka = z; in.kb = z;
    if (s < 6) { const bf16_t* q = qraw + (size_t)row * 768 + h * 96 + s * 16; in.qa = *(const u32x4*)q; in.qb = *(const u32x4*)(q + 8);
        const bf16_t* k = (s < 4) ? (kvraw + (size_t)row * 1024 + h * 128 + s * 16) : (pr + C_KR + (s - 4) * 16); in.ka = *(const u32x4*)k; in.kb = *(const u32x4*)(k + 8); }
    in.vv = *(const u32x4*)(kvraw + (size_t)row * 1024 + (lane >> 3) * 128 + 64 + (lane & 7) * 8);
}
__device__ __forceinline__ void unpack16(const u32x4 a, const u32x4 b, float (&v)[16]) {
    v[0] = bflo(a.x); v[1] = bfhi(a.x); v[2] = bflo(a.y); v[3] = bfhi(a.y); v[4] = bflo(a.z); v[5] = bfhi(a.z); v[6] = bflo(a.w); v[7] = bfhi(a.w);
    v[8] = bflo(b.x); v[9] = bfhi(b.x); v[10] = bflo(b.y); v[11] = bfhi(b.y); v[12] = bflo(b.z); v[13] = bfhi(b.z); v[14] = bflo(b.w); v[15] = bfhi(b.w);
}
__device__ __forceinline__ void p4_prep(Frame& F, const Args& a) {
    unsigned char* ws = F.ws;
    const bf16_t* proj = (const bf16_t*)(ws + WS_PROJ); const bf16_t* qraw = (const bf16_t*)(ws + WS_QRAW); const bf16_t* kvraw = (const bf16_t*)(ws + WS_KVRAW);
    bf16_t* QB = (bf16_t*)(ws + WS_QB); bf16_t* KB = (bf16_t*)(ws + WS_KB); bf16_t* VB = (bf16_t*)(ws + WS_VB);
    const float* rope = (const float*)(ws + WS_ROPE); const float* gq = a.in[8]; const float* gk = a.in[9];
    const int gw = F.vcu * NWAVES + F.wave, NGW = F.G * NWAVES, lane = F.lane, h = lane >> 3, s = lane & 7;
    float gqv[16], gkv[16];
#pragma unroll
    for (int j = 0; j < 16; ++j) { gqv[j] = (s < 6) ? gq[s * 16 + j] : 0.f; gkv[j] = (s < 6) ? gk[s * 16 + j] : 0.f; }
    PrepIn cur, nxt;
    if (gw < M_) p4_load(cur, gw, proj, qraw, kvraw, rope, lane);
    for (int row = gw; row < M_; row += NGW) {
        const bool hn = row + NGW < M_;
        if (hn) p4_load(nxt, row + NGW, proj, qraw, kvraw, rope, lane);
        float sq = bflo(cur.cq0) * bflo(cur.cq0) + bfhi(cur.cq0) * bfhi(cur.cq0) + bflo(cur.cq1) * bflo(cur.cq1) + bfhi(cur.cq1) * bfhi(cur.cq1) + bflo(cur.cq2) * bflo(cur.cq2) + bfhi(cur.cq2) * bfhi(cur.cq2);
        float skv = bflo(cur.ckv.x) * bflo(cur.ckv.x) + bfhi(cur.ckv.x) * bfhi(cur.ckv.x) + bflo(cur.ckv.y) * bflo(cur.ckv.y) + bfhi(cur.ckv.y) * bfhi(cur.ckv.y);
        sq = wave_sum(sq); skv = wave_sum(skv);
        const float var_cq = sq * (1.f / 384.f) + EPS;
        const float rstd_ckv = rsqrtf(skv * (1.f / 256.f) + EPS);
        float cs[16], sn[16];
#pragma unroll
        for (int j = 0; j < 16; ++j) { cs[j] = __int_as_float(__builtin_amdgcn_readlane(__float_as_int(cur.rope), j)); sn[j] = __int_as_float(__builtin_amdgcn_readlane(__float_as_int(cur.rope), 16 + j)); }
        {
            float v[16]; unpack16(cur.qa, cur.qb, v);
            float ss = 0.f;
#pragma unroll
            for (int j = 0; j < 16; ++j) ss += v[j] * v[j];
            ss = sum8(ss);
            const float r = rsqrtf(ss * (1.f / 96.f) + EPS * var_cq);
#pragma unroll
            for (int j = 0; j < 16; ++j) v[j] = v[j] * r * gqv[j];
            float o[16];
#pragma unroll
            for (int j = 0; j < 16; ++j) { const float pv = DPP_F(v[j], DPP_X1);
                o[j] = (s == 4) ? (v[j] * cs[j] - pv * sn[j]) : (s == 5) ? (v[j] * cs[j] + pv * sn[j]) : v[j]; o[j] *= MLA_QSCALE; }
            if (s < 6) st16bf(QB + (size_t)row * 768 + h * 96 + s * 16, o);
        }
        {
            float v[16]; unpack16(cur.ka, cur.kb, v);
            if (s < 4) {
#pragma unroll
                for (int j = 0; j < 16; ++j) v[j] *= rstd_ckv; }
            float ss = 0.f;
#pragma unroll
            for (int j = 0; j < 16; ++j) ss += v[j] * v[j];
            ss = sum8(ss);
            const float r = rsqrtf(ss * (1.f / 96.f) + EPS);
#pragma unroll
            for (int j = 0; j < 16; ++j) v[j] = v[j] * r * gkv[j];
            float o[16];
#pragma unroll
            for (int j = 0; j < 16; ++j) { const float pv = DPP_F(v[j], DPP_X1);
                o[j] = (s == 4) ? (v[j] * cs[j] - pv * sn[j]) : (s == 5) ? (v[j] * cs[j] + pv * sn[j]) : v[j]; }
            if (s < 6) st16bf(KB + (size_t)row * 768 + h * 96 + s * 16, o);
            const u32x4 vw = cur.vv;
            u32x4 ow; ow.x = cvtpk(bflo(vw.x) * rstd_ckv, bfhi(vw.x) * rstd_ckv); ow.y = cvtpk(bflo(vw.y) * rstd_ckv, bfhi(vw.y) * rstd_ckv);
            ow.z = cvtpk(bflo(vw.z) * rstd_ckv, bfhi(vw.z) * rstd_ckv); ow.w = cvtpk(bflo(vw.w) * rstd_ckv, bfhi(vw.w) * rstd_ckv);
            *(u32x4*)(VB + (size_t)row * 512 + lane * 8) = ow;
        }
        if (hn) cur = nxt;
    }
}
namespace att {
constexpr int BUFB = 20480;
constexpr int WREG = 8448;
constexpr int OST_OFF = 2 * BUFB;
constexpr int WSF_OFF = OST_OFF + 8 * WREG;
constexpr int FLG_OFF = WSF_OFF + 8 * 256;
__device__ __forceinline__ int crow(int r, int hi) { return (r & 3) + 8 * (r >> 2) + 4 * hi; }
__device__ __forceinline__ s16x4 vtr(const LAS char* p) { typedef short v4i16_t __attribute__((ext_vector_type(4))); return __builtin_bit_cast(s16x4, __builtin_amdgcn_ds_read_tr16_b64_v4i16((LAS v4i16_t*)p)); }
#define ATT_MFMA(a, b, c) __builtin_amdgcn_mfma_f32_32x32x16_bf16((a), (b), (c), 0, 0, 0)

template <int NCH> struct Stage {
    u32x4 k0, k1, v0;
    __device__ __forceinline__ void load(const bf16_t* Kb, int pitchK, const bf16_t* Vb, int pitchV, int key0, int wid, int lane) {
        k0 = *(const u32x4*)(Kb + (size_t)(key0 + lane) * pitchK + wid * 8);
        if (NCH > 8) { if (wid < NCH - 8) k1 = *(const u32x4*)(Kb + (size_t)(key0 + lane) * pitchK + (8 + wid) * 8); }
        v0 = *(const u32x4*)(Vb + (size_t)(key0 + 16 * (wid & 3) + (lane >> 2)) * pitchV + (wid >> 2) * 32 + (lane & 3) * 8);
    }
    __device__ __forceinline__ void write(LAS unsigned char* buf, int wid, int lane) const {
        *(LAS u32x4*)(buf + wid * 1024 + lane * 16) = k0;
        if (NCH > 8) { if (wid < NCH - 8) *(LAS u32x4*)(buf + (8 + wid) * 1024 + lane * 16) = k1; }
        *(LAS u32x4*)(buf + NCH * 1024 + wid * 1024 + lane * 16) = v0;
    }
};

__device__ __forceinline__ void pv_tile(f32x16 (&o)[2], const LAS char* vp, const bf16x8 (&pa)[4]) {
    __builtin_amdgcn_s_setprio(1);
#pragma unroll
    for (int d0 = 0; d0 < 2; ++d0)
#pragma unroll
        for (int ks = 0; ks < 4; ++ks) {
            const s16x4 lo = vtr(vp + d0 * 4096 + ks * 1024), hi = vtr(vp + d0 * 4096 + ks * 1024 + 512);
            const bf16x8 vf = __builtin_shufflevector(lo, hi, 0, 1, 2, 3, 4, 5, 6, 7);
            o[d0] = ATT_MFMA(pa[ks], vf, o[d0]);
        }
    __builtin_amdgcn_s_setprio(0);
}
__device__ __forceinline__ bf16x8 pack8(const f32x16& p, int base) {
    u32x4 w; w.x = cvtpk(p[base], p[base + 1]); w.y = cvtpk(p[base + 2], p[base + 3]); w.z = cvtpk(p[base + 4], p[base + 5]); w.w = cvtpk(p[base + 6], p[base + 7]);
    return __builtin_bit_cast(bf16x8, w);
}
__device__ __forceinline__ void store_o(const f32x16 (&o)[2], const float (&rs)[16], LAS unsigned char* lds, int wid, int lane, bf16_t* Ow) {
    const int r32 = lane & 31, hi = lane >> 5;
    LAS bf16_t* stg = (LAS bf16_t*)(lds + OST_OFF + wid * WREG);
#pragma unroll
    for (int r = 0; r < 16; ++r) { const int orow = crow(r, hi);
#pragma unroll
        for (int d0 = 0; d0 < 2; ++d0) { const unsigned w = cvtpk(o[d0][r] * rs[r], 0.f); stg[orow * 64 + d0 * 32 + r32] = (bf16_t)(w & 0xffffu); } }
    asm volatile("s_waitcnt lgkmcnt(0)" ::: "memory");
#pragma unroll
    for (int i = 0; i < 4; ++i) { const int row = i * 8 + (lane >> 3), ch = lane & 7; const u32x4 v = *(const LAS u32x4*)(stg + row * 64 + ch * 8); *(u32x4*)(Ow + (size_t)row * 512 + ch * 8) = v; }
    asm volatile("s_waitcnt lgkmcnt(0)" ::: "memory");
}


constexpr int MLA_CONV_PERIOD = 4;
struct Conv {
    const float* w_up; const float* w_down; unsigned char* up8; unsigned char* dn8; int item, step, ctr; bool inflight; f32x4 tv[8];
    static constexpr int I_UP1 = (D_ / 64) * (2 * DFF / 32), I_DN1 = (DFF / 64) * (D_ / 32), NI = NE * (I_UP1 + I_DN1);
    const float* src; unsigned char* dst; int K, N;
    __device__ __forceinline__ bool pending() const { return item < NI; }
    __device__ __forceinline__ void load(int lane) { load_to(tv, lane); }
    __device__ __forceinline__ void load_to(f32x4 (&t)[8], int lane) {
        int r = item;
        if (r < NE * I_UP1) { const int e = r / I_UP1; r %= I_UP1; K = D_; N = 2 * DFF; const int nblk = N / 32, kb = r / nblk, nb = r % nblk; src = w_up + (size_t)e * D_ * 2 * DFF + (size_t)(64 * kb) * N + 32 * nb; dst = up8 + (size_t)e * 2 * DFF * D_ + (size_t)(32 * nb) * K + 64 * kb; }
        else { r -= NE * I_UP1; const int e = r / I_DN1; r %= I_DN1; K = DFF; N = D_; const int nblk = N / 32, kb = r / nblk, nb = r % nblk; src = w_down + (size_t)e * DFF * D_ + (size_t)(64 * kb) * N + 32 * nb; dst = dn8 + (size_t)e * D_ * DFF + (size_t)(32 * nb) * K + 64 * kb; }
        const float* p = src + (size_t)(8 * (lane >> 3)) * N + 4 * (lane & 7);
#pragma unroll
        for (int j = 0; j < 8; ++j) t[j] = *(const f32x4*)(p + (size_t)j * N);
    }
    __device__ __forceinline__ void finish(LAS float* scr, int lane) { finish_from(tv, scr, lane); }
    __device__ __forceinline__ void finish_from(const f32x4 (&t)[8], LAS float*, int lane) {
        unsigned char* q = dst + (size_t)(4 * (lane & 7)) * K + 8 * (lane >> 3);
#pragma unroll
        for (int c4 = 0; c4 < 4; ++c4) {
            u32x2 o; o.x = pk_fp8x4(t[0][c4] * W8_SCALE, t[1][c4] * W8_SCALE, t[2][c4] * W8_SCALE, t[3][c4] * W8_SCALE); o.y = pk_fp8x4(t[4][c4] * W8_SCALE, t[5][c4] * W8_SCALE, t[6][c4] * W8_SCALE, t[7][c4] * W8_SCALE);
            *(u32x2*)(q + (size_t)c4 * K) = o; }
        item += step;
    }
    __device__ __forceinline__ void tick_begin(int lane) { if (!inflight && ctr == 0 && pending()) { load(lane); inflight = true; } }
    __device__ __forceinline__ void tick_end(LAS float* scr, int lane) { if (inflight && ctr == 2) { finish(scr, lane); inflight = false; } ctr = (ctr == MLA_CONV_PERIOD - 1) ? 0 : ctr + 1; }
    __device__ __forceinline__ void flush(LAS float* scr, int lane) { if (inflight) { finish(scr, lane); inflight = false; } ctr = 0; }
    __device__ __forceinline__ void drain(LAS float* scr, int lane) { while (pending()) { f32x4 t2[8]; load_to(t2, lane); finish_from(t2, scr, lane); } }
};
__device__ __forceinline__ void mla_unit(LAS unsigned char* lds, int b, int h, int qb, const bf16_t* QB, const bf16_t* KB, const bf16_t* VB, bf16_t* O, float m0, Conv& cv) {
    const int tid = threadIdx.x, lane = tid & 63, r32 = lane & 31, hi = lane >> 5; const int wid = __builtin_amdgcn_readfirstlane(tid >> 6);
    const size_t rb = (size_t)b * S_; const int q0 = qb * 256;
    const bf16_t* Kh = KB + rb * 768 + h * 96; const bf16_t* Vh = VB + rb * 512 + h * 64;
    bf16x8 qr[6];
    { const bf16_t* qp = QB + (rb + q0 + wid * 32 + r32) * 768 + h * 96 + hi * 8;
#pragma unroll
      for (int d0 = 0; d0 < 6; ++d0) qr[d0] = *(const bf16x8*)(qp + d0 * 16); }
    const int NT = 4 * qb + 4, my_last = 4 * qb + (wid >> 1);
    f32x16 o[2]; float l = 0.f;
#pragma unroll
    for (int r = 0; r < 16; ++r) { o[0][r] = 0.f; o[1][r] = 0.f; }
    f32x16 negm;
#pragma unroll
    for (int r = 0; r < 16; ++r) negm[r] = -m0;
    asm volatile("" : "+v"(negm));
    Stage<12> st;
    st.load(Kh, 768, Vh, 512, 0, wid, lane); st.write(lds, wid, lane);
    __syncthreads();
    LAS float* cscr = (LAS float*)(lds + OST_OFF + wid * WREG);
    for (int t = 0; t < NT; ++t) {
        if (t + 1 < NT) st.load(Kh, 768, Vh, 512, (t + 1) * 64, wid, lane);
        asm volatile("" ::: "memory");
        cv.tick_begin(lane);
        if (t <= my_last) {
            const LAS char* buf = (const LAS char*)(lds + (t & 1) * BUFB);
            const LAS char* kp = buf + hi * 1024 + r32 * 16;
            f32x16 p0, p1;
            __builtin_amdgcn_s_setprio(1);
#pragma unroll
            for (int d0 = 0; d0 < 6; ++d0) { const bf16x8 a0 = *(const LAS bf16x8*)(kp + d0 * 2048), a1 = *(const LAS bf16x8*)(kp + d0 * 2048 + 512);
#ifndef ABL_NOQK
                if (d0 == 0) { p0 = ATT_MFMA(a0, qr[0], negm); p1 = ATT_MFMA(a1, qr[0], negm); }
                else { p0 = ATT_MFMA(a0, qr[d0], p0); p1 = ATT_MFMA(a1, qr[d0], p1); }
#else
                if (d0 == 0) { p0 = negm; p1 = negm; } asm volatile("" :: "v"(a0), "v"(a1));
#endif
            }
            __builtin_amdgcn_s_setprio(0);
            float ls = 0.f;
#ifndef ABL_NOEXP
#pragma unroll
            for (int r = 0; r < 16; ++r) { p0[r] = __builtin_amdgcn_exp2f(p0[r]); p1[r] = __builtin_amdgcn_exp2f(p1[r]); ls += p0[r] + p1[r]; }
#endif
            l += ls;
            bf16x8 pa[4]; pa[0] = pack8(p0, 0); pa[1] = pack8(p0, 8); pa[2] = pack8(p1, 0); pa[3] = pack8(p1, 8);
            const LAS char* vp = buf + 12 * 1024 + ((lane >> 4) & 1) * 32 + (lane & 3) * 8 + (4 * hi + ((lane & 15) >> 2)) * 64;
#ifndef ABL_NOPV
            pv_tile(o, vp, pa);
#else
            asm volatile("" :: "v"(pa[0]), "v"(pa[1]), "v"(pa[2]), "v"(pa[3]), "v"(vp));
#endif
        }
        if (t + 1 < NT) st.write(lds + ((t + 1) & 1) * BUFB, wid, lane);
        cv.tick_end(cscr, lane);
        __syncthreads();
    }
    l += __shfl_xor(l, 32);
    LAS float* wsf = (LAS float*)(lds + WSF_OFF) + wid * 64;
    if (hi == 0) wsf[r32] = l;
    asm volatile("s_waitcnt lgkmcnt(0)" ::: "memory");
    float rs[16];
#pragma unroll
    for (int r = 0; r < 16; ++r) rs[r] = __builtin_amdgcn_rcpf(wsf[crow(r, hi)]);
    store_o(o, rs, lds, wid, lane, O + (rb + q0 + wid * 32) * 512 + h * 64);
}

__device__ __forceinline__ void sb_unit(LAS unsigned char* lds, int b, int h, int qb, const bf16_t* proj, bf16_t* O, Conv& cv) {
    const int tid = threadIdx.x, lane = tid & 63, r32 = lane & 31, hi = lane >> 5; const int wid = __builtin_amdgcn_readfirstlane(tid >> 6);
    const size_t rb = (size_t)b * S_; const int q0 = qb * 256;
    const bf16_t* Kh = proj + rb * INWP + C_SBK + h * 64; const bf16_t* Vh = proj + rb * INWP + C_SBV + h * 64;
    bf16x8 qr[4];
    { const bf16_t* qp = proj + (rb + q0 + wid * 32 + r32) * INWP + C_SBQ + h * 64 + hi * 8;
#pragma unroll
      for (int d0 = 0; d0 < 4; ++d0) qr[d0] = *(const bf16x8*)(qp + d0 * 16); }
    const int Ttop = 4 * qb + 3, qw0 = q0 + wid * 32, qabs = qw0 + r32;
    f32x16 o[2]; float carry = 1.f;
#pragma unroll
    for (int r = 0; r < 16; ++r) { o[0][r] = 0.f; o[1][r] = 0.f; }
    volatile LAS int* flg = (volatile LAS int*)(lds + FLG_OFF);
    Stage<8> st;
    st.load(Kh, INWP, Vh, INWP, Ttop * 64, wid, lane); st.write(lds, wid, lane);
    __syncthreads();
    bool alive = true;
    for (int it = 0;; ++it) {
        const int t = Ttop - it;
        if (t > 0) st.load(Kh, INWP, Vh, INWP, (t - 1) * 64, wid, lane);
        asm volatile("" ::: "memory");
        f32x4 ctv[8]; const bool cvp = cv.pending() && (((it + wid) & 1) == 0);
        if (cvp) cv.load_to(ctv, lane);
        if (alive && (64 * t <= qw0 + 30)) {
            const LAS char* buf = (const LAS char*)(lds + (it & 1) * BUFB);
            const LAS char* kp = buf + hi * 1024 + r32 * 16;
            const bool need_mask = (64 * t + 63 >= qw0);
            bf16x8 pa[4];
#pragma unroll
            for (int blk = 1; blk >= 0; --blk) {
                f32x16 p;
#pragma unroll
                for (int r = 0; r < 16; ++r) p[r] = 0.f;
#pragma unroll
                for (int d0 = 0; d0 < 4; ++d0) { const bf16x8 a0 = *(const LAS bf16x8*)(kp + d0 * 2048 + blk * 512); p = ATT_MFMA(a0, qr[d0], p); }
                const int kb0 = 64 * t + 32 * blk + 4 * hi;
                f32x16 s;
#pragma unroll
                for (int r = 0; r < 16; ++r) {
                    const int key = kb0 + (r & 3) + 8 * (r >> 2);
                    const float tt = __builtin_amdgcn_exp2f(-fmaxf(p[r], -80.f)); float be = __builtin_amdgcn_rcpf(1.f + tt); float sy = tt * be;
                    if (need_mask && !(key < qabs)) { be = 0.f; sy = 1.f; }
                    p[r] = be; s[r] = sy;
                }
                float T[5]; T[4] = 1.f;
#pragma unroll
                for (int i = 3; i >= 0; --i) T[i] = T[i + 1] * ((s[4 * i] * s[4 * i + 1]) * (s[4 * i + 2] * s[4 * i + 3]));
                float Tp[5]; Tp[4] = 1.f;
#pragma unroll
                for (int i = 0; i < 4; ++i) Tp[i] = __shfl_xor(T[i], 32);
#pragma unroll
                for (int i = 3; i >= 0; --i) {
                    float lat = carry * (T[i + 1] * (hi ? Tp[i + 1] : Tp[i]));
#pragma unroll
                    for (int e3 = 3; e3 >= 0; --e3) { const int r = 4 * i + e3; const float sy = s[r]; p[r] = p[r] * lat; lat *= sy; }
                }
                carry *= T[0] * Tp[0];
                pa[2 * blk] = pack8(p, 0); pa[2 * blk + 1] = pack8(p, 8);
            }
            const LAS char* vp = buf + 8 * 1024 + ((lane >> 4) & 1) * 32 + (lane & 3) * 8 + (4 * hi + ((lane & 15) >> 2)) * 64;
            pv_tile(o, vp, pa);
            alive = __any(carry > 0.f);
        }
        if (lane == 0) flg[(it & 1) * 8 + wid] = alive ? 1 : 0;
        if (t > 0) st.write(lds + ((it + 1) & 1) * BUFB, wid, lane);
        if (cvp) cv.finish_from(ctv, (LAS float*)(lds + OST_OFF + wid * WREG), lane);
        __syncthreads();
        if (t == 0) break;
        int any = 0;
#pragma unroll
        for (int w = 0; w < 8; ++w) any |= flg[(it & 1) * 8 + w];
        if (!any) break;
    }
    float rs[16];
#pragma unroll
    for (int r = 0; r < 16; ++r) rs[r] = 1.f;
    store_o(o, rs, lds, wid, lane, O + (rb + q0 + wid * 32) * 512 + h * 64);
}
}

__device__ __forceinline__ void p5_attention(Frame& F, const Args& a) {
    unsigned char* ws = F.ws;
    volatile LAS int* citem = (volatile LAS int*)(F.MISC + MI_CITEM) + F.wave;
    {
        float gm;
        { const float* gq = a.in[8]; const float* gk = a.in[9]; float mq = 0.f, mk = 0.f;
          for (int i = F.lane; i < 96; i += 64) { mq = fmaxf(mq, fabsf(gq[i])); mk = fmaxf(mk, fabsf(gk[i])); }
#pragma unroll
          for (int o = 1; o < 64; o <<= 1) { mq = fmaxf(mq, __shfl_xor(mq, o)); mk = fmaxf(mk, __shfl_xor(mk, o)); }
          gm = 9.79795897f * LOG2E * mq * mk; }
        att::Conv cv; cv.w_up = a.in[16]; cv.w_down = a.in[18]; cv.up8 = (unsigned char*)(ws + WS_WUP); cv.dn8 = (unsigned char*)(ws + WS_WDN);
        cv.item = F.vcu * NWAVES + F.wave; cv.step = F.G * NWAVES; cv.ctr = F.wave % att::MLA_CONV_PERIOD; cv.inflight = false;
#ifdef ABL_NOCONV
        cv.item = att::Conv::NI;
#endif
        for (int v = F.vcu; v < 256; v += F.G) {
            const int bh = v >> 3, s = v & 7, b = bh >> 3, h = bh & 7;
            for (int i = 0; i < 2; ++i) { const int qb = i ? 15 - s : s;
                att::mla_unit(F.lds, b, h, qb, (const bf16_t*)(ws + WS_QB), (const bf16_t*)(ws + WS_KB), (const bf16_t*)(ws + WS_VB), (bf16_t*)(ws + WS_OMLA), gm, cv);
                __syncthreads(); }
        }
        cv.flush((LAS float*)(F.lds + att::OST_OFF + F.wave * att::WREG), F.lane);
        if (F.lane == 0) *citem = cv.item;
    }
    __syncthreads();
#ifdef MEGA_STAMPS
    if (blockIdx.x == 0 && F.tid == 0) ((unsigned long long*)(ws + WS_CTL + 32768))[12] = __builtin_amdgcn_s_memrealtime();
#endif
    {
        att::Conv cv; cv.w_up = a.in[16]; cv.w_down = a.in[18]; cv.up8 = (unsigned char*)(ws + WS_WUP); cv.dn8 = (unsigned char*)(ws + WS_WDN);
        cv.item = __builtin_amdgcn_readfirstlane(*citem); cv.step = F.G * NWAVES; cv.ctr = 0; cv.inflight = false;
        for (int v = F.vcu; v < 256; v += F.G) {
            const int bh = v >> 3, s = v & 7, b = bh >> 3, h = bh & 7;
            for (int i = 0; i < 2; ++i) { const int qb = i ? 15 - s : s;
                att::sb_unit(F.lds, b, h, qb, (const bf16_t*)(ws + WS_PROJ), (bf16_t*)(ws + WS_OSB), cv);
                __syncthreads(); }
        }
        cv.drain((LAS float*)(F.lds + att::OST_OFF + F.wave * att::WREG), F.lane);
    }
}

__device__ __forceinline__ void p8_router(Frame& F, const Args& a) {
    unsigned char* ws = F.ws;
    const bf16_t* x1 = (const bf16_t*)(ws + WS_X1B); const float* wr = (const float*)(ws + WS_WR); const float* br = a.in[15]; const float* g = a.in[13];
    unsigned char* H2 = (unsigned char*)(ws + WS_H2F8); int* list = (int*)(ws + WS_LIST); float* topw = (float*)(ws + WS_TOPW); int* selo = (int*)(ws + WS_SEL);
    int* cnt = (int*)(ws + WS_CTL) + CW_CNT;
    volatile LAS int* lcnt = (volatile LAS int*)(F.MISC + MI_LCNT); volatile LAS int* lbase = (volatile LAS int*)(F.MISC + MI_BASE);
    const int lane = F.lane, wave = F.wave, tid = F.tid;
    constexpr int WST = 1028;
    LAS float* wt = (LAS float*)F.lds;
    if (F.vcu < M_ / 64) {
        for (int i = tid; i < D_ * NE / 4; i += NTHR) { const f32x4 v = *(const f32x4*)(wr + (size_t)i * 4); const int k = i >> 3, e = (i & 7) * 4;
            wt[(e + 0) * WST + k] = v.x; wt[(e + 1) * WST + k] = v.y; wt[(e + 2) * WST + k] = v.z; wt[(e + 3) * WST + k] = v.w; }
    }
    __syncthreads();
    for (int task = F.vcu; task < M_ / 64; task += F.G) {
        const int T0 = task * 64;
        if (tid < 32) lcnt[tid] = 0;
        __syncthreads();
        int my_e = 0, my_rank = 0; float my_w = 0.f;
        if (wave < 4) {
            const int tk = lane & 15, kp = lane >> 4, tok = T0 + wave * 16 + tk;
            const bf16_t* xp = x1 + (size_t)tok * D_ + kp * 256;
            const LAS float* w0 = wt + tk * WST + kp * 256; const LAS float* w1 = w0 + 16 * WST;
            f32x4 acc0 = {0.f, 0.f, 0.f, 0.f}, acc1 = {0.f, 0.f, 0.f, 0.f}; float ssq = 0.f;
#pragma unroll 4
            for (int i = 0; i < 256; i += 4) {
                const u32x2 aw = *(const u32x2*)(xp + i); const f32x4 a4 = {bflo(aw.x), bfhi(aw.x), bflo(aw.y), bfhi(aw.y)}; const f32x4 b0 = *(const LAS f32x4*)(w0 + i), b1 = *(const LAS f32x4*)(w1 + i);
                ssq += (a4.x * a4.x + a4.y * a4.y) + (a4.z * a4.z + a4.w * a4.w);
#pragma unroll
                for (int j = 0; j < 4; ++j) { acc0 = __builtin_amdgcn_mfma_f32_16x16x4f32(a4[j], b0[j], acc0, 0, 0, 0); acc1 = __builtin_amdgcn_mfma_f32_16x16x4f32(a4[j], b1[j], acc1, 0, 0, 0); }
            }
            ssq += __shfl_xor(ssq, 16); ssq += __shfl_xor(ssq, 32);
            const float rstd = rsqrtf(ssq * (1.f / D_) + EPS);
            const int e0 = lane & 15, grp = lane >> 4;
            const float bia0 = br[e0], bia1 = br[e0 + 16];
#pragma unroll
            for (int j = 0; j < 4; ++j) {
                const float rs = __shfl(rstd, 4 * grp + j);
                float c0 = acc0[j] * rs + bia0, c1 = acc1[j] * rs + bia1;
                float sv[4]; int si[4];
#pragma unroll
                for (int k = 0; k < 4; ++k) {
                    float best = c0; int bi = e0;
                    if (c1 > best) { best = c1; bi = e0 + 16; }
#pragma unroll
                    for (int st_ = 0; st_ < 4; ++st_) { const int ctl = st_ == 0 ? DPP_X1 : st_ == 1 ? DPP_X2 : st_ == 2 ? DPP_HM : DPP_RM;
                        float ob; int oi;
                        if (st_ == 0) { ob = DPP_F(best, DPP_X1); oi = DPP_I(bi, DPP_X1); } else if (st_ == 1) { ob = DPP_F(best, DPP_X2); oi = DPP_I(bi, DPP_X2); } else if (st_ == 2) { ob = DPP_F(best, DPP_HM); oi = DPP_I(bi, DPP_HM); } else { ob = DPP_F(best, DPP_RM); oi = DPP_I(bi, DPP_RM); }
                        (void)ctl; if (ob > best || (ob == best && oi < bi)) { best = ob; bi = oi; } }
                    sv[k] = best; si[k] = bi;
                    if (bi == e0) c0 = -INFINITY; if (bi == e0 + 16) c1 = -INFINITY;
                }
                float ex[4], sum = 0.f;
#pragma unroll
                for (int k = 0; k < 4; ++k) { ex[k] = __expf(sv[k] - sv[0]); sum += ex[k]; }
                const float inv = 1.f / sum;
                if (((lane >> 2) & 3) == j) {
#pragma unroll
                    for (int k = 0; k < 4; ++k) if ((lane & 3) == k) { my_e = si[k]; my_w = ex[k] * inv; }
                }
            }
            my_rank = atomicAdd((int*)&lcnt[my_e], 1);
        } else {
            const f32x4* gr = (const f32x4*)g + lane;
            f32x4 gg[4];
#pragma unroll
            for (int j = 0; j < 4; ++j) gg[j] = gr[64 * j] * X8_SCALE;
            for (int rr = 0; rr < 16; rr += 4) {
                const int t0 = T0 + (wave - 4) * 16 + rr;
                f32x4 v[4][4]; float s[4];
#pragma unroll
                for (int q = 0; q < 4; ++q) { const u32x2* xr = (const u32x2*)(x1 + (size_t)(t0 + q) * D_) + lane;
#pragma unroll
                    for (int j = 0; j < 4; ++j) { const u32x2 w = xr[64 * j]; v[q][j] = (f32x4){bflo(w.x), bfhi(w.x), bflo(w.y), bfhi(w.y)}; } }
#pragma unroll
                for (int q = 0; q < 4; ++q) { s[q] = 0.f;
#pragma unroll
                    for (int j = 0; j < 4; ++j) s[q] += (v[q][j].x * v[q][j].x + v[q][j].y * v[q][j].y) + (v[q][j].z * v[q][j].z + v[q][j].w * v[q][j].w); }
#pragma unroll
                for (int q = 0; q < 4; ++q) { const float r = rsqrtf(wave_sum(s[q]) * (1.f / D_) + EPS); unsigned* o = (unsigned*)(H2 + (size_t)(t0 + q) * D_) + lane;
#pragma unroll
                    for (int j = 0; j < 4; ++j) o[64 * j] = pk_fp8x4(v[q][j].x * r * gg[j].x, v[q][j].y * r * gg[j].y, v[q][j].z * r * gg[j].z, v[q][j].w * r * gg[j].w); }
            }
        }
        __syncthreads();
        if (tid < 32) lbase[tid] = lcnt[tid] ? atomicAdd(&cnt[tid], lcnt[tid]) : 0;
        __syncthreads();
        if (wave < 4) {
            const int grp = lane >> 4, jj = (lane >> 2) & 3, kk = lane & 3;
            const int tok = T0 + wave * 16 + 4 * grp + jj, slot = tok * 4 + kk;
            list[(size_t)my_e * M_ + lbase[my_e] + my_rank] = slot; ((float*)(ws + WS_LISTW))[(size_t)my_e * M_ + lbase[my_e] + my_rank] = my_w;
            topw[slot] = my_w; selo[slot] = my_e;
        }
        __syncthreads();
    }
}

struct MoeOrder {
    const bf16_t* A; const bf16_t* Bt; const int* list; volatile LAS unsigned* tab;
    int lda, ldb, nN, nwg, G, c, gather; size_t estride;
    __device__ void init(const bf16_t* A_, int lda_, const bf16_t* Bt_, int ldb_, size_t estride_, int nN_, const int* list_, volatile LAS unsigned* tab_, int gather_, int G_, int c_) {
        A = A_; lda = lda_; Bt = Bt_; ldb = ldb_; estride = estride_; nN = nN_; list = list_; tab = tab_; gather = gather_; G = G_; c = c_; nwg = (int)tab[MI_TPFX + NE] * nN_; }
    __device__ __forceinline__ bool next(int i, pg8::Unit& u) const {
        const long L = (long)i * G + c; if (L >= nwg) return false;
        int wgid = (int)L; { const int q = nwg / 8, r = nwg % 8, xcd = wgid % 8, off = wgid / 8; wgid = (xcd < r ? xcd * (q + 1) : r * (q + 1) + (xcd - r) * q) + off; }
        int e = 0;
        for (int k = 1; k < NE; ++k) if ((int)tab[MI_TPFX + k] * nN <= wgid) e = k;
        const int t0 = (int)tab[MI_TPFX + e], nt = (int)tab[MI_TPFX + e + 1] - t0, idx = wgid - t0 * nN;
        u.e = e; u.pn = idx / nt; u.rt = idx % nt; u.pm = t0 + u.rt; const int left = (int)tab[MI_CNT + e] - u.rt * 256; u.rows = left < 256 ? left : 256; return true;
    }
    __device__ __forceinline__ unsigned a_off(const pg8::Unit& u, int r, int C) const {
        int row;
        if (gather) row = (r < u.rows) ? (list[(size_t)u.e * M_ + u.rt * 256 + r] >> 2) : M_;
        else row = u.pm * 256 + r;
        return (unsigned)((row * lda + C) * 2);
    }
    __device__ __forceinline__ const char* b_base(const pg8::Unit& u) const { return (const char*)(Bt + (size_t)u.e * estride + (size_t)u.pn * 256 * ldb); }
};
__device__ __forceinline__ void moe_table(Frame& F) {
    int* cnt = (int*)(F.ws + WS_CTL) + CW_CNT;
    if (F.tid < NE) F.MISC[MI_CNT + F.tid] = __hip_atomic_load((unsigned*)cnt + F.tid, RLX_AGENT);
    __syncthreads();
    if (F.tid == 0) { unsigned p = 0; for (int e = 0; e < NE; ++e) { F.MISC[MI_TPFX + e] = p; p += (F.MISC[MI_CNT + e] + 255u) >> 8; } F.MISC[MI_TPFX + NE] = p; }
    __syncthreads();
}

__device__ __forceinline__ void p12_combine(Frame& F, const Args& a) {
    const bf16_t* Y = (const bf16_t*)(F.ws + WS_YB); const bf16_t* X1 = (const bf16_t*)(F.ws + WS_X1B); float* out = a.out;
    const int gt = (F.vcu * NWAVES + F.wave) * 64 + F.lane, NGT = F.G * NTHR;
    for (int i = gt; i < M_ * D_ / 8; i += NGT) {
        const int t = i >> 7, c = (i & 127) * 8;
        u32x4 w[5];
        w[4] = *(const u32x4*)(X1 + (size_t)t * D_ + c);
#pragma unroll
        for (int k = 0; k < 4; ++k) w[k] = *(const u32x4*)(Y + (size_t)(t * 4 + k) * D_ + c);
        f32x4 v0 = {bflo(w[4].x), bfhi(w[4].x), bflo(w[4].y), bfhi(w[4].y)}, v1 = {bflo(w[4].z), bfhi(w[4].z), bflo(w[4].w), bfhi(w[4].w)};
#pragma unroll
        for (int k = 0; k < 4; ++k) { v0.x += bflo(w[k].x); v0.y += bfhi(w[k].x); v0.z += bflo(w[k].y); v0.w += bfhi(w[k].y); v1.x += bflo(w[k].z); v1.y += bfhi(w[k].z); v1.z += bflo(w[k].w); v1.w += bfhi(w[k].w); }
        *(f32x4*)(out + (size_t)t * D_ + c) = v0; *(f32x4*)(out + (size_t)t * D_ + c + 4) = v1;
    }
}

constexpr int N_PHASES = 11;
#ifndef DUP_PHASE
#define DUP_PHASE -1
#endif
__global__ void __launch_bounds__(NTHR, 2) mega(Args args) {
    extern __shared__ __attribute__((aligned(16))) unsigned char lds_raw[];
    Frame F;
    F.lds = (LAS unsigned char*)lds_raw; F.MISC = (volatile LAS unsigned*)(F.lds + LDS_MISC);
    F.tid = threadIdx.x; F.lane = F.tid & 63; F.wave = __builtin_amdgcn_readfirstlane(F.tid >> 6);
    F.G = gridDim.x; { const int bx = blockIdx.x; F.vcu = (F.G % 8 == 0) ? (bx % 8) * (F.G / 8) + bx / 8 : bx; }
    F.ws = args.ws;
    unsigned char* ws = args.ws;
    for (int u = F.tid; u < (LDS_BYTES - LDS_MISC) / 4; u += NTHR) F.MISC[u] = 0u;
    __syncthreads();
    const int lo = args.ph_lo, hi = args.ph_hi;
    XcdBarrier bar; bar.bar = (unsigned*)(ws + WS_CTL) + CW_BAR; bar.x = 0; bar.st = nullptr;
    if (hi - lo > 1) bar = xcd_barrier_post((unsigned*)(ws + WS_CTL) + CW_BAR, F.MISC + MI_BAR);
#define IN(k) (lo <= (k) && (k) < hi)
#ifdef MEGA_STAMPS
#define STAMP(k) do { if (blockIdx.x == 0 && F.tid == 0) ((unsigned long long*)(ws + WS_CTL + 32768))[(k)] = __builtin_amdgcn_s_memrealtime(); } while (0)
#else
#define STAMP(k) do { } while (0)
#endif
#define SEAM(k) do { if (IN(k) && IN((k) + 1)) xcd_barrier(bar); STAMP((k) + 1); } while (0)
    const int cid = (int)blockIdx.x;
    STAMP(0);

    if (IN(0)) { p0_prologue(F, args, 0, 1); SEAM(0); }
    if (IN(1)) {
        pg8::Gemm g{(const bf16_t*)(ws + WS_HB), D_, D_, D_};
        pg8::StaticOrder S; S.init(g.A, D_, (const bf16_t*)(ws + WS_WIN), D_, M_, 4096, F.G, cid);
        pg8::EpiBf16 E{(bf16_t*)(ws + WS_PROJ), INWP};
        pg8::gemm_phase(F.lds, g, S, E);
        SEAM(1);
    }
    if (IN(2)) {
        { pg8::Gemm g{(const bf16_t*)(ws + WS_HB), D_, D_, D_};
          pg8::StaticOrder S; S.init(g.A, D_, (const bf16_t*)(ws + WS_WIN) + (size_t)4096 * D_, D_, M_, 256, F.G, cid);
          pg8::EpiBf16 E{(bf16_t*)(ws + WS_PROJ) + 4096, INWP};
          pg8::gemm_phase(F.lds, g, S, E); }
        { pg8::Gemm g{(const bf16_t*)(ws + WS_PROJ) + C_CQ, INWP, 384, 384};
          pg8::StaticOrder S; S.init(g.A, INWP, (const bf16_t*)(ws + WS_WUQ), 384, M_, 768, F.G, cid, F.G - 64);
          pg8::EpiBf16 E{(bf16_t*)(ws + WS_QRAW), 768};
          pg8::gemm_phase(F.lds, g, S, E); }
        { pg8::Gemm g{(const bf16_t*)(ws + WS_PROJ) + C_CKV, INWP, 256, 256};
          pg8::StaticOrder S; S.init(g.A, INWP, (const bf16_t*)(ws + WS_WUKV), 256, M_, 1024, F.G, cid);
          pg8::EpiBf16 E{(bf16_t*)(ws + WS_KVRAW), 1024};
          pg8::gemm_phase(F.lds, g, S, E); }
        SEAM(2);
    }
    if (IN(3)) { p4_prep(F, args); SEAM(3); }
    if (IN(4)) { p5_attention(F, args); SEAM(4); }
    if (IN(5)) {
        pg8::Gemm g{(const bf16_t*)(ws + WS_OSB), 512, 512, 512};
        pg8::PairOrder S; S.S.init(g.A, 512, (const bf16_t*)(ws + WS_WOSB), 512, M_, D_, F.G, cid); S.a1 = (WS_OMLA - WS_OSB) / 2; S.b1 = (WS_WOMLA - WS_WOSB) / 2;
        pg8::EpiGate2 E{(bf16_t*)(ws + WS_MIX), (const bf16_t*)(ws + WS_PROJ), INWP, C_GSB, C_GMLA};
        pg8::gemm_phase(F.lds, g, S, E);
        SEAM(5);
    }
    if (IN(6)) {
        pg8::Gemm g{(const bf16_t*)(ws + WS_MIX), D_, D_, D_};
        pg8::StaticOrder S; S.init(g.A, D_, (const bf16_t*)(ws + WS_WOUT), D_, M_, D_, F.G, cid);
        pg8::EpiRes E{args.in[0], (bf16_t*)(ws + WS_X1B)};
        pg8::gemm_phase(F.lds, g, S, E);
        SEAM(6);
    }
    if (IN(7)) { p8_router(F, args); SEAM(7); }
    if (IN(8)) {
        moe_table(F);
        pg8::Gemm g{(const bf16_t*)(ws + WS_H2F8), D_ / 2, D_ / 2, D_ / 2};
        MoeOrder S; S.init(g.A, D_ / 2, (const bf16_t*)(ws + WS_WUP), D_ / 2, (size_t)2 * DFF * D_ / 2, 8, (const int*)(ws + WS_LIST), F.MISC, 1, F.G, cid);
        pg8::EpiSwiglu8 E{(unsigned char*)(ws + WS_ACT), args.in[17]};
        pg8::gemm_phase<pg8::EpiSwiglu8, MoeOrder, true>(F.lds, g, S, E);
        SEAM(8);
    }
    if (IN(9)) {
        moe_table(F);
        pg8::Gemm g{(const bf16_t*)(ws + WS_ACT), DFF / 2, DFF / 2, DFF / 2};
        MoeOrder S; S.init(g.A, DFF / 2, (const bf16_t*)(ws + WS_WDN), DFF / 2, (size_t)D_ * DFF / 2, 4, (const int*)(ws + WS_LIST), F.MISC, 0, F.G, cid);
        pg8::EpiDown E{(bf16_t*)(ws + WS_YB), args.in[19], (const int*)(ws + WS_LIST), (const float*)(ws + WS_LISTW)};
        pg8::gemm_phase<pg8::EpiDown, MoeOrder, true>(F.lds, g, S, E);
        SEAM(9);
    }
    if (IN(10)) { p12_combine(F, args); STAMP(11); }
#undef IN
#undef SEAM
}
static int g_grid = 0;
static int setup_grid() {
    if (g_grid == 0) {
        int dev = 0, cus = 0;
        if (hipGetDevice(&dev) != hipSuccess || hipDeviceGetAttribute(&cus, hipDeviceAttributeMultiprocessorCount, dev) != hipSuccess) { g_grid = -1; return g_grid; }
        if (hipFuncSetAttribute((const void*)mega, hipFuncAttributeMaxDynamicSharedMemorySize, LDS_BYTES) != hipSuccess) { g_grid = -1; return g_grid; }
        int per_cu = 0;
        (void)hipOccupancyMaxActiveBlocksPerMultiprocessor(&per_cu, (const void*)mega, NTHR, LDS_BYTES);
        (void)hipGetLastError();
        g_grid = cus;
    }
    return g_grid;
}
static void launch_mega(void* const* d_in, void* d_out, void* d_ws, int lo, int hi, hipStream_t stream) {
    Args a; memset(&a, 0, sizeof(a));
    for (int i = 0; i < 20; ++i) a.in[i] = (const float*)d_in[i];
    a.out = (float*)d_out; a.ws = (unsigned char*)d_ws; a.ph_lo = lo; a.ph_hi = hi;
    hipLaunchKernelGGL(mega, dim3(g_grid), dim3(NTHR), LDS_BYTES, stream, a);
}
extern "C" void kernel_launch(void* const* d_in, const int* in_sizes, int n_in, void* d_out, int out_size, void* d_ws, size_t ws_size, hipStream_t stream) {
    if (n_in != 20 || ws_size < WS_OPT_END || out_size != M_ * D_) { fprintf(stderr, "kernel_launch: unexpected arguments\n"); return; }
    if (setup_grid() <= 0) return;
    (void)hipMemsetAsync((char*)d_ws + WS_CTL, 0, CTL_ZERO_BYTES, stream);
#if N_LAUNCH_SPLIT
    for (int p = 0; p < N_PHASES; ++p) { launch_mega(d_in, d_out, d_ws, p, p + 1, stream); if (p == DUP_PHASE) { if (p == 7) (void)hipMemsetAsync((char*)d_ws + WS_CTL, 0, 128, stream); if (p == 10) launch_mega(d_in, d_out, d_ws, 6, 7, stream); launch_mega(d_in, d_out, d_ws, p, p + 1, stream); } }
#else
    launch_mega(d_in, d_out, d_ws, 0, N_PHASES, stream);
#endif
}
```

```cpp
#define N_LAUNCH_SPLIT 0
#include <hip/hip_runtime.h>
#include <hip/hip_bf16.h>
#include <cstdio>
#include <cstdint>
#include <cstring>
#include <cmath>

constexpr int B_ = 4, S_ = 4096, D_ = 1024, M_ = B_ * S_;
constexpr int INW = 4256, INWP = 4352;
constexpr int C_SBQ = 0, C_SBK = 512, C_SBV = 1024, C_CQ = 1536, C_CKV = 1920, C_KR = 2176, C_GSB = 2208, C_GMLA = 3232;
constexpr int NE = 32, TOPK = 4, DFF = 1024;
constexpr float EPS = 1e-6f;
constexpr float LOG2E = 1.4426950408889634f;
constexpr float SB_QSCALE = 0.125f * LOG2E;
constexpr float MLA_QSCALE = 0.10206207261596577f * LOG2E;
constexpr int NWAVES = 8, NTHR = 512;

#define LAS __attribute__((address_space(3)))
#define GAS __attribute__((address_space(1)))
typedef unsigned short bf16_t;
typedef short bf16x8 __attribute__((ext_vector_type(8)));
typedef short s16x4 __attribute__((ext_vector_type(4)));
typedef float f32x4 __attribute__((ext_vector_type(4)));
typedef float f32x16 __attribute__((ext_vector_type(16)));
typedef unsigned u32x4 __attribute__((ext_vector_type(4)));
typedef unsigned u32x2 __attribute__((ext_vector_type(2)));
typedef float f32x2_t __attribute__((ext_vector_type(2)));
typedef __bf16 bf16x2_t __attribute__((ext_vector_type(2)));
typedef int v8i_t __attribute__((ext_vector_type(8)));
constexpr float W8_SCALE = 8.f, X8_SCALE = 8.f;
__device__ __forceinline__ unsigned pk_fp8x4(float a, float b, float c, float d) { unsigned w = 0; w = __builtin_amdgcn_cvt_pk_fp8_f32(a, b, w, false); w = __builtin_amdgcn_cvt_pk_fp8_f32(c, d, w, true); return w; }

__device__ __forceinline__ unsigned cvtpk(float lo, float hi) { f32x2_t v = {lo, hi}; bf16x2_t b = __builtin_convertvector(v, bf16x2_t); return __builtin_bit_cast(unsigned, b); }
__device__ __forceinline__ float bf2f(unsigned short h) { return __uint_as_float(((unsigned)h) << 16); }
__device__ __forceinline__ float bflo(unsigned w) { return __uint_as_float(w << 16); }
__device__ __forceinline__ float bfhi(unsigned w) { return __uint_as_float(w & 0xffff0000u); }
__device__ __forceinline__ float dpp_f(float v, int ctrl) { return v; }
#define DPP_F(v, ctrl) __int_as_float(__builtin_amdgcn_update_dpp(0, __float_as_int(v), (ctrl), 0xF, 0xF, true))
#define DPP_I(v, ctrl) __builtin_amdgcn_update_dpp(0, (v), (ctrl), 0xF, 0xF, true)
#define DPP_X1 0xB1
#define DPP_X2 0x4E
#define DPP_HM 0x141
#define DPP_RM 0x140
__device__ __forceinline__ float wave_sum(float v) {
    v += DPP_F(v, DPP_X1); v += DPP_F(v, DPP_X2); v += DPP_F(v, DPP_HM); v += DPP_F(v, DPP_RM);
    return (__int_as_float(__builtin_amdgcn_readlane(__float_as_int(v), 0)) + __int_as_float(__builtin_amdgcn_readlane(__float_as_int(v), 16)))
         + (__int_as_float(__builtin_amdgcn_readlane(__float_as_int(v), 32)) + __int_as_float(__builtin_amdgcn_readlane(__float_as_int(v), 48)));
}
__device__ __forceinline__ float sum8(float v) { v += DPP_F(v, DPP_X1); v += DPP_F(v, DPP_X2); v += DPP_F(v, DPP_HM); return v; }
__device__ __forceinline__ float sigmoidf_(float x) { return __builtin_amdgcn_rcpf(1.f + __builtin_amdgcn_exp2f(-x * LOG2E)); }

namespace pg8 {
constexpr int BM = 256, BK = 64, HALF = 128, HTB = HALF * BK * 2, STAGE_BYTES = 8 * HTB, NXCD = 8, WGM = 8;
__host__ __device__ __forceinline__ int lds_byte(int r, int c) { const int st = (r >> 4) * 2 + (c >> 5), rr = r & 15, cc = c & 31, ob = rr * 64 + cc * 2; return st * 1024 + (ob ^ (((ob >> 9) & 1) << 5)); }
__host__ __device__ __forceinline__ void stage_rc(int b, int& R, int& C) { const int st = b / 1024, sb = b % 1024, swz = sb ^ (((sb >> 9) & 1) << 5); R = (st >> 1) * 16 + swz / 64; C = (st & 1) * 32 + (swz % 64) / 2; }
__host__ __device__ __forceinline__ int perm32(int rho) { const int n = rho >> 4, i = rho & 15; return 8 * (i >> 2) + 4 * n + (i & 3); }

struct Unit { int pm, pn, e, rows, rt; };
struct Gemm { const bf16_t* A; int lda, ldb, K; };

struct StaticOrder {
    const bf16_t* A; const bf16_t* Bt; int lda, ldb;
    int nM, nN, nwg, G, c;
    __device__ void init(const bf16_t* A_, int lda_, const bf16_t* Bt_, int ldb_, int M, int N, int G_, int c_, int cshift = 0) { A = A_; Bt = Bt_; lda = lda_; ldb = ldb_; nM = M / BM; nN = N / BM; nwg = nM * nN; G = G_; c = (c_ + cshift) % G_; }
    __device__ __forceinline__ bool next(int i, Unit& u) const {
        const long L = (long)i * G + c; if (L >= nwg) return false;
        int wgid = (int)L; { const int q = nwg / NXCD, r = nwg % NXCD, xcd = wgid % NXCD, off = wgid / NXCD; wgid = (xcd < r ? xcd * (q + 1) : r * (q + 1) + (xcd - r) * q) + off; }
        const int nig = WGM * nN, gid = wgid / nig, fm = gid * WGM, gsz = (nM - fm) < WGM ? (nM - fm) : WGM;
        u.pm = fm + ((wgid % nig) % gsz); u.pn = (wgid % nig) / gsz; u.e = 0; u.rows = 256; u.rt = 0; return true;
    }
    __device__ __forceinline__ unsigned a_off(const Unit& u, int r, int C) const { return (unsigned)(((u.pm * BM + r) * lda + C) * 2); }
    __device__ __forceinline__ const char* b_base(const Unit& u) const { return (const char*)(Bt + (size_t)u.pn * BM * ldb); }
};

__device__ __forceinline__ v8i_t ld32_lds(const LAS unsigned char* p) { const u32x4 lo_ = *(const LAS u32x4*)p, hi_ = *(const LAS u32x4*)(p + 1024); return (v8i_t){(int)lo_.x, (int)lo_.y, (int)lo_.z, (int)lo_.w, (int)hi_.x, (int)hi_.y, (int)hi_.z, (int)hi_.w}; }
struct PairOrder {
    StaticOrder S; size_t a1, b1;
    __device__ __forceinline__ bool next(int i, Unit& u) const { if (!S.next(i >> 1, u)) return false; u.e = i & 1; return true; }
    __device__ __forceinline__ unsigned a_off(const Unit& u, int r, int C) const { return S.a_off(u, r, C) + (unsigned)(u.e ? a1 * 2 : 0); }
    __device__ __forceinline__ const char* b_base(const Unit& u) const { return S.b_base(u) + (u.e ? b1 * 2 : 0); }
};
__device__ __forceinline__ void mfma_f8(f32x4& c, const v8i_t a, const v8i_t b, int sa, int sb) {
    asm volatile("v_mfma_scale_f32_16x16x128_f8f6f4 %0, %1, %2, %0, %3, %4 op_sel_hi:[0,0,0]" : "+v"(c) : "v"(a), "v"(b), "v"(sa), "v"(sb));
}
template <bool F8> struct FragT { typedef bf16x8 type; };
template <> struct FragT<true> { typedef v8i_t type; };
template <class Epi, class Sched, bool FP8 = false>
__device__ __forceinline__ void gemm_phase(LAS unsigned char* lds, const Gemm g, const Sched& S, const Epi& E) {
    const int tid = threadIdx.x, wid = __builtin_amdgcn_readfirstlane(tid >> 6), lane = tid & 63, wr = wid >> 2, wc = wid & 3, fr = lane & 15, fq = lane >> 4;
    const int K = g.K, nt = K / BK;
    unsigned voffB[2];
#pragma unroll
    for (int i = 0; i < 2; ++i) { int R, C; stage_rc(tid * 16 + i * 8192, R, C); const int Rb = Epi::PERM ? ((R & ~31) + perm32(R & 31)) : R; voffB[i] = (unsigned)(Rb * g.ldb + C) * 2u; }
#define PG8_AOFF(dst, unit) do { int t_ = tid; asm volatile("" : "+v"(t_)); _Pragma("unroll") for (int i = 0; i < 2; ++i) { int R, C; stage_rc(t_ * 16 + i * 8192, R, C); \
        _Pragma("unroll") for (int h = 0; h < 2; ++h) dst[h][i] = S.a_off(unit, h * HALF + R, C); } } while (0)
    const size_t kstep = (size_t)(BK * 2);
    const size_t hstepB = (size_t)HALF * g.ldb * 2;
    const unsigned ldsw = (unsigned)wid * 1024u;
    const int aoff = lds_byte(wr * 64 + fr, fq * 8), boff = lds_byte(wc * 32 + fr, fq * 8);
#define PG8_SA(b, h) (((b) * 2 + (h)) * HTB)
#define PG8_SB(b, h) ((4 + (b) * 2 + (h)) * HTB)
#define PG8_STAGE(bufoff, gbase, voff) do { _Pragma("unroll") for (int _i = 0; _i < 2; ++_i) \
        __builtin_amdgcn_global_load_lds((const unsigned*)((const char*)(gbase) + (voff)[_i]), (LAS unsigned*)(lds + (bufoff) + ldsw + _i * 8192), 16, 0, 0); } while (0)
#define PG8_LD32(p) ld32_lds((const LAS unsigned char*)(p))
#define PG8_LDA(dst, b, h) do { if constexpr (FP8) { _Pragma("unroll") for (int m = 0; m < 4; ++m) dst[m][0] = __builtin_bit_cast(FT, PG8_LD32(lds + PG8_SA(b, h) + aoff + m * 2048)); } \
        else { _Pragma("unroll") for (int m = 0; m < 4; ++m) _Pragma("unroll") for (int k = 0; k < 2; ++k) dst[m][k] = __builtin_bit_cast(FT, *(const LAS FT*)(lds + PG8_SA(b, h) + aoff + m * 2048 + k * 1024)); } } while (0)
#define PG8_LDB(dst, b, h) do { if constexpr (FP8) { _Pragma("unroll") for (int n = 0; n < 2; ++n) dst[n][0] = __builtin_bit_cast(FT, PG8_LD32(lds + PG8_SB(b, h) + boff + n * 2048)); } \
        else { _Pragma("unroll") for (int n = 0; n < 2; ++n) _Pragma("unroll") for (int k = 0; k < 2; ++k) dst[n][k] = __builtin_bit_cast(FT, *(const LAS FT*)(lds + PG8_SB(b, h) + boff + n * 2048 + k * 1024)); } } while (0)
#define PG8_MMA(ai, bj, At, Bt) do { __builtin_amdgcn_s_setprio(1); \
        if constexpr (FP8) { _Pragma("unroll") for (int m = 0; m < 4; ++m) _Pragma("unroll") for (int n = 0; n < 2; ++n) \
            mfma_f8(acc[ai][bj][m][n], __builtin_bit_cast(v8i_t, Bt[n][0]), __builtin_bit_cast(v8i_t, At[m][0]), 0x7c7c7c7c, 0x7c7c7c7c); } \
        else { _Pragma("unroll") for (int m = 0; m < 4; ++m) _Pragma("unroll") for (int n = 0; n < 2; ++n) _Pragma("unroll") for (int k = 0; k < 2; ++k) \
            acc[ai][bj][m][n] = __builtin_amdgcn_mfma_f32_16x16x32_bf16(__builtin_bit_cast(bf16x8, Bt[n][k]), __builtin_bit_cast(bf16x8, At[m][k]), acc[ai][bj][m][n], 0, 0, 0); } \
        __builtin_amdgcn_s_setprio(0); } while (0)
#define PG8_WAIT_V(n) asm volatile("s_waitcnt vmcnt(" #n ")" ::: "memory")
#define PG8_WAIT_L(n) asm volatile("s_waitcnt lgkmcnt(" #n ")" ::: "memory")
#define PG8_BAR __builtin_amdgcn_s_barrier()
#define PG8_SCHED __builtin_amdgcn_sched_barrier(0)
    Unit cur, nxt; int ui = 0;
    if (!S.next(0, cur)) return;
    f32x4 acc[2][2][4][2];
#pragma unroll
    for (int a = 0; a < 2; ++a)
#pragma unroll
        for (int b = 0; b < 2; ++b)
#pragma unroll
            for (int m = 0; m < 4; ++m)
#pragma unroll
                for (int n = 0; n < 2; ++n) acc[a][b][m][n] = (f32x4){0.f, 0.f, 0.f, 0.f};
    typedef typename FragT<FP8>::type FT; constexpr int NK = FP8 ? 1 : 2;
    FT At[4][NK], B0[2][NK], B1[2][NK];
    const char* Ab = (const char*)g.A;
    const char* cB = S.b_base(cur);
    unsigned vaC[2][2], vaN[2][2];
    PG8_AOFF(vaC, cur);
    PG8_STAGE(PG8_SB(0, 0), cB, voffB); PG8_STAGE(PG8_SB(0, 1), cB + hstepB, voffB); PG8_STAGE(PG8_SA(0, 0), Ab, vaC[0]); PG8_STAGE(PG8_SA(0, 1), Ab, vaC[1]);
    if (wr == 1) PG8_BAR;
    PG8_WAIT_V(2); PG8_BAR;
    PG8_STAGE(PG8_SB(1, 0), cB + kstep, voffB); PG8_STAGE(PG8_SA(1, 0), Ab + kstep, vaC[0]); PG8_STAGE(PG8_SB(1, 1), cB + hstepB + kstep, voffB);
    PG8_WAIT_V(6); PG8_BAR;
    for (;;) {
        const bool has_next = S.next(ui + 1, nxt);
        const char* nB = has_next ? S.b_base(nxt) : cB;
        if (has_next) PG8_AOFF(vaN, nxt);
        else {
#pragma unroll
            for (int h = 0; h < 2; ++h)
#pragma unroll
                for (int i = 0; i < 2; ++i) vaN[h][i] = vaC[h][i]; }
        for (int t = 0; t < nt; t += 2) {
            const bool last = (t == nt - 2);
            const char* kA1 = Ab + (size_t)(t + 1) * kstep;
            const char* kA2 = last ? Ab : Ab + (size_t)(t + 2) * kstep; const char* b2 = last ? nB : cB + (size_t)(t + 2) * kstep;
            const char* kA3 = kA2 + kstep; const char* b3 = b2 + kstep;
            unsigned o2[2][2];
#pragma unroll
            for (int h = 0; h < 2; ++h)
#pragma unroll
                for (int i = 0; i < 2; ++i) o2[h][i] = last ? vaN[h][i] : vaC[h][i];
            PG8_LDB(B0, 0, 0); PG8_LDB(B1, 0, 1); PG8_SCHED; PG8_LDA(At, 0, 0); PG8_STAGE(PG8_SA(1, 1), kA1, vaC[1]);
            PG8_WAIT_V(8); PG8_WAIT_L(0); PG8_BAR; PG8_MMA(0, 0, At, B0); PG8_MMA(0, 1, At, B1); PG8_BAR; PG8_SCHED;
            PG8_LDA(At, 0, 1); PG8_STAGE(PG8_SB(0, 0), b2, voffB); PG8_STAGE(PG8_SB(0, 1), b2 + hstepB, voffB); PG8_STAGE(PG8_SA(0, 0), kA2, o2[0]);
            PG8_WAIT_V(8); PG8_WAIT_L(0); PG8_BAR; PG8_MMA(1, 0, At, B0); PG8_MMA(1, 1, At, B1); PG8_BAR; PG8_SCHED;
            PG8_LDB(B0, 1, 0); PG8_LDB(B1, 1, 1); PG8_SCHED; PG8_LDA(At, 1, 0); PG8_STAGE(PG8_SA(0, 1), kA2, o2[1]);
            PG8_WAIT_V(8); PG8_WAIT_L(0); PG8_BAR; PG8_MMA(0, 0, At, B0); PG8_MMA(0, 1, At, B1); PG8_BAR; PG8_SCHED;
            PG8_LDA(At, 1, 1); PG8_STAGE(PG8_SB(1, 0), b3, voffB); PG8_STAGE(PG8_SB(1, 1), b3 + hstepB, voffB); PG8_STAGE(PG8_SA(1, 0), kA3, o2[0]);
            PG8_WAIT_V(8); PG8_WAIT_L(0); PG8_BAR; PG8_MMA(1, 0, At, B0); PG8_MMA(1, 1, At, B1); PG8_BAR; PG8_SCHED;
        }
        if (wr == 0) PG8_BAR;
        if constexpr (FP8) asm volatile("s_nop 15\n\ts_nop 15" ::: "memory");
        E(acc, cur, wr, wc, fr, fq);
        if (!has_next) break;
#pragma unroll
        for (int a = 0; a < 2; ++a)
#pragma unroll
            for (int b = 0; b < 2; ++b)
#pragma unroll
                for (int m = 0; m < 4; ++m)
#pragma unroll
                    for (int n = 0; n < 2; ++n) acc[a][b][m][n] = (f32x4){0.f, 0.f, 0.f, 0.f};
        cur = nxt; cB = nB; ++ui;
#pragma unroll
        for (int h = 0; h < 2; ++h)
#pragma unroll
            for (int i = 0; i < 2; ++i) vaC[h][i] = vaN[h][i];
        if (wr == 1) PG8_BAR;
    }
    PG8_WAIT_V(0);
    PG8_BAR;
#undef PG8_SA
#undef PG8_AOFF
#undef PG8_SB
#undef PG8_STAGE
#undef PG8_LDA
#undef PG8_LDB
#undef PG8_MMA
#undef PG8_LD32
#undef PG8_WAIT_V
#undef PG8_WAIT_L
#undef PG8_BAR
#undef PG8_SCHED
}

struct EpiBf16 {
    static constexpr bool PERM = true;
    bf16_t* O; int ldc;
    __device__ __forceinline__ void operator()(const f32x4 (&acc)[2][2][4][2], const Unit& u, int wr, int wc, int fr, int fq) const {
        const int row0 = u.pm * BM + wr * 64 + fr, col0 = u.pn * BM + wc * 32 + 8 * fq;
#pragma unroll
        for (int ai = 0; ai < 2; ++ai)
#pragma unroll
            for (int m = 0; m < 4; ++m) { bf16_t* rowp = O + (size_t)(row0 + ai * HALF + m * 16) * ldc + col0;
#pragma unroll
                for (int bj = 0; bj < 2; ++bj) { const f32x4 v0 = acc[ai][bj][m][0], v1 = acc[ai][bj][m][1];
                    u32x4 w; w.x = cvtpk(v0[0], v0[1]); w.y = cvtpk(v0[2], v0[3]); w.z = cvtpk(v1[0], v1[1]); w.w = cvtpk(v1[2], v1[3]);
                    *(u32x4*)(rowp + bj * HALF) = w; } }
    }
};
struct EpiGate2 {
    static constexpr bool PERM = true;
    bf16_t* O; const bf16_t* G; int ldg, gcol0, gcol1;
    __device__ __forceinline__ void operator()(const f32x4 (&acc)[2][2][4][2], const Unit& u, int wr, int wc, int fr, int fq) const {
        const int row0 = u.pm * BM + wr * 64 + fr, col0 = u.pn * BM + wc * 32 + 8 * fq;
        const bool second = u.e != 0; const int gcol = second ? gcol1 : gcol0;
#pragma unroll
        for (int ai = 0; ai < 2; ++ai)
#pragma unroll
            for (int m = 0; m < 4; ++m) { const size_t r = (size_t)(row0 + ai * HALF + m * 16);
#pragma unroll
                for (int bj = 0; bj < 2; ++bj) { const f32x4 v0 = acc[ai][bj][m][0], v1 = acc[ai][bj][m][1];
                    const int c = col0 + bj * HALF;
                    const u32x4 gw = *(const u32x4*)(G + r * ldg + gcol + c);
                    bf16_t* op = O + r * D_ + c;
                    u32x4 pw = {0u, 0u, 0u, 0u}; if (second) pw = *(const u32x4*)op;
                    float o[8];
                    o[0] = sigmoidf_(bflo(gw.x)) * v0[0]; o[1] = sigmoidf_(bfhi(gw.x)) * v0[1]; o[2] = sigmoidf_(bflo(gw.y)) * v0[2]; o[3] = sigmoidf_(bfhi(gw.y)) * v0[3];
                    o[4] = sigmoidf_(bflo(gw.z)) * v1[0]; o[5] = sigmoidf_(bfhi(gw.z)) * v1[1]; o[6] = sigmoidf_(bflo(gw.w)) * v1[2]; o[7] = sigmoidf_(bfhi(gw.w)) * v1[3];
                    o[0] += bflo(pw.x); o[1] += bfhi(pw.x); o[2] += bflo(pw.y); o[3] += bfhi(pw.y); o[4] += bflo(pw.z); o[5] += bfhi(pw.z); o[6] += bflo(pw.w); o[7] += bfhi(pw.w);
                    u32x4 w; w.x = cvtpk(o[0], o[1]); w.y = cvtpk(o[2], o[3]); w.z = cvtpk(o[4], o[5]); w.w = cvtpk(o[6], o[7]);
                    *(u32x4*)op = w; } }
    }
};
struct EpiRes {
    static constexpr bool PERM = true;
    const float* base; bf16_t* out;
    __device__ __forceinline__ void operator()(const f32x4 (&acc)[2][2][4][2], const Unit& u, int wr, int wc, int fr, int fq) const {
        const int row0 = u.pm * BM + wr * 64 + fr, col0 = u.pn * BM + wc * 32 + 8 * fq;
#pragma unroll
        for (int ai = 0; ai < 2; ++ai)
#pragma unroll
            for (int m = 0; m < 4; ++m) { const size_t off = (size_t)(row0 + ai * HALF + m * 16) * D_ + col0;
#pragma unroll
                for (int bj = 0; bj < 2; ++bj) { const f32x4 v0 = *(const f32x4*)(base + off + bj * HALF) + acc[ai][bj][m][0], v1 = *(const f32x4*)(base + off + bj * HALF + 4) + acc[ai][bj][m][1];
                    u32x4 w; w.x = cvtpk(v0[0], v0[1]); w.y = cvtpk(v0[2], v0[3]); w.z = cvtpk(v1[0], v1[1]); w.w = cvtpk(v1[2], v1[3]);
                    *(u32x4*)(out + off + bj * HALF) = w; } }
    }
};
struct EpiSwiglu {
    static constexpr bool PERM = true;
    bf16_t* act; const float* b_up;
    __device__ __forceinline__ void operator()(const f32x4 (&acc)[2][2][4][2], const Unit& u, int wr, int wc, int fr, int fq) const {
        const int row0 = u.pm * BM + wr * 64 + fr, col0 = u.pn * BM + wc * 32 + 8 * fq;
        const float* bb = b_up + (size_t)u.e * (2 * DFF);
        f32x4 bv[2][2];
#pragma unroll
        for (int bj = 0; bj < 2; ++bj)
#pragma unroll
            for (int n = 0; n < 2; ++n) bv[bj][n] = *(const f32x4*)(bb + col0 + bj * HALF + 4 * n);
#pragma unroll
        for (int ai = 0; ai < 2; ++ai)
#pragma unroll
            for (int m = 0; m < 4; ++m) { bf16_t* rowp = act + (size_t)(row0 + ai * HALF + m * 16) * DFF + (col0 >> 1);
#pragma unroll
                for (int bj = 0; bj < 2; ++bj) { const f32x4 v0 = acc[ai][bj][m][0] + bv[bj][0], v1 = acc[ai][bj][m][1] + bv[bj][1];
                    float a[4];
#pragma unroll
                    for (int p = 0; p < 4; ++p) { float gl = (p < 2) ? v0[2 * p] : v1[2 * p - 4], li = (p < 2) ? v0[2 * p + 1] : v1[2 * p - 3];
                        gl = fminf(gl, 7.f); li = fminf(fmaxf(li, -7.f), 7.f);
                        a[p] = gl * sigmoidf_(1.702f * gl) * (li + 1.f); }
                    u32x2 w; w.x = cvtpk(a[0], a[1]); w.y = cvtpk(a[2], a[3]);
                    *(u32x2*)(rowp + bj * (HALF / 2)) = w; } }
    }
};
struct EpiSwiglu8 {
    static constexpr bool PERM = true;
    unsigned char* act; const float* b_up;
    __device__ __forceinline__ void operator()(const f32x4 (&acc)[2][2][4][2], const Unit& u, int wr, int wc, int fr, int fq) const {
        const int row0 = u.pm * BM + wr * 64 + fr, col0 = u.pn * BM + wc * 32 + 8 * fq;
        const float* bb = b_up + (size_t)u.e * (2 * DFF);
        f32x4 bv[2][2];
#pragma unroll
        for (int bj = 0; bj < 2; ++bj)
#pragma unroll
            for (int n = 0; n < 2; ++n) bv[bj][n] = *(const f32x4*)(bb + col0 + bj * HALF + 4 * n);
#pragma unroll
        for (int ai = 0; ai < 2; ++ai)
#pragma unroll
            for (int m = 0; m < 4; ++m) { unsigned char* rowp = act + (size_t)(row0 + ai * HALF + m * 16) * DFF + (col0 >> 1);
#pragma unroll
                for (int bj = 0; bj < 2; ++bj) { const f32x4 v0 = acc[ai][bj][m][0] + bv[bj][0], v1 = acc[ai][bj][m][1] + bv[bj][1];
                    float a[4];
#pragma unroll
                    for (int p = 0; p < 4; ++p) { float gl = (p < 2) ? v0[2 * p] : v1[2 * p - 4], li = (p < 2) ? v0[2 * p + 1] : v1[2 * p - 3];
                        gl = fminf(gl, 7.f); li = fminf(fmaxf(li, -7.f), 7.f);
                        a[p] = gl * sigmoidf_(1.702f * gl) * fmaf(li, X8_SCALE, X8_SCALE); }
                    *(unsigned*)(rowp + bj * (HALF / 2)) = pk_fp8x4(a[0], a[1], a[2], a[3]); } }
    }
};
struct EpiDown {
    static constexpr bool PERM = true;
    bf16_t* y; const float* b_down; const int* list; const float* listw;
    __device__ __forceinline__ void operator()(const f32x4 (&acc)[2][2][4][2], const Unit& u, int wr, int wc, int fr, int fq) const {
        const int col0 = u.pn * BM + wc * 32 + 8 * fq;
        const float* bb = b_down + (size_t)u.e * D_;
        f32x4 bv[2][2];
#pragma unroll
        for (int bj = 0; bj < 2; ++bj)
#pragma unroll
            for (int n = 0; n < 2; ++n) bv[bj][n] = *(const f32x4*)(bb + col0 + bj * HALF + 4 * n);
        const int* lp = list + (size_t)u.e * M_ + u.rt * BM; const float* lw = listw + (size_t)u.e * M_ + u.rt * BM;
#pragma unroll
        for (int ai = 0; ai < 2; ++ai)
#pragma unroll
            for (int m = 0; m < 4; ++m) { const int r = ai * HALF + wr * 64 + m * 16 + fr;
                if (r < u.rows) { const int slot = lp[r]; const float w = lw[r]; bf16_t* rowp = y + (size_t)slot * D_ + col0;
#pragma unroll
                    for (int bj = 0; bj < 2; ++bj) { const f32x4 v0 = (acc[ai][bj][m][0] + bv[bj][0]) * w, v1 = (acc[ai][bj][m][1] + bv[bj][1]) * w;
                        u32x4 o; o.x = cvtpk(v0[0], v0[1]); o.y = cvtpk(v0[2], v0[3]); o.z = cvtpk(v1[0], v1[1]); o.w = cvtpk(v1[2], v1[3]);
                        *(u32x4*)(rowp + bj * HALF) = o; } } }
    }
};
}
constexpr size_t MiB = 1ull << 20;
constexpr size_t WS_CTL = 0, CTL_ZERO_BYTES = 64 * 1024;
constexpr size_t WS_ROPE = 256 * 1024;
constexpr size_t WS_WR = 3 * MiB;
constexpr size_t WS_LIST = 4 * MiB;
constexpr size_t WS_TOPW = 6 * MiB;
constexpr size_t WS_SEL = 6 * MiB + 512 * 1024;
constexpr size_t WS_LISTW = 594 * MiB;
constexpr size_t WS_WIN = 8 * MiB;
constexpr size_t WS_WUQ = 17 * MiB;
constexpr size_t WS_WUKV = 18 * MiB;
constexpr size_t WS_WOSB = 19 * MiB;
constexpr size_t WS_WOMLA = 20 * MiB;
constexpr size_t WS_WOUT = 21 * MiB;
constexpr size_t WS_WUP = 24 * MiB;
constexpr size_t WS_WDN = 152 * MiB;
constexpr size_t WS_HB = 216 * MiB;
constexpr size_t WS_PROJ = 249 * MiB;
constexpr size_t WS_ACT = WS_PROJ;
constexpr size_t WS_QRAW = 393 * MiB;
constexpr size_t WS_KVRAW = WS_QRAW + 24 * MiB;
constexpr size_t WS_QB = WS_KVRAW + 32 * MiB;
constexpr size_t WS_KB = WS_QB + 24 * MiB;
constexpr size_t WS_VB = WS_KB + 24 * MiB;
constexpr size_t WS_OSB = WS_VB + 16 * MiB;
constexpr size_t WS_OMLA = WS_OSB + 16 * MiB;
constexpr size_t WS_YB = WS_QRAW;
constexpr size_t WS_MIX = 545 * MiB;
constexpr size_t WS_H2F8 = 577 * MiB;
constexpr size_t WS_X1B = 596 * MiB;
constexpr size_t WS_VARCQ = 628 * MiB;
constexpr size_t WS_OPT_END = 629 * MiB;
constexpr int CW_CNT = 0;
constexpr int CW_BAR = 1024;
constexpr int LDS_STAGE = 143360;
constexpr int LDS_MISC = LDS_STAGE;
constexpr int LDS_BYTES = 147456;
constexpr int MI_BAR = 0, MI_TPFX = 16, MI_CNT = 64, MI_FLAG = 128, MI_LCNT = 160, MI_BASE = 192, MI_RSTD = 256, MI_CITEM = 320;

typedef GAS unsigned gu32;
#define RLX_AGENT __ATOMIC_RELAXED, __HIP_MEMORY_SCOPE_AGENT

#define XB_TMO      128
#define XB_XCNT(j)  (256  + 64 * (j))
#define XB_XSUB(j)  (1280 + 64 * (j))
#define XB_XGEN(j)  (2304 + 64 * (j))
#define XB_TOP      3328
#define XB_TOPGEN   3392
#define XCD_BAR_WORDS 3456
#define XB_SPIN_CAP (1u << 18)
__device__ __forceinline__ unsigned xb_ld(unsigned* p)              { return __hip_atomic_load(p, __ATOMIC_RELAXED, __HIP_MEMORY_SCOPE_AGENT); }
__device__ __forceinline__ unsigned xb_add(unsigned* p, unsigned v) { return __hip_atomic_fetch_add(p, v, __ATOMIC_RELAXED, __HIP_MEMORY_SCOPE_AGENT); }
__device__ __forceinline__ unsigned xb_xcc_id() { return (unsigned)__builtin_amdgcn_s_getreg((3 << 11) | 20) & 0xFu; }
#define XB_SPIN(cond, bar) do { unsigned _sp = 0; while (cond) { __builtin_amdgcn_s_sleep(1); \
    if ((++_sp & 255u) == 0u) { if (xb_ld(&(bar)[XB_TMO])) break; if (_sp > XB_SPIN_CAP) { atomicAdd(&(bar)[XB_TMO], 1u); break; } } } } while (0)
struct XcdBarrier { unsigned* bar; unsigned x; volatile LAS unsigned* st; };
__device__ __forceinline__ XcdBarrier xcd_barrier_post(unsigned* bar, volatile LAS unsigned* st) {
    XcdBarrier b; b.bar = bar; b.x = xb_xcc_id(); b.st = st;
    if (threadIdx.x == 0) (void)xb_add(&bar[XB_XCNT(b.x)], 1u);
    return b;
}
__device__ __forceinline__ void xcd_barrier_complete(unsigned* bar, unsigned x, unsigned& nloc, unsigned& nx) {
    const unsigned G = gridDim.x * gridDim.y * gridDim.z;
    unsigned sum, cnt, mine, sp = 0u;
    for (;;) {
        sum = 0u; cnt = 0u; mine = 0u;
#pragma unroll
        for (unsigned j = 0; j < 16; ++j) { const unsigned c = xb_ld(&bar[XB_XCNT(j)]); sum += c; cnt += (c > 0u) ? 1u : 0u; mine = (j == x) ? c : mine; }
        if (sum == G) break;
        __builtin_amdgcn_s_sleep(1);
        if ((++sp & 255u) == 0u) { if (xb_ld(&bar[XB_TMO])) break; if (sp > XB_SPIN_CAP) { atomicAdd(&bar[XB_TMO], 1u); break; } }
    }
    nloc = mine > 0u ? mine : 1u; nx = cnt > 0u ? cnt : 1u;
}
__device__ __forceinline__ void xcd_barrier(const XcdBarrier& b) {
    asm volatile("s_waitcnt vmcnt(0)" ::: "memory");
    __syncthreads();
    if (threadIdx.x == 0) {
        unsigned* bar = b.bar;
        __builtin_amdgcn_s_waitcnt(0);
        unsigned nloc = b.st[0], nx = b.st[1];
        if (nloc == 0u) { xcd_barrier_complete(bar, b.x, nloc, nx); b.st[0] = nloc; b.st[1] = nx; }
        const unsigned old = xb_add(&bar[XB_XSUB(b.x)], 1u);
        const unsigned gen = old / nloc;
        if (old + 1u == (gen + 1u) * nloc) {
            __builtin_amdgcn_fence(__ATOMIC_RELEASE, "agent");
            asm volatile("s_waitcnt vmcnt(0)" ::: "memory");
            const unsigned og = xb_add(&bar[XB_TOP], 1u);
            const unsigned tg = og / nx;
            if (og + 1u == (tg + 1u) * nx) xb_add(&bar[XB_TOPGEN], 1u);
            else XB_SPIN(xb_ld(&bar[XB_TOPGEN]) == tg, bar);
            __builtin_amdgcn_fence(__ATOMIC_ACQUIRE, "agent");
            xb_add(&bar[XB_XGEN(b.x)], 1u);
            asm volatile("s_waitcnt vmcnt(0)" ::: "memory");
        } else {
            XB_SPIN(xb_ld(&bar[XB_XGEN(b.x)]) == gen, bar);
            __builtin_amdgcn_fence(__ATOMIC_ACQUIRE, "agent");
            asm volatile("s_waitcnt vmcnt(0)" ::: "memory");
        }
    }
    __syncthreads();
}

struct Args {
    const float* in[20]; float* out; unsigned char* ws;
    int ph_lo, ph_hi;
};

struct Frame {
    LAS unsigned char* lds; volatile LAS unsigned* MISC;
    int tid, lane, wave, vcu, G;
    unsigned char* ws;
};

__device__ __forceinline__ void p0_transpose_item(const float* W, int K, int N, bf16_t* WT, LAS float* scr, int item, int lane, const float* gk, float cs, int csn) {
    const int nblk = N / 32, kb = item / nblk, nb = item % nblk, k0 = 64 * kb, n0 = 32 * nb;
    const float colsc = (n0 < csn) ? cs : 1.f;
    float tv[32];
#pragma unroll
    for (int i = 0; i < 32; ++i) { const int kk = 2 * i + (lane >> 5); tv[i] = W[(size_t)(k0 + kk) * N + n0 + (lane & 31)]; }
#pragma unroll
    for (int i = 0; i < 32; ++i) { const int kk = 2 * i + (lane >> 5); float v = tv[i] * colsc; if (gk) v *= gk[k0 + kk]; scr[kk * 33 + (lane & 31)] = v; }
    asm volatile("s_waitcnt lgkmcnt(0)" ::: "memory");
    const int c = lane & 7;
#pragma unroll
    for (int j = 0; j < 4; ++j) { const int n = (lane >> 3) + 8 * j; const LAS float* s = scr + (8 * c) * 33 + n;
        u32x4 o; o.x = cvtpk(s[0 * 33], s[1 * 33]); o.y = cvtpk(s[2 * 33], s[3 * 33]); o.z = cvtpk(s[4 * 33], s[5 * 33]); o.w = cvtpk(s[6 * 33], s[7 * 33]);
        *(u32x4*)(WT + (size_t)(n0 + n) * K + k0 + 8 * c) = o; }
    asm volatile("s_waitcnt lgkmcnt(0)" ::: "memory");
}
__device__ __forceinline__ void p0_transpose_item_fp8(const float* W, int K, int N, unsigned char* WT, LAS float* scr, int item, int lane, float cs) {
    const int nblk = N / 32, kb = item / nblk, nb = item % nblk, k0 = 64 * kb, n0 = 32 * nb;
    float tv[32];
#pragma unroll
    for (int i = 0; i < 32; ++i) { const int kk = 2 * i + (lane >> 5); tv[i] = W[(size_t)(k0 + kk) * N + n0 + (lane & 31)]; }
#pragma unroll
    for (int i = 0; i < 32; ++i) { const int kk = 2 * i + (lane >> 5); scr[kk * 33 + (lane & 31)] = tv[i] * cs; }
    asm volatile("s_waitcnt lgkmcnt(0)" ::: "memory");
    const int c = lane & 7;
#pragma unroll
    for (int j = 0; j < 4; ++j) { const int n = (lane >> 3) + 8 * j; const LAS float* s = scr + (8 * c) * 33 + n;
        u32x2 o; o.x = pk_fp8x4(s[0 * 33], s[1 * 33], s[2 * 33], s[3 * 33]); o.y = pk_fp8x4(s[4 * 33], s[5 * 33], s[6 * 33], s[7 * 33]);
        *(u32x2*)(WT + (size_t)(n0 + n) * K + k0 + 8 * c) = o; }
    asm volatile("s_waitcnt lgkmcnt(0)" ::: "memory");
}
__device__ __forceinline__ void rms_row_to_bf16(const float* xrow, const float* g, bf16_t* orow, int lane) {
    const f32x4* xr = (const f32x4*)xrow + lane; const f32x4* gr = (const f32x4*)g + lane;
    f32x4 v[4]; float s = 0.f;
#pragma unroll
    for (int j = 0; j < 4; ++j) { v[j] = xr[64 * j]; s += (v[j].x * v[j].x + v[j].y * v[j].y) + (v[j].z * v[j].z + v[j].w * v[j].w); }
    const float rstd = rsqrtf(wave_sum(s) * (1.f / D_) + EPS);
    u32x2* o8 = (u32x2*)orow + lane;
#pragma unroll
    for (int j = 0; j < 4; ++j) { const f32x4 gg = gr[64 * j]; u32x2 w; w.x = cvtpk(v[j].x * rstd * gg.x, v[j].y * rstd * gg.y); w.y = cvtpk(v[j].z * rstd * gg.z, v[j].w * rstd * gg.w); o8[64 * j] = w; }
}
__device__ __forceinline__ void p0_prologue(Frame& F, const Args& a, int do_moe_w, int do_rest) {
    LAS float* scr = (LAS float*)(F.lds + F.wave * 16384);
    const int gw = F.vcu * NWAVES + F.wave, NGW = F.G * NWAVES;
    unsigned char* ws = F.ws;
    const float* w_in = a.in[3]; const float* g_cq = a.in[4]; const float* w_uq = a.in[5]; const float* g_ckv = a.in[6]; const float* w_ukv = a.in[7];
    const float* w_o_sb = a.in[10]; const float* w_o_mla = a.in[11]; const float* w_out = a.in[12]; const float* g_ffn = a.in[13]; const float* w_router = a.in[14];
    const float* w_up = a.in[16]; const float* w_down = a.in[18];
    constexpr int I_IN = (D_ / 64) * (INW / 32), I_UQ = (384 / 64) * (768 / 32), I_UKV = (256 / 64) * (1024 / 32), I_O = (512 / 64) * (1024 / 32), I_OUT = (1024 / 64) * (1024 / 32);
    constexpr int I_UP1 = (1024 / 64) * (2048 / 32), I_DN1 = (1024 / 64) * (1024 / 32);
    if (do_rest) {
        constexpr int NI = I_IN + I_UQ + I_UKV + 2 * I_O + I_OUT;
        for (int it = gw; it < NI; it += NGW) {
            int r = it;
            if (r < I_IN) { p0_transpose_item(w_in, D_, INW, (bf16_t*)(ws + WS_WIN), scr, r, F.lane, nullptr, SB_QSCALE, 512); continue; } r -= I_IN;
            if (r < I_UQ) { p0_transpose_item(w_uq, 384, 768, (bf16_t*)(ws + WS_WUQ), scr, r, F.lane, g_cq, 1.f, 0); continue; } r -= I_UQ;
            if (r < I_UKV) { p0_transpose_item(w_ukv, 256, 1024, (bf16_t*)(ws + WS_WUKV), scr, r, F.lane, g_ckv, 1.f, 0); continue; } r -= I_UKV;
            if (r < I_O) { p0_transpose_item(w_o_sb, 512, 1024, (bf16_t*)(ws + WS_WOSB), scr, r, F.lane, nullptr, 1.f, 0); continue; } r -= I_O;
            if (r < I_O) { p0_transpose_item(w_o_mla, 512, 1024, (bf16_t*)(ws + WS_WOMLA), scr, r, F.lane, nullptr, 1.f, 0); continue; } r -= I_O;
            p0_transpose_item(w_out, 1024, 1024, (bf16_t*)(ws + WS_WOUT), scr, r, F.lane, nullptr, 1.f, 0);
        }
        { const int gt = gw * 64 + F.lane, NGT = NGW * 64;
          u32x4 z = {0u, 0u, 0u, 0u};
          u32x4* pz = (u32x4*)((bf16_t*)(ws + WS_WIN) + (size_t)INW * D_);
          for (int i = gt; i < (INWP - INW) * D_ * 2 / 16; i += NGT) pz[i] = z;
          u32x4* hz = (u32x4*)((unsigned char*)(ws + WS_H2F8) + (size_t)M_ * D_);
          for (int i = gt; i < D_ / 16; i += NGT) hz[i] = z;
          const int* pos = (const int*)a.in[1]; float* rt = (float*)(ws + WS_ROPE);
          for (int i = gt; i < M_ * 16; i += NGT) { const int row = i >> 4, k = i & 15; const float inv = powf(10000.f, -(float)k / 16.f); const float ang = (float)pos[row] * inv; rt[row * 32 + k] = cosf(ang); rt[row * 32 + 16 + k] = sinf(ang); }
          float* wr = (float*)(ws + WS_WR);
          for (int i = gt; i < D_ * NE; i += NGT) wr[i] = w_router[i] * g_ffn[i >> 5];
        }
        {
            const f32x4* gr = (const f32x4*)a.in[2] + F.lane; f32x4 gg[4];
#pragma unroll
            for (int j = 0; j < 4; ++j) gg[j] = gr[64 * j];
            for (int m = gw; m < M_; m += 4 * NGW) {
                f32x4 v[4][4]; float s[4];
#pragma unroll
                for (int q = 0; q < 4; ++q) { const int row = m + q * NGW; const f32x4* xr = (const f32x4*)(a.in[0] + (size_t)(row < M_ ? row : m) * D_) + F.lane;
#pragma unroll
                    for (int j = 0; j < 4; ++j) v[q][j] = xr[64 * j]; }
#pragma unroll
                for (int q = 0; q < 4; ++q) { s[q] = 0.f;
#pragma unroll
                    for (int j = 0; j < 4; ++j) s[q] += (v[q][j].x * v[q][j].x + v[q][j].y * v[q][j].y) + (v[q][j].z * v[q][j].z + v[q][j].w * v[q][j].w); }
#pragma unroll
                for (int q = 0; q < 4; ++q) { const int row = m + q * NGW; const float r = rsqrtf(wave_sum(s[q]) * (1.f / D_) + EPS);
                    if (row < M_) { u32x2* o8 = (u32x2*)((bf16_t*)(ws + WS_HB) + (size_t)row * D_) + F.lane;
#pragma unroll
                        for (int j = 0; j < 4; ++j) { u32x2 w; w.x = cvtpk(v[q][j].x * r * gg[j].x, v[q][j].y * r * gg[j].y); w.y = cvtpk(v[q][j].z * r * gg[j].z, v[q][j].w * r * gg[j].w); o8[64 * j] = w; } } }
            }
        }
    }
    if (do_moe_w) {
        constexpr int NI = NE * (I_UP1 + I_DN1);
        for (int it = gw; it < NI; it += NGW) {
            int r = it;
            if (r < NE * I_UP1) { const int e = r / I_UP1; p0_transpose_item_fp8(w_up + (size_t)e * D_ * 2 * DFF, D_, 2 * DFF, (unsigned char*)(ws + WS_WUP) + (size_t)e * 2 * DFF * D_, scr, r % I_UP1, F.lane, W8_SCALE); continue; }
            r -= NE * I_UP1;
            { const int e = r / I_DN1; p0_transpose_item_fp8(w_down + (size_t)e * DFF * D_, DFF, D_, (unsigned char*)(ws + WS_WDN) + (size_t)e * D_ * DFF, scr, r % I_DN1, F.lane, W8_SCALE); }
        }
    }
}

__device__ __forceinline__ void ld16bf(const bf16_t* p, float (&v)[16]) {
    const u32x4 a = *(const u32x4*)p, b = *(const u32x4*)(p + 8);
    v[0] = bflo(a.x); v[1] = bfhi(a.x); v[2] = bflo(a.y); v[3] = bfhi(a.y); v[4] = bflo(a.z); v[5] = bfhi(a.z); v[6] = bflo(a.w); v[7] = bfhi(a.w);
    v[8] = bflo(b.x); v[9] = bfhi(b.x); v[10] = bflo(b.y); v[11] = bfhi(b.y); v[12] = bflo(b.z); v[13] = bfhi(b.z); v[14] = bflo(b.w); v[15] = bfhi(b.w);
}
__device__ __forceinline__ void st16bf(bf16_t* p, const float (&v)[16]) {
    u32x4 a, b; a.x = cvtpk(v[0], v[1]); a.y = cvtpk(v[2], v[3]); a.z = cvtpk(v[4], v[5]); a.w = cvtpk(v[6], v[7]);
    b.x = cvtpk(v[8], v[9]); b.y = cvtpk(v[10], v[11]); b.z = cvtpk(v[12], v[13]); b.w = cvtpk(v[14], v[15]);
    *(u32x4*)p = a; *(u32x4*)(p + 8) = b;
}
struct PrepIn { unsigned cq0, cq1, cq2; u32x2 ckv; u32x4 qa, qb, ka, kb, vv; float rope; };
__device__ __forceinline__ void p4_load(PrepIn& in, int row, const bf16_t* proj, const bf16_t* qraw, const bf16_t* kvraw, const float* rope, int lane) {
    const int h = lane >> 3, s = lane & 7;
    const bf16_t* pr = proj + (size_t)row * INWP;
    { const bf16_t* p = pr + C_CQ + lane * 6; in.cq0 = *(const unsigned*)p; in.cq1 = *(const unsigned*)(p + 2); in.cq2 = *(const unsigned*)(p + 4); }
    in.ckv = *(const u32x2*)(pr + C_CKV + lane * 4);
    in.rope = rope[(size_t)row * 32 + (lane & 31)];
    const u32x4 z = {0u, 0u, 0u, 0u};
    in.qa = z; in.qb = z; in.ka = z; in.kb = z;
    if (s < 6) {
        const bf16_t* k = (s < 4) ? (kvraw + (size_t)row * 1024 + h * 128 + s * 16) : (pr + C_KR + (s - 4) * 16); in.ka = *(const u32x4*)k; in.kb = *(const u32x4*)(k + 8); }
    in.vv = *(const u32x4*)(kvraw + (size_t)row * 1024 + (lane >> 3) * 128 + 64 + (lane & 7) * 8);
}
__device__ __forceinline__ void unpack16(const u32x4 a, const u32x4 b, float (&v)[16]) {
    v[0] = bflo(a.x); v[1] = bfhi(a.x); v[2] = bflo(a.y); v[3] = bfhi(a.y); v[4] = bflo(a.z); v[5] = bfhi(a.z); v[6] = bflo(a.w); v[7] = bfhi(a.w);
    v[8] = bflo(b.x); v[9] = bfhi(b.x); v[10] = bflo(b.y); v[11] = bfhi(b.y); v[12] = bflo(b.z); v[13] = bfhi(b.z); v[14] = bflo(b.w); v[15] = bfhi(b.w);
}
__device__ __forceinline__ void p4_prep(Frame& F, const Args& a) {
    unsigned char* ws = F.ws;
    const bf16_t* proj = (const bf16_t*)(ws + WS_PROJ); const bf16_t* qraw = (const bf16_t*)(ws + WS_QRAW); const bf16_t* kvraw = (const bf16_t*)(ws + WS_KVRAW);
    bf16_t* QB = (bf16_t*)(ws + WS_QB); bf16_t* KB = (bf16_t*)(ws + WS_KB); bf16_t* VB = (bf16_t*)(ws + WS_VB);
    const float* rope = (const float*)(ws + WS_ROPE); const float* gq = a.in[8]; const float* gk = a.in[9];
    const int gw = F.vcu * NWAVES + F.wave, NGW = F.G * NWAVES, lane = F.lane, h = lane >> 3, s = lane & 7;
    float gqv[16], gkv[16];
#pragma unroll
    for (int j = 0; j < 16; ++j) { gqv[j] = (s < 6) ? gq[s * 16 + j] : 0.f; gkv[j] = (s < 6) ? gk[s * 16 + j] : 0.f; }
    PrepIn cur, nxt;
    if (gw < M_) p4_load(cur, gw, proj, qraw, kvraw, rope, lane);
    for (int row = gw; row < M_; row += NGW) {
        const bool hn = row + NGW < M_;
        if (hn) p4_load(nxt, row + NGW, proj, qraw, kvraw, rope, lane);
        float sq = bflo(cur.cq0) * bflo(cur.cq0) + bfhi(cur.cq0) * bfhi(cur.cq0) + bflo(cur.cq1) * bflo(cur.cq1) + bfhi(cur.cq1) * bfhi(cur.cq1) + bflo(cur.cq2) * bflo(cur.cq2) + bfhi(cur.cq2) * bfhi(cur.cq2);
        float skv = bflo(cur.ckv.x) * bflo(cur.ckv.x) + bfhi(cur.ckv.x) * bfhi(cur.ckv.x) + bflo(cur.ckv.y) * bflo(cur.ckv.y) + bfhi(cur.ckv.y) * bfhi(cur.ckv.y);
        sq = wave_sum(sq); skv = wave_sum(skv);
        const float var_cq = sq * (1.f / 384.f) + EPS;
        const float rstd_ckv = rsqrtf(skv * (1.f / 256.f) + EPS);
        float cs[16], sn[16];
#pragma unroll
        for (int j = 0; j < 16; ++j) { cs[j] = __int_as_float(__builtin_amdgcn_readlane(__float_as_int(cur.rope), j)); sn[j] = __int_as_float(__builtin_amdgcn_readlane(__float_as_int(cur.rope), 16 + j)); }
        if (lane == 0) ((float*)(ws + WS_VARCQ))[row] = var_cq;
        {
            float v[16]; unpack16(cur.ka, cur.kb, v);
            if (s < 4) {
#pragma unroll
                for (int j = 0; j < 16; ++j) v[j] *= rstd_ckv; }
            float ss = 0.f;
#pragma unroll
            for (int j = 0; j < 16; ++j) ss += v[j] * v[j];
            ss = sum8(ss);
            const float r = rsqrtf(ss * (1.f / 96.f) + EPS);
#pragma unroll
            for (int j = 0; j < 16; ++j) v[j] = v[j] * r * gkv[j];
            float o[16];
#pragma unroll
            for (int j = 0; j < 16; ++j) { const float pv = DPP_F(v[j], DPP_X1);
                o[j] = (s == 4) ? (v[j] * cs[j] - pv * sn[j]) : (s == 5) ? (v[j] * cs[j] + pv * sn[j]) : v[j]; }
            if (s < 6) st16bf(KB + (size_t)row * 768 + h * 96 + s * 16, o);
            const u32x4 vw = cur.vv;
            u32x4 ow; ow.x = cvtpk(bflo(vw.x) * rstd_ckv, bfhi(vw.x) * rstd_ckv); ow.y = cvtpk(bflo(vw.y) * rstd_ckv, bfhi(vw.y) * rstd_ckv);
            ow.z = cvtpk(bflo(vw.z) * rstd_ckv, bfhi(vw.z) * rstd_ckv); ow.w = cvtpk(bflo(vw.w) * rstd_ckv, bfhi(vw.w) * rstd_ckv);
            *(u32x4*)(VB + (size_t)row * 512 + lane * 8) = ow;
        }
        if (hn) cur = nxt;
    }
}
namespace att {
constexpr int BUFB = 20480;
constexpr int WREG = 8448;
constexpr int OST_OFF = 2 * BUFB;
constexpr int WSF_OFF = OST_OFF + 8 * WREG;
constexpr int FLG_OFF = WSF_OFF + 8 * 256;
__device__ __forceinline__ int crow(int r, int hi) { return (r & 3) + 8 * (r >> 2) + 4 * hi; }
__device__ __forceinline__ s16x4 vtr(const LAS char* p) { typedef short v4i16_t __attribute__((ext_vector_type(4))); return __builtin_bit_cast(s16x4, __builtin_amdgcn_ds_read_tr16_b64_v4i16((LAS v4i16_t*)p)); }
#define ATT_MFMA(a, b, c) __builtin_amdgcn_mfma_f32_32x32x16_bf16((a), (b), (c), 0, 0, 0)

template <int NCH> struct Stage {
    u32x4 k0, k1, v0;
    __device__ __forceinline__ void load(const bf16_t* Kb, int pitchK, const bf16_t* Vb, int pitchV, int key0, int wid, int lane) {
        k0 = *(const u32x4*)(Kb + (size_t)(key0 + lane) * pitchK + wid * 8);
        if (NCH > 8) { if (wid < NCH - 8) k1 = *(const u32x4*)(Kb + (size_t)(key0 + lane) * pitchK + (8 + wid) * 8); }
        v0 = *(const u32x4*)(Vb + (size_t)(key0 + 16 * (wid & 3) + (lane >> 2)) * pitchV + (wid >> 2) * 32 + (lane & 3) * 8);
    }
    __device__ __forceinline__ void write(LAS unsigned char* buf, int wid, int lane) const {
        *(LAS u32x4*)(buf + wid * 1024 + lane * 16) = k0;
        if (NCH > 8) { if (wid < NCH - 8) *(LAS u32x4*)(buf + (8 + wid) * 1024 + lane * 16) = k1; }
        *(LAS u32x4*)(buf + NCH * 1024 + wid * 1024 + lane * 16) = v0;
    }
};

__device__ __forceinline__ void pv_tile(f32x16 (&o)[2], const LAS char* vp, const bf16x8 (&pa)[4]) {
    __builtin_amdgcn_s_setprio(1);
#pragma unroll
    for (int d0 = 0; d0 < 2; ++d0)
#pragma unroll
        for (int ks = 0; ks < 4; ++ks) {
            const s16x4 lo = vtr(vp + d0 * 4096 + ks * 1024), hi = vtr(vp + d0 * 4096 + ks * 1024 + 512);
            const bf16x8 vf = __builtin_shufflevector(lo, hi, 0, 1, 2, 3, 4, 5, 6, 7);
            o[d0] = ATT_MFMA(pa[ks], vf, o[d0]);
        }
    __builtin_amdgcn_s_setprio(0);
}
__device__ __forceinline__ bf16x8 pack8(const f32x16& p, int base) {
    u32x4 w; w.x = cvtpk(p[base], p[base + 1]); w.y = cvtpk(p[base + 2], p[base + 3]); w.z = cvtpk(p[base + 4], p[base + 5]); w.w = cvtpk(p[base + 6], p[base + 7]);
    return __builtin_bit_cast(bf16x8, w);
}
__device__ __forceinline__ void store_o(const f32x16 (&o)[2], const float (&rs)[16], LAS unsigned char* lds, int wid, int lane, bf16_t* Ow) {
    const int r32 = lane & 31, hi = lane >> 5;
    LAS bf16_t* stg = (LAS bf16_t*)(lds + OST_OFF + wid * WREG);
#pragma unroll
    for (int r = 0; r < 16; ++r) { const int orow = crow(r, hi);
#pragma unroll
        for (int d0 = 0; d0 < 2; ++d0) { const unsigned w = cvtpk(o[d0][r] * rs[r], 0.f); stg[orow * 64 + d0 * 32 + r32] = (bf16_t)(w & 0xffffu); } }
    asm volatile("s_waitcnt lgkmcnt(0)" ::: "memory");
#pragma unroll
    for (int i = 0; i < 4; ++i) { const int row = i * 8 + (lane >> 3), ch = lane & 7; const u32x4 v = *(const LAS u32x4*)(stg + row * 64 + ch * 8); *(u32x4*)(Ow + (size_t)row * 512 + ch * 8) = v; }
    asm volatile("s_waitcnt lgkmcnt(0)" ::: "memory");
}


constexpr int MLA_CONV_PERIOD = 4;
struct Conv {
    const float* w_up; const float* w_down; unsigned char* up8; unsigned char* dn8; int item, step, ctr; bool inflight;
    static constexpr int I_UP1 = (D_ / 64) * (2 * DFF / 32), I_DN1 = (DFF / 64) * (D_ / 32), NI = NE * (I_UP1 + I_DN1);
    const float* src; unsigned char* dst; int K, N;
    __device__ __forceinline__ bool pending() const { return item < NI; }
    __device__ __forceinline__ void load_to(f32x4 (&t)[8], int lane) {
        int r = item;
        if (r < NE * I_UP1) { const int e = r / I_UP1; r %= I_UP1; K = D_; N = 2 * DFF; const int nblk = N / 32, kb = r / nblk, nb = r % nblk; src = w_up + (size_t)e * D_ * 2 * DFF + (size_t)(64 * kb) * N + 32 * nb; dst = up8 + (size_t)e * 2 * DFF * D_ + (size_t)(32 * nb) * K + 64 * kb; }
        else { r -= NE * I_UP1; const int e = r / I_DN1; r %= I_DN1; K = DFF; N = D_; const int nblk = N / 32, kb = r / nblk, nb = r % nblk; src = w_down + (size_t)e * DFF * D_ + (size_t)(64 * kb) * N + 32 * nb; dst = dn8 + (size_t)e * D_ * DFF + (size_t)(32 * nb) * K + 64 * kb; }
        const float* p = src + (size_t)(8 * (lane >> 3)) * N + 4 * (lane & 7);
#pragma unroll
        for (int j = 0; j < 8; ++j) t[j] = *(const f32x4*)(p + (size_t)j * N);
    }
    __device__ __forceinline__ void finish_from(const f32x4 (&t)[8], LAS float*, int lane) {
        unsigned char* q = dst + (size_t)(4 * (lane & 7)) * K + 8 * (lane >> 3);
#pragma unroll
        for (int c4 = 0; c4 < 4; ++c4) {
            u32x2 o; o.x = pk_fp8x4(t[0][c4] * W8_SCALE, t[1][c4] * W8_SCALE, t[2][c4] * W8_SCALE, t[3][c4] * W8_SCALE); o.y = pk_fp8x4(t[4][c4] * W8_SCALE, t[5][c4] * W8_SCALE, t[6][c4] * W8_SCALE, t[7][c4] * W8_SCALE);
            *(u32x2*)(q + (size_t)c4 * K) = o; }
        item += step;
    }
    __device__ __forceinline__ void tick_begin(f32x4 (&tv)[8], int lane) { if (!inflight && ctr == 0 && pending()) { load_to(tv, lane); inflight = true; } }
    __device__ __forceinline__ void tick_end(const f32x4 (&tv)[8], LAS float* scr, int lane) { if (inflight && ctr == 2) { finish_from(tv, scr, lane); inflight = false; } ctr = (ctr == MLA_CONV_PERIOD - 1) ? 0 : ctr + 1; }
    __device__ __forceinline__ void flush(const f32x4 (&tv)[8], LAS float* scr, int lane) { if (inflight) { finish_from(tv, scr, lane); inflight = false; } }
    __device__ __forceinline__ void drain(LAS float* scr, int lane) { while (pending()) { f32x4 t2[8]; load_to(t2, lane); finish_from(t2, scr, lane); } }
};
__device__ __forceinline__ void mla_unit(LAS unsigned char* lds, int b, int h, int qb, const bf16_t* QB, const bf16_t* KB, const bf16_t* VB, bf16_t* O, float m0, Conv& cv, const Args& ka) {
    const int tid = threadIdx.x, lane = tid & 63, r32 = lane & 31, hi = lane >> 5; const int wid = __builtin_amdgcn_readfirstlane(tid >> 6);
    const size_t rb = (size_t)b * S_; const int q0 = qb * 256;
    const bf16_t* Kh = KB + rb * 768 + h * 96; const bf16_t* Vh = VB + rb * 512 + h * 64;
    bf16x8 qr[6];
    { const size_t row = rb + q0 + wid * 32 + r32;
      const float* gq = ka.in[8]; const float* ropet = (const float*)(ka.ws + WS_ROPE); const float* varcq = (const float*)(ka.ws + WS_VARCQ);
      const bf16_t* qp = QB + row * 768 + h * 96 + hi * 8;
      float v[6][8]; float ss = 0.f;
#pragma unroll
      for (int d0 = 0; d0 < 6; ++d0) { const u32x4 w = *(const u32x4*)(qp + d0 * 16);
          v[d0][0] = bflo(w.x); v[d0][1] = bfhi(w.x); v[d0][2] = bflo(w.y); v[d0][3] = bfhi(w.y); v[d0][4] = bflo(w.z); v[d0][5] = bfhi(w.z); v[d0][6] = bflo(w.w); v[d0][7] = bfhi(w.w);
#pragma unroll
          for (int j = 0; j < 8; ++j) ss += v[d0][j] * v[d0][j]; }
      ss += __shfl_xor(ss, 32);
      const float r = rsqrtf(ss * (1.f / 96.f) + EPS * varcq[row]) * MLA_QSCALE;
#pragma unroll
      for (int d0 = 0; d0 < 6; ++d0) { const f32x4 g0 = *(const f32x4*)(gq + d0 * 16 + hi * 8), g1 = *(const f32x4*)(gq + d0 * 16 + hi * 8 + 4);
          v[d0][0] *= r * g0.x; v[d0][1] *= r * g0.y; v[d0][2] *= r * g0.z; v[d0][3] *= r * g0.w; v[d0][4] *= r * g1.x; v[d0][5] *= r * g1.y; v[d0][6] *= r * g1.z; v[d0][7] *= r * g1.w; }
      { const f32x4 c0 = *(const f32x4*)(ropet + row * 32 + hi * 8), c1 = *(const f32x4*)(ropet + row * 32 + hi * 8 + 4), s0 = *(const f32x4*)(ropet + row * 32 + 16 + hi * 8), s1 = *(const f32x4*)(ropet + row * 32 + 16 + hi * 8 + 4);
        const float cs[8] = {c0.x, c0.y, c0.z, c0.w, c1.x, c1.y, c1.z, c1.w}, sn[8] = {s0.x, s0.y, s0.z, s0.w, s1.x, s1.y, s1.z, s1.w};
#pragma unroll
        for (int j = 0; j < 8; ++j) { const float x1 = v[4][j], x2 = v[5][j]; v[4][j] = x1 * cs[j] - x2 * sn[j]; v[5][j] = x2 * cs[j] + x1 * sn[j]; } }
#pragma unroll
      for (int d0 = 0; d0 < 6; ++d0) { u32x4 w; w.x = cvtpk(v[d0][0], v[d0][1]); w.y = cvtpk(v[d0][2], v[d0][3]); w.z = cvtpk(v[d0][4], v[d0][5]); w.w = cvtpk(v[d0][6], v[d0][7]); qr[d0] = __builtin_bit_cast(bf16x8, w); } }
    const int NT = 4 * qb + 4, my_last = 4 * qb + (wid >> 1);
    f32x16 o[2]; float l = 0.f;
#pragma unroll
    for (int r = 0; r < 16; ++r) { o[0][r] = 0.f; o[1][r] = 0.f; }
    f32x16 negm;
#pragma unroll
    for (int r = 0; r < 16; ++r) negm[r] = -m0;
    asm volatile("" : "+v"(negm));
    Stage<12> st;
    st.load(Kh, 768, Vh, 512, 0, wid, lane); st.write(lds, wid, lane);
    __syncthreads();
    LAS float* cscr = (LAS float*)(lds + OST_OFF + wid * WREG);
    f32x4 tv[8];
    for (int t = 0; t < NT; ++t) {
        if (t + 1 < NT) st.load(Kh, 768, Vh, 512, (t + 1) * 64, wid, lane);
        asm volatile("" ::: "memory");
        cv.tick_begin(tv, lane);
        if (t <= my_last) {
            const LAS char* buf = (const LAS char*)(lds + (t & 1) * BUFB);
            const LAS char* kp = buf + hi * 1024 + r32 * 16;
            f32x16 p0, p1;
            __builtin_amdgcn_s_setprio(1);
#pragma unroll
            for (int d0 = 0; d0 < 6; ++d0) { const bf16x8 a0 = *(const LAS bf16x8*)(kp + d0 * 2048), a1 = *(const LAS bf16x8*)(kp + d0 * 2048 + 512);
#ifndef ABL_NOQK
                if (d0 == 0) { p0 = ATT_MFMA(a0, qr[0], negm); p1 = ATT_MFMA(a1, qr[0], negm); }
                else { p0 = ATT_MFMA(a0, qr[d0], p0); p1 = ATT_MFMA(a1, qr[d0], p1); }
#else
                if (d0 == 0) { p0 = negm; p1 = negm; } asm volatile("" :: "v"(a0), "v"(a1));
#endif
            }
            __builtin_amdgcn_s_setprio(0);
            float ls = 0.f;
#ifndef ABL_NOEXP
#pragma unroll
            for (int r = 0; r < 16; ++r) { p0[r] = __builtin_amdgcn_exp2f(p0[r]); p1[r] = __builtin_amdgcn_exp2f(p1[r]); ls += p0[r] + p1[r]; }
#endif
            l += ls;
            bf16x8 pa[4]; pa[0] = pack8(p0, 0); pa[1] = pack8(p0, 8); pa[2] = pack8(p1, 0); pa[3] = pack8(p1, 8);
            const LAS char* vp = buf + 12 * 1024 + ((lane >> 4) & 1) * 32 + (lane & 3) * 8 + (4 * hi + ((lane & 15) >> 2)) * 64;
#ifndef ABL_NOPV
            pv_tile(o, vp, pa);
#else
            asm volatile("" :: "v"(pa[0]), "v"(pa[1]), "v"(pa[2]), "v"(pa[3]), "v"(vp));
#endif
        }
        if (t + 1 < NT) st.write(lds + ((t + 1) & 1) * BUFB, wid, lane);
        cv.tick_end(tv, cscr, lane);
        __syncthreads();
    }
    cv.flush(tv, cscr, lane);
    l += __shfl_xor(l, 32);
    LAS float* wsf = (LAS float*)(lds + WSF_OFF) + wid * 64;
    if (hi == 0) wsf[r32] = l;
    asm volatile("s_waitcnt lgkmcnt(0)" ::: "memory");
    float rs[16];
#pragma unroll
    for (int r = 0; r < 16; ++r) rs[r] = __builtin_amdgcn_rcpf(wsf[crow(r, hi)]);
    store_o(o, rs, lds, wid, lane, O + (rb + q0 + wid * 32) * 512 + h * 64);
}

__device__ __forceinline__ void sb_unit(LAS unsigned char* lds, int b, int h, int qb, const bf16_t* proj, bf16_t* O, Conv& cv) {
    const int tid = threadIdx.x, lane = tid & 63, r32 = lane & 31, hi = lane >> 5; const int wid = __builtin_amdgcn_readfirstlane(tid >> 6);
    const size_t rb = (size_t)b * S_; const int q0 = qb * 256;
    const bf16_t* Kh = proj + rb * INWP + C_SBK + h * 64; const bf16_t* Vh = proj + rb * INWP + C_SBV + h * 64;
    bf16x8 qr[4];
    { const bf16_t* qp = proj + (rb + q0 + wid * 32 + r32) * INWP + C_SBQ + h * 64 + hi * 8;
#pragma unroll
      for (int d0 = 0; d0 < 4; ++d0) qr[d0] = *(const bf16x8*)(qp + d0 * 16); }
    const int Ttop = 4 * qb + 3, qw0 = q0 + wid * 32, qabs = qw0 + r32;
    f32x16 o[2]; float carry = 1.f;
#pragma unroll
    for (int r = 0; r < 16; ++r) { o[0][r] = 0.f; o[1][r] = 0.f; }
    volatile LAS int* flg = (volatile LAS int*)(lds + FLG_OFF);
    Stage<8> st;
    st.load(Kh, INWP, Vh, INWP, Ttop * 64, wid, lane); st.write(lds, wid, lane);
    __syncthreads();
    bool alive = true;
    for (int it = 0;; ++it) {
        const int t = Ttop - it;
        if (t > 0) st.load(Kh, INWP, Vh, INWP, (t - 1) * 64, wid, lane);
        asm volatile("" ::: "memory");
        f32x4 ctv[8]; const bool cvp = cv.pending() && (((it + wid) & 1) == 0);
        if (cvp) cv.load_to(ctv, lane);
        if (alive && (64 * t <= qw0 + 30)) {
            const LAS char* buf = (const LAS char*)(lds + (it & 1) * BUFB);
            const LAS char* kp = buf + hi * 1024 + r32 * 16;
            const bool need_mask = (64 * t + 63 >= qw0);
            bf16x8 pa[4];
#pragma unroll
            for (int blk = 1; blk >= 0; --blk) {
                f32x16 p;
#pragma unroll
                for (int r = 0; r < 16; ++r) p[r] = 0.f;
#pragma unroll
                for (int d0 = 0; d0 < 4; ++d0) { const bf16x8 a0 = *(const LAS bf16x8*)(kp + d0 * 2048 + blk * 512); p = ATT_MFMA(a0, qr[d0], p); }
                const int kb0 = 64 * t + 32 * blk + 4 * hi;
                f32x16 s;
#pragma unroll
                for (int r = 0; r < 16; ++r) {
                    const int key = kb0 + (r & 3) + 8 * (r >> 2);
                    const float tt = __builtin_amdgcn_exp2f(-fmaxf(p[r], -80.f)); float be = __builtin_amdgcn_rcpf(1.f + tt); float sy = tt * be;
                    if (need_mask && !(key < qabs)) { be = 0.f; sy = 1.f; }
                    p[r] = be; s[r] = sy;
                }
                float T[5]; T[4] = 1.f;
#pragma unroll
                for (int i = 3; i >= 0; --i) T[i] = T[i + 1] * ((s[4 * i] * s[4 * i + 1]) * (s[4 * i + 2] * s[4 * i + 3]));
                float Tp[5]; Tp[4] = 1.f;
#pragma unroll
                for (int i = 0; i < 4; ++i) Tp[i] = __shfl_xor(T[i], 32);
#pragma unroll
                for (int i = 3; i >= 0; --i) {
                    float lat = carry * (T[i + 1] * (hi ? Tp[i + 1] : Tp[i]));
#pragma unroll
                    for (int e3 = 3; e3 >= 0; --e3) { const int r = 4 * i + e3; const float sy = s[r]; p[r] = p[r] * lat; lat *= sy; }
                }
                carry *= T[0] * Tp[0];
                pa[2 * blk] = pack8(p, 0); pa[2 * blk + 1] = pack8(p, 8);
            }
            const LAS char* vp = buf + 8 * 1024 + ((lane >> 4) & 1) * 32 + (lane & 3) * 8 + (4 * hi + ((lane & 15) >> 2)) * 64;
            pv_tile(o, vp, pa);
            alive = __any(carry > 0.f);
        }
        if (lane == 0) flg[(it & 1) * 8 + wid] = alive ? 1 : 0;
        if (t > 0) st.write(lds + ((it + 1) & 1) * BUFB, wid, lane);
        if (cvp) cv.finish_from(ctv, (LAS float*)(lds + OST_OFF + wid * WREG), lane);
        __syncthreads();
        if (t == 0) break;
        int any = 0;
#pragma unroll
        for (int w = 0; w < 8; ++w) any |= flg[(it & 1) * 8 + w];
        if (!any) break;
    }
    float rs[16];
#pragma unroll
    for (int r = 0; r < 16; ++r) rs[r] = 1.f;
    store_o(o, rs, lds, wid, lane, O + (rb + q0 + wid * 32) * 512 + h * 64);
}
}

__device__ __forceinline__ void p5_attention(Frame& F, const Args& a) {
    unsigned char* ws = F.ws;
    volatile LAS int* citem = (volatile LAS int*)(F.MISC + MI_CITEM) + F.wave;
    {
        float gm;
        { const float* gq = a.in[8]; const float* gk = a.in[9]; float mq = 0.f, mk = 0.f;
          for (int i = F.lane; i < 96; i += 64) { mq = fmaxf(mq, fabsf(gq[i])); mk = fmaxf(mk, fabsf(gk[i])); }
#pragma unroll
          for (int o = 1; o < 64; o <<= 1) { mq = fmaxf(mq, __shfl_xor(mq, o)); mk = fmaxf(mk, __shfl_xor(mk, o)); }
          gm = 9.79795897f * LOG2E * mq * mk; }
        att::Conv cv; cv.w_up = a.in[16]; cv.w_down = a.in[18]; cv.up8 = (unsigned char*)(ws + WS_WUP); cv.dn8 = (unsigned char*)(ws + WS_WDN);
        cv.item = F.vcu * NWAVES + F.wave; cv.step = F.G * NWAVES; cv.ctr = F.wave % att::MLA_CONV_PERIOD; cv.inflight = false;
#ifdef ABL_NOCONV
        cv.item = att::Conv::NI;
#endif
        for (int v = F.vcu; v < 256; v += F.G) {
            const int bh = v >> 3, s = v & 7, b = bh >> 3, h = bh & 7;
            for (int i = 0; i < 2; ++i) { const int qb = i ? 15 - s : s;
                att::mla_unit(F.lds, b, h, qb, (const bf16_t*)(ws + WS_QRAW), (const bf16_t*)(ws + WS_KB), (const bf16_t*)(ws + WS_VB), (bf16_t*)(ws + WS_OMLA), gm, cv, a);
                __syncthreads(); }
        }
        if (F.lane == 0) *citem = cv.item;
    }
    __syncthreads();
#ifdef MEGA_STAMPS
    if (blockIdx.x == 0 && F.tid == 0) ((unsigned long long*)(ws + WS_CTL + 32768))[12] = __builtin_amdgcn_s_memrealtime();
#endif
    {
        att::Conv cv; cv.w_up = a.in[16]; cv.w_down = a.in[18]; cv.up8 = (unsigned char*)(ws + WS_WUP); cv.dn8 = (unsigned char*)(ws + WS_WDN);
        cv.item = __builtin_amdgcn_readfirstlane(*citem); cv.step = F.G * NWAVES; cv.ctr = 0; cv.inflight = false;
        for (int v = F.vcu; v < 256; v += F.G) {
            const int bh = v >> 3, s = v & 7, b = bh >> 3, h = bh & 7;
            for (int i = 0; i < 2; ++i) { const int qb = i ? 15 - s : s;
                att::sb_unit(F.lds, b, h, qb, (const bf16_t*)(ws + WS_PROJ), (bf16_t*)(ws + WS_OSB), cv);
                __syncthreads(); }
        }
        cv.drain((LAS float*)(F.lds + att::OST_OFF + F.wave * att::WREG), F.lane);
    }
}

__device__ __forceinline__ void p8_router(Frame& F, const Args& a) {
    unsigned char* ws = F.ws;
    const bf16_t* x1 = (const bf16_t*)(ws + WS_X1B); const float* wr = (const float*)(ws + WS_WR); const float* br = a.in[15]; const float* g = a.in[13];
    unsigned char* H2 = (unsigned char*)(ws + WS_H2F8); int* list = (int*)(ws + WS_LIST); float* topw = (float*)(ws + WS_TOPW); int* selo = (int*)(ws + WS_SEL);
    int* cnt = (int*)(ws + WS_CTL) + CW_CNT;
    volatile LAS int* lcnt = (volatile LAS int*)(F.MISC + MI_LCNT); volatile LAS int* lbase = (volatile LAS int*)(F.MISC + MI_BASE);
    const int lane = F.lane, wave = F.wave, tid = F.tid;
    constexpr int WST = 1028;
    LAS float* wt = (LAS float*)F.lds;
    if (F.vcu < M_ / 64) {
        for (int i = tid; i < D_ * NE / 4; i += NTHR) { const f32x4 v = *(const f32x4*)(wr + (size_t)i * 4); const int k = i >> 3, e = (i & 7) * 4;
            wt[(e + 0) * WST + k] = v.x; wt[(e + 1) * WST + k] = v.y; wt[(e + 2) * WST + k] = v.z; wt[(e + 3) * WST + k] = v.w; }
    }
    __syncthreads();
    for (int task = F.vcu; task < M_ / 64; task += F.G) {
        const int T0 = task * 64;
        if (tid < 32) lcnt[tid] = 0;
        __syncthreads();
        int my_e = 0, my_rank = 0; float my_w = 0.f;
        if (wave < 4) {
            const int tk = lane & 15, kp = lane >> 4, tok = T0 + wave * 16 + tk;
            const bf16_t* xp = x1 + (size_t)tok * D_ + kp * 256;
            const LAS float* w0 = wt + tk * WST + kp * 256; const LAS float* w1 = w0 + 16 * WST;
            f32x4 acc0 = {0.f, 0.f, 0.f, 0.f}, acc1 = {0.f, 0.f, 0.f, 0.f}; float ssq = 0.f;
#pragma unroll 4
            for (int i = 0; i < 256; i += 4) {
                const u32x2 aw = *(const u32x2*)(xp + i); const f32x4 a4 = {bflo(aw.x), bfhi(aw.x), bflo(aw.y), bfhi(aw.y)}; const f32x4 b0 = *(const LAS f32x4*)(w0 + i), b1 = *(const LAS f32x4*)(w1 + i);
                ssq += (a4.x * a4.x + a4.y * a4.y) + (a4.z * a4.z + a4.w * a4.w);
#pragma unroll
                for (int j = 0; j < 4; ++j) { acc0 = __builtin_amdgcn_mfma_f32_16x16x4f32(a4[j], b0[j], acc0, 0, 0, 0); acc1 = __builtin_amdgcn_mfma_f32_16x16x4f32(a4[j], b1[j], acc1, 0, 0, 0); }
            }
            ssq += __shfl_xor(ssq, 16); ssq += __shfl_xor(ssq, 32);
            const float rstd = rsqrtf(ssq * (1.f / D_) + EPS);
            const int e0 = lane & 15, grp = lane >> 4;
            const float bia0 = br[e0], bia1 = br[e0 + 16];
#pragma unroll
            for (int j = 0; j < 4; ++j) {
                const float rs = __shfl(rstd, 4 * grp + j);
                float c0 = acc0[j] * rs + bia0, c1 = acc1[j] * rs + bia1;
                float sv[4]; int si[4];
#pragma unroll
                for (int k = 0; k < 4; ++k) {
                    float best = c0; int bi = e0;
                    if (c1 > best) { best = c1; bi = e0 + 16; }
#pragma unroll
                    for (int st_ = 0; st_ < 4; ++st_) { const int ctl = st_ == 0 ? DPP_X1 : st_ == 1 ? DPP_X2 : st_ == 2 ? DPP_HM : DPP_RM;
                        float ob; int oi;
                        if (st_ == 0) { ob = DPP_F(best, DPP_X1); oi = DPP_I(bi, DPP_X1); } else if (st_ == 1) { ob = DPP_F(best, DPP_X2); oi = DPP_I(bi, DPP_X2); } else if (st_ == 2) { ob = DPP_F(best, DPP_HM); oi = DPP_I(bi, DPP_HM); } else { ob = DPP_F(best, DPP_RM); oi = DPP_I(bi, DPP_RM); }
                        (void)ctl; if (ob > best || (ob == best && oi < bi)) { best = ob; bi = oi; } }
                    sv[k] = best; si[k] = bi;
                    if (bi == e0) c0 = -INFINITY; if (bi == e0 + 16) c1 = -INFINITY;
                }
                float ex[4], sum = 0.f;
#pragma unroll
                for (int k = 0; k < 4; ++k) { ex[k] = __expf(sv[k] - sv[0]); sum += ex[k]; }
                const float inv = 1.f / sum;
                if (((lane >> 2) & 3) == j) {
#pragma unroll
                    for (int k = 0; k < 4; ++k) if ((lane & 3) == k) { my_e = si[k]; my_w = ex[k] * inv; }
                }
            }
            my_rank = atomicAdd((int*)&lcnt[my_e], 1);
        } else {
            const f32x4* gr = (const f32x4*)g + lane;
            f32x4 gg[4];
#pragma unroll
            for (int j = 0; j < 4; ++j) gg[j] = gr[64 * j] * X8_SCALE;
            for (int rr = 0; rr < 16; rr += 4) {
                const int t0 = T0 + (wave - 4) * 16 + rr;
                f32x4 v[4][4]; float s[4];
#pragma unroll
                for (int q = 0; q < 4; ++q) { const u32x2* xr = (const u32x2*)(x1 + (size_t)(t0 + q) * D_) + lane;
#pragma unroll
                    for (int j = 0; j < 4; ++j) { const u32x2 w = xr[64 * j]; v[q][j] = (f32x4){bflo(w.x), bfhi(w.x), bflo(w.y), bfhi(w.y)}; } }
#pragma unroll
                for (int q = 0; q < 4; ++q) { s[q] = 0.f;
#pragma unroll
                    for (int j = 0; j < 4; ++j) s[q] += (v[q][j].x * v[q][j].x + v[q][j].y * v[q][j].y) + (v[q][j].z * v[q][j].z + v[q][j].w * v[q][j].w); }
#pragma unroll
                for (int q = 0; q < 4; ++q) { const float r = rsqrtf(wave_sum(s[q]) * (1.f / D_) + EPS); unsigned* o = (unsigned*)(H2 + (size_t)(t0 + q) * D_) + lane;
#pragma unroll
                    for (int j = 0; j < 4; ++j) o[64 * j] = pk_fp8x4(v[q][j].x * r * gg[j].x, v[q][j].y * r * gg[j].y, v[q][j].z * r * gg[j].z, v[q][j].w * r * gg[j].w); }
            }
        }
        __syncthreads();
        if (tid < 32) lbase[tid] = lcnt[tid] ? atomicAdd(&cnt[tid], lcnt[tid]) : 0;
        __syncthreads();
        if (wave < 4) {
            const int grp = lane >> 4, jj = (lane >> 2) & 3, kk = lane & 3;
            const int tok = T0 + wave * 16 + 4 * grp + jj, slot = tok * 4 + kk;
            list[(size_t)my_e * M_ + lbase[my_e] + my_rank] = slot; ((float*)(ws + WS_LISTW))[(size_t)my_e * M_ + lbase[my_e] + my_rank] = my_w;
            topw[slot] = my_w; selo[slot] = my_e;
        }
        __syncthreads();
    }
}

struct MoeOrder {
    const bf16_t* A; const bf16_t* Bt; const int* list; volatile LAS unsigned* tab;
    int lda, ldb, nN, nwg, G, c, gather; size_t estride;
    __device__ void init(const bf16_t* A_, int lda_, const bf16_t* Bt_, int ldb_, size_t estride_, int nN_, const int* list_, volatile LAS unsigned* tab_, int gather_, int G_, int c_) {
        A = A_; lda = lda_; Bt = Bt_; ldb = ldb_; estride = estride_; nN = nN_; list = list_; tab = tab_; gather = gather_; G = G_; c = c_; nwg = (int)tab[MI_TPFX + NE] * nN_; }
    __device__ __forceinline__ bool next(int i, pg8::Unit& u) const {
        const long L = (long)i * G + c; if (L >= nwg) return false;
        int wgid = (int)L; { const int q = nwg / 8, r = nwg % 8, xcd = wgid % 8, off = wgid / 8; wgid = (xcd < r ? xcd * (q + 1) : r * (q + 1) + (xcd - r) * q) + off; }
        int e = 0;
        for (int k = 1; k < NE; ++k) if ((int)tab[MI_TPFX + k] * nN <= wgid) e = k;
        const int t0 = (int)tab[MI_TPFX + e], nt = (int)tab[MI_TPFX + e + 1] - t0, idx = wgid - t0 * nN;
        u.e = e; u.pn = idx / nt; u.rt = idx % nt; u.pm = t0 + u.rt; const int left = (int)tab[MI_CNT + e] - u.rt * 256; u.rows = left < 256 ? left : 256; return true;
    }
    __device__ __forceinline__ unsigned a_off(const pg8::Unit& u, int r, int C) const {
        int row;
        if (gather) row = (r < u.rows) ? (list[(size_t)u.e * M_ + u.rt * 256 + r] >> 2) : M_;
        else row = u.pm * 256 + r;
        return (unsigned)((row * lda + C) * 2);
    }
    __device__ __forceinline__ const char* b_base(const pg8::Unit& u) const { return (const char*)(Bt + (size_t)u.e * estride + (size_t)u.pn * 256 * ldb); }
};
__device__ __forceinline__ void moe_table(Frame& F) {
    int* cnt = (int*)(F.ws + WS_CTL) + CW_CNT;
    if (F.tid < NE) F.MISC[MI_CNT + F.tid] = __hip_atomic_load((unsigned*)cnt + F.tid, RLX_AGENT);
    __syncthreads();
    if (F.tid == 0) { unsigned p = 0; for (int e = 0; e < NE; ++e) { F.MISC[MI_TPFX + e] = p; p += (F.MISC[MI_CNT + e] + 255u) >> 8; } F.MISC[MI_TPFX + NE] = p; }
    __syncthreads();
}

__device__ __forceinline__ void p12_combine(Frame& F, const Args& a) {
    const bf16_t* Y = (const bf16_t*)(F.ws + WS_YB); const bf16_t* X1 = (const bf16_t*)(F.ws + WS_X1B); float* out = a.out;
    const int gt = (F.vcu * NWAVES + F.wave) * 64 + F.lane, NGT = F.G * NTHR;
    for (int i = gt; i < M_ * D_ / 8; i += NGT) {
        const int t = i >> 7, c = (i & 127) * 8;
        u32x4 w[5];
        w[4] = *(const u32x4*)(X1 + (size_t)t * D_ + c);
#pragma unroll
        for (int k = 0; k < 4; ++k) w[k] = *(const u32x4*)(Y + (size_t)(t * 4 + k) * D_ + c);
        f32x4 v0 = {bflo(w[4].x), bfhi(w[4].x), bflo(w[4].y), bfhi(w[4].y)}, v1 = {bflo(w[4].z), bfhi(w[4].z), bflo(w[4].w), bfhi(w[4].w)};
#pragma unroll
        for (int k = 0; k < 4; ++k) { v0.x += bflo(w[k].x); v0.y += bfhi(w[k].x); v0.z += bflo(w[k].y); v0.w += bfhi(w[k].y); v1.x += bflo(w[k].z); v1.y += bfhi(w[k].z); v1.z += bflo(w[k].w); v1.w += bfhi(w[k].w); }
        *(f32x4*)(out + (size_t)t * D_ + c) = v0; *(f32x4*)(out + (size_t)t * D_ + c + 4) = v1;
    }
}

constexpr int N_PHASES = 11;
#ifndef DUP_PHASE
#define DUP_PHASE -1
#endif
__global__ void __launch_bounds__(NTHR, 2) mega(Args args) {
    extern __shared__ __attribute__((aligned(16))) unsigned char lds_raw[];
    Frame F;
    F.lds = (LAS unsigned char*)lds_raw; F.MISC = (volatile LAS unsigned*)(F.lds + LDS_MISC);
    F.tid = threadIdx.x; F.lane = F.tid & 63; F.wave = __builtin_amdgcn_readfirstlane(F.tid >> 6);
    F.G = gridDim.x; { const int bx = blockIdx.x; F.vcu = (F.G % 8 == 0) ? (bx % 8) * (F.G / 8) + bx / 8 : bx; }
    F.ws = args.ws;
    unsigned char* ws = args.ws;
    for (int u = F.tid; u < (LDS_BYTES - LDS_MISC) / 4; u += NTHR) F.MISC[u] = 0u;
    __syncthreads();
    const int lo = args.ph_lo, hi = args.ph_hi;
    XcdBarrier bar; bar.bar = (unsigned*)(ws + WS_CTL) + CW_BAR; bar.x = 0; bar.st = nullptr;
    if (hi - lo > 1) bar = xcd_barrier_post((unsigned*)(ws + WS_CTL) + CW_BAR, F.MISC + MI_BAR);
#define IN(k) (lo <= (k) && (k) < hi)
#ifdef MEGA_STAMPS
#define STAMP(k) do { if (blockIdx.x == 0 && F.tid == 0) ((unsigned long long*)(ws + WS_CTL + 32768))[(k)] = __builtin_amdgcn_s_memrealtime(); } while (0)
#else
#define STAMP(k) do { } while (0)
#endif
#define SEAM(k) do { if (IN(k) && IN((k) + 1)) xcd_barrier(bar); STAMP((k) + 1); } while (0)
    const int cid = (int)blockIdx.x;
    STAMP(0);

    if (IN(0)) { p0_prologue(F, args, 0, 1); SEAM(0); }
    if (IN(1)) {
        pg8::Gemm g{(const bf16_t*)(ws + WS_HB), D_, D_, D_};
        pg8::StaticOrder S; S.init(g.A, D_, (const bf16_t*)(ws + WS_WIN), D_, M_, 4096, F.G, cid);
        pg8::EpiBf16 E{(bf16_t*)(ws + WS_PROJ), INWP};
        pg8::gemm_phase(F.lds, g, S, E);
        SEAM(1);
    }
    if (IN(2)) {
        { pg8::Gemm g{(const bf16_t*)(ws + WS_HB), D_, D_, D_};
          pg8::StaticOrder S; S.init(g.A, D_, (const bf16_t*)(ws + WS_WIN) + (size_t)4096 * D_, D_, M_, 256, F.G, cid);
          pg8::EpiBf16 E{(bf16_t*)(ws + WS_PROJ) + 4096, INWP};
          pg8::gemm_phase(F.lds, g, S, E); }
        { pg8::Gemm g{(const bf16_t*)(ws + WS_PROJ) + C_CQ, INWP, 384, 384};
          pg8::StaticOrder S; S.init(g.A, INWP, (const bf16_t*)(ws + WS_WUQ), 384, M_, 768, F.G, cid, F.G - 64);
          pg8::EpiBf16 E{(bf16_t*)(ws + WS_QRAW), 768};
          pg8::gemm_phase(F.lds, g, S, E); }
        { pg8::Gemm g{(const bf16_t*)(ws + WS_PROJ) + C_CKV, INWP, 256, 256};
          pg8::StaticOrder S; S.init(g.A, INWP, (const bf16_t*)(ws + WS_WUKV), 256, M_, 1024, F.G, cid);
          pg8::EpiBf16 E{(bf16_t*)(ws + WS_KVRAW), 1024};
          pg8::gemm_phase(F.lds, g, S, E); }
        SEAM(2);
    }
    if (IN(3)) { p4_prep(F, args); SEAM(3); }
    if (IN(4)) { p5_attention(F, args); SEAM(4); }
    if (IN(5)) {
        pg8::Gemm g{(const bf16_t*)(ws + WS_OSB), 512, 512, 512};
        pg8::PairOrder S; S.S.init(g.A, 512, (const bf16_t*)(ws + WS_WOSB), 512, M_, D_, F.G, cid); S.a1 = (WS_OMLA - WS_OSB) / 2; S.b1 = (WS_WOMLA - WS_WOSB) / 2;
        pg8::EpiGate2 E{(bf16_t*)(ws + WS_MIX), (const bf16_t*)(ws + WS_PROJ), INWP, C_GSB, C_GMLA};
        pg8::gemm_phase(F.lds, g, S, E);
        SEAM(5);
    }
    if (IN(6)) {
        pg8::Gemm g{(const bf16_t*)(ws + WS_MIX), D_, D_, D_};
        pg8::StaticOrder S; S.init(g.A, D_, (const bf16_t*)(ws + WS_WOUT), D_, M_, D_, F.G, cid);
        pg8::EpiRes E{args.in[0], (bf16_t*)(ws + WS_X1B)};
        pg8::gemm_phase(F.lds, g, S, E);
        SEAM(6);
    }
    if (IN(7)) { p8_router(F, args); SEAM(7); }
    if (IN(8)) {
        moe_table(F);
        pg8::Gemm g{(const bf16_t*)(ws + WS_H2F8), D_ / 2, D_ / 2, D_ / 2};
        MoeOrder S; S.init(g.A, D_ / 2, (const bf16_t*)(ws + WS_WUP), D_ / 2, (size_t)2 * DFF * D_ / 2, 8, (const int*)(ws + WS_LIST), F.MISC, 1, F.G, cid);
        pg8::EpiSwiglu8 E{(unsigned char*)(ws + WS_ACT), args.in[17]};
        pg8::gemm_phase<pg8::EpiSwiglu8, MoeOrder, true>(F.lds, g, S, E);
        SEAM(8);
    }
    if (IN(9)) {
        moe_table(F);
        pg8::Gemm g{(const bf16_t*)(ws + WS_ACT), DFF / 2, DFF / 2, DFF / 2};
        MoeOrder S; S.init(g.A, DFF / 2, (const bf16_t*)(ws + WS_WDN), DFF / 2, (size_t)D_ * DFF / 2, 4, (const int*)(ws + WS_LIST), F.MISC, 0, F.G, cid);
        pg8::EpiDown E{(bf16_t*)(ws + WS_YB), args.in[19], (const int*)(ws + WS_LIST), (const float*)(ws + WS_LISTW)};
        pg8::gemm_phase<pg8::EpiDown, MoeOrder, true>(F.lds, g, S, E);
        SEAM(9);
    }
    if (IN(10)) { p12_combine(F, args); STAMP(11); }
#undef IN
#undef SEAM
}
static int g_grid = 0;
static int setup_grid() {
    if (g_grid == 0) {
        int dev = 0, cus = 0;
        if (hipGetDevice(&dev) != hipSuccess || hipDeviceGetAttribute(&cus, hipDeviceAttributeMultiprocessorCount, dev) != hipSuccess) { g_grid = -1; return g_grid; }
        if (hipFuncSetAttribute((const void*)mega, hipFuncAttributeMaxDynamicSharedMemorySize, LDS_BYTES) != hipSuccess) { g_grid = -1; return g_grid; }
        int per_cu = 0;
        (void)hipOccupancyMaxActiveBlocksPerMultiprocessor(&per_cu, (const void*)mega, NTHR, LDS_BYTES);
        (void)hipGetLastError();
        g_grid = cus;
    }
    return g_grid;
}
static void launch_mega(void* const* d_in, void* d_out, void* d_ws, int lo, int hi, hipStream_t stream) {
    Args a; memset(&a, 0, sizeof(a));
    for (int i = 0; i < 20; ++i) a.in[i] = (const float*)d_in[i];
    a.out = (float*)d_out; a.ws = (unsigned char*)d_ws; a.ph_lo = lo; a.ph_hi = hi;
    hipLaunchKernelGGL(mega, dim3(g_grid), dim3(NTHR), LDS_BYTES, stream, a);
}
extern "C" void kernel_launch(void* const* d_in, const int* in_sizes, int n_in, void* d_out, int out_size, void* d_ws, size_t ws_size, hipStream_t stream) {
    if (n_in != 20 || ws_size < WS_OPT_END || out_size != M_ * D_) { fprintf(stderr, "kernel_launch: unexpected arguments\n"); return; }
    if (setup_grid() <= 0) return;
    (void)hipMemsetAsync((char*)d_ws + WS_CTL, 0, CTL_ZERO_BYTES, stream);
#if N_LAUNCH_SPLIT
    for (int p = 0; p < N_PHASES; ++p) { launch_mega(d_in, d_out, d_ws, p, p + 1, stream); if (p == DUP_PHASE) { if (p == 7) (void)hipMemsetAsync((char*)d_ws + WS_CTL, 0, 128, stream); if (p == 10) launch_mega(d_in, d_out, d_ws, 6, 7, stream); launch_mega(d_in, d_out, d_ws, p, p + 1, stream); } }
#else
    launch_mega(d_in, d_out, d_ws, 0, N_PHASES, stream);
#endif
}
```

```cpp
#define N_LAUNCH_SPLIT 0
#include <hip/hip_runtime.h>
#include <hip/hip_bf16.h>
#include <cstdio>
#include <cstdint>
#include <cstring>
#include <cmath>

constexpr int B_ = 4, S_ = 4096, D_ = 1024, M_ = B_ * S_;
constexpr int INW = 4256, INWP = 4352;
constexpr int C_SBQ = 0, C_SBK = 512, C_SBV = 1024, C_CQ = 1536, C_CKV = 1920, C_KR = 2176, C_GSB = 2208, C_GMLA = 3232;
constexpr int NE = 32, TOPK = 4, DFF = 1024;
constexpr float EPS = 1e-6f;
constexpr float LOG2E = 1.4426950408889634f;
constexpr float SB_QSCALE = 0.125f * LOG2E;
constexpr float MLA_QSCALE = 0.10206207261596577f * LOG2E;
constexpr int NWAVES = 8, NTHR = 512;

#define LAS __attribute__((address_space(3)))
#define GAS __attribute__((address_space(1)))
typedef unsigned short bf16_t;
typedef short bf16x8 __attribute__((ext_vector_type(8)));
typedef short s16x4 __attribute__((ext_vector_type(4)));
typedef float f32x4 __attribute__((ext_vector_type(4)));
typedef float f32x16 __attribute__((ext_vector_type(16)));
typedef unsigned u32x4 __attribute__((ext_vector_type(4)));
typedef unsigned u32x2 __attribute__((ext_vector_type(2)));
typedef float f32x2_t __attribute__((ext_vector_type(2)));
typedef __bf16 bf16x2_t __attribute__((ext_vector_type(2)));
typedef int v8i_t __attribute__((ext_vector_type(8)));
constexpr float W8_SCALE = 8.f, X8_SCALE = 8.f;
__device__ __forceinline__ unsigned pk_fp8x4(float a, float b, float c, float d) { unsigned w = 0; w = __builtin_amdgcn_cvt_pk_fp8_f32(a, b, w, false); w = __builtin_amdgcn_cvt_pk_fp8_f32(c, d, w, true); return w; }

__device__ __forceinline__ unsigned cvtpk(float lo, float hi) { f32x2_t v = {lo, hi}; bf16x2_t b = __builtin_convertvector(v, bf16x2_t); return __builtin_bit_cast(unsigned, b); }
__device__ __forceinline__ float bf2f(unsigned short h) { return __uint_as_float(((unsigned)h) << 16); }
__device__ __forceinline__ float bflo(unsigned w) { return __uint_as_float(w << 16); }
__device__ __forceinline__ float bfhi(unsigned w) { return __uint_as_float(w & 0xffff0000u); }
__device__ __forceinline__ float dpp_f(float v, int ctrl) { return v; }
#define DPP_F(v, ctrl) __int_as_float(__builtin_amdgcn_update_dpp(0, __float_as_int(v), (ctrl), 0xF, 0xF, true))
#define DPP_I(v, ctrl) __builtin_amdgcn_update_dpp(0, (v), (ctrl), 0xF, 0xF, true)
#define DPP_X1 0xB1
#define DPP_X2 0x4E
#define DPP_HM 0x141
#define DPP_RM 0x140
__device__ __forceinline__ float wave_sum(float v) {
    v += DPP_F(v, DPP_X1); v += DPP_F(v, DPP_X2); v += DPP_F(v, DPP_HM); v += DPP_F(v, DPP_RM);
    return (__int_as_float(__builtin_amdgcn_readlane(__float_as_int(v), 0)) + __int_as_float(__builtin_amdgcn_readlane(__float_as_int(v), 16)))
         + (__int_as_float(__builtin_amdgcn_readlane(__float_as_int(v), 32)) + __int_as_float(__builtin_amdgcn_readlane(__float_as_int(v), 48)));
}
__device__ __forceinline__ float sum8(float v) { v += DPP_F(v, DPP_X1); v += DPP_F(v, DPP_X2); v += DPP_F(v, DPP_HM); return v; }
__device__ __forceinline__ float sigmoidf_(float x) { return __builtin_amdgcn_rcpf(1.f + __builtin_amdgcn_exp2f(-x * LOG2E)); }

namespace pg8 {
constexpr int BM = 256, BK = 64, HALF = 128, HTB = HALF * BK * 2, STAGE_BYTES = 8 * HTB, NXCD = 8, WGM = 8;
__host__ __device__ __forceinline__ int lds_byte(int r, int c) { const int st = (r >> 4) * 2 + (c >> 5), rr = r & 15, cc = c & 31, ob = rr * 64 + cc * 2; return st * 1024 + (ob ^ (((ob >> 9) & 1) << 5)); }
__host__ __device__ __forceinline__ void stage_rc(int b, int& R, int& C) { const int st = b / 1024, sb = b % 1024, swz = sb ^ (((sb >> 9) & 1) << 5); R = (st >> 1) * 16 + swz / 64; C = (st & 1) * 32 + (swz % 64) / 2; }
__host__ __device__ __forceinline__ int perm32(int rho) { const int n = rho >> 4, i = rho & 15; return 8 * (i >> 2) + 4 * n + (i & 3); }

struct Unit { int pm, pn, e, rows, rt; };
struct Gemm { const bf16_t* A; int lda, ldb, K; };

struct StaticOrder {
    const bf16_t* A; const bf16_t* Bt; int lda, ldb;
    int nM, nN, nwg, G, c;
    __device__ void init(const bf16_t* A_, int lda_, const bf16_t* Bt_, int ldb_, int M, int N, int G_, int c_, int cshift = 0) { A = A_; Bt = Bt_; lda = lda_; ldb = ldb_; nM = M / BM; nN = N / BM; nwg = nM * nN; G = G_; c = (c_ + cshift) % G_; }
    __device__ __forceinline__ bool next(int i, Unit& u) const {
        const long L = (long)i * G + c; if (L >= nwg) return false;
        int wgid = (int)L; { const int q = nwg / NXCD, r = nwg % NXCD, xcd = wgid % NXCD, off = wgid / NXCD; wgid = (xcd < r ? xcd * (q + 1) : r * (q + 1) + (xcd - r) * q) + off; }
        const int nig = WGM * nN, gid = wgid / nig, fm = gid * WGM, gsz = (nM - fm) < WGM ? (nM - fm) : WGM;
        u.pm = fm + ((wgid % nig) % gsz); u.pn = (wgid % nig) / gsz; u.e = 0; u.rows = 256; u.rt = 0; return true;
    }
    __device__ __forceinline__ unsigned a_off(const Unit& u, int r, int C) const { return (unsigned)(((u.pm * BM + r) * lda + C) * 2); }
    __device__ __forceinline__ const char* b_base(const Unit& u) const { return (const char*)(Bt + (size_t)u.pn * BM * ldb); }
};

__device__ __forceinline__ v8i_t ld32_lds(const LAS unsigned char* p) { const u32x4 lo_ = *(const LAS u32x4*)p, hi_ = *(const LAS u32x4*)(p + 1024); return (v8i_t){(int)lo_.x, (int)lo_.y, (int)lo_.z, (int)lo_.w, (int)hi_.x, (int)hi_.y, (int)hi_.z, (int)hi_.w}; }
struct PairOrder {
    StaticOrder S; size_t a1, b1;
    __device__ __forceinline__ bool next(int i, Unit& u) const { if (!S.next(i >> 1, u)) return false; u.e = i & 1; return true; }
    __device__ __forceinline__ unsigned a_off(const Unit& u, int r, int C) const { return S.a_off(u, r, C) + (unsigned)(u.e ? a1 * 2 : 0); }
    __device__ __forceinline__ const char* b_base(const Unit& u) const { return S.b_base(u) + (u.e ? b1 * 2 : 0); }
};
__device__ __forceinline__ void mfma_f8(f32x4& c, const v8i_t a, const v8i_t b, int sa, int sb) {
    asm volatile("v_mfma_scale_f32_16x16x128_f8f6f4 %0, %1, %2, %0, %3, %4 op_sel_hi:[0,0,0]" : "+v"(c) : "v"(a), "v"(b), "v"(sa), "v"(sb));
}
#ifdef ABL_NOMFMA16
__device__ __forceinline__ f32x4 ABL_MFMA16(bf16x8 a, bf16x8 b, f32x4 c) { asm volatile("" : "+v"(c) : "v"(a), "v"(b)); return c; }
#else
#define ABL_MFMA16(a, b, c) __builtin_amdgcn_mfma_f32_16x16x32_bf16((a), (b), (c), 0, 0, 0)
#endif
template <bool F8> struct FragT { typedef bf16x8 type; };
template <> struct FragT<true> { typedef v8i_t type; };
template <class Epi, class Sched, bool FP8 = false>
__device__ __forceinline__ void gemm_phase(LAS unsigned char* lds, const Gemm g, const Sched& S, const Epi& E) {
    const int tid = threadIdx.x, wid = __builtin_amdgcn_readfirstlane(tid >> 6), lane = tid & 63, wr = wid >> 2, wc = wid & 3, fr = lane & 15, fq = lane >> 4;
    const int K = g.K, nt = K / BK;
    unsigned voffB[2];
#pragma unroll
    for (int i = 0; i < 2; ++i) { int R, C; stage_rc(tid * 16 + i * 8192, R, C); const int Rb = Epi::PERM ? ((R & ~31) + perm32(R & 31)) : R; voffB[i] = (unsigned)(Rb * g.ldb + C) * 2u; }
#define PG8_AOFF(dst, unit) do { int t_ = tid; asm volatile("" : "+v"(t_)); _Pragma("unroll") for (int i = 0; i < 2; ++i) { int R, C; stage_rc(t_ * 16 + i * 8192, R, C); \
        _Pragma("unroll") for (int h = 0; h < 2; ++h) dst[h][i] = S.a_off(unit, h * HALF + R, C); } } while (0)
    const size_t kstep = (size_t)(BK * 2);
    const size_t hstepB = (size_t)HALF * g.ldb * 2;
    const unsigned ldsw = (unsigned)wid * 1024u;
    const int aoff = lds_byte(wr * 64 + fr, fq * 8), boff = lds_byte(wc * 32 + fr, fq * 8);
#define PG8_SA(b, h) (((b) * 2 + (h)) * HTB)
#define PG8_SB(b, h) ((4 + (b) * 2 + (h)) * HTB)
#define PG8_STAGE(bufoff, gbase, voff) do { _Pragma("unroll") for (int _i = 0; _i < 2; ++_i) \
        __builtin_amdgcn_global_load_lds((const unsigned*)((const char*)(gbase) + (voff)[_i]), (LAS unsigned*)(lds + (bufoff) + ldsw + _i * 8192), 16, 0, 0); } while (0)
#define PG8_LD32(p) ld32_lds((const LAS unsigned char*)(p))
#define PG8_LDA(dst, b, h) do { if constexpr (FP8) { _Pragma("unroll") for (int m = 0; m < 4; ++m) dst[m][0] = __builtin_bit_cast(FT, PG8_LD32(lds + PG8_SA(b, h) + aoff + m * 2048)); } \
        else { _Pragma("unroll") for (int m = 0; m < 4; ++m) _Pragma("unroll") for (int k = 0; k < 2; ++k) dst[m][k] = __builtin_bit_cast(FT, *(const LAS FT*)(lds + PG8_SA(b, h) + aoff + m * 2048 + k * 1024)); } } while (0)
#define PG8_LDB(dst, b, h) do { if constexpr (FP8) { _Pragma("unroll") for (int n = 0; n < 2; ++n) dst[n][0] = __builtin_bit_cast(FT, PG8_LD32(lds + PG8_SB(b, h) + boff + n * 2048)); } \
        else { _Pragma("unroll") for (int n = 0; n < 2; ++n) _Pragma("unroll") for (int k = 0; k < 2; ++k) dst[n][k] = __builtin_bit_cast(FT, *(const LAS FT*)(lds + PG8_SB(b, h) + boff + n * 2048 + k * 1024)); } } while (0)
#define PG8_MMA(ai, bj, At, Bt) do { __builtin_amdgcn_s_setprio(1); \
        if constexpr (FP8) { _Pragma("unroll") for (int m = 0; m < 4; ++m) _Pragma("unroll") for (int n = 0; n < 2; ++n) \
            mfma_f8(acc[ai][bj][m][n], __builtin_bit_cast(v8i_t, Bt[n][0]), __builtin_bit_cast(v8i_t, At[m][0]), 0x7c7c7c7c, 0x7c7c7c7c); } \
        else { _Pragma("unroll") for (int m = 0; m < 4; ++m) _Pragma("unroll") for (int n = 0; n < 2; ++n) _Pragma("unroll") for (int k = 0; k < 2; ++k) \
            acc[ai][bj][m][n] = ABL_MFMA16(__builtin_bit_cast(bf16x8, Bt[n][k]), __builtin_bit_cast(bf16x8, At[m][k]), acc[ai][bj][m][n]); } \
        __builtin_amdgcn_s_setprio(0); } while (0)
#define PG8_WAIT_V(n) asm volatile("s_waitcnt vmcnt(" #n ")" ::: "memory")
#define PG8_WAIT_L(n) asm volatile("s_waitcnt lgkmcnt(" #n ")" ::: "memory")
#define PG8_BAR __builtin_amdgcn_s_barrier()
#define PG8_SCHED __builtin_amdgcn_sched_barrier(0)
    Unit cur, nxt; int ui = 0;
    if (!S.next(0, cur)) return;
    f32x4 acc[2][2][4][2];
#pragma unroll
    for (int a = 0; a < 2; ++a)
#pragma unroll
        for (int b = 0; b < 2; ++b)
#pragma unroll
            for (int m = 0; m < 4; ++m)
#pragma unroll
                for (int n = 0; n < 2; ++n) acc[a][b][m][n] = (f32x4){0.f, 0.f, 0.f, 0.f};
    typedef typename FragT<FP8>::type FT; constexpr int NK = FP8 ? 1 : 2;
    FT At[4][NK], B0[2][NK], B1[2][NK];
    const char* Ab = (const char*)g.A;
    const char* cB = S.b_base(cur);
    unsigned vaC[2][2], vaN[2][2];
    PG8_AOFF(vaC, cur);
    PG8_STAGE(PG8_SB(0, 0), cB, voffB); PG8_STAGE(PG8_SB(0, 1), cB + hstepB, voffB); PG8_STAGE(PG8_SA(0, 0), Ab, vaC[0]); PG8_STAGE(PG8_SA(0, 1), Ab, vaC[1]);
    if (wr == 1) PG8_BAR;
    PG8_WAIT_V(2); PG8_BAR;
    PG8_STAGE(PG8_SB(1, 0), cB + kstep, voffB); PG8_STAGE(PG8_SA(1, 0), Ab + kstep, vaC[0]); PG8_STAGE(PG8_SB(1, 1), cB + hstepB + kstep, voffB);
    PG8_WAIT_V(6); PG8_BAR;
    for (;;) {
        const bool has_next = S.next(ui + 1, nxt);
        const char* nB = has_next ? S.b_base(nxt) : cB;
        if (has_next) PG8_AOFF(vaN, nxt);
        else {
#pragma unroll
            for (int h = 0; h < 2; ++h)
#pragma unroll
                for (int i = 0; i < 2; ++i) vaN[h][i] = vaC[h][i]; }
        for (int t = 0; t < nt; t += 2) {
            const bool last = (t == nt - 2);
            const char* kA1 = Ab + (size_t)(t + 1) * kstep;
            const char* kA2 = last ? Ab : Ab + (size_t)(t + 2) * kstep; const char* b2 = last ? nB : cB + (size_t)(t + 2) * kstep;
            const char* kA3 = kA2 + kstep; const char* b3 = b2 + kstep;
            unsigned o2[2][2];
#pragma unroll
            for (int h = 0; h < 2; ++h)
#pragma unroll
                for (int i = 0; i < 2; ++i) o2[h][i] = last ? vaN[h][i] : vaC[h][i];
            PG8_LDB(B0, 0, 0); PG8_LDB(B1, 0, 1); PG8_SCHED; PG8_LDA(At, 0, 0); PG8_STAGE(PG8_SA(1, 1), kA1, vaC[1]);
            PG8_WAIT_V(8); PG8_WAIT_L(0); PG8_BAR; PG8_MMA(0, 0, At, B0); PG8_MMA(0, 1, At, B1); PG8_BAR; PG8_SCHED;
            PG8_LDA(At, 0, 1); PG8_STAGE(PG8_SB(0, 0), b2, voffB); PG8_STAGE(PG8_SB(0, 1), b2 + hstepB, voffB); PG8_STAGE(PG8_SA(0, 0), kA2, o2[0]);
            PG8_WAIT_V(8); PG8_WAIT_L(0); PG8_BAR; PG8_MMA(1, 0, At, B0); PG8_MMA(1, 1, At, B1); PG8_BAR; PG8_SCHED;
            PG8_LDB(B0, 1, 0); PG8_LDB(B1, 1, 1); PG8_SCHED; PG8_LDA(At, 1, 0); PG8_STAGE(PG8_SA(0, 1), kA2, o2[1]);
            PG8_WAIT_V(8); PG8_WAIT_L(0); PG8_BAR; PG8_MMA(0, 0, At, B0); PG8_MMA(0, 1, At, B1); PG8_BAR; PG8_SCHED;
            PG8_LDA(At, 1, 1); PG8_STAGE(PG8_SB(1, 0), b3, voffB); PG8_STAGE(PG8_SB(1, 1), b3 + hstepB, voffB); PG8_STAGE(PG8_SA(1, 0), kA3, o2[0]);
            PG8_WAIT_V(8); PG8_WAIT_L(0); PG8_BAR; PG8_MMA(1, 0, At, B0); PG8_MMA(1, 1, At, B1); PG8_BAR; PG8_SCHED;
        }
        if (wr == 0) PG8_BAR;
        if constexpr (FP8) asm volatile("s_nop 15\n\ts_nop 15" ::: "memory");
        E(acc, cur, wr, wc, fr, fq);
        if (!has_next) break;
#pragma unroll
        for (int a = 0; a < 2; ++a)
#pragma unroll
            for (int b = 0; b < 2; ++b)
#pragma unroll
                for (int m = 0; m < 4; ++m)
#pragma unroll
                    for (int n = 0; n < 2; ++n) acc[a][b][m][n] = (f32x4){0.f, 0.f, 0.f, 0.f};
        cur = nxt; cB = nB; ++ui;
#pragma unroll
        for (int h = 0; h < 2; ++h)
#pragma unroll
            for (int i = 0; i < 2; ++i) vaC[h][i] = vaN[h][i];
        if (wr == 1) PG8_BAR;
    }
    PG8_WAIT_V(0);
    PG8_BAR;
#undef PG8_SA
#undef PG8_AOFF
#undef PG8_SB
#undef PG8_STAGE
#undef PG8_LDA
#undef PG8_LDB
#undef PG8_MMA
#undef PG8_LD32
#undef PG8_WAIT_V
#undef PG8_WAIT_L
#undef PG8_BAR
#undef PG8_SCHED
}

struct EpiBf16 {
    static constexpr bool PERM = true;
    bf16_t* O; int ldc;
    __device__ __forceinline__ void operator()(const f32x4 (&acc)[2][2][4][2], const Unit& u, int wr, int wc, int fr, int fq) const {
        const int row0 = u.pm * BM + wr * 64 + fr, col0 = u.pn * BM + wc * 32 + 8 * fq;
#pragma unroll
        for (int ai = 0; ai < 2; ++ai)
#pragma unroll
            for (int m = 0; m < 4; ++m) { bf16_t* rowp = O + (size_t)(row0 + ai * HALF + m * 16) * ldc + col0;
#pragma unroll
                for (int bj = 0; bj < 2; ++bj) { const f32x4 v0 = acc[ai][bj][m][0], v1 = acc[ai][bj][m][1];
                    u32x4 w; w.x = cvtpk(v0[0], v0[1]); w.y = cvtpk(v0[2], v0[3]); w.z = cvtpk(v1[0], v1[1]); w.w = cvtpk(v1[2], v1[3]);
                    *(u32x4*)(rowp + bj * HALF) = w; } }
    }
};
struct EpiGate2 {
    static constexpr bool PERM = true;
    bf16_t* O; const bf16_t* G; int ldg, gcol0, gcol1;
    __device__ __forceinline__ void operator()(const f32x4 (&acc)[2][2][4][2], const Unit& u, int wr, int wc, int fr, int fq) const {
        const int row0 = u.pm * BM + wr * 64 + fr, col0 = u.pn * BM + wc * 32 + 8 * fq;
        const bool second = u.e != 0; const int gcol = second ? gcol1 : gcol0;
#pragma unroll
        for (int ai = 0; ai < 2; ++ai)
#pragma unroll
            for (int m = 0; m < 4; ++m) { const size_t r = (size_t)(row0 + ai * HALF + m * 16);
#pragma unroll
                for (int bj = 0; bj < 2; ++bj) { const f32x4 v0 = acc[ai][bj][m][0], v1 = acc[ai][bj][m][1];
                    const int c = col0 + bj * HALF;
#ifdef ABL_G_NOLOAD
                    const u32x4 gw = {0u, 0u, 0u, 0u}; bf16_t* op = O + r * D_ + c; u32x4 pw = {0u, 0u, 0u, 0u};
#else
                    const u32x4 gw = *(const u32x4*)(G + r * ldg + gcol + c);
                    bf16_t* op = O + r * D_ + c;
                    u32x4 pw = {0u, 0u, 0u, 0u}; if (second) pw = *(const u32x4*)op;
#endif
                    float o[8];
                    o[0] = sigmoidf_(bflo(gw.x)) * v0[0]; o[1] = sigmoidf_(bfhi(gw.x)) * v0[1]; o[2] = sigmoidf_(bflo(gw.y)) * v0[2]; o[3] = sigmoidf_(bfhi(gw.y)) * v0[3];
                    o[4] = sigmoidf_(bflo(gw.z)) * v1[0]; o[5] = sigmoidf_(bfhi(gw.z)) * v1[1]; o[6] = sigmoidf_(bflo(gw.w)) * v1[2]; o[7] = sigmoidf_(bfhi(gw.w)) * v1[3];
                    o[0] += bflo(pw.x); o[1] += bfhi(pw.x); o[2] += bflo(pw.y); o[3] += bfhi(pw.y); o[4] += bflo(pw.z); o[5] += bfhi(pw.z); o[6] += bflo(pw.w); o[7] += bfhi(pw.w);
                    u32x4 w; w.x = cvtpk(o[0], o[1]); w.y = cvtpk(o[2], o[3]); w.z = cvtpk(o[4], o[5]); w.w = cvtpk(o[6], o[7]);
                    *(u32x4*)op = w; } }
    }
};
struct EpiRes {
    static constexpr bool PERM = true;
    const float* base; bf16_t* out;
    __device__ __forceinline__ void operator()(const f32x4 (&acc)[2][2][4][2], const Unit& u, int wr, int wc, int fr, int fq) const {
        const int row0 = u.pm * BM + wr * 64 + fr, col0 = u.pn * BM + wc * 32 + 8 * fq;
#pragma unroll
        for (int ai = 0; ai < 2; ++ai)
#pragma unroll
            for (int m = 0; m < 4; ++m) { const size_t off = (size_t)(row0 + ai * HALF + m * 16) * D_ + col0;
#pragma unroll
                for (int bj = 0; bj < 2; ++bj) { const f32x4 v0 = *(const f32x4*)(base + off + bj * HALF) + acc[ai][bj][m][0], v1 = *(const f32x4*)(base + off + bj * HALF + 4) + acc[ai][bj][m][1];
                    u32x4 w; w.x = cvtpk(v0[0], v0[1]); w.y = cvtpk(v0[2], v0[3]); w.z = cvtpk(v1[0], v1[1]); w.w = cvtpk(v1[2], v1[3]);
                    *(u32x4*)(out + off + bj * HALF) = w; } }
    }
};
struct EpiSwiglu {
    static constexpr bool PERM = true;
    bf16_t* act; const float* b_up;
    __device__ __forceinline__ void operator()(const f32x4 (&acc)[2][2][4][2], const Unit& u, int wr, int wc, int fr, int fq) const {
        const int row0 = u.pm * BM + wr * 64 + fr, col0 = u.pn * BM + wc * 32 + 8 * fq;
        const float* bb = b_up + (size_t)u.e * (2 * DFF);
        f32x4 bv[2][2];
#pragma unroll
        for (int bj = 0; bj < 2; ++bj)
#pragma unroll
            for (int n = 0; n < 2; ++n) bv[bj][n] = *(const f32x4*)(bb + col0 + bj * HALF + 4 * n);
#pragma unroll
        for (int ai = 0; ai < 2; ++ai)
#pragma unroll
            for (int m = 0; m < 4; ++m) { bf16_t* rowp = act + (size_t)(row0 + ai * HALF + m * 16) * DFF + (col0 >> 1);
#pragma unroll
                for (int bj = 0; bj < 2; ++bj) { const f32x4 v0 = acc[ai][bj][m][0] + bv[bj][0], v1 = acc[ai][bj][m][1] + bv[bj][1];
                    float a[4];
#pragma unroll
                    for (int p = 0; p < 4; ++p) { float gl = (p < 2) ? v0[2 * p] : v1[2 * p - 4], li = (p < 2) ? v0[2 * p + 1] : v1[2 * p - 3];
                        gl = fminf(gl, 7.f); li = fminf(fmaxf(li, -7.f), 7.f);
                        a[p] = gl * sigmoidf_(1.702f * gl) * (li + 1.f); }
                    u32x2 w; w.x = cvtpk(a[0], a[1]); w.y = cvtpk(a[2], a[3]);
                    *(u32x2*)(rowp + bj * (HALF / 2)) = w; } }
    }
};
struct EpiSwiglu8 {
    static constexpr bool PERM = true;
    unsigned char* act; const float* b_up;
    __device__ __forceinline__ void operator()(const f32x4 (&acc)[2][2][4][2], const Unit& u, int wr, int wc, int fr, int fq) const {
        const int row0 = u.pm * BM + wr * 64 + fr, col0 = u.pn * BM + wc * 32 + 8 * fq;
        const float* bb = b_up + (size_t)u.e * (2 * DFF);
        f32x4 bv[2][2];
#pragma unroll
        for (int bj = 0; bj < 2; ++bj)
#pragma unroll
            for (int n = 0; n < 2; ++n) bv[bj][n] = *(const f32x4*)(bb + col0 + bj * HALF + 4 * n);
#pragma unroll
        for (int ai = 0; ai < 2; ++ai)
#pragma unroll
            for (int m = 0; m < 4; ++m) { unsigned char* rowp = act + (size_t)(row0 + ai * HALF + m * 16) * DFF + (col0 >> 1);
#pragma unroll
                for (int bj = 0; bj < 2; ++bj) { const f32x4 v0 = acc[ai][bj][m][0] + bv[bj][0], v1 = acc[ai][bj][m][1] + bv[bj][1];
                    float a[4];
#pragma unroll
                    for (int p = 0; p < 4; ++p) { float gl = (p < 2) ? v0[2 * p] : v1[2 * p - 4], li = (p < 2) ? v0[2 * p + 1] : v1[2 * p - 3];
                        gl = fminf(gl, 7.f); li = fminf(fmaxf(li, -7.f), 7.f);
                        a[p] = gl * sigmoidf_(1.702f * gl) * fmaf(li, X8_SCALE, X8_SCALE); }
                    *(unsigned*)(rowp + bj * (HALF / 2)) = pk_fp8x4(a[0], a[1], a[2], a[3]); } }
    }
};
struct EpiDown {
    static constexpr bool PERM = true;
    bf16_t* y; const float* b_down; const int* list; const float* listw;
    __device__ __forceinline__ void operator()(const f32x4 (&acc)[2][2][4][2], const Unit& u, int wr, int wc, int fr, int fq) const {
        const int col0 = u.pn * BM + wc * 32 + 8 * fq;
        const float* bb = b_down + (size_t)u.e * D_;
        f32x4 bv[2][2];
#pragma unroll
        for (int bj = 0; bj < 2; ++bj)
#pragma unroll
            for (int n = 0; n < 2; ++n) bv[bj][n] = *(const f32x4*)(bb + col0 + bj * HALF + 4 * n);
        const int* lp = list + (size_t)u.e * M_ + u.rt * BM; const float* lw = listw + (size_t)u.e * M_ + u.rt * BM;
#pragma unroll
        for (int ai = 0; ai < 2; ++ai)
#pragma unroll
            for (int m = 0; m < 4; ++m) { const int r = ai * HALF + wr * 64 + m * 16 + fr;
                if (r < u.rows) { const int slot = lp[r]; const float w = lw[r]; bf16_t* rowp = y + (size_t)slot * D_ + col0;
#pragma unroll
                    for (int bj = 0; bj < 2; ++bj) { const f32x4 v0 = (acc[ai][bj][m][0] + bv[bj][0]) * w, v1 = (acc[ai][bj][m][1] + bv[bj][1]) * w;
                        u32x4 o; o.x = cvtpk(v0[0], v0[1]); o.y = cvtpk(v0[2], v0[3]); o.z = cvtpk(v1[0], v1[1]); o.w = cvtpk(v1[2], v1[3]);
                        *(u32x4*)(rowp + bj * HALF) = o; } } }
    }
};
}
constexpr size_t MiB = 1ull << 20;
constexpr size_t WS_CTL = 0, CTL_ZERO_BYTES = 64 * 1024;
constexpr size_t WS_ROPE = 256 * 1024;
constexpr size_t WS_WR = 3 * MiB;
constexpr size_t WS_LIST = 4 * MiB;
constexpr size_t WS_TOPW = 6 * MiB;
constexpr size_t WS_SEL = 6 * MiB + 512 * 1024;
constexpr size_t WS_LISTW = 594 * MiB;
constexpr size_t WS_WIN = 8 * MiB;
constexpr size_t WS_WUQ = 17 * MiB;
constexpr size_t WS_WUKV = 18 * MiB;
constexpr size_t WS_WOSB = 19 * MiB;
constexpr size_t WS_WOMLA = 20 * MiB;
constexpr size_t WS_WOUT = 21 * MiB;
constexpr size_t WS_WUP = 24 * MiB;
constexpr size_t WS_WDN = 152 * MiB;
constexpr size_t WS_HB = 216 * MiB;
constexpr size_t WS_PROJ = 249 * MiB;
constexpr size_t WS_ACT = WS_PROJ;
constexpr size_t WS_QRAW = 393 * MiB;
constexpr size_t WS_KVRAW = WS_QRAW + 24 * MiB;
constexpr size_t WS_QB = WS_KVRAW + 32 * MiB;
constexpr size_t WS_KB = WS_QB + 24 * MiB;
constexpr size_t WS_VB = WS_KB + 24 * MiB;
constexpr size_t WS_OSB = WS_VB + 16 * MiB;
constexpr size_t WS_OMLA = WS_OSB + 16 * MiB;
constexpr size_t WS_YB = WS_QRAW;
constexpr size_t WS_MIX = 545 * MiB;
constexpr size_t WS_H2F8 = 577 * MiB;
constexpr size_t WS_X1B = 596 * MiB;
constexpr size_t WS_VARCQ = 628 * MiB;
constexpr size_t WS_OPT_END = 629 * MiB;
constexpr int CW_CNT = 0;
constexpr int CW_BAR = 1024;
constexpr int LDS_STAGE = 143360;
constexpr int LDS_MISC = LDS_STAGE;
constexpr int LDS_BYTES = 147456;
constexpr int MI_BAR = 0, MI_TPFX = 16, MI_CNT = 64, MI_FLAG = 128, MI_LCNT = 160, MI_BASE = 192, MI_RSTD = 256, MI_CITEM = 320;

typedef GAS unsigned gu32;
#define RLX_AGENT __ATOMIC_RELAXED, __HIP_MEMORY_SCOPE_AGENT

#define XB_TMO      128
#define XB_XCNT(j)  (256  + 64 * (j))
#define XB_XSUB(j)  (1280 + 64 * (j))
#define XB_XGEN(j)  (2304 + 64 * (j))
#define XB_TOP      3328
#define XB_TOPGEN   3392
#define XCD_BAR_WORDS 3456
#define XB_SPIN_CAP (1u << 18)
__device__ __forceinline__ unsigned xb_ld(unsigned* p)              { return __hip_atomic_load(p, __ATOMIC_RELAXED, __HIP_MEMORY_SCOPE_AGENT); }
__device__ __forceinline__ unsigned xb_add(unsigned* p, unsigned v) { return __hip_atomic_fetch_add(p, v, __ATOMIC_RELAXED, __HIP_MEMORY_SCOPE_AGENT); }
__device__ __forceinline__ unsigned xb_xcc_id() { return (unsigned)__builtin_amdgcn_s_getreg((3 << 11) | 20) & 0xFu; }
#define XB_SPIN(cond, bar) do { unsigned _sp = 0; while (cond) { __builtin_amdgcn_s_sleep(1); \
    if ((++_sp & 255u) == 0u) { if (xb_ld(&(bar)[XB_TMO])) break; if (_sp > XB_SPIN_CAP) { atomicAdd(&(bar)[XB_TMO], 1u); break; } } } } while (0)
struct XcdBarrier { unsigned* bar; unsigned x; volatile LAS unsigned* st; };
__device__ __forceinline__ XcdBarrier xcd_barrier_post(unsigned* bar, volatile LAS unsigned* st) {
    XcdBarrier b; b.bar = bar; b.x = xb_xcc_id(); b.st = st;
    if (threadIdx.x == 0) (void)xb_add(&bar[XB_XCNT(b.x)], 1u);
    return b;
}
__device__ __forceinline__ void xcd_barrier_complete(unsigned* bar, unsigned x, unsigned& nloc, unsigned& nx) {
    const unsigned G = gridDim.x * gridDim.y * gridDim.z;
    unsigned sum, cnt, mine, sp = 0u;
    for (;;) {
        sum = 0u; cnt = 0u; mine = 0u;
#pragma unroll
        for (unsigned j = 0; j < 16; ++j) { const unsigned c = xb_ld(&bar[XB_XCNT(j)]); sum += c; cnt += (c > 0u) ? 1u : 0u; mine = (j == x) ? c : mine; }
        if (sum == G) break;
        __builtin_amdgcn_s_sleep(1);
        if ((++sp & 255u) == 0u) { if (xb_ld(&bar[XB_TMO])) break; if (sp > XB_SPIN_CAP) { atomicAdd(&bar[XB_TMO], 1u); break; } }
    }
    nloc = mine > 0u ? mine : 1u; nx = cnt > 0u ? cnt : 1u;
}
__device__ __forceinline__ void xcd_barrier(const XcdBarrier& b) {
    asm volatile("s_waitcnt vmcnt(0)" ::: "memory");
    __syncthreads();
    if (threadIdx.x == 0) {
        unsigned* bar = b.bar;
        __builtin_amdgcn_s_waitcnt(0);
        unsigned nloc = b.st[0], nx = b.st[1];
        if (nloc == 0u) { xcd_barrier_complete(bar, b.x, nloc, nx); b.st[0] = nloc; b.st[1] = nx; }
        const unsigned old = xb_add(&bar[XB_XSUB(b.x)], 1u);
        const unsigned gen = old / nloc;
        if (old + 1u == (gen + 1u) * nloc) {
            __builtin_amdgcn_fence(__ATOMIC_RELEASE, "agent");
            asm volatile("s_waitcnt vmcnt(0)" ::: "memory");
            const unsigned og = xb_add(&bar[XB_TOP], 1u);
            const unsigned tg = og / nx;
            if (og + 1u == (tg + 1u) * nx) xb_add(&bar[XB_TOPGEN], 1u);
            else XB_SPIN(xb_ld(&bar[XB_TOPGEN]) == tg, bar);
            __builtin_amdgcn_fence(__ATOMIC_ACQUIRE, "agent");
            xb_add(&bar[XB_XGEN(b.x)], 1u);
            asm volatile("s_waitcnt vmcnt(0)" ::: "memory");
        } else {
            XB_SPIN(xb_ld(&bar[XB_XGEN(b.x)]) == gen, bar);
            __builtin_amdgcn_fence(__ATOMIC_ACQUIRE, "agent");
            asm volatile("s_waitcnt vmcnt(0)" ::: "memory");
        }
    }
    __syncthreads();
}

struct Args {
    const float* in[20]; float* out; unsigned char* ws;
    int ph_lo, ph_hi;
};

struct Frame {
    LAS unsigned char* lds; volatile LAS unsigned* MISC;
    int tid, lane, wave, vcu, G;
    unsigned char* ws;
};

__device__ __forceinline__ void p0_transpose_item(const float* W, int K, int N, bf16_t* WT, LAS float* scr, int item, int lane, const float* gk, float cs, int csn) {
    const int nblk = N / 32, kb = item / nblk, nb = item % nblk, k0 = 64 * kb, n0 = 32 * nb;
    const float colsc = (n0 < csn) ? cs : 1.f;
    float tv[32];
#pragma unroll
    for (int i = 0; i < 32; ++i) { const int kk = 2 * i + (lane >> 5); tv[i] = W[(size_t)(k0 + kk) * N + n0 + (lane & 31)]; }
#pragma unroll
    for (int i = 0; i < 32; ++i) { const int kk = 2 * i + (lane >> 5); float v = tv[i] * colsc; if (gk) v *= gk[k0 + kk]; scr[kk * 33 + (lane & 31)] = v; }
    asm volatile("s_waitcnt lgkmcnt(0)" ::: "memory");
    const int c = lane & 7;
#pragma unroll
    for (int j = 0; j < 4; ++j) { const int n = (lane >> 3) + 8 * j; const LAS float* s = scr + (8 * c) * 33 + n;
        u32x4 o; o.x = cvtpk(s[0 * 33], s[1 * 33]); o.y = cvtpk(s[2 * 33], s[3 * 33]); o.z = cvtpk(s[4 * 33], s[5 * 33]); o.w = cvtpk(s[6 * 33], s[7 * 33]);
        *(u32x4*)(WT + (size_t)(n0 + n) * K + k0 + 8 * c) = o; }
    asm volatile("s_waitcnt lgkmcnt(0)" ::: "memory");
}
__device__ __forceinline__ void p0_transpose_item_fp8(const float* W, int K, int N, unsigned char* WT, LAS float* scr, int item, int lane, float cs) {
    const int nblk = N / 32, kb = item / nblk, nb = item % nblk, k0 = 64 * kb, n0 = 32 * nb;
    float tv[32];
#pragma unroll
    for (int i = 0; i < 32; ++i) { const int kk = 2 * i + (lane >> 5); tv[i] = W[(size_t)(k0 + kk) * N + n0 + (lane & 31)]; }
#pragma unroll
    for (int i = 0; i < 32; ++i) { const int kk = 2 * i + (lane >> 5); scr[kk * 33 + (lane & 31)] = tv[i] * cs; }
    asm volatile("s_waitcnt lgkmcnt(0)" ::: "memory");
    const int c = lane & 7;
#pragma unroll
    for (int j = 0; j < 4; ++j) { const int n = (lane >> 3) + 8 * j; const LAS float* s = scr + (8 * c) * 33 + n;
        u32x2 o; o.x = pk_fp8x4(s[0 * 33], s[1 * 33], s[2 * 33], s[3 * 33]); o.y = pk_fp8x4(s[4 * 33], s[5 * 33], s[6 * 33], s[7 * 33]);
        *(u32x2*)(WT + (size_t)(n0 + n) * K + k0 + 8 * c) = o; }
    asm volatile("s_waitcnt lgkmcnt(0)" ::: "memory");
}
__device__ __forceinline__ void rms_row_to_bf16(const float* xrow, const float* g, bf16_t* orow, int lane) {
    const f32x4* xr = (const f32x4*)xrow + lane; const f32x4* gr = (const f32x4*)g + lane;
    f32x4 v[4]; float s = 0.f;
#pragma unroll
    for (int j = 0; j < 4; ++j) { v[j] = xr[64 * j]; s += (v[j].x * v[j].x + v[j].y * v[j].y) + (v[j].z * v[j].z + v[j].w * v[j].w); }
    const float rstd = rsqrtf(wave_sum(s) * (1.f / D_) + EPS);
    u32x2* o8 = (u32x2*)orow + lane;
#pragma unroll
    for (int j = 0; j < 4; ++j) { const f32x4 gg = gr[64 * j]; u32x2 w; w.x = cvtpk(v[j].x * rstd * gg.x, v[j].y * rstd * gg.y); w.y = cvtpk(v[j].z * rstd * gg.z, v[j].w * rstd * gg.w); o8[64 * j] = w; }
}
__device__ __forceinline__ void p0_prologue(Frame& F, const Args& a, int do_moe_w, int do_rest) {
    LAS float* scr = (LAS float*)(F.lds + F.wave * 16384);
    const int gw = F.vcu * NWAVES + F.wave, NGW = F.G * NWAVES;
    unsigned char* ws = F.ws;
    const float* w_in = a.in[3]; const float* g_cq = a.in[4]; const float* w_uq = a.in[5]; const float* g_ckv = a.in[6]; const float* w_ukv = a.in[7];
    const float* w_o_sb = a.in[10]; const float* w_o_mla = a.in[11]; const float* w_out = a.in[12]; const float* g_ffn = a.in[13]; const float* w_router = a.in[14];
    const float* w_up = a.in[16]; const float* w_down = a.in[18];
    constexpr int I_IN = (D_ / 64) * (INW / 32), I_UQ = (384 / 64) * (768 / 32), I_UKV = (256 / 64) * (1024 / 32), I_O = (512 / 64) * (1024 / 32), I_OUT = (1024 / 64) * (1024 / 32);
    constexpr int I_UP1 = (1024 / 64) * (2048 / 32), I_DN1 = (1024 / 64) * (1024 / 32);
    if (do_rest) {
        constexpr int NI = I_IN + I_UQ + I_UKV + 2 * I_O + I_OUT;
        for (int it = gw; it < NI; it += NGW) {
            int r = it;
            if (r < I_IN) { p0_transpose_item(w_in, D_, INW, (bf16_t*)(ws + WS_WIN), scr, r, F.lane, nullptr, SB_QSCALE, 512); continue; } r -= I_IN;
            if (r < I_UQ) { p0_transpose_item(w_uq, 384, 768, (bf16_t*)(ws + WS_WUQ), scr, r, F.lane, g_cq, 1.f, 0); continue; } r -= I_UQ;
            if (r < I_UKV) { p0_transpose_item(w_ukv, 256, 1024, (bf16_t*)(ws + WS_WUKV), scr, r, F.lane, g_ckv, 1.f, 0); continue; } r -= I_UKV;
            if (r < I_O) { p0_transpose_item(w_o_sb, 512, 1024, (bf16_t*)(ws + WS_WOSB), scr, r, F.lane, nullptr, 1.f, 0); continue; } r -= I_O;
            if (r < I_O) { p0_transpose_item(w_o_mla, 512, 1024, (bf16_t*)(ws + WS_WOMLA), scr, r, F.lane, nullptr, 1.f, 0); continue; } r -= I_O;
            p0_transpose_item(w_out, 1024, 1024, (bf16_t*)(ws + WS_WOUT), scr, r, F.lane, nullptr, 1.f, 0);
        }
        { const int gt = gw * 64 + F.lane, NGT = NGW * 64;
          u32x4 z = {0u, 0u, 0u, 0u};
          u32x4* pz = (u32x4*)((bf16_t*)(ws + WS_WIN) + (size_t)INW * D_);
          for (int i = gt; i < (INWP - INW) * D_ * 2 / 16; i += NGT) pz[i] = z;
          u32x4* hz = (u32x4*)((unsigned char*)(ws + WS_H2F8) + (size_t)M_ * D_);
          for (int i = gt; i < D_ / 16; i += NGT) hz[i] = z;
          const int* pos = (const int*)a.in[1]; float* rt = (float*)(ws + WS_ROPE);
          for (int i = gt; i < M_ * 16; i += NGT) { const int row = i >> 4, k = i & 15; const float inv = powf(10000.f, -(float)k / 16.f); const float ang = (float)pos[row] * inv; rt[row * 32 + k] = cosf(ang); rt[row * 32 + 16 + k] = sinf(ang); }
          float* wr = (float*)(ws + WS_WR);
          for (int i = gt; i < D_ * NE; i += NGT) wr[(i & 31) * 1028 + (i >> 5)] = w_router[i] * g_ffn[i >> 5];
        }
        {
            const f32x4* gr = (const f32x4*)a.in[2] + F.lane; f32x4 gg[4];
#pragma unroll
            for (int j = 0; j < 4; ++j) gg[j] = gr[64 * j];
            for (int m = gw; m < M_; m += 4 * NGW) {
                f32x4 v[4][4]; float s[4];
#pragma unroll
                for (int q = 0; q < 4; ++q) { const int row = m + q * NGW; const f32x4* xr = (const f32x4*)(a.in[0] + (size_t)(row < M_ ? row : m) * D_) + F.lane;
#pragma unroll
                    for (int j = 0; j < 4; ++j) v[q][j] = xr[64 * j]; }
#pragma unroll
                for (int q = 0; q < 4; ++q) { s[q] = 0.f;
#pragma unroll
                    for (int j = 0; j < 4; ++j) s[q] += (v[q][j].x * v[q][j].x + v[q][j].y * v[q][j].y) + (v[q][j].z * v[q][j].z + v[q][j].w * v[q][j].w); }
#pragma unroll
                for (int q = 0; q < 4; ++q) { const int row = m + q * NGW; const float r = rsqrtf(wave_sum(s[q]) * (1.f / D_) + EPS);
                    if (row < M_) { u32x2* o8 = (u32x2*)((bf16_t*)(ws + WS_HB) + (size_t)row * D_) + F.lane;
#pragma unroll
                        for (int j = 0; j < 4; ++j) { u32x2 w; w.x = cvtpk(v[q][j].x * r * gg[j].x, v[q][j].y * r * gg[j].y); w.y = cvtpk(v[q][j].z * r * gg[j].z, v[q][j].w * r * gg[j].w); o8[64 * j] = w; } } }
            }
        }
    }
    if (do_moe_w) {
        constexpr int NI = NE * (I_UP1 + I_DN1);
        for (int it = gw; it < NI; it += NGW) {
            int r = it;
            if (r < NE * I_UP1) { const int e = r / I_UP1; p0_transpose_item_fp8(w_up + (size_t)e * D_ * 2 * DFF, D_, 2 * DFF, (unsigned char*)(ws + WS_WUP) + (size_t)e * 2 * DFF * D_, scr, r % I_UP1, F.lane, W8_SCALE); continue; }
            r -= NE * I_UP1;
            { const int e = r / I_DN1; p0_transpose_item_fp8(w_down + (size_t)e * DFF * D_, DFF, D_, (unsigned char*)(ws + WS_WDN) + (size_t)e * D_ * DFF, scr, r % I_DN1, F.lane, W8_SCALE); }
        }
    }
}

__device__ __forceinline__ void ld16bf(const bf16_t* p, float (&v)[16]) {
    const u32x4 a = *(const u32x4*)p, b = *(const u32x4*)(p + 8);
    v[0] = bflo(a.x); v[1] = bfhi(a.x); v[2] = bflo(a.y); v[3] = bfhi(a.y); v[4] = bflo(a.z); v[5] = bfhi(a.z); v[6] = bflo(a.w); v[7] = bfhi(a.w);
    v[8] = bflo(b.x); v[9] = bfhi(b.x); v[10] = bflo(b.y); v[11] = bfhi(b.y); v[12] = bflo(b.z); v[13] = bfhi(b.z); v[14] = bflo(b.w); v[15] = bfhi(b.w);
}
__device__ __forceinline__ void st16bf(bf16_t* p, const float (&v)[16]) {
    u32x4 a, b; a.x = cvtpk(v[0], v[1]); a.y = cvtpk(v[2], v[3]); a.z = cvtpk(v[4], v[5]); a.w = cvtpk(v[6], v[7]);
    b.x = cvtpk(v[8], v[9]); b.y = cvtpk(v[10], v[11]); b.z = cvtpk(v[12], v[13]); b.w = cvtpk(v[14], v[15]);
    *(u32x4*)p = a; *(u32x4*)(p + 8) = b;
}
struct PrepIn { unsigned cq0, cq1, cq2; u32x2 ckv; u32x4 qa, qb, ka, kb, vv; float rope; };
__device__ __forceinline__ void p4_load(PrepIn& in, int row, const bf16_t* proj, const bf16_t* qraw, const bf16_t* kvraw, const float* rope, int lane) {
    const int h = lane >> 3, s = lane & 7;
    const bf16_t* pr = proj + (size_t)row * INWP;
    { const bf16_t* p = pr + C_CQ + lane * 6; in.cq0 = *(const unsigned*)p; in.cq1 = *(const unsigned*)(p + 2); in.cq2 = *(const unsigned*)(p + 4); }
    in.ckv = *(const u32x2*)(pr + C_CKV + lane * 4);
    in.rope = rope[(size_t)row * 32 + (lane & 31)];
    const u32x4 z = {0u, 0u, 0u, 0u};
    in.qa = z; in.qb = z; in.ka = z; in.kb = z;
    if (s < 6) {
        const bf16_t* k = (s < 4) ? (kvraw + (size_t)row * 1024 + h * 128 + s * 16) : (pr + C_KR + (s - 4) * 16); in.ka = *(const u32x4*)k; in.kb = *(const u32x4*)(k + 8); }
    in.vv = *(const u32x4*)(kvraw + (size_t)row * 1024 + (lane >> 3) * 128 + 64 + (lane & 7) * 8);
}
__device__ __forceinline__ void unpack16(const u32x4 a, const u32x4 b, float (&v)[16]) {
    v[0] = bflo(a.x); v[1] = bfhi(a.x); v[2] = bflo(a.y); v[3] = bfhi(a.y); v[4] = bflo(a.z); v[5] = bfhi(a.z); v[6] = bflo(a.w); v[7] = bfhi(a.w);
    v[8] = bflo(b.x); v[9] = bfhi(b.x); v[10] = bflo(b.y); v[11] = bfhi(b.y); v[12] = bflo(b.z); v[13] = bfhi(b.z); v[14] = bflo(b.w); v[15] = bfhi(b.w);
}
__device__ __forceinline__ void p4_prep(Frame& F, const Args& a) {
    unsigned char* ws = F.ws;
    const bf16_t* proj = (const bf16_t*)(ws + WS_PROJ); const bf16_t* qraw = (const bf16_t*)(ws + WS_QRAW); const bf16_t* kvraw = (const bf16_t*)(ws + WS_KVRAW);
    bf16_t* QB = (bf16_t*)(ws + WS_QB); bf16_t* KB = (bf16_t*)(ws + WS_KB); bf16_t* VB = (bf16_t*)(ws + WS_VB);
    const float* rope = (const float*)(ws + WS_ROPE); const float* gq = a.in[8]; const float* gk = a.in[9];
    const int gw = F.vcu * NWAVES + F.wave, NGW = F.G * NWAVES, lane = F.lane, h = lane >> 3, s = lane & 7;
    float gqv[16], gkv[16];
#pragma unroll
    for (int j = 0; j < 16; ++j) { gqv[j] = (s < 6) ? gq[s * 16 + j] : 0.f; gkv[j] = (s < 6) ? gk[s * 16 + j] : 0.f; }
    PrepIn cur, nxt;
    if (gw < M_) p4_load(cur, gw, proj, qraw, kvraw, rope, lane);
    for (int row = gw; row < M_; row += NGW) {
        const bool hn = row + NGW < M_;
        if (hn) p4_load(nxt, row + NGW, proj, qraw, kvraw, rope, lane);
        float sq = bflo(cur.cq0) * bflo(cur.cq0) + bfhi(cur.cq0) * bfhi(cur.cq0) + bflo(cur.cq1) * bflo(cur.cq1) + bfhi(cur.cq1) * bfhi(cur.cq1) + bflo(cur.cq2) * bflo(cur.cq2) + bfhi(cur.cq2) * bfhi(cur.cq2);
        float skv = bflo(cur.ckv.x) * bflo(cur.ckv.x) + bfhi(cur.ckv.x) * bfhi(cur.ckv.x) + bflo(cur.ckv.y) * bflo(cur.ckv.y) + bfhi(cur.ckv.y) * bfhi(cur.ckv.y);
        sq = wave_sum(sq); skv = wave_sum(skv);
        const float var_cq = sq * (1.f / 384.f) + EPS;
        const float rstd_ckv = rsqrtf(skv * (1.f / 256.f) + EPS);
        float cs[16], sn[16];
#pragma unroll
        for (int j = 0; j < 16; ++j) { cs[j] = __int_as_float(__builtin_amdgcn_readlane(__float_as_int(cur.rope), j)); sn[j] = __int_as_float(__builtin_amdgcn_readlane(__float_as_int(cur.rope), 16 + j)); }
        if (lane == 0) ((float*)(ws + WS_VARCQ))[row] = var_cq;
        {
            float v[16]; unpack16(cur.ka, cur.kb, v);
            if (s < 4) {
#pragma unroll
                for (int j = 0; j < 16; ++j) v[j] *= rstd_ckv; }
            float ss = 0.f;
#pragma unroll
            for (int j = 0; j < 16; ++j) ss += v[j] * v[j];
            ss = sum8(ss);
            const float r = rsqrtf(ss * (1.f / 96.f) + EPS);
#pragma unroll
            for (int j = 0; j < 16; ++j) v[j] = v[j] * r * gkv[j];
            float o[16];
#pragma unroll
            for (int j = 0; j < 16; ++j) { const float pv = DPP_F(v[j], DPP_X1);
                o[j] = (s == 4) ? (v[j] * cs[j] - pv * sn[j]) : (s == 5) ? (v[j] * cs[j] + pv * sn[j]) : v[j]; }
            if (s < 6) st16bf(KB + (size_t)row * 768 + h * 96 + s * 16, o);
            const u32x4 vw = cur.vv;
            u32x4 ow; ow.x = cvtpk(bflo(vw.x) * rstd_ckv, bfhi(vw.x) * rstd_ckv); ow.y = cvtpk(bflo(vw.y) * rstd_ckv, bfhi(vw.y) * rstd_ckv);
            ow.z = cvtpk(bflo(vw.z) * rstd_ckv, bfhi(vw.z) * rstd_ckv); ow.w = cvtpk(bflo(vw.w) * rstd_ckv, bfhi(vw.w) * rstd_ckv);
            *(u32x4*)(VB + (size_t)row * 512 + lane * 8) = ow;
        }
        if (hn) cur = nxt;
    }
}
namespace att {
constexpr int BUFB = 20480;
constexpr int WREG = 8448;
constexpr int OST_OFF = 2 * BUFB;
constexpr int WSF_OFF = OST_OFF + 8 * WREG;
constexpr int FLG_OFF = WSF_OFF + 8 * 256;
__device__ __forceinline__ int crow(int r, int hi) { return (r & 3) + 8 * (r >> 2) + 4 * hi; }
__device__ __forceinline__ s16x4 vtr(const LAS char* p) { typedef short v4i16_t __attribute__((ext_vector_type(4))); return __builtin_bit_cast(s16x4, __builtin_amdgcn_ds_read_tr16_b64_v4i16((LAS v4i16_t*)p)); }
#define ATT_MFMA(a, b, c) __builtin_amdgcn_mfma_f32_32x32x16_bf16((a), (b), (c), 0, 0, 0)

template <int NCH> struct Stage {
    u32x4 k0, k1, v0;
    __device__ __forceinline__ void load(const bf16_t* Kb, int pitchK, const bf16_t* Vb, int pitchV, int key0, int wid, int lane) {
        k0 = *(const u32x4*)(Kb + (size_t)(key0 + lane) * pitchK + wid * 8);
        if (NCH > 8) { if (wid < NCH - 8) k1 = *(const u32x4*)(Kb + (size_t)(key0 + lane) * pitchK + (8 + wid) * 8); }
        v0 = *(const u32x4*)(Vb + (size_t)(key0 + 16 * (wid & 3) + (lane >> 2)) * pitchV + (wid >> 2) * 32 + (lane & 3) * 8);
    }
    __device__ __forceinline__ void write(LAS unsigned char* buf, int wid, int lane) const {
        *(LAS u32x4*)(buf + wid * 1024 + lane * 16) = k0;
        if (NCH > 8) { if (wid < NCH - 8) *(LAS u32x4*)(buf + (8 + wid) * 1024 + lane * 16) = k1; }
        *(LAS u32x4*)(buf + NCH * 1024 + wid * 1024 + lane * 16) = v0;
    }
};

__device__ __forceinline__ void pv_tile(f32x16 (&o)[2], const LAS char* vp, const bf16x8 (&pa)[4]) {
    __builtin_amdgcn_s_setprio(1);
#pragma unroll
    for (int d0 = 0; d0 < 2; ++d0)
#pragma unroll
        for (int ks = 0; ks < 4; ++ks) {
            const s16x4 lo = vtr(vp + d0 * 4096 + ks * 1024), hi = vtr(vp + d0 * 4096 + ks * 1024 + 512);
            const bf16x8 vf = __builtin_shufflevector(lo, hi, 0, 1, 2, 3, 4, 5, 6, 7);
            o[d0] = ATT_MFMA(pa[ks], vf, o[d0]);
        }
    __builtin_amdgcn_s_setprio(0);
}
__device__ __forceinline__ bf16x8 pack8(const f32x16& p, int base) {
    u32x4 w; w.x = cvtpk(p[base], p[base + 1]); w.y = cvtpk(p[base + 2], p[base + 3]); w.z = cvtpk(p[base + 4], p[base + 5]); w.w = cvtpk(p[base + 6], p[base + 7]);
    return __builtin_bit_cast(bf16x8, w);
}
__device__ __forceinline__ void store_o(const f32x16 (&o)[2], const float (&rs)[16], LAS unsigned char* lds, int wid, int lane, bf16_t* Ow) {
    const int r32 = lane & 31, hi = lane >> 5;
    LAS bf16_t* stg = (LAS bf16_t*)(lds + OST_OFF + wid * WREG);
#pragma unroll
    for (int r = 0; r < 16; ++r) { const int orow = crow(r, hi);
#pragma unroll
        for (int d0 = 0; d0 < 2; ++d0) { const unsigned w = cvtpk(o[d0][r] * rs[r], 0.f); stg[orow * 64 + d0 * 32 + r32] = (bf16_t)(w & 0xffffu); } }
    asm volatile("s_waitcnt lgkmcnt(0)" ::: "memory");
#pragma unroll
    for (int i = 0; i < 4; ++i) { const int row = i * 8 + (lane >> 3), ch = lane & 7; const u32x4 v = *(const LAS u32x4*)(stg + row * 64 + ch * 8); *(u32x4*)(Ow + (size_t)row * 512 + ch * 8) = v; }
    asm volatile("s_waitcnt lgkmcnt(0)" ::: "memory");
}


constexpr int MLA_CONV_PERIOD = 4;
struct Conv {
    const float* w_up; const float* w_down; unsigned char* up8; unsigned char* dn8; int item, step, ctr; bool inflight;
    static constexpr int I_UP1 = (D_ / 64) * (2 * DFF / 32), I_DN1 = (DFF / 64) * (D_ / 32), NI = NE * (I_UP1 + I_DN1);
    const float* src; unsigned char* dst; int K, N;
    __device__ __forceinline__ bool pending() const { return item < NI; }
    __device__ __forceinline__ void load_to(f32x4 (&t)[8], int lane) {
        int r = item;
        if (r < NE * I_UP1) { const int e = r / I_UP1; r %= I_UP1; K = D_; N = 2 * DFF; const int nblk = N / 32, kb = r / nblk, nb = r % nblk; src = w_up + (size_t)e * D_ * 2 * DFF + (size_t)(64 * kb) * N + 32 * nb; dst = up8 + (size_t)e * 2 * DFF * D_ + (size_t)(32 * nb) * K + 64 * kb; }
        else { r -= NE * I_UP1; const int e = r / I_DN1; r %= I_DN1; K = DFF; N = D_; const int nblk = N / 32, kb = r / nblk, nb = r % nblk; src = w_down + (size_t)e * DFF * D_ + (size_t)(64 * kb) * N + 32 * nb; dst = dn8 + (size_t)e * D_ * DFF + (size_t)(32 * nb) * K + 64 * kb; }
        const float* p = src + (size_t)(8 * (lane >> 3)) * N + 4 * (lane & 7);
#pragma unroll
        for (int j = 0; j < 8; ++j) t[j] = *(const f32x4*)(p + (size_t)j * N);
    }
    __device__ __forceinline__ void finish_from(const f32x4 (&t)[8], LAS float*, int lane) {
        unsigned char* q = dst + (size_t)(4 * (lane & 7)) * K + 8 * (lane >> 3);
#pragma unroll
        for (int c4 = 0; c4 < 4; ++c4) {
            u32x2 o; o.x = pk_fp8x4(t[0][c4] * W8_SCALE, t[1][c4] * W8_SCALE, t[2][c4] * W8_SCALE, t[3][c4] * W8_SCALE); o.y = pk_fp8x4(t[4][c4] * W8_SCALE, t[5][c4] * W8_SCALE, t[6][c4] * W8_SCALE, t[7][c4] * W8_SCALE);
            *(u32x2*)(q + (size_t)c4 * K) = o; }
        item += step;
    }
    __device__ __forceinline__ void tick_begin(f32x4 (&tv)[8], int lane) { if (!inflight && ctr == 0 && pending()) { load_to(tv, lane); inflight = true; } }
    __device__ __forceinline__ void tick_end(const f32x4 (&tv)[8], LAS float* scr, int lane) { if (inflight && ctr == 2) { finish_from(tv, scr, lane); inflight = false; } ctr = (ctr == MLA_CONV_PERIOD - 1) ? 0 : ctr + 1; }
    __device__ __forceinline__ void flush(const f32x4 (&tv)[8], LAS float* scr, int lane) { if (inflight) { finish_from(tv, scr, lane); inflight = false; } }
    __device__ __forceinline__ void drain(LAS float* scr, int lane) { while (pending()) { f32x4 t2[8]; load_to(t2, lane); finish_from(t2, scr, lane); } }
};
__device__ __forceinline__ void mla_unit(LAS unsigned char* lds, int b, int h, int qb, const bf16_t* QB, const bf16_t* KB, const bf16_t* VB, bf16_t* O, float m0, Conv& cv, const Args& ka) {
    const int tid = threadIdx.x, lane = tid & 63, r32 = lane & 31, hi = lane >> 5; const int wid = __builtin_amdgcn_readfirstlane(tid >> 6);
    const size_t rb = (size_t)b * S_; const int q0 = qb * 256;
    const bf16_t* Kh = KB + rb * 768 + h * 96; const bf16_t* Vh = VB + rb * 512 + h * 64;
    bf16x8 qr[6];
    { const size_t row = rb + q0 + wid * 32 + r32;
      const float* gq = ka.in[8]; const float* ropet = (const float*)(ka.ws + WS_ROPE); const float* varcq = (const float*)(ka.ws + WS_VARCQ);
      const bf16_t* qp = QB + row * 768 + h * 96 + hi * 8;
      float v[6][8]; float ss = 0.f;
#pragma unroll
      for (int d0 = 0; d0 < 6; ++d0) { const u32x4 w = *(const u32x4*)(qp + d0 * 16);
          v[d0][0] = bflo(w.x); v[d0][1] = bfhi(w.x); v[d0][2] = bflo(w.y); v[d0][3] = bfhi(w.y); v[d0][4] = bflo(w.z); v[d0][5] = bfhi(w.z); v[d0][6] = bflo(w.w); v[d0][7] = bfhi(w.w);
#pragma unroll
          for (int j = 0; j < 8; ++j) ss += v[d0][j] * v[d0][j]; }
      ss += __shfl_xor(ss, 32);
      const float r = rsqrtf(ss * (1.f / 96.f) + EPS * varcq[row]) * MLA_QSCALE;
#pragma unroll
      for (int d0 = 0; d0 < 6; ++d0) { const f32x4 g0 = *(const f32x4*)(gq + d0 * 16 + hi * 8), g1 = *(const f32x4*)(gq + d0 * 16 + hi * 8 + 4);
          v[d0][0] *= r * g0.x; v[d0][1] *= r * g0.y; v[d0][2] *= r * g0.z; v[d0][3] *= r * g0.w; v[d0][4] *= r * g1.x; v[d0][5] *= r * g1.y; v[d0][6] *= r * g1.z; v[d0][7] *= r * g1.w; }
      { const f32x4 c0 = *(const f32x4*)(ropet + row * 32 + hi * 8), c1 = *(const f32x4*)(ropet + row * 32 + hi * 8 + 4), s0 = *(const f32x4*)(ropet + row * 32 + 16 + hi * 8), s1 = *(const f32x4*)(ropet + row * 32 + 16 + hi * 8 + 4);
        const float cs[8] = {c0.x, c0.y, c0.z, c0.w, c1.x, c1.y, c1.z, c1.w}, sn[8] = {s0.x, s0.y, s0.z, s0.w, s1.x, s1.y, s1.z, s1.w};
#pragma unroll
        for (int j = 0; j < 8; ++j) { const float x1 = v[4][j], x2 = v[5][j]; v[4][j] = x1 * cs[j] - x2 * sn[j]; v[5][j] = x2 * cs[j] + x1 * sn[j]; } }
#pragma unroll
      for (int d0 = 0; d0 < 6; ++d0) { u32x4 w; w.x = cvtpk(v[d0][0], v[d0][1]); w.y = cvtpk(v[d0][2], v[d0][3]); w.z = cvtpk(v[d0][4], v[d0][5]); w.w = cvtpk(v[d0][6], v[d0][7]); qr[d0] = __builtin_bit_cast(bf16x8, w); } }
    const int NT = 4 * qb + 4, my_last = 4 * qb + (wid >> 1);
    f32x16 o[2]; float l = 0.f;
#pragma unroll
    for (int r = 0; r < 16; ++r) { o[0][r] = 0.f; o[1][r] = 0.f; }
    f32x16 negm;
#pragma unroll
    for (int r = 0; r < 16; ++r) negm[r] = -m0;
    asm volatile("" : "+v"(negm));
    Stage<12> st;
    st.load(Kh, 768, Vh, 512, 0, wid, lane); st.write(lds, wid, lane);
    __syncthreads();
    LAS float* cscr = (LAS float*)(lds + OST_OFF + wid * WREG);
    f32x4 tv[8];
    for (int t = 0; t < NT; ++t) {
        if (t + 1 < NT) st.load(Kh, 768, Vh, 512, (t + 1) * 64, wid, lane);
        asm volatile("" ::: "memory");
        cv.tick_begin(tv, lane);
        if (t <= my_last) {
            const LAS char* buf = (const LAS char*)(lds + (t & 1) * BUFB);
            const LAS char* kp = buf + hi * 1024 + r32 * 16;
            f32x16 p0, p1;
            __builtin_amdgcn_s_setprio(1);
#pragma unroll
            for (int d0 = 0; d0 < 6; ++d0) { const bf16x8 a0 = *(const LAS bf16x8*)(kp + d0 * 2048), a1 = *(const LAS bf16x8*)(kp + d0 * 2048 + 512);
#ifndef ABL_NOQK
                if (d0 == 0) { p0 = ATT_MFMA(a0, qr[0], negm); p1 = ATT_MFMA(a1, qr[0], negm); }
                else { p0 = ATT_MFMA(a0, qr[d0], p0); p1 = ATT_MFMA(a1, qr[d0], p1); }
#else
                if (d0 == 0) { p0 = negm; p1 = negm; } asm volatile("" :: "v"(a0), "v"(a1));
#endif
            }
            __builtin_amdgcn_s_setprio(0);
            float ls = 0.f;
#ifndef ABL_NOEXP
#pragma unroll
            for (int r = 0; r < 16; ++r) { p0[r] = __builtin_amdgcn_exp2f(p0[r]); p1[r] = __builtin_amdgcn_exp2f(p1[r]); ls += p0[r] + p1[r]; }
#endif
            l += ls;
            bf16x8 pa[4]; pa[0] = pack8(p0, 0); pa[1] = pack8(p0, 8); pa[2] = pack8(p1, 0); pa[3] = pack8(p1, 8);
            const LAS char* vp = buf + 12 * 1024 + ((lane >> 4) & 1) * 32 + (lane & 3) * 8 + (4 * hi + ((lane & 15) >> 2)) * 64;
#ifndef ABL_NOPV
            pv_tile(o, vp, pa);
#else
            asm volatile("" :: "v"(pa[0]), "v"(pa[1]), "v"(pa[2]), "v"(pa[3]), "v"(vp));
#endif
        }
        if (t + 1 < NT) st.write(lds + ((t + 1) & 1) * BUFB, wid, lane);
        cv.tick_end(tv, cscr, lane);
        __syncthreads();
    }
    cv.flush(tv, cscr, lane);
    l += __shfl_xor(l, 32);
    LAS float* wsf = (LAS float*)(lds + WSF_OFF) + wid * 64;
    if (hi == 0) wsf[r32] = l;
    asm volatile("s_waitcnt lgkmcnt(0)" ::: "memory");
    float rs[16];
#pragma unroll
    for (int r = 0; r < 16; ++r) rs[r] = __builtin_amdgcn_rcpf(wsf[crow(r, hi)]);
    store_o(o, rs, lds, wid, lane, O + (rb + q0 + wid * 32) * 512 + h * 64);
}

__device__ __forceinline__ void sb_unit(LAS unsigned char* lds, int b, int h, int qb, const bf16_t* proj, bf16_t* O, Conv& cv) {
    const int tid = threadIdx.x, lane = tid & 63, r32 = lane & 31, hi = lane >> 5; const int wid = __builtin_amdgcn_readfirstlane(tid >> 6);
    const size_t rb = (size_t)b * S_; const int q0 = qb * 256;
    const bf16_t* Kh = proj + rb * INWP + C_SBK + h * 64; const bf16_t* Vh = proj + rb * INWP + C_SBV + h * 64;
    bf16x8 qr[4];
    { const bf16_t* qp = proj + (rb + q0 + wid * 32 + r32) * INWP + C_SBQ + h * 64 + hi * 8;
#pragma unroll
      for (int d0 = 0; d0 < 4; ++d0) qr[d0] = *(const bf16x8*)(qp + d0 * 16); }
    const int Ttop = 4 * qb + 3, qw0 = q0 + wid * 32, qabs = qw0 + r32;
    f32x16 o[2]; float carry = 1.f;
#pragma unroll
    for (int r = 0; r < 16; ++r) { o[0][r] = 0.f; o[1][r] = 0.f; }
    volatile LAS int* flg = (volatile LAS int*)(lds + FLG_OFF);
    Stage<8> st;
    st.load(Kh, INWP, Vh, INWP, Ttop * 64, wid, lane); st.write(lds, wid, lane);
    __syncthreads();
    bool alive = true;
    for (int it = 0;; ++it) {
        const int t = Ttop - it;
        if (t > 0) st.load(Kh, INWP, Vh, INWP, (t - 1) * 64, wid, lane);
        asm volatile("" ::: "memory");
        f32x4 ctv[8]; const bool cvp = cv.pending() && (((it + wid) & 1) == 0);
        if (cvp) cv.load_to(ctv, lane);
        if (alive && (64 * t <= qw0 + 30)) {
            const LAS char* buf = (const LAS char*)(lds + (it & 1) * BUFB);
            const LAS char* kp = buf + hi * 1024 + r32 * 16;
            const bool need_mask = (64 * t + 63 >= qw0);
            bf16x8 pa[4];
#pragma unroll
            for (int blk = 1; blk >= 0; --blk) {
                f32x16 p;
#pragma unroll
                for (int r = 0; r < 16; ++r) p[r] = 0.f;
#pragma unroll
                for (int d0 = 0; d0 < 4; ++d0) { const bf16x8 a0 = *(const LAS bf16x8*)(kp + d0 * 2048 + blk * 512); p = ATT_MFMA(a0, qr[d0], p); }
                const int kb0 = 64 * t + 32 * blk + 4 * hi;
                f32x16 s;
#pragma unroll
                for (int r = 0; r < 16; ++r) {
                    const int key = kb0 + (r & 3) + 8 * (r >> 2);
                    const float tt = __builtin_amdgcn_exp2f(-fmaxf(p[r], -80.f)); float be = __builtin_amdgcn_rcpf(1.f + tt); float sy = tt * be;
                    if (need_mask && !(key < qabs)) { be = 0.f; sy = 1.f; }
                    p[r] = be; s[r] = sy;
                }
                float T[5]; T[4] = 1.f;
#pragma unroll
                for (int i = 3; i >= 0; --i) T[i] = T[i + 1] * ((s[4 * i] * s[4 * i + 1]) * (s[4 * i + 2] * s[4 * i + 3]));
                float Tp[5]; Tp[4] = 1.f;
#pragma unroll
                for (int i = 0; i < 4; ++i) Tp[i] = __shfl_xor(T[i], 32);
#pragma unroll
                for (int i = 3; i >= 0; --i) {
                    float lat = carry * (T[i + 1] * (hi ? Tp[i + 1] : Tp[i]));
#pragma unroll
                    for (int e3 = 3; e3 >= 0; --e3) { const int r = 4 * i + e3; const float sy = s[r]; p[r] = p[r] * lat; lat *= sy; }
                }
                carry *= T[0] * Tp[0];
                pa[2 * blk] = pack8(p, 0); pa[2 * blk + 1] = pack8(p, 8);
            }
            const LAS char* vp = buf + 8 * 1024 + ((lane >> 4) & 1) * 32 + (lane & 3) * 8 + (4 * hi + ((lane & 15) >> 2)) * 64;
            pv_tile(o, vp, pa);
            alive = __any(carry > 0.f);
        }
        if (lane == 0) flg[(it & 1) * 8 + wid] = alive ? 1 : 0;
        if (t > 0) st.write(lds + ((it + 1) & 1) * BUFB, wid, lane);
        if (cvp) cv.finish_from(ctv, (LAS float*)(lds + OST_OFF + wid * WREG), lane);
        __syncthreads();
        if (t == 0) break;
        int any = 0;
#pragma unroll
        for (int w = 0; w < 8; ++w) any |= flg[(it & 1) * 8 + w];
        if (!any) break;
    }
    float rs[16];
#pragma unroll
    for (int r = 0; r < 16; ++r) rs[r] = 1.f;
    store_o(o, rs, lds, wid, lane, O + (rb + q0 + wid * 32) * 512 + h * 64);
}
}

__device__ __forceinline__ void p5_attention(Frame& F, const Args& a) {
    unsigned char* ws = F.ws;
    volatile LAS int* citem = (volatile LAS int*)(F.MISC + MI_CITEM) + F.wave;
    {
        float gm;
        { const float* gq = a.in[8]; const float* gk = a.in[9]; float mq = 0.f, mk = 0.f;
          for (int i = F.lane; i < 96; i += 64) { mq = fmaxf(mq, fabsf(gq[i])); mk = fmaxf(mk, fabsf(gk[i])); }
#pragma unroll
          for (int o = 1; o < 64; o <<= 1) { mq = fmaxf(mq, __shfl_xor(mq, o)); mk = fmaxf(mk, __shfl_xor(mk, o)); }
          gm = 9.79795897f * LOG2E * mq * mk; }
        att::Conv cv; cv.w_up = a.in[16]; cv.w_down = a.in[18]; cv.up8 = (unsigned char*)(ws + WS_WUP); cv.dn8 = (unsigned char*)(ws + WS_WDN);
        cv.item = F.vcu * NWAVES + F.wave; cv.step = F.G * NWAVES; cv.ctr = F.wave % att::MLA_CONV_PERIOD; cv.inflight = false;
#ifdef ABL_NOCONV
        cv.item = att::Conv::NI;
#endif
        for (int v = F.vcu; v < 256; v += F.G) {
            const int bh = v >> 3, s = v & 7, b = bh >> 3, h = bh & 7;
            for (int i = 0; i < 2; ++i) { const int qb = i ? 15 - s : s;
                att::mla_unit(F.lds, b, h, qb, (const bf16_t*)(ws + WS_QRAW), (const bf16_t*)(ws + WS_KB), (const bf16_t*)(ws + WS_VB), (bf16_t*)(ws + WS_OMLA), gm, cv, a);
                __syncthreads(); }
        }
        if (F.lane == 0) *citem = cv.item;
    }
    __syncthreads();
#ifdef MEGA_STAMPS
    if (blockIdx.x == 0 && F.tid == 0) ((unsigned long long*)(ws + WS_CTL + 32768))[12] = __builtin_amdgcn_s_memrealtime();
#endif
    {
        att::Conv cv; cv.w_up = a.in[16]; cv.w_down = a.in[18]; cv.up8 = (unsigned char*)(ws + WS_WUP); cv.dn8 = (unsigned char*)(ws + WS_WDN);
        cv.item = __builtin_amdgcn_readfirstlane(*citem); cv.step = F.G * NWAVES; cv.ctr = 0; cv.inflight = false;
        for (int v = F.vcu; v < 256; v += F.G) {
            const int bh = v >> 3, s = v & 7, b = bh >> 3, h = bh & 7;
            for (int i = 0; i < 2; ++i) { const int qb = i ? 15 - s : s;
                att::sb_unit(F.lds, b, h, qb, (const bf16_t*)(ws + WS_PROJ), (bf16_t*)(ws + WS_OSB), cv);
                __syncthreads(); }
        }
        cv.drain((LAS float*)(F.lds + att::OST_OFF + F.wave * att::WREG), F.lane);
    }
}

__device__ __forceinline__ void p8_router(Frame& F, const Args& a) {
    unsigned char* ws = F.ws;
    const bf16_t* x1 = (const bf16_t*)(ws + WS_X1B); const float* wr = (const float*)(ws + WS_WR); const float* br = a.in[15]; const float* g = a.in[13];
    unsigned char* H2 = (unsigned char*)(ws + WS_H2F8); int* list = (int*)(ws + WS_LIST); float* topw = (float*)(ws + WS_TOPW); int* selo = (int*)(ws + WS_SEL);
    int* cnt = (int*)(ws + WS_CTL) + CW_CNT;
    volatile LAS int* lcnt = (volatile LAS int*)(F.MISC + MI_LCNT); volatile LAS int* lbase = (volatile LAS int*)(F.MISC + MI_BASE);
    const int lane = F.lane, wave = F.wave, tid = F.tid;
    constexpr int WST = 1028;
    LAS float* wt = (LAS float*)F.lds;
    if (F.vcu < M_ / 64) {
        for (int i = tid; i < NE * WST / 4; i += NTHR) *(LAS f32x4*)(wt + (size_t)i * 4) = *(const f32x4*)(wr + (size_t)i * 4);
    }
    __syncthreads();
    for (int task = F.vcu; task < M_ / 64; task += F.G) {
        const int T0 = task * 64;
        if (tid < 32) lcnt[tid] = 0;
        __syncthreads();
        int my_e = 0, my_rank = 0; float my_w = 0.f;
        if (wave < 4) {
            const int tk = lane & 15, kp = lane >> 4, tok = T0 + wave * 16 + tk;
            const bf16_t* xp = x1 + (size_t)tok * D_ + kp * 256;
            const LAS float* w0 = wt + tk * WST + kp * 256; const LAS float* w1 = w0 + 16 * WST;
            f32x4 acc0 = {0.f, 0.f, 0.f, 0.f}, acc1 = {0.f, 0.f, 0.f, 0.f}; float ssq = 0.f;
#pragma unroll 4
            for (int i = 0; i < 256; i += 4) {
                const u32x2 aw = *(const u32x2*)(xp + i); const f32x4 a4 = {bflo(aw.x), bfhi(aw.x), bflo(aw.y), bfhi(aw.y)}; const f32x4 b0 = *(const LAS f32x4*)(w0 + i), b1 = *(const LAS f32x4*)(w1 + i);
                ssq += (a4.x * a4.x + a4.y * a4.y) + (a4.z * a4.z + a4.w * a4.w);
#pragma unroll
                for (int j = 0; j < 4; ++j) { acc0 = __builtin_amdgcn_mfma_f32_16x16x4f32(a4[j], b0[j], acc0, 0, 0, 0); acc1 = __builtin_amdgcn_mfma_f32_16x16x4f32(a4[j], b1[j], acc1, 0, 0, 0); }
            }
            ssq += __shfl_xor(ssq, 16); ssq += __shfl_xor(ssq, 32);
            const float rstd = rsqrtf(ssq * (1.f / D_) + EPS);
            const int e0 = lane & 15, grp = lane >> 4;
            const float bia0 = br[e0], bia1 = br[e0 + 16];
#pragma unroll
            for (int j = 0; j < 4; ++j) {
                const float rs = __shfl(rstd, 4 * grp + j);
                float c0 = acc0[j] * rs + bia0, c1 = acc1[j] * rs + bia1;
                float sv[4]; int si[4];
#pragma unroll
                for (int k = 0; k < 4; ++k) {
                    float best = c0; int bi = e0;
                    if (c1 > best) { best = c1; bi = e0 + 16; }
#pragma unroll
                    for (int st_ = 0; st_ < 4; ++st_) { const int ctl = st_ == 0 ? DPP_X1 : st_ == 1 ? DPP_X2 : st_ == 2 ? DPP_HM : DPP_RM;
                        float ob; int oi;
                        if (st_ == 0) { ob = DPP_F(best, DPP_X1); oi = DPP_I(bi, DPP_X1); } else if (st_ == 1) { ob = DPP_F(best, DPP_X2); oi = DPP_I(bi, DPP_X2); } else if (st_ == 2) { ob = DPP_F(best, DPP_HM); oi = DPP_I(bi, DPP_HM); } else { ob = DPP_F(best, DPP_RM); oi = DPP_I(bi, DPP_RM); }
                        (void)ctl; if (ob > best || (ob == best && oi < bi)) { best = ob; bi = oi; } }
                    sv[k] = best; si[k] = bi;
                    if (bi == e0) c0 = -INFINITY; if (bi == e0 + 16) c1 = -INFINITY;
                }
                float ex[4], sum = 0.f;
#pragma unroll
                for (int k = 0; k < 4; ++k) { ex[k] = __expf(sv[k] - sv[0]); sum += ex[k]; }
                const float inv = 1.f / sum;
                if (((lane >> 2) & 3) == j) {
#pragma unroll
                    for (int k = 0; k < 4; ++k) if ((lane & 3) == k) { my_e = si[k]; my_w = ex[k] * inv; }
                }
            }
            my_rank = atomicAdd((int*)&lcnt[my_e], 1);
        } else {
            const f32x4* gr = (const f32x4*)g + lane;
            f32x4 gg[4];
#pragma unroll
            for (int j = 0; j < 4; ++j) gg[j] = gr[64 * j] * X8_SCALE;
            for (int rr = 0; rr < 16; rr += 4) {
                const int t0 = T0 + (wave - 4) * 16 + rr;
                f32x4 v[4][4]; float s[4];
#pragma unroll
                for (int q = 0; q < 4; ++q) { const u32x2* xr = (const u32x2*)(x1 + (size_t)(t0 + q) * D_) + lane;
#pragma unroll
                    for (int j = 0; j < 4; ++j) { const u32x2 w = xr[64 * j]; v[q][j] = (f32x4){bflo(w.x), bfhi(w.x), bflo(w.y), bfhi(w.y)}; } }
#pragma unroll
                for (int q = 0; q < 4; ++q) { s[q] = 0.f;
#pragma unroll
                    for (int j = 0; j < 4; ++j) s[q] += (v[q][j].x * v[q][j].x + v[q][j].y * v[q][j].y) + (v[q][j].z * v[q][j].z + v[q][j].w * v[q][j].w); }
#pragma unroll
                for (int q = 0; q < 4; ++q) { const float r = rsqrtf(wave_sum(s[q]) * (1.f / D_) + EPS); unsigned* o = (unsigned*)(H2 + (size_t)(t0 + q) * D_) + lane;
#pragma unroll
                    for (int j = 0; j < 4; ++j) o[64 * j] = pk_fp8x4(v[q][j].x * r * gg[j].x, v[q][j].y * r * gg[j].y, v[q][j].z * r * gg[j].z, v[q][j].w * r * gg[j].w); }
            }
        }
        __syncthreads();
        if (tid < 32) lbase[tid] = lcnt[tid] ? atomicAdd(&cnt[tid], lcnt[tid]) : 0;
        __syncthreads();
        if (wave < 4) {
            const int grp = lane >> 4, jj = (lane >> 2) & 3, kk = lane & 3;
            const int tok = T0 + wave * 16 + 4 * grp + jj, slot = tok * 4 + kk;
            list[(size_t)my_e * M_ + lbase[my_e] + my_rank] = slot; ((float*)(ws + WS_LISTW))[(size_t)my_e * M_ + lbase[my_e] + my_rank] = my_w;
            topw[slot] = my_w; selo[slot] = my_e;
        }
        __syncthreads();
    }
}

struct MoeOrder {
    const bf16_t* A; const bf16_t* Bt; const int* list; volatile LAS unsigned* tab;
    int lda, ldb, nN, nwg, G, c, gather; size_t estride;
    __device__ void init(const bf16_t* A_, int lda_, const bf16_t* Bt_, int ldb_, size_t estride_, int nN_, const int* list_, volatile LAS unsigned* tab_, int gather_, int G_, int c_) {
        A = A_; lda = lda_; Bt = Bt_; ldb = ldb_; estride = estride_; nN = nN_; list = list_; tab = tab_; gather = gather_; G = G_; c = c_; nwg = (int)tab[MI_TPFX + NE] * nN_; }
    __device__ __forceinline__ bool next(int i, pg8::Unit& u) const {
        const long L = (long)i * G + c; if (L >= nwg) return false;
        int wgid = (int)L; { const int q = nwg / 8, r = nwg % 8, xcd = wgid % 8, off = wgid / 8; wgid = (xcd < r ? xcd * (q + 1) : r * (q + 1) + (xcd - r) * q) + off; }
        int e = 0;
        for (int k = 1; k < NE; ++k) if ((int)tab[MI_TPFX + k] * nN <= wgid) e = k;
        const int t0 = (int)tab[MI_TPFX + e], nt = (int)tab[MI_TPFX + e + 1] - t0, idx = wgid - t0 * nN;
        u.e = e; u.pn = idx / nt; u.rt = idx % nt; u.pm = t0 + u.rt; const int left = (int)tab[MI_CNT + e] - u.rt * 256; u.rows = left < 256 ? left : 256; return true;
    }
    __device__ __forceinline__ unsigned a_off(const pg8::Unit& u, int r, int C) const {
        int row;
        if (gather) row = (r < u.rows) ? (list[(size_t)u.e * M_ + u.rt * 256 + r] >> 2) : M_;
        else row = u.pm * 256 + r;
        return (unsigned)((row * lda + C) * 2);
    }
    __device__ __forceinline__ const char* b_base(const pg8::Unit& u) const { return (const char*)(Bt + (size_t)u.e * estride + (size_t)u.pn * 256 * ldb); }
};
__device__ __forceinline__ void moe_table(Frame& F) {
    int* cnt = (int*)(F.ws + WS_CTL) + CW_CNT;
    if (F.tid < NE) F.MISC[MI_CNT + F.tid] = __hip_atomic_load((unsigned*)cnt + F.tid, RLX_AGENT);
    __syncthreads();
    if (F.tid == 0) { unsigned p = 0; for (int e = 0; e < NE; ++e) { F.MISC[MI_TPFX + e] = p; p += (F.MISC[MI_CNT + e] + 255u) >> 8; } F.MISC[MI_TPFX + NE] = p; }
    __syncthreads();
}

__device__ __forceinline__ void p12_combine(Frame& F, const Args& a) {
    const bf16_t* Y = (const bf16_t*)(F.ws + WS_YB); const bf16_t* X1 = (const bf16_t*)(F.ws + WS_X1B); float* out = a.out;
    const int gt = (F.vcu * NWAVES + F.wave) * 64 + F.lane, NGT = F.G * NTHR;
    for (int i = gt; i < M_ * D_ / 8; i += NGT) {
        const int t = i >> 7, c = (i & 127) * 8;
        u32x4 w[5];
        w[4] = *(const u32x4*)(X1 + (size_t)t * D_ + c);
#pragma unroll
        for (int k = 0; k < 4; ++k) w[k] = *(const u32x4*)(Y + (size_t)(t * 4 + k) * D_ + c);
        f32x4 v0 = {bflo(w[4].x), bfhi(w[4].x), bflo(w[4].y), bfhi(w[4].y)}, v1 = {bflo(w[4].z), bfhi(w[4].z), bflo(w[4].w), bfhi(w[4].w)};
#pragma unroll
        for (int k = 0; k < 4; ++k) { v0.x += bflo(w[k].x); v0.y += bfhi(w[k].x); v0.z += bflo(w[k].y); v0.w += bfhi(w[k].y); v1.x += bflo(w[k].z); v1.y += bfhi(w[k].z); v1.z += bflo(w[k].w); v1.w += bfhi(w[k].w); }
        *(f32x4*)(out + (size_t)t * D_ + c) = v0; *(f32x4*)(out + (size_t)t * D_ + c + 4) = v1;
    }
}

constexpr int N_PHASES = 11;
#ifndef DUP_PHASE
#define DUP_PHASE -1
#endif
__global__ void __launch_bounds__(NTHR, 2) mega(Args args) {
    extern __shared__ __attribute__((aligned(16))) unsigned char lds_raw[];
    Frame F;
    F.lds = (LAS unsigned char*)lds_raw; F.MISC = (volatile LAS unsigned*)(F.lds + LDS_MISC);
    F.tid = threadIdx.x; F.lane = F.tid & 63; F.wave = __builtin_amdgcn_readfirstlane(F.tid >> 6);
    F.G = gridDim.x; { const int bx = blockIdx.x; F.vcu = (F.G % 8 == 0) ? (bx % 8) * (F.G / 8) + bx / 8 : bx; }
    F.ws = args.ws;
    unsigned char* ws = args.ws;
    for (int u = F.tid; u < (LDS_BYTES - LDS_MISC) / 4; u += NTHR) F.MISC[u] = 0u;
    __syncthreads();
    const int lo = args.ph_lo, hi = args.ph_hi;
    XcdBarrier bar; bar.bar = (unsigned*)(ws + WS_CTL) + CW_BAR; bar.x = 0; bar.st = nullptr;
    if (hi - lo > 1) bar = xcd_barrier_post((unsigned*)(ws + WS_CTL) + CW_BAR, F.MISC + MI_BAR);
#define IN(k) (lo <= (k) && (k) < hi)
#ifdef MEGA_STAMPS
#define STAMP(k) do { if (blockIdx.x == 0 && F.tid == 0) ((unsigned long long*)(ws + WS_CTL + 32768))[(k)] = __builtin_amdgcn_s_memrealtime(); } while (0)
#else
#define STAMP(k) do { } while (0)
#endif
#define SEAM(k) do { if (IN(k) && IN((k) + 1)) xcd_barrier(bar); STAMP((k) + 1); } while (0)
    const int cid = (int)blockIdx.x;
    STAMP(0);

    if (IN(0)) { p0_prologue(F, args, 0, 1); SEAM(0); }
    if (IN(1)) {
        pg8::Gemm g{(const bf16_t*)(ws + WS_HB), D_, D_, D_};
        pg8::StaticOrder S; S.init(g.A, D_, (const bf16_t*)(ws + WS_WIN), D_, M_, 4096, F.G, cid);
        pg8::EpiBf16 E{(bf16_t*)(ws + WS_PROJ), INWP};
        pg8::gemm_phase(F.lds, g, S, E);
        SEAM(1);
    }
    if (IN(2)) {
        { pg8::Gemm g{(const bf16_t*)(ws + WS_HB), D_, D_, D_};
          pg8::StaticOrder S; S.init(g.A, D_, (const bf16_t*)(ws + WS_WIN) + (size_t)4096 * D_, D_, M_, 256, F.G, cid);
          pg8::EpiBf16 E{(bf16_t*)(ws + WS_PROJ) + 4096, INWP};
          pg8::gemm_phase(F.lds, g, S, E); }
        { pg8::Gemm g{(const bf16_t*)(ws + WS_PROJ) + C_CQ, INWP, 384, 384};
          pg8::StaticOrder S; S.init(g.A, INWP, (const bf16_t*)(ws + WS_WUQ), 384, M_, 768, F.G, cid, F.G - 64);
          pg8::EpiBf16 E{(bf16_t*)(ws + WS_QRAW), 768};
          pg8::gemm_phase(F.lds, g, S, E); }
        { pg8::Gemm g{(const bf16_t*)(ws + WS_PROJ) + C_CKV, INWP, 256, 256};
          pg8::StaticOrder S; S.init(g.A, INWP, (const bf16_t*)(ws + WS_WUKV), 256, M_, 1024, F.G, cid);
          pg8::EpiBf16 E{(bf16_t*)(ws + WS_KVRAW), 1024};
          pg8::gemm_phase(F.lds, g, S, E); }
        SEAM(2);
    }
    if (IN(3)) { p4_prep(F, args); SEAM(3); }
    if (IN(4)) { p5_attention(F, args); SEAM(4); }
    if (IN(5)) {
        pg8::Gemm g{(const bf16_t*)(ws + WS_OSB), 512, 512, 512};
        pg8::PairOrder S; S.S.init(g.A, 512, (const bf16_t*)(ws + WS_WOSB), 512, M_, D_, F.G, cid); S.a1 = (WS_OMLA - WS_OSB) / 2; S.b1 = (WS_WOMLA - WS_WOSB) / 2;
        pg8::EpiGate2 E{(bf16_t*)(ws + WS_MIX), (const bf16_t*)(ws + WS_PROJ), INWP, C_GSB, C_GMLA};
        pg8::gemm_phase(F.lds, g, S, E);
        SEAM(5);
    }
    if (IN(6)) {
        pg8::Gemm g{(const bf16_t*)(ws + WS_MIX), D_, D_, D_};
        pg8::StaticOrder S; S.init(g.A, D_, (const bf16_t*)(ws + WS_WOUT), D_, M_, D_, F.G, cid);
        pg8::EpiRes E{args.in[0], (bf16_t*)(ws + WS_X1B)};
        pg8::gemm_phase(F.lds, g, S, E);
        SEAM(6);
    }
    if (IN(7)) { p8_router(F, args); SEAM(7); }
    if (IN(8)) {
        moe_table(F);
        pg8::Gemm g{(const bf16_t*)(ws + WS_H2F8), D_ / 2, D_ / 2, D_ / 2};
        MoeOrder S; S.init(g.A, D_ / 2, (const bf16_t*)(ws + WS_WUP), D_ / 2, (size_t)2 * DFF * D_ / 2, 8, (const int*)(ws + WS_LIST), F.MISC, 1, F.G, cid);
        pg8::EpiSwiglu8 E{(unsigned char*)(ws + WS_ACT), args.in[17]};
        pg8::gemm_phase<pg8::EpiSwiglu8, MoeOrder, true>(F.lds, g, S, E);
        SEAM(8);
    }
    if (IN(9)) {
        moe_table(F);
        pg8::Gemm g{(const bf16_t*)(ws + WS_ACT), DFF / 2, DFF / 2, DFF / 2};
        MoeOrder S; S.init(g.A, DFF / 2, (const bf16_t*)(ws + WS_WDN), DFF / 2, (size_t)D_ * DFF / 2, 4, (const int*)(ws + WS_LIST), F.MISC, 0, F.G, cid);
        pg8::EpiDown E{(bf16_t*)(ws + WS_YB), args.in[19], (const int*)(ws + WS_LIST), (const float*)(ws + WS_LISTW)};
        pg8::gemm_phase<pg8::EpiDown, MoeOrder, true>(F.lds, g, S, E);
        SEAM(9);
    }
    if (IN(10)) { p12_combine(F, args); STAMP(11); }
#undef IN
#undef SEAM
}
static int g_grid = 0;
static int setup_grid() {
    if (g_grid == 0) {
        int dev = 0, cus = 0;
        if (hipGetDevice(&dev) != hipSuccess || hipDeviceGetAttribute(&cus, hipDeviceAttributeMultiprocessorCount, dev) != hipSuccess) { g_grid = -1; return g_grid; }
        if (hipFuncSetAttribute((const void*)mega, hipFuncAttributeMaxDynamicSharedMemorySize, LDS_BYTES) != hipSuccess) { g_grid = -1; return g_grid; }
        int per_cu = 0;
        (void)hipOccupancyMaxActiveBlocksPerMultiprocessor(&per_cu, (const void*)mega, NTHR, LDS_BYTES);
        (void)hipGetLastError();
        g_grid = cus;
    }
    return g_grid;
}
static void launch_mega(void* const* d_in, void* d_out, void* d_ws, int lo, int hi, hipStream_t stream) {
    Args a; memset(&a, 0, sizeof(a));
    for (int i = 0; i < 20; ++i) a.in[i] = (const float*)d_in[i];
    a.out = (float*)d_out; a.ws = (unsigned char*)d_ws; a.ph_lo = lo; a.ph_hi = hi;
    hipLaunchKernelGGL(mega, dim3(g_grid), dim3(NTHR), LDS_BYTES, stream, a);
}
extern "C" void kernel_launch(void* const* d_in, const int* in_sizes, int n_in, void* d_out, int out_size, void* d_ws, size_t ws_size, hipStream_t stream) {
    if (n_in != 20 || ws_size < WS_OPT_END || out_size != M_ * D_) { fprintf(stderr, "kernel_launch: unexpected arguments\n"); return; }
    if (setup_grid() <= 0) return;
    (void)hipMemsetAsync((char*)d_ws + WS_CTL, 0, CTL_ZERO_BYTES, stream);
#if N_LAUNCH_SPLIT
    for (int p = 0; p < N_PHASES; ++p) { launch_mega(d_in, d_out, d_ws, p, p + 1, stream); if (p == DUP_PHASE) { if (p == 7) (void)hipMemsetAsync((char*)d_ws + WS_CTL, 0, 128, stream); if (p == 10) launch_mega(d_in, d_out, d_ws, 6, 7, stream); launch_mega(d_in, d_out, d_ws, p, p + 1, stream); } }
#else
    launch_mega(d_in, d_out, d_ws, 0, N_PHASES, stream);
#endif
}
```

```cpp
#define N_LAUNCH_SPLIT 0
#include <hip/hip_runtime.h>
#include <hip/hip_bf16.h>
#include <cstdio>
#include <cstdint>
#include <cstring>
#include <cmath>

constexpr int B_ = 4, S_ = 4096, D_ = 1024, M_ = B_ * S_;
constexpr int INW = 4256, INWP = 4352;
constexpr int C_SBQ = 0, C_SBK = 512, C_SBV = 1024, C_CQ = 1536, C_CKV = 1920, C_KR = 2176, C_GSB = 2208, C_GMLA = 3232;
constexpr int NE = 32, TOPK = 4, DFF = 1024;
constexpr float EPS = 1e-6f;
constexpr float LOG2E = 1.4426950408889634f;
constexpr float SB_QSCALE = 0.125f * LOG2E;
constexpr float MLA_QSCALE = 0.10206207261596577f * LOG2E;
constexpr int NWAVES = 8, NTHR = 512;

#define LAS __attribute__((address_space(3)))
#define GAS __attribute__((address_space(1)))
typedef unsigned short bf16_t;
typedef short bf16x8 __attribute__((ext_vector_type(8)));
typedef short s16x4 __attribute__((ext_vector_type(4)));
typedef float f32x4 __attribute__((ext_vector_type(4)));
typedef float f32x16 __attribute__((ext_vector_type(16)));
typedef unsigned u32x4 __attribute__((ext_vector_type(4)));
typedef unsigned u32x2 __attribute__((ext_vector_type(2)));
typedef float f32x2_t __attribute__((ext_vector_type(2)));
typedef __bf16 bf16x2_t __attribute__((ext_vector_type(2)));
typedef int v8i_t __attribute__((ext_vector_type(8)));
constexpr float W8_SCALE = 8.f, X8_SCALE = 8.f;
__device__ __forceinline__ unsigned pk_fp8x4(float a, float b, float c, float d) { unsigned w = 0; w = __builtin_amdgcn_cvt_pk_fp8_f32(a, b, w, false); w = __builtin_amdgcn_cvt_pk_fp8_f32(c, d, w, true); return w; }

__device__ __forceinline__ unsigned cvtpk(float lo, float hi) { f32x2_t v = {lo, hi}; bf16x2_t b = __builtin_convertvector(v, bf16x2_t); return __builtin_bit_cast(unsigned, b); }
__device__ __forceinline__ float bf2f(unsigned short h) { return __uint_as_float(((unsigned)h) << 16); }
__device__ __forceinline__ float bflo(unsigned w) { return __uint_as_float(w << 16); }
__device__ __forceinline__ float bfhi(unsigned w) { return __uint_as_float(w & 0xffff0000u); }
__device__ __forceinline__ float dpp_f(float v, int ctrl) { return v; }
#define DPP_F(v, ctrl) __int_as_float(__builtin_amdgcn_update_dpp(0, __float_as_int(v), (ctrl), 0xF, 0xF, true))
#define DPP_I(v, ctrl) __builtin_amdgcn_update_dpp(0, (v), (ctrl), 0xF, 0xF, true)
#define DPP_X1 0xB1
#define DPP_X2 0x4E
#define DPP_HM 0x141
#define DPP_RM 0x140
__device__ __forceinline__ float wave_sum(float v) {
    v += DPP_F(v, DPP_X1); v += DPP_F(v, DPP_X2); v += DPP_F(v, DPP_HM); v += DPP_F(v, DPP_RM);
    return (__int_as_float(__builtin_amdgcn_readlane(__float_as_int(v), 0)) + __int_as_float(__builtin_amdgcn_readlane(__float_as_int(v), 16)))
         + (__int_as_float(__builtin_amdgcn_readlane(__float_as_int(v), 32)) + __int_as_float(__builtin_amdgcn_readlane(__float_as_int(v), 48)));
}
__device__ __forceinline__ float sum8(float v) { v += DPP_F(v, DPP_X1); v += DPP_F(v, DPP_X2); v += DPP_F(v, DPP_HM); return v; }
__device__ __forceinline__ float sigmoidf_(float x) { return __builtin_amdgcn_rcpf(1.f + __builtin_amdgcn_exp2f(-x * LOG2E)); }

namespace pg8 {
constexpr int BM = 256, BK = 64, HALF = 128, HTB = HALF * BK * 2, STAGE_BYTES = 8 * HTB, NXCD = 8, WGM = 8;
__host__ __device__ __forceinline__ int lds_byte(int r, int c) { const int st = (r >> 4) * 2 + (c >> 5), rr = r & 15, cc = c & 31, ob = rr * 64 + cc * 2; return st * 1024 + (ob ^ (((ob >> 9) & 1) << 5)); }
__host__ __device__ __forceinline__ void stage_rc(int b, int& R, int& C) { const int st = b / 1024, sb = b % 1024, swz = sb ^ (((sb >> 9) & 1) << 5); R = (st >> 1) * 16 + swz / 64; C = (st & 1) * 32 + (swz % 64) / 2; }
__host__ __device__ __forceinline__ int perm32(int rho) { const int n = rho >> 4, i = rho & 15; return 8 * (i >> 2) + 4 * n + (i & 3); }

struct Unit { int pm, pn, e, rows, rt; };
struct Gemm { const bf16_t* A; int lda, ldb, K; };

struct StaticOrder {
    const bf16_t* A; const bf16_t* Bt; int lda, ldb;
    int nM, nN, nwg, G, c;
    __device__ void init(const bf16_t* A_, int lda_, const bf16_t* Bt_, int ldb_, int M, int N, int G_, int c_, int cshift = 0) { A = A_; Bt = Bt_; lda = lda_; ldb = ldb_; nM = M / BM; nN = N / BM; nwg = nM * nN; G = G_; c = (c_ + cshift) % G_; }
    __device__ __forceinline__ bool next(int i, Unit& u) const {
        const long L = (long)i * G + c; if (L >= nwg) return false;
        int wgid = (int)L; { const int q = nwg / NXCD, r = nwg % NXCD, xcd = wgid % NXCD, off = wgid / NXCD; wgid = (xcd < r ? xcd * (q + 1) : r * (q + 1) + (xcd - r) * q) + off; }
        const int nig = WGM * nN, gid = wgid / nig, fm = gid * WGM, gsz = (nM - fm) < WGM ? (nM - fm) : WGM;
        u.pm = fm + ((wgid % nig) % gsz); u.pn = (wgid % nig) / gsz; u.e = 0; u.rows = 256; u.rt = 0; return true;
    }
    __device__ __forceinline__ unsigned a_off(const Unit& u, int r, int C) const { return (unsigned)(((u.pm * BM + r) * lda + C) * 2); }
    __device__ __forceinline__ const char* b_base(const Unit& u) const { return (const char*)(Bt + (size_t)u.pn * BM * ldb); }
};

__device__ __forceinline__ v8i_t ld32_lds(const LAS unsigned char* p) { const u32x4 lo_ = *(const LAS u32x4*)p, hi_ = *(const LAS u32x4*)(p + 1024); return (v8i_t){(int)lo_.x, (int)lo_.y, (int)lo_.z, (int)lo_.w, (int)hi_.x, (int)hi_.y, (int)hi_.z, (int)hi_.w}; }
struct PairOrder {
    StaticOrder S; size_t a1, b1;
    __device__ __forceinline__ bool next(int i, Unit& u) const { if (!S.next(i >> 1, u)) return false; u.e = i & 1; return true; }
    __device__ __forceinline__ unsigned a_off(const Unit& u, int r, int C) const { return S.a_off(u, r, C) + (unsigned)(u.e ? a1 * 2 : 0); }
    __device__ __forceinline__ const char* b_base(const Unit& u) const { return S.b_base(u) + (u.e ? b1 * 2 : 0); }
};
__device__ __forceinline__ void mfma_f8(f32x4& c, const v8i_t a, const v8i_t b, int sa, int sb) {
    asm volatile("v_mfma_scale_f32_16x16x128_f8f6f4 %0, %1, %2, %0, %3, %4 op_sel_hi:[0,0,0]" : "+v"(c) : "v"(a), "v"(b), "v"(sa), "v"(sb));
}
#ifdef ABL_NOMFMA16
__device__ __forceinline__ f32x4 ABL_MFMA16(bf16x8 a, bf16x8 b, f32x4 c) { asm volatile("" : "+v"(c) : "v"(a), "v"(b)); return c; }
#else
#define ABL_MFMA16(a, b, c) __builtin_amdgcn_mfma_f32_16x16x32_bf16((a), (b), (c), 0, 0, 0)
#endif
template <bool F8> struct FragT { typedef bf16x8 type; };
template <> struct FragT<true> { typedef v8i_t type; };
template <class Epi, class Sched, bool FP8 = false>
__device__ __forceinline__ void gemm_phase(LAS unsigned char* lds, const Gemm g, const Sched& S, const Epi& E) {
    const int tid = threadIdx.x, wid = __builtin_amdgcn_readfirstlane(tid >> 6), lane = tid & 63, wr = wid >> 2, wc = wid & 3, fr = lane & 15, fq = lane >> 4;
    const int K = g.K, nt = K / BK;
    unsigned voffB[2];
#pragma unroll
    for (int i = 0; i < 2; ++i) { int R, C; stage_rc(tid * 16 + i * 8192, R, C); const int Rb = Epi::PERM ? ((R & ~31) + perm32(R & 31)) : R; voffB[i] = (unsigned)(Rb * g.ldb + C) * 2u; }
#define PG8_AOFF(dst, unit) do { int t_ = tid; asm volatile("" : "+v"(t_)); _Pragma("unroll") for (int i = 0; i < 2; ++i) { int R, C; stage_rc(t_ * 16 + i * 8192, R, C); \
        _Pragma("unroll") for (int h = 0; h < 2; ++h) dst[h][i] = S.a_off(unit, h * HALF + R, C); } } while (0)
    const size_t kstep = (size_t)(BK * 2);
    const size_t hstepB = (size_t)HALF * g.ldb * 2;
    const unsigned ldsw = (unsigned)wid * 1024u;
    const int aoff = lds_byte(wr * 64 + fr, fq * 8), boff = lds_byte(wc * 32 + fr, fq * 8);
#define PG8_SA(b, h) (((b) * 2 + (h)) * HTB)
#define PG8_SB(b, h) ((4 + (b) * 2 + (h)) * HTB)
#define PG8_STAGE(bufoff, gbase, voff) do { _Pragma("unroll") for (int _i = 0; _i < 2; ++_i) \
        __builtin_amdgcn_global_load_lds((const unsigned*)((const char*)(gbase) + (voff)[_i]), (LAS unsigned*)(lds + (bufoff) + ldsw + _i * 8192), 16, 0, 0); } while (0)
#define PG8_LD32(p) ld32_lds((const LAS unsigned char*)(p))
#define PG8_LDA(dst, b, h) do { if constexpr (FP8) { _Pragma("unroll") for (int m = 0; m < 4; ++m) dst[m][0] = __builtin_bit_cast(FT, PG8_LD32(lds + PG8_SA(b, h) + aoff + m * 2048)); } \
        else { _Pragma("unroll") for (int m = 0; m < 4; ++m) _Pragma("unroll") for (int k = 0; k < 2; ++k) dst[m][k] = __builtin_bit_cast(FT, *(const LAS FT*)(lds + PG8_SA(b, h) + aoff + m * 2048 + k * 1024)); } } while (0)
#define PG8_LDB(dst, b, h) do { if constexpr (FP8) { _Pragma("unroll") for (int n = 0; n < 2; ++n) dst[n][0] = __builtin_bit_cast(FT, PG8_LD32(lds + PG8_SB(b, h) + boff + n * 2048)); } \
        else { _Pragma("unroll") for (int n = 0; n < 2; ++n) _Pragma("unroll") for (int k = 0; k < 2; ++k) dst[n][k] = __builtin_bit_cast(FT, *(const LAS FT*)(lds + PG8_SB(b, h) + boff + n * 2048 + k * 1024)); } } while (0)
#define PG8_MMA(ai, bj, At, Bt) do { __builtin_amdgcn_s_setprio(1); \
        if constexpr (FP8) { _Pragma("unroll") for (int m = 0; m < 4; ++m) _Pragma("unroll") for (int n = 0; n < 2; ++n) \
            mfma_f8(acc[ai][bj][m][n], __builtin_bit_cast(v8i_t, Bt[n][0]), __builtin_bit_cast(v8i_t, At[m][0]), 0x7c7c7c7c, 0x7c7c7c7c); } \
        else { _Pragma("unroll") for (int m = 0; m < 4; ++m) _Pragma("unroll") for (int n = 0; n < 2; ++n) _Pragma("unroll") for (int k = 0; k < 2; ++k) \
            acc[ai][bj][m][n] = ABL_MFMA16(__builtin_bit_cast(bf16x8, Bt[n][k]), __builtin_bit_cast(bf16x8, At[m][k]), acc[ai][bj][m][n]); } \
        __builtin_amdgcn_s_setprio(0); } while (0)
#define PG8_WAIT_V(n) asm volatile("s_waitcnt vmcnt(" #n ")" ::: "memory")
#define PG8_WAIT_L(n) asm volatile("s_waitcnt lgkmcnt(" #n ")" ::: "memory")
#define PG8_BAR __builtin_amdgcn_s_barrier()
#define PG8_SCHED __builtin_amdgcn_sched_barrier(0)
    Unit cur, nxt; int ui = 0;
    if (!S.next(0, cur)) return;
    f32x4 acc[2][2][4][2];
#pragma unroll
    for (int a = 0; a < 2; ++a)
#pragma unroll
        for (int b = 0; b < 2; ++b)
#pragma unroll
            for (int m = 0; m < 4; ++m)
#pragma unroll
                for (int n = 0; n < 2; ++n) acc[a][b][m][n] = (f32x4){0.f, 0.f, 0.f, 0.f};
    typedef typename FragT<FP8>::type FT; constexpr int NK = FP8 ? 1 : 2;
    FT At[4][NK], B0[2][NK], B1[2][NK];
    const char* Ab = (const char*)g.A;
    const char* cB = S.b_base(cur);
    unsigned vaC[2][2], vaN[2][2];
    PG8_AOFF(vaC, cur);
    PG8_STAGE(PG8_SB(0, 0), cB, voffB); PG8_STAGE(PG8_SB(0, 1), cB + hstepB, voffB); PG8_STAGE(PG8_SA(0, 0), Ab, vaC[0]); PG8_STAGE(PG8_SA(0, 1), Ab, vaC[1]);
    if (wr == 1) PG8_BAR;
    PG8_WAIT_V(2); PG8_BAR;
    PG8_STAGE(PG8_SB(1, 0), cB + kstep, voffB); PG8_STAGE(PG8_SA(1, 0), Ab + kstep, vaC[0]); PG8_STAGE(PG8_SB(1, 1), cB + hstepB + kstep, voffB);
    PG8_WAIT_V(6); PG8_BAR;
    for (;;) {
        const bool has_next = S.next(ui + 1, nxt);
        const char* nB = has_next ? S.b_base(nxt) : cB;
        if (has_next) PG8_AOFF(vaN, nxt);
        else {
#pragma unroll
            for (int h = 0; h < 2; ++h)
#pragma unroll
                for (int i = 0; i < 2; ++i) vaN[h][i] = vaC[h][i]; }
        for (int t = 0; t < nt; t += 2) {
            const bool last = (t == nt - 2);
            const char* kA1 = Ab + (size_t)(t + 1) * kstep;
            const char* kA2 = last ? Ab : Ab + (size_t)(t + 2) * kstep; const char* b2 = last ? nB : cB + (size_t)(t + 2) * kstep;
            const char* kA3 = kA2 + kstep; const char* b3 = b2 + kstep;
            unsigned o2[2][2];
#pragma unroll
            for (int h = 0; h < 2; ++h)
#pragma unroll
                for (int i = 0; i < 2; ++i) o2[h][i] = last ? vaN[h][i] : vaC[h][i];
            PG8_LDB(B0, 0, 0); PG8_LDB(B1, 0, 1); PG8_SCHED; PG8_LDA(At, 0, 0); PG8_STAGE(PG8_SA(1, 1), kA1, vaC[1]);
            PG8_WAIT_V(8); PG8_WAIT_L(0); PG8_BAR; PG8_MMA(0, 0, At, B0); PG8_MMA(0, 1, At, B1); PG8_BAR; PG8_SCHED;
            PG8_LDA(At, 0, 1); PG8_STAGE(PG8_SB(0, 0), b2, voffB); PG8_STAGE(PG8_SB(0, 1), b2 + hstepB, voffB); PG8_STAGE(PG8_SA(0, 0), kA2, o2[0]);
            PG8_WAIT_V(8); PG8_WAIT_L(0); PG8_BAR; PG8_MMA(1, 0, At, B0); PG8_MMA(1, 1, At, B1); PG8_BAR; PG8_SCHED;
            PG8_LDB(B0, 1, 0); PG8_LDB(B1, 1, 1); PG8_SCHED; PG8_LDA(At, 1, 0); PG8_STAGE(PG8_SA(0, 1), kA2, o2[1]);
            PG8_WAIT_V(8); PG8_WAIT_L(0); PG8_BAR; PG8_MMA(0, 0, At, B0); PG8_MMA(0, 1, At, B1); PG8_BAR; PG8_SCHED;
            PG8_LDA(At, 1, 1); PG8_STAGE(PG8_SB(1, 0), b3, voffB); PG8_STAGE(PG8_SB(1, 1), b3 + hstepB, voffB); PG8_STAGE(PG8_SA(1, 0), kA3, o2[0]);
            PG8_WAIT_V(8); PG8_WAIT_L(0); PG8_BAR; PG8_MMA(1, 0, At, B0); PG8_MMA(1, 1, At, B1); PG8_BAR; PG8_SCHED;
        }
        if (wr == 0) PG8_BAR;
        if constexpr (FP8) asm volatile("s_nop 15\n\ts_nop 15" ::: "memory");
        E(acc, cur, wr, wc, fr, fq);
        if (!has_next) break;
#pragma unroll
        for (int a = 0; a < 2; ++a)
#pragma unroll
            for (int b = 0; b < 2; ++b)
#pragma unroll
                for (int m = 0; m < 4; ++m)
#pragma unroll
                    for (int n = 0; n < 2; ++n) acc[a][b][m][n] = (f32x4){0.f, 0.f, 0.f, 0.f};
        cur = nxt; cB = nB; ++ui;
#pragma unroll
        for (int h = 0; h < 2; ++h)
#pragma unroll
            for (int i = 0; i < 2; ++i) vaC[h][i] = vaN[h][i];
        if (wr == 1) PG8_BAR;
    }
    PG8_WAIT_V(0);
    PG8_BAR;
#undef PG8_SA
#undef PG8_AOFF
#undef PG8_SB
#undef PG8_STAGE
#undef PG8_LDA
#undef PG8_LDB
#undef PG8_MMA
#undef PG8_LD32
#undef PG8_WAIT_V
#undef PG8_WAIT_L
#undef PG8_BAR
#undef PG8_SCHED
}

struct EpiBf16 {
    static constexpr bool PERM = true;
    bf16_t* O; int ldc;
    __device__ __forceinline__ void operator()(const f32x4 (&acc)[2][2][4][2], const Unit& u, int wr, int wc, int fr, int fq) const {
        const int row0 = u.pm * BM + wr * 64 + fr, col0 = u.pn * BM + wc * 32 + 8 * fq;
#pragma unroll
        for (int ai = 0; ai < 2; ++ai)
#pragma unroll
            for (int m = 0; m < 4; ++m) { bf16_t* rowp = O + (size_t)(row0 + ai * HALF + m * 16) * ldc + col0;
#pragma unroll
                for (int bj = 0; bj < 2; ++bj) { const f32x4 v0 = acc[ai][bj][m][0], v1 = acc[ai][bj][m][1];
                    u32x4 w; w.x = cvtpk(v0[0], v0[1]); w.y = cvtpk(v0[2], v0[3]); w.z = cvtpk(v1[0], v1[1]); w.w = cvtpk(v1[2], v1[3]);
                    *(u32x4*)(rowp + bj * HALF) = w; } }
    }
};
struct EpiGate2 {
    static constexpr bool PERM = true;
    bf16_t* O; const bf16_t* G; int ldg, gcol0, gcol1;
    __device__ __forceinline__ void operator()(const f32x4 (&acc)[2][2][4][2], const Unit& u, int wr, int wc, int fr, int fq) const {
        const int row0 = u.pm * BM + wr * 64 + fr, col0 = u.pn * BM + wc * 32 + 8 * fq;
        const bool second = u.e != 0; const int gcol = second ? gcol1 : gcol0;
#pragma unroll
        for (int ai = 0; ai < 2; ++ai)
#pragma unroll
            for (int m = 0; m < 4; ++m) { const size_t r = (size_t)(row0 + ai * HALF + m * 16);
#pragma unroll
                for (int bj = 0; bj < 2; ++bj) { const f32x4 v0 = acc[ai][bj][m][0], v1 = acc[ai][bj][m][1];
                    const int c = col0 + bj * HALF;
#ifdef ABL_G_NOLOAD
                    const u32x4 gw = {0u, 0u, 0u, 0u}; bf16_t* op = O + r * D_ + c; u32x4 pw = {0u, 0u, 0u, 0u};
#else
                    const u32x4 gw = *(const u32x4*)(G + r * ldg + gcol + c);
                    bf16_t* op = O + r * D_ + c;
                    u32x4 pw = {0u, 0u, 0u, 0u}; if (second) pw = *(const u32x4*)op;
#endif
                    float o[8];
                    o[0] = sigmoidf_(bflo(gw.x)) * v0[0]; o[1] = sigmoidf_(bfhi(gw.x)) * v0[1]; o[2] = sigmoidf_(bflo(gw.y)) * v0[2]; o[3] = sigmoidf_(bfhi(gw.y)) * v0[3];
                    o[4] = sigmoidf_(bflo(gw.z)) * v1[0]; o[5] = sigmoidf_(bfhi(gw.z)) * v1[1]; o[6] = sigmoidf_(bflo(gw.w)) * v1[2]; o[7] = sigmoidf_(bfhi(gw.w)) * v1[3];
                    o[0] += bflo(pw.x); o[1] += bfhi(pw.x); o[2] += bflo(pw.y); o[3] += bfhi(pw.y); o[4] += bflo(pw.z); o[5] += bfhi(pw.z); o[6] += bflo(pw.w); o[7] += bfhi(pw.w);
                    u32x4 w; w.x = cvtpk(o[0], o[1]); w.y = cvtpk(o[2], o[3]); w.z = cvtpk(o[4], o[5]); w.w = cvtpk(o[6], o[7]);
                    *(u32x4*)op = w; } }
    }
};
struct EpiRes {
    static constexpr bool PERM = true;
    const float* base; bf16_t* out;
    __device__ __forceinline__ void operator()(const f32x4 (&acc)[2][2][4][2], const Unit& u, int wr, int wc, int fr, int fq) const {
        const int row0 = u.pm * BM + wr * 64 + fr, col0 = u.pn * BM + wc * 32 + 8 * fq;
#pragma unroll
        for (int ai = 0; ai < 2; ++ai)
#pragma unroll
            for (int m = 0; m < 4; ++m) { const size_t off = (size_t)(row0 + ai * HALF + m * 16) * D_ + col0;
#pragma unroll
                for (int bj = 0; bj < 2; ++bj) { const f32x4 v0 = *(const f32x4*)(base + off + bj * HALF) + acc[ai][bj][m][0], v1 = *(const f32x4*)(base + off + bj * HALF + 4) + acc[ai][bj][m][1];
                    u32x4 w; w.x = cvtpk(v0[0], v0[1]); w.y = cvtpk(v0[2], v0[3]); w.z = cvtpk(v1[0], v1[1]); w.w = cvtpk(v1[2], v1[3]);
                    *(u32x4*)(out + off + bj * HALF) = w; } }
    }
};
struct EpiSwiglu {
    static constexpr bool PERM = true;
    bf16_t* act; const float* b_up;
    __device__ __forceinline__ void operator()(const f32x4 (&acc)[2][2][4][2], const Unit& u, int wr, int wc, int fr, int fq) const {
        const int row0 = u.pm * BM + wr * 64 + fr, col0 = u.pn * BM + wc * 32 + 8 * fq;
        const float* bb = b_up + (size_t)u.e * (2 * DFF);
        f32x4 bv[2][2];
#pragma unroll
        for (int bj = 0; bj < 2; ++bj)
#pragma unroll
            for (int n = 0; n < 2; ++n) bv[bj][n] = *(const f32x4*)(bb + col0 + bj * HALF + 4 * n);
#pragma unroll
        for (int ai = 0; ai < 2; ++ai)
#pragma unroll
            for (int m = 0; m < 4; ++m) { bf16_t* rowp = act + (size_t)(row0 + ai * HALF + m * 16) * DFF + (col0 >> 1);
#pragma unroll
                for (int bj = 0; bj < 2; ++bj) { const f32x4 v0 = acc[ai][bj][m][0] + bv[bj][0], v1 = acc[ai][bj][m][1] + bv[bj][1];
                    float a[4];
#pragma unroll
                    for (int p = 0; p < 4; ++p) { float gl = (p < 2) ? v0[2 * p] : v1[2 * p - 4], li = (p < 2) ? v0[2 * p + 1] : v1[2 * p - 3];
                        gl = fminf(gl, 7.f); li = fminf(fmaxf(li, -7.f), 7.f);
                        a[p] = gl * sigmoidf_(1.702f * gl) * (li + 1.f); }
                    u32x2 w; w.x = cvtpk(a[0], a[1]); w.y = cvtpk(a[2], a[3]);
                    *(u32x2*)(rowp + bj * (HALF / 2)) = w; } }
    }
};
struct EpiSwiglu8 {
    static constexpr bool PERM = true;
    unsigned char* act; const float* b_up;
    __device__ __forceinline__ void operator()(const f32x4 (&acc)[2][2][4][2], const Unit& u, int wr, int wc, int fr, int fq) const {
        const int row0 = u.pm * BM + wr * 64 + fr, col0 = u.pn * BM + wc * 32 + 8 * fq;
        const float* bb = b_up + (size_t)u.e * (2 * DFF);
        f32x4 bv[2][2];
#pragma unroll
        for (int bj = 0; bj < 2; ++bj)
#pragma unroll
            for (int n = 0; n < 2; ++n) bv[bj][n] = *(const f32x4*)(bb + col0 + bj * HALF + 4 * n);
#pragma unroll
        for (int ai = 0; ai < 2; ++ai)
#pragma unroll
            for (int m = 0; m < 4; ++m) { unsigned char* rowp = act + (size_t)(row0 + ai * HALF + m * 16) * DFF + (col0 >> 1);
#pragma unroll
                for (int bj = 0; bj < 2; ++bj) { const f32x4 v0 = acc[ai][bj][m][0] + bv[bj][0], v1 = acc[ai][bj][m][1] + bv[bj][1];
                    float a[4];
#pragma unroll
                    for (int p = 0; p < 4; ++p) { float gl = (p < 2) ? v0[2 * p] : v1[2 * p - 4], li = (p < 2) ? v0[2 * p + 1] : v1[2 * p - 3];
                        gl = fminf(gl, 7.f); li = fminf(fmaxf(li, -7.f), 7.f);
                        a[p] = gl * sigmoidf_(1.702f * gl) * fmaf(li, X8_SCALE, X8_SCALE); }
                    *(unsigned*)(rowp + bj * (HALF / 2)) = pk_fp8x4(a[0], a[1], a[2], a[3]); } }
    }
};
struct EpiDown {
    static constexpr bool PERM = true;
    bf16_t* y; const float* b_down; const int* list; const float* listw;
    __device__ __forceinline__ void operator()(const f32x4 (&acc)[2][2][4][2], const Unit& u, int wr, int wc, int fr, int fq) const {
        const int col0 = u.pn * BM + wc * 32 + 8 * fq;
        const float* bb = b_down + (size_t)u.e * D_;
        f32x4 bv[2][2];
#pragma unroll
        for (int bj = 0; bj < 2; ++bj)
#pragma unroll
            for (int n = 0; n < 2; ++n) bv[bj][n] = *(const f32x4*)(bb + col0 + bj * HALF + 4 * n);
        const int* lp = list + (size_t)u.e * M_ + u.rt * BM; const float* lw = listw + (size_t)u.e * M_ + u.rt * BM;
#pragma unroll
        for (int ai = 0; ai < 2; ++ai)
#pragma unroll
            for (int m = 0; m < 4; ++m) { const int r = ai * HALF + wr * 64 + m * 16 + fr;
                if (r < u.rows) { const int slot = lp[r]; const float w = lw[r]; bf16_t* rowp = y + (size_t)slot * D_ + col0;
#pragma unroll
                    for (int bj = 0; bj < 2; ++bj) { const f32x4 v0 = (acc[ai][bj][m][0] + bv[bj][0]) * w, v1 = (acc[ai][bj][m][1] + bv[bj][1]) * w;
                        u32x4 o; o.x = cvtpk(v0[0], v0[1]); o.y = cvtpk(v0[2], v0[3]); o.z = cvtpk(v1[0], v1[1]); o.w = cvtpk(v1[2], v1[3]);
                        *(u32x4*)(rowp + bj * HALF) = o; } } }
    }
};
}
constexpr size_t MiB = 1ull << 20;
constexpr size_t WS_CTL = 0, CTL_ZERO_BYTES = 64 * 1024;
constexpr size_t WS_ROPE = 256 * 1024;
constexpr size_t WS_WR = 3 * MiB;
constexpr size_t WS_LIST = 4 * MiB;
constexpr size_t WS_TOPW = 6 * MiB;
constexpr size_t WS_SEL = 6 * MiB + 512 * 1024;
constexpr size_t WS_LISTW = 594 * MiB;
constexpr size_t WS_WIN = 8 * MiB;
constexpr size_t WS_WUQ = 17 * MiB;
constexpr size_t WS_WUKV = 18 * MiB;
constexpr size_t WS_WOSB = 19 * MiB;
constexpr size_t WS_WOMLA = 20 * MiB;
constexpr size_t WS_WOUT = 21 * MiB;
constexpr size_t WS_WUP = 24 * MiB;
constexpr size_t WS_WDN = 152 * MiB;
constexpr size_t WS_HB = 216 * MiB;
constexpr size_t WS_PROJ = 249 * MiB;
constexpr size_t WS_ACT = WS_PROJ;
constexpr size_t WS_QRAW = 393 * MiB;
constexpr size_t WS_KVRAW = WS_QRAW + 24 * MiB;
constexpr size_t WS_QB = WS_KVRAW + 32 * MiB;
constexpr size_t WS_KB = WS_QB + 24 * MiB;
constexpr size_t WS_VB = WS_KB + 24 * MiB;
constexpr size_t WS_OSB = WS_VB + 16 * MiB;
constexpr size_t WS_OMLA = WS_OSB + 16 * MiB;
constexpr size_t WS_YB = WS_QRAW;
constexpr size_t WS_MIX = 545 * MiB;
constexpr size_t WS_H2F8 = 577 * MiB;
constexpr size_t WS_X1B = 596 * MiB;
constexpr size_t WS_VARCQ = 628 * MiB;
constexpr size_t WS_OPT_END = 629 * MiB;
constexpr int CW_CNT = 0;
constexpr int CW_BAR = 1024;
constexpr int LDS_STAGE = 143360;
constexpr int LDS_MISC = LDS_STAGE;
constexpr int LDS_BYTES = 147456;
constexpr int MI_BAR = 0, MI_TPFX = 16, MI_CNT = 64, MI_FLAG = 128, MI_LCNT = 160, MI_BASE = 192, MI_RSTD = 256, MI_CITEM = 320;

typedef GAS unsigned gu32;
#define RLX_AGENT __ATOMIC_RELAXED, __HIP_MEMORY_SCOPE_AGENT

#define XB_TMO      128
#define XB_XCNT(j)  (256  + 64 * (j))
#define XB_XSUB(j)  (1280 + 64 * (j))
#define XB_XGEN(j)  (2304 + 64 * (j))
#define XB_TOP      3328
#define XB_TOPGEN   3392
#define XCD_BAR_WORDS 3456
#define XB_SPIN_CAP (1u << 18)
__device__ __forceinline__ unsigned xb_ld(unsigned* p)              { return __hip_atomic_load(p, __ATOMIC_RELAXED, __HIP_MEMORY_SCOPE_AGENT); }
__device__ __forceinline__ unsigned xb_add(unsigned* p, unsigned v) { return __hip_atomic_fetch_add(p, v, __ATOMIC_RELAXED, __HIP_MEMORY_SCOPE_AGENT); }
__device__ __forceinline__ unsigned xb_xcc_id() { return (unsigned)__builtin_amdgcn_s_getreg((3 << 11) | 20) & 0xFu; }
#define XB_SPIN(cond, bar) do { unsigned _sp = 0; while (cond) { __builtin_amdgcn_s_sleep(1); \
    if ((++_sp & 255u) == 0u) { if (xb_ld(&(bar)[XB_TMO])) break; if (_sp > XB_SPIN_CAP) { atomicAdd(&(bar)[XB_TMO], 1u); break; } } } } while (0)
struct XcdBarrier { unsigned* bar; unsigned x; volatile LAS unsigned* st; };
__device__ __forceinline__ XcdBarrier xcd_barrier_post(unsigned* bar, volatile LAS unsigned* st) {
    XcdBarrier b; b.bar = bar; b.x = xb_xcc_id(); b.st = st;
    if (threadIdx.x == 0) (void)xb_add(&bar[XB_XCNT(b.x)], 1u);
    return b;
}
__device__ __forceinline__ void xcd_barrier_complete(unsigned* bar, unsigned x, unsigned& nloc, unsigned& nx) {
    const unsigned G = gridDim.x * gridDim.y * gridDim.z;
    unsigned sum, cnt, mine, sp = 0u;
    for (;;) {
        sum = 0u; cnt = 0u; mine = 0u;
#pragma unroll
        for (unsigned j = 0; j < 16; ++j) { const unsigned c = xb_ld(&bar[XB_XCNT(j)]); sum += c; cnt += (c > 0u) ? 1u : 0u; mine = (j == x) ? c : mine; }
        if (sum == G) break;
        __builtin_amdgcn_s_sleep(1);
        if ((++sp & 255u) == 0u) { if (xb_ld(&bar[XB_TMO])) break; if (sp > XB_SPIN_CAP) { atomicAdd(&bar[XB_TMO], 1u); break; } }
    }
    nloc = mine > 0u ? mine : 1u; nx = cnt > 0u ? cnt : 1u;
}
__device__ __forceinline__ void xcd_barrier(const XcdBarrier& b) {
    asm volatile("s_waitcnt vmcnt(0)" ::: "memory");
    __syncthreads();
    if (threadIdx.x == 0) {
        unsigned* bar = b.bar;
        __builtin_amdgcn_s_waitcnt(0);
        unsigned nloc = b.st[0], nx = b.st[1];
        if (nloc == 0u) { xcd_barrier_complete(bar, b.x, nloc, nx); b.st[0] = nloc; b.st[1] = nx; }
        const unsigned old = xb_add(&bar[XB_XSUB(b.x)], 1u);
        const unsigned gen = old / nloc;
        if (old + 1u == (gen + 1u) * nloc) {
            __builtin_amdgcn_fence(__ATOMIC_RELEASE, "agent");
            asm volatile("s_waitcnt vmcnt(0)" ::: "memory");
            const unsigned og = xb_add(&bar[XB_TOP], 1u);
            const unsigned tg = og / nx;
            if (og + 1u == (tg + 1u) * nx) xb_add(&bar[XB_TOPGEN], 1u);
            else XB_SPIN(xb_ld(&bar[XB_TOPGEN]) == tg, bar);
            __builtin_amdgcn_fence(__ATOMIC_ACQUIRE, "agent");
            xb_add(&bar[XB_XGEN(b.x)], 1u);
            asm volatile("s_waitcnt vmcnt(0)" ::: "memory");
        } else {
            XB_SPIN(xb_ld(&bar[XB_XGEN(b.x)]) == gen, bar);
            __builtin_amdgcn_fence(__ATOMIC_ACQUIRE, "agent");
            asm volatile("s_waitcnt vmcnt(0)" ::: "memory");
        }
    }
    __syncthreads();
}

struct Args {
    const float* in[20]; float* out; unsigned char* ws;
    int ph_lo, ph_hi;
};

struct Frame {
    LAS unsigned char* lds; volatile LAS unsigned* MISC;
    int tid, lane, wave, vcu, G;
    unsigned char* ws;
};

__device__ __forceinline__ void p0_transpose_item(const float* W, int K, int N, bf16_t* WT, LAS float* scr, int item, int lane, const float* gk, float cs, int csn) {
    const int nblk = N / 32, kb = item / nblk, nb = item % nblk, k0 = 64 * kb, n0 = 32 * nb;
    const float colsc = (n0 < csn) ? cs : 1.f;
    float tv[32];
#pragma unroll
    for (int i = 0; i < 32; ++i) { const int kk = 2 * i + (lane >> 5); tv[i] = W[(size_t)(k0 + kk) * N + n0 + (lane & 31)]; }
#pragma unroll
    for (int i = 0; i < 32; ++i) { const int kk = 2 * i + (lane >> 5); float v = tv[i] * colsc; if (gk) v *= gk[k0 + kk]; scr[kk * 33 + (lane & 31)] = v; }
    asm volatile("s_waitcnt lgkmcnt(0)" ::: "memory");
    const int c = lane & 7;
#pragma unroll
    for (int j = 0; j < 4; ++j) { const int n = (lane >> 3) + 8 * j; const LAS float* s = scr + (8 * c) * 33 + n;
        u32x4 o; o.x = cvtpk(s[0 * 33], s[1 * 33]); o.y = cvtpk(s[2 * 33], s[3 * 33]); o.z = cvtpk(s[4 * 33], s[5 * 33]); o.w = cvtpk(s[6 * 33], s[7 * 33]);
        *(u32x4*)(WT + (size_t)(n0 + n) * K + k0 + 8 * c) = o; }
    asm volatile("s_waitcnt lgkmcnt(0)" ::: "memory");
}
__device__ __forceinline__ void p0_transpose_item_fp8(const float* W, int K, int N, unsigned char* WT, LAS float* scr, int item, int lane, float cs) {
    const int nblk = N / 32, kb = item / nblk, nb = item % nblk, k0 = 64 * kb, n0 = 32 * nb;
    float tv[32];
#pragma unroll
    for (int i = 0; i < 32; ++i) { const int kk = 2 * i + (lane >> 5); tv[i] = W[(size_t)(k0 + kk) * N + n0 + (lane & 31)]; }
#pragma unroll
    for (int i = 0; i < 32; ++i) { const int kk = 2 * i + (lane >> 5); scr[kk * 33 + (lane & 31)] = tv[i] * cs; }
    asm volatile("s_waitcnt lgkmcnt(0)" ::: "memory");
    const int c = lane & 7;
#pragma unroll
    for (int j = 0; j < 4; ++j) { const int n = (lane >> 3) + 8 * j; const LAS float* s = scr + (8 * c) * 33 + n;
        u32x2 o; o.x = pk_fp8x4(s[0 * 33], s[1 * 33], s[2 * 33], s[3 * 33]); o.y = pk_fp8x4(s[4 * 33], s[5 * 33], s[6 * 33], s[7 * 33]);
        *(u32x2*)(WT + (size_t)(n0 + n) * K + k0 + 8 * c) = o; }
    asm volatile("s_waitcnt lgkmcnt(0)" ::: "memory");
}
__device__ __forceinline__ void rms_row_to_bf16(const float* xrow, const float* g, bf16_t* orow, int lane) {
    const f32x4* xr = (const f32x4*)xrow + lane; const f32x4* gr = (const f32x4*)g + lane;
    f32x4 v[4]; float s = 0.f;
#pragma unroll
    for (int j = 0; j < 4; ++j) { v[j] = xr[64 * j]; s += (v[j].x * v[j].x + v[j].y * v[j].y) + (v[j].z * v[j].z + v[j].w * v[j].w); }
    const float rstd = rsqrtf(wave_sum(s) * (1.f / D_) + EPS);
    u32x2* o8 = (u32x2*)orow + lane;
#pragma unroll
    for (int j = 0; j < 4; ++j) { const f32x4 gg = gr[64 * j]; u32x2 w; w.x = cvtpk(v[j].x * rstd * gg.x, v[j].y * rstd * gg.y); w.y = cvtpk(v[j].z * rstd * gg.z, v[j].w * rstd * gg.w); o8[64 * j] = w; }
}
__device__ __forceinline__ void p0_prologue(Frame& F, const Args& a, int do_moe_w, int do_rest) {
    LAS float* scr = (LAS float*)(F.lds + F.wave * 16384);
    const int gw = F.vcu * NWAVES + F.wave, NGW = F.G * NWAVES;
    unsigned char* ws = F.ws;
    const float* w_in = a.in[3]; const float* g_cq = a.in[4]; const float* w_uq = a.in[5]; const float* g_ckv = a.in[6]; const float* w_ukv = a.in[7];
    const float* w_o_sb = a.in[10]; const float* w_o_mla = a.in[11]; const float* w_out = a.in[12]; const float* g_ffn = a.in[13]; const float* w_router = a.in[14];
    const float* w_up = a.in[16]; const float* w_down = a.in[18];
    constexpr int I_IN = (D_ / 64) * (INW / 32), I_UQ = (384 / 64) * (768 / 32), I_UKV = (256 / 64) * (1024 / 32), I_O = (512 / 64) * (1024 / 32), I_OUT = (1024 / 64) * (1024 / 32);
    constexpr int I_UP1 = (1024 / 64) * (2048 / 32), I_DN1 = (1024 / 64) * (1024 / 32);
    if (do_rest) {
        constexpr int NI = I_IN + I_UQ + I_UKV + 2 * I_O + I_OUT;
#ifdef ABL_P0_NOW
        for (int it = gw; it < 0; it += NGW) {
#else
        for (int it = gw; it < NI; it += NGW) {
#endif
            int r = it;
            if (r < I_IN) { p0_transpose_item(w_in, D_, INW, (bf16_t*)(ws + WS_WIN), scr, r, F.lane, nullptr, SB_QSCALE, 512); continue; } r -= I_IN;
            if (r < I_UQ) { p0_transpose_item(w_uq, 384, 768, (bf16_t*)(ws + WS_WUQ), scr, r, F.lane, g_cq, 1.f, 0); continue; } r -= I_UQ;
            if (r < I_UKV) { p0_transpose_item(w_ukv, 256, 1024, (bf16_t*)(ws + WS_WUKV), scr, r, F.lane, g_ckv, 1.f, 0); continue; } r -= I_UKV;
            if (r < I_O) { p0_transpose_item(w_o_sb, 512, 1024, (bf16_t*)(ws + WS_WOSB), scr, r, F.lane, nullptr, 1.f, 0); continue; } r -= I_O;
            if (r < I_O) { p0_transpose_item(w_o_mla, 512, 1024, (bf16_t*)(ws + WS_WOMLA), scr, r, F.lane, nullptr, 1.f, 0); continue; } r -= I_O;
            p0_transpose_item(w_out, 1024, 1024, (bf16_t*)(ws + WS_WOUT), scr, r, F.lane, nullptr, 1.f, 0);
        }
        { const int gt = gw * 64 + F.lane, NGT = NGW * 64;
          u32x4 z = {0u, 0u, 0u, 0u};
          u32x4* pz = (u32x4*)((bf16_t*)(ws + WS_WIN) + (size_t)INW * D_);
          for (int i = gt; i < (INWP - INW) * D_ * 2 / 16; i += NGT) pz[i] = z;
          u32x4* hz = (u32x4*)((unsigned char*)(ws + WS_H2F8) + (size_t)M_ * D_);
          for (int i = gt; i < D_ / 16; i += NGT) hz[i] = z;
          const int* pos = (const int*)a.in[1]; float* rt = (float*)(ws + WS_ROPE);
#ifdef ABL_P0_NOROPE
          for (int i = gt; i < 0; i += NGT) { const int row = i >> 4, k = i & 15;
#else
          for (int i = gt; i < M_ * 16; i += NGT) { const int row = i >> 4, k = i & 15;
#endif
            const float inv = powf(10000.f, -(float)k / 16.f); const float ang = (float)pos[row] * inv; rt[row * 32 + k] = cosf(ang); rt[row * 32 + 16 + k] = sinf(ang); }
          float* wr = (float*)(ws + WS_WR);
          for (int i = gt; i < D_ * NE; i += NGT) wr[(i & 31) * 1028 + (i >> 5)] = w_router[i] * g_ffn[i >> 5];
        }
        {
            const f32x4* gr = (const f32x4*)a.in[2] + F.lane; f32x4 gg[4];
#pragma unroll
            for (int j = 0; j < 4; ++j) gg[j] = gr[64 * j];
#ifdef ABL_P0_NOROWS
            for (int m = gw; m < 0; m += 4 * NGW) {
#else
            for (int m = gw; m < M_; m += 4 * NGW) {
#endif
                f32x4 v[4][4]; float s[4];
#pragma unroll
                for (int q = 0; q < 4; ++q) { const int row = m + q * NGW; const f32x4* xr = (const f32x4*)(a.in[0] + (size_t)(row < M_ ? row : m) * D_) + F.lane;
#pragma unroll
                    for (int j = 0; j < 4; ++j) v[q][j] = xr[64 * j]; }
#pragma unroll
                for (int q = 0; q < 4; ++q) { s[q] = 0.f;
#pragma unroll
                    for (int j = 0; j < 4; ++j) s[q] += (v[q][j].x * v[q][j].x + v[q][j].y * v[q][j].y) + (v[q][j].z * v[q][j].z + v[q][j].w * v[q][j].w); }
#pragma unroll
                for (int q = 0; q < 4; ++q) { const int row = m + q * NGW; const float r = rsqrtf(wave_sum(s[q]) * (1.f / D_) + EPS);
                    if (row < M_) { u32x2* o8 = (u32x2*)((bf16_t*)(ws + WS_HB) + (size_t)row * D_) + F.lane;
#pragma unroll
                        for (int j = 0; j < 4; ++j) { u32x2 w; w.x = cvtpk(v[q][j].x * r * gg[j].x, v[q][j].y * r * gg[j].y); w.y = cvtpk(v[q][j].z * r * gg[j].z, v[q][j].w * r * gg[j].w); o8[64 * j] = w; } } }
            }
        }
    }
    if (do_moe_w) {
        constexpr int NI = NE * (I_UP1 + I_DN1);
        for (int it = gw; it < NI; it += NGW) {
            int r = it;
            if (r < NE * I_UP1) { const int e = r / I_UP1; p0_transpose_item_fp8(w_up + (size_t)e * D_ * 2 * DFF, D_, 2 * DFF, (unsigned char*)(ws + WS_WUP) + (size_t)e * 2 * DFF * D_, scr, r % I_UP1, F.lane, W8_SCALE); continue; }
            r -= NE * I_UP1;
            { const int e = r / I_DN1; p0_transpose_item_fp8(w_down + (size_t)e * DFF * D_, DFF, D_, (unsigned char*)(ws + WS_WDN) + (size_t)e * D_ * DFF, scr, r % I_DN1, F.lane, W8_SCALE); }
        }
    }
}

__device__ __forceinline__ void ld16bf(const bf16_t* p, float (&v)[16]) {
    const u32x4 a = *(const u32x4*)p, b = *(const u32x4*)(p + 8);
    v[0] = bflo(a.x); v[1] = bfhi(a.x); v[2] = bflo(a.y); v[3] = bfhi(a.y); v[4] = bflo(a.z); v[5] = bfhi(a.z); v[6] = bflo(a.w); v[7] = bfhi(a.w);
    v[8] = bflo(b.x); v[9] = bfhi(b.x); v[10] = bflo(b.y); v[11] = bfhi(b.y); v[12] = bflo(b.z); v[13] = bfhi(b.z); v[14] = bflo(b.w); v[15] = bfhi(b.w);
}
__device__ __forceinline__ void st16bf(bf16_t* p, const float (&v)[16]) {
    u32x4 a, b; a.x = cvtpk(v[0], v[1]); a.y = cvtpk(v[2], v[3]); a.z = cvtpk(v[4], v[5]); a.w = cvtpk(v[6], v[7]);
    b.x = cvtpk(v[8], v[9]); b.y = cvtpk(v[10], v[11]); b.z = cvtpk(v[12], v[13]); b.w = cvtpk(v[14], v[15]);
    *(u32x4*)p = a; *(u32x4*)(p + 8) = b;
}
struct PrepIn { unsigned cq0, cq1, cq2; u32x2 ckv; u32x4 qa, qb, ka, kb, vv; float rope; };
__device__ __forceinline__ void p4_load(PrepIn& in, int row, const bf16_t* proj, const bf16_t* qraw, const bf16_t* kvraw, const float* rope, int lane) {
    const int h = lane >> 3, s = lane & 7;
    const bf16_t* pr = proj + (size_t)row * INWP;
    { const bf16_t* p = pr + C_CQ + lane * 6; in.cq0 = *(const unsigned*)p; in.cq1 = *(const unsigned*)(p + 2); in.cq2 = *(const unsigned*)(p + 4); }
    in.ckv = *(const u32x2*)(pr + C_CKV + lane * 4);
    in.rope = rope[(size_t)row * 32 + (lane & 31)];
    const u32x4 z = {0u, 0u, 0u, 0u};
    in.qa = z; in.qb = z; in.ka = z; in.kb = z;
    if (s < 6) {
        const bf16_t* k = (s < 4) ? (kvraw + (size_t)row * 1024 + h * 128 + s * 16) : (pr + C_KR + (s - 4) * 16); in.ka = *(const u32x4*)k; in.kb = *(const u32x4*)(k + 8); }
    in.vv = *(const u32x4*)(kvraw + (size_t)row * 1024 + (lane >> 3) * 128 + 64 + (lane & 7) * 8);
}
__device__ __forceinline__ void unpack16(const u32x4 a, const u32x4 b, float (&v)[16]) {
    v[0] = bflo(a.x); v[1] = bfhi(a.x); v[2] = bflo(a.y); v[3] = bfhi(a.y); v[4] = bflo(a.z); v[5] = bfhi(a.z); v[6] = bflo(a.w); v[7] = bfhi(a.w);
    v[8] = bflo(b.x); v[9] = bfhi(b.x); v[10] = bflo(b.y); v[11] = bfhi(b.y); v[12] = bflo(b.z); v[13] = bfhi(b.z); v[14] = bflo(b.w); v[15] = bfhi(b.w);
}
__device__ __forceinline__ void p4_prep(Frame& F, const Args& a) {
    unsigned char* ws = F.ws;
    const bf16_t* proj = (const bf16_t*)(ws + WS_PROJ); const bf16_t* qraw = (const bf16_t*)(ws + WS_QRAW); const bf16_t* kvraw = (const bf16_t*)(ws + WS_KVRAW);
    bf16_t* QB = (bf16_t*)(ws + WS_QB); bf16_t* KB = (bf16_t*)(ws + WS_KB); bf16_t* VB = (bf16_t*)(ws + WS_VB);
    const float* rope = (const float*)(ws + WS_ROPE); const float* gq = a.in[8]; const float* gk = a.in[9];
    const int gw = F.vcu * NWAVES + F.wave, NGW = F.G * NWAVES, lane = F.lane, h = lane >> 3, s = lane & 7;
    float gqv[16], gkv[16];
#pragma unroll
    for (int j = 0; j < 16; ++j) { gqv[j] = (s < 6) ? gq[s * 16 + j] : 0.f; gkv[j] = (s < 6) ? gk[s * 16 + j] : 0.f; }
    PrepIn cur, nxt;
    if (gw < M_) p4_load(cur, gw, proj, qraw, kvraw, rope, lane);
    for (int row = gw; row < M_; row += NGW) {
        const bool hn = row + NGW < M_;
        if (hn) p4_load(nxt, row + NGW, proj, qraw, kvraw, rope, lane);
        float sq = bflo(cur.cq0) * bflo(cur.cq0) + bfhi(cur.cq0) * bfhi(cur.cq0) + bflo(cur.cq1) * bflo(cur.cq1) + bfhi(cur.cq1) * bfhi(cur.cq1) + bflo(cur.cq2) * bflo(cur.cq2) + bfhi(cur.cq2) * bfhi(cur.cq2);
        float skv = bflo(cur.ckv.x) * bflo(cur.ckv.x) + bfhi(cur.ckv.x) * bfhi(cur.ckv.x) + bflo(cur.ckv.y) * bflo(cur.ckv.y) + bfhi(cur.ckv.y) * bfhi(cur.ckv.y);
        sq = wave_sum(sq); skv = wave_sum(skv);
        const float var_cq = sq * (1.f / 384.f) + EPS;
        const float rstd_ckv = rsqrtf(skv * (1.f / 256.f) + EPS);
        float cs[16], sn[16];
#pragma unroll
        for (int j = 0; j < 16; ++j) { cs[j] = __int_as_float(__builtin_amdgcn_readlane(__float_as_int(cur.rope), j)); sn[j] = __int_as_float(__builtin_amdgcn_readlane(__float_as_int(cur.rope), 16 + j)); }
        if (lane == 0) ((float*)(ws + WS_VARCQ))[row] = var_cq;
        {
            float v[16]; unpack16(cur.ka, cur.kb, v);
            if (s < 4) {
#pragma unroll
                for (int j = 0; j < 16; ++j) v[j] *= rstd_ckv; }
            float ss = 0.f;
#pragma unroll
            for (int j = 0; j < 16; ++j) ss += v[j] * v[j];
            ss = sum8(ss);
            const float r = rsqrtf(ss * (1.f / 96.f) + EPS);
#pragma unroll
            for (int j = 0; j < 16; ++j) v[j] = v[j] * r * gkv[j];
            float o[16];
#pragma unroll
            for (int j = 0; j < 16; ++j) { const float pv = DPP_F(v[j], DPP_X1);
                o[j] = (s == 4) ? (v[j] * cs[j] - pv * sn[j]) : (s == 5) ? (v[j] * cs[j] + pv * sn[j]) : v[j]; }
            if (s < 6) st16bf(KB + (size_t)row * 768 + h * 96 + s * 16, o);
            const u32x4 vw = cur.vv;
            u32x4 ow; ow.x = cvtpk(bflo(vw.x) * rstd_ckv, bfhi(vw.x) * rstd_ckv); ow.y = cvtpk(bflo(vw.y) * rstd_ckv, bfhi(vw.y) * rstd_ckv);
            ow.z = cvtpk(bflo(vw.z) * rstd_ckv, bfhi(vw.z) * rstd_ckv); ow.w = cvtpk(bflo(vw.w) * rstd_ckv, bfhi(vw.w) * rstd_ckv);
            *(u32x4*)(VB + (size_t)row * 512 + lane * 8) = ow;
        }
        if (hn) cur = nxt;
    }
}
namespace att {
constexpr int BUFB = 20480;
constexpr int WREG = 8448;
constexpr int OST_OFF = 2 * BUFB;
constexpr int WSF_OFF = OST_OFF + 8 * WREG;
constexpr int FLG_OFF = WSF_OFF + 8 * 256;
__device__ __forceinline__ int crow(int r, int hi) { return (r & 3) + 8 * (r >> 2) + 4 * hi; }
__device__ __forceinline__ s16x4 vtr(const LAS char* p) { typedef short v4i16_t __attribute__((ext_vector_type(4))); return __builtin_bit_cast(s16x4, __builtin_amdgcn_ds_read_tr16_b64_v4i16((LAS v4i16_t*)p)); }
#define ATT_MFMA(a, b, c) __builtin_amdgcn_mfma_f32_32x32x16_bf16((a), (b), (c), 0, 0, 0)

template <int NCH> struct Stage {
    u32x4 k0, k1, v0;
    __device__ __forceinline__ void load(const bf16_t* Kb, int pitchK, const bf16_t* Vb, int pitchV, int key0, int wid, int lane) {
        k0 = *(const u32x4*)(Kb + (size_t)(key0 + lane) * pitchK + wid * 8);
        if (NCH > 8) { if (wid < NCH - 8) k1 = *(const u32x4*)(Kb + (size_t)(key0 + lane) * pitchK + (8 + wid) * 8); }
        v0 = *(const u32x4*)(Vb + (size_t)(key0 + 16 * (wid & 3) + (lane >> 2)) * pitchV + (wid >> 2) * 32 + (lane & 3) * 8);
    }
    __device__ __forceinline__ void write(LAS unsigned char* buf, int wid, int lane) const {
        *(LAS u32x4*)(buf + wid * 1024 + lane * 16) = k0;
        if (NCH > 8) { if (wid < NCH - 8) *(LAS u32x4*)(buf + (8 + wid) * 1024 + lane * 16) = k1; }
        *(LAS u32x4*)(buf + NCH * 1024 + wid * 1024 + lane * 16) = v0;
    }
};

__device__ __forceinline__ void pv_tile(f32x16 (&o)[2], const LAS char* vp, const bf16x8 (&pa)[4]) {
    __builtin_amdgcn_s_setprio(1);
#pragma unroll
    for (int d0 = 0; d0 < 2; ++d0)
#pragma unroll
        for (int ks = 0; ks < 4; ++ks) {
            const s16x4 lo = vtr(vp + d0 * 4096 + ks * 1024), hi = vtr(vp + d0 * 4096 + ks * 1024 + 512);
            const bf16x8 vf = __builtin_shufflevector(lo, hi, 0, 1, 2, 3, 4, 5, 6, 7);
            o[d0] = ATT_MFMA(pa[ks], vf, o[d0]);
        }
    __builtin_amdgcn_s_setprio(0);
}
__device__ __forceinline__ bf16x8 pack8(const f32x16& p, int base) {
    u32x4 w; w.x = cvtpk(p[base], p[base + 1]); w.y = cvtpk(p[base + 2], p[base + 3]); w.z = cvtpk(p[base + 4], p[base + 5]); w.w = cvtpk(p[base + 6], p[base + 7]);
    return __builtin_bit_cast(bf16x8, w);
}
__device__ __forceinline__ void store_o(const f32x16 (&o)[2], const float (&rs)[16], LAS unsigned char* lds, int wid, int lane, bf16_t* Ow) {
    const int r32 = lane & 31, hi = lane >> 5;
    LAS bf16_t* stg = (LAS bf16_t*)(lds + OST_OFF + wid * WREG);
#pragma unroll
    for (int r = 0; r < 16; ++r) { const int orow = crow(r, hi);
#pragma unroll
        for (int d0 = 0; d0 < 2; ++d0) { const unsigned w = cvtpk(o[d0][r] * rs[r], 0.f); stg[orow * 64 + d0 * 32 + r32] = (bf16_t)(w & 0xffffu); } }
    asm volatile("s_waitcnt lgkmcnt(0)" ::: "memory");
#pragma unroll
    for (int i = 0; i < 4; ++i) { const int row = i * 8 + (lane >> 3), ch = lane & 7; const u32x4 v = *(const LAS u32x4*)(stg + row * 64 + ch * 8); *(u32x4*)(Ow + (size_t)row * 512 + ch * 8) = v; }
    asm volatile("s_waitcnt lgkmcnt(0)" ::: "memory");
}


constexpr int MLA_CONV_PERIOD = 4;
struct Conv {
    const float* w_up; const float* w_down; unsigned char* up8; unsigned char* dn8; int item, step, ctr; bool inflight;
    static constexpr int I_UP1 = (D_ / 64) * (2 * DFF / 32), I_DN1 = (DFF / 64) * (D_ / 32), NI = NE * (I_UP1 + I_DN1);
    const float* src; unsigned char* dst; int K, N;
    __device__ __forceinline__ bool pending() const { return item < NI; }
    __device__ __forceinline__ void load_to(f32x4 (&t)[8], int lane) {
        int r = item;
        if (r < NE * I_UP1) { const int e = r / I_UP1; r %= I_UP1; K = D_; N = 2 * DFF; const int nblk = N / 32, kb = r / nblk, nb = r % nblk; src = w_up + (size_t)e * D_ * 2 * DFF + (size_t)(64 * kb) * N + 32 * nb; dst = up8 + (size_t)e * 2 * DFF * D_ + (size_t)(32 * nb) * K + 64 * kb; }
        else { r -= NE * I_UP1; const int e = r / I_DN1; r %= I_DN1; K = DFF; N = D_; const int nblk = N / 32, kb = r / nblk, nb = r % nblk; src = w_down + (size_t)e * DFF * D_ + (size_t)(64 * kb) * N + 32 * nb; dst = dn8 + (size_t)e * D_ * DFF + (size_t)(32 * nb) * K + 64 * kb; }
        const float* p = src + (size_t)(8 * (lane >> 3)) * N + 4 * (lane & 7);
#pragma unroll
        for (int j = 0; j < 8; ++j) t[j] = *(const f32x4*)(p + (size_t)j * N);
    }
    __device__ __forceinline__ void finish_from(const f32x4 (&t)[8], LAS float*, int lane) {
        unsigned char* q = dst + (size_t)(4 * (lane & 7)) * K + 8 * (lane >> 3);
#pragma unroll
        for (int c4 = 0; c4 < 4; ++c4) {
            u32x2 o; o.x = pk_fp8x4(t[0][c4] * W8_SCALE, t[1][c4] * W8_SCALE, t[2][c4] * W8_SCALE, t[3][c4] * W8_SCALE); o.y = pk_fp8x4(t[4][c4] * W8_SCALE, t[5][c4] * W8_SCALE, t[6][c4] * W8_SCALE, t[7][c4] * W8_SCALE);
            *(u32x2*)(q + (size_t)c4 * K) = o; }
        item += step;
    }
    __device__ __forceinline__ void tick_begin(f32x4 (&tv)[8], int lane) { if (!inflight && ctr == 0 && pending()) { load_to(tv, lane); inflight = true; } }
    __device__ __forceinline__ void tick_end(const f32x4 (&tv)[8], LAS float* scr, int lane) { if (inflight && ctr == 2) { finish_from(tv, scr, lane); inflight = false; } ctr = (ctr == MLA_CONV_PERIOD - 1) ? 0 : ctr + 1; }
    __device__ __forceinline__ void flush(const f32x4 (&tv)[8], LAS float* scr, int lane) { if (inflight) { finish_from(tv, scr, lane); inflight = false; } }
    __device__ __forceinline__ void drain(LAS float* scr, int lane) { while (pending()) { f32x4 t2[8]; load_to(t2, lane); finish_from(t2, scr, lane); } }
};
__device__ __forceinline__ void mla_unit(LAS unsigned char* lds, int b, int h, int qb, const bf16_t* QB, const bf16_t* KB, const bf16_t* VB, bf16_t* O, float m0, Conv& cv, const Args& ka) {
    const int tid = threadIdx.x, lane = tid & 63, r32 = lane & 31, hi = lane >> 5; const int wid = __builtin_amdgcn_readfirstlane(tid >> 6);
    const size_t rb = (size_t)b * S_; const int q0 = qb * 256;
    const bf16_t* Kh = KB + rb * 768 + h * 96; const bf16_t* Vh = VB + rb * 512 + h * 64;
    bf16x8 qr[6];
    { const size_t row = rb + q0 + wid * 32 + r32;
      const float* gq = ka.in[8]; const float* ropet = (const float*)(ka.ws + WS_ROPE); const float* varcq = (const float*)(ka.ws + WS_VARCQ);
      const bf16_t* qp = QB + row * 768 + h * 96 + hi * 8;
      float v[6][8]; float ss = 0.f;
#pragma unroll
      for (int d0 = 0; d0 < 6; ++d0) { const u32x4 w = *(const u32x4*)(qp + d0 * 16);
          v[d0][0] = bflo(w.x); v[d0][1] = bfhi(w.x); v[d0][2] = bflo(w.y); v[d0][3] = bfhi(w.y); v[d0][4] = bflo(w.z); v[d0][5] = bfhi(w.z); v[d0][6] = bflo(w.w); v[d0][7] = bfhi(w.w);
#pragma unroll
          for (int j = 0; j < 8; ++j) ss += v[d0][j] * v[d0][j]; }
      ss += __shfl_xor(ss, 32);
      const float r = rsqrtf(ss * (1.f / 96.f) + EPS * varcq[row]) * MLA_QSCALE;
#pragma unroll
      for (int d0 = 0; d0 < 6; ++d0) { const f32x4 g0 = *(const f32x4*)(gq + d0 * 16 + hi * 8), g1 = *(const f32x4*)(gq + d0 * 16 + hi * 8 + 4);
          v[d0][0] *= r * g0.x; v[d0][1] *= r * g0.y; v[d0][2] *= r * g0.z; v[d0][3] *= r * g0.w; v[d0][4] *= r * g1.x; v[d0][5] *= r * g1.y; v[d0][6] *= r * g1.z; v[d0][7] *= r * g1.w; }
      { const f32x4 c0 = *(const f32x4*)(ropet + row * 32 + hi * 8), c1 = *(const f32x4*)(ropet + row * 32 + hi * 8 + 4), s0 = *(const f32x4*)(ropet + row * 32 + 16 + hi * 8), s1 = *(const f32x4*)(ropet + row * 32 + 16 + hi * 8 + 4);
        const float cs[8] = {c0.x, c0.y, c0.z, c0.w, c1.x, c1.y, c1.z, c1.w}, sn[8] = {s0.x, s0.y, s0.z, s0.w, s1.x, s1.y, s1.z, s1.w};
#pragma unroll
        for (int j = 0; j < 8; ++j) { const float x1 = v[4][j], x2 = v[5][j]; v[4][j] = x1 * cs[j] - x2 * sn[j]; v[5][j] = x2 * cs[j] + x1 * sn[j]; } }
#pragma unroll
      for (int d0 = 0; d0 < 6; ++d0) { u32x4 w; w.x = cvtpk(v[d0][0], v[d0][1]); w.y = cvtpk(v[d0][2], v[d0][3]); w.z = cvtpk(v[d0][4], v[d0][5]); w.w = cvtpk(v[d0][6], v[d0][7]); qr[d0] = __builtin_bit_cast(bf16x8, w); } }
    const int NT = 4 * qb + 4, my_last = 4 * qb + (wid >> 1);
    f32x16 o[2]; float l = 0.f;
#pragma unroll
    for (int r = 0; r < 16; ++r) { o[0][r] = 0.f; o[1][r] = 0.f; }
    f32x16 negm;
#pragma unroll
    for (int r = 0; r < 16; ++r) negm[r] = -m0;
    asm volatile("" : "+v"(negm));
    Stage<12> st;
    st.load(Kh, 768, Vh, 512, 0, wid, lane); st.write(lds, wid, lane);
    __syncthreads();
    LAS float* cscr = (LAS float*)(lds + OST_OFF + wid * WREG);
    f32x4 tv[8];
    for (int t = 0; t < NT; ++t) {
        if (t + 1 < NT) st.load(Kh, 768, Vh, 512, (t + 1) * 64, wid, lane);
        asm volatile("" ::: "memory");
        cv.tick_begin(tv, lane);
        if (t <= my_last) {
            const LAS char* buf = (const LAS char*)(lds + (t & 1) * BUFB);
            const LAS char* kp = buf + hi * 1024 + r32 * 16;
            f32x16 p0, p1;
            __builtin_amdgcn_s_setprio(1);
#pragma unroll
            for (int d0 = 0; d0 < 6; ++d0) { const bf16x8 a0 = *(const LAS bf16x8*)(kp + d0 * 2048), a1 = *(const LAS bf16x8*)(kp + d0 * 2048 + 512);
#ifndef ABL_NOQK
                if (d0 == 0) { p0 = ATT_MFMA(a0, qr[0], negm); p1 = ATT_MFMA(a1, qr[0], negm); }
                else { p0 = ATT_MFMA(a0, qr[d0], p0); p1 = ATT_MFMA(a1, qr[d0], p1); }
#else
                if (d0 == 0) { p0 = negm; p1 = negm; } asm volatile("" :: "v"(a0), "v"(a1));
#endif
            }
            __builtin_amdgcn_s_setprio(0);
            float ls = 0.f;
#ifndef ABL_NOEXP
#pragma unroll
            for (int r = 0; r < 16; ++r) { p0[r] = __builtin_amdgcn_exp2f(p0[r]); p1[r] = __builtin_amdgcn_exp2f(p1[r]); ls += p0[r] + p1[r]; }
#endif
            l += ls;
            bf16x8 pa[4]; pa[0] = pack8(p0, 0); pa[1] = pack8(p0, 8); pa[2] = pack8(p1, 0); pa[3] = pack8(p1, 8);
            const LAS char* vp = buf + 12 * 1024 + ((lane >> 4) & 1) * 32 + (lane & 3) * 8 + (4 * hi + ((lane & 15) >> 2)) * 64;
#ifndef ABL_NOPV
            pv_tile(o, vp, pa);
#else
            asm volatile("" :: "v"(pa[0]), "v"(pa[1]), "v"(pa[2]), "v"(pa[3]), "v"(vp));
#endif
        }
        if (t + 1 < NT) st.write(lds + ((t + 1) & 1) * BUFB, wid, lane);
        cv.tick_end(tv, cscr, lane);
        __syncthreads();
    }
    cv.flush(tv, cscr, lane);
    l += __shfl_xor(l, 32);
    LAS float* wsf = (LAS float*)(lds + WSF_OFF) + wid * 64;
    if (hi == 0) wsf[r32] = l;
    asm volatile("s_waitcnt lgkmcnt(0)" ::: "memory");
    float rs[16];
#pragma unroll
    for (int r = 0; r < 16; ++r) rs[r] = __builtin_amdgcn_rcpf(wsf[crow(r, hi)]);
    store_o(o, rs, lds, wid, lane, O + (rb + q0 + wid * 32) * 512 + h * 64);
}

__device__ __forceinline__ void sb_unit(LAS unsigned char* lds, int b, int h, int qb, const bf16_t* proj, bf16_t* O, Conv& cv) {
    const int tid = threadIdx.x, lane = tid & 63, r32 = lane & 31, hi = lane >> 5; const int wid = __builtin_amdgcn_readfirstlane(tid >> 6);
    const size_t rb = (size_t)b * S_; const int q0 = qb * 256;
    const bf16_t* Kh = proj + rb * INWP + C_SBK + h * 64; const bf16_t* Vh = proj + rb * INWP + C_SBV + h * 64;
    bf16x8 qr[4];
    { const bf16_t* qp = proj + (rb + q0 + wid * 32 + r32) * INWP + C_SBQ + h * 64 + hi * 8;
#pragma unroll
      for (int d0 = 0; d0 < 4; ++d0) qr[d0] = *(const bf16x8*)(qp + d0 * 16); }
    const int Ttop = 4 * qb + 3, qw0 = q0 + wid * 32, qabs = qw0 + r32;
    f32x16 o[2]; float carry = 1.f;
#pragma unroll
    for (int r = 0; r < 16; ++r) { o[0][r] = 0.f; o[1][r] = 0.f; }
    volatile LAS int* flg = (volatile LAS int*)(lds + FLG_OFF);
    Stage<8> st;
    st.load(Kh, INWP, Vh, INWP, Ttop * 64, wid, lane); st.write(lds, wid, lane);
    __syncthreads();
    bool alive = true;
    for (int it = 0;; ++it) {
        const int t = Ttop - it;
        if (t > 0) st.load(Kh, INWP, Vh, INWP, (t - 1) * 64, wid, lane);
        asm volatile("" ::: "memory");
        f32x4 ctv[8]; const bool cvp = cv.pending() && (((it + wid) & 1) == 0);
        if (cvp) cv.load_to(ctv, lane);
        if (alive && (64 * t <= qw0 + 30)) {
            const LAS char* buf = (const LAS char*)(lds + (it & 1) * BUFB);
            const LAS char* kp = buf + hi * 1024 + r32 * 16;
            const bool need_mask = (64 * t + 63 >= qw0);
            bf16x8 pa[4];
#pragma unroll
            for (int blk = 1; blk >= 0; --blk) {
                f32x16 p;
#pragma unroll
                for (int r = 0; r < 16; ++r) p[r] = 0.f;
#pragma unroll
                for (int d0 = 0; d0 < 4; ++d0) { const bf16x8 a0 = *(const LAS bf16x8*)(kp + d0 * 2048 + blk * 512); p = ATT_MFMA(a0, qr[d0], p); }
                const int kb0 = 64 * t + 32 * blk + 4 * hi;
                f32x16 s;
#pragma unroll
                for (int r = 0; r < 16; ++r) {
                    const int key = kb0 + (r & 3) + 8 * (r >> 2);
                    const float tt = __builtin_amdgcn_exp2f(-fmaxf(p[r], -80.f)); float be = __builtin_amdgcn_rcpf(1.f + tt); float sy = tt * be;
                    if (need_mask && !(key < qabs)) { be = 0.f; sy = 1.f; }
                    p[r] = be; s[r] = sy;
                }
                float T[5]; T[4] = 1.f;
#pragma unroll
                for (int i = 3; i >= 0; --i) T[i] = T[i + 1] * ((s[4 * i] * s[4 * i + 1]) * (s[4 * i + 2] * s[4 * i + 3]));
                float Tp[5]; Tp[4] = 1.f;
#pragma unroll
                for (int i = 0; i < 4; ++i) Tp[i] = __shfl_xor(T[i], 32);
#pragma unroll
                for (int i = 3; i >= 0; --i) {
                    float lat = carry * (T[i + 1] * (hi ? Tp[i + 1] : Tp[i]));
#pragma unroll
                    for (int e3 = 3; e3 >= 0; --e3) { const int r = 4 * i + e3; const float sy = s[r]; p[r] = p[r] * lat; lat *= sy; }
                }
                carry *= T[0] * Tp[0];
                pa[2 * blk] = pack8(p, 0); pa[2 * blk + 1] = pack8(p, 8);
            }
            const LAS char* vp = buf + 8 * 1024 + ((lane >> 4) & 1) * 32 + (lane & 3) * 8 + (4 * hi + ((lane & 15) >> 2)) * 64;
            pv_tile(o, vp, pa);
            alive = __any(carry > 0.f);
        }
        if (lane == 0) flg[(it & 1) * 8 + wid] = alive ? 1 : 0;
        if (t > 0) st.write(lds + ((it + 1) & 1) * BUFB, wid, lane);
        if (cvp) cv.finish_from(ctv, (LAS float*)(lds + OST_OFF + wid * WREG), lane);
        __syncthreads();
        if (t == 0) break;
        int any = 0;
#pragma unroll
        for (int w = 0; w < 8; ++w) any |= flg[(it & 1) * 8 + w];
        if (!any) break;
    }
    float rs[16];
#pragma unroll
    for (int r = 0; r < 16; ++r) rs[r] = 1.f;
    store_o(o, rs, lds, wid, lane, O + (rb + q0 + wid * 32) * 512 + h * 64);
}
}

__device__ __forceinline__ void p5_attention(Frame& F, const Args& a) {
    unsigned char* ws = F.ws;
    volatile LAS int* citem = (volatile LAS int*)(F.MISC + MI_CITEM) + F.wave;
    {
        float gm;
        { const float* gq = a.in[8]; const float* gk = a.in[9]; float mq = 0.f, mk = 0.f;
          for (int i = F.lane; i < 96; i += 64) { mq = fmaxf(mq, fabsf(gq[i])); mk = fmaxf(mk, fabsf(gk[i])); }
#pragma unroll
          for (int o = 1; o < 64; o <<= 1) { mq = fmaxf(mq, __shfl_xor(mq, o)); mk = fmaxf(mk, __shfl_xor(mk, o)); }
          gm = 9.79795897f * LOG2E * mq * mk; }
        att::Conv cv; cv.w_up = a.in[16]; cv.w_down = a.in[18]; cv.up8 = (unsigned char*)(ws + WS_WUP); cv.dn8 = (unsigned char*)(ws + WS_WDN);
        cv.item = F.vcu * NWAVES + F.wave; cv.step = F.G * NWAVES; cv.ctr = F.wave % att::MLA_CONV_PERIOD; cv.inflight = false;
#ifdef ABL_NOCONV
        cv.item = att::Conv::NI;
#endif
        for (int v = F.vcu; v < 256; v += F.G) {
            const int bh = v >> 3, s = v & 7, b = bh >> 3, h = bh & 7;
            for (int i = 0; i < 2; ++i) { const int qb = i ? 15 - s : s;
                att::mla_unit(F.lds, b, h, qb, (const bf16_t*)(ws + WS_QRAW), (const bf16_t*)(ws + WS_KB), (const bf16_t*)(ws + WS_VB), (bf16_t*)(ws + WS_OMLA), gm, cv, a);
                __syncthreads(); }
        }
        if (F.lane == 0) *citem = cv.item;
    }
    __syncthreads();
#ifdef MEGA_STAMPS
    if (blockIdx.x == 0 && F.tid == 0) ((unsigned long long*)(ws + WS_CTL + 32768))[12] = __builtin_amdgcn_s_memrealtime();
#endif
    {
        att::Conv cv; cv.w_up = a.in[16]; cv.w_down = a.in[18]; cv.up8 = (unsigned char*)(ws + WS_WUP); cv.dn8 = (unsigned char*)(ws + WS_WDN);
        cv.item = __builtin_amdgcn_readfirstlane(*citem); cv.step = F.G * NWAVES; cv.ctr = 0; cv.inflight = false;
        for (int v = F.vcu; v < 256; v += F.G) {
            const int bh = v >> 3, s = v & 7, b = bh >> 3, h = bh & 7;
            for (int i = 0; i < 2; ++i) { const int qb = i ? 15 - s : s;
                att::sb_unit(F.lds, b, h, qb, (const bf16_t*)(ws + WS_PROJ), (bf16_t*)(ws + WS_OSB), cv);
                __syncthreads(); }
        }
        cv.drain((LAS float*)(F.lds + att::OST_OFF + F.wave * att::WREG), F.lane);
    }
}

__device__ __forceinline__ void p8_router(Frame& F, const Args& a) {
    unsigned char* ws = F.ws;
    const bf16_t* x1 = (const bf16_t*)(ws + WS_X1B); const float* wr = (const float*)(ws + WS_WR); const float* br = a.in[15]; const float* g = a.in[13];
    unsigned char* H2 = (unsigned char*)(ws + WS_H2F8); int* list = (int*)(ws + WS_LIST); float* topw = (float*)(ws + WS_TOPW); int* selo = (int*)(ws + WS_SEL);
    int* cnt = (int*)(ws + WS_CTL) + CW_CNT;
    volatile LAS int* lcnt = (volatile LAS int*)(F.MISC + MI_LCNT); volatile LAS int* lbase = (volatile LAS int*)(F.MISC + MI_BASE);
    const int lane = F.lane, wave = F.wave, tid = F.tid;
    constexpr int WST = 1028;
    LAS float* wt = (LAS float*)F.lds;
    if (F.vcu < M_ / 64) {
        for (int i = tid; i < NE * WST / 4; i += NTHR) *(LAS f32x4*)(wt + (size_t)i * 4) = *(const f32x4*)(wr + (size_t)i * 4);
    }
    __syncthreads();
    for (int task = F.vcu; task < M_ / 64; task += F.G) {
        const int T0 = task * 64;
        if (tid < 32) lcnt[tid] = 0;
        __syncthreads();
        int my_e = 0, my_rank = 0; float my_w = 0.f;
        if (wave < 4) {
            const int tk = lane & 15, kp = lane >> 4, tok = T0 + wave * 16 + tk;
            const bf16_t* xp = x1 + (size_t)tok * D_ + kp * 256;
            const LAS float* w0 = wt + tk * WST + kp * 256; const LAS float* w1 = w0 + 16 * WST;
            f32x4 acc0 = {0.f, 0.f, 0.f, 0.f}, acc1 = {0.f, 0.f, 0.f, 0.f}; float ssq = 0.f;
#pragma unroll 4
            for (int i = 0; i < 256; i += 4) {
                const u32x2 aw = *(const u32x2*)(xp + i); const f32x4 a4 = {bflo(aw.x), bfhi(aw.x), bflo(aw.y), bfhi(aw.y)}; const f32x4 b0 = *(const LAS f32x4*)(w0 + i), b1 = *(const LAS f32x4*)(w1 + i);
                ssq += (a4.x * a4.x + a4.y * a4.y) + (a4.z * a4.z + a4.w * a4.w);
#pragma unroll
                for (int j = 0; j < 4; ++j) { acc0 = __builtin_amdgcn_mfma_f32_16x16x4f32(a4[j], b0[j], acc0, 0, 0, 0); acc1 = __builtin_amdgcn_mfma_f32_16x16x4f32(a4[j], b1[j], acc1, 0, 0, 0); }
            }
            ssq += __shfl_xor(ssq, 16); ssq += __shfl_xor(ssq, 32);
            const float rstd = rsqrtf(ssq * (1.f / D_) + EPS);
            const int e0 = lane & 15, grp = lane >> 4;
            const float bia0 = br[e0], bia1 = br[e0 + 16];
#pragma unroll
            for (int j = 0; j < 4; ++j) {
                const float rs = __shfl(rstd, 4 * grp + j);
                float c0 = acc0[j] * rs + bia0, c1 = acc1[j] * rs + bia1;
                float sv[4]; int si[4];
#pragma unroll
                for (int k = 0; k < 4; ++k) {
                    float best = c0; int bi = e0;
                    if (c1 > best) { best = c1; bi = e0 + 16; }
#pragma unroll
                    for (int st_ = 0; st_ < 4; ++st_) { const int ctl = st_ == 0 ? DPP_X1 : st_ == 1 ? DPP_X2 : st_ == 2 ? DPP_HM : DPP_RM;
                        float ob; int oi;
                        if (st_ == 0) { ob = DPP_F(best, DPP_X1); oi = DPP_I(bi, DPP_X1); } else if (st_ == 1) { ob = DPP_F(best, DPP_X2); oi = DPP_I(bi, DPP_X2); } else if (st_ == 2) { ob = DPP_F(best, DPP_HM); oi = DPP_I(bi, DPP_HM); } else { ob = DPP_F(best, DPP_RM); oi = DPP_I(bi, DPP_RM); }
                        (void)ctl; if (ob > best || (ob == best && oi < bi)) { best = ob; bi = oi; } }
                    sv[k] = best; si[k] = bi;
                    if (bi == e0) c0 = -INFINITY; if (bi == e0 + 16) c1 = -INFINITY;
                }
                float ex[4], sum = 0.f;
#pragma unroll
                for (int k = 0; k < 4; ++k) { ex[k] = __expf(sv[k] - sv[0]); sum += ex[k]; }
                const float inv = 1.f / sum;
                if (((lane >> 2) & 3) == j) {
#pragma unroll
                    for (int k = 0; k < 4; ++k) if ((lane & 3) == k) { my_e = si[k]; my_w = ex[k] * inv; }
                }
            }
            my_rank = atomicAdd((int*)&lcnt[my_e], 1);
        } else {
            const f32x4* gr = (const f32x4*)g + lane;
            f32x4 gg[4];
#pragma unroll
            for (int j = 0; j < 4; ++j) gg[j] = gr[64 * j] * X8_SCALE;
            for (int rr = 0; rr < 16; rr += 4) {
                const int t0 = T0 + (wave - 4) * 16 + rr;
                f32x4 v[4][4]; float s[4];
#pragma unroll
                for (int q = 0; q < 4; ++q) { const u32x2* xr = (const u32x2*)(x1 + (size_t)(t0 + q) * D_) + lane;
#pragma unroll
                    for (int j = 0; j < 4; ++j) { const u32x2 w = xr[64 * j]; v[q][j] = (f32x4){bflo(w.x), bfhi(w.x), bflo(w.y), bfhi(w.y)}; } }
#pragma unroll
                for (int q = 0; q < 4; ++q) { s[q] = 0.f;
#pragma unroll
                    for (int j = 0; j < 4; ++j) s[q] += (v[q][j].x * v[q][j].x + v[q][j].y * v[q][j].y) + (v[q][j].z * v[q][j].z + v[q][j].w * v[q][j].w); }
#pragma unroll
                for (int q = 0; q < 4; ++q) { const float r = rsqrtf(wave_sum(s[q]) * (1.f / D_) + EPS); unsigned* o = (unsigned*)(H2 + (size_t)(t0 + q) * D_) + lane;
#pragma unroll
                    for (int j = 0; j < 4; ++j) o[64 * j] = pk_fp8x4(v[q][j].x * r * gg[j].x, v[q][j].y * r * gg[j].y, v[q][j].z * r * gg[j].z, v[q][j].w * r * gg[j].w); }
            }
        }
        __syncthreads();
        if (tid < 32) lbase[tid] = lcnt[tid] ? atomicAdd(&cnt[tid], lcnt[tid]) : 0;
        __syncthreads();
        if (wave < 4) {
            const int grp = lane >> 4, jj = (lane >> 2) & 3, kk = lane & 3;
            const int tok = T0 + wave * 16 + 4 * grp + jj, slot = tok * 4 + kk;
            list[(size_t)my_e * M_ + lbase[my_e] + my_rank] = slot; ((float*)(ws + WS_LISTW))[(size_t)my_e * M_ + lbase[my_e] + my_rank] = my_w;
            topw[slot] = my_w; selo[slot] = my_e;
        }
        __syncthreads();
    }
}

struct MoeOrder {
    const bf16_t* A; const bf16_t* Bt; const int* list; volatile LAS unsigned* tab;
    int lda, ldb, nN, nwg, G, c, gather; size_t estride;
    __device__ void init(const bf16_t* A_, int lda_, const bf16_t* Bt_, int ldb_, size_t estride_, int nN_, const int* list_, volatile LAS unsigned* tab_, int gather_, int G_, int c_) {
        A = A_; lda = lda_; Bt = Bt_; ldb = ldb_; estride = estride_; nN = nN_; list = list_; tab = tab_; gather = gather_; G = G_; c = c_; nwg = (int)tab[MI_TPFX + NE] * nN_; }
    __device__ __forceinline__ bool next(int i, pg8::Unit& u) const {
        const long L = (long)i * G + c; if (L >= nwg) return false;
        int wgid = (int)L; { const int q = nwg / 8, r = nwg % 8, xcd = wgid % 8, off = wgid / 8; wgid = (xcd < r ? xcd * (q + 1) : r * (q + 1) + (xcd - r) * q) + off; }
        int e = 0;
        for (int k = 1; k < NE; ++k) if ((int)tab[MI_TPFX + k] * nN <= wgid) e = k;
        const int t0 = (int)tab[MI_TPFX + e], nt = (int)tab[MI_TPFX + e + 1] - t0, idx = wgid - t0 * nN;
        u.e = e; u.pn = idx / nt; u.rt = idx % nt; u.pm = t0 + u.rt; const int left = (int)tab[MI_CNT + e] - u.rt * 256; u.rows = left < 256 ? left : 256; return true;
    }
    __device__ __forceinline__ unsigned a_off(const pg8::Unit& u, int r, int C) const {
        int row;
        if (gather) row = (r < u.rows) ? (list[(size_t)u.e * M_ + u.rt * 256 + r] >> 2) : M_;
        else row = u.pm * 256 + r;
        return (unsigned)((row * lda + C) * 2);
    }
    __device__ __forceinline__ const char* b_base(const pg8::Unit& u) const { return (const char*)(Bt + (size_t)u.e * estride + (size_t)u.pn * 256 * ldb); }
};
__device__ __forceinline__ void moe_table(Frame& F) {
    int* cnt = (int*)(F.ws + WS_CTL) + CW_CNT;
    if (F.tid < NE) F.MISC[MI_CNT + F.tid] = __hip_atomic_load((unsigned*)cnt + F.tid, RLX_AGENT);
    __syncthreads();
    if (F.tid == 0) { unsigned p = 0; for (int e = 0; e < NE; ++e) { F.MISC[MI_TPFX + e] = p; p += (F.MISC[MI_CNT + e] + 255u) >> 8; } F.MISC[MI_TPFX + NE] = p; }
    __syncthreads();
}

__device__ __forceinline__ void p12_combine(Frame& F, const Args& a) {
    const bf16_t* Y = (const bf16_t*)(F.ws + WS_YB); const bf16_t* X1 = (const bf16_t*)(F.ws + WS_X1B); float* out = a.out;
    const int gt = (F.vcu * NWAVES + F.wave) * 64 + F.lane, NGT = F.G * NTHR;
    for (int i = gt; i < M_ * D_ / 8; i += NGT) {
        const int t = i >> 7, c = (i & 127) * 8;
        u32x4 w[5];
        w[4] = *(const u32x4*)(X1 + (size_t)t * D_ + c);
#pragma unroll
        for (int k = 0; k < 4; ++k) w[k] = *(const u32x4*)(Y + (size_t)(t * 4 + k) * D_ + c);
        f32x4 v0 = {bflo(w[4].x), bfhi(w[4].x), bflo(w[4].y), bfhi(w[4].y)}, v1 = {bflo(w[4].z), bfhi(w[4].z), bflo(w[4].w), bfhi(w[4].w)};
#pragma unroll
        for (int k = 0; k < 4; ++k) { v0.x += bflo(w[k].x); v0.y += bfhi(w[k].x); v0.z += bflo(w[k].y); v0.w += bfhi(w[k].y); v1.x += bflo(w[k].z); v1.y += bfhi(w[k].z); v1.z += bflo(w[k].w); v1.w += bfhi(w[k].w); }
        *(f32x4*)(out + (size_t)t * D_ + c) = v0; *(f32x4*)(out + (size_t)t * D_ + c + 4) = v1;
    }
}

constexpr int N_PHASES = 11;
#ifndef DUP_PHASE
#define DUP_PHASE -1
#endif
__global__ void __launch_bounds__(NTHR, 2) mega(Args args) {
    extern __shared__ __attribute__((aligned(16))) unsigned char lds_raw[];
    Frame F;
    F.lds = (LAS unsigned char*)lds_raw; F.MISC = (volatile LAS unsigned*)(F.lds + LDS_MISC);
    F.tid = threadIdx.x; F.lane = F.tid & 63; F.wave = __builtin_amdgcn_readfirstlane(F.tid >> 6);
    F.G = gridDim.x; { const int bx = blockIdx.x; F.vcu = (F.G % 8 == 0) ? (bx % 8) * (F.G / 8) + bx / 8 : bx; }
    F.ws = args.ws;
    unsigned char* ws = args.ws;
    for (int u = F.tid; u < (LDS_BYTES - LDS_MISC) / 4; u += NTHR) F.MISC[u] = 0u;
    __syncthreads();
    const int lo = args.ph_lo, hi = args.ph_hi;
    XcdBarrier bar; bar.bar = (unsigned*)(ws + WS_CTL) + CW_BAR; bar.x = 0; bar.st = nullptr;
    if (hi - lo > 1) bar = xcd_barrier_post((unsigned*)(ws + WS_CTL) + CW_BAR, F.MISC + MI_BAR);
#define IN(k) (lo <= (k) && (k) < hi)
#ifdef MEGA_STAMPS
#define STAMP(k) do { if (blockIdx.x == 0 && F.tid == 0) ((unsigned long long*)(ws + WS_CTL + 32768))[(k)] = __builtin_amdgcn_s_memrealtime(); } while (0)
#else
#define STAMP(k) do { } while (0)
#endif
#define SEAM(k) do { if (IN(k) && IN((k) + 1)) xcd_barrier(bar); STAMP((k) + 1); } while (0)
    const int cid = (int)blockIdx.x;
    STAMP(0);

    if (IN(0)) { p0_prologue(F, args, 0, 1); SEAM(0); }
    if (IN(1)) {
        pg8::Gemm g{(const bf16_t*)(ws + WS_HB), D_, D_, D_};
        pg8::StaticOrder S; S.init(g.A, D_, (const bf16_t*)(ws + WS_WIN), D_, M_, 4096, F.G, cid);
        pg8::EpiBf16 E{(bf16_t*)(ws + WS_PROJ), INWP};
        pg8::gemm_phase(F.lds, g, S, E);
        SEAM(1);
    }
    if (IN(2)) {
        { pg8::Gemm g{(const bf16_t*)(ws + WS_HB), D_, D_, D_};
          pg8::StaticOrder S; S.init(g.A, D_, (const bf16_t*)(ws + WS_WIN) + (size_t)4096 * D_, D_, M_, 256, F.G, cid);
          pg8::EpiBf16 E{(bf16_t*)(ws + WS_PROJ) + 4096, INWP};
          pg8::gemm_phase(F.lds, g, S, E); }
        { pg8::Gemm g{(const bf16_t*)(ws + WS_PROJ) + C_CQ, INWP, 384, 384};
          pg8::StaticOrder S; S.init(g.A, INWP, (const bf16_t*)(ws + WS_WUQ), 384, M_, 768, F.G, cid, F.G - 64);
          pg8::EpiBf16 E{(bf16_t*)(ws + WS_QRAW), 768};
          pg8::gemm_phase(F.lds, g, S, E); }
        { pg8::Gemm g{(const bf16_t*)(ws + WS_PROJ) + C_CKV, INWP, 256, 256};
          pg8::StaticOrder S; S.init(g.A, INWP, (const bf16_t*)(ws + WS_WUKV), 256, M_, 1024, F.G, cid);
          pg8::EpiBf16 E{(bf16_t*)(ws + WS_KVRAW), 1024};
          pg8::gemm_phase(F.lds, g, S, E); }
        SEAM(2);
    }
    if (IN(3)) { p4_prep(F, args); SEAM(3); }
    if (IN(4)) { p5_attention(F, args); SEAM(4); }
    if (IN(5)) {
        pg8::Gemm g{(const bf16_t*)(ws + WS_OSB), 512, 512, 512};
        pg8::PairOrder S; S.S.init(g.A, 512, (const bf16_t*)(ws + WS_WOSB), 512, M_, D_, F.G, cid); S.a1 = (WS_OMLA - WS_OSB) / 2; S.b1 = (WS_WOMLA - WS_WOSB) / 2;
        pg8::EpiGate2 E{(bf16_t*)(ws + WS_MIX), (const bf16_t*)(ws + WS_PROJ), INWP, C_GSB, C_GMLA};
        pg8::gemm_phase(F.lds, g, S, E);
        SEAM(5);
    }
    if (IN(6)) {
        pg8::Gemm g{(const bf16_t*)(ws + WS_MIX), D_, D_, D_};
        pg8::StaticOrder S; S.init(g.A, D_, (const bf16_t*)(ws + WS_WOUT), D_, M_, D_, F.G, cid);
        pg8::EpiRes E{args.in[0], (bf16_t*)(ws + WS_X1B)};
        pg8::gemm_phase(F.lds, g, S, E);
        SEAM(6);
    }
    if (IN(7)) { p8_router(F, args); SEAM(7); }
    if (IN(8)) {
        moe_table(F);
        pg8::Gemm g{(const bf16_t*)(ws + WS_H2F8), D_ / 2, D_ / 2, D_ / 2};
        MoeOrder S; S.init(g.A, D_ / 2, (const bf16_t*)(ws + WS_WUP), D_ / 2, (size_t)2 * DFF * D_ / 2, 8, (const int*)(ws + WS_LIST), F.MISC, 1, F.G, cid);
        pg8::EpiSwiglu8 E{(unsigned char*)(ws + WS_ACT), args.in[17]};
        pg8::gemm_phase<pg8::EpiSwiglu8, MoeOrder, true>(F.lds, g, S, E);
        SEAM(8);
    }
    if (IN(9)) {
        moe_table(F);
        pg8::Gemm g{(const bf16_t*)(ws + WS_ACT), DFF / 2, DFF / 2, DFF / 2};
        MoeOrder S; S.init(g.A, DFF / 2, (const bf16_t*)(ws + WS_WDN), DFF / 2, (size_t)D_ * DFF / 2, 4, (const int*)(ws + WS_LIST), F.MISC, 0, F.G, cid);
        pg8::EpiDown E{(bf16_t*)(ws + WS_YB), args.in[19], (const int*)(ws + WS_LIST), (const float*)(ws + WS_LISTW)};
        pg8::gemm_phase<pg8::EpiDown, MoeOrder, true>(F.lds, g, S, E);
        SEAM(9);
    }
    if (IN(10)) { p12_combine(F, args); STAMP(11); }
#undef IN
#undef SEAM
}
static int g_grid = 0;
static int setup_grid() {
    if (g_grid == 0) {
        int dev = 0, cus = 0;
        if (hipGetDevice(&dev) != hipSuccess || hipDeviceGetAttribute(&cus, hipDeviceAttributeMultiprocessorCount, dev) != hipSuccess) { g_grid = -1; return g_grid; }
        if (hipFuncSetAttribute((const void*)mega, hipFuncAttributeMaxDynamicSharedMemorySize, LDS_BYTES) != hipSuccess) { g_grid = -1; return g_grid; }
        int per_cu = 0;
        (void)hipOccupancyMaxActiveBlocksPerMultiprocessor(&per_cu, (const void*)mega, NTHR, LDS_BYTES);
        (void)hipGetLastError();
        g_grid = cus;
    }
    return g_grid;
}
static void launch_mega(void* const* d_in, void* d_out, void* d_ws, int lo, int hi, hipStream_t stream) {
    Args a; memset(&a, 0, sizeof(a));
    for (int i = 0; i < 20; ++i) a.in[i] = (const float*)d_in[i];
    a.out = (float*)d_out; a.ws = (unsigned char*)d_ws; a.ph_lo = lo; a.ph_hi = hi;
    hipLaunchKernelGGL(mega, dim3(g_grid), dim3(NTHR), LDS_BYTES, stream, a);
}
extern "C" void kernel_launch(void* const* d_in, const int* in_sizes, int n_in, void* d_out, int out_size, void* d_ws, size_t ws_size, hipStream_t stream) {
    if (n_in != 20 || ws_size < WS_OPT_END || out_size != M_ * D_) { fprintf(stderr, "kernel_launch: unexpected arguments\n"); return; }
    if (setup_grid() <= 0) return;
    (void)hipMemsetAsync((char*)d_ws + WS_CTL, 0, CTL_ZERO_BYTES, stream);
#if N_LAUNCH_SPLIT
    for (int p = 0; p < N_PHASES; ++p) { launch_mega(d_in, d_out, d_ws, p, p + 1, stream); if (p == DUP_PHASE) { if (p == 7) (void)hipMemsetAsync((char*)d_ws + WS_CTL, 0, 128, stream); if (p == 10) launch_mega(d_in, d_out, d_ws, 6, 7, stream); launch_mega(d_in, d_out, d_ws, p, p + 1, stream); } }
#else
    launch_mega(d_in, d_out, d_ws, 0, N_PHASES, stream);
#endif
}
```
